# Optimizing an MI355X kernel written in HIP

```python
import math
import jax, jax.numpy as jnp
from jax import lax
import numpy as np

D_MODEL = 4096
BATCH = 4
SEQ = 4096
DEPTH = 2

DN_ALPHA = (2 * DEPTH) ** 0.25
DN_BETA = (8 * DEPTH) ** -0.25
LN_EPS = 1e-5
RMS_EPS = 1e-6
NEG_INF = -1e30
FORCE_SCORE = 1e9

MIX_WIDTH = D_MODEL

A_HEADS = 4
A_DQK = 256
A_DV = 512
A_QK = A_HEADS * A_DQK
A_V = A_HEADS * A_DV
A_CHUNK = 64
A_GATE_CAP = 15.0

B_HEADS = 16
B_Q_LORA = 1024
B_KV_LORA = 512
B_NOPE = 128
B_ROPE = 64
B_DV = 128
ROPE_THETA = 10000.0
Q_BLOCK = 128

C_HEADS = 32
C_KV_GROUPS = 4
C_HD = 128
C_KV = C_KV_GROUPS * C_HD
C_CMP_LEN = 32
C_CMP_STRIDE = 16
C_SEL_LEN = 64
C_N_SEL = 16
C_WINDOW = 512
C_CMP_HIDDEN = 256
C_Q_BLOCK = 64

FFN_HIDDEN = -(-(8 * D_MODEL) // (3 * 256)) * 256

AB_SPLITS = [int(v) for v in np.cumsum([A_QK, A_QK, A_V, A_HEADS, A_HEADS, A_V, B_Q_LORA, B_KV_LORA])]
AB_IN = AB_SPLITS[-1] + B_ROPE
C_SPLITS = [int(v) for v in np.cumsum([C_HEADS * C_HD] + [C_KV] * 6)]
C_IN = C_SPLITS[-1] + 3 * C_HEADS

kernel_name = "hybrid_mlstm_mla_nsa_deepnorm"


def layer_norm(x, g, b):
    xf = x.astype(jnp.float32)
    mu = jnp.mean(xf, -1, keepdims=True)
    var = jnp.mean(jnp.square(xf - mu), -1, keepdims=True)
    return ((xf - mu) * lax.rsqrt(var + LN_EPS) * g + b).astype(x.dtype)


def rms_norm(x, g):
    xf = x.astype(jnp.float32)
    return (xf * lax.rsqrt(jnp.mean(xf * xf, -1, keepdims=True) + RMS_EPS) * g).astype(x.dtype)


def rope(x, pos):
    half = x.shape[-1] // 2
    inv = ROPE_THETA ** (-jnp.arange(half, dtype=jnp.float32) / half)
    ang = pos.astype(jnp.float32)[:, None] * inv[None, :]
    cos, sin = jnp.cos(ang)[:, None, :], jnp.sin(ang)[:, None, :]
    xf = x.astype(jnp.float32)
    x1, x2 = xf[..., :half], xf[..., half:]
    return jnp.concatenate([x1 * cos - x2 * sin, x1 * sin + x2 * cos], -1).astype(x.dtype)


def masked_softmax(s, mask, axis=-1):
    s = jnp.where(mask, s.astype(jnp.float32), NEG_INF)
    return jax.nn.softmax(s, axis=axis) * mask


def soft_cap(z):
    return A_GATE_CAP * jnp.tanh(z / A_GATE_CAP)


def mlstm_chunkwise(q, k, v, logi, logf):
    B, S, H, DQK = q.shape
    DV = v.shape[-1]
    nc = S // A_CHUNK

    def to_chunks(t):
        t = t.reshape((B, nc, A_CHUNK, H) + t.shape[3:])
        return jnp.moveaxis(t, (1, 3), (0, 2))

    causal = jnp.tril(jnp.ones((A_CHUNK, A_CHUNK), bool))

    def step(carry, inp):
        C, n, m = carry
        qc, kc, vc, li, lf = inp
        b = jnp.cumsum(lf, axis=-1)
        dmat = jnp.where(causal, b[..., :, None] - b[..., None, :] + li[..., None, :], -jnp.inf)
        m_inter = b + m[..., None]
        m_t = jnp.maximum(m_inter, jnp.max(dmat, -1))
        w_inter = jnp.exp(m_inter - m_t)
        s = jnp.einsum('bhtd,bhsd->bhts', qc, kc) * jnp.exp(dmat - m_t[..., None])
        num = w_inter[..., None] * jnp.einsum('bhtd,bhde->bhte', qc, C) + jnp.einsum('bhts,bhse->bhte', s, vc)
        den = w_inter * jnp.einsum('bhtd,bhd->bht', qc, n) + jnp.sum(s, -1)
        h = num / jnp.maximum(jnp.abs(den), jnp.exp(-m_t))[..., None]
        g = b[..., -1]
        w_s = g[..., None] - b + li
        m_new = jnp.maximum(g + m, jnp.max(w_s, -1))
        decay = jnp.exp(g + m - m_new)
        kw = kc * jnp.exp(w_s - m_new[..., None])[..., None]
        C_new = decay[..., None, None] * C + jnp.einsum('bhsd,bhse->bhde', kw, vc)
        n_new = decay[..., None] * n + jnp.sum(kw, axis=2)
        return (C_new, n_new, m_new), h

    f32 = jnp.float32
    init = (jnp.zeros((B, H, DQK, DV), f32), jnp.zeros((B, H, DQK), f32), jnp.zeros((B, H), f32))
    _, hs = lax.scan(step, init, (to_chunks(q), to_chunks(k), to_chunks(v), to_chunks(logi), to_chunks(logf)))
    return jnp.moveaxis(hs, (0, 2), (1, 3)).reshape(B, S, H, DV)


def mla_attention(q_nope, q_rope, k_nope, k_rope, v):
    B, S, H, _ = q_nope.shape
    scale = (B_NOPE + B_ROPE) ** -0.5
    kpos = jnp.arange(S)

    def block(i):
        t0 = i * Q_BLOCK
        qn = lax.dynamic_slice_in_dim(q_nope, t0, Q_BLOCK, axis=1)
        qr = lax.dynamic_slice_in_dim(q_rope, t0, Q_BLOCK, axis=1)
        s = (jnp.einsum('bqhd,bkhd->bhqk', qn, k_nope) + jnp.einsum('bqhd,bkd->bhqk', qr, k_rope)) * scale
        mask = (t0 + jnp.arange(Q_BLOCK))[:, None] >= kpos[None, :]
        p = masked_softmax(s, mask)
        return jnp.einsum('bhqk,bkhd->bqhd', p.astype(v.dtype), v)

    out = lax.map(block, jnp.arange(S // Q_BLOCK))
    return jnp.moveaxis(out, 0, 1).reshape(B, S, H, v.shape[-1])


def mixer_ab(x, w_in, b_igate, b_fgate, mlstm_norm, q_norm, kv_norm, w_uq, w_ukv, w_o):
    B, S, _ = x.shape
    f32 = jnp.float32
    proj = x @ w_in
    q_a, k_a, v_a, ig, fg, og, cq, ckv, kr = jnp.split(proj, AB_SPLITS, axis=-1)
    qa = q_a.reshape(B, S, A_HEADS, A_DQK).astype(f32)
    ka = k_a.reshape(B, S, A_HEADS, A_DQK).astype(f32) * (A_DQK ** -0.5)
    va = v_a.reshape(B, S, A_HEADS, A_DV).astype(f32)
    logi = soft_cap(ig.astype(f32) + b_igate)
    logf = jax.nn.log_sigmoid(soft_cap(fg.astype(f32) + b_fgate))
    h_a = mlstm_chunkwise(qa, ka, va, logi, logf)
    h_a = rms_norm(h_a, mlstm_norm.reshape(A_HEADS, A_DV)).reshape(B, S, A_V)
    h_a = h_a * jax.nn.sigmoid(og.astype(f32))
    pos = jnp.arange(S)
    qb = (rms_norm(cq, q_norm) @ w_uq).reshape(B, S, B_HEADS, B_NOPE + B_ROPE)
    q_nope, q_rope = qb[..., :B_NOPE], rope(qb[..., B_NOPE:], pos)
    kvb = (rms_norm(ckv, kv_norm) @ w_ukv).reshape(B, S, B_HEADS, B_NOPE + B_DV)
    k_nope, v_b = kvb[..., :B_NOPE], kvb[..., B_NOPE:]
    k_rope = rope(kr.reshape(B, S, 1, B_ROPE), pos)[:, :, 0]
    h_b = mla_attention(q_nope, q_rope, k_nope, k_rope, v_b).reshape(B, S, B_HEADS * B_DV)
    h = jnp.concatenate([h_a.astype(x.dtype), h_b.astype(x.dtype)], -1)
    return h @ w_o


def mixer_c(x, w_in, b_gate, pe_k, pe_v, cmp_w1_k, cmp_w2_k, cmp_w1_v, cmp_w2_v, w_o):
    B, S, _ = x.shape
    G, HG, HD = C_KV_GROUPS, C_HEADS // C_KV_GROUPS, C_HD
    f32 = jnp.float32
    scale = HD ** -0.5
    proj = x @ w_in
    q, kc, vc, ks, vs, kw, vw, gates = jnp.split(proj, C_SPLITS, axis=-1)
    q = q.reshape(B, S, G, HG, HD)
    kc, vc, ks, vs, kw, vw = [t.reshape(B, S, G, HD) for t in (kc, vc, ks, vs, kw, vw)]
    gates = jax.nn.sigmoid(gates.astype(f32) + b_gate).reshape(B, S, 3, G, HG)

    n_cmp = (S - C_CMP_LEN) // C_CMP_STRIDE + 1
    cmp_start = jnp.arange(n_cmp) * C_CMP_STRIDE
    blk_idx = cmp_start[:, None] + jnp.arange(C_CMP_LEN)[None, :]
    cmp_end = cmp_start + C_CMP_LEN - 1

    def compress(t, pe, w1, w2):
        blocks = t[:, blk_idx] + pe[:, None, :]
        blocks = jnp.moveaxis(blocks, 3, 2).reshape(B, n_cmp, G, C_CMP_LEN * HD)
        return jax.nn.gelu(blocks @ w1) @ w2

    k_cmp = compress(kc, pe_k, cmp_w1_k, cmp_w2_k)
    v_cmp = compress(vc, pe_v, cmp_w1_v, cmp_w2_v)

    n_sel = S // C_SEL_LEN
    n_top = min(C_N_SEL, n_sel)
    sel_start = jnp.arange(n_sel) * C_SEL_LEN
    overlap = ((cmp_start[:, None] < sel_start[None, :] + C_SEL_LEN)
               & (cmp_start[:, None] + C_CMP_LEN > sel_start[None, :])).astype(f32)
    ks_blocks = jnp.moveaxis(ks.reshape(B, n_sel, C_SEL_LEN, G, HD), 3, 1)
    vs_blocks = jnp.moveaxis(vs.reshape(B, n_sel, C_SEL_LEN, G, HD), 3, 1)
    bi = jnp.arange(B)[:, None, None, None]
    gi = jnp.arange(G)[None, :, None, None]
    sblk = jnp.arange(n_sel)

    pad = ((0, 0), (C_WINDOW, 0), (0, 0), (0, 0))
    kw_pad, vw_pad = jnp.pad(kw, pad), jnp.pad(vw, pad)
    band = C_WINDOW + C_Q_BLOCK

    def block(i):
        t0 = i * C_Q_BLOCK
        tq = t0 + jnp.arange(C_Q_BLOCK)
        qb = lax.dynamic_slice_in_dim(q, t0, C_Q_BLOCK, 1).astype(f32)
        gb = lax.dynamic_slice_in_dim(gates, t0, C_Q_BLOCK, 1)
        s_c = jnp.einsum('bqghd,bngd->bghqn', qb, k_cmp) * scale
        p_c = masked_softmax(s_c, cmp_end[None, :] <= tq[:, None])
        o_c = jnp.einsum('bghqn,bngd->bqghd', p_c, v_cmp)
        imp = jnp.einsum('bghqn,ns->bgqs', p_c, overlap)
        cur = tq // C_SEL_LEN
        forced = (sblk[None, :] == 0) | (sblk[None, :] == cur[:, None]) | (sblk[None, :] == cur[:, None] - 1)
        imp = jnp.where(forced, FORCE_SCORE, imp)
        imp = jnp.where(sblk[None, :] <= cur[:, None], imp, NEG_INF)
        _, sel = lax.top_k(imp, n_top)
        k_sel = ks_blocks[bi, gi, sel]
        v_sel = vs_blocks[bi, gi, sel]
        s_s = jnp.einsum('bqghd,bgqnld->bghqnl', qb, k_sel) * scale
        kpos_s = sel[..., None] * C_SEL_LEN + jnp.arange(C_SEL_LEN)
        m_s = (kpos_s <= tq[None, None, :, None, None])[:, :, None]
        p_s = masked_softmax(s_s, m_s, axis=(-2, -1))
        o_s = jnp.einsum('bghqnl,bgqnld->bqghd', p_s, v_sel)
        kwb = lax.dynamic_slice_in_dim(kw_pad, t0, band, 1)
        vwb = lax.dynamic_slice_in_dim(vw_pad, t0, band, 1)
        kpos_w = t0 - C_WINDOW + jnp.arange(band)
        m_w = ((kpos_w[None, :] <= tq[:, None]) & (kpos_w[None, :] > tq[:, None] - C_WINDOW)
               & (kpos_w[None, :] >= 0))
        s_w = jnp.einsum('bqghd,bkgd->bghqk', qb, kwb) * scale
        p_w = masked_softmax(s_w, m_w)
        o_w = jnp.einsum('bghqk,bkgd->bqghd', p_w, vwb)
        return (gb[:, :, 0, :, :, None] * o_c + gb[:, :, 1, :, :, None] * o_s
                + gb[:, :, 2, :, :, None] * o_w)

    out = lax.map(block, jnp.arange(S // C_Q_BLOCK))
    out = jnp.moveaxis(out, 0, 1).reshape(B, S, C_HEADS * HD).astype(x.dtype)
    return out @ w_o


def swiglu(x, w_gate, w_up, w_down):
    return (jax.nn.silu(x @ w_gate) * (x @ w_up)) @ w_down


def setup_inputs(seed: int = 0) -> dict:
    key = jax.random.key(seed)
    ks = iter(jax.random.split(key, 40))
    NE, NO = (DEPTH + 1) // 2, DEPTH // 2

    def nrm(shape, scale):
        return jax.random.normal(next(ks), shape, jnp.float32) * scale

    def gain(shape):
        return 1.0 + nrm(shape, 0.02)

    return {
        "x": nrm((BATCH, SEQ, D_MODEL), 1.0),
        "ab_w_in": nrm((NE, D_MODEL, AB_IN), D_MODEL ** -0.5),
        "ab_b_igate": nrm((NE, A_HEADS), 0.1),
        "ab_b_fgate": 3.0 + 3.0 * jax.random.uniform(next(ks), (NE, A_HEADS), jnp.float32),
        "ab_mlstm_norm": gain((NE, A_V)),
        "ab_q_norm": gain((NE, B_Q_LORA)),
        "ab_kv_norm": gain((NE, B_KV_LORA)),
        "ab_w_uq": nrm((NE, B_Q_LORA, B_HEADS * (B_NOPE + B_ROPE)), B_Q_LORA ** -0.5),
        "ab_w_ukv": nrm((NE, B_KV_LORA, B_HEADS * (B_NOPE + B_DV)), B_KV_LORA ** -0.5),
        "ab_w_o": nrm((NE, MIX_WIDTH, D_MODEL), DN_BETA * MIX_WIDTH ** -0.5),
        "c_w_in": nrm((NO, D_MODEL, C_IN), D_MODEL ** -0.5),
        "c_b_gate": nrm((NO, 3 * C_HEADS), 0.1),
        "c_pe_k": nrm((NO, C_CMP_LEN, C_HD), 0.1),
        "c_pe_v": nrm((NO, C_CMP_LEN, C_HD), 0.1),
        "c_cmp_w1_k": nrm((NO, C_CMP_LEN * C_HD, C_CMP_HIDDEN), (C_CMP_LEN * C_HD) ** -0.5),
        "c_cmp_w2_k": nrm((NO, C_CMP_HIDDEN, C_HD), C_CMP_HIDDEN ** -0.5),
        "c_cmp_w1_v": nrm((NO, C_CMP_LEN * C_HD, C_CMP_HIDDEN), (C_CMP_LEN * C_HD) ** -0.5),
        "c_cmp_w2_v": nrm((NO, C_CMP_HIDDEN, C_HD), C_CMP_HIDDEN ** -0.5),
        "c_w_o": nrm((NO, MIX_WIDTH, D_MODEL), DN_BETA * MIX_WIDTH ** -0.5),
        "ffn_w_gate": nrm((DEPTH, D_MODEL, FFN_HIDDEN), D_MODEL ** -0.5),
        "ffn_w_up": nrm((DEPTH, D_MODEL, FFN_HIDDEN), D_MODEL ** -0.5),
        "ffn_w_down": nrm((DEPTH, FFN_HIDDEN, D_MODEL), DN_BETA * FFN_HIDDEN ** -0.5),
        "ln_mix_g": gain((DEPTH, D_MODEL)),
        "ln_mix_b": nrm((DEPTH, D_MODEL), 0.02),
        "ln_ffn_g": gain((DEPTH, D_MODEL)),
        "ln_ffn_b": nrm((DEPTH, D_MODEL), 0.02),
    }


def reference(x, ab_w_in, ab_b_igate, ab_b_fgate, ab_mlstm_norm, ab_q_norm, ab_kv_norm, ab_w_uq, ab_w_ukv,
              ab_w_o, c_w_in, c_b_gate, c_pe_k, c_pe_v, c_cmp_w1_k, c_cmp_w2_k, c_cmp_w1_v, c_cmp_w2_v, c_w_o,
              ffn_w_gate, ffn_w_up, ffn_w_down, ln_mix_g, ln_mix_b, ln_ffn_g, ln_ffn_b):
    for layer in range(DEPTH):
        j = layer // 2
        if layer % 2 == 0:
            y = mixer_ab(x, ab_w_in[j], ab_b_igate[j], ab_b_fgate[j], ab_mlstm_norm[j], ab_q_norm[j],
                         ab_kv_norm[j], ab_w_uq[j], ab_w_ukv[j], ab_w_o[j])
        else:
            y = mixer_c(x, c_w_in[j], c_b_gate[j], c_pe_k[j], c_pe_v[j], c_cmp_w1_k[j], c_cmp_w2_k[j],
                        c_cmp_w1_v[j], c_cmp_w2_v[j], c_w_o[j])
        x = layer_norm(DN_ALPHA * x + y, ln_mix_g[layer], ln_mix_b[layer])
        x = layer_norm(DN_ALPHA * x + swiglu(x, ffn_w_gate[layer], ffn_w_up[layer], ffn_w_down[layer]),
                       ln_ffn_g[layer], ln_ffn_b[layer])
    return x
```

```cpp
#include <hip/hip_runtime.h>
#include <stdint.h>
#include <stdio.h>

typedef unsigned short bf16_t;
typedef short bf16x8 __attribute__((ext_vector_type(8)));
typedef short s16x4 __attribute__((ext_vector_type(4)));
typedef float f32x2 __attribute__((ext_vector_type(2)));
typedef float f32x4 __attribute__((ext_vector_type(4)));
typedef float f32x16 __attribute__((ext_vector_type(16)));
typedef unsigned u32x2 __attribute__((ext_vector_type(2)));
typedef unsigned u32x4 __attribute__((ext_vector_type(4)));

constexpr int M_TOK = 16384, SEQ = 4096, NBATCH = 4, DM = 4096;
constexpr int AB_IN = 7752, AB_NP = 7936, C_IN = 7264, C_NP = 7424, FFH = 11008, GU_N = 22016;
constexpr float DN_ALPHA = 1.4142135623730951f;
constexpr float LN_EPS = 1e-5f, RMS_EPS = 1e-6f;
constexpr int AB_Q = 0, AB_K = 1024, AB_V = 2048, AB_IG = 4096, AB_FG = 4100, AB_OG = 4104, AB_CQ = 6152, AB_CKV = 7176, AB_KR = 7688;
constexpr int C_Q = 0, C_KC = 4096, C_VC = 4608, C_KS = 5120, C_VS = 5632, C_KW = 6144, C_VW = 6656, C_GATE = 7168;

__device__ __forceinline__ float bf2f(bf16_t b) { return __uint_as_float(((unsigned)b) << 16); }
__device__ __forceinline__ unsigned cvt_pk_bf16(float lo, float hi) { unsigned r; asm volatile("v_cvt_pk_bf16_f32 %0, %1, %2" : "=v"(r) : "v"(lo), "v"(hi)); return r; }
__device__ __forceinline__ bf16_t f2bf(float f) { return (bf16_t)(cvt_pk_bf16(f, 0.f) & 0xffffu); }
__device__ __forceinline__ void unpack8(const bf16x8 v, float (&f)[8]) {
#pragma unroll
    for (int j = 0; j < 8; ++j) f[j] = bf2f((bf16_t)v[j]);
}
__device__ __forceinline__ bf16x8 pack8f(const float (&f)[8]) {
    u32x4 w = {cvt_pk_bf16(f[0], f[1]), cvt_pk_bf16(f[2], f[3]), cvt_pk_bf16(f[4], f[5]), cvt_pk_bf16(f[6], f[7])};
    return *reinterpret_cast<bf16x8*>(&w);
}
__device__ __forceinline__ float wave_sum(float v) {
#pragma unroll
    for (int o = 32; o >= 1; o >>= 1) v += __shfl_xor(v, o);
    return v;
}
__device__ __forceinline__ float sigmoid_f(float x) { return __builtin_amdgcn_rcpf(1.0f + __expf(-x)); }

#define XB_TMO      128
#define XB_XCNT(j)  (256  + 64 * (j))
#define XB_XSUB(j)  (1280 + 64 * (j))
#define XB_XGEN(j)  (2304 + 64 * (j))
#define XB_TOP      3328
#define XB_TOPGEN   3392
#define XCD_BAR_WORDS 3456
#define XB_SPIN_CAP (1u << 22)
#define LAS __attribute__((address_space(3)))

__device__ __forceinline__ unsigned xb_ld(unsigned* p)              { return __hip_atomic_load(p, __ATOMIC_RELAXED, __HIP_MEMORY_SCOPE_AGENT); }
__device__ __forceinline__ unsigned xb_add(unsigned* p, unsigned v) { return __hip_atomic_fetch_add(p, v, __ATOMIC_RELAXED, __HIP_MEMORY_SCOPE_AGENT); }
__device__ __forceinline__ unsigned xb_xcc_id() { return (unsigned)__builtin_amdgcn_s_getreg((3 << 11) | 20) & 0xFu; }
#define XB_SPIN(cond, bar) do { unsigned _sp = 0; while (cond) { __builtin_amdgcn_s_sleep(1); \
    if ((++_sp & 255u) == 0u) { if (xb_ld(&(bar)[XB_TMO])) break; if (_sp > XB_SPIN_CAP) { atomicAdd(&(bar)[XB_TMO], 1u); break; } } } } while (0)

struct XcdBarrier {
    unsigned* bar; unsigned x;
    volatile LAS unsigned* st;
};

__device__ __forceinline__ XcdBarrier xcd_barrier_post(unsigned* bar, volatile LAS unsigned* st) {
    XcdBarrier b; b.bar = bar; b.x = xb_xcc_id(); b.st = st;
    if (threadIdx.x == 0) (void)xb_add(&bar[XB_XCNT(b.x)], 1u);
    return b;
}
__device__ __forceinline__ void xcd_barrier_complete(unsigned* bar, unsigned x, unsigned& nloc, unsigned& nx) {
    const unsigned G = gridDim.x * gridDim.y * gridDim.z;
    unsigned sum, cnt, mine, sp = 0u;
    for (;;) {
        sum = 0u; cnt = 0u; mine = 0u;
#pragma unroll
        for (unsigned j = 0; j < 16; ++j) { const unsigned c = xb_ld(&bar[XB_XCNT(j)]); sum += c; cnt += (c > 0u) ? 1u : 0u; mine = (j == x) ? c : mine; }
        if (sum == G) break;
        __builtin_amdgcn_s_sleep(1);
        if ((++sp & 255u) == 0u) { if (xb_ld(&bar[XB_TMO])) break; if (sp > XB_SPIN_CAP) { atomicAdd(&bar[XB_TMO], 1u); break; } }
    }
    nloc = mine > 0u ? mine : 1u; nx = cnt > 0u ? cnt : 1u;
}

__device__ __forceinline__ void xcd_barrier(const XcdBarrier& b) {
    asm volatile("s_waitcnt vmcnt(0)" ::: "memory");
    __syncthreads();
    if (threadIdx.x == 0) {
        unsigned* bar = b.bar;
        __builtin_amdgcn_s_waitcnt(0);
        unsigned nloc = b.st[0], nx = b.st[1];
        if (nloc == 0u) { xcd_barrier_complete(bar, b.x, nloc, nx); b.st[0] = nloc; b.st[1] = nx; }
        const unsigned old = xb_add(&bar[XB_XSUB(b.x)], 1u);
        const unsigned gen = old / nloc;
        if (old + 1u == (gen + 1u) * nloc) {
            __builtin_amdgcn_fence(__ATOMIC_RELEASE, "agent");
            asm volatile("s_waitcnt vmcnt(0)" ::: "memory");
            const unsigned og = xb_add(&bar[XB_TOP], 1u);
            const unsigned tg = og / nx;
            if (og + 1u == (tg + 1u) * nx) xb_add(&bar[XB_TOPGEN], 1u);
            else XB_SPIN(xb_ld(&bar[XB_TOPGEN]) == tg, bar);
            __builtin_amdgcn_fence(__ATOMIC_ACQUIRE, "agent");
            xb_add(&bar[XB_XGEN(b.x)], 1u);
            asm volatile("s_waitcnt vmcnt(0)" ::: "memory");
        } else {
            XB_SPIN(xb_ld(&bar[XB_XGEN(b.x)]) == gen, bar);
            __builtin_amdgcn_fence(__ATOMIC_ACQUIRE, "agent");
            asm volatile("s_waitcnt vmcnt(0)" ::: "memory");
        }
    }
    __syncthreads();
}namespace pg8 {
#define PG8_LAS __attribute__((address_space(3)))
typedef unsigned short bf16_t;
typedef short bf16x8 __attribute__((ext_vector_type(8)));
typedef float f32x4 __attribute__((ext_vector_type(4)));
typedef unsigned u32x4 __attribute__((ext_vector_type(4)));
constexpr int BM = 256, BK = 64, HALF = 128, HTB = HALF * BK * 2  , STAGE_BYTES = 8 * HTB, NXCD = 8, WGM = 8;

__host__ __device__ __forceinline__ int lds_byte(int r, int c) { const int st = (r >> 4) * 2 + (c >> 5), rr = r & 15, cc = c & 31, ob = rr * 64 + cc * 2; return st * 1024 + (ob ^ (((ob >> 9) & 1) << 5)); }
__host__ __device__ __forceinline__ void stage_rc(int b, int& R, int& C) { const int st = b / 1024, sb = b % 1024, swz = sb ^ (((sb >> 9) & 1) << 5); R = (st >> 1) * 16 + swz / 64; C = (st & 1) * 32 + (swz % 64) / 2; }
__host__ __device__ __forceinline__ int perm32(int rho) { const int n = rho >> 4, i = rho & 15; return 8 * (i >> 2) + 4 * n + (i & 3); }

struct Unit { int pm, pn; };
struct Gemm { const bf16_t* A; const bf16_t* Bt; int M, N, K; };

struct StaticOrder {
    int nM, nN, nwg, G, c;
    __host__ __device__ void init(int M, int N, int G_, int c_) { nM = M / BM; nN = N / BM; nwg = nM * nN; G = G_; c = c_; }
    __host__ __device__ bool next(int i, Unit& u) const {
        const long L = (long)i * G + c; if (L >= nwg) return false;
        int wgid = (int)L; { const int q = nwg / NXCD, r = nwg % NXCD, xcd = wgid % NXCD, off = wgid / NXCD; wgid = (xcd < r ? xcd * (q + 1) : r * (q + 1) + (xcd - r) * q) + off; }
        const int nig = WGM * nN, gid = wgid / nig, fm = gid * WGM, gsz = (nM - fm) < WGM ? (nM - fm) : WGM;
        u.pm = fm + ((wgid % nig) % gsz); u.pn = (wgid % nig) / gsz; return true;
    }
    __device__ __forceinline__ void a_ready(const Unit&) const {}
    __device__ __forceinline__ void done(const Unit&) const {}
};
struct CountedOrder : StaticOrder {
    const unsigned* ready; unsigned need; unsigned* tmo;
    __device__ __forceinline__ void a_ready(const Unit& u) const {
        if (threadIdx.x < 64) {
            const unsigned long long t0 = __builtin_amdgcn_s_memrealtime(); unsigned polls = 0;
            while ((unsigned)__builtin_amdgcn_readfirstlane(__hip_atomic_load(ready + 64 * u.pm, __ATOMIC_RELAXED, __HIP_MEMORY_SCOPE_AGENT)) < need) {
                if ((++polls & 255u) == 0u && __builtin_amdgcn_readfirstlane(__hip_atomic_load(tmo, __ATOMIC_RELAXED, __HIP_MEMORY_SCOPE_AGENT)) != 0u) break;
                if (__builtin_amdgcn_s_memrealtime() - t0 > 2000000ull) {
                    if (threadIdx.x == 0) { unsigned expect = 0u; __hip_atomic_compare_exchange_strong(tmo + 1, &expect, 0x600u | (unsigned)(u.pm & 0xff), __ATOMIC_RELAXED, __ATOMIC_RELAXED, __HIP_MEMORY_SCOPE_AGENT); __hip_atomic_store(tmo, 1u, __ATOMIC_RELAXED, __HIP_MEMORY_SCOPE_AGENT); }
                    break; }
                __builtin_amdgcn_s_sleep(2); }
            __builtin_amdgcn_fence(__ATOMIC_ACQUIRE, "agent");
            asm volatile("s_waitcnt vmcnt(0)" ::: "memory");
        }
#if !defined(BROKEN_HOOK_NO_BARRIER)
        asm volatile("" ::: "memory"); __builtin_amdgcn_s_barrier(); asm volatile("" ::: "memory");
#endif
    }
};

__device__ __forceinline__ unsigned cvt_pk_bf16(float lo, float hi) { unsigned r; asm volatile("v_cvt_pk_bf16_f32 %0, %1, %2" : "=v"(r) : "v"(lo), "v"(hi)); return r; }
typedef float f32x2 __attribute__((ext_vector_type(2)));
__device__ __forceinline__ f32x2 gelu_pk(f32x2 v) {
    const f32x2 av = __builtin_elementwise_abs(v), d = av * 0.2316418882f + 1.0f;
    f32x2 t; t.x = __builtin_amdgcn_rcpf(d.x); t.y = __builtin_amdgcn_rcpf(d.y);
    f32x2 q = t * 0.5307027145f + (-0.7265760135f); q = q * t + 0.7107068705f; q = q * t + (-0.142248368f); q = q * t + 0.127414796f; q = q * t;
    const f32x2 s = (v * v) * (-0.72134752044f);
    f32x2 e; e.x = __builtin_amdgcn_exp2f(s.x); e.y = __builtin_amdgcn_exp2f(s.y);
    const f32x2 m = v * (q * e), r = v - m;
    f32x2 o; o.x = v.x < 0.f ? m.x : r.x; o.y = v.y < 0.f ? m.y : r.y; return o;
}

struct EpiF32 {
    static constexpr bool PERM = false, AFTER_DRAIN = false;
    float* C; int ldc; const float* bias;
    __device__ __forceinline__ void operator()(const f32x4 (&acc)[2][2][4][2], const Unit& u, int wr, int wc, int fr, int fq) const {
        const int row0 = u.pm * BM + wr * 64 + fr, col0 = u.pn * BM + wc * 32 + 4 * fq;
        f32x4 bv[2][2];
#pragma unroll
        for (int bj = 0; bj < 2; ++bj)
#pragma unroll
            for (int n = 0; n < 2; ++n) bv[bj][n] = bias ? *(const f32x4*)(bias + col0 + bj * HALF + n * 16) : (f32x4){0.f, 0.f, 0.f, 0.f};
#pragma unroll
        for (int ai = 0; ai < 2; ++ai)
#pragma unroll
            for (int m = 0; m < 4; ++m) { float* rowp = C + (size_t)(row0 + ai * HALF + m * 16) * ldc + col0;
#pragma unroll
                for (int bj = 0; bj < 2; ++bj)
#pragma unroll
                    for (int n = 0; n < 2; ++n) *(f32x4*)(rowp + bj * HALF + n * 16) = acc[ai][bj][m][n] + bv[bj][n]; }
    }
};
template <int ACT  > struct EpiBf16 {
    static constexpr bool PERM = true, AFTER_DRAIN = false;
    bf16_t* O; int ldc; const float* bias; int split_cols; size_t split_stride;
    __device__ __forceinline__ void operator()(const f32x4 (&acc)[2][2][4][2], const Unit& u, int wr, int wc, int fr, int fq) const {
        const int row0 = u.pm * BM + wr * 64 + fr; int colt = u.pn * BM; bf16_t* base = O;
        if (split_cols) { const int t = colt / split_cols; base += (size_t)t * split_stride; colt -= t * split_cols; }
        const int col0 = colt + wc * 32 + 8 * fq, bcol0 = u.pn * BM + wc * 32 + 8 * fq;
        f32x4 bv[2][2];
#pragma unroll
        for (int bj = 0; bj < 2; ++bj)
#pragma unroll
            for (int n = 0; n < 2; ++n) bv[bj][n] = bias ? *(const f32x4*)(bias + bcol0 + bj * HALF + 4 * n) : (f32x4){0.f, 0.f, 0.f, 0.f};
#pragma unroll
        for (int ai = 0; ai < 2; ++ai)
#pragma unroll
            for (int m = 0; m < 4; ++m) { bf16_t* rowp = base + (size_t)(row0 + ai * HALF + m * 16) * ldc + col0;
#pragma unroll
                for (int bj = 0; bj < 2; ++bj) { f32x4 v0 = acc[ai][bj][m][0] + bv[bj][0], v1 = acc[ai][bj][m][1] + bv[bj][1];
                    if (ACT == 1) { f32x2 a = gelu_pk((f32x2){v0[0], v0[1]}), b = gelu_pk((f32x2){v0[2], v0[3]}), c = gelu_pk((f32x2){v1[0], v1[1]}), d = gelu_pk((f32x2){v1[2], v1[3]});
                        v0 = (f32x4){a.x, a.y, b.x, b.y}; v1 = (f32x4){c.x, c.y, d.x, d.y}; }
                    if (ACT == 2) {
#pragma unroll
                        for (int j = 0; j < 4; ++j) { v0[j] = 0.5f * v0[j] * (1.0f + erff(v0[j] * 0.70710678f)); v1[j] = 0.5f * v1[j] * (1.0f + erff(v1[j] * 0.70710678f)); } }
                    u32x4 w; w.x = cvt_pk_bf16(v0[0], v0[1]); w.y = cvt_pk_bf16(v0[2], v0[3]); w.z = cvt_pk_bf16(v1[0], v1[1]); w.w = cvt_pk_bf16(v1[2], v1[3]);
                    *(u32x4*)(rowp + bj * HALF) = w; } }
    }
};
__device__ __forceinline__ float silu_f(float g) { return g * __builtin_amdgcn_rcpf(1.0f + __expf(-g)); }
__device__ __forceinline__ float gelu_tanh_f(float x) { const float y = 0.7978845608028654f * (x + 0.044715f * x * x * x); const float e = __expf(2.0f * y); const float t = 1.0f - 2.0f * __builtin_amdgcn_rcpf(e + 1.0f); return 0.5f * x * (1.0f + t); }
template <int ACT> struct EpiB {
    static constexpr bool PERM = true, AFTER_DRAIN = false;
    bf16_t* O; int ldc;
    __device__ __forceinline__ void operator()(const f32x4 (&acc)[2][2][4][2], const Unit& u, int wr, int wc, int fr, int fq) const {
        const int row0 = u.pm * BM + wr * 64 + fr, col0 = u.pn * BM + wc * 32 + 8 * fq;
#pragma unroll
        for (int ai = 0; ai < 2; ++ai)
#pragma unroll
            for (int m = 0; m < 4; ++m) { bf16_t* rowp = O + (size_t)(row0 + ai * HALF + m * 16) * ldc + col0;
#pragma unroll
                for (int bj = 0; bj < 2; ++bj) { f32x4 v0 = acc[ai][bj][m][0], v1 = acc[ai][bj][m][1];
                    if (ACT == 1) {
#pragma unroll
                        for (int j = 0; j < 4; ++j) { v0[j] = gelu_tanh_f(v0[j]); v1[j] = gelu_tanh_f(v1[j]); } }
                    u32x4 w; w.x = cvt_pk_bf16(v0[0], v0[1]); w.y = cvt_pk_bf16(v0[2], v0[3]); w.z = cvt_pk_bf16(v1[0], v1[1]); w.w = cvt_pk_bf16(v1[2], v1[3]);
                    *(u32x4*)(rowp + bj * HALF) = w; } }
    }
};
struct EpiProj {
    static constexpr bool PERM = true, AFTER_DRAIN = false;
    bf16_t* O; int ldc; float* gates; int gate_pn;
    __device__ __forceinline__ void operator()(const f32x4 (&acc)[2][2][4][2], const Unit& u, int wr, int wc, int fr, int fq) const {
        const int row0 = u.pm * BM + wr * 64 + fr, col0 = u.pn * BM + wc * 32 + 8 * fq;
#pragma unroll
        for (int ai = 0; ai < 2; ++ai)
#pragma unroll
            for (int m = 0; m < 4; ++m) { bf16_t* rowp = O + (size_t)(row0 + ai * HALF + m * 16) * ldc + col0;
#pragma unroll
                for (int bj = 0; bj < 2; ++bj) { const f32x4 v0 = acc[ai][bj][m][0], v1 = acc[ai][bj][m][1];
                    u32x4 w; w.x = cvt_pk_bf16(v0[0], v0[1]); w.y = cvt_pk_bf16(v0[2], v0[3]); w.z = cvt_pk_bf16(v1[0], v1[1]); w.w = cvt_pk_bf16(v1[2], v1[3]);
                    *(u32x4*)(rowp + bj * HALF) = w; } }
        if (u.pn == gate_pn && wc == 0 && fq == 0) {
#pragma unroll
            for (int ai = 0; ai < 2; ++ai)
#pragma unroll
                for (int m = 0; m < 4; ++m) { float* g = gates + (size_t)(row0 + ai * HALF + m * 16) * 8;
                    *(f32x4*)g = acc[ai][0][m][0]; *(f32x4*)(g + 4) = acc[ai][0][m][1]; }
        }
    }
};
struct EpiSwiGLU {
    static constexpr bool PERM = true, AFTER_DRAIN = false;
    bf16_t* H; int ldh;
    __device__ __forceinline__ void operator()(const f32x4 (&acc)[2][2][4][2], const Unit& u, int wr, int wc, int fr, int fq) const {
        const int row0 = u.pm * BM + wr * 64 + fr, col0 = u.pn * HALF + wc * 32 + 8 * fq;
#pragma unroll
        for (int ai = 0; ai < 2; ++ai)
#pragma unroll
            for (int m = 0; m < 4; ++m) { bf16_t* rowp = H + (size_t)(row0 + ai * HALF + m * 16) * ldh + col0;
                const f32x4 g0 = acc[ai][0][m][0], g1 = acc[ai][0][m][1], u0 = acc[ai][1][m][0], u1 = acc[ai][1][m][1];
                float h[8];
#pragma unroll
                for (int j = 0; j < 4; ++j) { h[j] = silu_f(g0[j]) * u0[j]; h[4 + j] = silu_f(g1[j]) * u1[j]; }
                u32x4 w; w.x = cvt_pk_bf16(h[0], h[1]); w.y = cvt_pk_bf16(h[2], h[3]); w.z = cvt_pk_bf16(h[4], h[5]); w.w = cvt_pk_bf16(h[6], h[7]);
                *(u32x4*)rowp = w; }
    }
};
struct EpiResid {
    static constexpr bool PERM = false, AFTER_DRAIN = false;
    float* C; const float* R; int ldc; float alpha;
    __device__ __forceinline__ void operator()(const f32x4 (&acc)[2][2][4][2], const Unit& u, int wr, int wc, int fr, int fq) const {
        const int row0 = u.pm * BM + wr * 64 + fr, col0 = u.pn * BM + wc * 32 + 4 * fq;
#pragma unroll
        for (int ai = 0; ai < 2; ++ai)
#pragma unroll
            for (int m = 0; m < 4; ++m) { const size_t off = (size_t)(row0 + ai * HALF + m * 16) * ldc + col0;
#pragma unroll
                for (int bj = 0; bj < 2; ++bj)
#pragma unroll
                    for (int n = 0; n < 2; ++n) { const f32x4 r = *(const f32x4*)(R + off + bj * HALF + n * 16); *(f32x4*)(C + off + bj * HALF + n * 16) = acc[ai][bj][m][n] + alpha * r; }
                asm volatile("" ::: "memory"); }
    }
};
template <class Epi, class Sched, bool STAMP = false>
__device__ __forceinline__ void gemm_phase(PG8_LAS unsigned char* lds, const Gemm g, const Sched& S, const Epi& E, unsigned long long* stamps) {
    const int tid = threadIdx.x, wid = __builtin_amdgcn_readfirstlane(tid >> 6), lane = tid & 63, wr = wid >> 2, wc = wid & 3, fr = lane & 15, fq = lane >> 4;
    const int K = g.K, nt = K / BK;
    int ts_lo = 0, ts_hi = 0, nts = 0; const unsigned long long rt_entry = STAMP ? (unsigned long long)wall_clock64() : 0ull;
#define PG8_STAMP() do { if (STAMP && wid == 0 && nts < 64) { const unsigned long long _c = (unsigned long long)clock64(); \
        ts_lo = (lane == nts) ? (int)(unsigned)_c : ts_lo; ts_hi = (lane == nts) ? (int)(unsigned)(_c >> 32) : ts_hi; ++nts; } } while (0)
    PG8_STAMP();
    unsigned voffA[2], voffB[2];
#pragma unroll
    for (int i = 0; i < 2; ++i) { int R, C; stage_rc(tid * 16 + i * 8192, R, C); const int Rb = Epi::PERM ? ((R & ~31) + perm32(R & 31)) : R;
        voffA[i] = (unsigned)(R * K + C) * 2u; voffB[i] = (unsigned)(Rb * K + C) * 2u; }
    const size_t kstep = (size_t)(BK * 2);
    const size_t hstep = (size_t)HALF * K * 2;
    const size_t tstep = 2 * hstep;
    const unsigned ldsw = (unsigned)wid * 1024u;
    const int aoff = lds_byte(wr * 64 + fr, fq * 8), boff = lds_byte(wc * 32 + fr, fq * 8);
#define PG8_SA(b, h) (((b) * 2 + (h)) * HTB)
#define PG8_SB(b, h) ((4 + (b) * 2 + (h)) * HTB)
#define PG8_STAGE(bufoff, gbase, voff) do { _Pragma("unroll") for (int _i = 0; _i < 2; ++_i) \
        __builtin_amdgcn_global_load_lds((const unsigned*)((const char*)(gbase) + (voff)[_i]), (PG8_LAS unsigned*)(lds + (bufoff) + ldsw + _i * 8192), 16, 0, 0); } while (0)
#define PG8_LDA(dst, b, h) do { _Pragma("unroll") for (int m = 0; m < 4; ++m) _Pragma("unroll") for (int k = 0; k < 2; ++k) dst[m][k] = *(const PG8_LAS bf16x8*)(lds + PG8_SA(b, h) + aoff + m * 2048 + k * 1024); } while (0)
#define PG8_LDB(dst, b, h) do { _Pragma("unroll") for (int n = 0; n < 2; ++n) _Pragma("unroll") for (int k = 0; k < 2; ++k) dst[n][k] = *(const PG8_LAS bf16x8*)(lds + PG8_SB(b, h) + boff + n * 2048 + k * 1024); } while (0)
#define PG8_MMA(ai, bj, At, Bt) do { __builtin_amdgcn_s_setprio(1); _Pragma("unroll") for (int m = 0; m < 4; ++m) _Pragma("unroll") for (int n = 0; n < 2; ++n) _Pragma("unroll") for (int k = 0; k < 2; ++k) \
        acc[ai][bj][m][n] = __builtin_amdgcn_mfma_f32_16x16x32_bf16(Bt[n][k], At[m][k], acc[ai][bj][m][n], 0, 0, 0); __builtin_amdgcn_s_setprio(0); } while (0)
#define PG8_WAIT_V(n) asm volatile("s_waitcnt vmcnt(" #n ")" ::: "memory")
#define PG8_WAIT_L(n) asm volatile("s_waitcnt lgkmcnt(" #n ")" ::: "memory")
#define PG8_BAR __builtin_amdgcn_s_barrier()
#define PG8_SCHED __builtin_amdgcn_sched_barrier(0)
    Unit cur, nxt; int ui = 0;
    if (!S.next(0, cur)) return;
    f32x4 acc[2][2][4][2];
#pragma unroll
    for (int a = 0; a < 2; ++a)
#pragma unroll
        for (int b = 0; b < 2; ++b)
#pragma unroll
            for (int m = 0; m < 4; ++m)
#pragma unroll
                for (int n = 0; n < 2; ++n) acc[a][b][m][n] = (f32x4){0.f, 0.f, 0.f, 0.f};
    bf16x8 At[4][2], B0[2][2], B1[2][2];
    const char* cA = (const char*)g.A + (size_t)cur.pm * tstep; const char* cB = (const char*)g.Bt + (size_t)cur.pn * tstep;
    S.a_ready(cur);
    PG8_STAGE(PG8_SB(0, 0), cB, voffB); PG8_STAGE(PG8_SA(0, 0), cA, voffA); PG8_STAGE(PG8_SB(0, 1), cB + hstep, voffB); PG8_STAGE(PG8_SA(0, 1), cA + hstep, voffA);
    if (wr == 1) PG8_BAR;
    PG8_WAIT_V(4); PG8_BAR;
    PG8_STAGE(PG8_SB(1, 0), cB + kstep, voffB); PG8_STAGE(PG8_SA(1, 0), cA + kstep, voffA); PG8_STAGE(PG8_SB(1, 1), cB + hstep + kstep, voffB);
    PG8_WAIT_V(6); PG8_BAR;
    PG8_STAMP();
    for (;;) {
        const bool has_next = S.next(ui + 1, nxt);
        const char* nA = has_next ? (const char*)g.A + (size_t)nxt.pm * tstep : cA; const char* nB = has_next ? (const char*)g.Bt + (size_t)nxt.pn * tstep : cB;
        for (int t = 0; t < nt; t += 2) {
            const bool last = (t == nt - 2);
            const char* a1 = cA + (size_t)(t + 1) * kstep;
            const char* a2 = last ? nA : cA + (size_t)(t + 2) * kstep; const char* b2 = last ? nB : cB + (size_t)(t + 2) * kstep;
            const char* a3 = a2 + kstep; const char* b3 = b2 + kstep;
            if (last && has_next) S.a_ready(nxt);
            PG8_LDB(B0, 0, 0); PG8_SCHED; PG8_LDA(At, 0, 0); PG8_STAGE(PG8_SA(1, 1), a1 + hstep, voffA);
            PG8_WAIT_L(8); PG8_BAR; PG8_WAIT_L(0); PG8_MMA(0, 0, At, B0); PG8_BAR; PG8_SCHED;
            PG8_LDB(B1, 0, 1); PG8_STAGE(PG8_SB(0, 0), b2, voffB);
            PG8_BAR; PG8_WAIT_L(0); PG8_MMA(0, 1, At, B1); PG8_BAR;
            PG8_LDA(At, 0, 1); PG8_STAGE(PG8_SA(0, 0), a2, voffA);
            PG8_BAR; PG8_WAIT_L(0); PG8_MMA(1, 0, At, B0); PG8_BAR; PG8_SCHED;
            PG8_STAGE(PG8_SB(0, 1), b2 + hstep, voffB);
            PG8_WAIT_V(6); PG8_BAR; PG8_MMA(1, 1, At, B1); PG8_BAR;
            PG8_LDB(B0, 1, 0); PG8_SCHED; PG8_LDA(At, 1, 0); PG8_STAGE(PG8_SA(0, 1), a2 + hstep, voffA);
            PG8_WAIT_L(8); PG8_BAR; PG8_WAIT_L(0); PG8_MMA(0, 0, At, B0); PG8_BAR; PG8_SCHED;
            PG8_LDB(B1, 1, 1); PG8_STAGE(PG8_SB(1, 0), b3, voffB);
            PG8_BAR; PG8_WAIT_L(0); PG8_MMA(0, 1, At, B1); PG8_BAR;
            PG8_LDA(At, 1, 1); PG8_STAGE(PG8_SA(1, 0), a3, voffA);
            PG8_BAR; PG8_WAIT_L(0); PG8_MMA(1, 0, At, B0); PG8_BAR; PG8_SCHED;
            PG8_STAGE(PG8_SB(1, 1), b3 + hstep, voffB);
            PG8_WAIT_V(6); PG8_BAR; PG8_MMA(1, 1, At, B1); PG8_BAR;
        }
        PG8_STAMP();
        if constexpr (!Epi::AFTER_DRAIN) { E(acc, cur, wr, wc, fr, fq); S.done(cur); }
        PG8_STAMP();
        if (!has_next) break;
#pragma unroll
        for (int a = 0; a < 2; ++a)
#pragma unroll
            for (int b = 0; b < 2; ++b)
#pragma unroll
                for (int m = 0; m < 4; ++m)
#pragma unroll
                    for (int n = 0; n < 2; ++n) acc[a][b][m][n] = (f32x4){0.f, 0.f, 0.f, 0.f};
        cur = nxt; cA = nA; cB = nB; ++ui;
    }
    PG8_WAIT_V(0);
    if (wr == 0) PG8_BAR;
    PG8_BAR;
    if constexpr (Epi::AFTER_DRAIN) { E.fused(acc, cur, wr, wc, fr, fq, lds, wid, lane); S.done(cur); }
    PG8_STAMP();
    if (STAMP && wid == 0) { stamps[lane] = lane < nts ? (((unsigned long long)(unsigned)ts_hi << 32) | (unsigned)ts_lo) : 0ull;
        if (lane == 62) stamps[62] = rt_entry; if (lane == 63) stamps[63] = (unsigned long long)wall_clock64(); }
#undef PG8_STAMP
#undef PG8_SA
#undef PG8_SB
#undef PG8_STAGE
#undef PG8_LDA
#undef PG8_LDB
#undef PG8_MMA
#undef PG8_WAIT_V
#undef PG8_WAIT_L
#undef PG8_BAR
#undef PG8_SCHED
}
}
namespace fa {
constexpr int KVBLK = 64, SHM_V = 16384, SHM_K = 16384, SHM_KR = 8192;
constexpr int OFF_V = 0, OFF_K = 2 * SHM_V, OFF_KR = OFF_K + 2 * SHM_K, OFF_WS = OFF_KR + 2 * SHM_KR, OFF_IMP = OFF_WS + 8 * 64 * 4, IMP_LD = 257, OFF_QPARK = OFF_IMP + 32 * IMP_LD * 4 + 128  , LDS_END = OFF_QPARK + 8 * 4096;
#define KSWZ(row, colB) ((row) * 256 + ((colB) ^ (((row) & 7) << 4)))
#define SBAR() __builtin_amdgcn_sched_barrier(0)
__device__ __forceinline__ int v_st(int k, int c) { const int kk = (k & ~0xC) | ((k & 4) << 1) | ((k & 8) >> 1); return ((kk >> 3) * 4 + (c >> 5)) * 512 + ((kk & 7) * 32 + (c & 31)) * 2; }
__device__ __forceinline__ int v_rd_base(int lane) { return ((lane & 3) << 3) | (((lane >> 2) & 3) << 6) | (((lane >> 4) & 1) << 5) | (((lane >> 5) & 1) << 8); }
constexpr int v_rd_off(int d0, int ks, int half) { return d0 * 512 + ks * 4096 + half * 2048; }
__device__ __forceinline__ int crow(int r, int hi) { return (r & 3) + 8 * (r >> 2) + 4 * hi; }
__device__ __forceinline__ unsigned cvtpk(float lo, float hi) { unsigned r; asm volatile("v_cvt_pk_bf16_f32 %0, %1, %2" : "=v"(r) : "v"(lo), "v"(hi)); return r; }
__device__ __forceinline__ void mask_tile(f32x16& p0, f32x16& p1, int dq, unsigned W) {
    const float NEG = -__builtin_inff();
#pragma unroll
    for (int r = 0; r < 16; ++r) {
        const int c = (r & 3) + 8 * (r >> 2);
        if ((unsigned)(dq - c) >= W) p0[r] = NEG;
        if ((unsigned)(dq - c - 32) >= W) p1[r] = NEG;
    }
}
__device__ __forceinline__ void mask_all(f32x16& p0, f32x16& p1, bool kill) {
    const float NEG = -__builtin_inff();
#pragma unroll
    for (int r = 0; r < 16; ++r) { if (kill) { p0[r] = NEG; p1[r] = NEG; } }
}
__device__ __forceinline__ void partialSM(f32x16& p0, f32x16& p1, float& m_reg, float& mn, float& alpha, float scale, float C2) {
    float pmax = p0[0];
#pragma unroll
    for (int r = 1; r < 16; ++r) pmax = fmaxf(pmax, p0[r]);
#pragma unroll
    for (int r = 0; r < 16; ++r) pmax = fmaxf(pmax, p1[r]);
    { auto rr = __builtin_amdgcn_permlane32_swap(__float_as_uint(pmax), __float_as_uint(pmax), false, false);
      pmax = fmaxf(__uint_as_float(rr[0]), __uint_as_float(rr[1])); }
    if (__builtin_expect(__all((pmax - m_reg) * scale <= 4.0f), 1)) { mn = m_reg; alpha = 1.f; }
    else { mn = fmaxf(m_reg, pmax); alpha = __builtin_amdgcn_exp2f((m_reg - mn) * C2); m_reg = mn; }
    const float mnL = -mn * C2;
#pragma unroll
    for (int r = 0; r < 16; ++r) p0[r] = fmaf(p0[r], C2, mnL);
#pragma unroll
    for (int r = 0; r < 16; ++r) p1[r] = fmaf(p1[r], C2, mnL);
#pragma unroll
    for (int r = 0; r < 16; ++r) p0[r] = __builtin_amdgcn_exp2f(p0[r]);
}
__device__ __forceinline__ void finishSM(f32x16& p0, f32x16& p1, float alpha, float& l_reg, bf16x8& pa0, bf16x8& pa1, bf16x8& pa2, bf16x8& pa3) {
#pragma unroll
    for (int r = 0; r < 16; ++r) p1[r] = __builtin_amdgcn_exp2f(p1[r]);
    float ps = 0;
#pragma unroll
    for (int r = 0; r < 16; ++r) ps += p0[r];
#pragma unroll
    for (int r = 0; r < 16; ++r) ps += p1[r];
    { auto rr = __builtin_amdgcn_permlane32_swap(__float_as_uint(ps), __float_as_uint(ps), false, false);
      ps = __uint_as_float(rr[0]) + __uint_as_float(rr[1]); }
    l_reg = l_reg * alpha + ps;
#define PK4(P, B_, OUT) do { unsigned a0 = cvtpk(P[B_+0], P[B_+1]), a1 = cvtpk(P[B_+2], P[B_+3]);                          \
        unsigned b0 = cvtpk(P[B_+4], P[B_+5]), b1 = cvtpk(P[B_+6], P[B_+7]);                                             \
        auto r0 = __builtin_amdgcn_permlane32_swap(a0, b0, false, false); auto r1 = __builtin_amdgcn_permlane32_swap(a1, b1, false, false); \
        u32x4 w = {r0[0], r1[0], r0[1], r1[1]}; OUT = *reinterpret_cast<bf16x8*>(&w); } while (0)
    PK4(p0, 0, pa0); PK4(p0, 8, pa1); PK4(p1, 0, pa2); PK4(p1, 8, pa3);
#undef PK4
}
template <int KB, bool ROPE>
__device__ __forceinline__ void qkt(f32x16& p0, f32x16& p1, const char* lds, int r32, int hi, const bf16x8* qr, const char* qpark = nullptr) {
    p0 = f32x16{}; p1 = f32x16{};
    const char* K_lds = lds + OFF_K;
    const char* kb[4];
#pragma unroll
    for (int dd = 0; dd < 4; ++dd) kb[dd] = K_lds + KB * SHM_K + KSWZ(r32, (dd * 16 + hi * 8) * 2);
#pragma unroll
    for (int d0 = 0; d0 < 8; ++d0) { const char* a = kb[d0 & 3] + (d0 >> 2) * 128;
        bf16x8 b0 = *reinterpret_cast<const bf16x8*>(a);
        bf16x8 b1 = *reinterpret_cast<const bf16x8*>(a + 32 * 256);
        p0 = __builtin_amdgcn_mfma_f32_32x32x16_bf16(b0, qr[d0], p0, 0, 0, 0);
        p1 = __builtin_amdgcn_mfma_f32_32x32x16_bf16(b1, qr[d0], p1, 0, 0, 0); }
    if constexpr (ROPE) {
        const char* KR_lds = lds + OFF_KR + KB * SHM_KR + r32 * 128;
#pragma unroll
        for (int d0 = 0; d0 < 4; ++d0) { const char* a = KR_lds + ((d0 * 32 + hi * 16) ^ ((r32 & 7) << 4));
            bf16x8 b0 = *reinterpret_cast<const bf16x8*>(a);
            bf16x8 b1 = *reinterpret_cast<const bf16x8*>(a + 32 * 128);
            const bf16x8 qf = *reinterpret_cast<const bf16x8*>(qpark + d0 * 1024);
            p0 = __builtin_amdgcn_mfma_f32_32x32x16_bf16(b0, qf, p0, 0, 0, 0);
            p1 = __builtin_amdgcn_mfma_f32_32x32x16_bf16(b1, qf, p1, 0, 0, 0); }
    }
}
template <int VB>
__device__ __forceinline__ void pv_tile(f32x16* o, int vb0, bf16x8 pa0, bf16x8 pa1, bf16x8 pa2, bf16x8 pa3) {
#define TRRD(dst, off) asm volatile("ds_read_b64_tr_b16 %0, %1 offset:%2" : "=&v"(dst) : "v"(vb0), "i"(off) : "memory")
#define PV_D0(d0) do { s16x4 l0, l1, l2, l3, h0, h1, h2, h3; constexpr int b_ = OFF_V + VB * SHM_V + v_rd_off(d0, 0, 0);   \
        TRRD(l0, b_); TRRD(h0, b_ + 2048); TRRD(l1, b_ + 4096); TRRD(h1, b_ + 6144); TRRD(l2, b_ + 8192); TRRD(h2, b_ + 10240); TRRD(l3, b_ + 12288); TRRD(h3, b_ + 14336); \
        asm volatile("s_waitcnt lgkmcnt(0)" ::: "memory"); SBAR();   \
        o[d0] = __builtin_amdgcn_mfma_f32_32x32x16_bf16(pa0, (bf16x8){l0[0], l0[1], l0[2], l0[3], h0[0], h0[1], h0[2], h0[3]}, o[d0], 0, 0, 0);   \
        o[d0] = __builtin_amdgcn_mfma_f32_32x32x16_bf16(pa1, (bf16x8){l1[0], l1[1], l1[2], l1[3], h1[0], h1[1], h1[2], h1[3]}, o[d0], 0, 0, 0);   \
        o[d0] = __builtin_amdgcn_mfma_f32_32x32x16_bf16(pa2, (bf16x8){l2[0], l2[1], l2[2], l2[3], h2[0], h2[1], h2[2], h2[3]}, o[d0], 0, 0, 0);   \
        o[d0] = __builtin_amdgcn_mfma_f32_32x32x16_bf16(pa3, (bf16x8){l3[0], l3[1], l3[2], l3[3], h3[0], h3[1], h3[2], h3[3]}, o[d0], 0, 0, 0); } while (0)
    PV_D0(0); PV_D0(1); PV_D0(2); PV_D0(3);
#undef PV_D0
#undef TRRD
}

struct FUnit {
    const bf16_t* Kb; long ldk; const bf16_t* Vb; long ldv; const bf16_t* KRb;
    int j_lo, j_hi;
    int qlo, qhi;
    int qpos;
    unsigned long long sel;
};
template <int MODE>
__device__ __forceinline__ void flash_core(char* lds, const FUnit& u, const bf16x8* qr, float scale, f32x16 (&o)[4], float& m_reg, float& l_reg) {
    constexpr bool ROPE = (MODE == 0);
    const int tid = threadIdx.x, wid = __builtin_amdgcn_readfirstlane(tid >> 6), lane = tid & 63, r32 = lane & 31, hi = lane >> 5;
    const float C2 = 1.4426950408889634f * scale;
    char* V_lds = lds + OFF_V; char* K_lds = lds + OFF_K; char* KR_lds = lds + OFF_KR;
    float* ws = (float*)(lds + OFF_WS) + wid * 64; float* al_l = ws + 32;
    const int sr = tid >> 4, sc = (tid & 15) * 8, vst0 = v_st(sr, sc), vst1 = v_st(32 + sr, sc), kws = KSWZ(sr, sc * 2);
    const int rr = tid >> 3, rc = (tid & 7) * 8, krws = rr * 128 + ((rc * 2) ^ ((rr & 7) << 4));
    const int vb0 = (int)(uintptr_t)lds + v_rd_base(lane);
    const char* qpark = lds + OFF_QPARK + wid * 4096 + lane * 16;
    m_reg = -1e30f; l_reg = 0.f;
#pragma unroll
    for (int d = 0; d < 4; ++d) o[d] = f32x16{};
    const int NT = u.j_hi - u.j_lo;
    bf16x8 st_k0, st_k1, st_v0, st_v1, st_kr;
    f32x16 p0, p1; float mn, al; bf16x8 pa0, pa1, pa2, pa3;
    const unsigned W = (MODE == 1) ? 512u : ((MODE == 3) ? 0x80000000u : 0x7fffffffu);
#define FA_KBASE(t) ((u.j_lo + (t)) * KVBLK)
#define FA_SLOAD(k0) do { st_k0 = *(const bf16x8*)(u.Kb + (long)((k0) + sr) * u.ldk + sc); st_k1 = *(const bf16x8*)(u.Kb + (long)((k0) + 32 + sr) * u.ldk + sc);   \
                          st_v0 = *(const bf16x8*)(u.Vb + (long)((k0) + sr) * u.ldv + sc); st_v1 = *(const bf16x8*)(u.Vb + (long)((k0) + 32 + sr) * u.ldv + sc);   \
                          if constexpr (ROPE) st_kr = *(const bf16x8*)(u.KRb + (long)((k0) + rr) * 64 + rc); } while (0)
#define FA_SWRITE(bf) do { *(bf16x8*)(K_lds + (bf) * SHM_K + kws) = st_k0; *(bf16x8*)(K_lds + (bf) * SHM_K + kws + 32 * 256) = st_k1;   \
                           *(bf16x8*)(V_lds + (bf) * SHM_V + vst0) = st_v0; *(bf16x8*)(V_lds + (bf) * SHM_V + vst1) = st_v1;   \
                           if constexpr (ROPE) *(bf16x8*)(KR_lds + (bf) * SHM_KR + krws) = st_kr; } while (0)
#define FA_RESC(a) do { if (__any((a) < 1.f)) { if (hi == 0) al_l[r32] = (a); asm volatile("s_waitcnt lgkmcnt(0)" ::: "memory");              \
                     _Pragma("unroll") for (int d_ = 0; d_ < 4; ++d_) { _Pragma("unroll") for (int r = 0; r < 16; ++r) o[d_][r] *= al_l[crow(r, hi)]; } asm volatile("" ::: "memory"); } } while (0)
#define FA_MASK(t) do { const int kb_ = FA_KBASE(t);                                                                             \
        if (MODE == 1) { if (kb_ + KVBLK - 1 > u.qlo || kb_ <= u.qhi - 512) mask_tile(p0, p1, u.qpos - kb_ - 4 * hi, W); }       \
        else { if (kb_ + KVBLK - 1 > u.qlo) mask_tile(p0, p1, u.qpos - kb_ - 4 * hi, W); }                                       \
        if (MODE == 2) mask_all(p0, p1, ((u.sel >> (u.j_lo + (t))) & 1ull) == 0ull); } while (0)
#define FA_STEP(BF, t) do {                                                                                                      \
        asm volatile("s_waitcnt vmcnt(0)" ::: "memory"); FA_SWRITE(BF); __syncthreads();                                         \
        if ((t) + 1 < NT) FA_SLOAD(FA_KBASE((t) + 1));                                                                           \
        SBAR(); qkt<BF, ROPE>(p0, p1, lds, r32, hi, qr, qpark); FA_MASK(t);                                                             \
        partialSM(p0, p1, m_reg, mn, al, scale, C2); FA_RESC(al);                                                                \
        finishSM(p0, p1, al, l_reg, pa0, pa1, pa2, pa3); SBAR();                                                                 \
        pv_tile<BF>(o, vb0, pa0, pa1, pa2, pa3); } while (0)
    if (NT > 0) FA_SLOAD(FA_KBASE(0));
    for (int t = 0; t < NT; t += 2) {
        FA_STEP(0, t);
        if (t + 1 < NT) FA_STEP(1, t + 1);
    }
#undef FA_STEP
#undef FA_MASK
#undef FA_RESC
#undef FA_SWRITE
#undef FA_SLOAD
#undef FA_KBASE
}
__device__ __forceinline__ void row_factors(char* lds, int wid, int r32, int hi, float f, float (&rf)[16]) {
    float* li_l = (float*)(lds + OFF_WS) + wid * 64;
    asm volatile("" ::: "memory");
    if (hi == 0) li_l[r32] = f;
    asm volatile("s_waitcnt lgkmcnt(0)" ::: "memory");
#pragma unroll
    for (int r = 0; r < 16; ++r) rf[r] = li_l[crow(r, hi)];
    asm volatile("s_waitcnt lgkmcnt(0)" ::: "memory");
}
}

constexpr size_t MiB = 1ull << 20, KiB = 1ull << 10;
constexpr size_t WS_CTL = 0;
constexpr size_t WS_ROPE = 64 * KiB;
constexpr size_t WS_MG = WS_ROPE + 1 * MiB;
constexpr size_t WS_FLOOR = WS_MG + 512 * KiB;
constexpr size_t WS_DEN = WS_FLOOR + 256 * KiB;
constexpr size_t WS_GATES = WS_DEN + 256 * KiB;
constexpr size_t WS_SEL = WS_GATES + 512 * KiB;
constexpr size_t WS_KROPE = WS_SEL + 512 * KiB;
constexpr size_t WS_CQN = WS_KROPE + 2 * MiB;
constexpr size_t WS_CKVN = WS_CQN + 32 * MiB;
constexpr size_t WS_KVB = WS_CKVN + 16 * MiB;
constexpr size_t WS_XB = WS_KVB + 128 * MiB;
constexpr size_t WS_Z = WS_XB + 128 * MiB;
constexpr size_t WS_R = WS_Z + 256 * MiB;
constexpr size_t WS_W = WS_R + 344 * MiB;
constexpr size_t W_AB = WS_W, W_UQ = W_AB + 62 * MiB, W_UKV = W_UQ + 6 * MiB, W_O0 = W_UKV + 4 * MiB, W_GU0 = W_O0 + 32 * MiB, W_D0 = W_GU0 + 172 * MiB;
constexpr size_t W_C = W_D0 + 86 * MiB, W_C1K = W_C + 58 * MiB, W_C1V = W_C1K + 2 * MiB, W_C2K = W_C1V + 2 * MiB, W_C2V = W_C2K + 128 * KiB, W_O1 = W_C2V + 128 * KiB;
constexpr size_t W_GU1 = W_O1 + 32 * MiB, W_D1 = W_GU1 + 172 * MiB, WS_END = W_D1 + 86 * MiB;
constexpr size_t WS_AK = WS_KVB, WS_AV = WS_AK + 32 * MiB, WS_HK = WS_AV + 32 * MiB, WS_HV = WS_HK + 2 * MiB, WS_KCMP = WS_HV + 2 * MiB, WS_VCMP = WS_KCMP + 2 * MiB;
constexpr size_t WS_QB = WS_R + (size_t)M_TOK * AB_NP * 2;

constexpr int NTHREADS = 512;
constexpr int LDS_BYTES = 152 * 1024, LDS_CTL_OFF = LDS_BYTES - 256;
constexpr int N_TJOBS = 14;
struct TJob { const float* s; const float* s2; bf16_t* d; int K, N, Np, mode; };
struct Args { const float* in[26]; float* out; unsigned char* ws; TJob tj[N_TJOBS]; int ph_lo, ph_hi; };

__device__ __forceinline__ void transpose_jobs(char* lds, const Args& a) {
    float* T = (float*)lds;
    const int tid = threadIdx.x;
    for (int ji = 0; ji < N_TJOBS; ++ji) {
        const TJob jb = a.tj[ji];
        const int tk = jb.K >> 6, tn = jb.Np >> 6, nt = tk * tn;
        for (int t = blockIdx.x; t < nt; t += gridDim.x) {
            const int in_ = t % tn, ik = t / tn, n0 = in_ * 64, k0 = ik * 64;
            const float* sp = jb.s; int c0 = n0, ncols = jb.N;
            if (jb.mode == 1) { const int tile = n0 >> 8, j = n0 & 255; sp = (j < 128) ? jb.s : jb.s2; c0 = tile * 128 + (j & 127); }
            const int kk = tid >> 4, nc = (tid & 15) * 4;
            f32x4 v0 = {0.f, 0.f, 0.f, 0.f}, v1 = v0;
            if (c0 + nc < ncols) { v0 = *(const f32x4*)(sp + (size_t)(k0 + kk) * ncols + c0 + nc); v1 = *(const f32x4*)(sp + (size_t)(k0 + kk + 32) * ncols + c0 + nc); }
#pragma unroll
            for (int j = 0; j < 4; ++j) { T[(nc + j) * 65 + kk] = v0[j]; T[(nc + j) * 65 + kk + 32] = v1[j]; }
            __syncthreads();
            const int n = tid >> 3, kc = (tid & 7) * 8;
            float f[8];
#pragma unroll
            for (int j = 0; j < 8; ++j) f[j] = T[n * 65 + kc + j];
            *(bf16x8*)(jb.d + (size_t)(n0 + n) * jb.K + k0 + kc) = pack8f(f);
            __syncthreads();
        }
    }
}
__device__ __forceinline__ void p0_prologue(char* lds, const Args& a) {
    const int tid = threadIdx.x;
    const size_t gt = (size_t)blockIdx.x * NTHREADS + tid, gs = (size_t)gridDim.x * NTHREADS;
    { const float* x = a.in[0]; bf16_t* xb = (bf16_t*)(a.ws + WS_XB);
      for (size_t i = gt; i < (size_t)M_TOK * DM / 8; i += gs) { const f32x4 v0 = *(const f32x4*)(x + i * 8), v1 = *(const f32x4*)(x + i * 8 + 4);
          float f[8] = {v0[0], v0[1], v0[2], v0[3], v1[0], v1[1], v1[2], v1[3]}; *(bf16x8*)(xb + i * 8) = pack8f(f); } }
    { f32x2* rp = (f32x2*)(a.ws + WS_ROPE);
      for (size_t i = gt; i < (size_t)SEQ * 32; i += gs) { const int pos = (int)(i >> 5), j = (int)(i & 31);
          const double inv = exp(-(double)j / 32.0 * 9.210340371976184  ); const double ang = (double)pos * inv; rp[i] = (f32x2){(float)cos(ang), (float)sin(ang)}; } }
    transpose_jobs(lds, a);
}

__device__ __forceinline__ float softcap15(float z) { return 15.0f * tanhf(z * (1.0f / 15.0f)); }
__device__ __forceinline__ float logsigmoid_f(float z) { return fminf(z, 0.f) - log1pf(__expf(-fabsf(z))); }
__device__ __forceinline__ void p2_prep(const Args& a) {
    const int tid = threadIdx.x, lane = tid & 63, wid = tid >> 6;
    const int gw = blockIdx.x * 8 + wid, nw = gridDim.x * 8;
    const bf16_t* proj = (const bf16_t*)(a.ws + WS_R);
    if (gw < 16) {
        const int bh = gw, b = bh >> 2, h = bh & 3;
        const float* gates = (const float*)(a.ws + WS_GATES);
        f32x2* mg = (f32x2*)(a.ws + WS_MG) + (size_t)bh * SEQ; float* fl = (float*)(a.ws + WS_FLOOR) + (size_t)bh * SEQ;
        const float bi = a.in[2][h], bfg = a.in[3][h];
        float Fc = 0.f, Ac = 0.f, mprev = 0.f;
        for (int c = 0; c < SEQ / 64; ++c) {
            const int t = c * 64 + lane; const float* g = gates + (size_t)(b * SEQ + t) * 8;
            const float li = softcap15(g[h] + bi), lf = logsigmoid_f(softcap15(g[4 + h] + bfg));
            float F = lf;
#pragma unroll
            for (int o = 1; o < 64; o <<= 1) { const float y = __shfl_up(F, o); if (lane >= o) F += y; }
            F += Fc;
            float A = li - F;
#pragma unroll
            for (int o = 1; o < 64; o <<= 1) { const float y = __shfl_up(A, o); if (lane >= o) A = fmaxf(A, y); }
            A = fmaxf(A, Ac);
            const float m = F + A;
            float mp = __shfl_up(m, 1); if (lane == 0) mp = mprev;
            mg[t] = (f32x2){__expf(lf + mp - m), __expf(li - m)}; fl[t] = __expf(-m);
            Fc = __shfl(F, 63); Ac = __shfl(A, 63); mprev = __shfl(m, 63);
        }
    }
    const float* qn = a.in[5]; const float* kvn = a.in[6];
    bf16_t* cqn = (bf16_t*)(a.ws + WS_CQN); bf16_t* ckvn = (bf16_t*)(a.ws + WS_CKVN); bf16_t* krope = (bf16_t*)(a.ws + WS_KROPE);
    const f32x2* rp = (const f32x2*)(a.ws + WS_ROPE);
    for (int tk = gw; tk < M_TOK; tk += nw) {
        const bf16_t* row = proj + (size_t)tk * AB_NP;
        float x0[8], x1[8], y[8];
        unpack8(*(const bf16x8*)(row + AB_CQ + lane * 8), x0); unpack8(*(const bf16x8*)(row + AB_CQ + 512 + lane * 8), x1); unpack8(*(const bf16x8*)(row + AB_CKV + lane * 8), y);
        const float kr = bf2f(row[AB_KR + lane]);
        float s = 0.f, s2 = 0.f;
#pragma unroll
        for (int j = 0; j < 8; ++j) { s += x0[j] * x0[j] + x1[j] * x1[j]; s2 += y[j] * y[j]; }
        s = wave_sum(s); s2 = wave_sum(s2);
        const float r1 = rsqrtf(s * (1.0f / 1024.0f) + RMS_EPS), r2 = rsqrtf(s2 * (1.0f / 512.0f) + RMS_EPS);
#pragma unroll
        for (int j = 0; j < 8; ++j) { x0[j] *= r1 * qn[lane * 8 + j]; x1[j] *= r1 * qn[512 + lane * 8 + j]; y[j] *= r2 * kvn[lane * 8 + j]; }
        *(bf16x8*)(cqn + (size_t)tk * 1024 + lane * 8) = pack8f(x0); *(bf16x8*)(cqn + (size_t)tk * 1024 + 512 + lane * 8) = pack8f(x1);
        *(bf16x8*)(ckvn + (size_t)tk * 512 + lane * 8) = pack8f(y);
        const float pr = __shfl_xor(kr, 32); const f32x2 cs = rp[(size_t)(tk & (SEQ - 1)) * 32 + (lane & 31)];
        const float out = lane < 32 ? kr * cs.x - pr * cs.y : pr * cs.y + kr * cs.x;
        krope[(size_t)tk * 64 + lane] = f2bf(out);
    }
}

__device__ __forceinline__ float dpp_xor1(float v) { return __int_as_float(__builtin_amdgcn_update_dpp(0, __float_as_int(v), 0xB1, 0xF, 0xF, true)); }
__device__ __forceinline__ float dpp_xor2(float v) { return __int_as_float(__builtin_amdgcn_update_dpp(0, __float_as_int(v), 0x4E, 0xF, 0xF, true)); }
__device__ __forceinline__ float dpp_hmir(float v) { return __int_as_float(__builtin_amdgcn_update_dpp(0, __float_as_int(v), 0x141, 0xF, 0xF, true)); }
__device__ __forceinline__ float dpp_mir(float v)  { return __int_as_float(__builtin_amdgcn_update_dpp(0, __float_as_int(v), 0x140, 0xF, 0xF, true)); }
__device__ __forceinline__ float row16_sum(float v) { v += dpp_xor1(v); v += dpp_xor2(v); v += dpp_hmir(v); v += dpp_mir(v); return v; }
__device__ __forceinline__ float swap32_sum(float a, float b) {
    auto rr = __builtin_amdgcn_permlane32_swap(__float_as_uint(a), __float_as_uint(b), false, false); return __uint_as_float(rr[0]) + __uint_as_float(rr[1]); }
constexpr int ML_CH = 32;
constexpr int ML_Q = 0, ML_K = ML_CH * 256 * 4, ML_V = 2 * ML_CH * 256 * 4, ML_FI = ML_V + ML_CH * 32 * 4, ML_BUF = ML_FI + ML_CH * 8;
constexpr int ML_OUT = 2 * ML_BUF, ML_DEN = ML_OUT + ML_CH * 32 * 4, ML_END = ML_DEN + ML_CH * 4;
static_assert(ML_END <= LDS_CTL_OFF, "mLSTM LDS");
__device__ __forceinline__ void p4_mlstm(char* lds, const Args& a) {
    const int tid = threadIdx.x, lane = tid & 63, wid = __builtin_amdgcn_readfirstlane(tid >> 6);
    const bf16_t* proj = (const bf16_t*)(a.ws + WS_R); bf16_t* hcat = (bf16_t*)(a.ws + WS_XB);
    for (int unit = blockIdx.x; unit < 256; unit += gridDim.x) {
        const int bh = unit >> 4, sl = unit & 15, b = bh >> 2, h = bh & 3;
        const f32x2* mg = (const f32x2*)(a.ws + WS_MG) + (size_t)bh * SEQ;
        float* den = (float*)(a.ws + WS_DEN) + (size_t)bh * SEQ;
        const bool denw = (wid == 0) && (sl == 0);
        const int st = tid >> 4, sp = (tid & 15) * 16, vt = tid >> 2, vp = (tid & 3) * 8;
        const bf16_t* qsrc = proj + (size_t)(b * SEQ + st) * AB_NP + AB_Q + h * 256 + sp;
        const bf16_t* ksrc = proj + (size_t)(b * SEQ + st) * AB_NP + AB_K + h * 256 + sp;
        const bf16_t* vsrc = proj + (size_t)(b * SEQ + vt) * AB_NP + AB_V + h * 512 + sl * 32 + vp;
        bf16x8 rq0, rq1, rk0, rk1, rv; f32x2 rfi;
#define ML_LOAD(c) do { const size_t o_ = (size_t)(c) * ML_CH * AB_NP; rq0 = *(const bf16x8*)(qsrc + o_); rq1 = *(const bf16x8*)(qsrc + o_ + 8); rk0 = *(const bf16x8*)(ksrc + o_); rk1 = *(const bf16x8*)(ksrc + o_ + 8); \
        if (tid < 128) rv = *(const bf16x8*)(vsrc + o_); if (tid < ML_CH) rfi = mg[(c) * ML_CH + tid]; } while (0)
#define ML_STORE(bufp) do { float f_[8]; float* Q_ = (float*)((bufp) + ML_Q) + st * 256 + sp; float* K_ = (float*)((bufp) + ML_K) + st * 256 + sp; \
        unpack8(rq0, f_); *(f32x4*)(Q_) = (f32x4){f_[0], f_[1], f_[2], f_[3]}; *(f32x4*)(Q_ + 4) = (f32x4){f_[4], f_[5], f_[6], f_[7]}; \
        unpack8(rq1, f_); *(f32x4*)(Q_ + 8) = (f32x4){f_[0], f_[1], f_[2], f_[3]}; *(f32x4*)(Q_ + 12) = (f32x4){f_[4], f_[5], f_[6], f_[7]}; \
        unpack8(rk0, f_); *(f32x4*)(K_) = (f32x4){f_[0], f_[1], f_[2], f_[3]} * 0.0625f; *(f32x4*)(K_ + 4) = (f32x4){f_[4], f_[5], f_[6], f_[7]} * 0.0625f; \
        unpack8(rk1, f_); *(f32x4*)(K_ + 8) = (f32x4){f_[0], f_[1], f_[2], f_[3]} * 0.0625f; *(f32x4*)(K_ + 12) = (f32x4){f_[4], f_[5], f_[6], f_[7]} * 0.0625f; \
        if (tid < 128) { float* V_ = (float*)((bufp) + ML_V) + vt * 32 + vp; unpack8(rv, f_); *(f32x4*)(V_) = (f32x4){f_[0], f_[1], f_[2], f_[3]}; *(f32x4*)(V_ + 4) = (f32x4){f_[4], f_[5], f_[6], f_[7]}; } \
        if (tid < ML_CH) ((f32x2*)((bufp) + ML_FI))[tid] = rfi; } while (0)
        f32x4 C0 = {0.f, 0.f, 0.f, 0.f}, C1 = C0, C2 = C0, C3 = C0, n4 = C0;
        __syncthreads();
        ML_LOAD(0); ML_STORE(lds); __syncthreads();
        float* OUT = (float*)(lds + ML_OUT); float* DENs = (float*)(lds + ML_DEN);
        for (int c = 0; c < SEQ / ML_CH; ++c) {
            char* buf = lds + (c & 1) * ML_BUF;
            if (c + 1 < SEQ / ML_CH) ML_LOAD(c + 1);
            const float* Qs = (const float*)(buf + ML_Q) + lane * 4; const float* Ks = (const float*)(buf + ML_K) + lane * 4;
            const float* Vs = (const float*)(buf + ML_V) + wid * 4; const f32x2* FIs = (const f32x2*)(buf + ML_FI);
#pragma unroll 4
            for (int s = 0; s < ML_CH; ++s) {
                const f32x4 q4 = *(const f32x4*)(Qs + s * 256), k4 = *(const f32x4*)(Ks + s * 256), v4 = *(const f32x4*)(Vs + s * 32); const f32x2 fi = FIs[s];
                const f32x4 iv = v4 * fi.y;
                C0 = C0 * fi.x + iv * k4[0]; C1 = C1 * fi.x + iv * k4[1]; C2 = C2 * fi.x + iv * k4[2]; C3 = C3 * fi.x + iv * k4[3];
                f32x4 d = C0 * q4[0] + C1 * q4[1] + C2 * q4[2] + C3 * q4[3];
                float e0 = swap32_sum(d[0], d[2]), e1 = swap32_sum(d[1], d[3]);
                const float other = __shfl_xor((lane & 16) ? e0 : e1, 16);
                float r = ((lane & 16) ? e1 : e0) + other;
                r = row16_sum(r);
                if ((lane & 15) == 0) OUT[s * 32 + wid * 4 + (lane >> 5) * 2 + ((lane >> 4) & 1)] = r;
                if (denw) { n4 = n4 * fi.x + k4 * fi.y; float dn = n4[0] * q4[0] + n4[1] * q4[1] + n4[2] * q4[2] + n4[3] * q4[3];
                    dn = swap32_sum(dn, dn); dn += __shfl_xor(dn, 16); dn = row16_sum(dn); if (lane == 0) DENs[s] = dn; }
            }
            __syncthreads();
            if (tid < 128) { const float* o_ = OUT + vt * 32 + vp; float f[8];
#pragma unroll
                for (int j = 0; j < 8; ++j) f[j] = o_[j];
                *(bf16x8*)(hcat + (size_t)(b * SEQ + c * ML_CH + vt) * DM + h * 512 + sl * 32 + vp) = pack8f(f); }
            if (sl == 0 && tid < ML_CH) den[c * ML_CH + tid] = DENs[tid];
            if (c + 1 < SEQ / ML_CH) ML_STORE(lds + ((c + 1) & 1) * ML_BUF);
            __syncthreads();
        }
#undef ML_LOAD
#undef ML_STORE
    }
}

__device__ __forceinline__ void p5_mlstm_norm(const Args& a) {
    const int tid = threadIdx.x, lane = tid & 63, wid = tid >> 6;
    const int gw = blockIdx.x * 8 + wid, nw = gridDim.x * 8;
    const bf16_t* proj = (const bf16_t*)(a.ws + WS_R); bf16_t* hcat = (bf16_t*)(a.ws + WS_XB);
    const float* den = (const float*)(a.ws + WS_DEN); const float* fl = (const float*)(a.ws + WS_FLOOR); const float* mn = a.in[4];
    for (int it = gw; it < M_TOK * 4; it += nw) {
        const int tk = it >> 2, h = it & 3, b = tk >> 12, t = tk & (SEQ - 1), bh = b * 4 + h;
        bf16_t* hp = hcat + (size_t)tk * DM + h * 512 + lane * 8;
        float x[8], og[8];
        unpack8(*(const bf16x8*)hp, x); unpack8(*(const bf16x8*)(proj + (size_t)tk * AB_NP + AB_OG + h * 512 + lane * 8), og);
        const float dd = fmaxf(fabsf(den[(size_t)bh * SEQ + t]), fl[(size_t)bh * SEQ + t]); const float inv = 1.0f / dd;
        float s = 0.f;
#pragma unroll
        for (int j = 0; j < 8; ++j) { x[j] *= inv; s += x[j] * x[j]; }
        s = wave_sum(s);
        const float r = rsqrtf(s * (1.0f / 512.0f) + RMS_EPS);
#pragma unroll
        for (int j = 0; j < 8; ++j) x[j] = x[j] * r * mn[h * 512 + lane * 8 + j] * sigmoid_f(og[j]);
        *(bf16x8*)hp = pack8f(x);
    }
}
__device__ __forceinline__ void p5_mla(char* lds, const Args& a) {
    const int tid = threadIdx.x, wid = __builtin_amdgcn_readfirstlane(tid >> 6), lane = tid & 63, r32 = lane & 31, hi = lane >> 5;
    const bf16_t* qb = (const bf16_t*)(a.ws + WS_QB); const bf16_t* kvb = (const bf16_t*)(a.ws + WS_KVB); const bf16_t* krope = (const bf16_t*)(a.ws + WS_KROPE);
    bf16_t* hcat = (bf16_t*)(a.ws + WS_XB); const f32x2* rp = (const f32x2*)(a.ws + WS_ROPE);
    for (int item = blockIdx.x; item < 64 * 8 * 2; item += gridDim.x) {
        const int pass = item & 1, it2 = item >> 1, bh = it2 >> 3, x = it2 & 7, b = bh >> 4, h = bh & 15;
        const int qblk = pass ? 15 - x : x, t0 = qblk * 256, pos = t0 + wid * 32 + r32;
        const bf16_t* qrow = qb + (size_t)(b * SEQ + pos) * 3072 + h * 192;
        bf16x8 qr[8], qrr[4];
#pragma unroll
        for (int d0 = 0; d0 < 8; ++d0) qr[d0] = *(const bf16x8*)(qrow + d0 * 16 + hi * 8);
#pragma unroll
        for (int d0 = 0; d0 < 4; ++d0) qrr[d0] = *(const bf16x8*)(qrow + 128 + d0 * 16 + hi * 8);
#pragma unroll
        for (int g = 0; g < 2; ++g) { float x1[8], x2[8], o1[8], o2[8]; unpack8(qrr[g], x1); unpack8(qrr[2 + g], x2);
#pragma unroll
            for (int j = 0; j < 8; ++j) { const f32x2 cs = rp[(size_t)pos * 32 + g * 16 + hi * 8 + j]; o1[j] = x1[j] * cs.x - x2[j] * cs.y; o2[j] = x1[j] * cs.y + x2[j] * cs.x; }
            char* qpark = lds + fa::OFF_QPARK + wid * 4096 + lane * 16;
            *(bf16x8*)(qpark + g * 1024) = pack8f(o1); *(bf16x8*)(qpark + (2 + g) * 1024) = pack8f(o2); }
        fa::FUnit u; u.Kb = kvb + (size_t)(b * SEQ) * 4096 + h * 256; u.ldk = 4096; u.Vb = u.Kb + 128; u.ldv = 4096; u.KRb = krope + (size_t)(b * SEQ) * 64;
        u.j_lo = 0; u.j_hi = (t0 + 255) / 64 + 1; u.qlo = t0 + wid * 32; u.qhi = u.qlo + 31; u.qpos = pos; u.sel = 0ull;
        f32x16 o[4]; float m_reg, l_reg;
        fa::flash_core<0>(lds, u, qr, 0.07216878364870322f, o, m_reg, l_reg);
        float rf[16]; fa::row_factors(lds, wid, r32, hi, 1.0f / l_reg, rf);
        bf16_t* ob = hcat + (size_t)(b * SEQ + t0 + wid * 32) * DM + 2048 + h * 128;
#pragma unroll
        for (int r = 0; r < 16; ++r) { const int orow = fa::crow(r, hi);
#pragma unroll
            for (int d0 = 0; d0 < 4; ++d0) { const float v = o[d0][r] * rf[r]; const float vn = __shfl_xor(v, 1);
                if ((r32 & 1) == 0) *(unsigned*)(ob + (size_t)orow * DM + d0 * 32 + r32) = cvt_pk_bf16(v, vn); } }
        __syncthreads();
    }
}

__device__ __forceinline__ void p7_layernorm(const Args& a, int layer_idx, bool mix, float* outf, bf16_t* outb) {
    const int tid = threadIdx.x, lane = tid & 63, wid = tid >> 6;
    const int gw = blockIdx.x * 8 + wid, nw = gridDim.x * 8;
    const float* z = (const float*)(a.ws + WS_Z);
    const float* g = (mix ? a.in[22] : a.in[24]) + (size_t)layer_idx * DM; const float* bb = (mix ? a.in[23] : a.in[25]) + (size_t)layer_idx * DM;
    for (int row = gw; row < M_TOK; row += nw) {
        const float* zr = z + (size_t)row * DM;
        f32x4 v[16]; float s = 0.f;
#pragma unroll
        for (int i = 0; i < 16; ++i) { v[i] = *(const f32x4*)(zr + i * 256 + lane * 4); s += (v[i][0] + v[i][1]) + (v[i][2] + v[i][3]); }
        s = wave_sum(s); const float mu = s * (1.0f / DM);
        float q = 0.f;
#pragma unroll
        for (int i = 0; i < 16; ++i) { const f32x4 d = v[i] - mu; q += (d[0] * d[0] + d[1] * d[1]) + (d[2] * d[2] + d[3] * d[3]); }
        q = wave_sum(q); const float rs = rsqrtf(q * (1.0f / DM) + LN_EPS);
#pragma unroll
        for (int i = 0; i < 16; ++i) { const int c = i * 256 + lane * 4; const f32x4 gg = *(const f32x4*)(g + c), be = *(const f32x4*)(bb + c);
            const f32x4 y = (v[i] - mu) * rs * gg + be;
            *(f32x4*)(outf + (size_t)row * DM + c) = y;
            if (outb) { u32x2 w; w.x = cvt_pk_bf16(y[0], y[1]); w.y = cvt_pk_bf16(y[2], y[3]); *(u32x2*)(outb + (size_t)row * DM + c) = w; } }
    }
}
__device__ __forceinline__ void p12_blocks(const Args& a) {
    const bf16_t* projc = (const bf16_t*)(a.ws + WS_R);
    const size_t gt = (size_t)blockIdx.x * NTHREADS + threadIdx.x, gs = (size_t)gridDim.x * NTHREADS;
    for (size_t i = gt; i < (size_t)2 * 4096 * 512; i += gs) {
        const int which = (int)(i / ((size_t)4096 * 512)); const int rem = (int)(i % ((size_t)4096 * 512));
        const int r = rem >> 9, l = (rem >> 4) & 31, d8 = rem & 15, g = r & 3, n = (r >> 2) & 255, b = r >> 10;
        bf16_t* A = (bf16_t*)(a.ws + (which ? WS_AV : WS_AK)); const float* pe = which ? a.in[13] : a.in[12];
        float f[8];
        if (n < 255) { unpack8(*(const bf16x8*)(projc + (size_t)(b * SEQ + 16 * n + l) * C_NP + (which ? C_VC : C_KC) + g * 128 + d8 * 8), f);
#pragma unroll
            for (int j = 0; j < 8; ++j) f[j] += pe[l * 128 + d8 * 8 + j]; }
        else {
#pragma unroll
            for (int j = 0; j < 8; ++j) f[j] = 0.f; }
        *(bf16x8*)(A + (size_t)r * 4096 + l * 128 + d8 * 8) = pack8f(f);
    }
}
__device__ __forceinline__ float nsa_gate(const Args& a, int token, int br, int head) {
    const bf16_t* projc = (const bf16_t*)(a.ws + WS_R);
    return sigmoid_f(bf2f(projc[(size_t)token * C_NP + C_GATE + br * 32 + head]) + a.in[11][br * 32 + head]);
}
__device__ __forceinline__ void p15_cmp_attn(char* lds, const Args& a) {
    const int tid = threadIdx.x, wid = __builtin_amdgcn_readfirstlane(tid >> 6), lane = tid & 63, r32 = lane & 31, hi = lane >> 5;
    const bf16_t* projc = (const bf16_t*)(a.ws + WS_R); const bf16_t* kcmp = (const bf16_t*)(a.ws + WS_KCMP); const bf16_t* vcmp = (const bf16_t*)(a.ws + WS_VCMP);
    float* acc = (float*)(a.ws + WS_Z); unsigned long long* selp = (unsigned long long*)(a.ws + WS_SEL);
    const float scale = 0.08838834764831845f, C2 = 1.4426950408889634f * scale;
    float* IMP = (float*)(lds + fa::OFF_IMP);
    for (int unit = blockIdx.x; unit < 2048; unit += gridDim.x) {
        const int bg = unit >> 7, xb = unit & 127, b = bg >> 2, g = bg & 3, t0 = xb * 32;
        const int tokl = wid * 4 + (r32 >> 3), head = g * 8 + (r32 & 7), tq = t0 + tokl;
        const bf16_t* qrow = projc + (size_t)(b * SEQ + tq) * C_NP + C_Q + head * 128;
        bf16x8 qr[8];
#pragma unroll
        for (int d0 = 0; d0 < 8; ++d0) qr[d0] = *(const bf16x8*)(qrow + d0 * 16 + hi * 8);
        fa::FUnit u; u.Kb = kcmp + (size_t)(b * 256 * 4 + g) * 256; u.ldk = 1024; u.Vb = vcmp + (size_t)(b * 256 * 4 + g) * 256; u.ldv = 1024; u.KRb = nullptr;
        const int nmax_hi = (t0 + 31 - 31) >> 4;
        u.j_lo = 0; u.j_hi = (nmax_hi >> 6) + 1; u.qlo = (t0 + wid * 4 - 31) >> 4; u.qhi = (t0 + wid * 4 + 3 - 31) >> 4; u.qpos = (tq - 31) >> 4; u.sel = 0ull;
        f32x16 o[4]; float m_reg, l_reg;
        fa::flash_core<3>(lds, u, qr, scale, o, m_reg, l_reg);
        const float inv_l = l_reg > 0.f ? 1.0f / l_reg : 0.f;
        { float rf[16]; fa::row_factors(lds, wid, r32, hi, inv_l * nsa_gate(a, b * SEQ + tq, 0, head), rf);
#pragma unroll
          for (int r = 0; r < 16; ++r) { const int orow = fa::crow(r, hi); const int tk = t0 + wid * 4 + (orow >> 3), hd = g * 8 + (orow & 7);
              float* op = acc + (size_t)(b * SEQ + tk) * DM + hd * 128 + r32;
#pragma unroll
              for (int d0 = 0; d0 < 4; ++d0) op[d0 * 32] = o[d0][r] * rf[r]; } }
        __syncthreads();
        const float mL = -m_reg * C2;
        const int sr = tid >> 4, sc = (tid & 15) * 8, kws = KSWZ(sr, sc * 2);
        for (int t = 0; t < u.j_hi; ++t) {
            const int kb = t * 64;
            const bf16x8 k0 = *(const bf16x8*)(u.Kb + (long)(kb + sr) * u.ldk + sc), k1 = *(const bf16x8*)(u.Kb + (long)(kb + 32 + sr) * u.ldk + sc);
            *(bf16x8*)(lds + fa::OFF_K + kws) = k0; *(bf16x8*)(lds + fa::OFF_K + kws + 32 * 256) = k1;
            __syncthreads();
            f32x16 p0, p1; fa::qkt<0, false>(p0, p1, lds, r32, hi, qr);
            fa::mask_tile(p0, p1, u.qpos - kb - 4 * hi, 0x80000000u);
#pragma unroll
            for (int r = 0; r < 16; ++r) {
                float a0 = __builtin_amdgcn_exp2f(fmaf(p0[r], C2, mL)) * inv_l, a1 = __builtin_amdgcn_exp2f(fmaf(p1[r], C2, mL)) * inv_l;
                a0 += dpp_xor1(a0); a0 += dpp_xor2(a0); a0 += dpp_hmir(a0);
                a1 += dpp_xor1(a1); a1 += dpp_xor2(a1); a1 += dpp_hmir(a1);
                if ((r32 & 7) == 0) { const int n = kb + fa::crow(r, hi); IMP[tokl * fa::IMP_LD + n] = a0; IMP[tokl * fa::IMP_LD + n + 32] = a1; }
            }
            __syncthreads();
        }
        for (int q4 = 0; q4 < 4; ++q4) {
            const int tl = wid * 4 + q4, tqq = t0 + tl, cur = tqq >> 6, s = lane;
            float v = 0.f;
#pragma unroll
            for (int dn = -1; dn <= 3; ++dn) { const int n = 4 * s + dn; if (n >= 0 && n <= 254 && n < u.j_hi * 64) v += IMP[tl * fa::IMP_LD + n]; }
            if (s == 0 || s == cur || s == cur - 1) v = 1e9f;
            if (s > cur) v = -1e30f;
            int rank = 0;
#pragma nounroll
            for (int j = 0; j < 64; ++j) { const float vj = __int_as_float(__builtin_amdgcn_readlane(__float_as_int(v), j)); rank += (vj > v || (vj == v && j < s)) ? 1 : 0; }
            const unsigned long long msk = __ballot(rank < 16);
            if (lane == 0) selp[(size_t)bg * SEQ + tqq] = msk;
        }
        __syncthreads();
    }
}
template <int MODE>
__device__ __forceinline__ void p16_nsa_attn(char* lds, const Args& a) {
    const int tid = threadIdx.x, wid = __builtin_amdgcn_readfirstlane(tid >> 6), lane = tid & 63, r32 = lane & 31, hi = lane >> 5;
    const bf16_t* projc = (const bf16_t*)(a.ws + WS_R); float* acc = (float*)(a.ws + WS_Z); bf16_t* hcat = (bf16_t*)(a.ws + WS_XB);
    const unsigned long long* selp = (const unsigned long long*)(a.ws + WS_SEL);
    const float scale = 0.08838834764831845f;
    const int nitems = (MODE == 2) ? 2048 : 2048;
    for (int item = blockIdx.x; item < nitems; item += gridDim.x) {
        int bg, xb;
        if (MODE == 2) { const int pass = item & 1, it2 = item >> 1; bg = it2 >> 6; const int x = it2 & 63; xb = pass ? 127 - x : x; }
        else { bg = item >> 7; xb = item & 127; }
        const int b = bg >> 2, g = bg & 3, t0 = xb * 32, head = g * 8 + wid, tq = t0 + r32;
        const bf16_t* qrow = projc + (size_t)(b * SEQ + tq) * C_NP + C_Q + head * 128;
        bf16x8 qr[8];
#pragma unroll
        for (int d0 = 0; d0 < 8; ++d0) qr[d0] = *(const bf16x8*)(qrow + d0 * 16 + hi * 8);
        fa::FUnit u; u.KRb = nullptr; u.ldk = C_NP; u.ldv = C_NP; u.qlo = t0; u.qhi = t0 + 31; u.qpos = tq; u.sel = 0ull;
        if (MODE == 1) { u.Kb = projc + (size_t)(b * SEQ) * C_NP + C_KW + g * 128; u.Vb = projc + (size_t)(b * SEQ) * C_NP + C_VW + g * 128;
            const int lowk = t0 - 511; u.j_lo = lowk > 0 ? lowk / 64 : 0; u.j_hi = (t0 + 31) / 64 + 1; }
        else { u.Kb = projc + (size_t)(b * SEQ) * C_NP + C_KS + g * 128; u.Vb = projc + (size_t)(b * SEQ) * C_NP + C_VS + g * 128;
            u.j_lo = 0; u.j_hi = (t0 + 31) / 64 + 1; u.sel = selp[(size_t)bg * SEQ + tq]; }
        f32x16 o[4]; float m_reg, l_reg;
        fa::flash_core<MODE>(lds, u, qr, scale, o, m_reg, l_reg);
        float rf[16]; fa::row_factors(lds, wid, r32, hi, nsa_gate(a, b * SEQ + tq, MODE == 1 ? 2 : 1, head) / l_reg, rf);
#pragma unroll
        for (int r = 0; r < 16; ++r) { const int orow = fa::crow(r, hi); const size_t off = (size_t)(b * SEQ + t0 + orow) * DM + head * 128 + r32;
#pragma unroll
            for (int d0 = 0; d0 < 4; ++d0) { const float v = acc[off + d0 * 32] + o[d0][r] * rf[r];
                if (MODE == 1) acc[off + d0 * 32] = v;
                else { const float vn = __shfl_xor(v, 1); if ((r32 & 1) == 0) *(unsigned*)(hcat + off + d0 * 32) = cvt_pk_bf16(v, vn); } } }
        __syncthreads();
    }
}

constexpr int N_PHASES = 23;
__global__ void __launch_bounds__(NTHREADS, 2) fwd(Args args) {
    extern __shared__ __attribute__((aligned(16))) unsigned char shm[];
    char* lds = (char*)shm;
    PG8_LAS unsigned char* ldsg = (PG8_LAS unsigned char*)shm;
    unsigned char* ws = args.ws;
    if (threadIdx.x < 64) ((volatile LAS unsigned*)(ldsg + LDS_CTL_OFF))[threadIdx.x] = 0u;
    __syncthreads();
    XcdBarrier bar = xcd_barrier_post((unsigned*)(ws + WS_CTL), (volatile LAS unsigned*)(ldsg + LDS_CTL_OFF));
    const int lo = args.ph_lo, hi = args.ph_hi, G = gridDim.x, bx = blockIdx.x;
#define IN(k) (lo <= (k) && (k) < hi)
#define SEAM(k) do { if (IN(k) && IN((k) + 1)) xcd_barrier(bar); } while (0)
#define GEMM(EPI, Aoff, Boff, Mr, Nr, Kr, ...) do { pg8::Gemm g_{(const pg8::bf16_t*)(ws + (Aoff)), (const pg8::bf16_t*)(ws + (Boff)), (Mr), (Nr), (Kr)}; pg8::StaticOrder S_; S_.init((Mr), (Nr), G, bx); \
        EPI E_{__VA_ARGS__}; pg8::gemm_phase<EPI, pg8::StaticOrder, false>(ldsg, g_, S_, E_, nullptr); } while (0)
    float* xres = args.out;
    bf16_t* xb = (bf16_t*)(ws + WS_XB); float* z = (float*)(ws + WS_Z);

    if (IN(0)) { p0_prologue(lds, args); } SEAM(0);
    if (IN(1)) { GEMM(pg8::EpiProj, WS_XB, W_AB, M_TOK, AB_NP, DM, (bf16_t*)(ws + WS_R), AB_NP, (float*)(ws + WS_GATES), AB_IG / 256); } SEAM(1);
    if (IN(2)) { p2_prep(args); } SEAM(2);
    if (IN(3)) { GEMM(pg8::EpiB<0>, WS_CQN, W_UQ, M_TOK, 3072, 1024, (bf16_t*)(ws + WS_QB), 3072);
                 GEMM(pg8::EpiB<0>, WS_CKVN, W_UKV, M_TOK, 4096, 512, (bf16_t*)(ws + WS_KVB), 4096); } SEAM(3);
    if (IN(4)) { p4_mlstm(lds, args); } SEAM(4);
    if (IN(5)) { p5_mlstm_norm(args); p5_mla(lds, args); } SEAM(5);
    if (IN(6)) { GEMM(pg8::EpiResid, WS_XB, W_O0, M_TOK, DM, DM, z, args.in[0], DM, DN_ALPHA); } SEAM(6);
    if (IN(7)) { p7_layernorm(args, 0, true, xres, xb); } SEAM(7);
    if (IN(8)) { GEMM(pg8::EpiSwiGLU, WS_XB, W_GU0, M_TOK, GU_N, DM, (bf16_t*)(ws + WS_R), FFH); } SEAM(8);
    if (IN(9)) { GEMM(pg8::EpiResid, WS_R, W_D0, M_TOK, DM, FFH, z, xres, DM, DN_ALPHA); } SEAM(9);
    if (IN(10)) { p7_layernorm(args, 0, false, xres, xb); } SEAM(10);
    if (IN(11)) { GEMM(pg8::EpiB<0>, WS_XB, W_C, M_TOK, C_NP, DM, (bf16_t*)(ws + WS_R), C_NP); } SEAM(11);
    if (IN(12)) { p12_blocks(args); } SEAM(12);
    if (IN(13)) { GEMM(pg8::EpiB<1>, WS_AK, W_C1K, 4096, 256, 4096, (bf16_t*)(ws + WS_HK), 256);
                  GEMM(pg8::EpiB<1>, WS_AV, W_C1V, 4096, 256, 4096, (bf16_t*)(ws + WS_HV), 256); } SEAM(13);
    if (IN(14)) { GEMM(pg8::EpiB<0>, WS_HK, W_C2K, 4096, 256, 256, (bf16_t*)(ws + WS_KCMP), 256);
                  GEMM(pg8::EpiB<0>, WS_HV, W_C2V, 4096, 256, 256, (bf16_t*)(ws + WS_VCMP), 256); } SEAM(14);
    if (IN(15)) { p15_cmp_attn(lds, args); } SEAM(15);
    if (IN(16)) { p16_nsa_attn<1>(lds, args); } SEAM(16);
    if (IN(17)) { p16_nsa_attn<2>(lds, args); } SEAM(17);
    if (IN(18)) { GEMM(pg8::EpiResid, WS_XB, W_O1, M_TOK, DM, DM, z, xres, DM, DN_ALPHA); } SEAM(18);
    if (IN(19)) { p7_layernorm(args, 1, true, xres, xb); } SEAM(19);
    if (IN(20)) { GEMM(pg8::EpiSwiGLU, WS_XB, W_GU1, M_TOK, GU_N, DM, (bf16_t*)(ws + WS_R), FFH); } SEAM(20);
    if (IN(21)) { GEMM(pg8::EpiResid, WS_R, W_D1, M_TOK, DM, FFH, z, xres, DM, DN_ALPHA); } SEAM(21);
    if (IN(22)) { p7_layernorm(args, 1, false, xres, nullptr); }
#undef IN
#undef SEAM
#undef GEMM
}

#ifndef MK_N_LAUNCHES
#define MK_N_LAUNCHES 23
#endif
extern "C" void kernel_launch(void* const* d_in, const int* in_sizes, int n_in, void* d_out, int out_size, void* d_ws, size_t ws_size, hipStream_t stream) {
    static int grid = 0;
    if (grid == 0) {
        if (n_in != 26 || in_sizes[0] != M_TOK * DM || out_size != M_TOK * DM || ws_size < WS_END) {
            fprintf(stderr, "kernel_launch: unexpected shapes (n_in %d, in0 %d, out %d, ws %zu, need %zu); nothing launched\n", n_in, n_in > 0 ? in_sizes[0] : -1, out_size, ws_size, (size_t)WS_END); grid = -1; return; }
        int dev = 0, cus = 0, per_cu = 0;
        if (hipGetDevice(&dev) != hipSuccess || hipDeviceGetAttribute(&cus, hipDeviceAttributeMultiprocessorCount, dev) != hipSuccess) { grid = -1; return; }
        if (hipFuncSetAttribute((const void*)fwd, hipFuncAttributeMaxDynamicSharedMemorySize, LDS_BYTES) != hipSuccess) { fprintf(stderr, "kernel_launch: hipFuncSetAttribute failed\n"); grid = -1; return; }
        if (hipOccupancyMaxActiveBlocksPerMultiprocessor(&per_cu, (const void*)fwd, NTHREADS, LDS_BYTES) != hipSuccess || per_cu < 1) { fprintf(stderr, "kernel_launch: occupancy query says %d blocks per CU\n", per_cu); (void)hipGetLastError(); grid = -1; return; }
        grid = cus;
    }
    if (grid < 0) return;
    (void)hipMemsetAsync((char*)d_ws + WS_CTL, 0, 64 * 1024, stream);
    Args a{};
    for (int i = 0; i < 26; ++i) a.in[i] = (const float*)d_in[i];
    a.out = (float*)d_out; a.ws = (unsigned char*)d_ws;
    unsigned char* ws = (unsigned char*)d_ws;
    const float* fg = a.in[19]; const float* fu = a.in[20]; const float* fd = a.in[21];
    const size_t LW = (size_t)DM * FFH;
    int j = 0;
    a.tj[j++] = TJob{a.in[1], nullptr, (bf16_t*)(ws + W_AB), DM, AB_IN, AB_NP, 0};
    a.tj[j++] = TJob{a.in[7], nullptr, (bf16_t*)(ws + W_UQ), 1024, 3072, 3072, 0};
    a.tj[j++] = TJob{a.in[8], nullptr, (bf16_t*)(ws + W_UKV), 512, 4096, 4096, 0};
    a.tj[j++] = TJob{a.in[9], nullptr, (bf16_t*)(ws + W_O0), DM, DM, DM, 0};
    a.tj[j++] = TJob{fg, fu, (bf16_t*)(ws + W_GU0), DM, FFH, GU_N, 1};
    a.tj[j++] = TJob{fd, nullptr, (bf16_t*)(ws + W_D0), FFH, DM, DM, 0};
    a.tj[j++] = TJob{a.in[10], nullptr, (bf16_t*)(ws + W_C), DM, C_IN, C_NP, 0};
    a.tj[j++] = TJob{a.in[14], nullptr, (bf16_t*)(ws + W_C1K), 4096, 256, 256, 0};
    a.tj[j++] = TJob{a.in[16], nullptr, (bf16_t*)(ws + W_C1V), 4096, 256, 256, 0};
    a.tj[j++] = TJob{a.in[15], nullptr, (bf16_t*)(ws + W_C2K), 256, 128, 256, 0};
    a.tj[j++] = TJob{a.in[17], nullptr, (bf16_t*)(ws + W_C2V), 256, 128, 256, 0};
    a.tj[j++] = TJob{a.in[18], nullptr, (bf16_t*)(ws + W_O1), DM, DM, DM, 0};
    a.tj[j++] = TJob{fg + LW, fu + LW, (bf16_t*)(ws + W_GU1), DM, FFH, GU_N, 1};
    a.tj[j++] = TJob{fd + LW, nullptr, (bf16_t*)(ws + W_D1), FFH, DM, DM, 0};
#if MK_N_LAUNCHES == 1
    a.ph_lo = 0; a.ph_hi = N_PHASES;
    hipLaunchKernelGGL(fwd, dim3(grid), dim3(NTHREADS), LDS_BYTES, stream, a);
#else
    for (int p = 0; p < N_PHASES; ++p) { a.ph_lo = p; a.ph_hi = p + 1; hipLaunchKernelGGL(fwd, dim3(grid), dim3(NTHREADS), LDS_BYTES, stream, a); }
#endif
    const hipError_t le = hipPeekAtLastError();
    if (le != hipSuccess) fprintf(stderr, "kernel_launch: launch failed: %s\n", hipGetErrorName(le));
}
```

```cpp
#include <hip/hip_runtime.h>
#include <stdint.h>
#include <stdio.h>
#ifndef FLASH2
#define FLASH2 0
#endif
#ifndef DEBUG_CMP
#define DEBUG_CMP -1
#endif
#ifndef MLSTM_BOTH
#define MLSTM_BOTH 0
#endif
#ifndef MLSTM_CHUNK
#define MLSTM_CHUNK 1
#endif

typedef unsigned short bf16_t;
typedef short bf16x8 __attribute__((ext_vector_type(8)));
typedef short s16x4 __attribute__((ext_vector_type(4)));
typedef float f32x2 __attribute__((ext_vector_type(2)));
typedef float f32x4 __attribute__((ext_vector_type(4)));
typedef float f32x16 __attribute__((ext_vector_type(16)));
typedef unsigned u32x2 __attribute__((ext_vector_type(2)));
typedef unsigned u32x4 __attribute__((ext_vector_type(4)));

constexpr int M_TOK = 16384, SEQ = 4096, NBATCH = 4, DM = 4096;
constexpr int AB_IN = 7752, AB_NP = 7936, C_IN = 7264, C_NP = 7424, FFH = 11008, GU_N = 22016;
constexpr float DN_ALPHA = 1.4142135623730951f;
constexpr float LN_EPS = 1e-5f, RMS_EPS = 1e-6f;
constexpr int AB_Q = 0, AB_K = 1024, AB_V = 2048, AB_IG = 4096, AB_FG = 4100, AB_OG = 4104, AB_CQ = 6152, AB_CKV = 7176, AB_KR = 7688;
constexpr int C_Q = 0, C_KC = 4096, C_VC = 4608, C_KS = 5120, C_VS = 5632, C_KW = 6144, C_VW = 6656, C_GATE = 7168;

__device__ __forceinline__ float bf2f(bf16_t b) { return __uint_as_float(((unsigned)b) << 16); }
__device__ __forceinline__ unsigned cvt_pk_bf16(float lo, float hi) { unsigned r; asm volatile("v_cvt_pk_bf16_f32 %0, %1, %2" : "=v"(r) : "v"(lo), "v"(hi)); return r; }
__device__ __forceinline__ bf16_t f2bf(float f) { return (bf16_t)(cvt_pk_bf16(f, 0.f) & 0xffffu); }
__device__ __forceinline__ void unpack8(const bf16x8 v, float (&f)[8]) {
#pragma unroll
    for (int j = 0; j < 8; ++j) f[j] = bf2f((bf16_t)v[j]);
}
__device__ __forceinline__ bf16x8 pack8f(const float (&f)[8]) {
    u32x4 w = {cvt_pk_bf16(f[0], f[1]), cvt_pk_bf16(f[2], f[3]), cvt_pk_bf16(f[4], f[5]), cvt_pk_bf16(f[6], f[7])};
    return *reinterpret_cast<bf16x8*>(&w);
}
typedef _Float16 f16x2_t __attribute__((ext_vector_type(2)));
__device__ __forceinline__ unsigned cvt_pk_f16(float lo, float hi) { const f16x2_t h = {(_Float16)lo, (_Float16)hi}; return __builtin_bit_cast(unsigned, h); }
__device__ __forceinline__ void unpack8h(const bf16x8 v, float (&f)[8]) {
#pragma unroll
    for (int j = 0; j < 8; ++j) f[j] = (float)__builtin_bit_cast(_Float16, (short)v[j]);
}
__device__ __forceinline__ bf16x8 pack8h(const float (&f)[8]) {
    u32x4 w = {cvt_pk_f16(f[0], f[1]), cvt_pk_f16(f[2], f[3]), cvt_pk_f16(f[4], f[5]), cvt_pk_f16(f[6], f[7])};
    return *reinterpret_cast<bf16x8*>(&w);
}
__device__ __forceinline__ float wave_sum(float v) {
#pragma unroll
    for (int o = 32; o >= 1; o >>= 1) v += __shfl_xor(v, o);
    return v;
}
__device__ __forceinline__ float sigmoid_f(float x) { return __builtin_amdgcn_rcpf(1.0f + __expf(-x)); }

#define XB_TMO      128
#define XB_XCNT(j)  (256  + 64 * (j))
#define XB_XSUB(j)  (1280 + 64 * (j))
#define XB_XGEN(j)  (2304 + 64 * (j))
#define XB_TOP      3328
#define XB_TOPGEN   3392
#define XCD_BAR_WORDS 3456
#define XB_SPIN_CAP (1u << 22)
#define LAS __attribute__((address_space(3)))

__device__ __forceinline__ unsigned xb_ld(unsigned* p)              { return __hip_atomic_load(p, __ATOMIC_RELAXED, __HIP_MEMORY_SCOPE_AGENT); }
__device__ __forceinline__ unsigned xb_add(unsigned* p, unsigned v) { return __hip_atomic_fetch_add(p, v, __ATOMIC_RELAXED, __HIP_MEMORY_SCOPE_AGENT); }
__device__ __forceinline__ unsigned xb_xcc_id() { return (unsigned)__builtin_amdgcn_s_getreg((3 << 11) | 20) & 0xFu; }
#define XB_SPIN(cond, bar) do { unsigned _sp = 0; while (cond) { __builtin_amdgcn_s_sleep(1); \
    if ((++_sp & 255u) == 0u) { if (xb_ld(&(bar)[XB_TMO])) break; if (_sp > XB_SPIN_CAP) { atomicAdd(&(bar)[XB_TMO], 1u); break; } } } } while (0)

struct XcdBarrier {
    unsigned* bar; unsigned x;
    volatile LAS unsigned* st;
};

__device__ __forceinline__ XcdBarrier xcd_barrier_post(unsigned* bar, volatile LAS unsigned* st) {
    XcdBarrier b; b.bar = bar; b.x = xb_xcc_id(); b.st = st;
    if (threadIdx.x == 0) (void)xb_add(&bar[XB_XCNT(b.x)], 1u);
    return b;
}
__device__ __forceinline__ void xcd_barrier_complete(unsigned* bar, unsigned x, unsigned& nloc, unsigned& nx) {
    const unsigned G = gridDim.x * gridDim.y * gridDim.z;
    unsigned sum, cnt, mine, sp = 0u;
    for (;;) {
        sum = 0u; cnt = 0u; mine = 0u;
#pragma unroll
        for (unsigned j = 0; j < 16; ++j) { const unsigned c = xb_ld(&bar[XB_XCNT(j)]); sum += c; cnt += (c > 0u) ? 1u : 0u; mine = (j == x) ? c : mine; }
        if (sum == G) break;
        __builtin_amdgcn_s_sleep(1);
        if ((++sp & 255u) == 0u) { if (xb_ld(&bar[XB_TMO])) break; if (sp > XB_SPIN_CAP) { atomicAdd(&bar[XB_TMO], 1u); break; } }
    }
    nloc = mine > 0u ? mine : 1u; nx = cnt > 0u ? cnt : 1u;
}

__device__ __forceinline__ void xcd_barrier(const XcdBarrier& b) {
    asm volatile("s_waitcnt vmcnt(0)" ::: "memory");
    __syncthreads();
    if (threadIdx.x == 0) {
        unsigned* bar = b.bar;
        __builtin_amdgcn_s_waitcnt(0);
        unsigned nloc = b.st[0], nx = b.st[1];
        if (nloc == 0u) { xcd_barrier_complete(bar, b.x, nloc, nx); b.st[0] = nloc; b.st[1] = nx; }
        const unsigned old = xb_add(&bar[XB_XSUB(b.x)], 1u);
        const unsigned gen = old / nloc;
        if (old + 1u == (gen + 1u) * nloc) {
            __builtin_amdgcn_fence(__ATOMIC_RELEASE, "agent");
            asm volatile("s_waitcnt vmcnt(0)" ::: "memory");
            const unsigned og = xb_add(&bar[XB_TOP], 1u);
            const unsigned tg = og / nx;
            if (og + 1u == (tg + 1u) * nx) xb_add(&bar[XB_TOPGEN], 1u);
            else XB_SPIN(xb_ld(&bar[XB_TOPGEN]) == tg, bar);
            __builtin_amdgcn_fence(__ATOMIC_ACQUIRE, "agent");
            xb_add(&bar[XB_XGEN(b.x)], 1u);
            asm volatile("s_waitcnt vmcnt(0)" ::: "memory");
        } else {
            XB_SPIN(xb_ld(&bar[XB_XGEN(b.x)]) == gen, bar);
            __builtin_amdgcn_fence(__ATOMIC_ACQUIRE, "agent");
            asm volatile("s_waitcnt vmcnt(0)" ::: "memory");
        }
    }
    __syncthreads();
}namespace pg8 {
#define PG8_LAS __attribute__((address_space(3)))
typedef unsigned short bf16_t;
typedef short bf16x8 __attribute__((ext_vector_type(8)));
typedef float f32x4 __attribute__((ext_vector_type(4)));
typedef unsigned u32x4 __attribute__((ext_vector_type(4)));
constexpr int BM = 256, BK = 64, HALF = 128, HTB = HALF * BK * 2  , STAGE_BYTES = 8 * HTB, NXCD = 8;

__host__ __device__ __forceinline__ int lds_byte(int r, int c) { const int st = (r >> 4) * 2 + (c >> 5), rr = r & 15, cc = c & 31, ob = rr * 64 + cc * 2; return st * 1024 + (ob ^ (((ob >> 9) & 1) << 5)); }
__host__ __device__ __forceinline__ void stage_rc(int b, int& R, int& C) { const int st = b / 1024, sb = b % 1024, swz = sb ^ (((sb >> 9) & 1) << 5); R = (st >> 1) * 16 + swz / 64; C = (st & 1) * 32 + (swz % 64) / 2; }
__host__ __device__ __forceinline__ int perm32(int rho) { const int n = rho >> 4, i = rho & 15; return 8 * (i >> 2) + 4 * n + (i & 3); }

struct Unit { int pm, pn; };
struct Gemm { const bf16_t* A; const bf16_t* Bt; int M, N, K; };

struct StaticOrder {
    int nM, nN, nwg, G, c, WGM = 8;
    __host__ __device__ void init(int M, int N, int G_, int c_) { nM = M / BM; nN = N / BM; nwg = nM * nN; G = G_; c = c_; }
    __host__ __device__ bool next(int i, Unit& u) const {
        const long L = (long)i * G + c; if (L >= nwg) return false;
        int wgid = (int)L; { const int q = nwg / NXCD, r = nwg % NXCD, xcd = wgid % NXCD, off = wgid / NXCD; wgid = (xcd < r ? xcd * (q + 1) : r * (q + 1) + (xcd - r) * q) + off; }
        const int nig = WGM * nN, gid = wgid / nig, fm = gid * WGM, gsz = (nM - fm) < WGM ? (nM - fm) : WGM;
        u.pm = fm + ((wgid % nig) % gsz); u.pn = (wgid % nig) / gsz; return true;
    }
    __device__ __forceinline__ void a_ready(const Unit&) const {}
    __device__ __forceinline__ void done(const Unit&) const {}
};
struct CountedOrder : StaticOrder {
    const unsigned* ready; unsigned need; unsigned* tmo;
    __device__ __forceinline__ void a_ready(const Unit& u) const {
        if (threadIdx.x < 64) {
            const unsigned long long t0 = __builtin_amdgcn_s_memrealtime(); unsigned polls = 0;
            while ((unsigned)__builtin_amdgcn_readfirstlane(__hip_atomic_load(ready + 64 * u.pm, __ATOMIC_RELAXED, __HIP_MEMORY_SCOPE_AGENT)) < need) {
                if ((++polls & 255u) == 0u && __builtin_amdgcn_readfirstlane(__hip_atomic_load(tmo, __ATOMIC_RELAXED, __HIP_MEMORY_SCOPE_AGENT)) != 0u) break;
                if (__builtin_amdgcn_s_memrealtime() - t0 > 2000000ull) {
                    if (threadIdx.x == 0) { unsigned expect = 0u; __hip_atomic_compare_exchange_strong(tmo + 1, &expect, 0x600u | (unsigned)(u.pm & 0xff), __ATOMIC_RELAXED, __ATOMIC_RELAXED, __HIP_MEMORY_SCOPE_AGENT); __hip_atomic_store(tmo, 1u, __ATOMIC_RELAXED, __HIP_MEMORY_SCOPE_AGENT); }
                    break; }
                __builtin_amdgcn_s_sleep(2); }
            __builtin_amdgcn_fence(__ATOMIC_ACQUIRE, "agent");
            asm volatile("s_waitcnt vmcnt(0)" ::: "memory");
        }
#if !defined(BROKEN_HOOK_NO_BARRIER)
        asm volatile("" ::: "memory"); __builtin_amdgcn_s_barrier(); asm volatile("" ::: "memory");
#endif
    }
};

__device__ __forceinline__ unsigned cvt_pk_bf16(float lo, float hi) { unsigned r; asm volatile("v_cvt_pk_bf16_f32 %0, %1, %2" : "=v"(r) : "v"(lo), "v"(hi)); return r; }
typedef float f32x2 __attribute__((ext_vector_type(2)));
__device__ __forceinline__ f32x2 gelu_pk(f32x2 v) {
    const f32x2 av = __builtin_elementwise_abs(v), d = av * 0.2316418882f + 1.0f;
    f32x2 t; t.x = __builtin_amdgcn_rcpf(d.x); t.y = __builtin_amdgcn_rcpf(d.y);
    f32x2 q = t * 0.5307027145f + (-0.7265760135f); q = q * t + 0.7107068705f; q = q * t + (-0.142248368f); q = q * t + 0.127414796f; q = q * t;
    const f32x2 s = (v * v) * (-0.72134752044f);
    f32x2 e; e.x = __builtin_amdgcn_exp2f(s.x); e.y = __builtin_amdgcn_exp2f(s.y);
    const f32x2 m = v * (q * e), r = v - m;
    f32x2 o; o.x = v.x < 0.f ? m.x : r.x; o.y = v.y < 0.f ? m.y : r.y; return o;
}

struct EpiF32 {
    static constexpr bool PERM = false, AFTER_DRAIN = false;
    float* C; int ldc; const float* bias;
    __device__ __forceinline__ void operator()(const f32x4 (&acc)[2][2][4][2], const Unit& u, int wr, int wc, int fr, int fq) const {
        const int row0 = u.pm * BM + wr * 64 + fr, col0 = u.pn * BM + wc * 32 + 4 * fq;
        f32x4 bv[2][2];
#pragma unroll
        for (int bj = 0; bj < 2; ++bj)
#pragma unroll
            for (int n = 0; n < 2; ++n) bv[bj][n] = bias ? *(const f32x4*)(bias + col0 + bj * HALF + n * 16) : (f32x4){0.f, 0.f, 0.f, 0.f};
#pragma unroll
        for (int ai = 0; ai < 2; ++ai)
#pragma unroll
            for (int m = 0; m < 4; ++m) { float* rowp = C + (size_t)(row0 + ai * HALF + m * 16) * ldc + col0;
#pragma unroll
                for (int bj = 0; bj < 2; ++bj)
#pragma unroll
                    for (int n = 0; n < 2; ++n) *(f32x4*)(rowp + bj * HALF + n * 16) = acc[ai][bj][m][n] + bv[bj][n]; }
    }
};
template <int ACT  > struct EpiBf16 {
    static constexpr bool PERM = true, AFTER_DRAIN = false;
    bf16_t* O; int ldc; const float* bias; int split_cols; size_t split_stride;
    __device__ __forceinline__ void operator()(const f32x4 (&acc)[2][2][4][2], const Unit& u, int wr, int wc, int fr, int fq) const {
        const int row0 = u.pm * BM + wr * 64 + fr; int colt = u.pn * BM; bf16_t* base = O;
        if (split_cols) { const int t = colt / split_cols; base += (size_t)t * split_stride; colt -= t * split_cols; }
        const int col0 = colt + wc * 32 + 8 * fq, bcol0 = u.pn * BM + wc * 32 + 8 * fq;
        f32x4 bv[2][2];
#pragma unroll
        for (int bj = 0; bj < 2; ++bj)
#pragma unroll
            for (int n = 0; n < 2; ++n) bv[bj][n] = bias ? *(const f32x4*)(bias + bcol0 + bj * HALF + 4 * n) : (f32x4){0.f, 0.f, 0.f, 0.f};
#pragma unroll
        for (int ai = 0; ai < 2; ++ai)
#pragma unroll
            for (int m = 0; m < 4; ++m) { bf16_t* rowp = base + (size_t)(row0 + ai * HALF + m * 16) * ldc + col0;
#pragma unroll
                for (int bj = 0; bj < 2; ++bj) { f32x4 v0 = acc[ai][bj][m][0] + bv[bj][0], v1 = acc[ai][bj][m][1] + bv[bj][1];
                    if (ACT == 1) { f32x2 a = gelu_pk((f32x2){v0[0], v0[1]}), b = gelu_pk((f32x2){v0[2], v0[3]}), c = gelu_pk((f32x2){v1[0], v1[1]}), d = gelu_pk((f32x2){v1[2], v1[3]});
                        v0 = (f32x4){a.x, a.y, b.x, b.y}; v1 = (f32x4){c.x, c.y, d.x, d.y}; }
                    if (ACT == 2) {
#pragma unroll
                        for (int j = 0; j < 4; ++j) { v0[j] = 0.5f * v0[j] * (1.0f + erff(v0[j] * 0.70710678f)); v1[j] = 0.5f * v1[j] * (1.0f + erff(v1[j] * 0.70710678f)); } }
                    u32x4 w; w.x = cvt_pk_bf16(v0[0], v0[1]); w.y = cvt_pk_bf16(v0[2], v0[3]); w.z = cvt_pk_bf16(v1[0], v1[1]); w.w = cvt_pk_bf16(v1[2], v1[3]);
                    *(u32x4*)(rowp + bj * HALF) = w; } }
    }
};
__device__ __forceinline__ float silu_f(float g) { return g * __builtin_amdgcn_rcpf(1.0f + __expf(-g)); }
__device__ __forceinline__ float gelu_tanh_f(float x) { const float y = 0.7978845608028654f * (x + 0.044715f * x * x * x); const float e = __expf(2.0f * y); const float t = 1.0f - 2.0f * __builtin_amdgcn_rcpf(e + 1.0f); return 0.5f * x * (1.0f + t); }
template <int ACT> struct EpiB {
    static constexpr bool PERM = true, AFTER_DRAIN = false;
    bf16_t* O; int ldc;
    __device__ __forceinline__ void operator()(const f32x4 (&acc)[2][2][4][2], const Unit& u, int wr, int wc, int fr, int fq) const {
        const int row0 = u.pm * BM + wr * 64 + fr, col0 = u.pn * BM + wc * 32 + 8 * fq;
        float one = 1.0f; asm volatile("" : "+v"(one));
#pragma unroll
        for (int ai = 0; ai < 2; ++ai)
#pragma unroll
            for (int m = 0; m < 4; ++m) { bf16_t* rowp = O + (size_t)(row0 + ai * HALF + m * 16) * ldc + col0;
#pragma unroll
                for (int bj = 0; bj < 2; ++bj) { f32x4 v0 = acc[ai][bj][m][0] * one, v1 = acc[ai][bj][m][1] * one;
                    if (ACT == 1) {
#pragma unroll
                        for (int j = 0; j < 4; ++j) { v0[j] = gelu_tanh_f(v0[j]); v1[j] = gelu_tanh_f(v1[j]); } }
                    u32x4 w; w.x = cvt_pk_bf16(v0[0], v0[1]); w.y = cvt_pk_bf16(v0[2], v0[3]); w.z = cvt_pk_bf16(v1[0], v1[1]); w.w = cvt_pk_bf16(v1[2], v1[3]);
                    *(u32x4*)(rowp + bj * HALF) = w; } }
    }
};
struct EpiProj {
    static constexpr bool PERM = true, AFTER_DRAIN = false;
    bf16_t* O; int ldc; float* gates; int gate_pn;
    __device__ __forceinline__ void operator()(const f32x4 (&acc)[2][2][4][2], const Unit& u, int wr, int wc, int fr, int fq) const {
        const int row0 = u.pm * BM + wr * 64 + fr, col0 = u.pn * BM + wc * 32 + 8 * fq;
        float one = 1.0f; asm volatile("" : "+v"(one));
#pragma unroll
        for (int ai = 0; ai < 2; ++ai)
#pragma unroll
            for (int m = 0; m < 4; ++m) { bf16_t* rowp = O + (size_t)(row0 + ai * HALF + m * 16) * ldc + col0;
#pragma unroll
                for (int bj = 0; bj < 2; ++bj) { const f32x4 v0 = acc[ai][bj][m][0] * one, v1 = acc[ai][bj][m][1] * one;
                    u32x4 w; w.x = cvt_pk_bf16(v0[0], v0[1]); w.y = cvt_pk_bf16(v0[2], v0[3]); w.z = cvt_pk_bf16(v1[0], v1[1]); w.w = cvt_pk_bf16(v1[2], v1[3]);
                    *(u32x4*)(rowp + bj * HALF) = w; } }
        if (u.pn == gate_pn && wc == 0 && fq == 0) {
#pragma unroll
            for (int ai = 0; ai < 2; ++ai)
#pragma unroll
                for (int m = 0; m < 4; ++m) { float* g = gates + (size_t)(row0 + ai * HALF + m * 16) * 8;
                    *(f32x4*)g = acc[ai][0][m][0]; *(f32x4*)(g + 4) = acc[ai][0][m][1]; }
        }
    }
};
struct EpiSwiGLU {
    static constexpr bool PERM = true, AFTER_DRAIN = false;
    bf16_t* H; int ldh;
    __device__ __forceinline__ void operator()(const f32x4 (&acc)[2][2][4][2], const Unit& u, int wr, int wc, int fr, int fq) const {
        const int row0 = u.pm * BM + wr * 64 + fr, col0 = u.pn * HALF + wc * 32 + 8 * fq;
#pragma unroll
        for (int ai = 0; ai < 2; ++ai)
#pragma unroll
            for (int m = 0; m < 4; ++m) { bf16_t* rowp = H + (size_t)(row0 + ai * HALF + m * 16) * ldh + col0;
                const f32x4 g0 = acc[ai][0][m][0], g1 = acc[ai][0][m][1], u0 = acc[ai][1][m][0], u1 = acc[ai][1][m][1];
                float h[8];
#pragma unroll
                for (int j = 0; j < 4; ++j) { h[j] = silu_f(g0[j]) * u0[j]; h[4 + j] = silu_f(g1[j]) * u1[j]; }
                u32x4 w; w.x = cvt_pk_bf16(h[0], h[1]); w.y = cvt_pk_bf16(h[2], h[3]); w.z = cvt_pk_bf16(h[4], h[5]); w.w = cvt_pk_bf16(h[6], h[7]);
                *(u32x4*)rowp = w; }
    }
};
struct EpiResid {
    static constexpr bool PERM = false, AFTER_DRAIN = false;
    float* C; const float* R; int ldc; float alpha;
    __device__ __forceinline__ void operator()(const f32x4 (&acc)[2][2][4][2], const Unit& u, int wr, int wc, int fr, int fq) const {
        const int row0 = u.pm * BM + wr * 64 + fr, col0 = u.pn * BM + wc * 32 + 4 * fq;
#pragma unroll
        for (int ai = 0; ai < 2; ++ai) {
            f32x4 r[4][2][2];
#pragma unroll
            for (int m = 0; m < 4; ++m) { const size_t off = (size_t)(row0 + ai * HALF + m * 16) * ldc + col0;
#pragma unroll
                for (int bj = 0; bj < 2; ++bj)
#pragma unroll
                    for (int n = 0; n < 2; ++n) r[m][bj][n] = *(const f32x4*)(R + off + bj * HALF + n * 16); }
            asm volatile("" ::: "memory");
#pragma unroll
            for (int m = 0; m < 4; ++m) { const size_t off = (size_t)(row0 + ai * HALF + m * 16) * ldc + col0;
#pragma unroll
                for (int bj = 0; bj < 2; ++bj)
#pragma unroll
                    for (int n = 0; n < 2; ++n) *(f32x4*)(C + off + bj * HALF + n * 16) = acc[ai][bj][m][n] + alpha * r[m][bj][n]; }
            asm volatile("" ::: "memory");
        }
    }
};
struct EpiResidLN {
    static constexpr bool PERM = false, AFTER_DRAIN = false;
    float* C; const float* Zp; const f32x2* st; const float* g; const float* b; int ldc; float alpha;
    __device__ __forceinline__ void operator()(const f32x4 (&acc)[2][2][4][2], const Unit& u, int wr, int wc, int fr, int fq) const {
        const int row0 = u.pm * BM + wr * 64 + fr, col0 = u.pn * BM + wc * 32 + 4 * fq;
#pragma unroll
        for (int bj = 0; bj < 2; ++bj)
#pragma unroll
            for (int n = 0; n < 2; ++n) {
                const int cc = col0 + bj * HALF + n * 16;
                const f32x4 gv = *(const f32x4*)(g + cc) * alpha, bv = *(const f32x4*)(b + cc) * alpha;
                f32x4 r[2][4]; f32x2 ms[2][4];
#pragma unroll
                for (int ai = 0; ai < 2; ++ai)
#pragma unroll
                    for (int m = 0; m < 4; ++m) { const int row = row0 + ai * HALF + m * 16; ms[ai][m] = st[row]; r[ai][m] = *(const f32x4*)(Zp + (size_t)row * ldc + cc); }
                asm volatile("" ::: "memory");
#pragma unroll
                for (int ai = 0; ai < 2; ++ai)
#pragma unroll
                    for (int m = 0; m < 4; ++m) { const int row = row0 + ai * HALF + m * 16;
                        *(f32x4*)(C + (size_t)row * ldc + cc) = acc[ai][bj][m][n] + ((r[ai][m] - ms[ai][m].x) * ms[ai][m].y) * gv + bv; }
                asm volatile("" ::: "memory");
            }
    }
};
struct EpiResidB {
    static constexpr bool PERM = true, AFTER_DRAIN = false;
    bf16_t* C; const bf16_t* R;
    __device__ __forceinline__ void operator()(const f32x4 (&acc)[2][2][4][2], const Unit& u, int wr, int wc, int fr, int fq) const {
        const int row0 = u.pm * BM + wr * 64 + fr, col0 = u.pn * BM + wc * 32 + 8 * fq;
#pragma unroll
        for (int ai = 0; ai < 2; ++ai) {
            bf16x8 r[4][2];
#pragma unroll
            for (int m = 0; m < 4; ++m)
#pragma unroll
                for (int bj = 0; bj < 2; ++bj) r[m][bj] = *(const bf16x8*)((const char*)R + (unsigned)((row0 + ai * HALF + m * 16) * DM + col0 + bj * HALF) * 2u);
            asm volatile("" ::: "memory");
#pragma unroll
            for (int m = 0; m < 4; ++m)
#pragma unroll
                for (int bj = 0; bj < 2; ++bj) { float x[8]; unpack8(r[m][bj], x);
                    const f32x4 a0 = acc[ai][bj][m][0], a1 = acc[ai][bj][m][1];
                    float v[8];
#pragma unroll
                    for (int j = 0; j < 4; ++j) { v[j] = a0[j] + DN_ALPHA * x[j]; v[4 + j] = a1[j] + DN_ALPHA * x[4 + j]; }
                    *(bf16x8*)((char*)C + (unsigned)((row0 + ai * HALF + m * 16) * DM + col0 + bj * HALF) * 2u) = pack8h(v); }
            asm volatile("" ::: "memory");
        }
    }
};
struct EpiResidLNB {
    static constexpr bool PERM = true, AFTER_DRAIN = false;
    bf16_t* C; const bf16_t* Zp; const f32x2* st; const float* g; const float* b;
    __device__ __forceinline__ void operator()(const f32x4 (&acc)[2][2][4][2], const Unit& u, int wr, int wc, int fr, int fq) const {
        const int row0 = u.pm * BM + wr * 64 + fr, col0 = u.pn * BM + wc * 32 + 8 * fq;
#pragma unroll
        for (int bj = 0; bj < 2; ++bj) {
            const int cc = col0 + bj * HALF;
            const f32x4 g0 = *(const f32x4*)(g + cc) * DN_ALPHA, g1 = *(const f32x4*)(g + cc + 4) * DN_ALPHA, b0 = *(const f32x4*)(b + cc) * DN_ALPHA, b1 = *(const f32x4*)(b + cc + 4) * DN_ALPHA;
            bf16x8 r[2][4]; f32x2 ms[2][4];
#pragma unroll
            for (int ai = 0; ai < 2; ++ai)
#pragma unroll
                for (int m = 0; m < 4; ++m) { const int row = row0 + ai * HALF + m * 16; ms[ai][m] = *(const f32x2*)((const char*)st + (unsigned)row * 8u); r[ai][m] = *(const bf16x8*)((const char*)Zp + (unsigned)(row * DM + cc) * 2u); }
            asm volatile("" ::: "memory");
#pragma unroll
            for (int ai = 0; ai < 2; ++ai)
#pragma unroll
                for (int m = 0; m < 4; ++m) { const int row = row0 + ai * HALF + m * 16; float x[8]; unpack8h(r[ai][m], x);
                    const f32x4 a0 = acc[ai][bj][m][0], a1 = acc[ai][bj][m][1]; const float mu = ms[ai][m].x, rs = ms[ai][m].y;
                    float v[8];
#pragma unroll
                    for (int j = 0; j < 4; ++j) { v[j] = a0[j] + (((x[j] - mu) * rs) * g0[j] + b0[j]); v[4 + j] = a1[j] + (((x[4 + j] - mu) * rs) * g1[j] + b1[j]); }
                    *(bf16x8*)((char*)C + (unsigned)(row * DM + cc) * 2u) = pack8h(v); __builtin_amdgcn_sched_barrier(0); }
            asm volatile("" ::: "memory");
        }
    }
};
template <class Epi, class Sched, bool ALIGN_EPI = false, bool SP2 = false>
__device__ __forceinline__ void gemm_phase(PG8_LAS unsigned char* lds, const Gemm g, const Sched& S, const Epi& E) {
    const int tid = threadIdx.x, wid = __builtin_amdgcn_readfirstlane(tid >> 6), lane = tid & 63, wr = wid >> 2, wc = wid & 3, fr = lane & 15, fq = lane >> 4;
    const int K = g.K, nt = K / BK;
    unsigned voffA[2], voffB[2];
#pragma unroll
    for (int i = 0; i < 2; ++i) { int R, C; stage_rc(tid * 16 + i * 8192, R, C); const int Rb = Epi::PERM ? ((R & ~31) + perm32(R & 31)) : R;
        voffA[i] = (unsigned)(R * K + C) * 2u; voffB[i] = (unsigned)(Rb * K + C) * 2u; }
    const size_t kstep = (size_t)(BK * 2);
    const size_t hstep = (size_t)HALF * K * 2;
    const size_t tstep = 2 * hstep;
    const unsigned ldsw = (unsigned)wid * 1024u;
    const int aoff = lds_byte(wr * 64 + fr, fq * 8), boff = lds_byte(wc * 32 + fr, fq * 8);
#define PG8_SA(b, h) (((b) * 2 + (h)) * HTB)
#define PG8_SB(b, h) ((4 + (b) * 2 + (h)) * HTB)
#define PG8_STAGE(bufoff, gbase, voff) do { _Pragma("unroll") for (int _i = 0; _i < 2; ++_i) \
        __builtin_amdgcn_global_load_lds((const unsigned*)((const char*)(gbase) + (voff)[_i]), (PG8_LAS unsigned*)(lds + (bufoff) + ldsw + _i * 8192), 16, 0, 0); } while (0)
#define PG8_LDA(dst, b, h) do { _Pragma("unroll") for (int m = 0; m < 4; ++m) _Pragma("unroll") for (int k = 0; k < 2; ++k) dst[m][k] = *(const PG8_LAS bf16x8*)(lds + PG8_SA(b, h) + aoff + m * 2048 + k * 1024); } while (0)
#define PG8_LDB(dst, b, h) do { _Pragma("unroll") for (int n = 0; n < 2; ++n) _Pragma("unroll") for (int k = 0; k < 2; ++k) dst[n][k] = *(const PG8_LAS bf16x8*)(lds + PG8_SB(b, h) + boff + n * 2048 + k * 1024); } while (0)
#define PG8_MMA(ai, bj, At, Bt) do { __builtin_amdgcn_s_setprio(1); _Pragma("unroll") for (int m = 0; m < 4; ++m) _Pragma("unroll") for (int n = 0; n < 2; ++n) _Pragma("unroll") for (int k = 0; k < 2; ++k) \
        acc[ai][bj][m][n] = __builtin_amdgcn_mfma_f32_16x16x32_bf16(Bt[n][k], At[m][k], acc[ai][bj][m][n], 0, 0, 0); __builtin_amdgcn_s_setprio(0); } while (0)
#define PG8_WAIT_V(n) asm volatile("s_waitcnt vmcnt(" #n ")" ::: "memory")
#define PG8_WAIT_L(n) asm volatile("s_waitcnt lgkmcnt(" #n ")" ::: "memory")
#define PG8_BAR __builtin_amdgcn_s_barrier()
#define PG8_SCHED __builtin_amdgcn_sched_barrier(0)
    Unit cur, nxt; int ui = 0;
    if (!S.next(0, cur)) return;
    f32x4 acc[2][2][4][2];
#pragma unroll
    for (int a = 0; a < 2; ++a)
#pragma unroll
        for (int b = 0; b < 2; ++b)
#pragma unroll
            for (int m = 0; m < 4; ++m)
#pragma unroll
                for (int n = 0; n < 2; ++n) acc[a][b][m][n] = (f32x4){0.f, 0.f, 0.f, 0.f};
    bf16x8 At[4][2], B0[2][2], B1[2][2];
    const char* cA = (const char*)g.A + (size_t)cur.pm * tstep; const char* cB = (const char*)g.Bt + (size_t)cur.pn * tstep;
    S.a_ready(cur);
    if constexpr (SP2) {
        PG8_STAGE(PG8_SB(0, 0), cB, voffB); PG8_STAGE(PG8_SB(0, 1), cB + hstep, voffB); PG8_STAGE(PG8_SA(0, 0), cA, voffA); PG8_STAGE(PG8_SA(0, 1), cA + hstep, voffA);
        if (wr == 1) PG8_BAR;
        PG8_WAIT_V(2); PG8_BAR;
        PG8_STAGE(PG8_SB(1, 0), cB + kstep, voffB); PG8_STAGE(PG8_SA(1, 0), cA + kstep, voffA); PG8_STAGE(PG8_SB(1, 1), cB + hstep + kstep, voffB);
        PG8_WAIT_V(6); PG8_BAR;
    } else {
        PG8_STAGE(PG8_SB(0, 0), cB, voffB); PG8_STAGE(PG8_SA(0, 0), cA, voffA); PG8_STAGE(PG8_SB(0, 1), cB + hstep, voffB); PG8_STAGE(PG8_SA(0, 1), cA + hstep, voffA);
        if (wr == 1) PG8_BAR;
        PG8_WAIT_V(4); PG8_BAR;
        PG8_STAGE(PG8_SB(1, 0), cB + kstep, voffB); PG8_STAGE(PG8_SA(1, 0), cA + kstep, voffA); PG8_STAGE(PG8_SB(1, 1), cB + hstep + kstep, voffB);
        PG8_WAIT_V(6); PG8_BAR;
    }
    for (;;) {
        const bool has_next = S.next(ui + 1, nxt);
        const char* nA = has_next ? (const char*)g.A + (size_t)nxt.pm * tstep : cA; const char* nB = has_next ? (const char*)g.Bt + (size_t)nxt.pn * tstep : cB;
        for (int t = 0; t < nt; t += 2) {
            const bool last = (t == nt - 2);
            const char* a1 = cA + (size_t)(t + 1) * kstep;
            const char* a2 = last ? nA : cA + (size_t)(t + 2) * kstep; const char* b2 = last ? nB : cB + (size_t)(t + 2) * kstep;
            const char* a3 = a2 + kstep; const char* b3 = b2 + kstep;
            if (last && has_next) S.a_ready(nxt);
            if constexpr (SP2) {
            PG8_LDB(B0, 0, 0); PG8_LDB(B1, 0, 1); PG8_SCHED; PG8_LDA(At, 0, 0); PG8_STAGE(PG8_SA(1, 1), a1 + hstep, voffA);
            PG8_WAIT_V(8); PG8_WAIT_L(0); PG8_BAR; PG8_MMA(0, 0, At, B0); PG8_MMA(0, 1, At, B1); PG8_BAR; PG8_SCHED;
            PG8_LDA(At, 0, 1); PG8_STAGE(PG8_SB(0, 0), b2, voffB); PG8_STAGE(PG8_SB(0, 1), b2 + hstep, voffB); PG8_STAGE(PG8_SA(0, 0), a2, voffA);
            PG8_WAIT_V(8); PG8_WAIT_L(0); PG8_BAR; PG8_MMA(1, 0, At, B0); PG8_MMA(1, 1, At, B1); PG8_BAR; PG8_SCHED;
            PG8_LDB(B0, 1, 0); PG8_LDB(B1, 1, 1); PG8_SCHED; PG8_LDA(At, 1, 0); PG8_STAGE(PG8_SA(0, 1), a2 + hstep, voffA);
            PG8_WAIT_V(8); PG8_WAIT_L(0); PG8_BAR; PG8_MMA(0, 0, At, B0); PG8_MMA(0, 1, At, B1); PG8_BAR; PG8_SCHED;
            PG8_LDA(At, 1, 1); PG8_STAGE(PG8_SB(1, 0), b3, voffB); PG8_STAGE(PG8_SB(1, 1), b3 + hstep, voffB); PG8_STAGE(PG8_SA(1, 0), a3, voffA);
            PG8_WAIT_V(8); PG8_WAIT_L(0); PG8_BAR; PG8_MMA(1, 0, At, B0); PG8_MMA(1, 1, At, B1); PG8_BAR; PG8_SCHED;
            } else {
            PG8_LDB(B0, 0, 0); PG8_SCHED; PG8_LDA(At, 0, 0); PG8_STAGE(PG8_SA(1, 1), a1 + hstep, voffA);
            PG8_WAIT_L(8); PG8_BAR; PG8_WAIT_L(0); PG8_MMA(0, 0, At, B0); PG8_BAR; PG8_SCHED;
            PG8_LDB(B1, 0, 1); PG8_STAGE(PG8_SB(0, 0), b2, voffB);
            PG8_BAR; PG8_WAIT_L(0); PG8_MMA(0, 1, At, B1); PG8_BAR;
            PG8_LDA(At, 0, 1); PG8_STAGE(PG8_SA(0, 0), a2, voffA);
            PG8_BAR; PG8_WAIT_L(0); PG8_MMA(1, 0, At, B0); PG8_BAR; PG8_SCHED;
            PG8_STAGE(PG8_SB(0, 1), b2 + hstep, voffB);
            PG8_WAIT_V(6); PG8_BAR; PG8_MMA(1, 1, At, B1); PG8_BAR;
            PG8_LDB(B0, 1, 0); PG8_SCHED; PG8_LDA(At, 1, 0); PG8_STAGE(PG8_SA(0, 1), a2 + hstep, voffA);
            PG8_WAIT_L(8); PG8_BAR; PG8_WAIT_L(0); PG8_MMA(0, 0, At, B0); PG8_BAR; PG8_SCHED;
            PG8_LDB(B1, 1, 1); PG8_STAGE(PG8_SB(1, 0), b3, voffB);
            PG8_BAR; PG8_WAIT_L(0); PG8_MMA(0, 1, At, B1); PG8_BAR;
            PG8_LDA(At, 1, 1); PG8_STAGE(PG8_SA(1, 0), a3, voffA);
            PG8_BAR; PG8_WAIT_L(0); PG8_MMA(1, 0, At, B0); PG8_BAR; PG8_SCHED;
            PG8_STAGE(PG8_SB(1, 1), b3 + hstep, voffB);
            PG8_WAIT_V(6); PG8_BAR; PG8_MMA(1, 1, At, B1); PG8_BAR;
            }
        }
        if constexpr (ALIGN_EPI) { if (wr == 0) PG8_BAR; }
        if constexpr (!Epi::AFTER_DRAIN) { E(acc, cur, wr, wc, fr, fq); S.done(cur); }
        if (!has_next) break;
#pragma unroll
        for (int a = 0; a < 2; ++a)
#pragma unroll
            for (int b = 0; b < 2; ++b)
#pragma unroll
                for (int m = 0; m < 4; ++m)
#pragma unroll
                    for (int n = 0; n < 2; ++n) acc[a][b][m][n] = (f32x4){0.f, 0.f, 0.f, 0.f};
        cur = nxt; cA = nA; cB = nB; ++ui;
        if constexpr (ALIGN_EPI) { if (wr == 1) PG8_BAR; }
    }
    PG8_WAIT_V(0);
    if constexpr (!ALIGN_EPI) { if (wr == 0) PG8_BAR; }
    PG8_BAR;
    if constexpr (Epi::AFTER_DRAIN) { E.fused(acc, cur, wr, wc, fr, fq, lds, wid, lane); S.done(cur); }
#undef PG8_SA
#undef PG8_SB
#undef PG8_STAGE
#undef PG8_LDA
#undef PG8_LDB
#undef PG8_MMA
#undef PG8_WAIT_V
#undef PG8_WAIT_L
#undef PG8_BAR
#undef PG8_SCHED
}
}
namespace fa {
constexpr int KVBLK = 64, SHM_V = 16384, SHM_K = 16384, SHM_KR = 8192;
constexpr int OFF_V = 0, OFF_K = 2 * SHM_V, OFF_KR = OFF_K + 2 * SHM_K, OFF_WS = OFF_KR + 2 * SHM_KR, OFF_IMP = OFF_WS + 8 * 64 * 4, IMP_LD = 257, OFF_QPARK = OFF_IMP + 32 * IMP_LD * 4 + 128  , LDS_END = OFF_QPARK + 8 * 4096;
#define KSWZ(row, colB) ((row) * 256 + ((colB) ^ (((row) & 7) << 4)))
#define KSWZ16(row, colB) ((row) * 256 + ((colB) ^ (((row) & 15) << 4)))
#define SBAR() __builtin_amdgcn_sched_barrier(0)
__device__ __forceinline__ int v_st(int k, int c) { const int kk = (k & ~0xC) | ((k & 4) << 1) | ((k & 8) >> 1); return ((kk >> 3) * 4 + (c >> 5)) * 512 + ((kk & 7) * 32 + (c & 31)) * 2; }
__device__ __forceinline__ int v_rd_base(int lane) { return ((lane & 3) << 3) | (((lane >> 2) & 3) << 6) | (((lane >> 4) & 1) << 5) | (((lane >> 5) & 1) << 8); }
constexpr int v_rd_off(int d0, int ks, int half) { return d0 * 512 + ks * 4096 + half * 2048; }
__device__ __forceinline__ int crow(int r, int hi) { return (r & 3) + 8 * (r >> 2) + 4 * hi; }
__device__ __forceinline__ unsigned cvtpk(float lo, float hi) { unsigned r; asm volatile("v_cvt_pk_bf16_f32 %0, %1, %2" : "=v"(r) : "v"(lo), "v"(hi)); return r; }
__device__ __forceinline__ bf16x8 pack8(f32x4 a, f32x4 b) { u32x4 w = {cvtpk(a[0], a[1]), cvtpk(a[2], a[3]), cvtpk(b[0], b[1]), cvtpk(b[2], b[3])}; return *reinterpret_cast<bf16x8*>(&w); }
__device__ __forceinline__ void mask_tile(f32x16& p0, f32x16& p1, int dq, unsigned W) {
    const float NEG = -__builtin_inff();
#pragma unroll
    for (int r = 0; r < 16; ++r) {
        const int c = (r & 3) + 8 * (r >> 2);
        if ((unsigned)(dq - c) >= W) p0[r] = NEG;
        if ((unsigned)(dq - c - 32) >= W) p1[r] = NEG;
    }
}
__device__ __forceinline__ void mask_all(f32x16& p0, f32x16& p1, bool kill) {
    const float NEG = -__builtin_inff();
#pragma unroll
    for (int r = 0; r < 16; ++r) { if (kill) { p0[r] = NEG; p1[r] = NEG; } }
}
__device__ __forceinline__ void partialSM(f32x16& p0, f32x16& p1, float& m_reg, float& mn, float& alpha, float scale, float C2, bool kill = false) {
    float pmax = p0[0];
#pragma unroll
    for (int r = 1; r < 16; ++r) pmax = fmaxf(pmax, p0[r]);
#pragma unroll
    for (int r = 0; r < 16; ++r) pmax = fmaxf(pmax, p1[r]);
    { auto rr = __builtin_amdgcn_permlane32_swap(__float_as_uint(pmax), __float_as_uint(pmax), false, false);
      pmax = fmaxf(__uint_as_float(rr[0]), __uint_as_float(rr[1])); }
    if (__builtin_expect(__all((pmax - m_reg) * scale <= 8.0f), 1)) { mn = m_reg; alpha = 1.f; }
    else { mn = fmaxf(m_reg, pmax); alpha = __builtin_amdgcn_exp2f((m_reg - mn) * C2); m_reg = mn; }
    const float mnL = kill ? -__builtin_inff() : -mn * C2;
#pragma unroll
    for (int r = 0; r < 16; ++r) p0[r] = fmaf(p0[r], C2, mnL);
#pragma unroll
    for (int r = 0; r < 16; ++r) p1[r] = fmaf(p1[r], C2, mnL);
#pragma unroll
    for (int r = 0; r < 16; ++r) p0[r] = __builtin_amdgcn_exp2f(p0[r]);
}
__device__ __forceinline__ void finishSM(f32x16& p0, f32x16& p1, float alpha, float& l_reg, bf16x8& pa0, bf16x8& pa1, bf16x8& pa2, bf16x8& pa3) {
#pragma unroll
    for (int r = 0; r < 16; ++r) p1[r] = __builtin_amdgcn_exp2f(p1[r]);
    float ps = 0;
#pragma unroll
    for (int r = 0; r < 16; ++r) ps += p0[r];
#pragma unroll
    for (int r = 0; r < 16; ++r) ps += p1[r];
    { auto rr = __builtin_amdgcn_permlane32_swap(__float_as_uint(ps), __float_as_uint(ps), false, false);
      ps = __uint_as_float(rr[0]) + __uint_as_float(rr[1]); }
    l_reg = l_reg * alpha + ps;
#define PK4(P, B_, OUT) do { unsigned a0 = cvtpk(P[B_+0], P[B_+1]), a1 = cvtpk(P[B_+2], P[B_+3]);                          \
        unsigned b0 = cvtpk(P[B_+4], P[B_+5]), b1 = cvtpk(P[B_+6], P[B_+7]);                                             \
        auto r0 = __builtin_amdgcn_permlane32_swap(a0, b0, false, false); auto r1 = __builtin_amdgcn_permlane32_swap(a1, b1, false, false); \
        u32x4 w = {r0[0], r1[0], r0[1], r1[1]}; OUT = *reinterpret_cast<bf16x8*>(&w); } while (0)
    PK4(p0, 0, pa0); PK4(p0, 8, pa1); PK4(p1, 0, pa2); PK4(p1, 8, pa3);
#undef PK4
}
template <int KB, bool ROPE, bool LIGHT = false>
__device__ __forceinline__ void qkt(f32x16& p0, f32x16& p1, const char* lds, int r32, int hi, const bf16x8* qr, const char* qpark = nullptr) {
    p0 = f32x16{}; p1 = f32x16{};
    const char* K_lds = lds + OFF_K;
    const char* kb[4];
#pragma unroll
    for (int dd = 0; dd < 4; ++dd) kb[dd] = K_lds + KB * SHM_K + KSWZ(r32, (dd * 16 + hi * 8) * 2);
    bf16x8 f[4][4];
#define QK_LD(g) do { const char* a0_ = kb[(2 * (g)) & 3] + ((2 * (g)) >> 2) * 128; const char* a1_ = kb[(2 * (g) + 1) & 3] + ((2 * (g) + 1) >> 2) * 128; \
        f[(g) & 3][0] = *reinterpret_cast<const bf16x8*>(a0_); f[(g) & 3][1] = *reinterpret_cast<const bf16x8*>(a0_ + 32 * 256); \
        f[(g) & 3][2] = *reinterpret_cast<const bf16x8*>(a1_); f[(g) & 3][3] = *reinterpret_cast<const bf16x8*>(a1_ + 32 * 256); } while (0)
#define QK_MM(g) do { p0 = __builtin_amdgcn_mfma_f32_32x32x16_bf16(f[(g) & 3][0], qr[2 * (g)], p0, 0, 0, 0); p1 = __builtin_amdgcn_mfma_f32_32x32x16_bf16(f[(g) & 3][1], qr[2 * (g)], p1, 0, 0, 0); \
        p0 = __builtin_amdgcn_mfma_f32_32x32x16_bf16(f[(g) & 3][2], qr[2 * (g) + 1], p0, 0, 0, 0); p1 = __builtin_amdgcn_mfma_f32_32x32x16_bf16(f[(g) & 3][3], qr[2 * (g) + 1], p1, 0, 0, 0); } while (0)
    if constexpr (ROPE) {
        QK_LD(0); SBAR();
        QK_LD(1); SBAR(); QK_MM(0); SBAR();
        QK_LD(2); SBAR(); QK_MM(1); SBAR();
        QK_LD(3); SBAR(); QK_MM(2); SBAR();
        const char* KR_lds = lds + OFF_KR + KB * SHM_KR + r32 * 128;
        bf16x8 ra[2], rb[2], qa, qb_;
#define QR_LD(d0, R, Q) do { const char* a = KR_lds + (((d0) * 32 + hi * 16) ^ ((r32 & 7) << 4)); R[0] = *reinterpret_cast<const bf16x8*>(a); R[1] = *reinterpret_cast<const bf16x8*>(a + 32 * 128); Q = *reinterpret_cast<const bf16x8*>(qpark + (d0) * 1024); } while (0)
#define QR_MM(R, Q) do { p0 = __builtin_amdgcn_mfma_f32_32x32x16_bf16(R[0], Q, p0, 0, 0, 0); p1 = __builtin_amdgcn_mfma_f32_32x32x16_bf16(R[1], Q, p1, 0, 0, 0); } while (0)
        QR_LD(0, ra, qa); SBAR(); QK_MM(3); SBAR();
        QR_LD(1, rb, qb_); SBAR(); QR_MM(ra, qa); SBAR();
        QR_LD(2, ra, qa); SBAR(); QR_MM(rb, qb_); SBAR();
        QR_LD(3, rb, qb_); SBAR(); QR_MM(ra, qa); SBAR();
        QR_MM(rb, qb_);
#undef QR_LD
#undef QR_MM
    } else if constexpr (LIGHT) {
        QK_LD(0); SBAR();
        QK_LD(1); SBAR(); QK_MM(0); SBAR();
        QK_LD(2); SBAR(); QK_MM(1); SBAR();
        QK_LD(3); SBAR(); QK_MM(2); SBAR();
        QK_MM(3);
    } else {
        QK_LD(0); QK_LD(1); SBAR();
        QK_LD(2); SBAR(); QK_MM(0); SBAR();
        QK_LD(3); SBAR(); QK_MM(1); SBAR();
        QK_MM(2); QK_MM(3);
    }
#undef QK_LD
#undef QK_MM
}
template <int VB, bool PIPE>
__device__ __forceinline__ void pv_tile(f32x16* o, int vb0, bf16x8 pa0, bf16x8 pa1, bf16x8 pa2, bf16x8 pa3) {
#define TRRD(dst, off) asm volatile("ds_read_b64_tr_b16 %0, %1 offset:%2" : "=&v"(dst) : "v"(vb0), "i"(off) : "memory")
#define PV_LD(S, d0) do { constexpr int b_ = OFF_V + VB * SHM_V + v_rd_off(d0, 0, 0); TRRD(S[0], b_); TRRD(S[1], b_ + 2048); TRRD(S[2], b_ + 4096); TRRD(S[3], b_ + 6144); TRRD(S[4], b_ + 8192); TRRD(S[5], b_ + 10240); TRRD(S[6], b_ + 12288); TRRD(S[7], b_ + 14336); } while (0)
#define PV_MM(S, d0) do { \
        o[d0] = __builtin_amdgcn_mfma_f32_32x32x16_bf16(pa0, (bf16x8){S[0][0], S[0][1], S[0][2], S[0][3], S[1][0], S[1][1], S[1][2], S[1][3]}, o[d0], 0, 0, 0);   \
        o[d0] = __builtin_amdgcn_mfma_f32_32x32x16_bf16(pa1, (bf16x8){S[2][0], S[2][1], S[2][2], S[2][3], S[3][0], S[3][1], S[3][2], S[3][3]}, o[d0], 0, 0, 0);   \
        o[d0] = __builtin_amdgcn_mfma_f32_32x32x16_bf16(pa2, (bf16x8){S[4][0], S[4][1], S[4][2], S[4][3], S[5][0], S[5][1], S[5][2], S[5][3]}, o[d0], 0, 0, 0);   \
        o[d0] = __builtin_amdgcn_mfma_f32_32x32x16_bf16(pa3, (bf16x8){S[6][0], S[6][1], S[6][2], S[6][3], S[7][0], S[7][1], S[7][2], S[7][3]}, o[d0], 0, 0, 0); } while (0)
#define PV_W(n) do { asm volatile("s_waitcnt lgkmcnt(" #n ")" ::: "memory"); SBAR(); } while (0)
    if constexpr (PIPE) {
        s16x4 A[8], B[8];
        PV_LD(A, 0); PV_LD(B, 1); PV_W(8); PV_MM(A, 0);
        PV_LD(A, 2); PV_W(8); PV_MM(B, 1);
        PV_LD(B, 3); PV_W(8); PV_MM(A, 2);
        PV_W(0); PV_MM(B, 3);
    } else {
        s16x4 A[8];
        PV_LD(A, 0); PV_W(0); PV_MM(A, 0); PV_LD(A, 1); PV_W(0); PV_MM(A, 1); PV_LD(A, 2); PV_W(0); PV_MM(A, 2); PV_LD(A, 3); PV_W(0); PV_MM(A, 3);
    }
#undef PV_W
#undef PV_MM
#undef PV_LD
#undef TRRD
}

struct FUnit {
    const bf16_t* Kb; long ldk; const bf16_t* Vb; long ldv; const bf16_t* KRb;
    int j_lo, j_hi;
    int qlo, qhi;
    int qpos;
    unsigned long long sel;
};
template <int MODE, int VAR = 0>
__device__ __forceinline__ void flash_core(char* lds, const FUnit& u, const bf16x8* qr, float scale, f32x16 (&o)[4], float& m_reg, float& l_reg) {
    constexpr bool ROPE = (MODE == 0);
    const int tid = threadIdx.x, wid = __builtin_amdgcn_readfirstlane(tid >> 6), lane = tid & 63, r32 = lane & 31, hi = lane >> 5;
    const int grp = wid >> 2;
    const float C2 = 1.4426950408889634f * scale;
    char* V_lds = lds + OFF_V; char* K_lds = lds + OFF_K; char* KR_lds = lds + OFF_KR;
    float* ws = (float*)(lds + OFF_WS) + wid * 64; float* al_l = ws + 32;
    const int sr = tid >> 4, sc = (tid & 15) * 8, vst0 = v_st(sr, sc), vst1 = v_st(32 + sr, sc), kws = KSWZ(sr, sc * 2);
    const int rr = tid >> 3, rc = (tid & 7) * 8, krws = rr * 128 + ((rc * 2) ^ ((rr & 7) << 4));
    const int vb0 = (int)(uintptr_t)lds + v_rd_base(lane);
    const char* qpark = lds + OFF_QPARK + wid * 4096 + lane * 16;
    m_reg = -1e30f; l_reg = 0.f;
#pragma unroll
    for (int d = 0; d < 4; ++d) o[d] = f32x16{};
    const int NT = u.j_hi - u.j_lo;
    if (NT <= 0) return;
    bf16x8 st_k0, st_k1, st_v0, st_v1, st_kr;
    f32x16 p0, p1; float mn, al; bf16x8 pa0, pa1, pa2, pa3;
    const unsigned W = (MODE == 1) ? 512u : ((MODE == 3) ? 0x80000000u : 0x7fffffffu);
#define FA_KBASE(t) ((u.j_lo + (t)) * KVBLK)
#define FA_KLOAD(k0) do { st_k0 = *(const bf16x8*)(u.Kb + (long)((k0) + sr) * u.ldk + sc); st_k1 = *(const bf16x8*)(u.Kb + (long)((k0) + 32 + sr) * u.ldk + sc);   \
                          if constexpr (ROPE) st_kr = *(const bf16x8*)(u.KRb + (long)((k0) + rr) * 64 + rc); } while (0)
#define FA_VLOAD(k0) do { st_v0 = *(const bf16x8*)(u.Vb + (long)((k0) + sr) * u.ldv + sc); st_v1 = *(const bf16x8*)(u.Vb + (long)((k0) + 32 + sr) * u.ldv + sc); } while (0)
#define FA_KWRITE(bf) do { *(bf16x8*)(K_lds + (bf) * SHM_K + kws) = st_k0; *(bf16x8*)(K_lds + (bf) * SHM_K + kws + 32 * 256) = st_k1;   \
                           if constexpr (ROPE) *(bf16x8*)(KR_lds + (bf) * SHM_KR + krws) = st_kr; } while (0)
#define FA_VWRITE(bf) do { *(bf16x8*)(V_lds + (bf) * SHM_V + vst0) = st_v0; *(bf16x8*)(V_lds + (bf) * SHM_V + vst1) = st_v1; } while (0)
#define FA_BAR() do { asm volatile("s_waitcnt lgkmcnt(0)" ::: "memory"); __builtin_amdgcn_s_barrier(); asm volatile("" ::: "memory"); } while (0)
#define FA_RESC(a) do { if (__any((a) < 1.f)) { if (hi == 0) al_l[r32] = (a); asm volatile("s_waitcnt lgkmcnt(0)" ::: "memory");              \
                     _Pragma("unroll") for (int d_ = 0; d_ < 4; ++d_) { _Pragma("unroll") for (int r = 0; r < 16; ++r) o[d_][r] *= al_l[crow(r, hi)]; } asm volatile("" ::: "memory"); } } while (0)
#define FA_MASK(t) do { const int kb_ = FA_KBASE(t);                                                                             \
        if (MODE == 1) { if (kb_ + KVBLK - 1 > u.qlo || kb_ <= u.qhi - 512) mask_tile(p0, p1, u.qpos - kb_ - 4 * hi, W); }       \
        else { if (kb_ + KVBLK - 1 > u.qlo) mask_tile(p0, p1, u.qpos - kb_ - 4 * hi, W); }                                       \
        } while (0)
#define FA_KILL(t) ((MODE == 2) && (((u.sel >> (u.j_lo + (t))) & 1ull) == 0ull))
    const int kb_last = FA_KBASE(NT - 1);
    FA_KLOAD(FA_KBASE(0)); FA_VLOAD(FA_KBASE(0));
    FA_KWRITE(0); FA_VWRITE(0);
    { const int k1 = FA_KBASE(1); FA_KLOAD(k1 < kb_last ? k1 : kb_last); }
    FA_BAR();
    if (grp == 1) FA_BAR();
#define FA_STEP(BF, t) do {                                                                                                      \
        if (!(VAR & 8)) { const int k1 = FA_KBASE((t) + 1); FA_VLOAD(k1 < kb_last ? k1 : kb_last); }                             \
        SBAR(); if (!(VAR & 1)) qkt<BF, ROPE, MODE == 3>(p0, p1, lds, r32, hi, qr, qpark); else { p0 = f32x16{}; p1 = f32x16{}; p0[0] = (float)(t); }   \
        if (!(VAR & 2)) { FA_MASK(t); partialSM(p0, p1, m_reg, mn, al, scale, C2, FA_KILL(t)); FA_RESC(al); } else { al = 1.f; }   \
        if (!(VAR & 8)) FA_KWRITE((BF) ^ 1);                                                                                     \
        if (!(VAR & 16)) FA_BAR();                                                                                               \
        if (!(VAR & 8)) { const int k2 = FA_KBASE((t) + 2); FA_KLOAD(k2 < kb_last ? k2 : kb_last); }                             \
        if (!(VAR & 2)) finishSM(p0, p1, al, l_reg, pa0, pa1, pa2, pa3); else { l_reg += p0[0]; pa0 = pack8(f32x4{p0[0], p0[1], p0[2], p0[3]}, f32x4{p1[0], p1[1], p1[2], p1[3]}); pa1 = pa0; pa2 = pa0; pa3 = pa0; } \
        SBAR();                                                                                                                  \
        if (!(VAR & 4)) pv_tile<BF, (MODE == 1 || MODE == 2)>(o, vb0, pa0, pa1, pa2, pa3); else { o[0][0] += __builtin_bit_cast(float, (int)pa0[0]); }      \
        if (!(VAR & 8)) FA_VWRITE((BF) ^ 1);                                                                                     \
        if (!(VAR & 16)) FA_BAR(); } while (0)
    int t = 0;
    for (; t + 1 < NT; t += 2) {
        FA_STEP(0, t);
        FA_STEP(1, t + 1);
    }
    if (NT & 1) {
        SBAR(); if (!(VAR & 1)) qkt<0, ROPE, MODE == 3>(p0, p1, lds, r32, hi, qr, qpark); else { p0 = f32x16{}; p1 = f32x16{}; }
        if (!(VAR & 2)) { FA_MASK(t); partialSM(p0, p1, m_reg, mn, al, scale, C2, FA_KILL(t)); FA_RESC(al); } else { al = 1.f; }
        if (!(VAR & 16)) FA_BAR();
        if (!(VAR & 2)) finishSM(p0, p1, al, l_reg, pa0, pa1, pa2, pa3); else { pa0 = pack8(f32x4{p0[0], p0[1], p0[2], p0[3]}, f32x4{p1[0], p1[1], p1[2], p1[3]}); pa1 = pa0; pa2 = pa0; pa3 = pa0; }
        SBAR();
        if (!(VAR & 4)) pv_tile<0, (MODE == 1 || MODE == 2)>(o, vb0, pa0, pa1, pa2, pa3);
        if (!(VAR & 16)) FA_BAR();
    }
#undef FA_STEP
    if (grp == 0) FA_BAR();
#undef FA_MASK
#undef FA_KILL
#undef FA_RESC
#undef FA_BAR
#undef FA_VWRITE
#undef FA_KWRITE
#undef FA_VLOAD
#undef FA_KLOAD
#undef FA_KBASE
}
template <int MODE>
__device__ __forceinline__ void flash_core2(char* lds, const FUnit& u, const bf16x8* qr, float scale, f32x16 (&o)[4], float& m_reg, float& l_reg) {
    const int tid = threadIdx.x, wid = __builtin_amdgcn_readfirstlane(tid >> 6), lane = tid & 63, r32 = lane & 31, hi = lane >> 5;
    const float C2 = 1.4426950408889634f * scale;
    char* V_lds = lds + OFF_V; char* K_lds = lds + OFF_K;
    float* ws = (float*)(lds + OFF_WS) + wid * 64; float* al_l = ws + 32;
    const int sr = tid >> 4, sc = (tid & 15) * 8, vst0 = v_st(sr, sc), vst1 = v_st(32 + sr, sc), kws = KSWZ(sr, sc * 2);
    const int vb0 = (int)(uintptr_t)lds + v_rd_base(lane);
    m_reg = -1e30f; l_reg = 0.f;
#pragma unroll
    for (int d = 0; d < 4; ++d) o[d] = f32x16{};
    const int NT = u.j_hi - u.j_lo;
    if (NT <= 0) return;
    bf16x8 st_k0, st_k1, st_v0, st_v1;
    f32x16 pA0, pA1, pB0, pB1; float mnA, mnB, alA, alB; bf16x8 pa0, pa1, pa2, pa3;
    const unsigned W = (MODE == 1) ? 512u : 0x7fffffffu;
#define F2_KBASE(t) ((u.j_lo + (t)) * KVBLK)
#define F2_LOAD(k0) do { st_v0 = *(const bf16x8*)(u.Vb + (long)((k0) + sr) * u.ldv + sc); st_v1 = *(const bf16x8*)(u.Vb + (long)((k0) + 32 + sr) * u.ldv + sc);   \
                         st_k0 = *(const bf16x8*)(u.Kb + (long)((k0) + sr) * u.ldk + sc); st_k1 = *(const bf16x8*)(u.Kb + (long)((k0) + 32 + sr) * u.ldk + sc); } while (0)
#define F2_WRITE(bf) do { *(bf16x8*)(V_lds + (bf) * SHM_V + vst0) = st_v0; *(bf16x8*)(V_lds + (bf) * SHM_V + vst1) = st_v1;   \
                          *(bf16x8*)(K_lds + (bf) * SHM_K + kws) = st_k0; *(bf16x8*)(K_lds + (bf) * SHM_K + kws + 32 * 256) = st_k1; } while (0)
#define F2_VMW() asm volatile("s_waitcnt vmcnt(0)" ::: "memory")
#define F2_RESC(a) do { if (__any((a) < 1.f)) { if (hi == 0) al_l[r32] = (a); asm volatile("s_waitcnt lgkmcnt(0)" ::: "memory");              \
                     _Pragma("unroll") for (int d_ = 0; d_ < 4; ++d_) { _Pragma("unroll") for (int r = 0; r < 16; ++r) o[d_][r] *= al_l[crow(r, hi)]; } asm volatile("" ::: "memory"); } } while (0)
#define F2_MASK(P0_, P1_, t) do { const int kb_ = F2_KBASE(t);                                                                    \
        if (MODE == 1) { if (kb_ + KVBLK - 1 > u.qlo || kb_ <= u.qhi - 512) mask_tile(P0_, P1_, u.qpos - kb_ - 4 * hi, W); }      \
        else { if (kb_ + KVBLK - 1 > u.qlo) mask_tile(P0_, P1_, u.qpos - kb_ - 4 * hi, W); } } while (0)
#define F2_KILL(t) ((MODE == 2) && (((u.sel >> (u.j_lo + (t))) & 1ull) == 0ull))
#define F2_HALF(PX0, PX1, mnX, alX, PY0, PY1, alY, t, KB, VB, SB) do {                                                            \
        SBAR(); qkt<KB, false, true>(PX0, PX1, lds, r32, hi, qr);                                                                 \
        finishSM(PY0, PY1, alY, l_reg, pa0, pa1, pa2, pa3); SBAR();                                                               \
        if ((t) + 1 < NT) { F2_LOAD(F2_KBASE((t) + 1)); SBAR(); }                                                                 \
        pv_tile<VB, false>(o, vb0, pa0, pa1, pa2, pa3); F2_MASK(PX0, PX1, (t)); partialSM(PX0, PX1, m_reg, mnX, alX, scale, C2, F2_KILL(t)); \
        __syncthreads();                                                                                                          \
        if ((t) + 1 < NT) { F2_VMW(); F2_WRITE(SB); }                                                                             \
        F2_RESC(alX); __syncthreads(); } while (0)
    F2_LOAD(F2_KBASE(0)); F2_VMW(); F2_WRITE(0); __syncthreads();
    if (NT > 1) F2_LOAD(F2_KBASE(1));
    SBAR(); qkt<0, false, true>(pA0, pA1, lds, r32, hi, qr);
    F2_MASK(pA0, pA1, 0); partialSM(pA0, pA1, m_reg, mnA, alA, scale, C2, F2_KILL(0));
    if (NT > 1) { F2_VMW(); F2_WRITE(1); }
    __syncthreads();
    for (int t = 1; t + 1 < NT; t += 2) {
        F2_HALF(pB0, pB1, mnB, alB, pA0, pA1, alA, t, 1, 0, 0);
        F2_HALF(pA0, pA1, mnA, alA, pB0, pB1, alB, t + 1, 0, 1, 1);
    }
    const bool even = (NT & 1) == 0;
    if (even) { SBAR(); qkt<1, false, true>(pB0, pB1, lds, r32, hi, qr); SBAR(); }
    finishSM(pA0, pA1, alA, l_reg, pa0, pa1, pa2, pa3); SBAR();
    pv_tile<0, false>(o, vb0, pa0, pa1, pa2, pa3);
    if (even) { F2_MASK(pB0, pB1, NT - 1); partialSM(pB0, pB1, m_reg, mnB, alB, scale, C2, F2_KILL(NT - 1)); F2_RESC(alB);
        finishSM(pB0, pB1, alB, l_reg, pa0, pa1, pa2, pa3); SBAR(); pv_tile<1, false>(o, vb0, pa0, pa1, pa2, pa3); }
#undef F2_HALF
#undef F2_KILL
#undef F2_MASK
#undef F2_RESC
#undef F2_VMW
#undef F2_WRITE
#undef F2_LOAD
#undef F2_KBASE
}
__device__ __forceinline__ void row_factors(char* lds, int wid, int r32, int hi, float f, float (&rf)[16]) {
    float* li_l = (float*)(lds + OFF_WS) + wid * 64;
    asm volatile("" ::: "memory");
    if (hi == 0) li_l[r32] = f;
    asm volatile("s_waitcnt lgkmcnt(0)" ::: "memory");
#pragma unroll
    for (int r = 0; r < 16; ++r) rf[r] = li_l[crow(r, hi)];
    asm volatile("s_waitcnt lgkmcnt(0)" ::: "memory");
}
}

constexpr size_t MiB = 1ull << 20, KiB = 1ull << 10;
constexpr size_t WS_CTL = 0;
constexpr size_t WS_ROPE = 64 * KiB;
constexpr size_t WS_MG = WS_ROPE + 1 * MiB;
constexpr size_t WS_FLOOR = WS_MG + 512 * KiB;
constexpr size_t WS_DEN = WS_FLOOR + 256 * KiB;
constexpr size_t WS_GATES = WS_DEN + 256 * KiB;
constexpr size_t WS_SEL = WS_GATES + 512 * KiB;
constexpr size_t WS_KROPE = WS_SEL + 512 * KiB;
constexpr size_t WS_CQN = WS_KROPE + 2 * MiB;
constexpr size_t WS_CKVN = WS_CQN + 32 * MiB;
constexpr size_t WS_KVB = WS_CKVN + 16 * MiB;
constexpr size_t WS_XB = WS_KVB + 128 * MiB;
constexpr size_t WS_Z = WS_XB + 128 * MiB;
constexpr size_t WS_R = WS_Z + 256 * MiB;
constexpr size_t WS_W = WS_R + 344 * MiB;
constexpr size_t W_AB = WS_W, W_UQ = W_AB + 62 * MiB, W_UKV = W_UQ + 6 * MiB, W_O0 = W_UKV + 4 * MiB, W_GU0 = W_O0 + 32 * MiB, W_D0 = W_GU0 + 172 * MiB;
constexpr size_t W_C = W_D0 + 86 * MiB, W_C1K = W_C + 58 * MiB, W_C1V = W_C1K + 2 * MiB, W_C2K = W_C1V + 2 * MiB, W_C2V = W_C2K + 128 * KiB, W_O1 = W_C2V + 128 * KiB;
constexpr size_t W_GU1 = W_O1 + 32 * MiB, W_D1 = W_GU1 + 172 * MiB, WS_AT = W_D1 + 86 * MiB;
constexpr size_t WS_AA = WS_AT + 256 * KiB;
constexpr size_t WS_DENI = WS_AA + 256 * KiB;
constexpr size_t WS_DENP = WS_DENI + 256 * KiB;
constexpr size_t WS_STATS = WS_DENP + 4 * MiB;
constexpr size_t WS_END = WS_STATS + 128 * KiB;
constexpr size_t WS_AK = WS_KVB, WS_AV = WS_AK + 32 * MiB, WS_HK = WS_AV + 32 * MiB, WS_HV = WS_HK + 2 * MiB, WS_KCMP = WS_HV + 2 * MiB, WS_VCMP = WS_KCMP + 2 * MiB;
constexpr size_t WS_QB = WS_R + (size_t)M_TOK * AB_NP * 2;

constexpr int NTHREADS = 512;
constexpr int LDS_BYTES = 152 * 1024, LDS_CTL_OFF = LDS_BYTES - 256;
constexpr int N_TJOBS = 14;
struct TJob { const float* s; const float* s2; bf16_t* d; int K, N, Np, mode; };
struct Args { const float* in[26]; float* out; unsigned char* ws; TJob tj[N_TJOBS]; int ph_lo, ph_hi; };

__device__ __forceinline__ void transpose_tile(char* lds, const TJob& jb, int t) {
    float* T = (float*)lds;
    const int tid = threadIdx.x;
    const int tn = jb.Np >> 6;
    const int in_ = t % tn, ik = t / tn, n0 = in_ * 64, k0 = ik * 64;
    const float* sp = jb.s; int c0 = n0; const int ncols = jb.N;
    if (jb.mode == 1) { const int tile = n0 >> 8, j = n0 & 255; sp = (j < 128) ? jb.s : jb.s2; c0 = tile * 128 + (j & 127); }
    const int kk = tid >> 4, nc = (tid & 15) * 4;
    f32x4 v0 = {0.f, 0.f, 0.f, 0.f}, v1 = v0;
    if (c0 + nc < ncols) { v0 = *(const f32x4*)(sp + (size_t)(k0 + kk) * ncols + c0 + nc); v1 = *(const f32x4*)(sp + (size_t)(k0 + kk + 32) * ncols + c0 + nc); }
#pragma unroll
    for (int j = 0; j < 4; ++j) { T[(nc + j) * 65 + kk] = v0[j]; T[(nc + j) * 65 + kk + 32] = v1[j]; }
    __syncthreads();
    const int n = tid >> 3, kc = (tid & 7) * 8;
    float f[8];
#pragma unroll
    for (int j = 0; j < 8; ++j) f[j] = T[n * 65 + kc + j];
    *(bf16x8*)(jb.d + (size_t)(n0 + n) * jb.K + k0 + kc) = pack8f(f);
    __syncthreads();
}
constexpr int N_TJOBS_PRO = 11;
__device__ __forceinline__ void transpose_jobs(char* lds, const Args& a) {
    for (int ji = 0; ji < N_TJOBS_PRO; ++ji) {
        const TJob jb = a.tj[ji];
        const int nt = (jb.K >> 6) * (jb.Np >> 6);
        for (int t = blockIdx.x; t < nt; t += gridDim.x) transpose_tile(lds, jb, t);
    }
}
constexpr int LATE_T0 = 64 * 64, LATE_T1 = 64 * 344, LATE_T2 = 172 * 64, LATE_TOTAL = LATE_T0 + LATE_T1 + LATE_T2, LATE_SLOTS = 64 + 128 + 192 + 224, LATE_PER = (LATE_TOTAL + LATE_SLOTS - 1) / LATE_SLOTS;
struct TTile { const float* sp; bf16_t* d; int K, ncols, c0, n0, k0; };
__device__ __forceinline__ TTile late_tile(const Args& a, int g) {
    const int ji = g < LATE_T0 ? 11 : (g < LATE_T0 + LATE_T1 ? 12 : 13); const int t = g - (ji == 11 ? 0 : (ji == 12 ? LATE_T0 : LATE_T0 + LATE_T1));
    const TJob jb = a.tj[ji]; const int tn = jb.Np >> 6; TTile r; r.n0 = (t % tn) * 64; r.k0 = (t / tn) * 64; r.sp = jb.s; r.c0 = r.n0; r.ncols = jb.N; r.d = jb.d; r.K = jb.K;
    if (jb.mode == 1) { const int tile = r.n0 >> 8, j = r.n0 & 255; r.sp = (j < 128) ? jb.s : jb.s2; r.c0 = tile * 128 + (j & 127); }
    return r;
}
__device__ __forceinline__ void transpose_late(char* lds, const Args& a, int slot) {
    float* T = (float*)lds;
    const int tid = threadIdx.x, kk = tid >> 4, nc = (tid & 15) * 4, n = tid >> 3, kc = (tid & 7) * 8;
    const int g0 = slot * LATE_PER, g1 = (slot + 1) * LATE_PER < LATE_TOTAL ? (slot + 1) * LATE_PER : LATE_TOTAL;
    if (g0 >= g1) return;
    __syncthreads();
    TTile cur = late_tile(a, g0);
    f32x4 v0 = {0.f, 0.f, 0.f, 0.f}, v1 = v0;
    if (cur.c0 + nc < cur.ncols) { v0 = *(const f32x4*)(cur.sp + (size_t)(cur.k0 + kk) * cur.ncols + cur.c0 + nc); v1 = *(const f32x4*)(cur.sp + (size_t)(cur.k0 + kk + 32) * cur.ncols + cur.c0 + nc); }
    for (int g = g0; g < g1; ++g) {
        const TTile nxt = late_tile(a, g + 1 < g1 ? g + 1 : g);
        f32x4 w0 = {0.f, 0.f, 0.f, 0.f}, w1 = w0;
        if (nxt.c0 + nc < nxt.ncols) { w0 = *(const f32x4*)(nxt.sp + (size_t)(nxt.k0 + kk) * nxt.ncols + nxt.c0 + nc); w1 = *(const f32x4*)(nxt.sp + (size_t)(nxt.k0 + kk + 32) * nxt.ncols + nxt.c0 + nc); }
#pragma unroll
        for (int j = 0; j < 4; ++j) { T[(nc + j) * 65 + kk] = v0[j]; T[(nc + j) * 65 + kk + 32] = v1[j]; }
        __syncthreads();
        float f[8];
#pragma unroll
        for (int j = 0; j < 8; ++j) f[j] = T[n * 65 + kc + j];
        *(bf16x8*)(cur.d + (size_t)(cur.n0 + n) * cur.K + cur.k0 + kc) = pack8f(f);
        __syncthreads();
        cur = nxt; v0 = w0; v1 = w1;
    }
}
__device__ __forceinline__ void p0_prologue(char* lds, const Args& a) {
    const int tid = threadIdx.x;
    const size_t gt = (size_t)blockIdx.x * NTHREADS + tid, gs = (size_t)gridDim.x * NTHREADS;
    { const float* x = a.in[0]; bf16_t* xb = (bf16_t*)(a.ws + WS_XB);
      for (size_t i = gt; i < (size_t)M_TOK * DM / 8; i += gs) { const f32x4 v0 = *(const f32x4*)(x + i * 8), v1 = *(const f32x4*)(x + i * 8 + 4);
          float f[8] = {v0[0], v0[1], v0[2], v0[3], v1[0], v1[1], v1[2], v1[3]}; *(bf16x8*)(xb + i * 8) = pack8f(f); } }
    { f32x2* rp = (f32x2*)(a.ws + WS_ROPE);
      for (size_t i = gt; i < (size_t)SEQ * 32; i += gs) { const int pos = (int)(i >> 5), j = (int)(i & 31);
          const double inv = exp(-(double)j / 32.0 * 9.210340371976184  ); const double ang = (double)pos * inv; rp[i] = (f32x2){(float)cos(ang), (float)sin(ang)}; } }
    transpose_jobs(lds, a);
}

__device__ __forceinline__ float softcap15(float z) { return 15.0f * tanhf(z * (1.0f / 15.0f)); }
__device__ __forceinline__ float logsigmoid_f(float z) { return fminf(z, 0.f) - log1pf(__expf(-fabsf(z))); }
__device__ __forceinline__ void p2_prep(const Args& a) {
    const int tid = threadIdx.x, lane = tid & 63, wid = tid >> 6;
    const int gw = blockIdx.x * 8 + wid, nw = gridDim.x * 8;
    const bf16_t* proj = (const bf16_t*)(a.ws + WS_R);
    if (gw < 16) {
        const int bh = gw, b = bh >> 2, h = bh & 3;
        const float* gates = (const float*)(a.ws + WS_GATES);
        f32x2* mg = (f32x2*)(a.ws + WS_MG) + (size_t)bh * SEQ; float* fl = (float*)(a.ws + WS_FLOOR) + (size_t)bh * SEQ;
        const float bi = a.in[2][h], bfg = a.in[3][h];
        float Fc = 0.f, Ac = 0.f, mprev = 0.f;
        for (int c = 0; c < SEQ / 64; ++c) {
            const int t = c * 64 + lane; const float* g = gates + (size_t)(b * SEQ + t) * 8;
            const float li = softcap15(g[h] + bi), lf = logsigmoid_f(softcap15(g[4 + h] + bfg));
            float F = lf;
#pragma unroll
            for (int o = 1; o < 64; o <<= 1) { const float y = __shfl_up(F, o); if (lane >= o) F += y; }
            F += Fc;
            float A = li - F;
#pragma unroll
            for (int o = 1; o < 64; o <<= 1) { const float y = __shfl_up(A, o); if (lane >= o) A = fmaxf(A, y); }
            A = fmaxf(A, Ac);
            const float m = F + A;
            float mp = __shfl_up(m, 1); if (lane == 0) mp = mprev;
            mg[t] = (f32x2){__expf(lf + mp - m), __expf(li - m)}; fl[t] = __expf(-m);
            ((float*)(a.ws + WS_AT))[(size_t)bh * SEQ + t] = li - F; ((float*)(a.ws + WS_AA))[(size_t)bh * SEQ + t] = A;
            Fc = __shfl(F, 63); Ac = __shfl(A, 63); mprev = __shfl(m, 63);
        }
    }
    const float* qn = a.in[5]; const float* kvn = a.in[6];
    bf16_t* cqn = (bf16_t*)(a.ws + WS_CQN); bf16_t* ckvn = (bf16_t*)(a.ws + WS_CKVN); bf16_t* krope = (bf16_t*)(a.ws + WS_KROPE);
    const f32x2* rp = (const f32x2*)(a.ws + WS_ROPE);
    for (int tk = gw; tk < M_TOK; tk += nw) {
        const bf16_t* row = proj + (size_t)tk * AB_NP;
        float x0[8], x1[8], y[8];
        unpack8(*(const bf16x8*)(row + AB_CQ + lane * 8), x0); unpack8(*(const bf16x8*)(row + AB_CQ + 512 + lane * 8), x1); unpack8(*(const bf16x8*)(row + AB_CKV + lane * 8), y);
        const float kr = bf2f(row[AB_KR + lane]);
        float s = 0.f, s2 = 0.f;
#pragma unroll
        for (int j = 0; j < 8; ++j) { s += x0[j] * x0[j] + x1[j] * x1[j]; s2 += y[j] * y[j]; }
        s = wave_sum(s); s2 = wave_sum(s2);
        const float r1 = rsqrtf(s * (1.0f / 1024.0f) + RMS_EPS), r2 = rsqrtf(s2 * (1.0f / 512.0f) + RMS_EPS);
#pragma unroll
        for (int j = 0; j < 8; ++j) { x0[j] *= r1 * qn[lane * 8 + j]; x1[j] *= r1 * qn[512 + lane * 8 + j]; y[j] *= r2 * kvn[lane * 8 + j]; }
        *(bf16x8*)(cqn + (size_t)tk * 1024 + lane * 8) = pack8f(x0); *(bf16x8*)(cqn + (size_t)tk * 1024 + 512 + lane * 8) = pack8f(x1);
        *(bf16x8*)(ckvn + (size_t)tk * 512 + lane * 8) = pack8f(y);
        const float pr = __shfl_xor(kr, 32); const f32x2 cs = rp[(size_t)(tk & (SEQ - 1)) * 32 + (lane & 31)];
        const float out = lane < 32 ? kr * cs.x - pr * cs.y : pr * cs.y + kr * cs.x;
        krope[(size_t)tk * 64 + lane] = f2bf(out);
    }
}

__device__ __forceinline__ float dpp_xor1(float v) { return __int_as_float(__builtin_amdgcn_update_dpp(0, __float_as_int(v), 0xB1, 0xF, 0xF, true)); }
__device__ __forceinline__ float dpp_xor2(float v) { return __int_as_float(__builtin_amdgcn_update_dpp(0, __float_as_int(v), 0x4E, 0xF, 0xF, true)); }
__device__ __forceinline__ float dpp_hmir(float v) { return __int_as_float(__builtin_amdgcn_update_dpp(0, __float_as_int(v), 0x141, 0xF, 0xF, true)); }
__device__ __forceinline__ float dpp_mir(float v)  { return __int_as_float(__builtin_amdgcn_update_dpp(0, __float_as_int(v), 0x140, 0xF, 0xF, true)); }
__device__ __forceinline__ float row16_sum(float v) { v += dpp_xor1(v); v += dpp_xor2(v); v += dpp_hmir(v); v += dpp_mir(v); return v; }
__device__ __forceinline__ float swap32_sum(float a, float b) {
    auto rr = __builtin_amdgcn_permlane32_swap(__float_as_uint(a), __float_as_uint(b), false, false); return __uint_as_float(rr[0]) + __uint_as_float(rr[1]); }
constexpr int ML_CH = 32;
constexpr int ML_Q = 0, ML_K = ML_CH * 256 * 4, ML_V = 2 * ML_CH * 256 * 4, ML_FI = ML_V + ML_CH * 32 * 4, ML_BUF = ML_FI + ML_CH * 8;
constexpr int ML_OUT = 2 * ML_BUF, ML_DEN = ML_OUT + ML_CH * 32 * 4, ML_END = ML_DEN + ML_CH * 4;
static_assert(ML_END <= LDS_CTL_OFF, "mLSTM LDS");
__device__ __forceinline__ void p4_mlstm(char* lds, const Args& a) {
    const int tid = threadIdx.x, lane = tid & 63, wid = __builtin_amdgcn_readfirstlane(tid >> 6);
    const bf16_t* proj = (const bf16_t*)(a.ws + WS_R); bf16_t* hcat = (bf16_t*)a.out;
    for (int unit = blockIdx.x; unit < 256; unit += gridDim.x) {
        const int bh = unit >> 4, sl = unit & 15, b = bh >> 2, h = bh & 3;
        const f32x2* mg = (const f32x2*)(a.ws + WS_MG) + (size_t)bh * SEQ;
        float* den = (float*)(a.ws + WS_DEN) + (size_t)bh * SEQ;
        const bool denw = (wid == 0) && (sl == 0);
        const int st = tid >> 4, sp = (tid & 15) * 16, vt = tid >> 2, vp = (tid & 3) * 8;
        const bf16_t* qsrc = proj + (size_t)(b * SEQ + st) * AB_NP + AB_Q + h * 256 + sp;
        const bf16_t* ksrc = proj + (size_t)(b * SEQ + st) * AB_NP + AB_K + h * 256 + sp;
        const bf16_t* vsrc = proj + (size_t)(b * SEQ + vt) * AB_NP + AB_V + h * 512 + sl * 32 + vp;
        bf16x8 rq0, rq1, rk0, rk1, rv; f32x2 rfi;
#define ML_LOAD(c) do { const size_t o_ = (size_t)(c) * ML_CH * AB_NP; rq0 = *(const bf16x8*)(qsrc + o_); rq1 = *(const bf16x8*)(qsrc + o_ + 8); rk0 = *(const bf16x8*)(ksrc + o_); rk1 = *(const bf16x8*)(ksrc + o_ + 8); \
        if (tid < 128) rv = *(const bf16x8*)(vsrc + o_); if (tid < ML_CH) rfi = mg[(c) * ML_CH + tid]; } while (0)
#define ML_STORE(bufp) do { float f_[8]; float* Q_ = (float*)((bufp) + ML_Q) + st * 256 + sp; float* K_ = (float*)((bufp) + ML_K) + st * 256 + sp; \
        unpack8(rq0, f_); *(f32x4*)(Q_) = (f32x4){f_[0], f_[1], f_[2], f_[3]}; *(f32x4*)(Q_ + 4) = (f32x4){f_[4], f_[5], f_[6], f_[7]}; \
        unpack8(rq1, f_); *(f32x4*)(Q_ + 8) = (f32x4){f_[0], f_[1], f_[2], f_[3]}; *(f32x4*)(Q_ + 12) = (f32x4){f_[4], f_[5], f_[6], f_[7]}; \
        unpack8(rk0, f_); *(f32x4*)(K_) = (f32x4){f_[0], f_[1], f_[2], f_[3]} * 0.0625f; *(f32x4*)(K_ + 4) = (f32x4){f_[4], f_[5], f_[6], f_[7]} * 0.0625f; \
        unpack8(rk1, f_); *(f32x4*)(K_ + 8) = (f32x4){f_[0], f_[1], f_[2], f_[3]} * 0.0625f; *(f32x4*)(K_ + 12) = (f32x4){f_[4], f_[5], f_[6], f_[7]} * 0.0625f; \
        if (tid < 128) { float* V_ = (float*)((bufp) + ML_V) + vt * 32 + vp; unpack8(rv, f_); *(f32x4*)(V_) = (f32x4){f_[0], f_[1], f_[2], f_[3]}; *(f32x4*)(V_ + 4) = (f32x4){f_[4], f_[5], f_[6], f_[7]}; } \
        if (tid < ML_CH) ((f32x2*)((bufp) + ML_FI))[tid] = rfi; } while (0)
        f32x4 C0 = {0.f, 0.f, 0.f, 0.f}, C1 = C0, C2 = C0, C3 = C0, n4 = C0;
        __syncthreads();
        ML_LOAD(0); ML_STORE(lds); __syncthreads();
        float* OUT = (float*)(lds + ML_OUT); float* DENs = (float*)(lds + ML_DEN);
        for (int c = 0; c < SEQ / ML_CH; ++c) {
            char* buf = lds + (c & 1) * ML_BUF;
            if (c + 1 < SEQ / ML_CH) ML_LOAD(c + 1);
            const float* Qs = (const float*)(buf + ML_Q) + lane * 4; const float* Ks = (const float*)(buf + ML_K) + lane * 4;
            const float* Vs = (const float*)(buf + ML_V) + wid * 4; const f32x2* FIs = (const f32x2*)(buf + ML_FI);
#pragma unroll 4
            for (int s = 0; s < ML_CH; ++s) {
                const f32x4 q4 = *(const f32x4*)(Qs + s * 256), k4 = *(const f32x4*)(Ks + s * 256), v4 = *(const f32x4*)(Vs + s * 32); const f32x2 fi = FIs[s];
                const f32x4 iv = v4 * fi.y;
                C0 = C0 * fi.x + iv * k4[0]; C1 = C1 * fi.x + iv * k4[1]; C2 = C2 * fi.x + iv * k4[2]; C3 = C3 * fi.x + iv * k4[3];
                f32x4 d = C0 * q4[0] + C1 * q4[1] + C2 * q4[2] + C3 * q4[3];
                float e0 = swap32_sum(d[0], d[2]), e1 = swap32_sum(d[1], d[3]);
                const float other = __shfl_xor((lane & 16) ? e0 : e1, 16);
                float r = ((lane & 16) ? e1 : e0) + other;
                r = row16_sum(r);
                if ((lane & 15) == 0) OUT[s * 32 + wid * 4 + (lane >> 5) * 2 + ((lane >> 4) & 1)] = r;
                if (denw) { n4 = n4 * fi.x + k4 * fi.y; float dn = n4[0] * q4[0] + n4[1] * q4[1] + n4[2] * q4[2] + n4[3] * q4[3];
                    dn = swap32_sum(dn, dn); dn += __shfl_xor(dn, 16); dn = row16_sum(dn); if (lane == 0) DENs[s] = dn; }
            }
            __syncthreads();
            if (tid < 128) { const float* o_ = OUT + vt * 32 + vp; float f[8];
#pragma unroll
                for (int j = 0; j < 8; ++j) f[j] = o_[j];
                *(bf16x8*)(hcat + (size_t)(b * SEQ + c * ML_CH + vt) * DM + h * 512 + sl * 32 + vp) = pack8f(f); }
            if (sl == 0 && tid < ML_CH) den[c * ML_CH + tid] = DENs[tid];
            if (c + 1 < SEQ / ML_CH) ML_STORE(lds + ((c + 1) & 1) * ML_BUF);
            __syncthreads();
        }
#undef ML_LOAD
#undef ML_STORE
    }
}

#define TRRD(dst, base, off) asm volatile("ds_read_b64_tr_b16 %0, %1 offset:%2" : "=&v"(dst) : "v"(base), "i"(off) : "memory")
#define TRRD(dst, base, off) asm volatile("ds_read_b64_tr_b16 %0, %1 offset:%2" : "=&v"(dst) : "v"(base), "i"(off) : "memory")
namespace mc {
constexpr int L_K = 0, L_Q = 32768, L_V = 65536, L_EV = 81920, L_CT = 98304, L_TAB = 114688, L_G = 116736;
constexpr int T_A = 0, T_AA = 64, T_INT = 128, T_E = 192;
__device__ __forceinline__ int kaddr(int s, int d) { return (d >> 7) * 16384 + s * 256 + (((d & 127) * 2) ^ ((s & 7) << 4)); }
}
#define MC_QF(d0) (*(const bf16x8*)(lds + L_Q + ((d0) >> 3) * 16384 + TB * 8192 + kq[(d0) & 3] + (((d0) >> 2) & 1) * 128))
template <int TB>
__device__ __forceinline__ void mc_inter(char* lds, float* TAB, const int (&kq)[4], int cfrag, int csw, int lane, int hi) {
    using namespace mc;
    f32x16 o = f32x16{};
    bf16x8 fq[2][2], fc[2][2];
#define MJ_LD(g) do { _Pragma("unroll") for (int e = 0; e < 2; ++e) { const int d0 = 2 * (g) + e; fq[(g) & 1][e] = MC_QF(d0); fc[(g) & 1][e] = *(const bf16x8*)(lds + L_CT + cfrag + (((d0 * 16 + hi * 8) * 2) ^ csw)); } } while (0)
#define MJ_MM(g) do { _Pragma("unroll") for (int e = 0; e < 2; ++e) o = __builtin_amdgcn_mfma_f32_32x32x16_bf16(fq[(g) & 1][e], fc[(g) & 1][e], o, 0, 0, 0); } while (0)
    MJ_LD(0); SBAR();
#pragma unroll
    for (int g = 0; g < 8; ++g) { if (g + 1 < 8) { MJ_LD(g + 1); } SBAR(); MJ_MM(g); SBAR(); }
#undef MJ_LD
#undef MJ_MM
    const float* ti = TAB + T_INT + TB * 32 + 4 * hi; float* G = (float*)(lds + L_G) + TB * 1024 + lane;
#pragma unroll
    for (int r = 0; r < 16; ++r) G[r * 64] = o[r] * ti[(r & 3) + 8 * (r >> 2)];
}
template <int TB>
__device__ __forceinline__ void mc_intra(char* lds, float* TAB, const int (&kq)[4], int vbV, int r32, int hi, f32x16& o, float& ps) {
    using namespace mc;
    const float LOG2E = 1.4426950408889634f;
    const int tl = TB * 32 + r32;
    f32x16 p0 = f32x16{}, p1 = f32x16{};
    bf16x8 fq[2][2], fa0[2][2], fa1[2][2];
#define MI_LD(g) do { _Pragma("unroll") for (int e = 0; e < 2; ++e) { const int d0 = 2 * (g) + e; const char* ap = lds + L_K + (d0 >> 3) * 16384 + kq[d0 & 3] + ((d0 >> 2) & 1) * 128; \
        fq[(g) & 1][e] = MC_QF(d0); fa0[(g) & 1][e] = *(const bf16x8*)ap; if constexpr (TB == 1) fa1[(g) & 1][e] = *(const bf16x8*)(ap + 8192); } } while (0)
#define MI_MM(g) do { _Pragma("unroll") for (int e = 0; e < 2; ++e) { p0 = __builtin_amdgcn_mfma_f32_32x32x16_bf16(fa0[(g) & 1][e], fq[(g) & 1][e], p0, 0, 0, 0); \
        if constexpr (TB == 1) p1 = __builtin_amdgcn_mfma_f32_32x32x16_bf16(fa1[(g) & 1][e], fq[(g) & 1][e], p1, 0, 0, 0); } } while (0)
    MI_LD(0); SBAR();
#pragma unroll
    for (int g = 0; g < 8; ++g) { if (g + 1 < 8) { MI_LD(g + 1); } SBAR(); MI_MM(g); SBAR(); }
#undef MI_LD
#undef MI_MM
    const float At = TAB[T_AA + tl];
    ps = 0.f;
    const float* ta = TAB + T_A + 4 * hi;
#pragma unroll
    for (int r = 0; r < 16; ++r) { const int s0 = fa::crow(r, hi), c0 = (r & 3) + 8 * (r >> 2);
        const float e0 = __builtin_amdgcn_exp2f((ta[c0] - At) * LOG2E) * 0.0625f; const float w0 = (s0 <= tl) ? e0 : 0.f; p0[r] *= w0; ps += p0[r];
        if constexpr (TB == 1) { const float e1 = __builtin_amdgcn_exp2f((ta[32 + c0] - At) * LOG2E) * 0.0625f; const float w1 = (s0 + 32 <= tl) ? e1 : 0.f; p1[r] *= w1; ps += p1[r]; } }
    { auto rr = __builtin_amdgcn_permlane32_swap(__float_as_uint(ps), __float_as_uint(ps), false, false); ps = __uint_as_float(rr[0]) + __uint_as_float(rr[1]); }
    bf16x8 pa0, pa1, pa2, pa3;
#define PK4(P, B_, OUT) do { unsigned a0 = fa::cvtpk(P[B_+0], P[B_+1]), a1 = fa::cvtpk(P[B_+2], P[B_+3]);                  \
        unsigned b0_ = fa::cvtpk(P[B_+4], P[B_+5]), b1_ = fa::cvtpk(P[B_+6], P[B_+7]);                                   \
        auto r0 = __builtin_amdgcn_permlane32_swap(a0, b0_, false, false); auto r1 = __builtin_amdgcn_permlane32_swap(a1, b1_, false, false); \
        u32x4 w = {r0[0], r1[0], r0[1], r1[1]}; OUT = *reinterpret_cast<bf16x8*>(&w); } while (0)
    PK4(p0, 0, pa0); PK4(p0, 8, pa1); PK4(p1, 0, pa2); PK4(p1, 8, pa3);
#undef PK4
    o = f32x16{};
    { s16x4 l0, l1, l2, l3, h0, h1, h2, h3;
      TRRD(l0, vbV, 0); TRRD(h0, vbV, 2048); TRRD(l1, vbV, 4096); TRRD(h1, vbV, 6144); TRRD(l2, vbV, 8192); TRRD(h2, vbV, 10240); TRRD(l3, vbV, 12288); TRRD(h3, vbV, 14336);
      asm volatile("s_waitcnt lgkmcnt(0)" ::: "memory"); SBAR();
      o = __builtin_amdgcn_mfma_f32_32x32x16_bf16(pa0, (bf16x8){l0[0], l0[1], l0[2], l0[3], h0[0], h0[1], h0[2], h0[3]}, o, 0, 0, 0);
      o = __builtin_amdgcn_mfma_f32_32x32x16_bf16(pa1, (bf16x8){l1[0], l1[1], l1[2], l1[3], h1[0], h1[1], h1[2], h1[3]}, o, 0, 0, 0);
      if constexpr (TB == 1) { o = __builtin_amdgcn_mfma_f32_32x32x16_bf16(pa2, (bf16x8){l2[0], l2[1], l2[2], l2[3], h2[0], h2[1], h2[2], h2[3]}, o, 0, 0, 0);
                               o = __builtin_amdgcn_mfma_f32_32x32x16_bf16(pa3, (bf16x8){l3[0], l3[1], l3[2], l3[3], h3[0], h3[1], h3[2], h3[3]}, o, 0, 0, 0); } }
}
#undef MC_QF
__device__ __forceinline__ void p4_mlstm_chunk(char* lds, const Args& a) {
    using namespace mc;
    const int tid = threadIdx.x, lane = tid & 63, wid = __builtin_amdgcn_readfirstlane(tid >> 6);
    const bf16_t* proj = (const bf16_t*)(a.ws + WS_R); bf16_t* hcat = (bf16_t*)a.out;
    float* TAB = (float*)(lds + L_TAB);
    const float LOG2E = 1.4426950408889634f;
    for (int unit = blockIdx.x; unit < 256; unit += gridDim.x) {
        const int bh = (gridDim.x == 256) ? 2 * (unit & 7) + (unit >> 7) : unit >> 4, sl = (gridDim.x == 256) ? (unit >> 3) & 15 : unit & 15, b = bh >> 2, h = bh & 3;
        const float* AT = (const float*)(a.ws + WS_AT) + (size_t)bh * SEQ; const float* AA = (const float*)(a.ws + WS_AA) + (size_t)bh * SEQ;
        float* deni = (float*)(a.ws + WS_DENI) + (size_t)bh * SEQ; float* denp = (float*)(a.ws + WS_DENP) + (size_t)(bh * 16 + sl) * SEQ;
        const int krow = tid >> 3, kch = (tid & 7) * 4, vrow = (tid >> 2) & 63, vch = tid & 3;
        const bf16_t* ksrc = proj + (size_t)(b * SEQ + krow) * AB_NP + AB_K + h * 256 + kch * 8;
        const bf16_t* qsrc = proj + (size_t)(b * SEQ + krow) * AB_NP + AB_Q + h * 256 + kch * 8;
        const bf16_t* vsrc = proj + (size_t)(b * SEQ + vrow) * AB_NP + AB_V + h * 512 + sl * 32 + vch * 8;
        int kdst[4];
#pragma unroll
        for (int i = 0; i < 4; ++i) { const int ch = kch + i; kdst[i] = (ch >> 4) * 16384 + KSWZ(krow, (ch & 15) * 16); }
        const int vdst = fa::v_st(vrow, vch * 8);
        bf16x8 rk[4], rq[4], rv; float pa_t = 0.f, pA_t = 0.f, pa_v = 0.f, pA_prev = 0.f, pA_end = 0.f;
#define MC_LOAD(c) do { const size_t o_ = (size_t)(c) * 64 * AB_NP; _Pragma("unroll") for (int i = 0; i < 4; ++i) { rk[i] = *(const bf16x8*)(ksrc + o_ + i * 8); rq[i] = *(const bf16x8*)(qsrc + o_ + i * 8); } \
        if (tid < 256) { rv = *(const bf16x8*)(vsrc + o_); pa_v = AT[(c) * 64 + vrow]; } if (tid < 64) { pa_t = AT[(c) * 64 + tid]; pA_t = AA[(c) * 64 + tid]; } \
        pA_end = AA[(c) * 64 + 63]; pA_prev = (c) > 0 ? AA[(c) * 64 - 1] : 0.f; } while (0)
        f32x16 Cacc = f32x16{};
        f32x16 oi = f32x16{}; float psi = 0.f;
        float nreg = 0.f;
        __syncthreads();
        for (int i = tid; i < 16384 / 16; i += NTHREADS) *(u32x4*)(lds + L_CT + i * 16) = (u32x4){0u, 0u, 0u, 0u};
        MC_LOAD(0);
        for (int c = 0; c < SEQ / 64; ++c) {
            const int t0 = c * 64;
            const float A_prev = pA_prev, A_end = pA_end;
            asm volatile("s_waitcnt vmcnt(0)" ::: "memory");
#pragma unroll
            for (int i = 0; i < 4; ++i) { *(bf16x8*)(lds + L_K + kdst[i]) = rk[i]; *(bf16x8*)(lds + L_Q + kdst[i]) = rq[i]; }
            if (tid < 256) { *(bf16x8*)(lds + L_V + vdst) = rv; const float e = __builtin_amdgcn_exp2f((pa_v - A_end) * LOG2E) * 0.0625f;
                float f[8]; unpack8(rv, f);
#pragma unroll
                for (int j = 0; j < 8; ++j) f[j] *= e;
                *(bf16x8*)(lds + L_EV + vdst) = pack8f(f); }
            if (tid < 64) { TAB[T_A + tid] = pa_t; TAB[T_AA + tid] = pA_t; TAB[T_INT + tid] = __builtin_amdgcn_exp2f((A_prev - pA_t) * LOG2E); TAB[T_E + tid] = __builtin_amdgcn_exp2f((pa_t - A_end) * LOG2E) * 0.0625f; }
            __syncthreads();
            if (c + 1 < SEQ / 64) MC_LOAD(c + 1);
            const float decay = __builtin_amdgcn_exp2f((A_prev - A_end) * LOG2E);
            int lane_o = lane; asm volatile("" : "+v"(lane_o));
            const int r32 = lane_o & 31, hi = lane_o >> 5;
            int kq[4];
#pragma unroll
            for (int dd = 0; dd < 4; ++dd) kq[dd] = KSWZ(r32, dd * 32 + hi * 16);
            const int cfrag = r32 * 512, csw = (r32 & 15) << 4;
            const int trq = (lane_o & 15) >> 2, trp = lane_o & 3, trg = (lane_o >> 4) & 1;
            const int vbV = (int)(uintptr_t)lds + L_V + fa::v_rd_base(lane_o), vbE = (int)(uintptr_t)lds + L_EV + fa::v_rd_base(lane_o);
            if (wid == 0) mc_intra<0>(lds, TAB, kq, vbV, r32, hi, oi, psi);
            else if (wid == 1) mc_intra<1>(lds, TAB, kq, vbV, r32, hi, oi, psi);
            else if (wid == 2) mc_inter<0>(lds, TAB, kq, cfrag, csw, lane_o, hi);
            else if (wid == 3) mc_inter<1>(lds, TAB, kq, cfrag, csw, lane_o, hi);
            if (wid == 7) {
                const int d0_ = 16 * sl;
                float qv[16]; { float f[8]; unpack8(*(const bf16x8*)(lds + L_Q + kaddr(lane, d0_)), f);
#pragma unroll
                    for (int j = 0; j < 8; ++j) qv[j] = f[j];
                    unpack8(*(const bf16x8*)(lds + L_Q + kaddr(lane, d0_ + 8)), f);
#pragma unroll
                    for (int j = 0; j < 8; ++j) qv[8 + j] = f[j]; }
                float dsum = 0.f;
#pragma unroll
                for (int d = 0; d < 16; ++d) dsum += qv[d] * __int_as_float(__builtin_amdgcn_readlane(__float_as_int(nreg), d));
                denp[t0 + lane] = dsum * TAB[T_INT + lane];
                const int dd = lane & 15, sq = lane >> 4; float part = 0.f;
#pragma unroll
                for (int j = 0; j < 16; ++j) { const int s = sq * 16 + j; part += TAB[T_E + s] * bf2f(*(const bf16_t*)(lds + L_K + kaddr(s, d0_ + dd))); }
                part += __shfl_xor(part, 16); part += __shfl_xor(part, 32);
                nreg = nreg * decay + part;
            }
            {
#pragma unroll
                for (int r = 0; r < 16; ++r) Cacc[r] *= decay;
                s16x4 l0, l1, l2, l3, h0, h1, h2, h3;
                TRRD(l0, vbE, 0); TRRD(h0, vbE, 2048); TRRD(l1, vbE, 4096); TRRD(h1, vbE, 6144); TRRD(l2, vbE, 8192); TRRD(h2, vbE, 10240); TRRD(l3, vbE, 12288); TRRD(h3, vbE, 14336);
                s16x4 ka[4][2];
                { const int d = 32 * wid + trg * 16 + 4 * trp;
                  const int ad0 = (int)(uintptr_t)lds + L_K + kaddr(8 * hi + trq, d), ad1 = (int)(uintptr_t)lds + L_K + kaddr(8 * hi + 4 + trq, d);
                  TRRD(ka[0][0], ad0, 0); TRRD(ka[0][1], ad1, 0); TRRD(ka[1][0], ad0, 4096); TRRD(ka[1][1], ad1, 4096);
                  TRRD(ka[2][0], ad0, 8192); TRRD(ka[2][1], ad1, 8192); TRRD(ka[3][0], ad0, 12288); TRRD(ka[3][1], ad1, 12288); }
                asm volatile("s_waitcnt lgkmcnt(0)" ::: "memory"); SBAR();
#define KAF(ks) (bf16x8){ka[ks][0][0], ka[ks][0][1], ka[ks][0][2], ka[ks][0][3], ka[ks][1][0], ka[ks][1][1], ka[ks][1][2], ka[ks][1][3]}
                Cacc = __builtin_amdgcn_mfma_f32_32x32x16_bf16(KAF(0), (bf16x8){l0[0], l0[1], l0[2], l0[3], h0[0], h0[1], h0[2], h0[3]}, Cacc, 0, 0, 0);
                Cacc = __builtin_amdgcn_mfma_f32_32x32x16_bf16(KAF(1), (bf16x8){l1[0], l1[1], l1[2], l1[3], h1[0], h1[1], h1[2], h1[3]}, Cacc, 0, 0, 0);
                Cacc = __builtin_amdgcn_mfma_f32_32x32x16_bf16(KAF(2), (bf16x8){l2[0], l2[1], l2[2], l2[3], h2[0], h2[1], h2[2], h2[3]}, Cacc, 0, 0, 0);
                Cacc = __builtin_amdgcn_mfma_f32_32x32x16_bf16(KAF(3), (bf16x8){l3[0], l3[1], l3[2], l3[3], h3[0], h3[1], h3[2], h3[3]}, Cacc, 0, 0, 0);
#undef KAF
            }
            __syncthreads();
            float one = 1.0f; asm volatile("" : "+v"(one));
#pragma unroll
            for (int g = 0; g < 4; ++g) { const int d4 = 32 * wid + 8 * g + 4 * hi; u32x2 w; w.x = cvt_pk_bf16(Cacc[4 * g] * one, Cacc[4 * g + 1] * one); w.y = cvt_pk_bf16(Cacc[4 * g + 2] * one, Cacc[4 * g + 3] * one);
                *(u32x2*)(lds + L_CT + cfrag + ((d4 * 2) ^ csw)) = w; }
            if (wid < 2) {
                const float* G = (const float*)(lds + L_G) + wid * 1024 + lane_o;
                bf16_t* ob = hcat + (size_t)(b * SEQ + t0 + wid * 32) * DM + h * 512 + sl * 32;
                const int lofs = hi * 4 * DM + r32;
#pragma unroll
                for (int r = 0; r < 16; ++r) { const float v = oi[r] + G[r * 64], vn = dpp_xor1(v);
                    if ((r32 & 1) == 0) *(unsigned*)((ob + (size_t)((r & 3) + 8 * (r >> 2)) * DM) + lofs) = cvt_pk_bf16(v, vn); }
                if (sl == 0 && hi == 0) deni[t0 + wid * 32 + r32] = psi;
            }
        }
#undef MC_LOAD
        __syncthreads();
    }
}
#undef TRRD

__device__ __forceinline__ void p5_mlstm_norm(const Args& a) {
    const int tid = threadIdx.x, lane = tid & 63, wid = tid >> 6;
    const int gw = blockIdx.x * 8 + wid, nw = gridDim.x * 8;
    const bf16_t* proj = (const bf16_t*)(a.ws + WS_R); bf16_t* hcat = (bf16_t*)a.out;
    const float* den = (const float*)(a.ws + WS_DEN); const float* fl = (const float*)(a.ws + WS_FLOOR); const float* mn = a.in[4];
    for (int it = gw; it < M_TOK * 4; it += nw) {
        const int tk = it >> 2, h = it & 3, b = tk >> 12, t = tk & (SEQ - 1), bh = b * 4 + h;
        bf16_t* hp = hcat + (size_t)tk * DM + h * 512 + lane * 8;
        float x[8], og[8];
        unpack8(*(const bf16x8*)hp, x); unpack8(*(const bf16x8*)(proj + (size_t)tk * AB_NP + AB_OG + h * 512 + lane * 8), og);
#if MLSTM_CHUNK && !MLSTM_BOTH && (DEBUG_CMP < 0)
        float dsum = ((const float*)(a.ws + WS_DENI))[(size_t)bh * SEQ + t];
#pragma unroll
        for (int q = 0; q < 16; ++q) dsum += ((const float*)(a.ws + WS_DENP))[(size_t)(bh * 16 + q) * SEQ + t];
#else
        const float dsum = den[(size_t)bh * SEQ + t];
#endif
        const float dd = fmaxf(fabsf(dsum), fl[(size_t)bh * SEQ + t]); const float inv = 1.0f / dd;
        float s = 0.f;
#pragma unroll
        for (int j = 0; j < 8; ++j) { x[j] *= inv; s += x[j] * x[j]; }
        s = wave_sum(s);
        const float r = rsqrtf(s * (1.0f / 512.0f) + RMS_EPS);
#pragma unroll
        for (int j = 0; j < 8; ++j) x[j] = x[j] * r * mn[h * 512 + lane * 8 + j] * sigmoid_f(og[j]);
        *(bf16x8*)hp = pack8f(x);
    }
}
__device__ __forceinline__ int xcd_unit(int k, int per, int groups, int upg) {
    const int w = blockIdx.x, G = gridDim.x;
    if (G != 256 || per * 256 != groups * upg) return w + k * G;
    const int j = w & 7, s = w >> 3, lu = k * 32 + s;
    return (j * (groups >> 3) + lu / upg) * upg + lu % upg;
}
__device__ __forceinline__ void p5_mla(char* lds, const Args& a) {
    const int tid = threadIdx.x, wid = __builtin_amdgcn_readfirstlane(tid >> 6), lane = tid & 63, r32 = lane & 31, hi = lane >> 5;
    const bf16_t* qb = (const bf16_t*)(a.ws + WS_QB); const bf16_t* kvb = (const bf16_t*)(a.ws + WS_KVB); const bf16_t* krope = (const bf16_t*)(a.ws + WS_KROPE);
    bf16_t* hcat = (bf16_t*)a.out;     const f32x2* rp = (const f32x2*)(a.ws + WS_ROPE);
    for (int kk = 0; kk * (int)gridDim.x < 64 * 8 * 2; ++kk) {
        const int it2 = xcd_unit(kk >> 1, 2, 64, 8), pass = kk & 1; if (it2 >= 512) break;
        const int bh = it2 >> 3, x = it2 & 7, b = bh >> 4, h = bh & 15;
        const int qblk = pass ? 15 - x : x, t0 = qblk * 256, pos = t0 + wid * 32 + r32;
        const bf16_t* qrow = qb + (size_t)(b * SEQ + pos) * 3072 + h * 192;
        bf16x8 qr[8], qrr[4];
#pragma unroll
        for (int d0 = 0; d0 < 8; ++d0) qr[d0] = *(const bf16x8*)(qrow + d0 * 16 + hi * 8);
#pragma unroll
        for (int d0 = 0; d0 < 4; ++d0) qrr[d0] = *(const bf16x8*)(qrow + 128 + d0 * 16 + hi * 8);
#pragma unroll
        for (int g = 0; g < 2; ++g) { float x1[8], x2[8], o1[8], o2[8]; unpack8(qrr[g], x1); unpack8(qrr[2 + g], x2);
#pragma unroll
            for (int j = 0; j < 8; ++j) { const f32x2 cs = rp[(size_t)pos * 32 + g * 16 + hi * 8 + j]; o1[j] = x1[j] * cs.x - x2[j] * cs.y; o2[j] = x1[j] * cs.y + x2[j] * cs.x; }
            char* qpark = lds + fa::OFF_QPARK + wid * 4096 + lane * 16;
            *(bf16x8*)(qpark + g * 1024) = pack8f(o1); *(bf16x8*)(qpark + (2 + g) * 1024) = pack8f(o2); }
        fa::FUnit u; u.Kb = kvb + (size_t)(b * SEQ) * 4096 + h * 256; u.ldk = 4096; u.Vb = u.Kb + 128; u.ldv = 4096; u.KRb = krope + (size_t)(b * SEQ) * 64;
        u.j_lo = 0; u.j_hi = (t0 + 255) / 64 + 1; u.qlo = t0 + wid * 32; u.qhi = u.qlo + 31; u.qpos = pos; u.sel = 0ull;
        f32x16 o[4]; float m_reg, l_reg;
        fa::flash_core<0>(lds, u, qr, 0.07216878364870322f, o, m_reg, l_reg);
        float rf[16]; fa::row_factors(lds, wid, r32, hi, 1.0f / l_reg, rf);
        bf16_t* ob = hcat + (size_t)(b * SEQ + t0 + wid * 32) * DM + 2048 + h * 128;
#pragma unroll
        for (int r = 0; r < 16; ++r) { const int orow = fa::crow(r, hi);
#pragma unroll
            for (int d0 = 0; d0 < 4; ++d0) { const float v = o[d0][r] * rf[r]; const float vn = __shfl_xor(v, 1);
                if ((r32 & 1) == 0) *(unsigned*)(ob + (size_t)orow * DM + d0 * 32 + r32) = cvt_pk_bf16(v, vn); } }
        __syncthreads();
    }
}

__device__ __forceinline__ void p7_layernorm(const Args& a, int layer_idx, bool mix, const float* z, float* outf, bf16_t* outb, f32x2* stats) {
    const int tid = threadIdx.x, lane = tid & 63, wid = tid >> 6;
    const int gw = blockIdx.x * 8 + wid, nw = gridDim.x * 8;
    const float* g = (mix ? a.in[22] : a.in[24]) + (size_t)layer_idx * DM; const float* bb = (mix ? a.in[23] : a.in[25]) + (size_t)layer_idx * DM;
    for (int row = gw; row < M_TOK; row += nw) {
        const float* zr = z + (size_t)row * DM;
        f32x4 v[16]; float s = 0.f;
#pragma unroll
        for (int i = 0; i < 16; ++i) { v[i] = *(const f32x4*)(zr + i * 256 + lane * 4); s += (v[i][0] + v[i][1]) + (v[i][2] + v[i][3]); }
        s = wave_sum(s); const float mu = s * (1.0f / DM);
        float q = 0.f;
#pragma unroll
        for (int i = 0; i < 16; ++i) { const f32x4 d = v[i] - mu; q += (d[0] * d[0] + d[1] * d[1]) + (d[2] * d[2] + d[3] * d[3]); }
        q = wave_sum(q); const float rs = rsqrtf(q * (1.0f / DM) + LN_EPS);
        if (stats && lane == 0) stats[row] = (f32x2){mu, rs};
#pragma unroll
        for (int i = 0; i < 16; ++i) { const int c = i * 256 + lane * 4; const f32x4 gg = *(const f32x4*)(g + c), be = *(const f32x4*)(bb + c);
            const f32x4 y = (v[i] - mu) * rs * gg + be;
            if (outf) *(f32x4*)(outf + (size_t)row * DM + c) = y;
            if (outb) { u32x2 w; w.x = cvt_pk_bf16(y[0], y[1]); w.y = cvt_pk_bf16(y[2], y[3]); *(u32x2*)(outb + (size_t)row * DM + c) = w; } }
    }
}
__device__ __forceinline__ void p7_layernorm_b(const Args& a, int layer_idx, bool mix, const bf16_t* zb, float* outf, bf16_t* outb, f32x2* stats) {
    const int tid = threadIdx.x, lane = tid & 63, wid = tid >> 6;
    const int gw = blockIdx.x * 8 + wid, nw = gridDim.x * 8;
    const float* g = (mix ? a.in[22] : a.in[24]) + (size_t)layer_idx * DM; const float* bb = (mix ? a.in[23] : a.in[25]) + (size_t)layer_idx * DM;
    for (int row = gw; row < M_TOK; row += nw) {
        const bf16_t* zr = zb + (size_t)row * DM;
        float v[8][8]; float s = 0.f;
#pragma unroll
        for (int i = 0; i < 8; ++i) { unpack8h(*(const bf16x8*)(zr + i * 512 + lane * 8), v[i]); s += ((v[i][0] + v[i][1]) + (v[i][2] + v[i][3])) + ((v[i][4] + v[i][5]) + (v[i][6] + v[i][7])); }
        s = wave_sum(s); const float mu = s * (1.0f / DM);
        float q = 0.f;
#pragma unroll
        for (int i = 0; i < 8; ++i)
#pragma unroll
            for (int j = 0; j < 8; ++j) { const float d = v[i][j] - mu; q += d * d; }
        q = wave_sum(q); const float rs = rsqrtf(q * (1.0f / DM) + LN_EPS);
        if (stats && lane == 0) stats[row] = (f32x2){mu, rs};
#pragma unroll
        for (int i = 0; i < 8; ++i) { const int c = i * 512 + lane * 8; const f32x4 g0 = *(const f32x4*)(g + c), g1 = *(const f32x4*)(g + c + 4), b0 = *(const f32x4*)(bb + c), b1 = *(const f32x4*)(bb + c + 4);
            float y[8];
#pragma unroll
            for (int j = 0; j < 4; ++j) { y[j] = (v[i][j] - mu) * rs * g0[j] + b0[j]; y[4 + j] = (v[i][4 + j] - mu) * rs * g1[j] + b1[j]; }
            if (outf) { *(f32x4*)(outf + (size_t)row * DM + c) = (f32x4){y[0], y[1], y[2], y[3]}; *(f32x4*)(outf + (size_t)row * DM + c + 4) = (f32x4){y[4], y[5], y[6], y[7]}; }
            if (outb) *(bf16x8*)(outb + (size_t)row * DM + c) = pack8f(y); }
    }
}
__device__ __forceinline__ void p12_blocks(const Args& a) {
    const bf16_t* projc = (const bf16_t*)(a.ws + WS_R);
    const size_t gt = (size_t)blockIdx.x * NTHREADS + threadIdx.x, gs = (size_t)gridDim.x * NTHREADS;
    for (size_t i = gt; i < (size_t)2 * 4096 * 512; i += gs) {
        const int which = (int)(i / ((size_t)4096 * 512)); const int rem = (int)(i % ((size_t)4096 * 512));
        const int r = rem >> 9, l = (rem >> 4) & 31, d8 = rem & 15, g = r & 3, n = (r >> 2) & 255, b = r >> 10;
        bf16_t* A = (bf16_t*)(a.ws + (which ? WS_AV : WS_AK)); const float* pe = which ? a.in[13] : a.in[12];
        float f[8];
        if (n < 255) { unpack8(*(const bf16x8*)(projc + (size_t)(b * SEQ + 16 * n + l) * C_NP + (which ? C_VC : C_KC) + g * 128 + d8 * 8), f);
#pragma unroll
            for (int j = 0; j < 8; ++j) f[j] += pe[l * 128 + d8 * 8 + j]; }
        else {
#pragma unroll
            for (int j = 0; j < 8; ++j) f[j] = 0.f; }
        *(bf16x8*)(A + (size_t)r * 4096 + l * 128 + d8 * 8) = pack8f(f);
    }
}
__device__ __forceinline__ float nsa_gate(const Args& a, int token, int br, int head) {
    const bf16_t* projc = (const bf16_t*)(a.ws + WS_R);
    return sigmoid_f(bf2f(projc[(size_t)token * C_NP + C_GATE + br * 32 + head]) + a.in[11][br * 32 + head]);
}
__device__ __forceinline__ void p15_cmp_attn(char* lds, const Args& a) {
    const int tid = threadIdx.x, wid = __builtin_amdgcn_readfirstlane(tid >> 6), lane = tid & 63, r32 = lane & 31, hi = lane >> 5;
    const bf16_t* projc = (const bf16_t*)(a.ws + WS_R); const bf16_t* kcmp = (const bf16_t*)(a.ws + WS_KCMP); const bf16_t* vcmp = (const bf16_t*)(a.ws + WS_VCMP);
    float* acc = (float*)(a.ws + WS_Z); unsigned long long* selp = (unsigned long long*)(a.ws + WS_SEL);
    const float scale = 0.08838834764831845f, C2 = 1.4426950408889634f * scale;
    float* IMP = (float*)(lds + fa::OFF_IMP);
    for (int kk = 0; kk * (int)gridDim.x < 2048; ++kk) {
        const int unit = xcd_unit(kk, 8, 16, 128); if (unit >= 2048) break;
        const int bg = unit >> 7, xb = unit & 127, b = bg >> 2, g = bg & 3, t0 = xb * 32;
        const int tokl = wid * 4 + (r32 >> 3), head = g * 8 + (r32 & 7), tq = t0 + tokl;
        const bf16_t* qrow = projc + (size_t)(b * SEQ + tq) * C_NP + C_Q + head * 128;
        bf16x8 qr[8];
#pragma unroll
        for (int d0 = 0; d0 < 8; ++d0) qr[d0] = *(const bf16x8*)(qrow + d0 * 16 + hi * 8);
        fa::FUnit u; u.Kb = kcmp + (size_t)(b * 256 * 4 + g) * 256; u.ldk = 1024; u.Vb = vcmp + (size_t)(b * 256 * 4 + g) * 256; u.ldv = 1024; u.KRb = nullptr;
        const int nmax_hi = (t0 + 31 - 31) >> 4;
        u.j_lo = 0; u.j_hi = (nmax_hi >> 6) + 1; u.qlo = (t0 + wid * 4 - 31) >> 4; u.qhi = (t0 + wid * 4 + 3 - 31) >> 4; u.qpos = (tq - 31) >> 4; u.sel = 0ull;
        f32x16 o[4]; float m_reg, l_reg;
        fa::flash_core<3>(lds, u, qr, scale, o, m_reg, l_reg);
        const float inv_l = l_reg > 0.f ? 1.0f / l_reg : 0.f;
        { float rf[16]; fa::row_factors(lds, wid, r32, hi, inv_l * nsa_gate(a, b * SEQ + tq, 0, head), rf);
#pragma unroll
          for (int r = 0; r < 16; ++r) { const int orow = fa::crow(r, hi); const int tk = t0 + wid * 4 + (orow >> 3), hd = g * 8 + (orow & 7);
              float* op = acc + (size_t)(b * SEQ + tk) * DM + hd * 128 + r32;
#pragma unroll
              for (int d0 = 0; d0 < 4; ++d0) op[d0 * 32] = o[d0][r] * rf[r]; } }
        __syncthreads();
        const float mL = -m_reg * C2;
        const int sr = tid >> 4, sc = (tid & 15) * 8, kws = KSWZ(sr, sc * 2);
        for (int t = 0; t < u.j_hi; ++t) {
            const int kb = t * 64;
            const bf16x8 k0 = *(const bf16x8*)(u.Kb + (long)(kb + sr) * u.ldk + sc), k1 = *(const bf16x8*)(u.Kb + (long)(kb + 32 + sr) * u.ldk + sc);
            *(bf16x8*)(lds + fa::OFF_K + kws) = k0; *(bf16x8*)(lds + fa::OFF_K + kws + 32 * 256) = k1;
            __syncthreads();
            f32x16 p0, p1; fa::qkt<0, false, true>(p0, p1, lds, r32, hi, qr);
            fa::mask_tile(p0, p1, u.qpos - kb - 4 * hi, 0x80000000u);
#pragma unroll
            for (int r = 0; r < 16; ++r) {
                float a0 = __builtin_amdgcn_exp2f(fmaf(p0[r], C2, mL)) * inv_l, a1 = __builtin_amdgcn_exp2f(fmaf(p1[r], C2, mL)) * inv_l;
                a0 += dpp_xor1(a0); a0 += dpp_xor2(a0); a0 += dpp_hmir(a0);
                a1 += dpp_xor1(a1); a1 += dpp_xor2(a1); a1 += dpp_hmir(a1);
                if ((r32 & 7) == 0) { const int n = kb + fa::crow(r, hi); IMP[tokl * fa::IMP_LD + n] = a0; IMP[tokl * fa::IMP_LD + n + 32] = a1; }
            }
            __syncthreads();
        }
        for (int q4 = 0; q4 < 4; ++q4) {
            const int tl = wid * 4 + q4, tqq = t0 + tl, cur = tqq >> 6, s = lane;
            float v = 0.f;
#pragma unroll
            for (int dn = -1; dn <= 3; ++dn) { const int n = 4 * s + dn; if (n >= 0 && n <= 254 && n < u.j_hi * 64) v += IMP[tl * fa::IMP_LD + n]; }
            if (s == 0 || s == cur || s == cur - 1) v = 1e9f;
            if (s > cur) v = -1e30f;
            int rank = 0;
#pragma nounroll
            for (int j = 0; j < 64; ++j) { const float vj = __int_as_float(__builtin_amdgcn_readlane(__float_as_int(v), j)); rank += (vj > v || (vj == v && j < s)) ? 1 : 0; }
            const unsigned long long msk = __ballot(rank < 16);
            if (lane == 0) selp[(size_t)bg * SEQ + tqq] = msk;
        }
        __syncthreads();
    }
}
template <int MODE, int VAR = 0>
__device__ __forceinline__ void p16_nsa_attn(char* lds, const Args& a) {
    const int tid = threadIdx.x, wid = __builtin_amdgcn_readfirstlane(tid >> 6), lane = tid & 63, r32 = lane & 31, hi = lane >> 5;
    const bf16_t* projc = (const bf16_t*)(a.ws + WS_R); float* acc = (float*)(a.ws + WS_Z); bf16_t* hcat = (bf16_t*)a.out;
    const unsigned long long* selp = (const unsigned long long*)(a.ws + WS_SEL);
    const float scale = 0.08838834764831845f;
    const int nitems = (MODE == 2) ? 2048 : 2048;
    for (int kk = 0; kk * (int)gridDim.x < nitems; ++kk) {
        int bg, xb;
        if (MODE == 2) { const int pass = kk & 1, it2 = xcd_unit(kk >> 1, 4, 16, 64); if (it2 >= 1024) break; bg = it2 >> 6; const int x = it2 & 63; xb = pass ? 127 - x : x; }
        else { const int item = xcd_unit(kk, 8, 16, 128); if (item >= 2048) break; bg = item >> 7; xb = item & 127; }
        const int b = bg >> 2, g = bg & 3, t0 = xb * 32, head = g * 8 + wid, tq = t0 + r32;
        const bf16_t* qrow = projc + (size_t)(b * SEQ + tq) * C_NP + C_Q + head * 128;
        bf16x8 qr[8];
#pragma unroll
        for (int d0 = 0; d0 < 8; ++d0) qr[d0] = *(const bf16x8*)(qrow + d0 * 16 + hi * 8);
        fa::FUnit u; u.KRb = nullptr; u.ldk = C_NP; u.ldv = C_NP; u.qlo = t0; u.qhi = t0 + 31; u.qpos = tq; u.sel = 0ull;
        if (MODE == 1) { u.Kb = projc + (size_t)(b * SEQ) * C_NP + C_KW + g * 128; u.Vb = projc + (size_t)(b * SEQ) * C_NP + C_VW + g * 128;
            const int lowk = t0 - 511; u.j_lo = lowk > 0 ? lowk / 64 : 0; u.j_hi = (t0 + 31) / 64 + 1; }
        else { u.Kb = projc + (size_t)(b * SEQ) * C_NP + C_KS + g * 128; u.Vb = projc + (size_t)(b * SEQ) * C_NP + C_VS + g * 128;
            u.j_lo = 0; u.j_hi = (t0 + 31) / 64 + 1; u.sel = selp[(size_t)bg * SEQ + tq]; }
        f32x16 o[4]; float m_reg, l_reg;
#if FLASH2
        fa::flash_core2<MODE>(lds, u, qr, scale, o, m_reg, l_reg);
#else
        fa::flash_core<MODE, VAR>(lds, u, qr, scale, o, m_reg, l_reg);
#endif
        float rf[16]; fa::row_factors(lds, wid, r32, hi, nsa_gate(a, b * SEQ + tq, MODE == 1 ? 2 : 1, head) / l_reg, rf);
        if (VAR != 0) { float sink = 0.f; for (int d0 = 0; d0 < 4; ++d0) for (int r = 0; r < 16; ++r) sink += o[d0][r] * rf[r]; if (sink == 1.2345e-30f) acc[0] = sink; __syncthreads(); continue; }
        const size_t off0 = (size_t)(b * SEQ + t0 + 4 * hi) * DM + head * 128 + r32;
        float av[16][4];
#pragma unroll
        for (int r = 0; r < 16; ++r)
#pragma unroll
            for (int d0 = 0; d0 < 4; ++d0) av[r][d0] = acc[off0 + (size_t)((r & 3) + 8 * (r >> 2)) * DM + d0 * 32];
        asm volatile("" ::: "memory");
#pragma unroll
        for (int r = 0; r < 16; ++r) { const size_t off = off0 + (size_t)((r & 3) + 8 * (r >> 2)) * DM;
#pragma unroll
            for (int d0 = 0; d0 < 4; ++d0) { const float v = av[r][d0] + o[d0][r] * rf[r];
                if (MODE == 1) acc[off + d0 * 32] = v;
                else { const float vn = dpp_xor1(v); if ((r32 & 1) == 0) *(unsigned*)(hcat + off + d0 * 32) = cvt_pk_bf16(v, vn); } } }
        __syncthreads();
    }
}


#ifndef DEBUG_CMP
#define DEBUG_CMP -1
#endif
#if DEBUG_CMP >= 0
__device__ __forceinline__ void dbg_copy(const Args& a) {
    const bf16_t* hcat = (const bf16_t*)(a.ws + WS_XB); bf16_t* dbg = (bf16_t*)(a.ws + WS_Z);
    const size_t gt = (size_t)blockIdx.x * NTHREADS + threadIdx.x, gs = (size_t)gridDim.x * NTHREADS;
    for (size_t i = gt; i < (size_t)M_TOK * 256; i += gs) { const size_t row = i >> 8, c8 = i & 255; *(bf16x8*)(dbg + row * 2048 + c8 * 8) = *(const bf16x8*)(hcat + row * DM + c8 * 8); }
}
__device__ __forceinline__ void dbg_compare(const Args& a) {
    const bf16_t* hcat = (const bf16_t*)(a.ws + WS_XB); const bf16_t* dbg = (const bf16_t*)(a.ws + WS_Z);
    float* accum = (float*)(a.ws + WS_CTL + 32 * 1024);
    const size_t gt = (size_t)blockIdx.x * NTHREADS + threadIdx.x, gs = (size_t)gridDim.x * NTHREADS;
    float sd = 0.f, sr = 0.f;
    for (size_t i = gt; i < (size_t)M_TOK * 256; i += gs) { const size_t row = i >> 8, c8 = i & 255; const int t = (int)(row & (SEQ - 1));
        bool in = false;
        if (DEBUG_CMP == 0) in = t < 32; if (DEBUG_CMP == 1) in = t >= 32 && t < 64; if (DEBUG_CMP == 2) in = t >= 64 && t < 128; if (DEBUG_CMP == 3) in = true;
        if (DEBUG_CMP == 4) in = (t & 63) < 32; if (DEBUG_CMP == 5) in = (t & 63) >= 32;
        if (!in) continue;
        float x[8], y[8]; unpack8(*(const bf16x8*)(hcat + row * DM + c8 * 8), x); unpack8(*(const bf16x8*)(dbg + row * 2048 + c8 * 8), y);
#pragma unroll
        for (int j = 0; j < 8; ++j) { const float d = x[j] - y[j]; sd += d * d; sr += x[j] * x[j]; } }
    sd = wave_sum(sd); sr = wave_sum(sr);
    if ((threadIdx.x & 63) == 0) { atomicAdd((unsigned long long*)accum, (unsigned long long)(sd * 1048576.0f)); atomicAdd((unsigned long long*)accum + 1, (unsigned long long)(sr * 1048576.0f)); }
}
#endif

constexpr int N_PHASES = 23;
__global__ void __launch_bounds__(NTHREADS, 2) fwd(Args args) {
    extern __shared__ __attribute__((aligned(16))) unsigned char shm[];
    char* lds = (char*)shm;
    PG8_LAS unsigned char* ldsg = (PG8_LAS unsigned char*)shm;
    unsigned char* ws = args.ws;
    if (threadIdx.x < 64) ((volatile LAS unsigned*)(ldsg + LDS_CTL_OFF))[threadIdx.x] = 0u;
    __syncthreads();
    XcdBarrier bar = xcd_barrier_post((unsigned*)(ws + WS_CTL), (volatile LAS unsigned*)(ldsg + LDS_CTL_OFF));
    const int lo = args.ph_lo, hi = args.ph_hi, G = gridDim.x, bx = blockIdx.x;
#define IN(k) (lo <= (k) && (k) < hi)
#define SEAM(k) do { if (IN(k) && IN((k) + 1)) xcd_barrier(bar); } while (0)
#define GEMMC(EPI, cidx, Aoff, Boff, Mr, Nr, Kr, ...) do { pg8::Gemm g_{(const pg8::bf16_t*)(ws + (Aoff)), (const pg8::bf16_t*)(ws + (Boff)), (Mr), (Nr), (Kr)}; pg8::StaticOrder S_; S_.init((Mr), (Nr), G, (cidx)); S_.WGM = GEMM_WGM; \
        EPI E_{__VA_ARGS__}; pg8::gemm_phase<EPI, pg8::StaticOrder, true, true>(ldsg, g_, S_, E_); } while (0)
#define GEMM(EPI, ...) GEMMC(EPI, bx, __VA_ARGS__)
#define GEMMA(EPI, Aptr, Boff, Mr, Nr, Kr, ...) do { pg8::Gemm g_{(const pg8::bf16_t*)(Aptr), (const pg8::bf16_t*)(ws + (Boff)), (Mr), (Nr), (Kr)}; pg8::StaticOrder S_; S_.init((Mr), (Nr), G, bx); S_.WGM = GEMM_WGM; \
        EPI E_{__VA_ARGS__}; pg8::gemm_phase<EPI, pg8::StaticOrder, true, true>(ldsg, g_, S_, E_); } while (0)
#define GEMM_WGM gemm_wgm
    float* xres = args.out;
    bf16_t* xb = (bf16_t*)(ws + WS_XB); const bf16_t* hcat = (const bf16_t*)args.out; f32x2* stats = (f32x2*)(ws + WS_STATS);
    bf16_t* zA = (bf16_t*)(ws + WS_Z); bf16_t* zB = (bf16_t*)args.out + (size_t)M_TOK * DM; bf16_t* zC = zA; bf16_t* zD = zA + (size_t)M_TOK * DM;

#ifndef FFN_CHUNKED
#define FFN_CHUNKED 0
#endif
#ifndef WGM_IN
#define WGM_IN 8
#endif
#ifndef WGM_WO
#define WGM_WO 4
#endif
#ifndef WGM_UP
#define WGM_UP 8
#endif
#ifndef WGM_DOWN
#define WGM_DOWN 2
#endif
    int gemm_wgm = 8;
#ifndef PROBE_MASK
#define PROBE_MASK 0u
#endif
#define PB(k) (((PROBE_MASK) >> (k)) & 1u)
#define PH(k, ...) do { if (IN(k)) { __VA_ARGS__; if (PB(k)) { xcd_barrier(bar); __VA_ARGS__; } } SEAM(k); } while (0)
    PH(0, p0_prologue(lds, args));
    gemm_wgm = WGM_IN; PH(1, GEMM(pg8::EpiProj, WS_XB, W_AB, M_TOK, AB_NP, DM, (bf16_t*)(ws + WS_R), AB_NP, (float*)(ws + WS_GATES), AB_IG / 256); if (bx >= 192 && G == 256) transpose_late(lds, args, bx - 192));
    PH(2, p2_prep(args));
    gemm_wgm = 8; if (IN(3)) { GEMM(pg8::EpiB<0>, WS_CQN, W_UQ, M_TOK, 3072, 1024, (bf16_t*)(ws + WS_QB), 3072); GEMM(pg8::EpiB<0>, WS_CKVN, W_UKV, M_TOK, 4096, 512, (bf16_t*)(ws + WS_KVB), 4096); }
    if (!(IN(3) && IN(4))) SEAM(3);
#if DEBUG_CMP >= 0
#if MC_VALU_STATE == 4
    PH(4, p4_mlstm_chunk(lds, args); xcd_barrier(bar); p4_mlstm(lds, args));
#else
    PH(4, p4_mlstm_chunk(lds, args); xcd_barrier(bar); dbg_copy(args); xcd_barrier(bar); p4_mlstm(lds, args); xcd_barrier(bar); dbg_compare(args));
#endif
#elif MLSTM_BOTH
    PH(4, p4_mlstm_chunk(lds, args); xcd_barrier(bar); p4_mlstm(lds, args));
#elif MLSTM_CHUNK
    PH(4, p4_mlstm_chunk(lds, args));
#else
    PH(4, p4_mlstm(lds, args));
#endif
    if (IN(5)) { p5_mlstm_norm(args); p5_mla(lds, args); if (PB(5)) { xcd_barrier(bar); p5_mla(lds, args); } } SEAM(5);
    gemm_wgm = WGM_WO; PH(6, GEMMA(pg8::EpiResidB, hcat, W_O0, M_TOK, DM, DM, zA, xb));
    PH(7, p7_layernorm_b(args, 0, true, zA, nullptr, xb, stats));
#if FFN_CHUNKED
#define FFN_UP(WGU, half) GEMM(pg8::EpiSwiGLU, WS_XB + (size_t)(half) * 8192 * DM * 2, WGU, 8192, GU_N, DM, (bf16_t*)(ws + WS_R) + (size_t)(half) * 8192 * FFH, FFH)
#define FFN_DOWN(WD, half, Cp, Zpp, lg, lb) GEMM(pg8::EpiResidLN, WS_R + (size_t)(half) * 8192 * FFH * 2, WD, 8192, DM, FFH, (Cp) + (size_t)(half) * 8192 * DM, (Zpp) + (size_t)(half) * 8192 * DM, stats + (half) * 8192, lg, lb, DM, DN_ALPHA)
    if (IN(8)) { gemm_wgm = WGM_UP; FFN_UP(W_GU0, 0); if (bx >= 192 && G == 256) transpose_late(lds, args, 64 + bx - 192); } SEAM(8);
    if (IN(9)) { gemm_wgm = WGM_DOWN; FFN_DOWN(W_D0, 0, xres, z, args.in[22], args.in[23]); gemm_wgm = WGM_UP; FFN_UP(W_GU0, 1); if (bx >= 192 && G == 256) transpose_late(lds, args, 128 + bx - 192);
                 xcd_barrier(bar); gemm_wgm = WGM_DOWN; FFN_DOWN(W_D0, 1, xres, z, args.in[22], args.in[23]); } SEAM(9);
#else
    gemm_wgm = WGM_UP; PH(8, GEMM(pg8::EpiSwiGLU, WS_XB, W_GU0, M_TOK, GU_N, DM, (bf16_t*)(ws + WS_R), FFH); if (bx >= 128 && G == 256) transpose_late(lds, args, 64 + bx - 128));
    gemm_wgm = WGM_DOWN; PH(9, GEMM(pg8::EpiResidLNB, WS_R, W_D0, M_TOK, DM, FFH, zB, zA, stats, args.in[22], args.in[23]));
#endif
    PH(10, p7_layernorm_b(args, 0, false, zB, nullptr, xb, stats));
    gemm_wgm = WGM_IN; PH(11, GEMM(pg8::EpiB<0>, WS_XB, W_C, M_TOK, C_NP, DM, (bf16_t*)(ws + WS_R), C_NP); if (bx >= 64 && G == 256) transpose_late(lds, args, 192 + bx - 64));
    PH(12, p12_blocks(args));
    gemm_wgm = 8; PH(13, GEMM(pg8::EpiB<1>, WS_AK, W_C1K, 4096, 256, 4096, (bf16_t*)(ws + WS_HK), 256);
           GEMMC(pg8::EpiB<1>, (bx + G - 16) % G, WS_AV, W_C1V, 4096, 256, 4096, (bf16_t*)(ws + WS_HV), 256);
           if (G == 256) { if (bx >= 32) transpose_late(lds, args, 384 + bx - 32); } else { for (int sl_ = bx; sl_ < LATE_SLOTS; sl_ += G) transpose_late(lds, args, sl_); });
    PH(14, GEMM(pg8::EpiB<0>, WS_HK, W_C2K, 4096, 256, 256, (bf16_t*)(ws + WS_KCMP), 256);
           GEMMC(pg8::EpiB<0>, (bx + G - 16) % G, WS_HV, W_C2V, 4096, 256, 256, (bf16_t*)(ws + WS_VCMP), 256));
    if (IN(15)) { p15_cmp_attn(lds, args); } SEAM(15);
    if (IN(16)) { p16_nsa_attn<1>(lds, args); if (PB(16)) { xcd_barrier(bar); p15_cmp_attn(lds, args); xcd_barrier(bar); p16_nsa_attn<1>(lds, args); } } SEAM(16);
#ifndef PROBE_VAR
#define PROBE_VAR 0
#endif
    if (IN(17)) { p16_nsa_attn<2>(lds, args); if (PB(17)) { xcd_barrier(bar); p16_nsa_attn<2, PROBE_VAR>(lds, args); } } SEAM(17);
    gemm_wgm = WGM_WO; PH(18, GEMMA(pg8::EpiResidLNB, hcat, W_O1, M_TOK, DM, DM, zC, zB, stats, args.in[24], args.in[25]));
    PH(19, p7_layernorm_b(args, 1, true, zC, nullptr, xb, stats));
#if FFN_CHUNKED
    if (IN(20)) { gemm_wgm = WGM_UP; FFN_UP(W_GU1, 0); } SEAM(20);
    if (IN(21)) { gemm_wgm = WGM_DOWN; FFN_DOWN(W_D1, 0, xres, z, args.in[22] + DM, args.in[23] + DM); gemm_wgm = WGM_UP; FFN_UP(W_GU1, 1);
                  xcd_barrier(bar); gemm_wgm = WGM_DOWN; FFN_DOWN(W_D1, 1, xres, z, args.in[22] + DM, args.in[23] + DM); } SEAM(21);
#else
    gemm_wgm = WGM_UP; PH(20, GEMM(pg8::EpiSwiGLU, WS_XB, W_GU1, M_TOK, GU_N, DM, (bf16_t*)(ws + WS_R), FFH));
    gemm_wgm = WGM_DOWN; PH(21, GEMM(pg8::EpiResidLNB, WS_R, W_D1, M_TOK, DM, FFH, zD, zC, stats, args.in[22] + DM, args.in[23] + DM));
#endif
    PH(22, p7_layernorm_b(args, 1, false, zD, xres, nullptr, nullptr));
#if DEBUG_CMP >= 0
    if (IN(22)) { xcd_barrier(bar); if (bx == 0 && threadIdx.x == 0) { const unsigned long long* accum = (const unsigned long long*)(ws + WS_CTL + 32 * 1024); const float rel = sqrtf((float)((double)accum[0] / fmax((double)accum[1], 1.0)));
        float k = -20.0f * log10f(fmaxf(rel, 1e-6f)); k = fminf(fmaxf(rintf(k), 0.f), 89.f); xres[0] = 1000.0f + 100.0f * k; } }
#endif
#undef PH
#undef PB
#undef IN
#undef SEAM
#undef GEMM
#undef GEMMC
}

#ifndef MK_N_LAUNCHES
#define MK_N_LAUNCHES 1
#endif
extern "C" void kernel_launch(void* const* d_in, const int* in_sizes, int n_in, void* d_out, int out_size, void* d_ws, size_t ws_size, hipStream_t stream) {
    static int grid = 0;
    if (grid == 0) {
        if (n_in != 26 || in_sizes[0] != M_TOK * DM || out_size != M_TOK * DM || ws_size < WS_END) {
            fprintf(stderr, "kernel_launch: unexpected shapes (n_in %d, in0 %d, out %d, ws %zu, need %zu); nothing launched\n", n_in, n_in > 0 ? in_sizes[0] : -1, out_size, ws_size, (size_t)WS_END); grid = -1; return; }
        int dev = 0, cus = 0, per_cu = 0;
        if (hipGetDevice(&dev) != hipSuccess || hipDeviceGetAttribute(&cus, hipDeviceAttributeMultiprocessorCount, dev) != hipSuccess) { grid = -1; return; }
        if (hipFuncSetAttribute((const void*)fwd, hipFuncAttributeMaxDynamicSharedMemorySize, LDS_BYTES) != hipSuccess) { fprintf(stderr, "kernel_launch: hipFuncSetAttribute failed\n"); grid = -1; return; }
        if (hipOccupancyMaxActiveBlocksPerMultiprocessor(&per_cu, (const void*)fwd, NTHREADS, LDS_BYTES) != hipSuccess || per_cu < 1) { fprintf(stderr, "kernel_launch: occupancy query says %d blocks per CU\n", per_cu); (void)hipGetLastError(); grid = -1; return; }
        grid = cus;
    }
    if (grid < 0) return;
    (void)hipMemsetAsync((char*)d_ws + WS_CTL, 0, 64 * 1024, stream);
    Args a{};
    for (int i = 0; i < 26; ++i) a.in[i] = (const float*)d_in[i];
    a.out = (float*)d_out; a.ws = (unsigned char*)d_ws;
    unsigned char* ws = (unsigned char*)d_ws;
    const float* fg = a.in[19]; const float* fu = a.in[20]; const float* fd = a.in[21];
    const size_t LW = (size_t)DM * FFH;
    int j = 0;
    a.tj[j++] = TJob{a.in[1], nullptr, (bf16_t*)(ws + W_AB), DM, AB_IN, AB_NP, 0};
    a.tj[j++] = TJob{a.in[7], nullptr, (bf16_t*)(ws + W_UQ), 1024, 3072, 3072, 0};
    a.tj[j++] = TJob{a.in[8], nullptr, (bf16_t*)(ws + W_UKV), 512, 4096, 4096, 0};
    a.tj[j++] = TJob{a.in[9], nullptr, (bf16_t*)(ws + W_O0), DM, DM, DM, 0};
    a.tj[j++] = TJob{fg, fu, (bf16_t*)(ws + W_GU0), DM, FFH, GU_N, 1};
    a.tj[j++] = TJob{fd, nullptr, (bf16_t*)(ws + W_D0), FFH, DM, DM, 0};
    a.tj[j++] = TJob{a.in[10], nullptr, (bf16_t*)(ws + W_C), DM, C_IN, C_NP, 0};
    a.tj[j++] = TJob{a.in[14], nullptr, (bf16_t*)(ws + W_C1K), 4096, 256, 256, 0};
    a.tj[j++] = TJob{a.in[16], nullptr, (bf16_t*)(ws + W_C1V), 4096, 256, 256, 0};
    a.tj[j++] = TJob{a.in[15], nullptr, (bf16_t*)(ws + W_C2K), 256, 128, 256, 0};
    a.tj[j++] = TJob{a.in[17], nullptr, (bf16_t*)(ws + W_C2V), 256, 128, 256, 0};
    a.tj[j++] = TJob{a.in[18], nullptr, (bf16_t*)(ws + W_O1), DM, DM, DM, 0};
    a.tj[j++] = TJob{fg + LW, fu + LW, (bf16_t*)(ws + W_GU1), DM, FFH, GU_N, 1};
    a.tj[j++] = TJob{fd + LW, nullptr, (bf16_t*)(ws + W_D1), FFH, DM, DM, 0};
#if MK_N_LAUNCHES == 1
    a.ph_lo = 0; a.ph_hi = N_PHASES;
    hipLaunchKernelGGL(fwd, dim3(grid), dim3(NTHREADS), LDS_BYTES, stream, a);
#else
    for (int p = 0; p < N_PHASES; ++p) { a.ph_lo = p; a.ph_hi = p + 1; hipLaunchKernelGGL(fwd, dim3(grid), dim3(NTHREADS), LDS_BYTES, stream, a); }
#endif
    const hipError_t le = hipPeekAtLastError();
    if (le != hipSuccess) fprintf(stderr, "kernel_launch: launch failed: %s\n", hipGetErrorName(le));
}
```

```cpp
#include <hip/hip_runtime.h>
#include <stdint.h>
#include <stdio.h>
#ifndef FLASH2
#define FLASH2 0
#endif
#ifndef DEBUG_CMP
#define DEBUG_CMP -1
#endif
#ifndef MLSTM_BOTH
#define MLSTM_BOTH 0
#endif
#ifndef MLSTM_CHUNK
#define MLSTM_CHUNK 1
#endif

typedef unsigned short bf16_t;
typedef short bf16x8 __attribute__((ext_vector_type(8)));
typedef short s16x4 __attribute__((ext_vector_type(4)));
typedef float f32x2 __attribute__((ext_vector_type(2)));
typedef float f32x4 __attribute__((ext_vector_type(4)));
typedef float f32x16 __attribute__((ext_vector_type(16)));
typedef unsigned u32x2 __attribute__((ext_vector_type(2)));
typedef unsigned u32x4 __attribute__((ext_vector_type(4)));

constexpr int M_TOK = 16384, SEQ = 4096, NBATCH = 4, DM = 4096;
constexpr int AB_IN = 7752, AB_NP = 7936, C_IN = 7264, C_NP = 7424, FFH = 11008, GU_N = 22016;
constexpr float DN_ALPHA = 1.4142135623730951f;
constexpr float LN_EPS = 1e-5f, RMS_EPS = 1e-6f;
constexpr int AB_Q = 0, AB_K = 1024, AB_V = 2048, AB_IG = 4096, AB_FG = 4100, AB_OG = 4104, AB_CQ = 6152, AB_CKV = 7176, AB_KR = 7688;
constexpr int C_Q = 0, C_KC = 4096, C_VC = 4608, C_KS = 5120, C_VS = 5632, C_KW = 6144, C_VW = 6656, C_GATE = 7168;

__device__ __forceinline__ float bf2f(bf16_t b) { return __uint_as_float(((unsigned)b) << 16); }
__device__ __forceinline__ unsigned cvt_pk_bf16(float lo, float hi) { unsigned r; asm volatile("v_cvt_pk_bf16_f32 %0, %1, %2" : "=v"(r) : "v"(lo), "v"(hi)); return r; }
__device__ __forceinline__ bf16_t f2bf(float f) { return (bf16_t)(cvt_pk_bf16(f, 0.f) & 0xffffu); }
__device__ __forceinline__ void unpack8(const bf16x8 v, float (&f)[8]) {
#pragma unroll
    for (int j = 0; j < 8; ++j) f[j] = bf2f((bf16_t)v[j]);
}
__device__ __forceinline__ bf16x8 pack8f(const float (&f)[8]) {
    u32x4 w = {cvt_pk_bf16(f[0], f[1]), cvt_pk_bf16(f[2], f[3]), cvt_pk_bf16(f[4], f[5]), cvt_pk_bf16(f[6], f[7])};
    return *reinterpret_cast<bf16x8*>(&w);
}
typedef _Float16 f16x2_t __attribute__((ext_vector_type(2)));
__device__ __forceinline__ unsigned cvt_pk_f16(float lo, float hi) { const f16x2_t h = {(_Float16)lo, (_Float16)hi}; return __builtin_bit_cast(unsigned, h); }
__device__ __forceinline__ void unpack8h(const bf16x8 v, float (&f)[8]) {
#pragma unroll
    for (int j = 0; j < 8; ++j) f[j] = (float)__builtin_bit_cast(_Float16, (short)v[j]);
}
__device__ __forceinline__ bf16x8 pack8h(const float (&f)[8]) {
    u32x4 w = {cvt_pk_f16(f[0], f[1]), cvt_pk_f16(f[2], f[3]), cvt_pk_f16(f[4], f[5]), cvt_pk_f16(f[6], f[7])};
    return *reinterpret_cast<bf16x8*>(&w);
}
__device__ __forceinline__ float wave_sum(float v) {
#pragma unroll
    for (int o = 32; o >= 1; o >>= 1) v += __shfl_xor(v, o);
    return v;
}
__device__ __forceinline__ float sigmoid_f(float x) { return __builtin_amdgcn_rcpf(1.0f + __expf(-x)); }

#define XB_TMO      128
#define XB_XCNT(j)  (256  + 64 * (j))
#define XB_XSUB(j)  (1280 + 64 * (j))
#define XB_XGEN(j)  (2304 + 64 * (j))
#define XB_TOP      3328
#define XB_TOPGEN   3392
#define XCD_BAR_WORDS 3456
#define XB_SPIN_CAP (1u << 22)
#define LAS __attribute__((address_space(3)))

__device__ __forceinline__ unsigned xb_ld(unsigned* p)              { return __hip_atomic_load(p, __ATOMIC_RELAXED, __HIP_MEMORY_SCOPE_AGENT); }
__device__ __forceinline__ unsigned xb_add(unsigned* p, unsigned v) { return __hip_atomic_fetch_add(p, v, __ATOMIC_RELAXED, __HIP_MEMORY_SCOPE_AGENT); }
__device__ __forceinline__ unsigned xb_xcc_id() { return (unsigned)__builtin_amdgcn_s_getreg((3 << 11) | 20) & 0xFu; }
#define XB_SPIN(cond, bar) do { unsigned _sp = 0; while (cond) { __builtin_amdgcn_s_sleep(1); \
    if ((++_sp & 255u) == 0u) { if (xb_ld(&(bar)[XB_TMO])) break; if (_sp > XB_SPIN_CAP) { atomicAdd(&(bar)[XB_TMO], 1u); break; } } } } while (0)

struct XcdBarrier {
    unsigned* bar; unsigned x;
    volatile LAS unsigned* st;
};

__device__ __forceinline__ XcdBarrier xcd_barrier_post(unsigned* bar, volatile LAS unsigned* st) {
    XcdBarrier b; b.bar = bar; b.x = xb_xcc_id(); b.st = st;
    if (threadIdx.x == 0) (void)xb_add(&bar[XB_XCNT(b.x)], 1u);
    return b;
}
__device__ __forceinline__ void xcd_barrier_complete(unsigned* bar, unsigned x, unsigned& nloc, unsigned& nx) {
    const unsigned G = gridDim.x * gridDim.y * gridDim.z;
    unsigned sum, cnt, mine, sp = 0u;
    for (;;) {
        sum = 0u; cnt = 0u; mine = 0u;
#pragma unroll
        for (unsigned j = 0; j < 16; ++j) { const unsigned c = xb_ld(&bar[XB_XCNT(j)]); sum += c; cnt += (c > 0u) ? 1u : 0u; mine = (j == x) ? c : mine; }
        if (sum == G) break;
        __builtin_amdgcn_s_sleep(1);
        if ((++sp & 255u) == 0u) { if (xb_ld(&bar[XB_TMO])) break; if (sp > XB_SPIN_CAP) { atomicAdd(&bar[XB_TMO], 1u); break; } }
    }
    nloc = mine > 0u ? mine : 1u; nx = cnt > 0u ? cnt : 1u;
}

__device__ __forceinline__ void xcd_barrier(const XcdBarrier& b) {
    asm volatile("s_waitcnt vmcnt(0)" ::: "memory");
    __syncthreads();
    if (threadIdx.x == 0) {
        unsigned* bar = b.bar;
        __builtin_amdgcn_s_waitcnt(0);
        unsigned nloc = b.st[0], nx = b.st[1];
        if (nloc == 0u) { xcd_barrier_complete(bar, b.x, nloc, nx); b.st[0] = nloc; b.st[1] = nx; }
        const unsigned old = xb_add(&bar[XB_XSUB(b.x)], 1u);
        const unsigned gen = old / nloc;
        if (old + 1u == (gen + 1u) * nloc) {
            __builtin_amdgcn_fence(__ATOMIC_RELEASE, "agent");
            asm volatile("s_waitcnt vmcnt(0)" ::: "memory");
            const unsigned og = xb_add(&bar[XB_TOP], 1u);
            const unsigned tg = og / nx;
            if (og + 1u == (tg + 1u) * nx) xb_add(&bar[XB_TOPGEN], 1u);
            else XB_SPIN(xb_ld(&bar[XB_TOPGEN]) == tg, bar);
            __builtin_amdgcn_fence(__ATOMIC_ACQUIRE, "agent");
            xb_add(&bar[XB_XGEN(b.x)], 1u);
            asm volatile("s_waitcnt vmcnt(0)" ::: "memory");
        } else {
            XB_SPIN(xb_ld(&bar[XB_XGEN(b.x)]) == gen, bar);
            __builtin_amdgcn_fence(__ATOMIC_ACQUIRE, "agent");
            asm volatile("s_waitcnt vmcnt(0)" ::: "memory");
        }
    }
    __syncthreads();
}namespace pg8 {
#define PG8_LAS __attribute__((address_space(3)))
typedef unsigned short bf16_t;
typedef short bf16x8 __attribute__((ext_vector_type(8)));
typedef float f32x4 __attribute__((ext_vector_type(4)));
typedef unsigned u32x4 __attribute__((ext_vector_type(4)));
constexpr int BM = 256, BK = 64, HALF = 128, HTB = HALF * BK * 2  , STAGE_BYTES = 8 * HTB, NXCD = 8;

__host__ __device__ __forceinline__ int lds_byte(int r, int c) { const int st = (r >> 4) * 2 + (c >> 5), rr = r & 15, cc = c & 31, ob = rr * 64 + cc * 2; return st * 1024 + (ob ^ (((ob >> 9) & 1) << 5)); }
__host__ __device__ __forceinline__ void stage_rc(int b, int& R, int& C) { const int st = b / 1024, sb = b % 1024, swz = sb ^ (((sb >> 9) & 1) << 5); R = (st >> 1) * 16 + swz / 64; C = (st & 1) * 32 + (swz % 64) / 2; }
__host__ __device__ __forceinline__ int perm32(int rho) { const int n = rho >> 4, i = rho & 15; return 8 * (i >> 2) + 4 * n + (i & 3); }

struct Unit { int pm, pn; };
struct Gemm { const bf16_t* A; const bf16_t* Bt; int M, N, K; };

struct StaticOrder {
    int nM, nN, nwg, G, c, WGM = 8;
    __host__ __device__ void init(int M, int N, int G_, int c_) { nM = M / BM; nN = N / BM; nwg = nM * nN; G = G_; c = c_; }
    __host__ __device__ bool next(int i, Unit& u) const {
        const long L = (long)i * G + c; if (L >= nwg) return false;
        int wgid = (int)L; { const int q = nwg / NXCD, r = nwg % NXCD, xcd = wgid % NXCD, off = wgid / NXCD; wgid = (xcd < r ? xcd * (q + 1) : r * (q + 1) + (xcd - r) * q) + off; }
        const int nig = WGM * nN, gid = wgid / nig, fm = gid * WGM, gsz = (nM - fm) < WGM ? (nM - fm) : WGM;
        u.pm = fm + ((wgid % nig) % gsz); u.pn = (wgid % nig) / gsz; return true;
    }
    __device__ __forceinline__ void a_ready(const Unit&) const {}
    __device__ __forceinline__ void done(const Unit&) const {}
};
struct CountedOrder : StaticOrder {
    const unsigned* ready; unsigned need; unsigned* tmo;
    __device__ __forceinline__ void a_ready(const Unit& u) const {
        if (threadIdx.x < 64) {
            const unsigned long long t0 = __builtin_amdgcn_s_memrealtime(); unsigned polls = 0;
            while ((unsigned)__builtin_amdgcn_readfirstlane(__hip_atomic_load(ready + 64 * u.pm, __ATOMIC_RELAXED, __HIP_MEMORY_SCOPE_AGENT)) < need) {
                if ((++polls & 255u) == 0u && __builtin_amdgcn_readfirstlane(__hip_atomic_load(tmo, __ATOMIC_RELAXED, __HIP_MEMORY_SCOPE_AGENT)) != 0u) break;
                if (__builtin_amdgcn_s_memrealtime() - t0 > 2000000ull) {
                    if (threadIdx.x == 0) { unsigned expect = 0u; __hip_atomic_compare_exchange_strong(tmo + 1, &expect, 0x600u | (unsigned)(u.pm & 0xff), __ATOMIC_RELAXED, __ATOMIC_RELAXED, __HIP_MEMORY_SCOPE_AGENT); __hip_atomic_store(tmo, 1u, __ATOMIC_RELAXED, __HIP_MEMORY_SCOPE_AGENT); }
                    break; }
                __builtin_amdgcn_s_sleep(2); }
            __builtin_amdgcn_fence(__ATOMIC_ACQUIRE, "agent");
            asm volatile("s_waitcnt vmcnt(0)" ::: "memory");
        }
#if !defined(BROKEN_HOOK_NO_BARRIER)
        asm volatile("" ::: "memory"); __builtin_amdgcn_s_barrier(); asm volatile("" ::: "memory");
#endif
    }
};

__device__ __forceinline__ unsigned cvt_pk_bf16(float lo, float hi) { unsigned r; asm volatile("v_cvt_pk_bf16_f32 %0, %1, %2" : "=v"(r) : "v"(lo), "v"(hi)); return r; }
typedef float f32x2 __attribute__((ext_vector_type(2)));
__device__ __forceinline__ f32x2 gelu_pk(f32x2 v) {
    const f32x2 av = __builtin_elementwise_abs(v), d = av * 0.2316418882f + 1.0f;
    f32x2 t; t.x = __builtin_amdgcn_rcpf(d.x); t.y = __builtin_amdgcn_rcpf(d.y);
    f32x2 q = t * 0.5307027145f + (-0.7265760135f); q = q * t + 0.7107068705f; q = q * t + (-0.142248368f); q = q * t + 0.127414796f; q = q * t;
    const f32x2 s = (v * v) * (-0.72134752044f);
    f32x2 e; e.x = __builtin_amdgcn_exp2f(s.x); e.y = __builtin_amdgcn_exp2f(s.y);
    const f32x2 m = v * (q * e), r = v - m;
    f32x2 o; o.x = v.x < 0.f ? m.x : r.x; o.y = v.y < 0.f ? m.y : r.y; return o;
}

struct EpiF32 {
    static constexpr bool PERM = false, AFTER_DRAIN = false, PREFETCH = false;
    float* C; int ldc; const float* bias;
    __device__ __forceinline__ void operator()(const f32x4 (&acc)[2][2][4][2], const Unit& u, int wr, int wc, int fr, int fq) const {
        const int row0 = u.pm * BM + wr * 64 + fr, col0 = u.pn * BM + wc * 32 + 4 * fq;
        f32x4 bv[2][2];
#pragma unroll
        for (int bj = 0; bj < 2; ++bj)
#pragma unroll
            for (int n = 0; n < 2; ++n) bv[bj][n] = bias ? *(const f32x4*)(bias + col0 + bj * HALF + n * 16) : (f32x4){0.f, 0.f, 0.f, 0.f};
#pragma unroll
        for (int ai = 0; ai < 2; ++ai)
#pragma unroll
            for (int m = 0; m < 4; ++m) { float* rowp = C + (size_t)(row0 + ai * HALF + m * 16) * ldc + col0;
#pragma unroll
                for (int bj = 0; bj < 2; ++bj)
#pragma unroll
                    for (int n = 0; n < 2; ++n) *(f32x4*)(rowp + bj * HALF + n * 16) = acc[ai][bj][m][n] + bv[bj][n]; }
    }
};
template <int ACT  > struct EpiBf16 {
    static constexpr bool PERM = true, AFTER_DRAIN = false, PREFETCH = false;
    bf16_t* O; int ldc; const float* bias; int split_cols; size_t split_stride;
    __device__ __forceinline__ void operator()(const f32x4 (&acc)[2][2][4][2], const Unit& u, int wr, int wc, int fr, int fq) const {
        const int row0 = u.pm * BM + wr * 64 + fr; int colt = u.pn * BM; bf16_t* base = O;
        if (split_cols) { const int t = colt / split_cols; base += (size_t)t * split_stride; colt -= t * split_cols; }
        const int col0 = colt + wc * 32 + 8 * fq, bcol0 = u.pn * BM + wc * 32 + 8 * fq;
        f32x4 bv[2][2];
#pragma unroll
        for (int bj = 0; bj < 2; ++bj)
#pragma unroll
            for (int n = 0; n < 2; ++n) bv[bj][n] = bias ? *(const f32x4*)(bias + bcol0 + bj * HALF + 4 * n) : (f32x4){0.f, 0.f, 0.f, 0.f};
#pragma unroll
        for (int ai = 0; ai < 2; ++ai)
#pragma unroll
            for (int m = 0; m < 4; ++m) { bf16_t* rowp = base + (size_t)(row0 + ai * HALF + m * 16) * ldc + col0;
#pragma unroll
                for (int bj = 0; bj < 2; ++bj) { f32x4 v0 = acc[ai][bj][m][0] + bv[bj][0], v1 = acc[ai][bj][m][1] + bv[bj][1];
                    if (ACT == 1) { f32x2 a = gelu_pk((f32x2){v0[0], v0[1]}), b = gelu_pk((f32x2){v0[2], v0[3]}), c = gelu_pk((f32x2){v1[0], v1[1]}), d = gelu_pk((f32x2){v1[2], v1[3]});
                        v0 = (f32x4){a.x, a.y, b.x, b.y}; v1 = (f32x4){c.x, c.y, d.x, d.y}; }
                    if (ACT == 2) {
#pragma unroll
                        for (int j = 0; j < 4; ++j) { v0[j] = 0.5f * v0[j] * (1.0f + erff(v0[j] * 0.70710678f)); v1[j] = 0.5f * v1[j] * (1.0f + erff(v1[j] * 0.70710678f)); } }
                    u32x4 w; w.x = cvt_pk_bf16(v0[0], v0[1]); w.y = cvt_pk_bf16(v0[2], v0[3]); w.z = cvt_pk_bf16(v1[0], v1[1]); w.w = cvt_pk_bf16(v1[2], v1[3]);
                    *(u32x4*)(rowp + bj * HALF) = w; } }
    }
};
#ifndef EPI_PREFETCH
#define EPI_PREFETCH false
#endif
#ifndef EPI_PF_TILES
#define EPI_PF_TILES 16
#endif
__device__ __forceinline__ float silu_f(float g) { return g * __builtin_amdgcn_rcpf(1.0f + __expf(-g)); }
__device__ __forceinline__ float gelu_tanh_f(float x) { const float y = 0.7978845608028654f * (x + 0.044715f * x * x * x); const float e = __expf(2.0f * y); const float t = 1.0f - 2.0f * __builtin_amdgcn_rcpf(e + 1.0f); return 0.5f * x * (1.0f + t); }
template <int ACT> struct EpiB {
    static constexpr bool PERM = true, AFTER_DRAIN = false, PREFETCH = false;
    bf16_t* O; int ldc;
    __device__ __forceinline__ void operator()(const f32x4 (&acc)[2][2][4][2], const Unit& u, int wr, int wc, int fr, int fq) const {
        const int row0 = u.pm * BM + wr * 64 + fr, col0 = u.pn * BM + wc * 32 + 8 * fq;
        float one = 1.0f; asm volatile("" : "+v"(one));
#pragma unroll
        for (int ai = 0; ai < 2; ++ai)
#pragma unroll
            for (int m = 0; m < 4; ++m) { bf16_t* rowp = O + (size_t)(row0 + ai * HALF + m * 16) * ldc + col0;
#pragma unroll
                for (int bj = 0; bj < 2; ++bj) { f32x4 v0 = acc[ai][bj][m][0] * one, v1 = acc[ai][bj][m][1] * one;
                    if (ACT == 1) {
#pragma unroll
                        for (int j = 0; j < 4; ++j) { v0[j] = gelu_tanh_f(v0[j]); v1[j] = gelu_tanh_f(v1[j]); } }
                    u32x4 w; w.x = cvt_pk_bf16(v0[0], v0[1]); w.y = cvt_pk_bf16(v0[2], v0[3]); w.z = cvt_pk_bf16(v1[0], v1[1]); w.w = cvt_pk_bf16(v1[2], v1[3]);
                    *(u32x4*)(rowp + bj * HALF) = w; } }
    }
};
struct EpiProj {
    static constexpr bool PERM = true, AFTER_DRAIN = false, PREFETCH = false;
    bf16_t* O; int ldc; float* gates; int gate_pn;
    __device__ __forceinline__ void operator()(const f32x4 (&acc)[2][2][4][2], const Unit& u, int wr, int wc, int fr, int fq) const {
        const int row0 = u.pm * BM + wr * 64 + fr, col0 = u.pn * BM + wc * 32 + 8 * fq;
        float one = 1.0f; asm volatile("" : "+v"(one));
#pragma unroll
        for (int ai = 0; ai < 2; ++ai)
#pragma unroll
            for (int m = 0; m < 4; ++m) { bf16_t* rowp = O + (size_t)(row0 + ai * HALF + m * 16) * ldc + col0;
#pragma unroll
                for (int bj = 0; bj < 2; ++bj) { const f32x4 v0 = acc[ai][bj][m][0] * one, v1 = acc[ai][bj][m][1] * one;
                    u32x4 w; w.x = cvt_pk_bf16(v0[0], v0[1]); w.y = cvt_pk_bf16(v0[2], v0[3]); w.z = cvt_pk_bf16(v1[0], v1[1]); w.w = cvt_pk_bf16(v1[2], v1[3]);
                    *(u32x4*)(rowp + bj * HALF) = w; } }
        if (u.pn == gate_pn && wc == 0 && fq == 0) {
#pragma unroll
            for (int ai = 0; ai < 2; ++ai)
#pragma unroll
                for (int m = 0; m < 4; ++m) { float* g = gates + (size_t)(row0 + ai * HALF + m * 16) * 8;
                    *(f32x4*)g = acc[ai][0][m][0]; *(f32x4*)(g + 4) = acc[ai][0][m][1]; }
        }
    }
};
struct EpiSwiGLU {
    static constexpr bool PERM = true, AFTER_DRAIN = false, PREFETCH = false;
    bf16_t* H; int ldh;
    __device__ __forceinline__ void operator()(const f32x4 (&acc)[2][2][4][2], const Unit& u, int wr, int wc, int fr, int fq) const {
        const int row0 = u.pm * BM + wr * 64 + fr, col0 = u.pn * HALF + wc * 32 + 8 * fq;
#pragma unroll
        for (int ai = 0; ai < 2; ++ai)
#pragma unroll
            for (int m = 0; m < 4; ++m) { bf16_t* rowp = H + (size_t)(row0 + ai * HALF + m * 16) * ldh + col0;
                const f32x4 g0 = acc[ai][0][m][0], g1 = acc[ai][0][m][1], u0 = acc[ai][1][m][0], u1 = acc[ai][1][m][1];
                float h[8];
#pragma unroll
                for (int j = 0; j < 4; ++j) { h[j] = silu_f(g0[j]) * u0[j]; h[4 + j] = silu_f(g1[j]) * u1[j]; }
                u32x4 w; w.x = cvt_pk_bf16(h[0], h[1]); w.y = cvt_pk_bf16(h[2], h[3]); w.z = cvt_pk_bf16(h[4], h[5]); w.w = cvt_pk_bf16(h[6], h[7]);
                *(u32x4*)rowp = w; }
    }
};
struct EpiResid {
    static constexpr bool PERM = false, AFTER_DRAIN = false, PREFETCH = false;
    float* C; const float* R; int ldc; float alpha;
    __device__ __forceinline__ void operator()(const f32x4 (&acc)[2][2][4][2], const Unit& u, int wr, int wc, int fr, int fq) const {
        const int row0 = u.pm * BM + wr * 64 + fr, col0 = u.pn * BM + wc * 32 + 4 * fq;
#pragma unroll
        for (int ai = 0; ai < 2; ++ai) {
            f32x4 r[4][2][2];
#pragma unroll
            for (int m = 0; m < 4; ++m) { const size_t off = (size_t)(row0 + ai * HALF + m * 16) * ldc + col0;
#pragma unroll
                for (int bj = 0; bj < 2; ++bj)
#pragma unroll
                    for (int n = 0; n < 2; ++n) r[m][bj][n] = *(const f32x4*)(R + off + bj * HALF + n * 16); }
            asm volatile("" ::: "memory");
#pragma unroll
            for (int m = 0; m < 4; ++m) { const size_t off = (size_t)(row0 + ai * HALF + m * 16) * ldc + col0;
#pragma unroll
                for (int bj = 0; bj < 2; ++bj)
#pragma unroll
                    for (int n = 0; n < 2; ++n) *(f32x4*)(C + off + bj * HALF + n * 16) = acc[ai][bj][m][n] + alpha * r[m][bj][n]; }
            asm volatile("" ::: "memory");
        }
    }
};
struct EpiResidLN {
    static constexpr bool PERM = false, AFTER_DRAIN = false, PREFETCH = false;
    float* C; const float* Zp; const f32x2* st; const float* g; const float* b; int ldc; float alpha;
    __device__ __forceinline__ void operator()(const f32x4 (&acc)[2][2][4][2], const Unit& u, int wr, int wc, int fr, int fq) const {
        const int row0 = u.pm * BM + wr * 64 + fr, col0 = u.pn * BM + wc * 32 + 4 * fq;
#pragma unroll
        for (int bj = 0; bj < 2; ++bj)
#pragma unroll
            for (int n = 0; n < 2; ++n) {
                const int cc = col0 + bj * HALF + n * 16;
                const f32x4 gv = *(const f32x4*)(g + cc) * alpha, bv = *(const f32x4*)(b + cc) * alpha;
                f32x4 r[2][4]; f32x2 ms[2][4];
#pragma unroll
                for (int ai = 0; ai < 2; ++ai)
#pragma unroll
                    for (int m = 0; m < 4; ++m) { const int row = row0 + ai * HALF + m * 16; ms[ai][m] = st[row]; r[ai][m] = *(const f32x4*)(Zp + (size_t)row * ldc + cc); }
                asm volatile("" ::: "memory");
#pragma unroll
                for (int ai = 0; ai < 2; ++ai)
#pragma unroll
                    for (int m = 0; m < 4; ++m) { const int row = row0 + ai * HALF + m * 16;
                        *(f32x4*)(C + (size_t)row * ldc + cc) = acc[ai][bj][m][n] + ((r[ai][m] - ms[ai][m].x) * ms[ai][m].y) * gv + bv; }
                asm volatile("" ::: "memory");
            }
    }
};
struct EpiResidB {
    static constexpr bool PERM = true, AFTER_DRAIN = false, PREFETCH = EPI_PREFETCH;
    bf16_t* C; const bf16_t* R;
    __device__ __forceinline__ void prefetch(const Unit& u, PG8_LAS unsigned char* dummy, int wid, int lane) const {
#pragma unroll
        for (int i = 0; i < 2; ++i) { const int L = wid * 128 + i * 64 + lane;
            __builtin_amdgcn_global_load_lds((const unsigned*)((const char*)R + (unsigned)((u.pm * BM + (L >> 2)) * DM + u.pn * BM + (L & 3) * 64) * 2u), (PG8_LAS unsigned*)dummy, 4, 0, 0); }
    }
    __device__ __forceinline__ void operator()(const f32x4 (&acc)[2][2][4][2], const Unit& u, int wr, int wc, int fr, int fq) const {
        const int row0 = u.pm * BM + wr * 64 + fr, col0 = u.pn * BM + wc * 32 + 8 * fq;
#pragma unroll
        for (int ai = 0; ai < 2; ++ai) {
            bf16x8 r[4][2];
#pragma unroll
            for (int m = 0; m < 4; ++m)
#pragma unroll
                for (int bj = 0; bj < 2; ++bj) r[m][bj] = *(const bf16x8*)((const char*)R + (unsigned)((row0 + ai * HALF + m * 16) * DM + col0 + bj * HALF) * 2u);
            asm volatile("" ::: "memory");
#pragma unroll
            for (int m = 0; m < 4; ++m)
#pragma unroll
                for (int bj = 0; bj < 2; ++bj) { float x[8]; unpack8(r[m][bj], x);
                    const f32x4 a0 = acc[ai][bj][m][0], a1 = acc[ai][bj][m][1];
                    float v[8];
#pragma unroll
                    for (int j = 0; j < 4; ++j) { v[j] = a0[j] + DN_ALPHA * x[j]; v[4 + j] = a1[j] + DN_ALPHA * x[4 + j]; }
                    *(bf16x8*)((char*)C + (unsigned)((row0 + ai * HALF + m * 16) * DM + col0 + bj * HALF) * 2u) = pack8h(v); }
            asm volatile("" ::: "memory");
        }
    }
};
struct EpiResidLNB {
    static constexpr bool PERM = true, AFTER_DRAIN = false, PREFETCH = EPI_PREFETCH;
    bf16_t* C; const bf16_t* Zp; const f32x2* st; const float* g; const float* b;
    __device__ __forceinline__ void prefetch(const Unit& u, PG8_LAS unsigned char* dummy, int wid, int lane) const {
#pragma unroll
        for (int i = 0; i < 2; ++i) { const int L = wid * 128 + i * 64 + lane;
            __builtin_amdgcn_global_load_lds((const unsigned*)((const char*)Zp + (unsigned)((u.pm * BM + (L >> 2)) * DM + u.pn * BM + (L & 3) * 64) * 2u), (PG8_LAS unsigned*)dummy, 4, 0, 0); }
    }
    __device__ __forceinline__ void operator()(const f32x4 (&acc)[2][2][4][2], const Unit& u, int wr, int wc, int fr, int fq) const {
        const int row0 = u.pm * BM + wr * 64 + fr, col0 = u.pn * BM + wc * 32 + 8 * fq;
#pragma unroll
        for (int bj = 0; bj < 2; ++bj) {
            const int cc = col0 + bj * HALF;
            const f32x4 g0 = *(const f32x4*)(g + cc) * DN_ALPHA, g1 = *(const f32x4*)(g + cc + 4) * DN_ALPHA, b0 = *(const f32x4*)(b + cc) * DN_ALPHA, b1 = *(const f32x4*)(b + cc + 4) * DN_ALPHA;
            bf16x8 r[2][4]; f32x2 ms[2][4];
#pragma unroll
            for (int ai = 0; ai < 2; ++ai)
#pragma unroll
                for (int m = 0; m < 4; ++m) { const int row = row0 + ai * HALF + m * 16; ms[ai][m] = *(const f32x2*)((const char*)st + (unsigned)row * 8u); r[ai][m] = *(const bf16x8*)((const char*)Zp + (unsigned)(row * DM + cc) * 2u); }
            asm volatile("" ::: "memory");
#pragma unroll
            for (int ai = 0; ai < 2; ++ai)
#pragma unroll
                for (int m = 0; m < 4; ++m) { const int row = row0 + ai * HALF + m * 16; float x[8]; unpack8h(r[ai][m], x);
                    const f32x4 a0 = acc[ai][bj][m][0], a1 = acc[ai][bj][m][1]; const float mu = ms[ai][m].x, rs = ms[ai][m].y;
                    float v[8];
#pragma unroll
                    for (int j = 0; j < 4; ++j) { v[j] = a0[j] + (((x[j] - mu) * rs) * g0[j] + b0[j]); v[4 + j] = a1[j] + (((x[4 + j] - mu) * rs) * g1[j] + b1[j]); }
                    *(bf16x8*)((char*)C + (unsigned)(row * DM + cc) * 2u) = pack8h(v); __builtin_amdgcn_sched_barrier(0); }
            asm volatile("" ::: "memory");
        }
    }
};
template <class Epi, class Sched, bool ALIGN_EPI = false, bool SP2 = false>
__device__ __forceinline__ void gemm_phase(PG8_LAS unsigned char* lds, const Gemm g, const Sched& S, const Epi& E) {
    const int tid = threadIdx.x, wid = __builtin_amdgcn_readfirstlane(tid >> 6), lane = tid & 63, wr = wid >> 2, wc = wid & 3, fr = lane & 15, fq = lane >> 4;
    const int K = g.K, nt = K / BK;
    unsigned voffA[2], voffB[2];
#pragma unroll
    for (int i = 0; i < 2; ++i) { int R, C; stage_rc(tid * 16 + i * 8192, R, C); const int Rb = Epi::PERM ? ((R & ~31) + perm32(R & 31)) : R;
        voffA[i] = (unsigned)(R * K + C) * 2u; voffB[i] = (unsigned)(Rb * K + C) * 2u; }
    const size_t kstep = (size_t)(BK * 2);
    const size_t hstep = (size_t)HALF * K * 2;
    const size_t tstep = 2 * hstep;
    const unsigned ldsw = (unsigned)wid * 1024u;
    const int aoff = lds_byte(wr * 64 + fr, fq * 8), boff = lds_byte(wc * 32 + fr, fq * 8);
#define PG8_SA(b, h) (((b) * 2 + (h)) * HTB)
#define PG8_SB(b, h) ((4 + (b) * 2 + (h)) * HTB)
#define PG8_STAGE(bufoff, gbase, voff) do { _Pragma("unroll") for (int _i = 0; _i < 2; ++_i) \
        __builtin_amdgcn_global_load_lds((const unsigned*)((const char*)(gbase) + (voff)[_i]), (PG8_LAS unsigned*)(lds + (bufoff) + ldsw + _i * 8192), 16, 0, 0); } while (0)
#define PG8_LDA(dst, b, h) do { _Pragma("unroll") for (int m = 0; m < 4; ++m) _Pragma("unroll") for (int k = 0; k < 2; ++k) dst[m][k] = *(const PG8_LAS bf16x8*)(lds + PG8_SA(b, h) + aoff + m * 2048 + k * 1024); } while (0)
#define PG8_LDB(dst, b, h) do { _Pragma("unroll") for (int n = 0; n < 2; ++n) _Pragma("unroll") for (int k = 0; k < 2; ++k) dst[n][k] = *(const PG8_LAS bf16x8*)(lds + PG8_SB(b, h) + boff + n * 2048 + k * 1024); } while (0)
#define PG8_MMA(ai, bj, At, Bt) do { __builtin_amdgcn_s_setprio(1); _Pragma("unroll") for (int m = 0; m < 4; ++m) _Pragma("unroll") for (int n = 0; n < 2; ++n) _Pragma("unroll") for (int k = 0; k < 2; ++k) \
        acc[ai][bj][m][n] = __builtin_amdgcn_mfma_f32_16x16x32_bf16(Bt[n][k], At[m][k], acc[ai][bj][m][n], 0, 0, 0); __builtin_amdgcn_s_setprio(0); } while (0)
#define PG8_WAIT_V(n) asm volatile("s_waitcnt vmcnt(" #n ")" ::: "memory")
#define PG8_WAIT_L(n) asm volatile("s_waitcnt lgkmcnt(" #n ")" ::: "memory")
#define PG8_BAR __builtin_amdgcn_s_barrier()
#define PG8_SCHED __builtin_amdgcn_sched_barrier(0)
    Unit cur, nxt; int ui = 0;
    if (!S.next(0, cur)) return;
    f32x4 acc[2][2][4][2];
#pragma unroll
    for (int a = 0; a < 2; ++a)
#pragma unroll
        for (int b = 0; b < 2; ++b)
#pragma unroll
            for (int m = 0; m < 4; ++m)
#pragma unroll
                for (int n = 0; n < 2; ++n) acc[a][b][m][n] = (f32x4){0.f, 0.f, 0.f, 0.f};
    bf16x8 At[4][2], B0[2][2], B1[2][2];
    const char* cA = (const char*)g.A + (size_t)cur.pm * tstep; const char* cB = (const char*)g.Bt + (size_t)cur.pn * tstep;
    S.a_ready(cur);
    if constexpr (SP2) {
        PG8_STAGE(PG8_SB(0, 0), cB, voffB); PG8_STAGE(PG8_SB(0, 1), cB + hstep, voffB); PG8_STAGE(PG8_SA(0, 0), cA, voffA); PG8_STAGE(PG8_SA(0, 1), cA + hstep, voffA);
        if (wr == 1) PG8_BAR;
        PG8_WAIT_V(2); PG8_BAR;
        PG8_STAGE(PG8_SB(1, 0), cB + kstep, voffB); PG8_STAGE(PG8_SA(1, 0), cA + kstep, voffA); PG8_STAGE(PG8_SB(1, 1), cB + hstep + kstep, voffB);
        PG8_WAIT_V(6); PG8_BAR;
    } else {
        PG8_STAGE(PG8_SB(0, 0), cB, voffB); PG8_STAGE(PG8_SA(0, 0), cA, voffA); PG8_STAGE(PG8_SB(0, 1), cB + hstep, voffB); PG8_STAGE(PG8_SA(0, 1), cA + hstep, voffA);
        if (wr == 1) PG8_BAR;
        PG8_WAIT_V(4); PG8_BAR;
        PG8_STAGE(PG8_SB(1, 0), cB + kstep, voffB); PG8_STAGE(PG8_SA(1, 0), cA + kstep, voffA); PG8_STAGE(PG8_SB(1, 1), cB + hstep + kstep, voffB);
        PG8_WAIT_V(6); PG8_BAR;
    }
    for (;;) {
        const bool has_next = S.next(ui + 1, nxt);
        const char* nA = has_next ? (const char*)g.A + (size_t)nxt.pm * tstep : cA; const char* nB = has_next ? (const char*)g.Bt + (size_t)nxt.pn * tstep : cB;
        for (int t = 0; t < nt; t += 2) {
            const bool last = (t == nt - 2);
            const char* a1 = cA + (size_t)(t + 1) * kstep;
            const char* a2 = last ? nA : cA + (size_t)(t + 2) * kstep; const char* b2 = last ? nB : cB + (size_t)(t + 2) * kstep;
            const char* a3 = a2 + kstep; const char* b3 = b2 + kstep;
            if (last && has_next) S.a_ready(nxt);
            if constexpr (Epi::PREFETCH) { if (t == nt - EPI_PF_TILES) E.prefetch(cur, lds + STAGE_BYTES + wid * 256, wid, lane); }
            if constexpr (SP2) {
            PG8_LDB(B0, 0, 0); PG8_LDB(B1, 0, 1); PG8_SCHED; PG8_LDA(At, 0, 0); PG8_STAGE(PG8_SA(1, 1), a1 + hstep, voffA);
            PG8_WAIT_V(8); PG8_WAIT_L(0); PG8_BAR; PG8_MMA(0, 0, At, B0); PG8_MMA(0, 1, At, B1); PG8_BAR; PG8_SCHED;
            PG8_LDA(At, 0, 1); PG8_STAGE(PG8_SB(0, 0), b2, voffB); PG8_STAGE(PG8_SB(0, 1), b2 + hstep, voffB); PG8_STAGE(PG8_SA(0, 0), a2, voffA);
            PG8_WAIT_V(8); PG8_WAIT_L(0); PG8_BAR; PG8_MMA(1, 0, At, B0); PG8_MMA(1, 1, At, B1); PG8_BAR; PG8_SCHED;
            PG8_LDB(B0, 1, 0); PG8_LDB(B1, 1, 1); PG8_SCHED; PG8_LDA(At, 1, 0); PG8_STAGE(PG8_SA(0, 1), a2 + hstep, voffA);
            PG8_WAIT_V(8); PG8_WAIT_L(0); PG8_BAR; PG8_MMA(0, 0, At, B0); PG8_MMA(0, 1, At, B1); PG8_BAR; PG8_SCHED;
            PG8_LDA(At, 1, 1); PG8_STAGE(PG8_SB(1, 0), b3, voffB); PG8_STAGE(PG8_SB(1, 1), b3 + hstep, voffB); PG8_STAGE(PG8_SA(1, 0), a3, voffA);
            PG8_WAIT_V(8); PG8_WAIT_L(0); PG8_BAR; PG8_MMA(1, 0, At, B0); PG8_MMA(1, 1, At, B1); PG8_BAR; PG8_SCHED;
            } else {
            PG8_LDB(B0, 0, 0); PG8_SCHED; PG8_LDA(At, 0, 0); PG8_STAGE(PG8_SA(1, 1), a1 + hstep, voffA);
            PG8_WAIT_L(8); PG8_BAR; PG8_WAIT_L(0); PG8_MMA(0, 0, At, B0); PG8_BAR; PG8_SCHED;
            PG8_LDB(B1, 0, 1); PG8_STAGE(PG8_SB(0, 0), b2, voffB);
            PG8_BAR; PG8_WAIT_L(0); PG8_MMA(0, 1, At, B1); PG8_BAR;
            PG8_LDA(At, 0, 1); PG8_STAGE(PG8_SA(0, 0), a2, voffA);
            PG8_BAR; PG8_WAIT_L(0); PG8_MMA(1, 0, At, B0); PG8_BAR; PG8_SCHED;
            PG8_STAGE(PG8_SB(0, 1), b2 + hstep, voffB);
            PG8_WAIT_V(6); PG8_BAR; PG8_MMA(1, 1, At, B1); PG8_BAR;
            PG8_LDB(B0, 1, 0); PG8_SCHED; PG8_LDA(At, 1, 0); PG8_STAGE(PG8_SA(0, 1), a2 + hstep, voffA);
            PG8_WAIT_L(8); PG8_BAR; PG8_WAIT_L(0); PG8_MMA(0, 0, At, B0); PG8_BAR; PG8_SCHED;
            PG8_LDB(B1, 1, 1); PG8_STAGE(PG8_SB(1, 0), b3, voffB);
            PG8_BAR; PG8_WAIT_L(0); PG8_MMA(0, 1, At, B1); PG8_BAR;
            PG8_LDA(At, 1, 1); PG8_STAGE(PG8_SA(1, 0), a3, voffA);
            PG8_BAR; PG8_WAIT_L(0); PG8_MMA(1, 0, At, B0); PG8_BAR; PG8_SCHED;
            PG8_STAGE(PG8_SB(1, 1), b3 + hstep, voffB);
            PG8_WAIT_V(6); PG8_BAR; PG8_MMA(1, 1, At, B1); PG8_BAR;
            }
        }
        if constexpr (ALIGN_EPI) { if (wr == 0) PG8_BAR; }
        if constexpr (!Epi::AFTER_DRAIN) { E(acc, cur, wr, wc, fr, fq); S.done(cur); }
        if (!has_next) break;
#pragma unroll
        for (int a = 0; a < 2; ++a)
#pragma unroll
            for (int b = 0; b < 2; ++b)
#pragma unroll
                for (int m = 0; m < 4; ++m)
#pragma unroll
                    for (int n = 0; n < 2; ++n) acc[a][b][m][n] = (f32x4){0.f, 0.f, 0.f, 0.f};
        cur = nxt; cA = nA; cB = nB; ++ui;
        if constexpr (ALIGN_EPI) { if (wr == 1) PG8_BAR; }
    }
    PG8_WAIT_V(0);
    if constexpr (!ALIGN_EPI) { if (wr == 0) PG8_BAR; }
    PG8_BAR;
    if constexpr (Epi::AFTER_DRAIN) { E.fused(acc, cur, wr, wc, fr, fq, lds, wid, lane); S.done(cur); }
#undef PG8_SA
#undef PG8_SB
#undef PG8_STAGE
#undef PG8_LDA
#undef PG8_LDB
#undef PG8_MMA
#undef PG8_WAIT_V
#undef PG8_WAIT_L
#undef PG8_BAR
#undef PG8_SCHED
}
}
namespace fa {
constexpr int KVBLK = 64, SHM_V = 16384, SHM_K = 16384, SHM_KR = 8192;
constexpr int OFF_V = 0, OFF_K = 2 * SHM_V, OFF_KR = OFF_K + 2 * SHM_K, OFF_WS = OFF_KR + 2 * SHM_KR, OFF_IMP = OFF_WS + 8 * 64 * 4, IMP_LD = 257, OFF_QPARK = OFF_IMP + 32 * IMP_LD * 4 + 128  , LDS_END = OFF_QPARK + 8 * 4096;
#define KSWZ(row, colB) ((row) * 256 + ((colB) ^ (((row) & 7) << 4)))
#define KSWZ16(row, colB) ((row) * 256 + ((colB) ^ (((row) & 15) << 4)))
#define SBAR() __builtin_amdgcn_sched_barrier(0)
__device__ __forceinline__ int v_st(int k, int c) { const int kk = (k & ~0xC) | ((k & 4) << 1) | ((k & 8) >> 1); return ((kk >> 3) * 4 + (c >> 5)) * 512 + ((kk & 7) * 32 + (c & 31)) * 2; }
__device__ __forceinline__ int v_rd_base(int lane) { return ((lane & 3) << 3) | (((lane >> 2) & 3) << 6) | (((lane >> 4) & 1) << 5) | (((lane >> 5) & 1) << 8); }
constexpr int v_rd_off(int d0, int ks, int half) { return d0 * 512 + ks * 4096 + half * 2048; }
__device__ __forceinline__ int crow(int r, int hi) { return (r & 3) + 8 * (r >> 2) + 4 * hi; }
__device__ __forceinline__ unsigned cvtpk(float lo, float hi) { unsigned r; asm volatile("v_cvt_pk_bf16_f32 %0, %1, %2" : "=v"(r) : "v"(lo), "v"(hi)); return r; }
__device__ __forceinline__ bf16x8 pack8(f32x4 a, f32x4 b) { u32x4 w = {cvtpk(a[0], a[1]), cvtpk(a[2], a[3]), cvtpk(b[0], b[1]), cvtpk(b[2], b[3])}; return *reinterpret_cast<bf16x8*>(&w); }
__device__ __forceinline__ void mask_tile(f32x16& p0, f32x16& p1, int dq, unsigned W) {
    const float NEG = -__builtin_inff();
#pragma unroll
    for (int r = 0; r < 16; ++r) {
        const int c = (r & 3) + 8 * (r >> 2);
        if ((unsigned)(dq - c) >= W) p0[r] = NEG;
        if ((unsigned)(dq - c - 32) >= W) p1[r] = NEG;
    }
}
__device__ __forceinline__ void mask_all(f32x16& p0, f32x16& p1, bool kill) {
    const float NEG = -__builtin_inff();
#pragma unroll
    for (int r = 0; r < 16; ++r) { if (kill) { p0[r] = NEG; p1[r] = NEG; } }
}
__device__ __forceinline__ void partialSM(f32x16& p0, f32x16& p1, float& m_reg, float& mn, float& alpha, float scale, float C2, bool kill = false) {
    float pmax = p0[0];
#pragma unroll
    for (int r = 1; r < 16; ++r) pmax = fmaxf(pmax, p0[r]);
#pragma unroll
    for (int r = 0; r < 16; ++r) pmax = fmaxf(pmax, p1[r]);
    { auto rr = __builtin_amdgcn_permlane32_swap(__float_as_uint(pmax), __float_as_uint(pmax), false, false);
      pmax = fmaxf(__uint_as_float(rr[0]), __uint_as_float(rr[1])); }
    if (__builtin_expect(__all((pmax - m_reg) * scale <= 8.0f), 1)) { mn = m_reg; alpha = 1.f; }
    else { mn = fmaxf(m_reg, pmax); alpha = __builtin_amdgcn_exp2f((m_reg - mn) * C2); m_reg = mn; }
    const float mnL = kill ? -__builtin_inff() : -mn * C2;
#pragma unroll
    for (int r = 0; r < 16; ++r) p0[r] = fmaf(p0[r], C2, mnL);
#pragma unroll
    for (int r = 0; r < 16; ++r) p1[r] = fmaf(p1[r], C2, mnL);
#pragma unroll
    for (int r = 0; r < 16; ++r) p0[r] = __builtin_amdgcn_exp2f(p0[r]);
}
__device__ __forceinline__ void finishSM(f32x16& p0, f32x16& p1, float alpha, float& l_reg, bf16x8& pa0, bf16x8& pa1, bf16x8& pa2, bf16x8& pa3) {
#pragma unroll
    for (int r = 0; r < 16; ++r) p1[r] = __builtin_amdgcn_exp2f(p1[r]);
    float ps = 0;
#pragma unroll
    for (int r = 0; r < 16; ++r) ps += p0[r];
#pragma unroll
    for (int r = 0; r < 16; ++r) ps += p1[r];
    { auto rr = __builtin_amdgcn_permlane32_swap(__float_as_uint(ps), __float_as_uint(ps), false, false);
      ps = __uint_as_float(rr[0]) + __uint_as_float(rr[1]); }
    l_reg = l_reg * alpha + ps;
#define PK4(P, B_, OUT) do { unsigned a0 = cvtpk(P[B_+0], P[B_+1]), a1 = cvtpk(P[B_+2], P[B_+3]);                          \
        unsigned b0 = cvtpk(P[B_+4], P[B_+5]), b1 = cvtpk(P[B_+6], P[B_+7]);                                             \
        auto r0 = __builtin_amdgcn_permlane32_swap(a0, b0, false, false); auto r1 = __builtin_amdgcn_permlane32_swap(a1, b1, false, false); \
        u32x4 w = {r0[0], r1[0], r0[1], r1[1]}; OUT = *reinterpret_cast<bf16x8*>(&w); } while (0)
    PK4(p0, 0, pa0); PK4(p0, 8, pa1); PK4(p1, 0, pa2); PK4(p1, 8, pa3);
#undef PK4
}
template <int KB, bool ROPE, bool LIGHT = false>
__device__ __forceinline__ void qkt(f32x16& p0, f32x16& p1, const char* lds, int r32, int hi, const bf16x8* qr, const char* qpark = nullptr) {
    p0 = f32x16{}; p1 = f32x16{};
    const char* K_lds = lds + OFF_K;
    const char* kb[4];
#pragma unroll
    for (int dd = 0; dd < 4; ++dd) kb[dd] = K_lds + KB * SHM_K + KSWZ(r32, (dd * 16 + hi * 8) * 2);
    bf16x8 f[4][4];
#define QK_LD(g) do { const char* a0_ = kb[(2 * (g)) & 3] + ((2 * (g)) >> 2) * 128; const char* a1_ = kb[(2 * (g) + 1) & 3] + ((2 * (g) + 1) >> 2) * 128; \
        f[(g) & 3][0] = *reinterpret_cast<const bf16x8*>(a0_); f[(g) & 3][1] = *reinterpret_cast<const bf16x8*>(a0_ + 32 * 256); \
        f[(g) & 3][2] = *reinterpret_cast<const bf16x8*>(a1_); f[(g) & 3][3] = *reinterpret_cast<const bf16x8*>(a1_ + 32 * 256); } while (0)
#define QK_MM(g) do { p0 = __builtin_amdgcn_mfma_f32_32x32x16_bf16(f[(g) & 3][0], qr[2 * (g)], p0, 0, 0, 0); p1 = __builtin_amdgcn_mfma_f32_32x32x16_bf16(f[(g) & 3][1], qr[2 * (g)], p1, 0, 0, 0); \
        p0 = __builtin_amdgcn_mfma_f32_32x32x16_bf16(f[(g) & 3][2], qr[2 * (g) + 1], p0, 0, 0, 0); p1 = __builtin_amdgcn_mfma_f32_32x32x16_bf16(f[(g) & 3][3], qr[2 * (g) + 1], p1, 0, 0, 0); } while (0)
    if constexpr (ROPE) {
        QK_LD(0); SBAR();
        QK_LD(1); SBAR(); QK_MM(0); SBAR();
        QK_LD(2); SBAR(); QK_MM(1); SBAR();
        QK_LD(3); SBAR(); QK_MM(2); SBAR();
        const char* KR_lds = lds + OFF_KR + KB * SHM_KR + r32 * 128;
        bf16x8 ra[2], rb[2], qa, qb_;
#define QR_LD(d0, R, Q) do { const char* a = KR_lds + (((d0) * 32 + hi * 16) ^ ((r32 & 7) << 4)); R[0] = *reinterpret_cast<const bf16x8*>(a); R[1] = *reinterpret_cast<const bf16x8*>(a + 32 * 128); Q = *reinterpret_cast<const bf16x8*>(qpark + (d0) * 1024); } while (0)
#define QR_MM(R, Q) do { p0 = __builtin_amdgcn_mfma_f32_32x32x16_bf16(R[0], Q, p0, 0, 0, 0); p1 = __builtin_amdgcn_mfma_f32_32x32x16_bf16(R[1], Q, p1, 0, 0, 0); } while (0)
        QR_LD(0, ra, qa); SBAR(); QK_MM(3); SBAR();
        QR_LD(1, rb, qb_); SBAR(); QR_MM(ra, qa); SBAR();
        QR_LD(2, ra, qa); SBAR(); QR_MM(rb, qb_); SBAR();
        QR_LD(3, rb, qb_); SBAR(); QR_MM(ra, qa); SBAR();
        QR_MM(rb, qb_);
#undef QR_LD
#undef QR_MM
    } else if constexpr (LIGHT) {
        QK_LD(0); SBAR();
        QK_LD(1); SBAR(); QK_MM(0); SBAR();
        QK_LD(2); SBAR(); QK_MM(1); SBAR();
        QK_LD(3); SBAR(); QK_MM(2); SBAR();
        QK_MM(3);
    } else {
        QK_LD(0); QK_LD(1); SBAR();
        QK_LD(2); SBAR(); QK_MM(0); SBAR();
        QK_LD(3); SBAR(); QK_MM(1); SBAR();
        QK_MM(2); QK_MM(3);
    }
#undef QK_LD
#undef QK_MM
}
template <int VB, bool PIPE>
__device__ __forceinline__ void pv_tile(f32x16* o, int vb0, bf16x8 pa0, bf16x8 pa1, bf16x8 pa2, bf16x8 pa3) {
#define TRRD(dst, off) asm volatile("ds_read_b64_tr_b16 %0, %1 offset:%2" : "=&v"(dst) : "v"(vb0), "i"(off) : "memory")
#define PV_LD(S, d0) do { constexpr int b_ = OFF_V + VB * SHM_V + v_rd_off(d0, 0, 0); TRRD(S[0], b_); TRRD(S[1], b_ + 2048); TRRD(S[2], b_ + 4096); TRRD(S[3], b_ + 6144); TRRD(S[4], b_ + 8192); TRRD(S[5], b_ + 10240); TRRD(S[6], b_ + 12288); TRRD(S[7], b_ + 14336); } while (0)
#define PV_MM(S, d0) do { \
        o[d0] = __builtin_amdgcn_mfma_f32_32x32x16_bf16(pa0, (bf16x8){S[0][0], S[0][1], S[0][2], S[0][3], S[1][0], S[1][1], S[1][2], S[1][3]}, o[d0], 0, 0, 0);   \
        o[d0] = __builtin_amdgcn_mfma_f32_32x32x16_bf16(pa1, (bf16x8){S[2][0], S[2][1], S[2][2], S[2][3], S[3][0], S[3][1], S[3][2], S[3][3]}, o[d0], 0, 0, 0);   \
        o[d0] = __builtin_amdgcn_mfma_f32_32x32x16_bf16(pa2, (bf16x8){S[4][0], S[4][1], S[4][2], S[4][3], S[5][0], S[5][1], S[5][2], S[5][3]}, o[d0], 0, 0, 0);   \
        o[d0] = __builtin_amdgcn_mfma_f32_32x32x16_bf16(pa3, (bf16x8){S[6][0], S[6][1], S[6][2], S[6][3], S[7][0], S[7][1], S[7][2], S[7][3]}, o[d0], 0, 0, 0); } while (0)
#define PV_W(n) do { asm volatile("s_waitcnt lgkmcnt(" #n ")" ::: "memory"); SBAR(); } while (0)
    if constexpr (PIPE) {
        s16x4 A[8], B[8];
        PV_LD(A, 0); PV_LD(B, 1); PV_W(8); PV_MM(A, 0);
        PV_LD(A, 2); PV_W(8); PV_MM(B, 1);
        PV_LD(B, 3); PV_W(8); PV_MM(A, 2);
        PV_W(0); PV_MM(B, 3);
    } else {
        s16x4 A[8];
        PV_LD(A, 0); PV_W(0); PV_MM(A, 0); PV_LD(A, 1); PV_W(0); PV_MM(A, 1); PV_LD(A, 2); PV_W(0); PV_MM(A, 2); PV_LD(A, 3); PV_W(0); PV_MM(A, 3);
    }
#undef PV_W
#undef PV_MM
#undef PV_LD
#undef TRRD
}

struct FUnit {
    const bf16_t* Kb; long ldk; const bf16_t* Vb; long ldv; const bf16_t* KRb;
    int j_lo, j_hi;
    int qlo, qhi;
    int qpos;
    unsigned long long sel;
};
template <int MODE, int VAR = 0>
__device__ __forceinline__ void flash_core(char* lds, const FUnit& u, const bf16x8* qr, float scale, f32x16 (&o)[4], float& m_reg, float& l_reg) {
    constexpr bool ROPE = (MODE == 0);
    const int tid = threadIdx.x, wid = __builtin_amdgcn_readfirstlane(tid >> 6), lane = tid & 63, r32 = lane & 31, hi = lane >> 5;
    const int grp = wid >> 2;
    const float C2 = 1.4426950408889634f * scale;
    char* V_lds = lds + OFF_V; char* K_lds = lds + OFF_K; char* KR_lds = lds + OFF_KR;
    float* ws = (float*)(lds + OFF_WS) + wid * 64; float* al_l = ws + 32;
    const int sr = tid >> 4, sc = (tid & 15) * 8, vst0 = v_st(sr, sc), vst1 = v_st(32 + sr, sc), kws = KSWZ(sr, sc * 2);
    const int rr = tid >> 3, rc = (tid & 7) * 8, krws = rr * 128 + ((rc * 2) ^ ((rr & 7) << 4));
    const int vb0 = (int)(uintptr_t)lds + v_rd_base(lane);
    const char* qpark = lds + OFF_QPARK + wid * 4096 + lane * 16;
    m_reg = -1e30f; l_reg = 0.f;
#pragma unroll
    for (int d = 0; d < 4; ++d) o[d] = f32x16{};
    const int NT = u.j_hi - u.j_lo;
    if (NT <= 0) return;
    bf16x8 st_k0, st_k1, st_v0, st_v1, st_kr;
    f32x16 p0, p1; float mn, al; bf16x8 pa0, pa1, pa2, pa3;
    const unsigned W = (MODE == 1) ? 512u : ((MODE == 3) ? 0x80000000u : 0x7fffffffu);
#define FA_KBASE(t) ((u.j_lo + (t)) * KVBLK)
#define FA_KLOAD(k0) do { st_k0 = *(const bf16x8*)(u.Kb + (long)((k0) + sr) * u.ldk + sc); st_k1 = *(const bf16x8*)(u.Kb + (long)((k0) + 32 + sr) * u.ldk + sc);   \
                          if constexpr (ROPE) st_kr = *(const bf16x8*)(u.KRb + (long)((k0) + rr) * 64 + rc); } while (0)
#define FA_VLOAD(k0) do { st_v0 = *(const bf16x8*)(u.Vb + (long)((k0) + sr) * u.ldv + sc); st_v1 = *(const bf16x8*)(u.Vb + (long)((k0) + 32 + sr) * u.ldv + sc); } while (0)
#define FA_KWRITE(bf) do { *(bf16x8*)(K_lds + (bf) * SHM_K + kws) = st_k0; *(bf16x8*)(K_lds + (bf) * SHM_K + kws + 32 * 256) = st_k1;   \
                           if constexpr (ROPE) *(bf16x8*)(KR_lds + (bf) * SHM_KR + krws) = st_kr; } while (0)
#define FA_VWRITE(bf) do { *(bf16x8*)(V_lds + (bf) * SHM_V + vst0) = st_v0; *(bf16x8*)(V_lds + (bf) * SHM_V + vst1) = st_v1; } while (0)
#define FA_BAR() do { asm volatile("s_waitcnt lgkmcnt(0)" ::: "memory"); __builtin_amdgcn_s_barrier(); asm volatile("" ::: "memory"); } while (0)
#define FA_RESC(a) do { if (__any((a) < 1.f)) { if (hi == 0) al_l[r32] = (a); asm volatile("s_waitcnt lgkmcnt(0)" ::: "memory");              \
                     _Pragma("unroll") for (int d_ = 0; d_ < 4; ++d_) { _Pragma("unroll") for (int r = 0; r < 16; ++r) o[d_][r] *= al_l[crow(r, hi)]; } asm volatile("" ::: "memory"); } } while (0)
#define FA_MASK(t) do { const int kb_ = FA_KBASE(t);                                                                             \
        if (MODE == 1) { if (kb_ + KVBLK - 1 > u.qlo || kb_ <= u.qhi - 512) mask_tile(p0, p1, u.qpos - kb_ - 4 * hi, W); }       \
        else { if (kb_ + KVBLK - 1 > u.qlo) mask_tile(p0, p1, u.qpos - kb_ - 4 * hi, W); }                                       \
        } while (0)
#define FA_KILL(t) ((MODE == 2) && (((u.sel >> (u.j_lo + (t))) & 1ull) == 0ull))
    const int kb_last = FA_KBASE(NT - 1);
    FA_KLOAD(FA_KBASE(0)); FA_VLOAD(FA_KBASE(0));
    FA_KWRITE(0); FA_VWRITE(0);
    { const int k1 = FA_KBASE(1); FA_KLOAD(k1 < kb_last ? k1 : kb_last); }
    FA_BAR();
    if (grp == 1) FA_BAR();
#define FA_STEP(BF, t) do {                                                                                                      \
        if (!(VAR & 8)) { const int k1 = FA_KBASE((t) + 1); FA_VLOAD(k1 < kb_last ? k1 : kb_last); }                             \
        SBAR(); if (!(VAR & 1)) qkt<BF, ROPE, MODE == 3>(p0, p1, lds, r32, hi, qr, qpark); else { p0 = f32x16{}; p1 = f32x16{}; p0[0] = (float)(t); }   \
        if (!(VAR & 2)) { FA_MASK(t); partialSM(p0, p1, m_reg, mn, al, scale, C2, FA_KILL(t)); FA_RESC(al); } else { al = 1.f; }   \
        if (!(VAR & 8)) FA_KWRITE((BF) ^ 1);                                                                                     \
        if (!(VAR & 16)) FA_BAR();                                                                                               \
        if (!(VAR & 8)) { const int k2 = FA_KBASE((t) + 2); FA_KLOAD(k2 < kb_last ? k2 : kb_last); }                             \
        if (!(VAR & 2)) finishSM(p0, p1, al, l_reg, pa0, pa1, pa2, pa3); else { l_reg += p0[0]; pa0 = pack8(f32x4{p0[0], p0[1], p0[2], p0[3]}, f32x4{p1[0], p1[1], p1[2], p1[3]}); pa1 = pa0; pa2 = pa0; pa3 = pa0; } \
        SBAR();                                                                                                                  \
        if (!(VAR & 4)) pv_tile<BF, (MODE == 1 || MODE == 2)>(o, vb0, pa0, pa1, pa2, pa3); else { o[0][0] += __builtin_bit_cast(float, (int)pa0[0]); }      \
        if (!(VAR & 8)) FA_VWRITE((BF) ^ 1);                                                                                     \
        if (!(VAR & 16)) FA_BAR(); } while (0)
    int t = 0;
    for (; t + 1 < NT; t += 2) {
        FA_STEP(0, t);
        FA_STEP(1, t + 1);
    }
    if (NT & 1) {
        SBAR(); if (!(VAR & 1)) qkt<0, ROPE, MODE == 3>(p0, p1, lds, r32, hi, qr, qpark); else { p0 = f32x16{}; p1 = f32x16{}; }
        if (!(VAR & 2)) { FA_MASK(t); partialSM(p0, p1, m_reg, mn, al, scale, C2, FA_KILL(t)); FA_RESC(al); } else { al = 1.f; }
        if (!(VAR & 16)) FA_BAR();
        if (!(VAR & 2)) finishSM(p0, p1, al, l_reg, pa0, pa1, pa2, pa3); else { pa0 = pack8(f32x4{p0[0], p0[1], p0[2], p0[3]}, f32x4{p1[0], p1[1], p1[2], p1[3]}); pa1 = pa0; pa2 = pa0; pa3 = pa0; }
        SBAR();
        if (!(VAR & 4)) pv_tile<0, (MODE == 1 || MODE == 2)>(o, vb0, pa0, pa1, pa2, pa3);
        if (!(VAR & 16)) FA_BAR();
    }
#undef FA_STEP
    if (grp == 0) FA_BAR();
#undef FA_MASK
#undef FA_KILL
#undef FA_RESC
#undef FA_BAR
#undef FA_VWRITE
#undef FA_KWRITE
#undef FA_VLOAD
#undef FA_KLOAD
#undef FA_KBASE
}
template <int MODE>
__device__ __forceinline__ void flash_core2(char* lds, const FUnit& u, const bf16x8* qr, float scale, f32x16 (&o)[4], float& m_reg, float& l_reg) {
    const int tid = threadIdx.x, wid = __builtin_amdgcn_readfirstlane(tid >> 6), lane = tid & 63, r32 = lane & 31, hi = lane >> 5;
    const float C2 = 1.4426950408889634f * scale;
    char* V_lds = lds + OFF_V; char* K_lds = lds + OFF_K;
    float* ws = (float*)(lds + OFF_WS) + wid * 64; float* al_l = ws + 32;
    const int sr = tid >> 4, sc = (tid & 15) * 8, vst0 = v_st(sr, sc), vst1 = v_st(32 + sr, sc), kws = KSWZ(sr, sc * 2);
    const int vb0 = (int)(uintptr_t)lds + v_rd_base(lane);
    m_reg = -1e30f; l_reg = 0.f;
#pragma unroll
    for (int d = 0; d < 4; ++d) o[d] = f32x16{};
    const int NT = u.j_hi - u.j_lo;
    if (NT <= 0) return;
    bf16x8 st_k0, st_k1, st_v0, st_v1;
    f32x16 pA0, pA1, pB0, pB1; float mnA, mnB, alA, alB; bf16x8 pa0, pa1, pa2, pa3;
    const unsigned W = (MODE == 1) ? 512u : 0x7fffffffu;
#define F2_KBASE(t) ((u.j_lo + (t)) * KVBLK)
#define F2_LOAD(k0) do { st_v0 = *(const bf16x8*)(u.Vb + (long)((k0) + sr) * u.ldv + sc); st_v1 = *(const bf16x8*)(u.Vb + (long)((k0) + 32 + sr) * u.ldv + sc);   \
                         st_k0 = *(const bf16x8*)(u.Kb + (long)((k0) + sr) * u.ldk + sc); st_k1 = *(const bf16x8*)(u.Kb + (long)((k0) + 32 + sr) * u.ldk + sc); } while (0)
#define F2_WRITE(bf) do { *(bf16x8*)(V_lds + (bf) * SHM_V + vst0) = st_v0; *(bf16x8*)(V_lds + (bf) * SHM_V + vst1) = st_v1;   \
                          *(bf16x8*)(K_lds + (bf) * SHM_K + kws) = st_k0; *(bf16x8*)(K_lds + (bf) * SHM_K + kws + 32 * 256) = st_k1; } while (0)
#define F2_VMW() asm volatile("s_waitcnt vmcnt(0)" ::: "memory")
#define F2_RESC(a) do { if (__any((a) < 1.f)) { if (hi == 0) al_l[r32] = (a); asm volatile("s_waitcnt lgkmcnt(0)" ::: "memory");              \
                     _Pragma("unroll") for (int d_ = 0; d_ < 4; ++d_) { _Pragma("unroll") for (int r = 0; r < 16; ++r) o[d_][r] *= al_l[crow(r, hi)]; } asm volatile("" ::: "memory"); } } while (0)
#define F2_MASK(P0_, P1_, t) do { const int kb_ = F2_KBASE(t);                                                                    \
        if (MODE == 1) { if (kb_ + KVBLK - 1 > u.qlo || kb_ <= u.qhi - 512) mask_tile(P0_, P1_, u.qpos - kb_ - 4 * hi, W); }      \
        else { if (kb_ + KVBLK - 1 > u.qlo) mask_tile(P0_, P1_, u.qpos - kb_ - 4 * hi, W); } } while (0)
#define F2_KILL(t) ((MODE == 2) && (((u.sel >> (u.j_lo + (t))) & 1ull) == 0ull))
#define F2_HALF(PX0, PX1, mnX, alX, PY0, PY1, alY, t, KB, VB, SB) do {                                                            \
        SBAR(); qkt<KB, false, true>(PX0, PX1, lds, r32, hi, qr);                                                                 \
        finishSM(PY0, PY1, alY, l_reg, pa0, pa1, pa2, pa3); SBAR();                                                               \
        if ((t) + 1 < NT) { F2_LOAD(F2_KBASE((t) + 1)); SBAR(); }                                                                 \
        pv_tile<VB, false>(o, vb0, pa0, pa1, pa2, pa3); F2_MASK(PX0, PX1, (t)); partialSM(PX0, PX1, m_reg, mnX, alX, scale, C2, F2_KILL(t)); \
        __syncthreads();                                                                                                          \
        if ((t) + 1 < NT) { F2_VMW(); F2_WRITE(SB); }                                                                             \
        F2_RESC(alX); __syncthreads(); } while (0)
    F2_LOAD(F2_KBASE(0)); F2_VMW(); F2_WRITE(0); __syncthreads();
    if (NT > 1) F2_LOAD(F2_KBASE(1));
    SBAR(); qkt<0, false, true>(pA0, pA1, lds, r32, hi, qr);
    F2_MASK(pA0, pA1, 0); partialSM(pA0, pA1, m_reg, mnA, alA, scale, C2, F2_KILL(0));
    if (NT > 1) { F2_VMW(); F2_WRITE(1); }
    __syncthreads();
    for (int t = 1; t + 1 < NT; t += 2) {
        F2_HALF(pB0, pB1, mnB, alB, pA0, pA1, alA, t, 1, 0, 0);
        F2_HALF(pA0, pA1, mnA, alA, pB0, pB1, alB, t + 1, 0, 1, 1);
    }
    const bool even = (NT & 1) == 0;
    if (even) { SBAR(); qkt<1, false, true>(pB0, pB1, lds, r32, hi, qr); SBAR(); }
    finishSM(pA0, pA1, alA, l_reg, pa0, pa1, pa2, pa3); SBAR();
    pv_tile<0, false>(o, vb0, pa0, pa1, pa2, pa3);
    if (even) { F2_MASK(pB0, pB1, NT - 1); partialSM(pB0, pB1, m_reg, mnB, alB, scale, C2, F2_KILL(NT - 1)); F2_RESC(alB);
        finishSM(pB0, pB1, alB, l_reg, pa0, pa1, pa2, pa3); SBAR(); pv_tile<1, false>(o, vb0, pa0, pa1, pa2, pa3); }
#undef F2_HALF
#undef F2_KILL
#undef F2_MASK
#undef F2_RESC
#undef F2_VMW
#undef F2_WRITE
#undef F2_LOAD
#undef F2_KBASE
}
__device__ __forceinline__ void row_factors(char* lds, int wid, int r32, int hi, float f, float (&rf)[16]) {
    float* li_l = (float*)(lds + OFF_WS) + wid * 64;
    asm volatile("" ::: "memory");
    if (hi == 0) li_l[r32] = f;
    asm volatile("s_waitcnt lgkmcnt(0)" ::: "memory");
#pragma unroll
    for (int r = 0; r < 16; ++r) rf[r] = li_l[crow(r, hi)];
    asm volatile("s_waitcnt lgkmcnt(0)" ::: "memory");
}
}

constexpr size_t MiB = 1ull << 20, KiB = 1ull << 10;
constexpr size_t WS_CTL = 0;
constexpr size_t WS_ROPE = 64 * KiB;
constexpr size_t WS_MG = WS_ROPE + 1 * MiB;
constexpr size_t WS_FLOOR = WS_MG + 512 * KiB;
constexpr size_t WS_DEN = WS_FLOOR + 256 * KiB;
constexpr size_t WS_GATES = WS_DEN + 256 * KiB;
constexpr size_t WS_SEL = WS_GATES + 512 * KiB;
constexpr size_t WS_KROPE = WS_SEL + 512 * KiB;
constexpr size_t WS_CQN = WS_KROPE + 2 * MiB;
constexpr size_t WS_CKVN = WS_CQN + 32 * MiB;
constexpr size_t WS_KVB = WS_CKVN + 16 * MiB;
constexpr size_t WS_XB = WS_KVB + 128 * MiB;
constexpr size_t WS_Z = WS_XB + 128 * MiB;
constexpr size_t WS_R = WS_Z + 256 * MiB;
constexpr size_t WS_W = WS_R + 344 * MiB;
constexpr size_t W_AB = WS_W, W_UQ = W_AB + 62 * MiB, W_UKV = W_UQ + 6 * MiB, W_O0 = W_UKV + 4 * MiB, W_GU0 = W_O0 + 32 * MiB, W_D0 = W_GU0 + 172 * MiB;
constexpr size_t W_C = W_D0 + 86 * MiB, W_C1K = W_C + 58 * MiB, W_C1V = W_C1K + 2 * MiB, W_C2K = W_C1V + 2 * MiB, W_C2V = W_C2K + 128 * KiB, W_O1 = W_C2V + 128 * KiB;
constexpr size_t W_GU1 = W_O1 + 32 * MiB, W_D1 = W_GU1 + 172 * MiB, WS_AT = W_D1 + 86 * MiB;
constexpr size_t WS_AA = WS_AT + 256 * KiB;
constexpr size_t WS_DENI = WS_AA + 256 * KiB;
constexpr size_t WS_DENP = WS_DENI + 256 * KiB;
constexpr size_t WS_STATS = WS_DENP + 4 * MiB;
constexpr size_t WS_END = WS_STATS + 128 * KiB;
constexpr size_t WS_AK = WS_KVB, WS_AV = WS_AK + 32 * MiB, WS_HK = WS_AV + 32 * MiB, WS_HV = WS_HK + 2 * MiB, WS_KCMP = WS_HV + 2 * MiB, WS_VCMP = WS_KCMP + 2 * MiB;
constexpr size_t WS_QB = WS_R + (size_t)M_TOK * AB_NP * 2;

constexpr int NTHREADS = 512;
constexpr int LDS_BYTES = 152 * 1024, LDS_CTL_OFF = LDS_BYTES - 256;
constexpr int N_TJOBS = 14;
struct TJob { const float* s; const float* s2; bf16_t* d; int K, N, Np, mode; };
struct Args { const float* in[26]; float* out; unsigned char* ws; TJob tj[N_TJOBS]; int ph_lo, ph_hi; };

__device__ __forceinline__ void transpose_tile(char* lds, const TJob& jb, int t) {
    float* T = (float*)lds;
    const int tid = threadIdx.x;
    const int tn = jb.Np >> 6;
    const int in_ = t % tn, ik = t / tn, n0 = in_ * 64, k0 = ik * 64;
    const float* sp = jb.s; int c0 = n0; const int ncols = jb.N;
    if (jb.mode == 1) { const int tile = n0 >> 8, j = n0 & 255; sp = (j < 128) ? jb.s : jb.s2; c0 = tile * 128 + (j & 127); }
    const int kk = tid >> 4, nc = (tid & 15) * 4;
    f32x4 v0 = {0.f, 0.f, 0.f, 0.f}, v1 = v0;
    if (c0 + nc < ncols) { v0 = *(const f32x4*)(sp + (size_t)(k0 + kk) * ncols + c0 + nc); v1 = *(const f32x4*)(sp + (size_t)(k0 + kk + 32) * ncols + c0 + nc); }
#pragma unroll
    for (int j = 0; j < 4; ++j) { T[(nc + j) * 65 + kk] = v0[j]; T[(nc + j) * 65 + kk + 32] = v1[j]; }
    __syncthreads();
    const int n = tid >> 3, kc = (tid & 7) * 8;
    float f[8];
#pragma unroll
    for (int j = 0; j < 8; ++j) f[j] = T[n * 65 + kc + j];
    *(bf16x8*)(jb.d + (size_t)(n0 + n) * jb.K + k0 + kc) = pack8f(f);
    __syncthreads();
}
constexpr int N_TJOBS_PRO = 11;
__device__ __forceinline__ void transpose_jobs(char* lds, const Args& a) {
    for (int ji = 0; ji < N_TJOBS_PRO; ++ji) {
        const TJob jb = a.tj[ji];
        const int nt = (jb.K >> 6) * (jb.Np >> 6);
        for (int t = blockIdx.x; t < nt; t += gridDim.x) transpose_tile(lds, jb, t);
    }
}
constexpr int LATE_T0 = 64 * 64, LATE_T1 = 64 * 344, LATE_T2 = 172 * 64, LATE_TOTAL = LATE_T0 + LATE_T1 + LATE_T2, LATE_SLOTS = 64 + 128 + 192 + 224, LATE_PER = (LATE_TOTAL + LATE_SLOTS - 1) / LATE_SLOTS;
struct TTile { const float* sp; bf16_t* d; int K, ncols, c0, n0, k0; };
__device__ __forceinline__ TTile late_tile(const Args& a, int g) {
    const int ji = g < LATE_T0 ? 11 : (g < LATE_T0 + LATE_T1 ? 12 : 13); const int t = g - (ji == 11 ? 0 : (ji == 12 ? LATE_T0 : LATE_T0 + LATE_T1));
    const TJob jb = a.tj[ji]; const int tn = jb.Np >> 6; TTile r; r.n0 = (t % tn) * 64; r.k0 = (t / tn) * 64; r.sp = jb.s; r.c0 = r.n0; r.ncols = jb.N; r.d = jb.d; r.K = jb.K;
    if (jb.mode == 1) { const int tile = r.n0 >> 8, j = r.n0 & 255; r.sp = (j < 128) ? jb.s : jb.s2; r.c0 = tile * 128 + (j & 127); }
    return r;
}
__device__ __forceinline__ void transpose_late(char* lds, const Args& a, int slot) {
    float* T = (float*)lds;
    const int tid = threadIdx.x, kk = tid >> 4, nc = (tid & 15) * 4, n = tid >> 3, kc = (tid & 7) * 8;
    const int g0 = slot * LATE_PER, g1 = (slot + 1) * LATE_PER < LATE_TOTAL ? (slot + 1) * LATE_PER : LATE_TOTAL;
    if (g0 >= g1) return;
    __syncthreads();
    TTile cur = late_tile(a, g0);
    f32x4 v0 = {0.f, 0.f, 0.f, 0.f}, v1 = v0;
    if (cur.c0 + nc < cur.ncols) { v0 = *(const f32x4*)(cur.sp + (size_t)(cur.k0 + kk) * cur.ncols + cur.c0 + nc); v1 = *(const f32x4*)(cur.sp + (size_t)(cur.k0 + kk + 32) * cur.ncols + cur.c0 + nc); }
    for (int g = g0; g < g1; ++g) {
        const TTile nxt = late_tile(a, g + 1 < g1 ? g + 1 : g);
        f32x4 w0 = {0.f, 0.f, 0.f, 0.f}, w1 = w0;
        if (nxt.c0 + nc < nxt.ncols) { w0 = *(const f32x4*)(nxt.sp + (size_t)(nxt.k0 + kk) * nxt.ncols + nxt.c0 + nc); w1 = *(const f32x4*)(nxt.sp + (size_t)(nxt.k0 + kk + 32) * nxt.ncols + nxt.c0 + nc); }
#pragma unroll
        for (int j = 0; j < 4; ++j) { T[(nc + j) * 65 + kk] = v0[j]; T[(nc + j) * 65 + kk + 32] = v1[j]; }
        __syncthreads();
        float f[8];
#pragma unroll
        for (int j = 0; j < 8; ++j) f[j] = T[n * 65 + kc + j];
        *(bf16x8*)(cur.d + (size_t)(cur.n0 + n) * cur.K + cur.k0 + kc) = pack8f(f);
        __syncthreads();
        cur = nxt; v0 = w0; v1 = w1;
    }
}
__device__ __forceinline__ void p0_prologue(char* lds, const Args& a) {
    const int tid = threadIdx.x;
    const size_t gt = (size_t)blockIdx.x * NTHREADS + tid, gs = (size_t)gridDim.x * NTHREADS;
    { const float* x = a.in[0]; bf16_t* xb = (bf16_t*)(a.ws + WS_XB);
      for (size_t i = gt; i < (size_t)M_TOK * DM / 8; i += gs) { const f32x4 v0 = *(const f32x4*)(x + i * 8), v1 = *(const f32x4*)(x + i * 8 + 4);
          float f[8] = {v0[0], v0[1], v0[2], v0[3], v1[0], v1[1], v1[2], v1[3]}; *(bf16x8*)(xb + i * 8) = pack8f(f); } }
    { f32x2* rp = (f32x2*)(a.ws + WS_ROPE);
      for (size_t i = gt; i < (size_t)SEQ * 32; i += gs) { const int pos = (int)(i >> 5), j = (int)(i & 31);
          const double inv = exp(-(double)j / 32.0 * 9.210340371976184  ); const double ang = (double)pos * inv; rp[i] = (f32x2){(float)cos(ang), (float)sin(ang)}; } }
    transpose_jobs(lds, a);
}

__device__ __forceinline__ float softcap15(float z) { return 15.0f * tanhf(z * (1.0f / 15.0f)); }
__device__ __forceinline__ float logsigmoid_f(float z) { return fminf(z, 0.f) - log1pf(__expf(-fabsf(z))); }
__device__ __forceinline__ void p2_prep(const Args& a) {
    const int tid = threadIdx.x, lane = tid & 63, wid = tid >> 6;
    const int gw = blockIdx.x * 8 + wid, nw = gridDim.x * 8;
    const bf16_t* proj = (const bf16_t*)(a.ws + WS_R);
    if (gw < 16) {
        const int bh = gw, b = bh >> 2, h = bh & 3;
        const float* gates = (const float*)(a.ws + WS_GATES);
        f32x2* mg = (f32x2*)(a.ws + WS_MG) + (size_t)bh * SEQ; float* fl = (float*)(a.ws + WS_FLOOR) + (size_t)bh * SEQ;
        const float bi = a.in[2][h], bfg = a.in[3][h];
        float Fc = 0.f, Ac = 0.f, mprev = 0.f;
        for (int c = 0; c < SEQ / 64; ++c) {
            const int t = c * 64 + lane; const float* g = gates + (size_t)(b * SEQ + t) * 8;
            const float li = softcap15(g[h] + bi), lf = logsigmoid_f(softcap15(g[4 + h] + bfg));
            float F = lf;
#pragma unroll
            for (int o = 1; o < 64; o <<= 1) { const float y = __shfl_up(F, o); if (lane >= o) F += y; }
            F += Fc;
            float A = li - F;
#pragma unroll
            for (int o = 1; o < 64; o <<= 1) { const float y = __shfl_up(A, o); if (lane >= o) A = fmaxf(A, y); }
            A = fmaxf(A, Ac);
            const float m = F + A;
            float mp = __shfl_up(m, 1); if (lane == 0) mp = mprev;
            mg[t] = (f32x2){__expf(lf + mp - m), __expf(li - m)}; fl[t] = __expf(-m);
            ((float*)(a.ws + WS_AT))[(size_t)bh * SEQ + t] = li - F; ((float*)(a.ws + WS_AA))[(size_t)bh * SEQ + t] = A;
            Fc = __shfl(F, 63); Ac = __shfl(A, 63); mprev = __shfl(m, 63);
        }
    }
    const float* qn = a.in[5]; const float* kvn = a.in[6];
    bf16_t* cqn = (bf16_t*)(a.ws + WS_CQN); bf16_t* ckvn = (bf16_t*)(a.ws + WS_CKVN); bf16_t* krope = (bf16_t*)(a.ws + WS_KROPE);
    const f32x2* rp = (const f32x2*)(a.ws + WS_ROPE);
    for (int tk = gw; tk < M_TOK; tk += nw) {
        const bf16_t* row = proj + (size_t)tk * AB_NP;
        float x0[8], x1[8], y[8];
        unpack8(*(const bf16x8*)(row + AB_CQ + lane * 8), x0); unpack8(*(const bf16x8*)(row + AB_CQ + 512 + lane * 8), x1); unpack8(*(const bf16x8*)(row + AB_CKV + lane * 8), y);
        const float kr = bf2f(row[AB_KR + lane]);
        float s = 0.f, s2 = 0.f;
#pragma unroll
        for (int j = 0; j < 8; ++j) { s += x0[j] * x0[j] + x1[j] * x1[j]; s2 += y[j] * y[j]; }
        s = wave_sum(s); s2 = wave_sum(s2);
        const float r1 = rsqrtf(s * (1.0f / 1024.0f) + RMS_EPS), r2 = rsqrtf(s2 * (1.0f / 512.0f) + RMS_EPS);
#pragma unroll
        for (int j = 0; j < 8; ++j) { x0[j] *= r1 * qn[lane * 8 + j]; x1[j] *= r1 * qn[512 + lane * 8 + j]; y[j] *= r2 * kvn[lane * 8 + j]; }
        *(bf16x8*)(cqn + (size_t)tk * 1024 + lane * 8) = pack8f(x0); *(bf16x8*)(cqn + (size_t)tk * 1024 + 512 + lane * 8) = pack8f(x1);
        *(bf16x8*)(ckvn + (size_t)tk * 512 + lane * 8) = pack8f(y);
        const float pr = __shfl_xor(kr, 32); const f32x2 cs = rp[(size_t)(tk & (SEQ - 1)) * 32 + (lane & 31)];
        const float out = lane < 32 ? kr * cs.x - pr * cs.y : pr * cs.y + kr * cs.x;
        krope[(size_t)tk * 64 + lane] = f2bf(out);
    }
}

__device__ __forceinline__ float dpp_xor1(float v) { return __int_as_float(__builtin_amdgcn_update_dpp(0, __float_as_int(v), 0xB1, 0xF, 0xF, true)); }
__device__ __forceinline__ float dpp_xor2(float v) { return __int_as_float(__builtin_amdgcn_update_dpp(0, __float_as_int(v), 0x4E, 0xF, 0xF, true)); }
__device__ __forceinline__ float dpp_hmir(float v) { return __int_as_float(__builtin_amdgcn_update_dpp(0, __float_as_int(v), 0x141, 0xF, 0xF, true)); }
__device__ __forceinline__ float dpp_mir(float v)  { return __int_as_float(__builtin_amdgcn_update_dpp(0, __float_as_int(v), 0x140, 0xF, 0xF, true)); }
__device__ __forceinline__ float row16_sum(float v) { v += dpp_xor1(v); v += dpp_xor2(v); v += dpp_hmir(v); v += dpp_mir(v); return v; }
__device__ __forceinline__ float swap32_sum(float a, float b) {
    auto rr = __builtin_amdgcn_permlane32_swap(__float_as_uint(a), __float_as_uint(b), false, false); return __uint_as_float(rr[0]) + __uint_as_float(rr[1]); }
constexpr int ML_CH = 32;
constexpr int ML_Q = 0, ML_K = ML_CH * 256 * 4, ML_V = 2 * ML_CH * 256 * 4, ML_FI = ML_V + ML_CH * 32 * 4, ML_BUF = ML_FI + ML_CH * 8;
constexpr int ML_OUT = 2 * ML_BUF, ML_DEN = ML_OUT + ML_CH * 32 * 4, ML_END = ML_DEN + ML_CH * 4;
static_assert(ML_END <= LDS_CTL_OFF, "mLSTM LDS");
__device__ __forceinline__ void p4_mlstm(char* lds, const Args& a) {
    const int tid = threadIdx.x, lane = tid & 63, wid = __builtin_amdgcn_readfirstlane(tid >> 6);
    const bf16_t* proj = (const bf16_t*)(a.ws + WS_R); bf16_t* hcat = (bf16_t*)a.out;
    for (int unit = blockIdx.x; unit < 256; unit += gridDim.x) {
        const int bh = unit >> 4, sl = unit & 15, b = bh >> 2, h = bh & 3;
        const f32x2* mg = (const f32x2*)(a.ws + WS_MG) + (size_t)bh * SEQ;
        float* den = (float*)(a.ws + WS_DEN) + (size_t)bh * SEQ;
        const bool denw = (wid == 0) && (sl == 0);
        const int st = tid >> 4, sp = (tid & 15) * 16, vt = tid >> 2, vp = (tid & 3) * 8;
        const bf16_t* qsrc = proj + (size_t)(b * SEQ + st) * AB_NP + AB_Q + h * 256 + sp;
        const bf16_t* ksrc = proj + (size_t)(b * SEQ + st) * AB_NP + AB_K + h * 256 + sp;
        const bf16_t* vsrc = proj + (size_t)(b * SEQ + vt) * AB_NP + AB_V + h * 512 + sl * 32 + vp;
        bf16x8 rq0, rq1, rk0, rk1, rv; f32x2 rfi;
#define ML_LOAD(c) do { const size_t o_ = (size_t)(c) * ML_CH * AB_NP; rq0 = *(const bf16x8*)(qsrc + o_); rq1 = *(const bf16x8*)(qsrc + o_ + 8); rk0 = *(const bf16x8*)(ksrc + o_); rk1 = *(const bf16x8*)(ksrc + o_ + 8); \
        if (tid < 128) rv = *(const bf16x8*)(vsrc + o_); if (tid < ML_CH) rfi = mg[(c) * ML_CH + tid]; } while (0)
#define ML_STORE(bufp) do { float f_[8]; float* Q_ = (float*)((bufp) + ML_Q) + st * 256 + sp; float* K_ = (float*)((bufp) + ML_K) + st * 256 + sp; \
        unpack8(rq0, f_); *(f32x4*)(Q_) = (f32x4){f_[0], f_[1], f_[2], f_[3]}; *(f32x4*)(Q_ + 4) = (f32x4){f_[4], f_[5], f_[6], f_[7]}; \
        unpack8(rq1, f_); *(f32x4*)(Q_ + 8) = (f32x4){f_[0], f_[1], f_[2], f_[3]}; *(f32x4*)(Q_ + 12) = (f32x4){f_[4], f_[5], f_[6], f_[7]}; \
        unpack8(rk0, f_); *(f32x4*)(K_) = (f32x4){f_[0], f_[1], f_[2], f_[3]} * 0.0625f; *(f32x4*)(K_ + 4) = (f32x4){f_[4], f_[5], f_[6], f_[7]} * 0.0625f; \
        unpack8(rk1, f_); *(f32x4*)(K_ + 8) = (f32x4){f_[0], f_[1], f_[2], f_[3]} * 0.0625f; *(f32x4*)(K_ + 12) = (f32x4){f_[4], f_[5], f_[6], f_[7]} * 0.0625f; \
        if (tid < 128) { float* V_ = (float*)((bufp) + ML_V) + vt * 32 + vp; unpack8(rv, f_); *(f32x4*)(V_) = (f32x4){f_[0], f_[1], f_[2], f_[3]}; *(f32x4*)(V_ + 4) = (f32x4){f_[4], f_[5], f_[6], f_[7]}; } \
        if (tid < ML_CH) ((f32x2*)((bufp) + ML_FI))[tid] = rfi; } while (0)
        f32x4 C0 = {0.f, 0.f, 0.f, 0.f}, C1 = C0, C2 = C0, C3 = C0, n4 = C0;
        __syncthreads();
        ML_LOAD(0); ML_STORE(lds); __syncthreads();
        float* OUT = (float*)(lds + ML_OUT); float* DENs = (float*)(lds + ML_DEN);
        for (int c = 0; c < SEQ / ML_CH; ++c) {
            char* buf = lds + (c & 1) * ML_BUF;
            if (c + 1 < SEQ / ML_CH) ML_LOAD(c + 1);
            const float* Qs = (const float*)(buf + ML_Q) + lane * 4; const float* Ks = (const float*)(buf + ML_K) + lane * 4;
            const float* Vs = (const float*)(buf + ML_V) + wid * 4; const f32x2* FIs = (const f32x2*)(buf + ML_FI);
#pragma unroll 4
            for (int s = 0; s < ML_CH; ++s) {
                const f32x4 q4 = *(const f32x4*)(Qs + s * 256), k4 = *(const f32x4*)(Ks + s * 256), v4 = *(const f32x4*)(Vs + s * 32); const f32x2 fi = FIs[s];
                const f32x4 iv = v4 * fi.y;
                C0 = C0 * fi.x + iv * k4[0]; C1 = C1 * fi.x + iv * k4[1]; C2 = C2 * fi.x + iv * k4[2]; C3 = C3 * fi.x + iv * k4[3];
                f32x4 d = C0 * q4[0] + C1 * q4[1] + C2 * q4[2] + C3 * q4[3];
                float e0 = swap32_sum(d[0], d[2]), e1 = swap32_sum(d[1], d[3]);
                const float other = __shfl_xor((lane & 16) ? e0 : e1, 16);
                float r = ((lane & 16) ? e1 : e0) + other;
                r = row16_sum(r);
                if ((lane & 15) == 0) OUT[s * 32 + wid * 4 + (lane >> 5) * 2 + ((lane >> 4) & 1)] = r;
                if (denw) { n4 = n4 * fi.x + k4 * fi.y; float dn = n4[0] * q4[0] + n4[1] * q4[1] + n4[2] * q4[2] + n4[3] * q4[3];
                    dn = swap32_sum(dn, dn); dn += __shfl_xor(dn, 16); dn = row16_sum(dn); if (lane == 0) DENs[s] = dn; }
            }
            __syncthreads();
            if (tid < 128) { const float* o_ = OUT + vt * 32 + vp; float f[8];
#pragma unroll
                for (int j = 0; j < 8; ++j) f[j] = o_[j];
                *(bf16x8*)(hcat + (size_t)(b * SEQ + c * ML_CH + vt) * DM + h * 512 + sl * 32 + vp) = pack8f(f); }
            if (sl == 0 && tid < ML_CH) den[c * ML_CH + tid] = DENs[tid];
            if (c + 1 < SEQ / ML_CH) ML_STORE(lds + ((c + 1) & 1) * ML_BUF);
            __syncthreads();
        }
#undef ML_LOAD
#undef ML_STORE
    }
}

#define TRRD(dst, base, off) asm volatile("ds_read_b64_tr_b16 %0, %1 offset:%2" : "=&v"(dst) : "v"(base), "i"(off) : "memory")
#define TRRD(dst, base, off) asm volatile("ds_read_b64_tr_b16 %0, %1 offset:%2" : "=&v"(dst) : "v"(base), "i"(off) : "memory")
namespace mc {
constexpr int L_K = 0, L_Q = 32768, L_V = 65536, L_EV = 81920, L_CT = 98304, L_TAB = 114688, L_G = 116736;
constexpr int T_A = 0, T_AA = 64, T_INT = 128, T_E = 192;
__device__ __forceinline__ int kaddr(int s, int d) { return (d >> 7) * 16384 + s * 256 + (((d & 127) * 2) ^ ((s & 7) << 4)); }
}
#define MC_QF(d0) (*(const bf16x8*)(lds + L_Q + ((d0) >> 3) * 16384 + TB * 8192 + kq[(d0) & 3] + (((d0) >> 2) & 1) * 128))
template <int TB>
__device__ __forceinline__ void mc_inter(char* lds, float* TAB, const int (&kq)[4], int cfrag, int csw, int lane, int hi) {
    using namespace mc;
    f32x16 o = f32x16{};
    bf16x8 fq[2][2], fc[2][2];
#define MJ_LD(g) do { _Pragma("unroll") for (int e = 0; e < 2; ++e) { const int d0 = 2 * (g) + e; fq[(g) & 1][e] = MC_QF(d0); fc[(g) & 1][e] = *(const bf16x8*)(lds + L_CT + cfrag + (((d0 * 16 + hi * 8) * 2) ^ csw)); } } while (0)
#define MJ_MM(g) do { _Pragma("unroll") for (int e = 0; e < 2; ++e) o = __builtin_amdgcn_mfma_f32_32x32x16_bf16(fq[(g) & 1][e], fc[(g) & 1][e], o, 0, 0, 0); } while (0)
    MJ_LD(0); SBAR();
#pragma unroll
    for (int g = 0; g < 8; ++g) { if (g + 1 < 8) { MJ_LD(g + 1); } SBAR(); MJ_MM(g); SBAR(); }
#undef MJ_LD
#undef MJ_MM
    const float* ti = TAB + T_INT + TB * 32 + 4 * hi; float* G = (float*)(lds + L_G) + TB * 1024 + lane;
#pragma unroll
    for (int r = 0; r < 16; ++r) G[r * 64] = o[r] * ti[(r & 3) + 8 * (r >> 2)];
}
template <int TB>
__device__ __forceinline__ void mc_intra(char* lds, float* TAB, const int (&kq)[4], int vbV, int r32, int hi, f32x16& o, float& ps) {
    using namespace mc;
    const float LOG2E = 1.4426950408889634f;
    const int tl = TB * 32 + r32;
    f32x16 p0 = f32x16{}, p1 = f32x16{};
    bf16x8 fq[2][2], fa0[2][2], fa1[2][2];
#define MI_LD(g) do { _Pragma("unroll") for (int e = 0; e < 2; ++e) { const int d0 = 2 * (g) + e; const char* ap = lds + L_K + (d0 >> 3) * 16384 + kq[d0 & 3] + ((d0 >> 2) & 1) * 128; \
        fq[(g) & 1][e] = MC_QF(d0); fa0[(g) & 1][e] = *(const bf16x8*)ap; if constexpr (TB == 1) fa1[(g) & 1][e] = *(const bf16x8*)(ap + 8192); } } while (0)
#define MI_MM(g) do { _Pragma("unroll") for (int e = 0; e < 2; ++e) { p0 = __builtin_amdgcn_mfma_f32_32x32x16_bf16(fa0[(g) & 1][e], fq[(g) & 1][e], p0, 0, 0, 0); \
        if constexpr (TB == 1) p1 = __builtin_amdgcn_mfma_f32_32x32x16_bf16(fa1[(g) & 1][e], fq[(g) & 1][e], p1, 0, 0, 0); } } while (0)
    MI_LD(0); SBAR();
#pragma unroll
    for (int g = 0; g < 8; ++g) { if (g + 1 < 8) { MI_LD(g + 1); } SBAR(); MI_MM(g); SBAR(); }
#undef MI_LD
#undef MI_MM
    const float At = TAB[T_AA + tl];
    ps = 0.f;
    const float* ta = TAB + T_A + 4 * hi;
#pragma unroll
    for (int r = 0; r < 16; ++r) { const int s0 = fa::crow(r, hi), c0 = (r & 3) + 8 * (r >> 2);
        const float e0 = __builtin_amdgcn_exp2f((ta[c0] - At) * LOG2E) * 0.0625f; const float w0 = (s0 <= tl) ? e0 : 0.f; p0[r] *= w0; ps += p0[r];
        if constexpr (TB == 1) { const float e1 = __builtin_amdgcn_exp2f((ta[32 + c0] - At) * LOG2E) * 0.0625f; const float w1 = (s0 + 32 <= tl) ? e1 : 0.f; p1[r] *= w1; ps += p1[r]; } }
    { auto rr = __builtin_amdgcn_permlane32_swap(__float_as_uint(ps), __float_as_uint(ps), false, false); ps = __uint_as_float(rr[0]) + __uint_as_float(rr[1]); }
    bf16x8 pa0, pa1, pa2, pa3;
#define PK4(P, B_, OUT) do { unsigned a0 = fa::cvtpk(P[B_+0], P[B_+1]), a1 = fa::cvtpk(P[B_+2], P[B_+3]);                  \
        unsigned b0_ = fa::cvtpk(P[B_+4], P[B_+5]), b1_ = fa::cvtpk(P[B_+6], P[B_+7]);                                   \
        auto r0 = __builtin_amdgcn_permlane32_swap(a0, b0_, false, false); auto r1 = __builtin_amdgcn_permlane32_swap(a1, b1_, false, false); \
        u32x4 w = {r0[0], r1[0], r0[1], r1[1]}; OUT = *reinterpret_cast<bf16x8*>(&w); } while (0)
    PK4(p0, 0, pa0); PK4(p0, 8, pa1); PK4(p1, 0, pa2); PK4(p1, 8, pa3);
#undef PK4
    o = f32x16{};
    { s16x4 l0, l1, l2, l3, h0, h1, h2, h3;
      TRRD(l0, vbV, 0); TRRD(h0, vbV, 2048); TRRD(l1, vbV, 4096); TRRD(h1, vbV, 6144); TRRD(l2, vbV, 8192); TRRD(h2, vbV, 10240); TRRD(l3, vbV, 12288); TRRD(h3, vbV, 14336);
      asm volatile("s_waitcnt lgkmcnt(0)" ::: "memory"); SBAR();
      o = __builtin_amdgcn_mfma_f32_32x32x16_bf16(pa0, (bf16x8){l0[0], l0[1], l0[2], l0[3], h0[0], h0[1], h0[2], h0[3]}, o, 0, 0, 0);
      o = __builtin_amdgcn_mfma_f32_32x32x16_bf16(pa1, (bf16x8){l1[0], l1[1], l1[2], l1[3], h1[0], h1[1], h1[2], h1[3]}, o, 0, 0, 0);
      if constexpr (TB == 1) { o = __builtin_amdgcn_mfma_f32_32x32x16_bf16(pa2, (bf16x8){l2[0], l2[1], l2[2], l2[3], h2[0], h2[1], h2[2], h2[3]}, o, 0, 0, 0);
                               o = __builtin_amdgcn_mfma_f32_32x32x16_bf16(pa3, (bf16x8){l3[0], l3[1], l3[2], l3[3], h3[0], h3[1], h3[2], h3[3]}, o, 0, 0, 0); } }
}
#undef MC_QF
__device__ __forceinline__ void p4_mlstm_chunk(char* lds, const Args& a) {
    using namespace mc;
    const int tid = threadIdx.x, lane = tid & 63, wid = __builtin_amdgcn_readfirstlane(tid >> 6);
    const bf16_t* proj = (const bf16_t*)(a.ws + WS_R); bf16_t* hcat = (bf16_t*)a.out;
    float* TAB = (float*)(lds + L_TAB);
    const float LOG2E = 1.4426950408889634f;
    for (int unit = blockIdx.x; unit < 256; unit += gridDim.x) {
        const int bh = (gridDim.x == 256) ? 2 * (unit & 7) + (unit >> 7) : unit >> 4, sl = (gridDim.x == 256) ? (unit >> 3) & 15 : unit & 15, b = bh >> 2, h = bh & 3;
        const float* AT = (const float*)(a.ws + WS_AT) + (size_t)bh * SEQ; const float* AA = (const float*)(a.ws + WS_AA) + (size_t)bh * SEQ;
        float* deni = (float*)(a.ws + WS_DENI) + (size_t)bh * SEQ; float* denp = (float*)(a.ws + WS_DENP) + (size_t)(bh * 16 + sl) * SEQ;
        const int krow = tid >> 3, kch = (tid & 7) * 4, vrow = (tid >> 2) & 63, vch = tid & 3;
        const bf16_t* ksrc = proj + (size_t)(b * SEQ + krow) * AB_NP + AB_K + h * 256 + kch * 8;
        const bf16_t* qsrc = proj + (size_t)(b * SEQ + krow) * AB_NP + AB_Q + h * 256 + kch * 8;
        const bf16_t* vsrc = proj + (size_t)(b * SEQ + vrow) * AB_NP + AB_V + h * 512 + sl * 32 + vch * 8;
        int kdst[4];
#pragma unroll
        for (int i = 0; i < 4; ++i) { const int ch = kch + i; kdst[i] = (ch >> 4) * 16384 + KSWZ(krow, (ch & 15) * 16); }
        const int vdst = fa::v_st(vrow, vch * 8);
        bf16x8 rk[4], rq[4], rv; float pa_t = 0.f, pA_t = 0.f, pa_v = 0.f, pA_prev = 0.f, pA_end = 0.f;
#define MC_LOAD(c) do { const size_t o_ = (size_t)(c) * 64 * AB_NP; _Pragma("unroll") for (int i = 0; i < 4; ++i) { rk[i] = *(const bf16x8*)(ksrc + o_ + i * 8); rq[i] = *(const bf16x8*)(qsrc + o_ + i * 8); } \
        if (tid < 256) { rv = *(const bf16x8*)(vsrc + o_); pa_v = AT[(c) * 64 + vrow]; } if (tid < 64) { pa_t = AT[(c) * 64 + tid]; pA_t = AA[(c) * 64 + tid]; } \
        pA_end = AA[(c) * 64 + 63]; pA_prev = (c) > 0 ? AA[(c) * 64 - 1] : 0.f; } while (0)
        f32x16 Cacc = f32x16{};
        f32x16 oi = f32x16{}; float psi = 0.f;
        float nreg = 0.f;
        __syncthreads();
        for (int i = tid; i < 16384 / 16; i += NTHREADS) *(u32x4*)(lds + L_CT + i * 16) = (u32x4){0u, 0u, 0u, 0u};
        MC_LOAD(0);
        for (int c = 0; c < SEQ / 64; ++c) {
            const int t0 = c * 64;
            const float A_prev = pA_prev, A_end = pA_end;
            asm volatile("s_waitcnt vmcnt(0)" ::: "memory");
#pragma unroll
            for (int i = 0; i < 4; ++i) { *(bf16x8*)(lds + L_K + kdst[i]) = rk[i]; *(bf16x8*)(lds + L_Q + kdst[i]) = rq[i]; }
            if (tid < 256) { *(bf16x8*)(lds + L_V + vdst) = rv; const float e = __builtin_amdgcn_exp2f((pa_v - A_end) * LOG2E) * 0.0625f;
                float f[8]; unpack8(rv, f);
#pragma unroll
                for (int j = 0; j < 8; ++j) f[j] *= e;
                *(bf16x8*)(lds + L_EV + vdst) = pack8f(f); }
            if (tid < 64) { TAB[T_A + tid] = pa_t; TAB[T_AA + tid] = pA_t; TAB[T_INT + tid] = __builtin_amdgcn_exp2f((A_prev - pA_t) * LOG2E); TAB[T_E + tid] = __builtin_amdgcn_exp2f((pa_t - A_end) * LOG2E) * 0.0625f; }
            __syncthreads();
            if (c + 1 < SEQ / 64) MC_LOAD(c + 1);
            const float decay = __builtin_amdgcn_exp2f((A_prev - A_end) * LOG2E);
            int lane_o = lane; asm volatile("" : "+v"(lane_o));
            const int r32 = lane_o & 31, hi = lane_o >> 5;
            int kq[4];
#pragma unroll
            for (int dd = 0; dd < 4; ++dd) kq[dd] = KSWZ(r32, dd * 32 + hi * 16);
            const int cfrag = r32 * 512, csw = (r32 & 15) << 4;
            const int trq = (lane_o & 15) >> 2, trp = lane_o & 3, trg = (lane_o >> 4) & 1;
            const int vbV = (int)(uintptr_t)lds + L_V + fa::v_rd_base(lane_o), vbE = (int)(uintptr_t)lds + L_EV + fa::v_rd_base(lane_o);
            if (wid == 0) mc_intra<0>(lds, TAB, kq, vbV, r32, hi, oi, psi);
            else if (wid == 1) mc_intra<1>(lds, TAB, kq, vbV, r32, hi, oi, psi);
            else if (wid == 2) mc_inter<0>(lds, TAB, kq, cfrag, csw, lane_o, hi);
            else if (wid == 3) mc_inter<1>(lds, TAB, kq, cfrag, csw, lane_o, hi);
            if (wid == 7) {
                const int d0_ = 16 * sl;
                float qv[16]; { float f[8]; unpack8(*(const bf16x8*)(lds + L_Q + kaddr(lane, d0_)), f);
#pragma unroll
                    for (int j = 0; j < 8; ++j) qv[j] = f[j];
                    unpack8(*(const bf16x8*)(lds + L_Q + kaddr(lane, d0_ + 8)), f);
#pragma unroll
                    for (int j = 0; j < 8; ++j) qv[8 + j] = f[j]; }
                float dsum = 0.f;
#pragma unroll
                for (int d = 0; d < 16; ++d) dsum += qv[d] * __int_as_float(__builtin_amdgcn_readlane(__float_as_int(nreg), d));
                denp[t0 + lane] = dsum * TAB[T_INT + lane];
                const int dd = lane & 15, sq = lane >> 4; float part = 0.f;
#pragma unroll
                for (int j = 0; j < 16; ++j) { const int s = sq * 16 + j; part += TAB[T_E + s] * bf2f(*(const bf16_t*)(lds + L_K + kaddr(s, d0_ + dd))); }
                part += __shfl_xor(part, 16); part += __shfl_xor(part, 32);
                nreg = nreg * decay + part;
            }
            {
#pragma unroll
                for (int r = 0; r < 16; ++r) Cacc[r] *= decay;
                s16x4 l0, l1, l2, l3, h0, h1, h2, h3;
                TRRD(l0, vbE, 0); TRRD(h0, vbE, 2048); TRRD(l1, vbE, 4096); TRRD(h1, vbE, 6144); TRRD(l2, vbE, 8192); TRRD(h2, vbE, 10240); TRRD(l3, vbE, 12288); TRRD(h3, vbE, 14336);
                s16x4 ka[4][2];
                { const int d = 32 * wid + trg * 16 + 4 * trp;
                  const int ad0 = (int)(uintptr_t)lds + L_K + kaddr(8 * hi + trq, d), ad1 = (int)(uintptr_t)lds + L_K + kaddr(8 * hi + 4 + trq, d);
                  TRRD(ka[0][0], ad0, 0); TRRD(ka[0][1], ad1, 0); TRRD(ka[1][0], ad0, 4096); TRRD(ka[1][1], ad1, 4096);
                  TRRD(ka[2][0], ad0, 8192); TRRD(ka[2][1], ad1, 8192); TRRD(ka[3][0], ad0, 12288); TRRD(ka[3][1], ad1, 12288); }
                asm volatile("s_waitcnt lgkmcnt(0)" ::: "memory"); SBAR();
#define KAF(ks) (bf16x8){ka[ks][0][0], ka[ks][0][1], ka[ks][0][2], ka[ks][0][3], ka[ks][1][0], ka[ks][1][1], ka[ks][1][2], ka[ks][1][3]}
                Cacc = __builtin_amdgcn_mfma_f32_32x32x16_bf16(KAF(0), (bf16x8){l0[0], l0[1], l0[2], l0[3], h0[0], h0[1], h0[2], h0[3]}, Cacc, 0, 0, 0);
                Cacc = __builtin_amdgcn_mfma_f32_32x32x16_bf16(KAF(1), (bf16x8){l1[0], l1[1], l1[2], l1[3], h1[0], h1[1], h1[2], h1[3]}, Cacc, 0, 0, 0);
                Cacc = __builtin_amdgcn_mfma_f32_32x32x16_bf16(KAF(2), (bf16x8){l2[0], l2[1], l2[2], l2[3], h2[0], h2[1], h2[2], h2[3]}, Cacc, 0, 0, 0);
                Cacc = __builtin_amdgcn_mfma_f32_32x32x16_bf16(KAF(3), (bf16x8){l3[0], l3[1], l3[2], l3[3], h3[0], h3[1], h3[2], h3[3]}, Cacc, 0, 0, 0);
#undef KAF
            }
            __syncthreads();
            float one = 1.0f; asm volatile("" : "+v"(one));
#pragma unroll
            for (int g = 0; g < 4; ++g) { const int d4 = 32 * wid + 8 * g + 4 * hi; u32x2 w; w.x = cvt_pk_bf16(Cacc[4 * g] * one, Cacc[4 * g + 1] * one); w.y = cvt_pk_bf16(Cacc[4 * g + 2] * one, Cacc[4 * g + 3] * one);
                *(u32x2*)(lds + L_CT + cfrag + ((d4 * 2) ^ csw)) = w; }
            if (wid < 2) {
                const float* G = (const float*)(lds + L_G) + wid * 1024 + lane_o;
                bf16_t* ob = hcat + (size_t)(b * SEQ + t0 + wid * 32) * DM + h * 512 + sl * 32;
                const int lofs = hi * 4 * DM + r32;
#pragma unroll
                for (int r = 0; r < 16; ++r) { const float v = oi[r] + G[r * 64], vn = dpp_xor1(v);
                    if ((r32 & 1) == 0) *(unsigned*)((ob + (size_t)((r & 3) + 8 * (r >> 2)) * DM) + lofs) = cvt_pk_bf16(v, vn); }
                if (sl == 0 && hi == 0) deni[t0 + wid * 32 + r32] = psi;
            }
        }
#undef MC_LOAD
        __syncthreads();
    }
}
#undef TRRD

__device__ __forceinline__ void p5_mlstm_norm(const Args& a) {
    const int tid = threadIdx.x, lane = tid & 63, wid = tid >> 6;
    const int gw = blockIdx.x * 8 + wid, nw = gridDim.x * 8;
    const bf16_t* proj = (const bf16_t*)(a.ws + WS_R); bf16_t* hcat = (bf16_t*)a.out;
    const float* den = (const float*)(a.ws + WS_DEN); const float* fl = (const float*)(a.ws + WS_FLOOR); const float* mn = a.in[4];
    for (int it = gw; it < M_TOK * 4; it += nw) {
        const int tk = it >> 2, h = it & 3, b = tk >> 12, t = tk & (SEQ - 1), bh = b * 4 + h;
        bf16_t* hp = hcat + (size_t)tk * DM + h * 512 + lane * 8;
        float x[8], og[8];
        unpack8(*(const bf16x8*)hp, x); unpack8(*(const bf16x8*)(proj + (size_t)tk * AB_NP + AB_OG + h * 512 + lane * 8), og);
#if MLSTM_CHUNK && !MLSTM_BOTH && (DEBUG_CMP < 0)
        float dsum = ((const float*)(a.ws + WS_DENI))[(size_t)bh * SEQ + t];
#pragma unroll
        for (int q = 0; q < 16; ++q) dsum += ((const float*)(a.ws + WS_DENP))[(size_t)(bh * 16 + q) * SEQ + t];
#else
        const float dsum = den[(size_t)bh * SEQ + t];
#endif
        const float dd = fmaxf(fabsf(dsum), fl[(size_t)bh * SEQ + t]); const float inv = 1.0f / dd;
        float s = 0.f;
#pragma unroll
        for (int j = 0; j < 8; ++j) { x[j] *= inv; s += x[j] * x[j]; }
        s = wave_sum(s);
        const float r = rsqrtf(s * (1.0f / 512.0f) + RMS_EPS);
#pragma unroll
        for (int j = 0; j < 8; ++j) x[j] = x[j] * r * mn[h * 512 + lane * 8 + j] * sigmoid_f(og[j]);
        *(bf16x8*)hp = pack8f(x);
    }
}
__device__ __forceinline__ int xcd_unit(int k, int per, int groups, int upg) {
    const int w = blockIdx.x, G = gridDim.x;
    if (G != 256 || per * 256 != groups * upg) return w + k * G;
    const int j = w & 7, s = w >> 3, lu = k * 32 + s;
    return (j * (groups >> 3) + lu / upg) * upg + lu % upg;
}
__device__ __forceinline__ void p5_mla(char* lds, const Args& a) {
    const int tid = threadIdx.x, wid = __builtin_amdgcn_readfirstlane(tid >> 6), lane = tid & 63, r32 = lane & 31, hi = lane >> 5;
    const bf16_t* qb = (const bf16_t*)(a.ws + WS_QB); const bf16_t* kvb = (const bf16_t*)(a.ws + WS_KVB); const bf16_t* krope = (const bf16_t*)(a.ws + WS_KROPE);
    bf16_t* hcat = (bf16_t*)a.out;     const f32x2* rp = (const f32x2*)(a.ws + WS_ROPE);
    for (int kk = 0; kk * (int)gridDim.x < 64 * 8 * 2; ++kk) {
        const int it2 = xcd_unit(kk >> 1, 2, 64, 8), pass = kk & 1; if (it2 >= 512) break;
        const int bh = it2 >> 3, x = it2 & 7, b = bh >> 4, h = bh & 15;
        const int qblk = pass ? 15 - x : x, t0 = qblk * 256, pos = t0 + wid * 32 + r32;
        const bf16_t* qrow = qb + (size_t)(b * SEQ + pos) * 3072 + h * 192;
        bf16x8 qr[8], qrr[4];
#pragma unroll
        for (int d0 = 0; d0 < 8; ++d0) qr[d0] = *(const bf16x8*)(qrow + d0 * 16 + hi * 8);
#pragma unroll
        for (int d0 = 0; d0 < 4; ++d0) qrr[d0] = *(const bf16x8*)(qrow + 128 + d0 * 16 + hi * 8);
#pragma unroll
        for (int g = 0; g < 2; ++g) { float x1[8], x2[8], o1[8], o2[8]; unpack8(qrr[g], x1); unpack8(qrr[2 + g], x2);
#pragma unroll
            for (int j = 0; j < 8; ++j) { const f32x2 cs = rp[(size_t)pos * 32 + g * 16 + hi * 8 + j]; o1[j] = x1[j] * cs.x - x2[j] * cs.y; o2[j] = x1[j] * cs.y + x2[j] * cs.x; }
            char* qpark = lds + fa::OFF_QPARK + wid * 4096 + lane * 16;
            *(bf16x8*)(qpark + g * 1024) = pack8f(o1); *(bf16x8*)(qpark + (2 + g) * 1024) = pack8f(o2); }
        fa::FUnit u; u.Kb = kvb + (size_t)(b * SEQ) * 4096 + h * 256; u.ldk = 4096; u.Vb = u.Kb + 128; u.ldv = 4096; u.KRb = krope + (size_t)(b * SEQ) * 64;
        u.j_lo = 0; u.j_hi = (t0 + 255) / 64 + 1; u.qlo = t0 + wid * 32; u.qhi = u.qlo + 31; u.qpos = pos; u.sel = 0ull;
        f32x16 o[4]; float m_reg, l_reg;
        fa::flash_core<0>(lds, u, qr, 0.07216878364870322f, o, m_reg, l_reg);
        float rf[16]; fa::row_factors(lds, wid, r32, hi, 1.0f / l_reg, rf);
        bf16_t* ob = hcat + (size_t)(b * SEQ + t0 + wid * 32) * DM + 2048 + h * 128;
#pragma unroll
        for (int r = 0; r < 16; ++r) { const int orow = fa::crow(r, hi);
#pragma unroll
            for (int d0 = 0; d0 < 4; ++d0) { const float v = o[d0][r] * rf[r]; const float vn = __shfl_xor(v, 1);
                if ((r32 & 1) == 0) *(unsigned*)(ob + (size_t)orow * DM + d0 * 32 + r32) = cvt_pk_bf16(v, vn); } }
        __syncthreads();
    }
}

__device__ __forceinline__ void p7_layernorm(const Args& a, int layer_idx, bool mix, const float* z, float* outf, bf16_t* outb, f32x2* stats) {
    const int tid = threadIdx.x, lane = tid & 63, wid = tid >> 6;
    const int gw = blockIdx.x * 8 + wid, nw = gridDim.x * 8;
    const float* g = (mix ? a.in[22] : a.in[24]) + (size_t)layer_idx * DM; const float* bb = (mix ? a.in[23] : a.in[25]) + (size_t)layer_idx * DM;
    for (int row = gw; row < M_TOK; row += nw) {
        const float* zr = z + (size_t)row * DM;
        f32x4 v[16]; float s = 0.f;
#pragma unroll
        for (int i = 0; i < 16; ++i) { v[i] = *(const f32x4*)(zr + i * 256 + lane * 4); s += (v[i][0] + v[i][1]) + (v[i][2] + v[i][3]); }
        s = wave_sum(s); const float mu = s * (1.0f / DM);
        float q = 0.f;
#pragma unroll
        for (int i = 0; i < 16; ++i) { const f32x4 d = v[i] - mu; q += (d[0] * d[0] + d[1] * d[1]) + (d[2] * d[2] + d[3] * d[3]); }
        q = wave_sum(q); const float rs = rsqrtf(q * (1.0f / DM) + LN_EPS);
        if (stats && lane == 0) stats[row] = (f32x2){mu, rs};
#pragma unroll
        for (int i = 0; i < 16; ++i) { const int c = i * 256 + lane * 4; const f32x4 gg = *(const f32x4*)(g + c), be = *(const f32x4*)(bb + c);
            const f32x4 y = (v[i] - mu) * rs * gg + be;
            if (outf) *(f32x4*)(outf + (size_t)row * DM + c) = y;
            if (outb) { u32x2 w; w.x = cvt_pk_bf16(y[0], y[1]); w.y = cvt_pk_bf16(y[2], y[3]); *(u32x2*)(outb + (size_t)row * DM + c) = w; } }
    }
}
__device__ __forceinline__ void p7_layernorm_b(const Args& a, int layer_idx, bool mix, const bf16_t* zb, float* outf, bf16_t* outb, f32x2* stats) {
    const int tid = threadIdx.x, lane = tid & 63, wid = tid >> 6;
    const int gw = blockIdx.x * 8 + wid, nw = gridDim.x * 8;
    const float* g = (mix ? a.in[22] : a.in[24]) + (size_t)layer_idx * DM; const float* bb = (mix ? a.in[23] : a.in[25]) + (size_t)layer_idx * DM;
    bf16x8 nx[8];
    if (gw < M_TOK) {
#pragma unroll
        for (int i = 0; i < 8; ++i) nx[i] = *(const bf16x8*)(zb + (size_t)gw * DM + i * 512 + lane * 8); }
    for (int row = gw; row < M_TOK; row += nw) {
        float v[8][8]; float s = 0.f;
#pragma unroll
        for (int i = 0; i < 8; ++i) { unpack8h(nx[i], v[i]); s += ((v[i][0] + v[i][1]) + (v[i][2] + v[i][3])) + ((v[i][4] + v[i][5]) + (v[i][6] + v[i][7])); }
        { const int rn = row + nw < M_TOK ? row + nw : row;
#pragma unroll
          for (int i = 0; i < 8; ++i) nx[i] = *(const bf16x8*)(zb + (size_t)rn * DM + i * 512 + lane * 8); }
        s = wave_sum(s); const float mu = s * (1.0f / DM);
        float q = 0.f;
#pragma unroll
        for (int i = 0; i < 8; ++i)
#pragma unroll
            for (int j = 0; j < 8; ++j) { const float d = v[i][j] - mu; q += d * d; }
        q = wave_sum(q); const float rs = rsqrtf(q * (1.0f / DM) + LN_EPS);
        if (stats && lane == 0) stats[row] = (f32x2){mu, rs};
#pragma unroll
        for (int i = 0; i < 8; ++i) { const int c = i * 512 + lane * 8; const f32x4 g0 = *(const f32x4*)(g + c), g1 = *(const f32x4*)(g + c + 4), b0 = *(const f32x4*)(bb + c), b1 = *(const f32x4*)(bb + c + 4);
            float y[8];
#pragma unroll
            for (int j = 0; j < 4; ++j) { y[j] = (v[i][j] - mu) * rs * g0[j] + b0[j]; y[4 + j] = (v[i][4 + j] - mu) * rs * g1[j] + b1[j]; }
            if (outf) { *(f32x4*)(outf + (size_t)row * DM + c) = (f32x4){y[0], y[1], y[2], y[3]}; *(f32x4*)(outf + (size_t)row * DM + c + 4) = (f32x4){y[4], y[5], y[6], y[7]}; }
            if (outb) *(bf16x8*)(outb + (size_t)row * DM + c) = pack8f(y); }
    }
}
__device__ __forceinline__ void p12_blocks(const Args& a) {
    const bf16_t* projc = (const bf16_t*)(a.ws + WS_R);
    const size_t gt = (size_t)blockIdx.x * NTHREADS + threadIdx.x, gs = (size_t)gridDim.x * NTHREADS;
    for (size_t i = gt; i < (size_t)2 * 4096 * 512; i += gs) {
        const int which = (int)(i / ((size_t)4096 * 512)); const int rem = (int)(i % ((size_t)4096 * 512));
        const int r = rem >> 9, l = (rem >> 4) & 31, d8 = rem & 15, g = r & 3, n = (r >> 2) & 255, b = r >> 10;
        bf16_t* A = (bf16_t*)(a.ws + (which ? WS_AV : WS_AK)); const float* pe = which ? a.in[13] : a.in[12];
        float f[8];
        if (n < 255) { unpack8(*(const bf16x8*)(projc + (size_t)(b * SEQ + 16 * n + l) * C_NP + (which ? C_VC : C_KC) + g * 128 + d8 * 8), f);
#pragma unroll
            for (int j = 0; j < 8; ++j) f[j] += pe[l * 128 + d8 * 8 + j]; }
        else {
#pragma unroll
            for (int j = 0; j < 8; ++j) f[j] = 0.f; }
        *(bf16x8*)(A + (size_t)r * 4096 + l * 128 + d8 * 8) = pack8f(f);
    }
}
__device__ __forceinline__ float nsa_gate(const Args& a, int token, int br, int head) {
    const bf16_t* projc = (const bf16_t*)(a.ws + WS_R);
    return sigmoid_f(bf2f(projc[(size_t)token * C_NP + C_GATE + br * 32 + head]) + a.in[11][br * 32 + head]);
}
__device__ __forceinline__ void p15_cmp_attn(char* lds, const Args& a) {
    const int tid = threadIdx.x, wid = __builtin_amdgcn_readfirstlane(tid >> 6), lane = tid & 63, r32 = lane & 31, hi = lane >> 5;
    const bf16_t* projc = (const bf16_t*)(a.ws + WS_R); const bf16_t* kcmp = (const bf16_t*)(a.ws + WS_KCMP); const bf16_t* vcmp = (const bf16_t*)(a.ws + WS_VCMP);
    float* acc = (float*)(a.ws + WS_Z); unsigned long long* selp = (unsigned long long*)(a.ws + WS_SEL);
    const float scale = 0.08838834764831845f, C2 = 1.4426950408889634f * scale;
    float* IMP = (float*)(lds + fa::OFF_IMP);
    for (int kk = 0; kk * (int)gridDim.x < 2048; ++kk) {
        const int unit = xcd_unit(kk, 8, 16, 128); if (unit >= 2048) break;
        const int bg = unit >> 7, xb = unit & 127, b = bg >> 2, g = bg & 3, t0 = xb * 32;
        const int tokl = wid * 4 + (r32 >> 3), head = g * 8 + (r32 & 7), tq = t0 + tokl;
        const bf16_t* qrow = projc + (size_t)(b * SEQ + tq) * C_NP + C_Q + head * 128;
        bf16x8 qr[8];
#pragma unroll
        for (int d0 = 0; d0 < 8; ++d0) qr[d0] = *(const bf16x8*)(qrow + d0 * 16 + hi * 8);
        fa::FUnit u; u.Kb = kcmp + (size_t)(b * 256 * 4 + g) * 256; u.ldk = 1024; u.Vb = vcmp + (size_t)(b * 256 * 4 + g) * 256; u.ldv = 1024; u.KRb = nullptr;
        const int nmax_hi = (t0 + 31 - 31) >> 4;
        u.j_lo = 0; u.j_hi = (nmax_hi >> 6) + 1; u.qlo = (t0 + wid * 4 - 31) >> 4; u.qhi = (t0 + wid * 4 + 3 - 31) >> 4; u.qpos = (tq - 31) >> 4; u.sel = 0ull;
        f32x16 o[4]; float m_reg, l_reg;
        fa::flash_core<3>(lds, u, qr, scale, o, m_reg, l_reg);
        const float inv_l = l_reg > 0.f ? 1.0f / l_reg : 0.f;
        { float rf[16]; fa::row_factors(lds, wid, r32, hi, inv_l * nsa_gate(a, b * SEQ + tq, 0, head), rf);
#pragma unroll
          for (int r = 0; r < 16; ++r) { const int orow = fa::crow(r, hi); const int tk = t0 + wid * 4 + (orow >> 3), hd = g * 8 + (orow & 7);
              float* op = acc + (size_t)(b * SEQ + tk) * DM + hd * 128 + r32;
#pragma unroll
              for (int d0 = 0; d0 < 4; ++d0) op[d0 * 32] = o[d0][r] * rf[r]; } }
        __syncthreads();
        const float mL = -m_reg * C2;
        const int sr = tid >> 4, sc = (tid & 15) * 8, kws = KSWZ(sr, sc * 2);
        for (int t = 0; t < u.j_hi; ++t) {
            const int kb = t * 64;
            const bf16x8 k0 = *(const bf16x8*)(u.Kb + (long)(kb + sr) * u.ldk + sc), k1 = *(const bf16x8*)(u.Kb + (long)(kb + 32 + sr) * u.ldk + sc);
            *(bf16x8*)(lds + fa::OFF_K + kws) = k0; *(bf16x8*)(lds + fa::OFF_K + kws + 32 * 256) = k1;
            __syncthreads();
            f32x16 p0, p1; fa::qkt<0, false, true>(p0, p1, lds, r32, hi, qr);
            fa::mask_tile(p0, p1, u.qpos - kb - 4 * hi, 0x80000000u);
#pragma unroll
            for (int r = 0; r < 16; ++r) {
                float a0 = __builtin_amdgcn_exp2f(fmaf(p0[r], C2, mL)) * inv_l, a1 = __builtin_amdgcn_exp2f(fmaf(p1[r], C2, mL)) * inv_l;
                a0 += dpp_xor1(a0); a0 += dpp_xor2(a0); a0 += dpp_hmir(a0);
                a1 += dpp_xor1(a1); a1 += dpp_xor2(a1); a1 += dpp_hmir(a1);
                if ((r32 & 7) == 0) { const int n = kb + fa::crow(r, hi); IMP[tokl * fa::IMP_LD + n] = a0; IMP[tokl * fa::IMP_LD + n + 32] = a1; }
            }
            __syncthreads();
        }
        for (int q4 = 0; q4 < 4; ++q4) {
            const int tl = wid * 4 + q4, tqq = t0 + tl, cur = tqq >> 6, s = lane;
            float v = 0.f;
#pragma unroll
            for (int dn = -1; dn <= 3; ++dn) { const int n = 4 * s + dn; if (n >= 0 && n <= 254 && n < u.j_hi * 64) v += IMP[tl * fa::IMP_LD + n]; }
            if (s == 0 || s == cur || s == cur - 1) v = 1e9f;
            if (s > cur) v = -1e30f;
            int rank = 0;
#pragma nounroll
            for (int j = 0; j < 64; ++j) { const float vj = __int_as_float(__builtin_amdgcn_readlane(__float_as_int(v), j)); rank += (vj > v || (vj == v && j < s)) ? 1 : 0; }
            const unsigned long long msk = __ballot(rank < 16);
            if (lane == 0) selp[(size_t)bg * SEQ + tqq] = msk;
        }
        __syncthreads();
    }
}
template <int MODE, int VAR = 0>
__device__ __forceinline__ void p16_nsa_attn(char* lds, const Args& a) {
    const int tid = threadIdx.x, wid = __builtin_amdgcn_readfirstlane(tid >> 6), lane = tid & 63, r32 = lane & 31, hi = lane >> 5;
    const bf16_t* projc = (const bf16_t*)(a.ws + WS_R); float* acc = (float*)(a.ws + WS_Z); bf16_t* hcat = (bf16_t*)a.out;
    const unsigned long long* selp = (const unsigned long long*)(a.ws + WS_SEL);
    const float scale = 0.08838834764831845f;
    const int nitems = (MODE == 2) ? 2048 : 2048;
    for (int kk = 0; kk * (int)gridDim.x < nitems; ++kk) {
        int bg, xb;
        if (MODE == 2) { const int pass = kk & 1, it2 = xcd_unit(kk >> 1, 4, 16, 64); if (it2 >= 1024) break; bg = it2 >> 6; const int x = it2 & 63; xb = pass ? 127 - x : x; }
        else { const int item = xcd_unit(kk, 8, 16, 128); if (item >= 2048) break; bg = item >> 7; xb = item & 127; }
        const int b = bg >> 2, g = bg & 3, t0 = xb * 32, head = g * 8 + wid, tq = t0 + r32;
        const bf16_t* qrow = projc + (size_t)(b * SEQ + tq) * C_NP + C_Q + head * 128;
        bf16x8 qr[8];
#pragma unroll
        for (int d0 = 0; d0 < 8; ++d0) qr[d0] = *(const bf16x8*)(qrow + d0 * 16 + hi * 8);
        fa::FUnit u; u.KRb = nullptr; u.ldk = C_NP; u.ldv = C_NP; u.qlo = t0; u.qhi = t0 + 31; u.qpos = tq; u.sel = 0ull;
        if (MODE == 1) { u.Kb = projc + (size_t)(b * SEQ) * C_NP + C_KW + g * 128; u.Vb = projc + (size_t)(b * SEQ) * C_NP + C_VW + g * 128;
            const int lowk = t0 - 511; u.j_lo = lowk > 0 ? lowk / 64 : 0; u.j_hi = (t0 + 31) / 64 + 1; }
        else { u.Kb = projc + (size_t)(b * SEQ) * C_NP + C_KS + g * 128; u.Vb = projc + (size_t)(b * SEQ) * C_NP + C_VS + g * 128;
            u.j_lo = 0; u.j_hi = (t0 + 31) / 64 + 1; u.sel = selp[(size_t)bg * SEQ + tq]; }
        f32x16 o[4]; float m_reg, l_reg;
#if FLASH2
        fa::flash_core2<MODE>(lds, u, qr, scale, o, m_reg, l_reg);
#else
        fa::flash_core<MODE, VAR>(lds, u, qr, scale, o, m_reg, l_reg);
#endif
        float rf[16]; fa::row_factors(lds, wid, r32, hi, nsa_gate(a, b * SEQ + tq, MODE == 1 ? 2 : 1, head) / l_reg, rf);
        if (VAR != 0) { float sink = 0.f; for (int d0 = 0; d0 < 4; ++d0) for (int r = 0; r < 16; ++r) sink += o[d0][r] * rf[r]; if (sink == 1.2345e-30f) acc[0] = sink; __syncthreads(); continue; }
        const size_t off0 = (size_t)(b * SEQ + t0 + 4 * hi) * DM + head * 128 + r32;
        float av[16][4];
#pragma unroll
        for (int r = 0; r < 16; ++r)
#pragma unroll
            for (int d0 = 0; d0 < 4; ++d0) av[r][d0] = acc[off0 + (size_t)((r & 3) + 8 * (r >> 2)) * DM + d0 * 32];
        asm volatile("" ::: "memory");
#pragma unroll
        for (int r = 0; r < 16; ++r) { const size_t off = off0 + (size_t)((r & 3) + 8 * (r >> 2)) * DM;
#pragma unroll
            for (int d0 = 0; d0 < 4; ++d0) { const float v = av[r][d0] + o[d0][r] * rf[r];
                if (MODE == 1) acc[off + d0 * 32] = v;
                else { const float vn = dpp_xor1(v); if ((r32 & 1) == 0) *(unsigned*)(hcat + off + d0 * 32) = cvt_pk_bf16(v, vn); } } }
        __syncthreads();
    }
}


#ifndef DEBUG_CMP
#define DEBUG_CMP -1
#endif
#if DEBUG_CMP >= 0
__device__ __forceinline__ void dbg_copy(const Args& a) {
    const bf16_t* hcat = (const bf16_t*)(a.ws + WS_XB); bf16_t* dbg = (bf16_t*)(a.ws + WS_Z);
    const size_t gt = (size_t)blockIdx.x * NTHREADS + threadIdx.x, gs = (size_t)gridDim.x * NTHREADS;
    for (size_t i = gt; i < (size_t)M_TOK * 256; i += gs) { const size_t row = i >> 8, c8 = i & 255; *(bf16x8*)(dbg + row * 2048 + c8 * 8) = *(const bf16x8*)(hcat + row * DM + c8 * 8); }
}
__device__ __forceinline__ void dbg_compare(const Args& a) {
    const bf16_t* hcat = (const bf16_t*)(a.ws + WS_XB); const bf16_t* dbg = (const bf16_t*)(a.ws + WS_Z);
    float* accum = (float*)(a.ws + WS_CTL + 32 * 1024);
    const size_t gt = (size_t)blockIdx.x * NTHREADS + threadIdx.x, gs = (size_t)gridDim.x * NTHREADS;
    float sd = 0.f, sr = 0.f;
    for (size_t i = gt; i < (size_t)M_TOK * 256; i += gs) { const size_t row = i >> 8, c8 = i & 255; const int t = (int)(row & (SEQ - 1));
        bool in = false;
        if (DEBUG_CMP == 0) in = t < 32; if (DEBUG_CMP == 1) in = t >= 32 && t < 64; if (DEBUG_CMP == 2) in = t >= 64 && t < 128; if (DEBUG_CMP == 3) in = true;
        if (DEBUG_CMP == 4) in = (t & 63) < 32; if (DEBUG_CMP == 5) in = (t & 63) >= 32;
        if (!in) continue;
        float x[8], y[8]; unpack8(*(const bf16x8*)(hcat + row * DM + c8 * 8), x); unpack8(*(const bf16x8*)(dbg + row * 2048 + c8 * 8), y);
#pragma unroll
        for (int j = 0; j < 8; ++j) { const float d = x[j] - y[j]; sd += d * d; sr += x[j] * x[j]; } }
    sd = wave_sum(sd); sr = wave_sum(sr);
    if ((threadIdx.x & 63) == 0) { atomicAdd((unsigned long long*)accum, (unsigned long long)(sd * 1048576.0f)); atomicAdd((unsigned long long*)accum + 1, (unsigned long long)(sr * 1048576.0f)); }
}
#endif

constexpr int N_PHASES = 23;
__global__ void __launch_bounds__(NTHREADS, 2) fwd(Args args) {
    extern __shared__ __attribute__((aligned(16))) unsigned char shm[];
    char* lds = (char*)shm;
    PG8_LAS unsigned char* ldsg = (PG8_LAS unsigned char*)shm;
    unsigned char* ws = args.ws;
    if (threadIdx.x < 64) ((volatile LAS unsigned*)(ldsg + LDS_CTL_OFF))[threadIdx.x] = 0u;
    __syncthreads();
    XcdBarrier bar = xcd_barrier_post((unsigned*)(ws + WS_CTL), (volatile LAS unsigned*)(ldsg + LDS_CTL_OFF));
    const int lo = args.ph_lo, hi = args.ph_hi, G = gridDim.x, bx = blockIdx.x;
#define IN(k) (lo <= (k) && (k) < hi)
#define SEAM(k) do { if (IN(k) && IN((k) + 1)) xcd_barrier(bar); } while (0)
#define GEMMC(EPI, cidx, Aoff, Boff, Mr, Nr, Kr, ...) do { pg8::Gemm g_{(const pg8::bf16_t*)(ws + (Aoff)), (const pg8::bf16_t*)(ws + (Boff)), (Mr), (Nr), (Kr)}; pg8::StaticOrder S_; S_.init((Mr), (Nr), G, (cidx)); S_.WGM = GEMM_WGM; \
        EPI E_{__VA_ARGS__}; pg8::gemm_phase<EPI, pg8::StaticOrder, true, true>(ldsg, g_, S_, E_); } while (0)
#define GEMM(EPI, ...) GEMMC(EPI, bx, __VA_ARGS__)
#define GEMMA(EPI, Aptr, Boff, Mr, Nr, Kr, ...) do { pg8::Gemm g_{(const pg8::bf16_t*)(Aptr), (const pg8::bf16_t*)(ws + (Boff)), (Mr), (Nr), (Kr)}; pg8::StaticOrder S_; S_.init((Mr), (Nr), G, bx); S_.WGM = GEMM_WGM; \
        EPI E_{__VA_ARGS__}; pg8::gemm_phase<EPI, pg8::StaticOrder, true, true>(ldsg, g_, S_, E_); } while (0)
#define GEMM_WGM gemm_wgm
    float* xres = args.out;
    bf16_t* xb = (bf16_t*)(ws + WS_XB); const bf16_t* hcat = (const bf16_t*)args.out; f32x2* stats = (f32x2*)(ws + WS_STATS);
    bf16_t* zA = (bf16_t*)(ws + WS_Z); bf16_t* zB = (bf16_t*)args.out + (size_t)M_TOK * DM; bf16_t* zC = zA; bf16_t* zD = zA + (size_t)M_TOK * DM;

#ifndef FFN_CHUNKED
#define FFN_CHUNKED 0
#endif
#ifndef WGM_IN
#define WGM_IN 8
#endif
#ifndef WGM_WO
#define WGM_WO 4
#endif
#ifndef WGM_UP
#define WGM_UP 8
#endif
#ifndef WGM_DOWN
#define WGM_DOWN 2
#endif
    int gemm_wgm = 8;
#ifndef PROBE_MASK
#define PROBE_MASK 0u
#endif
#define PB(k) (((PROBE_MASK) >> (k)) & 1u)
#define PH(k, ...) do { if (IN(k)) { __VA_ARGS__; if (PB(k)) { xcd_barrier(bar); __VA_ARGS__; } } SEAM(k); } while (0)
    PH(0, p0_prologue(lds, args));
    gemm_wgm = WGM_IN; PH(1, GEMM(pg8::EpiProj, WS_XB, W_AB, M_TOK, AB_NP, DM, (bf16_t*)(ws + WS_R), AB_NP, (float*)(ws + WS_GATES), AB_IG / 256); if (bx >= 192 && G == 256) transpose_late(lds, args, bx - 192));
    PH(2, p2_prep(args));
    gemm_wgm = 8; if (IN(3)) { GEMM(pg8::EpiB<0>, WS_CQN, W_UQ, M_TOK, 3072, 1024, (bf16_t*)(ws + WS_QB), 3072); GEMM(pg8::EpiB<0>, WS_CKVN, W_UKV, M_TOK, 4096, 512, (bf16_t*)(ws + WS_KVB), 4096); }
    if (!(IN(3) && IN(4))) SEAM(3);
#if DEBUG_CMP >= 0
#if MC_VALU_STATE == 4
    PH(4, p4_mlstm_chunk(lds, args); xcd_barrier(bar); p4_mlstm(lds, args));
#else
    PH(4, p4_mlstm_chunk(lds, args); xcd_barrier(bar); dbg_copy(args); xcd_barrier(bar); p4_mlstm(lds, args); xcd_barrier(bar); dbg_compare(args));
#endif
#elif MLSTM_BOTH
    PH(4, p4_mlstm_chunk(lds, args); xcd_barrier(bar); p4_mlstm(lds, args));
#elif MLSTM_CHUNK
    PH(4, p4_mlstm_chunk(lds, args));
#else
    PH(4, p4_mlstm(lds, args));
#endif
    if (IN(5)) { p5_mlstm_norm(args); p5_mla(lds, args); if (PB(5)) { xcd_barrier(bar); p5_mla(lds, args); } } SEAM(5);
    gemm_wgm = WGM_WO; PH(6, GEMMA(pg8::EpiResidB, hcat, W_O0, M_TOK, DM, DM, zA, xb));
    PH(7, p7_layernorm_b(args, 0, true, zA, nullptr, xb, stats));
#if FFN_CHUNKED
#define FFN_UP(WGU, half) GEMM(pg8::EpiSwiGLU, WS_XB + (size_t)(half) * 8192 * DM * 2, WGU, 8192, GU_N, DM, (bf16_t*)(ws + WS_R) + (size_t)(half) * 8192 * FFH, FFH)
#define FFN_DOWN(WD, half, Cp, Zpp, lg, lb) GEMM(pg8::EpiResidLN, WS_R + (size_t)(half) * 8192 * FFH * 2, WD, 8192, DM, FFH, (Cp) + (size_t)(half) * 8192 * DM, (Zpp) + (size_t)(half) * 8192 * DM, stats + (half) * 8192, lg, lb, DM, DN_ALPHA)
    if (IN(8)) { gemm_wgm = WGM_UP; FFN_UP(W_GU0, 0); if (bx >= 192 && G == 256) transpose_late(lds, args, 64 + bx - 192); } SEAM(8);
    if (IN(9)) { gemm_wgm = WGM_DOWN; FFN_DOWN(W_D0, 0, xres, z, args.in[22], args.in[23]); gemm_wgm = WGM_UP; FFN_UP(W_GU0, 1); if (bx >= 192 && G == 256) transpose_late(lds, args, 128 + bx - 192);
                 xcd_barrier(bar); gemm_wgm = WGM_DOWN; FFN_DOWN(W_D0, 1, xres, z, args.in[22], args.in[23]); } SEAM(9);
#else
    gemm_wgm = WGM_UP; PH(8, GEMM(pg8::EpiSwiGLU, WS_XB, W_GU0, M_TOK, GU_N, DM, (bf16_t*)(ws + WS_R), FFH); if (bx >= 128 && G == 256) transpose_late(lds, args, 64 + bx - 128));
    gemm_wgm = WGM_DOWN; PH(9, GEMM(pg8::EpiResidLNB, WS_R, W_D0, M_TOK, DM, FFH, zB, zA, stats, args.in[22], args.in[23]));
#endif
    PH(10, p7_layernorm_b(args, 0, false, zB, nullptr, xb, stats));
    gemm_wgm = WGM_IN; PH(11, GEMM(pg8::EpiB<0>, WS_XB, W_C, M_TOK, C_NP, DM, (bf16_t*)(ws + WS_R), C_NP); if (bx >= 64 && G == 256) transpose_late(lds, args, 192 + bx - 64));
    PH(12, p12_blocks(args));
    gemm_wgm = 8; PH(13, GEMM(pg8::EpiB<1>, WS_AK, W_C1K, 4096, 256, 4096, (bf16_t*)(ws + WS_HK), 256);
           GEMMC(pg8::EpiB<1>, (bx + G - 16) % G, WS_AV, W_C1V, 4096, 256, 4096, (bf16_t*)(ws + WS_HV), 256);
           if (G == 256) { if (bx >= 32) transpose_late(lds, args, 384 + bx - 32); } else { for (int sl_ = bx; sl_ < LATE_SLOTS; sl_ += G) transpose_late(lds, args, sl_); });
    PH(14, GEMM(pg8::EpiB<0>, WS_HK, W_C2K, 4096, 256, 256, (bf16_t*)(ws + WS_KCMP), 256);
           GEMMC(pg8::EpiB<0>, (bx + G - 16) % G, WS_HV, W_C2V, 4096, 256, 256, (bf16_t*)(ws + WS_VCMP), 256));
    if (IN(15)) { p15_cmp_attn(lds, args); } SEAM(15);
    if (IN(16)) { p16_nsa_attn<1>(lds, args); if (PB(16)) { xcd_barrier(bar); p15_cmp_attn(lds, args); xcd_barrier(bar); p16_nsa_attn<1>(lds, args); } } SEAM(16);
#ifndef PROBE_VAR
#define PROBE_VAR 0
#endif
    if (IN(17)) { p16_nsa_attn<2>(lds, args); if (PB(17)) { xcd_barrier(bar); p16_nsa_attn<2, PROBE_VAR>(lds, args); } } SEAM(17);
    gemm_wgm = WGM_WO; PH(18, GEMMA(pg8::EpiResidLNB, hcat, W_O1, M_TOK, DM, DM, zC, zB, stats, args.in[24], args.in[25]));
    PH(19, p7_layernorm_b(args, 1, true, zC, nullptr, xb, stats));
#if FFN_CHUNKED
    if (IN(20)) { gemm_wgm = WGM_UP; FFN_UP(W_GU1, 0); } SEAM(20);
    if (IN(21)) { gemm_wgm = WGM_DOWN; FFN_DOWN(W_D1, 0, xres, z, args.in[22] + DM, args.in[23] + DM); gemm_wgm = WGM_UP; FFN_UP(W_GU1, 1);
                  xcd_barrier(bar); gemm_wgm = WGM_DOWN; FFN_DOWN(W_D1, 1, xres, z, args.in[22] + DM, args.in[23] + DM); } SEAM(21);
#else
    gemm_wgm = WGM_UP; PH(20, GEMM(pg8::EpiSwiGLU, WS_XB, W_GU1, M_TOK, GU_N, DM, (bf16_t*)(ws + WS_R), FFH));
    gemm_wgm = WGM_DOWN; PH(21, GEMM(pg8::EpiResidLNB, WS_R, W_D1, M_TOK, DM, FFH, zD, zC, stats, args.in[22] + DM, args.in[23] + DM));
#endif
    PH(22, p7_layernorm_b(args, 1, false, zD, xres, nullptr, nullptr));
#if DEBUG_CMP >= 0
    if (IN(22)) { xcd_barrier(bar); if (bx == 0 && threadIdx.x == 0) { const unsigned long long* accum = (const unsigned long long*)(ws + WS_CTL + 32 * 1024); const float rel = sqrtf((float)((double)accum[0] / fmax((double)accum[1], 1.0)));
        float k = -20.0f * log10f(fmaxf(rel, 1e-6f)); k = fminf(fmaxf(rintf(k), 0.f), 89.f); xres[0] = 1000.0f + 100.0f * k; } }
#endif
#undef PH
#undef PB
#undef IN
#undef SEAM
#undef GEMM
#undef GEMMC
}

#ifndef MK_N_LAUNCHES
#define MK_N_LAUNCHES 1
#endif
extern "C" void kernel_launch(void* const* d_in, const int* in_sizes, int n_in, void* d_out, int out_size, void* d_ws, size_t ws_size, hipStream_t stream) {
    static int grid = 0;
    if (grid == 0) {
        if (n_in != 26 || in_sizes[0] != M_TOK * DM || out_size != M_TOK * DM || ws_size < WS_END) {
            fprintf(stderr, "kernel_launch: unexpected shapes (n_in %d, in0 %d, out %d, ws %zu, need %zu); nothing launched\n", n_in, n_in > 0 ? in_sizes[0] : -1, out_size, ws_size, (size_t)WS_END); grid = -1; return; }
        int dev = 0, cus = 0, per_cu = 0;
        if (hipGetDevice(&dev) != hipSuccess || hipDeviceGetAttribute(&cus, hipDeviceAttributeMultiprocessorCount, dev) != hipSuccess) { grid = -1; return; }
        if (hipFuncSetAttribute((const void*)fwd, hipFuncAttributeMaxDynamicSharedMemorySize, LDS_BYTES) != hipSuccess) { fprintf(stderr, "kernel_launch: hipFuncSetAttribute failed\n"); grid = -1; return; }
        if (hipOccupancyMaxActiveBlocksPerMultiprocessor(&per_cu, (const void*)fwd, NTHREADS, LDS_BYTES) != hipSuccess || per_cu < 1) { fprintf(stderr, "kernel_launch: occupancy query says %d blocks per CU\n", per_cu); (void)hipGetLastError(); grid = -1; return; }
        grid = cus;
    }
    if (grid < 0) return;
    (void)hipMemsetAsync((char*)d_ws + WS_CTL, 0, 64 * 1024, stream);
    Args a{};
    for (int i = 0; i < 26; ++i) a.in[i] = (const float*)d_in[i];
    a.out = (float*)d_out; a.ws = (unsigned char*)d_ws;
    unsigned char* ws = (unsigned char*)d_ws;
    const float* fg = a.in[19]; const float* fu = a.in[20]; const float* fd = a.in[21];
    const size_t LW = (size_t)DM * FFH;
    int j = 0;
    a.tj[j++] = TJob{a.in[1], nullptr, (bf16_t*)(ws + W_AB), DM, AB_IN, AB_NP, 0};
    a.tj[j++] = TJob{a.in[7], nullptr, (bf16_t*)(ws + W_UQ), 1024, 3072, 3072, 0};
    a.tj[j++] = TJob{a.in[8], nullptr, (bf16_t*)(ws + W_UKV), 512, 4096, 4096, 0};
    a.tj[j++] = TJob{a.in[9], nullptr, (bf16_t*)(ws + W_O0), DM, DM, DM, 0};
    a.tj[j++] = TJob{fg, fu, (bf16_t*)(ws + W_GU0), DM, FFH, GU_N, 1};
    a.tj[j++] = TJob{fd, nullptr, (bf16_t*)(ws + W_D0), FFH, DM, DM, 0};
    a.tj[j++] = TJob{a.in[10], nullptr, (bf16_t*)(ws + W_C), DM, C_IN, C_NP, 0};
    a.tj[j++] = TJob{a.in[14], nullptr, (bf16_t*)(ws + W_C1K), 4096, 256, 256, 0};
    a.tj[j++] = TJob{a.in[16], nullptr, (bf16_t*)(ws + W_C1V), 4096, 256, 256, 0};
    a.tj[j++] = TJob{a.in[15], nullptr, (bf16_t*)(ws + W_C2K), 256, 128, 256, 0};
    a.tj[j++] = TJob{a.in[17], nullptr, (bf16_t*)(ws + W_C2V), 256, 128, 256, 0};
    a.tj[j++] = TJob{a.in[18], nullptr, (bf16_t*)(ws + W_O1), DM, DM, DM, 0};
    a.tj[j++] = TJob{fg + LW, fu + LW, (bf16_t*)(ws + W_GU1), DM, FFH, GU_N, 1};
    a.tj[j++] = TJob{fd + LW, nullptr, (bf16_t*)(ws + W_D1), FFH, DM, DM, 0};
#if MK_N_LAUNCHES == 1
    a.ph_lo = 0; a.ph_hi = N_PHASES;
    hipLaunchKernelGGL(fwd, dim3(grid), dim3(NTHREADS), LDS_BYTES, stream, a);
#else
    for (int p = 0; p < N_PHASES; ++p) { a.ph_lo = p; a.ph_hi = p + 1; hipLaunchKernelGGL(fwd, dim3(grid), dim3(NTHREADS), LDS_BYTES, stream, a); }
#endif
    const hipError_t le = hipPeekAtLastError();
    if (le != hipSuccess) fprintf(stderr, "kernel_launch: launch failed: %s\n", hipGetErrorName(le));
}
```

```cpp
#include <hip/hip_runtime.h>
#include <stdint.h>
#include <stdio.h>
#ifndef FLASH2
#define FLASH2 0
#endif
#ifndef DEBUG_CMP
#define DEBUG_CMP -1
#endif
#ifndef MLSTM_BOTH
#define MLSTM_BOTH 0
#endif
#ifndef MLSTM_CHUNK
#define MLSTM_CHUNK 1
#endif

typedef unsigned short bf16_t;
typedef short bf16x8 __attribute__((ext_vector_type(8)));
typedef short s16x4 __attribute__((ext_vector_type(4)));
typedef float f32x2 __attribute__((ext_vector_type(2)));
typedef float f32x4 __attribute__((ext_vector_type(4)));
typedef float f32x16 __attribute__((ext_vector_type(16)));
typedef unsigned u32x2 __attribute__((ext_vector_type(2)));
typedef unsigned u32x4 __attribute__((ext_vector_type(4)));

constexpr int M_TOK = 16384, SEQ = 4096, NBATCH = 4, DM = 4096;
constexpr int AB_IN = 7752, AB_NP = 7936, C_IN = 7264, C_NP = 7424, FFH = 11008, GU_N = 22016;
constexpr float DN_ALPHA = 1.4142135623730951f;
constexpr float LN_EPS = 1e-5f, RMS_EPS = 1e-6f;
constexpr int AB_Q = 0, AB_K = 1024, AB_V = 2048, AB_IG = 4096, AB_FG = 4100, AB_OG = 4104, AB_CQ = 6152, AB_CKV = 7176, AB_KR = 7688;
constexpr int C_Q = 0, C_KC = 4096, C_VC = 4608, C_KS = 5120, C_VS = 5632, C_KW = 6144, C_VW = 6656, C_GATE = 7168;

__device__ __forceinline__ float bf2f(bf16_t b) { return __uint_as_float(((unsigned)b) << 16); }
__device__ __forceinline__ unsigned cvt_pk_bf16(float lo, float hi) { unsigned r; asm volatile("v_cvt_pk_bf16_f32 %0, %1, %2" : "=v"(r) : "v"(lo), "v"(hi)); return r; }
__device__ __forceinline__ bf16_t f2bf(float f) { return (bf16_t)(cvt_pk_bf16(f, 0.f) & 0xffffu); }
__device__ __forceinline__ void unpack8(const bf16x8 v, float (&f)[8]) {
#pragma unroll
    for (int j = 0; j < 8; ++j) f[j] = bf2f((bf16_t)v[j]);
}
__device__ __forceinline__ bf16x8 pack8f(const float (&f)[8]) {
    u32x4 w = {cvt_pk_bf16(f[0], f[1]), cvt_pk_bf16(f[2], f[3]), cvt_pk_bf16(f[4], f[5]), cvt_pk_bf16(f[6], f[7])};
    return *reinterpret_cast<bf16x8*>(&w);
}
typedef _Float16 f16x2_t __attribute__((ext_vector_type(2)));
__device__ __forceinline__ unsigned cvt_pk_f16(float lo, float hi) { const f16x2_t h = {(_Float16)lo, (_Float16)hi}; return __builtin_bit_cast(unsigned, h); }
__device__ __forceinline__ void unpack8h(const bf16x8 v, float (&f)[8]) {
#pragma unroll
    for (int j = 0; j < 8; ++j) f[j] = (float)__builtin_bit_cast(_Float16, (short)v[j]);
}
__device__ __forceinline__ bf16x8 pack8h(const float (&f)[8]) {
    u32x4 w = {cvt_pk_f16(f[0], f[1]), cvt_pk_f16(f[2], f[3]), cvt_pk_f16(f[4], f[5]), cvt_pk_f16(f[6], f[7])};
    return *reinterpret_cast<bf16x8*>(&w);
}
__device__ __forceinline__ float wave_sum(float v) {
#pragma unroll
    for (int o = 32; o >= 1; o >>= 1) v += __shfl_xor(v, o);
    return v;
}
__device__ __forceinline__ float sigmoid_f(float x) { return __builtin_amdgcn_rcpf(1.0f + __expf(-x)); }

#define XB_TMO      128
#define XB_XCNT(j)  (256  + 64 * (j))
#define XB_XSUB(j)  (1280 + 64 * (j))
#define XB_XGEN(j)  (2304 + 64 * (j))
#define XB_TOP      3328
#define XB_TOPGEN   3392
#define XCD_BAR_WORDS 3456
#define XB_SPIN_CAP (1u << 22)
#define LAS __attribute__((address_space(3)))

__device__ __forceinline__ unsigned xb_ld(unsigned* p)              { return __hip_atomic_load(p, __ATOMIC_RELAXED, __HIP_MEMORY_SCOPE_AGENT); }
__device__ __forceinline__ unsigned xb_add(unsigned* p, unsigned v) { return __hip_atomic_fetch_add(p, v, __ATOMIC_RELAXED, __HIP_MEMORY_SCOPE_AGENT); }
__device__ __forceinline__ unsigned xb_xcc_id() { return (unsigned)__builtin_amdgcn_s_getreg((3 << 11) | 20) & 0xFu; }
#define XB_SPIN(cond, bar) do { unsigned _sp = 0; while (cond) { __builtin_amdgcn_s_sleep(1); \
    if ((++_sp & 255u) == 0u) { if (xb_ld(&(bar)[XB_TMO])) break; if (_sp > XB_SPIN_CAP) { atomicAdd(&(bar)[XB_TMO], 1u); break; } } } } while (0)

struct XcdBarrier {
    unsigned* bar; unsigned x;
    volatile LAS unsigned* st;
};

__device__ __forceinline__ XcdBarrier xcd_barrier_post(unsigned* bar, volatile LAS unsigned* st) {
    XcdBarrier b; b.bar = bar; b.x = xb_xcc_id(); b.st = st;
    if (threadIdx.x == 0) (void)xb_add(&bar[XB_XCNT(b.x)], 1u);
    return b;
}
__device__ __forceinline__ void xcd_barrier_complete(unsigned* bar, unsigned x, unsigned& nloc, unsigned& nx) {
    const unsigned G = gridDim.x * gridDim.y * gridDim.z;
    unsigned sum, cnt, mine, sp = 0u;
    for (;;) {
        sum = 0u; cnt = 0u; mine = 0u;
#pragma unroll
        for (unsigned j = 0; j < 16; ++j) { const unsigned c = xb_ld(&bar[XB_XCNT(j)]); sum += c; cnt += (c > 0u) ? 1u : 0u; mine = (j == x) ? c : mine; }
        if (sum == G) break;
        __builtin_amdgcn_s_sleep(1);
        if ((++sp & 255u) == 0u) { if (xb_ld(&bar[XB_TMO])) break; if (sp > XB_SPIN_CAP) { atomicAdd(&bar[XB_TMO], 1u); break; } }
    }
    nloc = mine > 0u ? mine : 1u; nx = cnt > 0u ? cnt : 1u;
}

__device__ __forceinline__ void xcd_barrier(const XcdBarrier& b) {
    asm volatile("s_waitcnt vmcnt(0)" ::: "memory");
    __syncthreads();
    if (threadIdx.x == 0) {
        unsigned* bar = b.bar;
        __builtin_amdgcn_s_waitcnt(0);
        unsigned nloc = b.st[0], nx = b.st[1];
        if (nloc == 0u) { xcd_barrier_complete(bar, b.x, nloc, nx); b.st[0] = nloc; b.st[1] = nx; }
        const unsigned old = xb_add(&bar[XB_XSUB(b.x)], 1u);
        const unsigned gen = old / nloc;
        if (old + 1u == (gen + 1u) * nloc) {
            __builtin_amdgcn_fence(__ATOMIC_RELEASE, "agent");
            asm volatile("s_waitcnt vmcnt(0)" ::: "memory");
            const unsigned og = xb_add(&bar[XB_TOP], 1u);
            const unsigned tg = og / nx;
            if (og + 1u == (tg + 1u) * nx) xb_add(&bar[XB_TOPGEN], 1u);
            else XB_SPIN(xb_ld(&bar[XB_TOPGEN]) == tg, bar);
            __builtin_amdgcn_fence(__ATOMIC_ACQUIRE, "agent");
            xb_add(&bar[XB_XGEN(b.x)], 1u);
            asm volatile("s_waitcnt vmcnt(0)" ::: "memory");
        } else {
            XB_SPIN(xb_ld(&bar[XB_XGEN(b.x)]) == gen, bar);
            __builtin_amdgcn_fence(__ATOMIC_ACQUIRE, "agent");
            asm volatile("s_waitcnt vmcnt(0)" ::: "memory");
        }
    }
    __syncthreads();
}namespace pg8 {
#define PG8_LAS __attribute__((address_space(3)))
typedef unsigned short bf16_t;
typedef short bf16x8 __attribute__((ext_vector_type(8)));
typedef float f32x4 __attribute__((ext_vector_type(4)));
typedef unsigned u32x4 __attribute__((ext_vector_type(4)));
constexpr int BM = 256, BK = 64, HALF = 128, HTB = HALF * BK * 2  , STAGE_BYTES = 8 * HTB, NXCD = 8;

__host__ __device__ __forceinline__ int lds_byte(int r, int c) { const int st = (r >> 4) * 2 + (c >> 5), rr = r & 15, cc = c & 31, ob = rr * 64 + cc * 2; return st * 1024 + (ob ^ (((ob >> 9) & 1) << 5)); }
__host__ __device__ __forceinline__ void stage_rc(int b, int& R, int& C) { const int st = b / 1024, sb = b % 1024, swz = sb ^ (((sb >> 9) & 1) << 5); R = (st >> 1) * 16 + swz / 64; C = (st & 1) * 32 + (swz % 64) / 2; }
__host__ __device__ __forceinline__ int perm32(int rho) { const int n = rho >> 4, i = rho & 15; return 8 * (i >> 2) + 4 * n + (i & 3); }

struct Unit { int pm, pn; };
struct Gemm { const bf16_t* A; const bf16_t* Bt; int M, N, K; };

struct StaticOrder {
    int nM, nN, nwg, G, c, WGM = 8;
    __host__ __device__ void init(int M, int N, int G_, int c_) { nM = M / BM; nN = N / BM; nwg = nM * nN; G = G_; c = c_; }
    __host__ __device__ bool next(int i, Unit& u) const {
        const long L = (long)i * G + c; if (L >= nwg) return false;
        int wgid = (int)L; { const int q = nwg / NXCD, r = nwg % NXCD, xcd = wgid % NXCD, off = wgid / NXCD; wgid = (xcd < r ? xcd * (q + 1) : r * (q + 1) + (xcd - r) * q) + off; }
        const int nig = WGM * nN, gid = wgid / nig, fm = gid * WGM, gsz = (nM - fm) < WGM ? (nM - fm) : WGM;
        u.pm = fm + ((wgid % nig) % gsz); u.pn = (wgid % nig) / gsz; return true;
    }
    __device__ __forceinline__ void a_ready(const Unit&) const {}
    __device__ __forceinline__ void done(const Unit&) const {}
};
struct CountedOrder : StaticOrder {
    const unsigned* ready; unsigned need; unsigned* tmo;
    __device__ __forceinline__ void a_ready(const Unit& u) const {
        if (threadIdx.x < 64) {
            const unsigned long long t0 = __builtin_amdgcn_s_memrealtime(); unsigned polls = 0;
            while ((unsigned)__builtin_amdgcn_readfirstlane(__hip_atomic_load(ready + 64 * u.pm, __ATOMIC_RELAXED, __HIP_MEMORY_SCOPE_AGENT)) < need) {
                if ((++polls & 255u) == 0u && __builtin_amdgcn_readfirstlane(__hip_atomic_load(tmo, __ATOMIC_RELAXED, __HIP_MEMORY_SCOPE_AGENT)) != 0u) break;
                if (__builtin_amdgcn_s_memrealtime() - t0 > 2000000ull) {
                    if (threadIdx.x == 0) { unsigned expect = 0u; __hip_atomic_compare_exchange_strong(tmo + 1, &expect, 0x600u | (unsigned)(u.pm & 0xff), __ATOMIC_RELAXED, __ATOMIC_RELAXED, __HIP_MEMORY_SCOPE_AGENT); __hip_atomic_store(tmo, 1u, __ATOMIC_RELAXED, __HIP_MEMORY_SCOPE_AGENT); }
                    break; }
                __builtin_amdgcn_s_sleep(2); }
            __builtin_amdgcn_fence(__ATOMIC_ACQUIRE, "agent");
            asm volatile("s_waitcnt vmcnt(0)" ::: "memory");
        }
#if !defined(BROKEN_HOOK_NO_BARRIER)
        asm volatile("" ::: "memory"); __builtin_amdgcn_s_barrier(); asm volatile("" ::: "memory");
#endif
    }
};

__device__ __forceinline__ unsigned cvt_pk_bf16(float lo, float hi) { unsigned r; asm volatile("v_cvt_pk_bf16_f32 %0, %1, %2" : "=v"(r) : "v"(lo), "v"(hi)); return r; }
typedef float f32x2 __attribute__((ext_vector_type(2)));
__device__ __forceinline__ f32x2 gelu_pk(f32x2 v) {
    const f32x2 av = __builtin_elementwise_abs(v), d = av * 0.2316418882f + 1.0f;
    f32x2 t; t.x = __builtin_amdgcn_rcpf(d.x); t.y = __builtin_amdgcn_rcpf(d.y);
    f32x2 q = t * 0.5307027145f + (-0.7265760135f); q = q * t + 0.7107068705f; q = q * t + (-0.142248368f); q = q * t + 0.127414796f; q = q * t;
    const f32x2 s = (v * v) * (-0.72134752044f);
    f32x2 e; e.x = __builtin_amdgcn_exp2f(s.x); e.y = __builtin_amdgcn_exp2f(s.y);
    const f32x2 m = v * (q * e), r = v - m;
    f32x2 o; o.x = v.x < 0.f ? m.x : r.x; o.y = v.y < 0.f ? m.y : r.y; return o;
}

struct EpiF32 {
    static constexpr bool PERM = false, AFTER_DRAIN = false, PREFETCH = false;
    float* C; int ldc; const float* bias;
    __device__ __forceinline__ void operator()(const f32x4 (&acc)[2][2][4][2], const Unit& u, int wr, int wc, int fr, int fq) const {
        const int row0 = u.pm * BM + wr * 64 + fr, col0 = u.pn * BM + wc * 32 + 4 * fq;
        f32x4 bv[2][2];
#pragma unroll
        for (int bj = 0; bj < 2; ++bj)
#pragma unroll
            for (int n = 0; n < 2; ++n) bv[bj][n] = bias ? *(const f32x4*)(bias + col0 + bj * HALF + n * 16) : (f32x4){0.f, 0.f, 0.f, 0.f};
#pragma unroll
        for (int ai = 0; ai < 2; ++ai)
#pragma unroll
            for (int m = 0; m < 4; ++m) { float* rowp = C + (size_t)(row0 + ai * HALF + m * 16) * ldc + col0;
#pragma unroll
                for (int bj = 0; bj < 2; ++bj)
#pragma unroll
                    for (int n = 0; n < 2; ++n) *(f32x4*)(rowp + bj * HALF + n * 16) = acc[ai][bj][m][n] + bv[bj][n]; }
    }
};
template <int ACT  > struct EpiBf16 {
    static constexpr bool PERM = true, AFTER_DRAIN = false, PREFETCH = false;
    bf16_t* O; int ldc; const float* bias; int split_cols; size_t split_stride;
    __device__ __forceinline__ void operator()(const f32x4 (&acc)[2][2][4][2], const Unit& u, int wr, int wc, int fr, int fq) const {
        const int row0 = u.pm * BM + wr * 64 + fr; int colt = u.pn * BM; bf16_t* base = O;
        if (split_cols) { const int t = colt / split_cols; base += (size_t)t * split_stride; colt -= t * split_cols; }
        const int col0 = colt + wc * 32 + 8 * fq, bcol0 = u.pn * BM + wc * 32 + 8 * fq;
        f32x4 bv[2][2];
#pragma unroll
        for (int bj = 0; bj < 2; ++bj)
#pragma unroll
            for (int n = 0; n < 2; ++n) bv[bj][n] = bias ? *(const f32x4*)(bias + bcol0 + bj * HALF + 4 * n) : (f32x4){0.f, 0.f, 0.f, 0.f};
#pragma unroll
        for (int ai = 0; ai < 2; ++ai)
#pragma unroll
            for (int m = 0; m < 4; ++m) { bf16_t* rowp = base + (size_t)(row0 + ai * HALF + m * 16) * ldc + col0;
#pragma unroll
                for (int bj = 0; bj < 2; ++bj) { f32x4 v0 = acc[ai][bj][m][0] + bv[bj][0], v1 = acc[ai][bj][m][1] + bv[bj][1];
                    if (ACT == 1) { f32x2 a = gelu_pk((f32x2){v0[0], v0[1]}), b = gelu_pk((f32x2){v0[2], v0[3]}), c = gelu_pk((f32x2){v1[0], v1[1]}), d = gelu_pk((f32x2){v1[2], v1[3]});
                        v0 = (f32x4){a.x, a.y, b.x, b.y}; v1 = (f32x4){c.x, c.y, d.x, d.y}; }
                    if (ACT == 2) {
#pragma unroll
                        for (int j = 0; j < 4; ++j) { v0[j] = 0.5f * v0[j] * (1.0f + erff(v0[j] * 0.70710678f)); v1[j] = 0.5f * v1[j] * (1.0f + erff(v1[j] * 0.70710678f)); } }
                    u32x4 w; w.x = cvt_pk_bf16(v0[0], v0[1]); w.y = cvt_pk_bf16(v0[2], v0[3]); w.z = cvt_pk_bf16(v1[0], v1[1]); w.w = cvt_pk_bf16(v1[2], v1[3]);
                    *(u32x4*)(rowp + bj * HALF) = w; } }
    }
};
#ifndef EPI_PREFETCH
#define EPI_PREFETCH false
#endif
#ifndef EPI_PF_TILES
#define EPI_PF_TILES 16
#endif
__device__ __forceinline__ float silu_f(float g) { return g * __builtin_amdgcn_rcpf(1.0f + __expf(-g)); }
__device__ __forceinline__ float gelu_tanh_f(float x) { const float y = 0.7978845608028654f * (x + 0.044715f * x * x * x); const float e = __expf(2.0f * y); const float t = 1.0f - 2.0f * __builtin_amdgcn_rcpf(e + 1.0f); return 0.5f * x * (1.0f + t); }
template <int ACT> struct EpiB {
    static constexpr bool PERM = true, AFTER_DRAIN = false, PREFETCH = false;
    bf16_t* O; int ldc;
    __device__ __forceinline__ void operator()(const f32x4 (&acc)[2][2][4][2], const Unit& u, int wr, int wc, int fr, int fq) const {
        const int row0 = u.pm * BM + wr * 64 + fr, col0 = u.pn * BM + wc * 32 + 8 * fq;
        float one = 1.0f; asm volatile("" : "+v"(one));
#pragma unroll
        for (int ai = 0; ai < 2; ++ai)
#pragma unroll
            for (int m = 0; m < 4; ++m) { bf16_t* rowp = O + (size_t)(row0 + ai * HALF + m * 16) * ldc + col0;
#pragma unroll
                for (int bj = 0; bj < 2; ++bj) { f32x4 v0 = acc[ai][bj][m][0] * one, v1 = acc[ai][bj][m][1] * one;
                    if (ACT == 1) {
#pragma unroll
                        for (int j = 0; j < 4; ++j) { v0[j] = gelu_tanh_f(v0[j]); v1[j] = gelu_tanh_f(v1[j]); } }
                    u32x4 w; w.x = cvt_pk_bf16(v0[0], v0[1]); w.y = cvt_pk_bf16(v0[2], v0[3]); w.z = cvt_pk_bf16(v1[0], v1[1]); w.w = cvt_pk_bf16(v1[2], v1[3]);
                    *(u32x4*)(rowp + bj * HALF) = w; } }
    }
};
struct EpiProj {
    static constexpr bool PERM = true, AFTER_DRAIN = false, PREFETCH = false;
    bf16_t* O; int ldc; float* gates; int gate_pn;
    __device__ __forceinline__ void operator()(const f32x4 (&acc)[2][2][4][2], const Unit& u, int wr, int wc, int fr, int fq) const {
        const int row0 = u.pm * BM + wr * 64 + fr, col0 = u.pn * BM + wc * 32 + 8 * fq;
        float one = 1.0f; asm volatile("" : "+v"(one));
#pragma unroll
        for (int ai = 0; ai < 2; ++ai)
#pragma unroll
            for (int m = 0; m < 4; ++m) { bf16_t* rowp = O + (size_t)(row0 + ai * HALF + m * 16) * ldc + col0;
#pragma unroll
                for (int bj = 0; bj < 2; ++bj) { const f32x4 v0 = acc[ai][bj][m][0] * one, v1 = acc[ai][bj][m][1] * one;
                    u32x4 w; w.x = cvt_pk_bf16(v0[0], v0[1]); w.y = cvt_pk_bf16(v0[2], v0[3]); w.z = cvt_pk_bf16(v1[0], v1[1]); w.w = cvt_pk_bf16(v1[2], v1[3]);
                    *(u32x4*)(rowp + bj * HALF) = w; } }
        if (u.pn == gate_pn && wc == 0 && fq == 0) {
#pragma unroll
            for (int ai = 0; ai < 2; ++ai)
#pragma unroll
                for (int m = 0; m < 4; ++m) { float* g = gates + (size_t)(row0 + ai * HALF + m * 16) * 8;
                    *(f32x4*)g = acc[ai][0][m][0]; *(f32x4*)(g + 4) = acc[ai][0][m][1]; }
        }
    }
};
struct EpiSwiGLU {
    static constexpr bool PERM = true, AFTER_DRAIN = false, PREFETCH = false;
    bf16_t* H; int ldh;
    __device__ __forceinline__ void operator()(const f32x4 (&acc)[2][2][4][2], const Unit& u, int wr, int wc, int fr, int fq) const {
        const int row0 = u.pm * BM + wr * 64 + fr, col0 = u.pn * HALF + wc * 32 + 8 * fq;
#pragma unroll
        for (int ai = 0; ai < 2; ++ai)
#pragma unroll
            for (int m = 0; m < 4; ++m) { bf16_t* rowp = H + (size_t)(row0 + ai * HALF + m * 16) * ldh + col0;
                const f32x4 g0 = acc[ai][0][m][0], g1 = acc[ai][0][m][1], u0 = acc[ai][1][m][0], u1 = acc[ai][1][m][1];
                float h[8];
#pragma unroll
                for (int j = 0; j < 4; ++j) { h[j] = silu_f(g0[j]) * u0[j]; h[4 + j] = silu_f(g1[j]) * u1[j]; }
                u32x4 w; w.x = cvt_pk_bf16(h[0], h[1]); w.y = cvt_pk_bf16(h[2], h[3]); w.z = cvt_pk_bf16(h[4], h[5]); w.w = cvt_pk_bf16(h[6], h[7]);
                *(u32x4*)rowp = w; }
    }
};
struct EpiResid {
    static constexpr bool PERM = false, AFTER_DRAIN = false, PREFETCH = false;
    float* C; const float* R; int ldc; float alpha;
    __device__ __forceinline__ void operator()(const f32x4 (&acc)[2][2][4][2], const Unit& u, int wr, int wc, int fr, int fq) const {
        const int row0 = u.pm * BM + wr * 64 + fr, col0 = u.pn * BM + wc * 32 + 4 * fq;
#pragma unroll
        for (int ai = 0; ai < 2; ++ai) {
            f32x4 r[4][2][2];
#pragma unroll
            for (int m = 0; m < 4; ++m) { const size_t off = (size_t)(row0 + ai * HALF + m * 16) * ldc + col0;
#pragma unroll
                for (int bj = 0; bj < 2; ++bj)
#pragma unroll
                    for (int n = 0; n < 2; ++n) r[m][bj][n] = *(const f32x4*)(R + off + bj * HALF + n * 16); }
            asm volatile("" ::: "memory");
#pragma unroll
            for (int m = 0; m < 4; ++m) { const size_t off = (size_t)(row0 + ai * HALF + m * 16) * ldc + col0;
#pragma unroll
                for (int bj = 0; bj < 2; ++bj)
#pragma unroll
                    for (int n = 0; n < 2; ++n) *(f32x4*)(C + off + bj * HALF + n * 16) = acc[ai][bj][m][n] + alpha * r[m][bj][n]; }
            asm volatile("" ::: "memory");
        }
    }
};
struct EpiResidLN {
    static constexpr bool PERM = false, AFTER_DRAIN = false, PREFETCH = false;
    float* C; const float* Zp; const f32x2* st; const float* g; const float* b; int ldc; float alpha;
    __device__ __forceinline__ void operator()(const f32x4 (&acc)[2][2][4][2], const Unit& u, int wr, int wc, int fr, int fq) const {
        const int row0 = u.pm * BM + wr * 64 + fr, col0 = u.pn * BM + wc * 32 + 4 * fq;
#pragma unroll
        for (int bj = 0; bj < 2; ++bj)
#pragma unroll
            for (int n = 0; n < 2; ++n) {
                const int cc = col0 + bj * HALF + n * 16;
                const f32x4 gv = *(const f32x4*)(g + cc) * alpha, bv = *(const f32x4*)(b + cc) * alpha;
                f32x4 r[2][4]; f32x2 ms[2][4];
#pragma unroll
                for (int ai = 0; ai < 2; ++ai)
#pragma unroll
                    for (int m = 0; m < 4; ++m) { const int row = row0 + ai * HALF + m * 16; ms[ai][m] = st[row]; r[ai][m] = *(const f32x4*)(Zp + (size_t)row * ldc + cc); }
                asm volatile("" ::: "memory");
#pragma unroll
                for (int ai = 0; ai < 2; ++ai)
#pragma unroll
                    for (int m = 0; m < 4; ++m) { const int row = row0 + ai * HALF + m * 16;
                        *(f32x4*)(C + (size_t)row * ldc + cc) = acc[ai][bj][m][n] + ((r[ai][m] - ms[ai][m].x) * ms[ai][m].y) * gv + bv; }
                asm volatile("" ::: "memory");
            }
    }
};
struct EpiResidB {
    static constexpr bool PERM = true, AFTER_DRAIN = false, PREFETCH = EPI_PREFETCH;
    bf16_t* C; const bf16_t* R;
    __device__ __forceinline__ void prefetch(const Unit& u, PG8_LAS unsigned char* dummy, int wid, int lane) const {
#pragma unroll
        for (int i = 0; i < 2; ++i) { const int L = wid * 128 + i * 64 + lane;
            __builtin_amdgcn_global_load_lds((const unsigned*)((const char*)R + (unsigned)((u.pm * BM + (L >> 2)) * DM + u.pn * BM + (L & 3) * 64) * 2u), (PG8_LAS unsigned*)dummy, 4, 0, 0); }
    }
    __device__ __forceinline__ void operator()(const f32x4 (&acc)[2][2][4][2], const Unit& u, int wr, int wc, int fr, int fq) const {
        const int row0 = u.pm * BM + wr * 64 + fr, col0 = u.pn * BM + wc * 32 + 8 * fq;
#pragma unroll
        for (int ai = 0; ai < 2; ++ai) {
            bf16x8 r[4][2];
#pragma unroll
            for (int m = 0; m < 4; ++m)
#pragma unroll
                for (int bj = 0; bj < 2; ++bj) r[m][bj] = *(const bf16x8*)((const char*)R + (unsigned)((row0 + ai * HALF + m * 16) * DM + col0 + bj * HALF) * 2u);
            asm volatile("" ::: "memory");
#pragma unroll
            for (int m = 0; m < 4; ++m)
#pragma unroll
                for (int bj = 0; bj < 2; ++bj) { float x[8]; unpack8(r[m][bj], x);
                    const f32x4 a0 = acc[ai][bj][m][0], a1 = acc[ai][bj][m][1];
                    float v[8];
#pragma unroll
                    for (int j = 0; j < 4; ++j) { v[j] = a0[j] + DN_ALPHA * x[j]; v[4 + j] = a1[j] + DN_ALPHA * x[4 + j]; }
                    *(bf16x8*)((char*)C + (unsigned)((row0 + ai * HALF + m * 16) * DM + col0 + bj * HALF) * 2u) = pack8h(v); }
            asm volatile("" ::: "memory");
        }
    }
};
struct EpiResidLNB {
    static constexpr bool PERM = true, AFTER_DRAIN = false, PREFETCH = EPI_PREFETCH;
    bf16_t* C; const bf16_t* Zp; const f32x2* st; const float* g; const float* b;
    __device__ __forceinline__ void prefetch(const Unit& u, PG8_LAS unsigned char* dummy, int wid, int lane) const {
#pragma unroll
        for (int i = 0; i < 2; ++i) { const int L = wid * 128 + i * 64 + lane;
            __builtin_amdgcn_global_load_lds((const unsigned*)((const char*)Zp + (unsigned)((u.pm * BM + (L >> 2)) * DM + u.pn * BM + (L & 3) * 64) * 2u), (PG8_LAS unsigned*)dummy, 4, 0, 0); }
    }
    __device__ __forceinline__ void operator()(const f32x4 (&acc)[2][2][4][2], const Unit& u, int wr, int wc, int fr, int fq) const {
        const int row0 = u.pm * BM + wr * 64 + fr, col0 = u.pn * BM + wc * 32 + 8 * fq;
#pragma unroll
        for (int bj = 0; bj < 2; ++bj) {
            const int cc = col0 + bj * HALF;
            const f32x4 g0 = *(const f32x4*)(g + cc) * DN_ALPHA, g1 = *(const f32x4*)(g + cc + 4) * DN_ALPHA, b0 = *(const f32x4*)(b + cc) * DN_ALPHA, b1 = *(const f32x4*)(b + cc + 4) * DN_ALPHA;
            bf16x8 r[2][4]; f32x2 ms[2][4];
#pragma unroll
            for (int ai = 0; ai < 2; ++ai)
#pragma unroll
                for (int m = 0; m < 4; ++m) { const int row = row0 + ai * HALF + m * 16; ms[ai][m] = *(const f32x2*)((const char*)st + (unsigned)row * 8u); r[ai][m] = *(const bf16x8*)((const char*)Zp + (unsigned)(row * DM + cc) * 2u); }
            asm volatile("" ::: "memory");
#pragma unroll
            for (int ai = 0; ai < 2; ++ai)
#pragma unroll
                for (int m = 0; m < 4; ++m) { const int row = row0 + ai * HALF + m * 16; float x[8]; unpack8h(r[ai][m], x);
                    const f32x4 a0 = acc[ai][bj][m][0], a1 = acc[ai][bj][m][1]; const float mu = ms[ai][m].x, rs = ms[ai][m].y;
                    float v[8];
#pragma unroll
                    for (int j = 0; j < 4; ++j) { v[j] = a0[j] + (((x[j] - mu) * rs) * g0[j] + b0[j]); v[4 + j] = a1[j] + (((x[4 + j] - mu) * rs) * g1[j] + b1[j]); }
                    *(bf16x8*)((char*)C + (unsigned)(row * DM + cc) * 2u) = pack8h(v); __builtin_amdgcn_sched_barrier(0); }
            asm volatile("" ::: "memory");
        }
    }
};
template <class Epi, class Sched, bool ALIGN_EPI = false, bool SP2 = false>
__device__ __forceinline__ void gemm_phase(PG8_LAS unsigned char* lds, const Gemm g, const Sched& S, const Epi& E) {
    const int tid = threadIdx.x, wid = __builtin_amdgcn_readfirstlane(tid >> 6), lane = tid & 63, wr = wid >> 2, wc = wid & 3, fr = lane & 15, fq = lane >> 4;
    const int K = g.K, nt = K / BK;
    unsigned voffA[2], voffB[2];
#pragma unroll
    for (int i = 0; i < 2; ++i) { int R, C; stage_rc(tid * 16 + i * 8192, R, C); const int Rb = Epi::PERM ? ((R & ~31) + perm32(R & 31)) : R;
        voffA[i] = (unsigned)(R * K + C) * 2u; voffB[i] = (unsigned)(Rb * K + C) * 2u; }
    const size_t kstep = (size_t)(BK * 2);
    const size_t hstep = (size_t)HALF * K * 2;
    const size_t tstep = 2 * hstep;
    const unsigned ldsw = (unsigned)wid * 1024u;
    const int aoff = lds_byte(wr * 64 + fr, fq * 8), boff = lds_byte(wc * 32 + fr, fq * 8);
#define PG8_SA(b, h) (((b) * 2 + (h)) * HTB)
#define PG8_SB(b, h) ((4 + (b) * 2 + (h)) * HTB)
#define PG8_STAGE(bufoff, gbase, voff) do { _Pragma("unroll") for (int _i = 0; _i < 2; ++_i) \
        __builtin_amdgcn_global_load_lds((const unsigned*)((const char*)(gbase) + (voff)[_i]), (PG8_LAS unsigned*)(lds + (bufoff) + ldsw + _i * 8192), 16, 0, 0); } while (0)
#define PG8_LDA(dst, b, h) do { _Pragma("unroll") for (int m = 0; m < 4; ++m) _Pragma("unroll") for (int k = 0; k < 2; ++k) dst[m][k] = *(const PG8_LAS bf16x8*)(lds + PG8_SA(b, h) + aoff + m * 2048 + k * 1024); } while (0)
#define PG8_LDB(dst, b, h) do { _Pragma("unroll") for (int n = 0; n < 2; ++n) _Pragma("unroll") for (int k = 0; k < 2; ++k) dst[n][k] = *(const PG8_LAS bf16x8*)(lds + PG8_SB(b, h) + boff + n * 2048 + k * 1024); } while (0)
#define PG8_MMA(ai, bj, At, Bt) do { __builtin_amdgcn_s_setprio(1); _Pragma("unroll") for (int m = 0; m < 4; ++m) _Pragma("unroll") for (int n = 0; n < 2; ++n) _Pragma("unroll") for (int k = 0; k < 2; ++k) \
        acc[ai][bj][m][n] = __builtin_amdgcn_mfma_f32_16x16x32_bf16(Bt[n][k], At[m][k], acc[ai][bj][m][n], 0, 0, 0); __builtin_amdgcn_s_setprio(0); } while (0)
#define PG8_WAIT_V(n) asm volatile("s_waitcnt vmcnt(" #n ")" ::: "memory")
#define PG8_WAIT_L(n) asm volatile("s_waitcnt lgkmcnt(" #n ")" ::: "memory")
#define PG8_BAR __builtin_amdgcn_s_barrier()
#define PG8_SCHED __builtin_amdgcn_sched_barrier(0)
    Unit cur, nxt; int ui = 0;
    if (!S.next(0, cur)) return;
    f32x4 acc[2][2][4][2];
#pragma unroll
    for (int a = 0; a < 2; ++a)
#pragma unroll
        for (int b = 0; b < 2; ++b)
#pragma unroll
            for (int m = 0; m < 4; ++m)
#pragma unroll
                for (int n = 0; n < 2; ++n) acc[a][b][m][n] = (f32x4){0.f, 0.f, 0.f, 0.f};
    bf16x8 At[4][2], B0[2][2], B1[2][2];
    const char* cA = (const char*)g.A + (size_t)cur.pm * tstep; const char* cB = (const char*)g.Bt + (size_t)cur.pn * tstep;
    S.a_ready(cur);
    if constexpr (SP2) {
        PG8_STAGE(PG8_SB(0, 0), cB, voffB); PG8_STAGE(PG8_SB(0, 1), cB + hstep, voffB); PG8_STAGE(PG8_SA(0, 0), cA, voffA); PG8_STAGE(PG8_SA(0, 1), cA + hstep, voffA);
        if (wr == 1) PG8_BAR;
        PG8_WAIT_V(2); PG8_BAR;
        PG8_STAGE(PG8_SB(1, 0), cB + kstep, voffB); PG8_STAGE(PG8_SA(1, 0), cA + kstep, voffA); PG8_STAGE(PG8_SB(1, 1), cB + hstep + kstep, voffB);
        PG8_WAIT_V(6); PG8_BAR;
    } else {
        PG8_STAGE(PG8_SB(0, 0), cB, voffB); PG8_STAGE(PG8_SA(0, 0), cA, voffA); PG8_STAGE(PG8_SB(0, 1), cB + hstep, voffB); PG8_STAGE(PG8_SA(0, 1), cA + hstep, voffA);
        if (wr == 1) PG8_BAR;
        PG8_WAIT_V(4); PG8_BAR;
        PG8_STAGE(PG8_SB(1, 0), cB + kstep, voffB); PG8_STAGE(PG8_SA(1, 0), cA + kstep, voffA); PG8_STAGE(PG8_SB(1, 1), cB + hstep + kstep, voffB);
        PG8_WAIT_V(6); PG8_BAR;
    }
    for (;;) {
        const bool has_next = S.next(ui + 1, nxt);
        const char* nA = has_next ? (const char*)g.A + (size_t)nxt.pm * tstep : cA; const char* nB = has_next ? (const char*)g.Bt + (size_t)nxt.pn * tstep : cB;
        for (int t = 0; t < nt; t += 2) {
            const bool last = (t == nt - 2);
            const char* a1 = cA + (size_t)(t + 1) * kstep;
            const char* a2 = last ? nA : cA + (size_t)(t + 2) * kstep; const char* b2 = last ? nB : cB + (size_t)(t + 2) * kstep;
            const char* a3 = a2 + kstep; const char* b3 = b2 + kstep;
            if (last && has_next) S.a_ready(nxt);
            if constexpr (Epi::PREFETCH) { if (t == nt - EPI_PF_TILES) E.prefetch(cur, lds + STAGE_BYTES + wid * 256, wid, lane); }
            if constexpr (SP2) {
            PG8_LDB(B0, 0, 0); PG8_LDB(B1, 0, 1); PG8_SCHED; PG8_LDA(At, 0, 0); PG8_STAGE(PG8_SA(1, 1), a1 + hstep, voffA);
            PG8_WAIT_V(8); PG8_WAIT_L(0); PG8_BAR; PG8_MMA(0, 0, At, B0); PG8_MMA(0, 1, At, B1); PG8_BAR; PG8_SCHED;
            PG8_LDA(At, 0, 1); PG8_STAGE(PG8_SB(0, 0), b2, voffB); PG8_STAGE(PG8_SB(0, 1), b2 + hstep, voffB); PG8_STAGE(PG8_SA(0, 0), a2, voffA);
            PG8_WAIT_V(8); PG8_WAIT_L(0); PG8_BAR; PG8_MMA(1, 0, At, B0); PG8_MMA(1, 1, At, B1); PG8_BAR; PG8_SCHED;
            PG8_LDB(B0, 1, 0); PG8_LDB(B1, 1, 1); PG8_SCHED; PG8_LDA(At, 1, 0); PG8_STAGE(PG8_SA(0, 1), a2 + hstep, voffA);
            PG8_WAIT_V(8); PG8_WAIT_L(0); PG8_BAR; PG8_MMA(0, 0, At, B0); PG8_MMA(0, 1, At, B1); PG8_BAR; PG8_SCHED;
            PG8_LDA(At, 1, 1); PG8_STAGE(PG8_SB(1, 0), b3, voffB); PG8_STAGE(PG8_SB(1, 1), b3 + hstep, voffB); PG8_STAGE(PG8_SA(1, 0), a3, voffA);
            PG8_WAIT_V(8); PG8_WAIT_L(0); PG8_BAR; PG8_MMA(1, 0, At, B0); PG8_MMA(1, 1, At, B1); PG8_BAR; PG8_SCHED;
            } else {
            PG8_LDB(B0, 0, 0); PG8_SCHED; PG8_LDA(At, 0, 0); PG8_STAGE(PG8_SA(1, 1), a1 + hstep, voffA);
            PG8_WAIT_L(8); PG8_BAR; PG8_WAIT_L(0); PG8_MMA(0, 0, At, B0); PG8_BAR; PG8_SCHED;
            PG8_LDB(B1, 0, 1); PG8_STAGE(PG8_SB(0, 0), b2, voffB);
            PG8_BAR; PG8_WAIT_L(0); PG8_MMA(0, 1, At, B1); PG8_BAR;
            PG8_LDA(At, 0, 1); PG8_STAGE(PG8_SA(0, 0), a2, voffA);
            PG8_BAR; PG8_WAIT_L(0); PG8_MMA(1, 0, At, B0); PG8_BAR; PG8_SCHED;
            PG8_STAGE(PG8_SB(0, 1), b2 + hstep, voffB);
            PG8_WAIT_V(6); PG8_BAR; PG8_MMA(1, 1, At, B1); PG8_BAR;
            PG8_LDB(B0, 1, 0); PG8_SCHED; PG8_LDA(At, 1, 0); PG8_STAGE(PG8_SA(0, 1), a2 + hstep, voffA);
            PG8_WAIT_L(8); PG8_BAR; PG8_WAIT_L(0); PG8_MMA(0, 0, At, B0); PG8_BAR; PG8_SCHED;
            PG8_LDB(B1, 1, 1); PG8_STAGE(PG8_SB(1, 0), b3, voffB);
            PG8_BAR; PG8_WAIT_L(0); PG8_MMA(0, 1, At, B1); PG8_BAR;
            PG8_LDA(At, 1, 1); PG8_STAGE(PG8_SA(1, 0), a3, voffA);
            PG8_BAR; PG8_WAIT_L(0); PG8_MMA(1, 0, At, B0); PG8_BAR; PG8_SCHED;
            PG8_STAGE(PG8_SB(1, 1), b3 + hstep, voffB);
            PG8_WAIT_V(6); PG8_BAR; PG8_MMA(1, 1, At, B1); PG8_BAR;
            }
        }
        if constexpr (ALIGN_EPI) { if (wr == 0) PG8_BAR; }
        if constexpr (!Epi::AFTER_DRAIN) { E(acc, cur, wr, wc, fr, fq); S.done(cur); }
        if (!has_next) break;
#pragma unroll
        for (int a = 0; a < 2; ++a)
#pragma unroll
            for (int b = 0; b < 2; ++b)
#pragma unroll
                for (int m = 0; m < 4; ++m)
#pragma unroll
                    for (int n = 0; n < 2; ++n) acc[a][b][m][n] = (f32x4){0.f, 0.f, 0.f, 0.f};
        cur = nxt; cA = nA; cB = nB; ++ui;
        if constexpr (ALIGN_EPI) { if (wr == 1) PG8_BAR; }
    }
    PG8_WAIT_V(0);
    if constexpr (!ALIGN_EPI) { if (wr == 0) PG8_BAR; }
    PG8_BAR;
    if constexpr (Epi::AFTER_DRAIN) { E.fused(acc, cur, wr, wc, fr, fq, lds, wid, lane); S.done(cur); }
#undef PG8_SA
#undef PG8_SB
#undef PG8_STAGE
#undef PG8_LDA
#undef PG8_LDB
#undef PG8_MMA
#undef PG8_WAIT_V
#undef PG8_WAIT_L
#undef PG8_BAR
#undef PG8_SCHED
}
}
namespace fa {
constexpr int KVBLK = 64, SHM_V = 16384, SHM_K = 16384, SHM_KR = 8192;
constexpr int OFF_V = 0, OFF_K = 2 * SHM_V, OFF_KR = OFF_K + 2 * SHM_K, OFF_WS = OFF_KR + 2 * SHM_KR, OFF_IMP = OFF_WS + 8 * 64 * 4, IMP_LD = 257, OFF_QPARK = OFF_IMP + 32 * IMP_LD * 4 + 128  , LDS_END = OFF_QPARK + 8 * 4096;
#define KSWZ(row, colB) ((row) * 256 + ((colB) ^ (((row) & 7) << 4)))
#define KSWZ16(row, colB) ((row) * 256 + ((colB) ^ (((row) & 15) << 4)))
#define SBAR() __builtin_amdgcn_sched_barrier(0)
__device__ __forceinline__ int v_st(int k, int c) { const int kk = (k & ~0xC) | ((k & 4) << 1) | ((k & 8) >> 1); return ((kk >> 3) * 4 + (c >> 5)) * 512 + ((kk & 7) * 32 + (c & 31)) * 2; }
__device__ __forceinline__ int v_rd_base(int lane) { return ((lane & 3) << 3) | (((lane >> 2) & 3) << 6) | (((lane >> 4) & 1) << 5) | (((lane >> 5) & 1) << 8); }
constexpr int v_rd_off(int d0, int ks, int half) { return d0 * 512 + ks * 4096 + half * 2048; }
__device__ __forceinline__ int crow(int r, int hi) { return (r & 3) + 8 * (r >> 2) + 4 * hi; }
__device__ __forceinline__ unsigned cvtpk(float lo, float hi) { unsigned r; asm volatile("v_cvt_pk_bf16_f32 %0, %1, %2" : "=v"(r) : "v"(lo), "v"(hi)); return r; }
__device__ __forceinline__ bf16x8 pack8(f32x4 a, f32x4 b) { u32x4 w = {cvtpk(a[0], a[1]), cvtpk(a[2], a[3]), cvtpk(b[0], b[1]), cvtpk(b[2], b[3])}; return *reinterpret_cast<bf16x8*>(&w); }
__device__ __forceinline__ void mask_tile(f32x16& p0, f32x16& p1, int dq, unsigned W) {
    const float NEG = -__builtin_inff();
#pragma unroll
    for (int r = 0; r < 16; ++r) {
        const int c = (r & 3) + 8 * (r >> 2);
        if ((unsigned)(dq - c) >= W) p0[r] = NEG;
        if ((unsigned)(dq - c - 32) >= W) p1[r] = NEG;
    }
}
__device__ __forceinline__ void mask_all(f32x16& p0, f32x16& p1, bool kill) {
    const float NEG = -__builtin_inff();
#pragma unroll
    for (int r = 0; r < 16; ++r) { if (kill) { p0[r] = NEG; p1[r] = NEG; } }
}
__device__ __forceinline__ void partialSM(f32x16& p0, f32x16& p1, float& m_reg, float& mn, float& alpha, float scale, float C2, bool kill = false) {
    float pmax = p0[0];
#pragma unroll
    for (int r = 1; r < 16; ++r) pmax = fmaxf(pmax, p0[r]);
#pragma unroll
    for (int r = 0; r < 16; ++r) pmax = fmaxf(pmax, p1[r]);
    { auto rr = __builtin_amdgcn_permlane32_swap(__float_as_uint(pmax), __float_as_uint(pmax), false, false);
      pmax = fmaxf(__uint_as_float(rr[0]), __uint_as_float(rr[1])); }
    if (__builtin_expect(__all((pmax - m_reg) * scale <= 8.0f), 1)) { mn = m_reg; alpha = 1.f; }
    else { mn = fmaxf(m_reg, pmax); alpha = __builtin_amdgcn_exp2f((m_reg - mn) * C2); m_reg = mn; }
    const float mnL = kill ? -__builtin_inff() : -mn * C2;
#pragma unroll
    for (int r = 0; r < 16; ++r) p0[r] = fmaf(p0[r], C2, mnL);
#pragma unroll
    for (int r = 0; r < 16; ++r) p1[r] = fmaf(p1[r], C2, mnL);
#pragma unroll
    for (int r = 0; r < 16; ++r) p0[r] = __builtin_amdgcn_exp2f(p0[r]);
}
__device__ __forceinline__ void finishSM(f32x16& p0, f32x16& p1, float alpha, float& l_reg, bf16x8& pa0, bf16x8& pa1, bf16x8& pa2, bf16x8& pa3) {
#pragma unroll
    for (int r = 0; r < 16; ++r) p1[r] = __builtin_amdgcn_exp2f(p1[r]);
    float ps = 0;
#pragma unroll
    for (int r = 0; r < 16; ++r) ps += p0[r];
#pragma unroll
    for (int r = 0; r < 16; ++r) ps += p1[r];
    { auto rr = __builtin_amdgcn_permlane32_swap(__float_as_uint(ps), __float_as_uint(ps), false, false);
      ps = __uint_as_float(rr[0]) + __uint_as_float(rr[1]); }
    l_reg = l_reg * alpha + ps;
#define PK4(P, B_, OUT) do { unsigned a0 = cvtpk(P[B_+0], P[B_+1]), a1 = cvtpk(P[B_+2], P[B_+3]);                          \
        unsigned b0 = cvtpk(P[B_+4], P[B_+5]), b1 = cvtpk(P[B_+6], P[B_+7]);                                             \
        auto r0 = __builtin_amdgcn_permlane32_swap(a0, b0, false, false); auto r1 = __builtin_amdgcn_permlane32_swap(a1, b1, false, false); \
        u32x4 w = {r0[0], r1[0], r0[1], r1[1]}; OUT = *reinterpret_cast<bf16x8*>(&w); } while (0)
    PK4(p0, 0, pa0); PK4(p0, 8, pa1); PK4(p1, 0, pa2); PK4(p1, 8, pa3);
#undef PK4
}
template <int KB, bool ROPE, bool LIGHT = false>
__device__ __forceinline__ void qkt(f32x16& p0, f32x16& p1, const char* lds, int r32, int hi, const bf16x8* qr, const char* qpark = nullptr) {
    p0 = f32x16{}; p1 = f32x16{};
    const char* K_lds = lds + OFF_K;
    const char* kb[4];
#pragma unroll
    for (int dd = 0; dd < 4; ++dd) kb[dd] = K_lds + KB * SHM_K + KSWZ(r32, (dd * 16 + hi * 8) * 2);
    bf16x8 f[4][4];
#define QK_LD(g) do { const char* a0_ = kb[(2 * (g)) & 3] + ((2 * (g)) >> 2) * 128; const char* a1_ = kb[(2 * (g) + 1) & 3] + ((2 * (g) + 1) >> 2) * 128; \
        f[(g) & 3][0] = *reinterpret_cast<const bf16x8*>(a0_); f[(g) & 3][1] = *reinterpret_cast<const bf16x8*>(a0_ + 32 * 256); \
        f[(g) & 3][2] = *reinterpret_cast<const bf16x8*>(a1_); f[(g) & 3][3] = *reinterpret_cast<const bf16x8*>(a1_ + 32 * 256); } while (0)
#define QK_MM(g) do { p0 = __builtin_amdgcn_mfma_f32_32x32x16_bf16(f[(g) & 3][0], qr[2 * (g)], p0, 0, 0, 0); p1 = __builtin_amdgcn_mfma_f32_32x32x16_bf16(f[(g) & 3][1], qr[2 * (g)], p1, 0, 0, 0); \
        p0 = __builtin_amdgcn_mfma_f32_32x32x16_bf16(f[(g) & 3][2], qr[2 * (g) + 1], p0, 0, 0, 0); p1 = __builtin_amdgcn_mfma_f32_32x32x16_bf16(f[(g) & 3][3], qr[2 * (g) + 1], p1, 0, 0, 0); } while (0)
    if constexpr (ROPE) {
        QK_LD(0); SBAR();
        QK_LD(1); SBAR(); QK_MM(0); SBAR();
        QK_LD(2); SBAR(); QK_MM(1); SBAR();
        QK_LD(3); SBAR(); QK_MM(2); SBAR();
        const char* KR_lds = lds + OFF_KR + KB * SHM_KR + r32 * 128;
        bf16x8 ra[2], rb[2], qa, qb_;
#define QR_LD(d0, R, Q) do { const char* a = KR_lds + (((d0) * 32 + hi * 16) ^ ((r32 & 7) << 4)); R[0] = *reinterpret_cast<const bf16x8*>(a); R[1] = *reinterpret_cast<const bf16x8*>(a + 32 * 128); Q = *reinterpret_cast<const bf16x8*>(qpark + (d0) * 1024); } while (0)
#define QR_MM(R, Q) do { p0 = __builtin_amdgcn_mfma_f32_32x32x16_bf16(R[0], Q, p0, 0, 0, 0); p1 = __builtin_amdgcn_mfma_f32_32x32x16_bf16(R[1], Q, p1, 0, 0, 0); } while (0)
        QR_LD(0, ra, qa); SBAR(); QK_MM(3); SBAR();
        QR_LD(1, rb, qb_); SBAR(); QR_MM(ra, qa); SBAR();
        QR_LD(2, ra, qa); SBAR(); QR_MM(rb, qb_); SBAR();
        QR_LD(3, rb, qb_); SBAR(); QR_MM(ra, qa); SBAR();
        QR_MM(rb, qb_);
#undef QR_LD
#undef QR_MM
    } else if constexpr (LIGHT) {
        QK_LD(0); SBAR();
        QK_LD(1); SBAR(); QK_MM(0); SBAR();
        QK_LD(2); SBAR(); QK_MM(1); SBAR();
        QK_LD(3); SBAR(); QK_MM(2); SBAR();
        QK_MM(3);
    } else {
        QK_LD(0); QK_LD(1); SBAR();
        QK_LD(2); SBAR(); QK_MM(0); SBAR();
        QK_LD(3); SBAR(); QK_MM(1); SBAR();
        QK_MM(2); QK_MM(3);
    }
#undef QK_LD
#undef QK_MM
}
template <int VB, bool PIPE>
__device__ __forceinline__ void pv_tile(f32x16* o, int vb0, bf16x8 pa0, bf16x8 pa1, bf16x8 pa2, bf16x8 pa3) {
#define TRRD(dst, off) asm volatile("ds_read_b64_tr_b16 %0, %1 offset:%2" : "=&v"(dst) : "v"(vb0), "i"(off) : "memory")
#define PV_LD(S, d0) do { constexpr int b_ = OFF_V + VB * SHM_V + v_rd_off(d0, 0, 0); TRRD(S[0], b_); TRRD(S[1], b_ + 2048); TRRD(S[2], b_ + 4096); TRRD(S[3], b_ + 6144); TRRD(S[4], b_ + 8192); TRRD(S[5], b_ + 10240); TRRD(S[6], b_ + 12288); TRRD(S[7], b_ + 14336); } while (0)
#define PV_MM(S, d0) do { \
        o[d0] = __builtin_amdgcn_mfma_f32_32x32x16_bf16(pa0, (bf16x8){S[0][0], S[0][1], S[0][2], S[0][3], S[1][0], S[1][1], S[1][2], S[1][3]}, o[d0], 0, 0, 0);   \
        o[d0] = __builtin_amdgcn_mfma_f32_32x32x16_bf16(pa1, (bf16x8){S[2][0], S[2][1], S[2][2], S[2][3], S[3][0], S[3][1], S[3][2], S[3][3]}, o[d0], 0, 0, 0);   \
        o[d0] = __builtin_amdgcn_mfma_f32_32x32x16_bf16(pa2, (bf16x8){S[4][0], S[4][1], S[4][2], S[4][3], S[5][0], S[5][1], S[5][2], S[5][3]}, o[d0], 0, 0, 0);   \
        o[d0] = __builtin_amdgcn_mfma_f32_32x32x16_bf16(pa3, (bf16x8){S[6][0], S[6][1], S[6][2], S[6][3], S[7][0], S[7][1], S[7][2], S[7][3]}, o[d0], 0, 0, 0); } while (0)
#define PV_W(n) do { asm volatile("s_waitcnt lgkmcnt(" #n ")" ::: "memory"); SBAR(); } while (0)
    if constexpr (PIPE) {
        s16x4 A[8], B[8];
        PV_LD(A, 0); PV_LD(B, 1); PV_W(8); PV_MM(A, 0);
        PV_LD(A, 2); PV_W(8); PV_MM(B, 1);
        PV_LD(B, 3); PV_W(8); PV_MM(A, 2);
        PV_W(0); PV_MM(B, 3);
    } else {
        s16x4 A[8];
        PV_LD(A, 0); PV_W(0); PV_MM(A, 0); PV_LD(A, 1); PV_W(0); PV_MM(A, 1); PV_LD(A, 2); PV_W(0); PV_MM(A, 2); PV_LD(A, 3); PV_W(0); PV_MM(A, 3);
    }
#undef PV_W
#undef PV_MM
#undef PV_LD
#undef TRRD
}

struct FUnit {
    const bf16_t* Kb; long ldk; const bf16_t* Vb; long ldv; const bf16_t* KRb;
    int j_lo, j_hi;
    int qlo, qhi;
    int qpos;
    unsigned long long sel;
};
template <int MODE, int VAR = 0>
__device__ __forceinline__ void flash_core(char* lds, const FUnit& u, const bf16x8* qr, float scale, f32x16 (&o)[4], float& m_reg, float& l_reg) {
    constexpr bool ROPE = (MODE == 0);
    const int tid = threadIdx.x, wid = __builtin_amdgcn_readfirstlane(tid >> 6), lane = tid & 63, r32 = lane & 31, hi = lane >> 5;
    const int grp = wid >> 2;
    const float C2 = 1.4426950408889634f * scale;
    char* V_lds = lds + OFF_V; char* K_lds = lds + OFF_K; char* KR_lds = lds + OFF_KR;
    float* ws = (float*)(lds + OFF_WS) + wid * 64; float* al_l = ws + 32;
    const int sr = tid >> 4, sc = (tid & 15) * 8, vst0 = v_st(sr, sc), vst1 = v_st(32 + sr, sc), kws = KSWZ(sr, sc * 2);
    const int rr = tid >> 3, rc = (tid & 7) * 8, krws = rr * 128 + ((rc * 2) ^ ((rr & 7) << 4));
    const int vb0 = (int)(uintptr_t)lds + v_rd_base(lane);
    const char* qpark = lds + OFF_QPARK + wid * 4096 + lane * 16;
    m_reg = -1e30f; l_reg = 0.f;
#pragma unroll
    for (int d = 0; d < 4; ++d) o[d] = f32x16{};
    const int NT = u.j_hi - u.j_lo;
    if (NT <= 0) return;
    bf16x8 st_k0, st_k1, st_v0, st_v1, st_kr;
    f32x16 p0, p1; float mn, al; bf16x8 pa0, pa1, pa2, pa3;
    const unsigned W = (MODE == 1) ? 512u : ((MODE == 3) ? 0x80000000u : 0x7fffffffu);
#define FA_KBASE(t) ((u.j_lo + (t)) * KVBLK)
#define FA_KLOAD(k0) do { st_k0 = *(const bf16x8*)(u.Kb + (long)((k0) + sr) * u.ldk + sc); st_k1 = *(const bf16x8*)(u.Kb + (long)((k0) + 32 + sr) * u.ldk + sc);   \
                          if constexpr (ROPE) st_kr = *(const bf16x8*)(u.KRb + (long)((k0) + rr) * 64 + rc); } while (0)
#define FA_VLOAD(k0) do { st_v0 = *(const bf16x8*)(u.Vb + (long)((k0) + sr) * u.ldv + sc); st_v1 = *(const bf16x8*)(u.Vb + (long)((k0) + 32 + sr) * u.ldv + sc); } while (0)
#define FA_KWRITE(bf) do { *(bf16x8*)(K_lds + (bf) * SHM_K + kws) = st_k0; *(bf16x8*)(K_lds + (bf) * SHM_K + kws + 32 * 256) = st_k1;   \
                           if constexpr (ROPE) *(bf16x8*)(KR_lds + (bf) * SHM_KR + krws) = st_kr; } while (0)
#define FA_VWRITE(bf) do { *(bf16x8*)(V_lds + (bf) * SHM_V + vst0) = st_v0; *(bf16x8*)(V_lds + (bf) * SHM_V + vst1) = st_v1; } while (0)
#define FA_BAR() do { asm volatile("s_waitcnt lgkmcnt(0)" ::: "memory"); __builtin_amdgcn_s_barrier(); asm volatile("" ::: "memory"); } while (0)
#define FA_RESC(a) do { if (__any((a) < 1.f)) { if (hi == 0) al_l[r32] = (a); asm volatile("s_waitcnt lgkmcnt(0)" ::: "memory");              \
                     _Pragma("unroll") for (int d_ = 0; d_ < 4; ++d_) { _Pragma("unroll") for (int r = 0; r < 16; ++r) o[d_][r] *= al_l[crow(r, hi)]; } asm volatile("" ::: "memory"); } } while (0)
#define FA_MASK(t) do { const int kb_ = FA_KBASE(t);                                                                             \
        if (MODE == 1) { if (kb_ + KVBLK - 1 > u.qlo || kb_ <= u.qhi - 512) mask_tile(p0, p1, u.qpos - kb_ - 4 * hi, W); }       \
        else { if (kb_ + KVBLK - 1 > u.qlo) mask_tile(p0, p1, u.qpos - kb_ - 4 * hi, W); }                                       \
        } while (0)
#define FA_KILL(t) ((MODE == 2) && (((u.sel >> (u.j_lo + (t))) & 1ull) == 0ull))
    const int kb_last = FA_KBASE(NT - 1);
    FA_KLOAD(FA_KBASE(0)); FA_VLOAD(FA_KBASE(0));
    FA_KWRITE(0); FA_VWRITE(0);
    { const int k1 = FA_KBASE(1); FA_KLOAD(k1 < kb_last ? k1 : kb_last); }
    FA_BAR();
    if (grp == 1) FA_BAR();
#define FA_STEP(BF, t) do {                                                                                                      \
        if (!(VAR & 8)) { const int k1 = FA_KBASE((t) + 1); FA_VLOAD(k1 < kb_last ? k1 : kb_last); }                             \
        SBAR(); if (!(VAR & 1)) qkt<BF, ROPE, MODE == 3>(p0, p1, lds, r32, hi, qr, qpark); else { p0 = f32x16{}; p1 = f32x16{}; p0[0] = (float)(t); }   \
        if (!(VAR & 2)) { FA_MASK(t); partialSM(p0, p1, m_reg, mn, al, scale, C2, FA_KILL(t)); FA_RESC(al); } else { al = 1.f; }   \
        if (!(VAR & 8)) FA_KWRITE((BF) ^ 1);                                                                                     \
        if (!(VAR & 16)) FA_BAR();                                                                                               \
        if (!(VAR & 8)) { const int k2 = FA_KBASE((t) + 2); FA_KLOAD(k2 < kb_last ? k2 : kb_last); }                             \
        if (!(VAR & 2)) finishSM(p0, p1, al, l_reg, pa0, pa1, pa2, pa3); else { l_reg += p0[0]; pa0 = pack8(f32x4{p0[0], p0[1], p0[2], p0[3]}, f32x4{p1[0], p1[1], p1[2], p1[3]}); pa1 = pa0; pa2 = pa0; pa3 = pa0; } \
        SBAR();                                                                                                                  \
        if (!(VAR & 4)) pv_tile<BF, (MODE == 1 || MODE == 2)>(o, vb0, pa0, pa1, pa2, pa3); else { o[0][0] += __builtin_bit_cast(float, (int)pa0[0]); }      \
        if (!(VAR & 8)) FA_VWRITE((BF) ^ 1);                                                                                     \
        if (!(VAR & 16)) FA_BAR(); } while (0)
    int t = 0;
    for (; t + 1 < NT; t += 2) {
        FA_STEP(0, t);
        FA_STEP(1, t + 1);
    }
    if (NT & 1) {
        SBAR(); if (!(VAR & 1)) qkt<0, ROPE, MODE == 3>(p0, p1, lds, r32, hi, qr, qpark); else { p0 = f32x16{}; p1 = f32x16{}; }
        if (!(VAR & 2)) { FA_MASK(t); partialSM(p0, p1, m_reg, mn, al, scale, C2, FA_KILL(t)); FA_RESC(al); } else { al = 1.f; }
        if (!(VAR & 16)) FA_BAR();
        if (!(VAR & 2)) finishSM(p0, p1, al, l_reg, pa0, pa1, pa2, pa3); else { pa0 = pack8(f32x4{p0[0], p0[1], p0[2], p0[3]}, f32x4{p1[0], p1[1], p1[2], p1[3]}); pa1 = pa0; pa2 = pa0; pa3 = pa0; }
        SBAR();
        if (!(VAR & 4)) pv_tile<0, (MODE == 1 || MODE == 2)>(o, vb0, pa0, pa1, pa2, pa3);
        if (!(VAR & 16)) FA_BAR();
    }
#undef FA_STEP
    if (grp == 0) FA_BAR();
#undef FA_MASK
#undef FA_KILL
#undef FA_RESC
#undef FA_BAR
#undef FA_VWRITE
#undef FA_KWRITE
#undef FA_VLOAD
#undef FA_KLOAD
#undef FA_KBASE
}
template <int MODE>
__device__ __forceinline__ void flash_core2(char* lds, const FUnit& u, const bf16x8* qr, float scale, f32x16 (&o)[4], float& m_reg, float& l_reg) {
    const int tid = threadIdx.x, wid = __builtin_amdgcn_readfirstlane(tid >> 6), lane = tid & 63, r32 = lane & 31, hi = lane >> 5;
    const float C2 = 1.4426950408889634f * scale;
    char* V_lds = lds + OFF_V; char* K_lds = lds + OFF_K;
    float* ws = (float*)(lds + OFF_WS) + wid * 64; float* al_l = ws + 32;
    const int sr = tid >> 4, sc = (tid & 15) * 8, vst0 = v_st(sr, sc), vst1 = v_st(32 + sr, sc), kws = KSWZ(sr, sc * 2);
    const int vb0 = (int)(uintptr_t)lds + v_rd_base(lane);
    m_reg = -1e30f; l_reg = 0.f;
#pragma unroll
    for (int d = 0; d < 4; ++d) o[d] = f32x16{};
    const int NT = u.j_hi - u.j_lo;
    if (NT <= 0) return;
    bf16x8 st_k0, st_k1, st_v0, st_v1;
    f32x16 pA0, pA1, pB0, pB1; float mnA, mnB, alA, alB; bf16x8 pa0, pa1, pa2, pa3;
    const unsigned W = (MODE == 1) ? 512u : 0x7fffffffu;
#define F2_KBASE(t) ((u.j_lo + (t)) * KVBLK)
#define F2_LOAD(k0) do { st_v0 = *(const bf16x8*)(u.Vb + (long)((k0) + sr) * u.ldv + sc); st_v1 = *(const bf16x8*)(u.Vb + (long)((k0) + 32 + sr) * u.ldv + sc);   \
                         st_k0 = *(const bf16x8*)(u.Kb + (long)((k0) + sr) * u.ldk + sc); st_k1 = *(const bf16x8*)(u.Kb + (long)((k0) + 32 + sr) * u.ldk + sc); } while (0)
#define F2_WRITE(bf) do { *(bf16x8*)(V_lds + (bf) * SHM_V + vst0) = st_v0; *(bf16x8*)(V_lds + (bf) * SHM_V + vst1) = st_v1;   \
                          *(bf16x8*)(K_lds + (bf) * SHM_K + kws) = st_k0; *(bf16x8*)(K_lds + (bf) * SHM_K + kws + 32 * 256) = st_k1; } while (0)
#define F2_VMW() asm volatile("s_waitcnt vmcnt(0)" ::: "memory")
#define F2_RESC(a) do { if (__any((a) < 1.f)) { if (hi == 0) al_l[r32] = (a); asm volatile("s_waitcnt lgkmcnt(0)" ::: "memory");              \
                     _Pragma("unroll") for (int d_ = 0; d_ < 4; ++d_) { _Pragma("unroll") for (int r = 0; r < 16; ++r) o[d_][r] *= al_l[crow(r, hi)]; } asm volatile("" ::: "memory"); } } while (0)
#define F2_MASK(P0_, P1_, t) do { const int kb_ = F2_KBASE(t);                                                                    \
        if (MODE == 1) { if (kb_ + KVBLK - 1 > u.qlo || kb_ <= u.qhi - 512) mask_tile(P0_, P1_, u.qpos - kb_ - 4 * hi, W); }      \
        else { if (kb_ + KVBLK - 1 > u.qlo) mask_tile(P0_, P1_, u.qpos - kb_ - 4 * hi, W); } } while (0)
#define F2_KILL(t) ((MODE == 2) && (((u.sel >> (u.j_lo + (t))) & 1ull) == 0ull))
#define F2_HALF(PX0, PX1, mnX, alX, PY0, PY1, alY, t, KB, VB, SB) do {                                                            \
        SBAR(); qkt<KB, false, true>(PX0, PX1, lds, r32, hi, qr);                                                                 \
        finishSM(PY0, PY1, alY, l_reg, pa0, pa1, pa2, pa3); SBAR();                                                               \
        if ((t) + 1 < NT) { F2_LOAD(F2_KBASE((t) + 1)); SBAR(); }                                                                 \
        pv_tile<VB, false>(o, vb0, pa0, pa1, pa2, pa3); F2_MASK(PX0, PX1, (t)); partialSM(PX0, PX1, m_reg, mnX, alX, scale, C2, F2_KILL(t)); \
        __syncthreads();                                                                                                          \
        if ((t) + 1 < NT) { F2_VMW(); F2_WRITE(SB); }                                                                             \
        F2_RESC(alX); __syncthreads(); } while (0)
    F2_LOAD(F2_KBASE(0)); F2_VMW(); F2_WRITE(0); __syncthreads();
    if (NT > 1) F2_LOAD(F2_KBASE(1));
    SBAR(); qkt<0, false, true>(pA0, pA1, lds, r32, hi, qr);
    F2_MASK(pA0, pA1, 0); partialSM(pA0, pA1, m_reg, mnA, alA, scale, C2, F2_KILL(0));
    if (NT > 1) { F2_VMW(); F2_WRITE(1); }
    __syncthreads();
    for (int t = 1; t + 1 < NT; t += 2) {
        F2_HALF(pB0, pB1, mnB, alB, pA0, pA1, alA, t, 1, 0, 0);
        F2_HALF(pA0, pA1, mnA, alA, pB0, pB1, alB, t + 1, 0, 1, 1);
    }
    const bool even = (NT & 1) == 0;
    if (even) { SBAR(); qkt<1, false, true>(pB0, pB1, lds, r32, hi, qr); SBAR(); }
    finishSM(pA0, pA1, alA, l_reg, pa0, pa1, pa2, pa3); SBAR();
    pv_tile<0, false>(o, vb0, pa0, pa1, pa2, pa3);
    if (even) { F2_MASK(pB0, pB1, NT - 1); partialSM(pB0, pB1, m_reg, mnB, alB, scale, C2, F2_KILL(NT - 1)); F2_RESC(alB);
        finishSM(pB0, pB1, alB, l_reg, pa0, pa1, pa2, pa3); SBAR(); pv_tile<1, false>(o, vb0, pa0, pa1, pa2, pa3); }
#undef F2_HALF
#undef F2_KILL
#undef F2_MASK
#undef F2_RESC
#undef F2_VMW
#undef F2_WRITE
#undef F2_LOAD
#undef F2_KBASE
}
__device__ __forceinline__ void row_factors(char* lds, int wid, int r32, int hi, float f, float (&rf)[16]) {
    float* li_l = (float*)(lds + OFF_WS) + wid * 64;
    asm volatile("" ::: "memory");
    if (hi == 0) li_l[r32] = f;
    asm volatile("s_waitcnt lgkmcnt(0)" ::: "memory");
#pragma unroll
    for (int r = 0; r < 16; ++r) rf[r] = li_l[crow(r, hi)];
    asm volatile("s_waitcnt lgkmcnt(0)" ::: "memory");
}
}

constexpr size_t MiB = 1ull << 20, KiB = 1ull << 10;
constexpr size_t WS_CTL = 0;
constexpr size_t WS_ROPE = 64 * KiB;
constexpr size_t WS_MG = WS_ROPE + 1 * MiB;
constexpr size_t WS_FLOOR = WS_MG + 512 * KiB;
constexpr size_t WS_DEN = WS_FLOOR + 256 * KiB;
constexpr size_t WS_GATES = WS_DEN + 256 * KiB;
constexpr size_t WS_SEL = WS_GATES + 512 * KiB;
constexpr size_t WS_KROPE = WS_SEL + 512 * KiB;
constexpr size_t WS_CQN = WS_KROPE + 2 * MiB;
constexpr size_t WS_CKVN = WS_CQN + 32 * MiB;
constexpr size_t WS_KVB = WS_CKVN + 16 * MiB;
constexpr size_t WS_XB = WS_KVB + 128 * MiB;
constexpr size_t WS_Z = WS_XB + 128 * MiB;
constexpr size_t WS_R = WS_Z + 256 * MiB;
constexpr size_t WS_W = WS_R + 344 * MiB;
constexpr size_t W_AB = WS_W, W_UQ = W_AB + 62 * MiB, W_UKV = W_UQ + 6 * MiB, W_O0 = W_UKV + 4 * MiB, W_GU0 = W_O0 + 32 * MiB, W_D0 = W_GU0 + 172 * MiB;
constexpr size_t W_C = W_D0 + 86 * MiB, W_C1K = W_C + 58 * MiB, W_C1V = W_C1K + 2 * MiB, W_C2K = W_C1V + 2 * MiB, W_C2V = W_C2K + 128 * KiB, W_O1 = W_C2V + 128 * KiB;
constexpr size_t W_GU1 = W_O1 + 32 * MiB, W_D1 = W_GU1 + 172 * MiB, WS_AT = W_D1 + 86 * MiB;
constexpr size_t WS_AA = WS_AT + 256 * KiB;
constexpr size_t WS_DENI = WS_AA + 256 * KiB;
constexpr size_t WS_DENP = WS_DENI + 256 * KiB;
constexpr size_t WS_STATS = WS_DENP + 4 * MiB;
constexpr size_t WS_END = WS_STATS + 128 * KiB;
constexpr size_t WS_AK = WS_KVB, WS_AV = WS_AK + 32 * MiB, WS_HK = WS_AV + 32 * MiB, WS_HV = WS_HK + 2 * MiB, WS_KCMP = WS_HV + 2 * MiB, WS_VCMP = WS_KCMP + 2 * MiB;
constexpr size_t WS_QB = WS_R + (size_t)M_TOK * AB_NP * 2;

constexpr int NTHREADS = 512;
constexpr int LDS_BYTES = 152 * 1024, LDS_CTL_OFF = LDS_BYTES - 256;
constexpr int N_TJOBS = 14;
struct TJob { const float* s; const float* s2; bf16_t* d; int K, N, Np, mode; };
struct Args { const float* in[26]; float* out; unsigned char* ws; TJob tj[N_TJOBS]; int ph_lo, ph_hi; };

__device__ __forceinline__ void transpose_tile(char* lds, const TJob& jb, int t) {
    float* T = (float*)lds;
    const int tid = threadIdx.x;
    const int tn = jb.Np >> 6;
    const int in_ = t % tn, ik = t / tn, n0 = in_ * 64, k0 = ik * 64;
    const float* sp = jb.s; int c0 = n0; const int ncols = jb.N;
    if (jb.mode == 1) { const int tile = n0 >> 8, j = n0 & 255; sp = (j < 128) ? jb.s : jb.s2; c0 = tile * 128 + (j & 127); }
    const int kk = tid >> 4, nc = (tid & 15) * 4;
    f32x4 v0 = {0.f, 0.f, 0.f, 0.f}, v1 = v0;
    if (c0 + nc < ncols) { v0 = *(const f32x4*)(sp + (size_t)(k0 + kk) * ncols + c0 + nc); v1 = *(const f32x4*)(sp + (size_t)(k0 + kk + 32) * ncols + c0 + nc); }
#pragma unroll
    for (int j = 0; j < 4; ++j) { T[(nc + j) * 65 + kk] = v0[j]; T[(nc + j) * 65 + kk + 32] = v1[j]; }
    __syncthreads();
    const int n = tid >> 3, kc = (tid & 7) * 8;
    float f[8];
#pragma unroll
    for (int j = 0; j < 8; ++j) f[j] = T[n * 65 + kc + j];
    *(bf16x8*)(jb.d + (size_t)(n0 + n) * jb.K + k0 + kc) = pack8f(f);
    __syncthreads();
}
constexpr int N_TJOBS_PRO = 11;
__device__ __forceinline__ void transpose_jobs(char* lds, const Args& a) {
    for (int ji = 0; ji < N_TJOBS_PRO; ++ji) {
        const TJob jb = a.tj[ji];
        const int nt = (jb.K >> 6) * (jb.Np >> 6);
        for (int t = blockIdx.x; t < nt; t += gridDim.x) transpose_tile(lds, jb, t);
    }
}
constexpr int LATE_T0 = 64 * 64, LATE_T1 = 64 * 344, LATE_T2 = 172 * 64, LATE_TOTAL = LATE_T0 + LATE_T1 + LATE_T2, LATE_SLOTS = 64 + 128 + 192 + 224, LATE_PER = (LATE_TOTAL + LATE_SLOTS - 1) / LATE_SLOTS;
struct TTile { const float* sp; bf16_t* d; int K, ncols, c0, n0, k0; };
__device__ __forceinline__ TTile late_tile(const Args& a, int g) {
    const int ji = g < LATE_T0 ? 11 : (g < LATE_T0 + LATE_T1 ? 12 : 13); const int t = g - (ji == 11 ? 0 : (ji == 12 ? LATE_T0 : LATE_T0 + LATE_T1));
    const TJob jb = a.tj[ji]; const int tn = jb.Np >> 6; TTile r; r.n0 = (t % tn) * 64; r.k0 = (t / tn) * 64; r.sp = jb.s; r.c0 = r.n0; r.ncols = jb.N; r.d = jb.d; r.K = jb.K;
    if (jb.mode == 1) { const int tile = r.n0 >> 8, j = r.n0 & 255; r.sp = (j < 128) ? jb.s : jb.s2; r.c0 = tile * 128 + (j & 127); }
    return r;
}
__device__ __forceinline__ void transpose_late(char* lds, const Args& a, int slot) {
    float* T = (float*)lds;
    const int tid = threadIdx.x, kk = tid >> 4, nc = (tid & 15) * 4, n = tid >> 3, kc = (tid & 7) * 8;
    const int g0 = slot * LATE_PER, g1 = (slot + 1) * LATE_PER < LATE_TOTAL ? (slot + 1) * LATE_PER : LATE_TOTAL;
    if (g0 >= g1) return;
    __syncthreads();
    TTile cur = late_tile(a, g0);
    f32x4 v0 = {0.f, 0.f, 0.f, 0.f}, v1 = v0;
    if (cur.c0 + nc < cur.ncols) { v0 = *(const f32x4*)(cur.sp + (size_t)(cur.k0 + kk) * cur.ncols + cur.c0 + nc); v1 = *(const f32x4*)(cur.sp + (size_t)(cur.k0 + kk + 32) * cur.ncols + cur.c0 + nc); }
    for (int g = g0; g < g1; ++g) {
        const TTile nxt = late_tile(a, g + 1 < g1 ? g + 1 : g);
        f32x4 w0 = {0.f, 0.f, 0.f, 0.f}, w1 = w0;
        if (nxt.c0 + nc < nxt.ncols) { w0 = *(const f32x4*)(nxt.sp + (size_t)(nxt.k0 + kk) * nxt.ncols + nxt.c0 + nc); w1 = *(const f32x4*)(nxt.sp + (size_t)(nxt.k0 + kk + 32) * nxt.ncols + nxt.c0 + nc); }
#pragma unroll
        for (int j = 0; j < 4; ++j) { T[(nc + j) * 65 + kk] = v0[j]; T[(nc + j) * 65 + kk + 32] = v1[j]; }
        __syncthreads();
        float f[8];
#pragma unroll
        for (int j = 0; j < 8; ++j) f[j] = T[n * 65 + kc + j];
        *(bf16x8*)(cur.d + (size_t)(cur.n0 + n) * cur.K + cur.k0 + kc) = pack8f(f);
        __syncthreads();
        cur = nxt; v0 = w0; v1 = w1;
    }
}
__device__ __forceinline__ void p0_prologue(char* lds, const Args& a) {
    const int tid = threadIdx.x;
    const size_t gt = (size_t)blockIdx.x * NTHREADS + tid, gs = (size_t)gridDim.x * NTHREADS;
    { const float* x = a.in[0]; bf16_t* xb = (bf16_t*)(a.ws + WS_XB);
      for (size_t i = gt; i < (size_t)M_TOK * DM / 8; i += gs) { const f32x4 v0 = *(const f32x4*)(x + i * 8), v1 = *(const f32x4*)(x + i * 8 + 4);
          float f[8] = {v0[0], v0[1], v0[2], v0[3], v1[0], v1[1], v1[2], v1[3]}; *(bf16x8*)(xb + i * 8) = pack8f(f); } }
    { f32x2* rp = (f32x2*)(a.ws + WS_ROPE);
      for (size_t i = gt; i < (size_t)SEQ * 32; i += gs) { const int pos = (int)(i >> 5), j = (int)(i & 31);
          const double inv = exp(-(double)j / 32.0 * 9.210340371976184  ); const double ang = (double)pos * inv; rp[i] = (f32x2){(float)cos(ang), (float)sin(ang)}; } }
    transpose_jobs(lds, a);
}

__device__ __forceinline__ float softcap15(float z) { return 15.0f * tanhf(z * (1.0f / 15.0f)); }
__device__ __forceinline__ float logsigmoid_f(float z) { return fminf(z, 0.f) - log1pf(__expf(-fabsf(z))); }
__device__ __forceinline__ void p2_prep(const Args& a) {
    const int tid = threadIdx.x, lane = tid & 63, wid = tid >> 6;
    const int gw = blockIdx.x * 8 + wid, nw = gridDim.x * 8;
    const bf16_t* proj = (const bf16_t*)(a.ws + WS_R);
    if (gw < 16) {
        const int bh = gw, b = bh >> 2, h = bh & 3;
        const float* gates = (const float*)(a.ws + WS_GATES);
        f32x2* mg = (f32x2*)(a.ws + WS_MG) + (size_t)bh * SEQ; float* fl = (float*)(a.ws + WS_FLOOR) + (size_t)bh * SEQ;
        const float bi = a.in[2][h], bfg = a.in[3][h];
        float Fc = 0.f, Ac = 0.f, mprev = 0.f;
        for (int c = 0; c < SEQ / 64; ++c) {
            const int t = c * 64 + lane; const float* g = gates + (size_t)(b * SEQ + t) * 8;
            const float li = softcap15(g[h] + bi), lf = logsigmoid_f(softcap15(g[4 + h] + bfg));
            float F = lf;
#pragma unroll
            for (int o = 1; o < 64; o <<= 1) { const float y = __shfl_up(F, o); if (lane >= o) F += y; }
            F += Fc;
            float A = li - F;
#pragma unroll
            for (int o = 1; o < 64; o <<= 1) { const float y = __shfl_up(A, o); if (lane >= o) A = fmaxf(A, y); }
            A = fmaxf(A, Ac);
            const float m = F + A;
            float mp = __shfl_up(m, 1); if (lane == 0) mp = mprev;
            mg[t] = (f32x2){__expf(lf + mp - m), __expf(li - m)}; fl[t] = __expf(-m);
            ((float*)(a.ws + WS_AT))[(size_t)bh * SEQ + t] = li - F; ((float*)(a.ws + WS_AA))[(size_t)bh * SEQ + t] = A;
            Fc = __shfl(F, 63); Ac = __shfl(A, 63); mprev = __shfl(m, 63);
        }
    }
    const float* qn = a.in[5]; const float* kvn = a.in[6];
    bf16_t* cqn = (bf16_t*)(a.ws + WS_CQN); bf16_t* ckvn = (bf16_t*)(a.ws + WS_CKVN); bf16_t* krope = (bf16_t*)(a.ws + WS_KROPE);
    const f32x2* rp = (const f32x2*)(a.ws + WS_ROPE);
    for (int tk = gw; tk < M_TOK; tk += nw) {
        const bf16_t* row = proj + (size_t)tk * AB_NP;
        float x0[8], x1[8], y[8];
        unpack8(*(const bf16x8*)(row + AB_CQ + lane * 8), x0); unpack8(*(const bf16x8*)(row + AB_CQ + 512 + lane * 8), x1); unpack8(*(const bf16x8*)(row + AB_CKV + lane * 8), y);
        const float kr = bf2f(row[AB_KR + lane]);
        float s = 0.f, s2 = 0.f;
#pragma unroll
        for (int j = 0; j < 8; ++j) { s += x0[j] * x0[j] + x1[j] * x1[j]; s2 += y[j] * y[j]; }
        s = wave_sum(s); s2 = wave_sum(s2);
        const float r1 = rsqrtf(s * (1.0f / 1024.0f) + RMS_EPS), r2 = rsqrtf(s2 * (1.0f / 512.0f) + RMS_EPS);
#pragma unroll
        for (int j = 0; j < 8; ++j) { x0[j] *= r1 * qn[lane * 8 + j]; x1[j] *= r1 * qn[512 + lane * 8 + j]; y[j] *= r2 * kvn[lane * 8 + j]; }
        *(bf16x8*)(cqn + (size_t)tk * 1024 + lane * 8) = pack8f(x0); *(bf16x8*)(cqn + (size_t)tk * 1024 + 512 + lane * 8) = pack8f(x1);
        *(bf16x8*)(ckvn + (size_t)tk * 512 + lane * 8) = pack8f(y);
        const float pr = __shfl_xor(kr, 32); const f32x2 cs = rp[(size_t)(tk & (SEQ - 1)) * 32 + (lane & 31)];
        const float out = lane < 32 ? kr * cs.x - pr * cs.y : pr * cs.y + kr * cs.x;
        krope[(size_t)tk * 64 + lane] = f2bf(out);
    }
}

__device__ __forceinline__ float dpp_xor1(float v) { return __int_as_float(__builtin_amdgcn_update_dpp(0, __float_as_int(v), 0xB1, 0xF, 0xF, true)); }
__device__ __forceinline__ float dpp_xor2(float v) { return __int_as_float(__builtin_amdgcn_update_dpp(0, __float_as_int(v), 0x4E, 0xF, 0xF, true)); }
__device__ __forceinline__ float dpp_hmir(float v) { return __int_as_float(__builtin_amdgcn_update_dpp(0, __float_as_int(v), 0x141, 0xF, 0xF, true)); }
__device__ __forceinline__ float dpp_mir(float v)  { return __int_as_float(__builtin_amdgcn_update_dpp(0, __float_as_int(v), 0x140, 0xF, 0xF, true)); }
__device__ __forceinline__ float row16_sum(float v) { v += dpp_xor1(v); v += dpp_xor2(v); v += dpp_hmir(v); v += dpp_mir(v); return v; }
__device__ __forceinline__ float swap32_sum(float a, float b) {
    auto rr = __builtin_amdgcn_permlane32_swap(__float_as_uint(a), __float_as_uint(b), false, false); return __uint_as_float(rr[0]) + __uint_as_float(rr[1]); }
constexpr int ML_CH = 32;
constexpr int ML_Q = 0, ML_K = ML_CH * 256 * 4, ML_V = 2 * ML_CH * 256 * 4, ML_FI = ML_V + ML_CH * 32 * 4, ML_BUF = ML_FI + ML_CH * 8;
constexpr int ML_OUT = 2 * ML_BUF, ML_DEN = ML_OUT + ML_CH * 32 * 4, ML_END = ML_DEN + ML_CH * 4;
static_assert(ML_END <= LDS_CTL_OFF, "mLSTM LDS");
__device__ __forceinline__ void p4_mlstm(char* lds, const Args& a) {
    const int tid = threadIdx.x, lane = tid & 63, wid = __builtin_amdgcn_readfirstlane(tid >> 6);
    const bf16_t* proj = (const bf16_t*)(a.ws + WS_R); bf16_t* hcat = (bf16_t*)a.out;
    for (int unit = blockIdx.x; unit < 256; unit += gridDim.x) {
        const int bh = unit >> 4, sl = unit & 15, b = bh >> 2, h = bh & 3;
        const f32x2* mg = (const f32x2*)(a.ws + WS_MG) + (size_t)bh * SEQ;
        float* den = (float*)(a.ws + WS_DEN) + (size_t)bh * SEQ;
        const bool denw = (wid == 0) && (sl == 0);
        const int st = tid >> 4, sp = (tid & 15) * 16, vt = tid >> 2, vp = (tid & 3) * 8;
        const bf16_t* qsrc = proj + (size_t)(b * SEQ + st) * AB_NP + AB_Q + h * 256 + sp;
        const bf16_t* ksrc = proj + (size_t)(b * SEQ + st) * AB_NP + AB_K + h * 256 + sp;
        const bf16_t* vsrc = proj + (size_t)(b * SEQ + vt) * AB_NP + AB_V + h * 512 + sl * 32 + vp;
        bf16x8 rq0, rq1, rk0, rk1, rv; f32x2 rfi;
#define ML_LOAD(c) do { const size_t o_ = (size_t)(c) * ML_CH * AB_NP; rq0 = *(const bf16x8*)(qsrc + o_); rq1 = *(const bf16x8*)(qsrc + o_ + 8); rk0 = *(const bf16x8*)(ksrc + o_); rk1 = *(const bf16x8*)(ksrc + o_ + 8); \
        if (tid < 128) rv = *(const bf16x8*)(vsrc + o_); if (tid < ML_CH) rfi = mg[(c) * ML_CH + tid]; } while (0)
#define ML_STORE(bufp) do { float f_[8]; float* Q_ = (float*)((bufp) + ML_Q) + st * 256 + sp; float* K_ = (float*)((bufp) + ML_K) + st * 256 + sp; \
        unpack8(rq0, f_); *(f32x4*)(Q_) = (f32x4){f_[0], f_[1], f_[2], f_[3]}; *(f32x4*)(Q_ + 4) = (f32x4){f_[4], f_[5], f_[6], f_[7]}; \
        unpack8(rq1, f_); *(f32x4*)(Q_ + 8) = (f32x4){f_[0], f_[1], f_[2], f_[3]}; *(f32x4*)(Q_ + 12) = (f32x4){f_[4], f_[5], f_[6], f_[7]}; \
        unpack8(rk0, f_); *(f32x4*)(K_) = (f32x4){f_[0], f_[1], f_[2], f_[3]} * 0.0625f; *(f32x4*)(K_ + 4) = (f32x4){f_[4], f_[5], f_[6], f_[7]} * 0.0625f; \
        unpack8(rk1, f_); *(f32x4*)(K_ + 8) = (f32x4){f_[0], f_[1], f_[2], f_[3]} * 0.0625f; *(f32x4*)(K_ + 12) = (f32x4){f_[4], f_[5], f_[6], f_[7]} * 0.0625f; \
        if (tid < 128) { float* V_ = (float*)((bufp) + ML_V) + vt * 32 + vp; unpack8(rv, f_); *(f32x4*)(V_) = (f32x4){f_[0], f_[1], f_[2], f_[3]}; *(f32x4*)(V_ + 4) = (f32x4){f_[4], f_[5], f_[6], f_[7]}; } \
        if (tid < ML_CH) ((f32x2*)((bufp) + ML_FI))[tid] = rfi; } while (0)
        f32x4 C0 = {0.f, 0.f, 0.f, 0.f}, C1 = C0, C2 = C0, C3 = C0, n4 = C0;
        __syncthreads();
        ML_LOAD(0); ML_STORE(lds); __syncthreads();
        float* OUT = (float*)(lds + ML_OUT); float* DENs = (float*)(lds + ML_DEN);
        for (int c = 0; c < SEQ / ML_CH; ++c) {
            char* buf = lds + (c & 1) * ML_BUF;
            if (c + 1 < SEQ / ML_CH) ML_LOAD(c + 1);
            const float* Qs = (const float*)(buf + ML_Q) + lane * 4; const float* Ks = (const float*)(buf + ML_K) + lane * 4;
            const float* Vs = (const float*)(buf + ML_V) + wid * 4; const f32x2* FIs = (const f32x2*)(buf + ML_FI);
#pragma unroll 4
            for (int s = 0; s < ML_CH; ++s) {
                const f32x4 q4 = *(const f32x4*)(Qs + s * 256), k4 = *(const f32x4*)(Ks + s * 256), v4 = *(const f32x4*)(Vs + s * 32); const f32x2 fi = FIs[s];
                const f32x4 iv = v4 * fi.y;
                C0 = C0 * fi.x + iv * k4[0]; C1 = C1 * fi.x + iv * k4[1]; C2 = C2 * fi.x + iv * k4[2]; C3 = C3 * fi.x + iv * k4[3];
                f32x4 d = C0 * q4[0] + C1 * q4[1] + C2 * q4[2] + C3 * q4[3];
                float e0 = swap32_sum(d[0], d[2]), e1 = swap32_sum(d[1], d[3]);
                const float other = __shfl_xor((lane & 16) ? e0 : e1, 16);
                float r = ((lane & 16) ? e1 : e0) + other;
                r = row16_sum(r);
                if ((lane & 15) == 0) OUT[s * 32 + wid * 4 + (lane >> 5) * 2 + ((lane >> 4) & 1)] = r;
                if (denw) { n4 = n4 * fi.x + k4 * fi.y; float dn = n4[0] * q4[0] + n4[1] * q4[1] + n4[2] * q4[2] + n4[3] * q4[3];
                    dn = swap32_sum(dn, dn); dn += __shfl_xor(dn, 16); dn = row16_sum(dn); if (lane == 0) DENs[s] = dn; }
            }
            __syncthreads();
            if (tid < 128) { const float* o_ = OUT + vt * 32 + vp; float f[8];
#pragma unroll
                for (int j = 0; j < 8; ++j) f[j] = o_[j];
                *(bf16x8*)(hcat + (size_t)(b * SEQ + c * ML_CH + vt) * DM + h * 512 + sl * 32 + vp) = pack8f(f); }
            if (sl == 0 && tid < ML_CH) den[c * ML_CH + tid] = DENs[tid];
            if (c + 1 < SEQ / ML_CH) ML_STORE(lds + ((c + 1) & 1) * ML_BUF);
            __syncthreads();
        }
#undef ML_LOAD
#undef ML_STORE
    }
}

#define TRRD(dst, base, off) asm volatile("ds_read_b64_tr_b16 %0, %1 offset:%2" : "=&v"(dst) : "v"(base), "i"(off) : "memory")
#define TRRD(dst, base, off) asm volatile("ds_read_b64_tr_b16 %0, %1 offset:%2" : "=&v"(dst) : "v"(base), "i"(off) : "memory")
namespace mc {
constexpr int L_K = 0, L_Q = 32768, L_V = 65536, L_EV = 81920, L_CT = 98304, L_TAB = 114688, L_G = 116736;
constexpr int T_A = 0, T_AA = 64, T_INT = 128, T_E = 192;
__device__ __forceinline__ int kaddr(int s, int d) { return (d >> 7) * 16384 + s * 256 + (((d & 127) * 2) ^ ((s & 7) << 4)); }
}
#define MC_QF(d0) (*(const bf16x8*)(lds + L_Q + ((d0) >> 3) * 16384 + TB * 8192 + kq[(d0) & 3] + (((d0) >> 2) & 1) * 128))
template <int TB>
__device__ __forceinline__ void mc_inter(char* lds, float* TAB, const int (&kq)[4], int cfrag, int csw, int lane, int hi) {
    using namespace mc;
    f32x16 o = f32x16{};
    bf16x8 fq[2][2], fc[2][2];
#define MJ_LD(g) do { _Pragma("unroll") for (int e = 0; e < 2; ++e) { const int d0 = 2 * (g) + e; fq[(g) & 1][e] = MC_QF(d0); fc[(g) & 1][e] = *(const bf16x8*)(lds + L_CT + cfrag + (((d0 * 16 + hi * 8) * 2) ^ csw)); } } while (0)
#define MJ_MM(g) do { _Pragma("unroll") for (int e = 0; e < 2; ++e) o = __builtin_amdgcn_mfma_f32_32x32x16_bf16(fq[(g) & 1][e], fc[(g) & 1][e], o, 0, 0, 0); } while (0)
    MJ_LD(0); SBAR();
#pragma unroll
    for (int g = 0; g < 8; ++g) { if (g + 1 < 8) { MJ_LD(g + 1); } SBAR(); MJ_MM(g); SBAR(); }
#undef MJ_LD
#undef MJ_MM
    const float* ti = TAB + T_INT + TB * 32 + 4 * hi; float* G = (float*)(lds + L_G) + TB * 1024 + lane;
#pragma unroll
    for (int r = 0; r < 16; ++r) G[r * 64] = o[r] * ti[(r & 3) + 8 * (r >> 2)];
}
template <int TB>
__device__ __forceinline__ void mc_intra(char* lds, float* TAB, const int (&kq)[4], int vbV, int r32, int hi, f32x16& o, float& ps) {
    using namespace mc;
    const float LOG2E = 1.4426950408889634f;
    const int tl = TB * 32 + r32;
    f32x16 p0 = f32x16{}, p1 = f32x16{};
    bf16x8 fq[2][2], fa0[2][2], fa1[2][2];
#define MI_LD(g) do { _Pragma("unroll") for (int e = 0; e < 2; ++e) { const int d0 = 2 * (g) + e; const char* ap = lds + L_K + (d0 >> 3) * 16384 + kq[d0 & 3] + ((d0 >> 2) & 1) * 128; \
        fq[(g) & 1][e] = MC_QF(d0); fa0[(g) & 1][e] = *(const bf16x8*)ap; if constexpr (TB == 1) fa1[(g) & 1][e] = *(const bf16x8*)(ap + 8192); } } while (0)
#define MI_MM(g) do { _Pragma("unroll") for (int e = 0; e < 2; ++e) { p0 = __builtin_amdgcn_mfma_f32_32x32x16_bf16(fa0[(g) & 1][e], fq[(g) & 1][e], p0, 0, 0, 0); \
        if constexpr (TB == 1) p1 = __builtin_amdgcn_mfma_f32_32x32x16_bf16(fa1[(g) & 1][e], fq[(g) & 1][e], p1, 0, 0, 0); } } while (0)
    MI_LD(0); SBAR();
#pragma unroll
    for (int g = 0; g < 8; ++g) { if (g + 1 < 8) { MI_LD(g + 1); } SBAR(); MI_MM(g); SBAR(); }
#undef MI_LD
#undef MI_MM
    const float At = TAB[T_AA + tl];
    ps = 0.f;
    const float* ta = TAB + T_A + 4 * hi;
#pragma unroll
    for (int r = 0; r < 16; ++r) { const int s0 = fa::crow(r, hi), c0 = (r & 3) + 8 * (r >> 2);
        const float e0 = __builtin_amdgcn_exp2f((ta[c0] - At) * LOG2E) * 0.0625f; const float w0 = (s0 <= tl) ? e0 : 0.f; p0[r] *= w0; ps += p0[r];
        if constexpr (TB == 1) { const float e1 = __builtin_amdgcn_exp2f((ta[32 + c0] - At) * LOG2E) * 0.0625f; const float w1 = (s0 + 32 <= tl) ? e1 : 0.f; p1[r] *= w1; ps += p1[r]; } }
    { auto rr = __builtin_amdgcn_permlane32_swap(__float_as_uint(ps), __float_as_uint(ps), false, false); ps = __uint_as_float(rr[0]) + __uint_as_float(rr[1]); }
    bf16x8 pa0, pa1, pa2, pa3;
#define PK4(P, B_, OUT) do { unsigned a0 = fa::cvtpk(P[B_+0], P[B_+1]), a1 = fa::cvtpk(P[B_+2], P[B_+3]);                  \
        unsigned b0_ = fa::cvtpk(P[B_+4], P[B_+5]), b1_ = fa::cvtpk(P[B_+6], P[B_+7]);                                   \
        auto r0 = __builtin_amdgcn_permlane32_swap(a0, b0_, false, false); auto r1 = __builtin_amdgcn_permlane32_swap(a1, b1_, false, false); \
        u32x4 w = {r0[0], r1[0], r0[1], r1[1]}; OUT = *reinterpret_cast<bf16x8*>(&w); } while (0)
    PK4(p0, 0, pa0); PK4(p0, 8, pa1); PK4(p1, 0, pa2); PK4(p1, 8, pa3);
#undef PK4
    o = f32x16{};
    { s16x4 l0, l1, l2, l3, h0, h1, h2, h3;
      TRRD(l0, vbV, 0); TRRD(h0, vbV, 2048); TRRD(l1, vbV, 4096); TRRD(h1, vbV, 6144); TRRD(l2, vbV, 8192); TRRD(h2, vbV, 10240); TRRD(l3, vbV, 12288); TRRD(h3, vbV, 14336);
      asm volatile("s_waitcnt lgkmcnt(0)" ::: "memory"); SBAR();
      o = __builtin_amdgcn_mfma_f32_32x32x16_bf16(pa0, (bf16x8){l0[0], l0[1], l0[2], l0[3], h0[0], h0[1], h0[2], h0[3]}, o, 0, 0, 0);
      o = __builtin_amdgcn_mfma_f32_32x32x16_bf16(pa1, (bf16x8){l1[0], l1[1], l1[2], l1[3], h1[0], h1[1], h1[2], h1[3]}, o, 0, 0, 0);
      if constexpr (TB == 1) { o = __builtin_amdgcn_mfma_f32_32x32x16_bf16(pa2, (bf16x8){l2[0], l2[1], l2[2], l2[3], h2[0], h2[1], h2[2], h2[3]}, o, 0, 0, 0);
                               o = __builtin_amdgcn_mfma_f32_32x32x16_bf16(pa3, (bf16x8){l3[0], l3[1], l3[2], l3[3], h3[0], h3[1], h3[2], h3[3]}, o, 0, 0, 0); } }
}
#undef MC_QF
__device__ __forceinline__ void p4_mlstm_chunk(char* lds, const Args& a) {
    using namespace mc;
    const int tid = threadIdx.x, lane = tid & 63, wid = __builtin_amdgcn_readfirstlane(tid >> 6);
    const bf16_t* proj = (const bf16_t*)(a.ws + WS_R); bf16_t* hcat = (bf16_t*)a.out;
    float* TAB = (float*)(lds + L_TAB);
    const float LOG2E = 1.4426950408889634f;
    for (int unit = blockIdx.x; unit < 256; unit += gridDim.x) {
        const int bh = (gridDim.x == 256) ? 2 * (unit & 7) + (unit >> 7) : unit >> 4, sl = (gridDim.x == 256) ? (unit >> 3) & 15 : unit & 15, b = bh >> 2, h = bh & 3;
        const float* AT = (const float*)(a.ws + WS_AT) + (size_t)bh * SEQ; const float* AA = (const float*)(a.ws + WS_AA) + (size_t)bh * SEQ;
        float* deni = (float*)(a.ws + WS_DENI) + (size_t)bh * SEQ; float* denp = (float*)(a.ws + WS_DENP) + (size_t)(bh * 16 + sl) * SEQ;
        const int krow = tid >> 3, kch = (tid & 7) * 4, vrow = (tid >> 2) & 63, vch = tid & 3;
        const bf16_t* ksrc = proj + (size_t)(b * SEQ + krow) * AB_NP + AB_K + h * 256 + kch * 8;
        const bf16_t* qsrc = proj + (size_t)(b * SEQ + krow) * AB_NP + AB_Q + h * 256 + kch * 8;
        const bf16_t* vsrc = proj + (size_t)(b * SEQ + vrow) * AB_NP + AB_V + h * 512 + sl * 32 + vch * 8;
        int kdst[4];
#pragma unroll
        for (int i = 0; i < 4; ++i) { const int ch = kch + i; kdst[i] = (ch >> 4) * 16384 + KSWZ(krow, (ch & 15) * 16); }
        const int vdst = fa::v_st(vrow, vch * 8);
        bf16x8 rk[4], rq[4], rv; float pa_t = 0.f, pA_t = 0.f, pa_v = 0.f, pA_prev = 0.f, pA_end = 0.f;
#define MC_LOAD(c) do { const size_t o_ = (size_t)(c) * 64 * AB_NP; _Pragma("unroll") for (int i = 0; i < 4; ++i) { rk[i] = *(const bf16x8*)(ksrc + o_ + i * 8); rq[i] = *(const bf16x8*)(qsrc + o_ + i * 8); } \
        if (tid < 256) { rv = *(const bf16x8*)(vsrc + o_); pa_v = AT[(c) * 64 + vrow]; } if (tid < 64) { pa_t = AT[(c) * 64 + tid]; pA_t = AA[(c) * 64 + tid]; } \
        pA_end = AA[(c) * 64 + 63]; pA_prev = (c) > 0 ? AA[(c) * 64 - 1] : 0.f; } while (0)
        f32x16 Cacc = f32x16{};
        f32x16 oi = f32x16{}; float psi = 0.f;
        float nreg = 0.f;
        __syncthreads();
        for (int i = tid; i < 16384 / 16; i += NTHREADS) *(u32x4*)(lds + L_CT + i * 16) = (u32x4){0u, 0u, 0u, 0u};
        MC_LOAD(0);
        for (int c = 0; c < SEQ / 64; ++c) {
            const int t0 = c * 64;
            const float A_prev = pA_prev, A_end = pA_end;
            asm volatile("s_waitcnt vmcnt(0)" ::: "memory");
#pragma unroll
            for (int i = 0; i < 4; ++i) { *(bf16x8*)(lds + L_K + kdst[i]) = rk[i]; *(bf16x8*)(lds + L_Q + kdst[i]) = rq[i]; }
            if (tid < 256) { *(bf16x8*)(lds + L_V + vdst) = rv; const float e = __builtin_amdgcn_exp2f((pa_v - A_end) * LOG2E) * 0.0625f;
                float f[8]; unpack8(rv, f);
#pragma unroll
                for (int j = 0; j < 8; ++j) f[j] *= e;
                *(bf16x8*)(lds + L_EV + vdst) = pack8f(f); }
            if (tid < 64) { TAB[T_A + tid] = pa_t; TAB[T_AA + tid] = pA_t; TAB[T_INT + tid] = __builtin_amdgcn_exp2f((A_prev - pA_t) * LOG2E); TAB[T_E + tid] = __builtin_amdgcn_exp2f((pa_t - A_end) * LOG2E) * 0.0625f; }
            __syncthreads();
            if (c + 1 < SEQ / 64) MC_LOAD(c + 1);
            const float decay = __builtin_amdgcn_exp2f((A_prev - A_end) * LOG2E);
            int lane_o = lane; asm volatile("" : "+v"(lane_o));
            const int r32 = lane_o & 31, hi = lane_o >> 5;
            int kq[4];
#pragma unroll
            for (int dd = 0; dd < 4; ++dd) kq[dd] = KSWZ(r32, dd * 32 + hi * 16);
            const int cfrag = r32 * 512, csw = (r32 & 15) << 4;
            const int trq = (lane_o & 15) >> 2, trp = lane_o & 3, trg = (lane_o >> 4) & 1;
            const int vbV = (int)(uintptr_t)lds + L_V + fa::v_rd_base(lane_o), vbE = (int)(uintptr_t)lds + L_EV + fa::v_rd_base(lane_o);
            if (wid == 0) mc_intra<0>(lds, TAB, kq, vbV, r32, hi, oi, psi);
            else if (wid == 1) mc_intra<1>(lds, TAB, kq, vbV, r32, hi, oi, psi);
            else if (wid == 2) mc_inter<0>(lds, TAB, kq, cfrag, csw, lane_o, hi);
            else if (wid == 3) mc_inter<1>(lds, TAB, kq, cfrag, csw, lane_o, hi);
            if (wid == 7) {
                const int d0_ = 16 * sl;
                float qv[16]; { float f[8]; unpack8(*(const bf16x8*)(lds + L_Q + kaddr(lane, d0_)), f);
#pragma unroll
                    for (int j = 0; j < 8; ++j) qv[j] = f[j];
                    unpack8(*(const bf16x8*)(lds + L_Q + kaddr(lane, d0_ + 8)), f);
#pragma unroll
                    for (int j = 0; j < 8; ++j) qv[8 + j] = f[j]; }
                float dsum = 0.f;
#pragma unroll
                for (int d = 0; d < 16; ++d) dsum += qv[d] * __int_as_float(__builtin_amdgcn_readlane(__float_as_int(nreg), d));
                denp[t0 + lane] = dsum * TAB[T_INT + lane];
                const int dd = lane & 15, sq = lane >> 4; float part = 0.f;
#pragma unroll
                for (int j = 0; j < 16; ++j) { const int s = sq * 16 + j; part += TAB[T_E + s] * bf2f(*(const bf16_t*)(lds + L_K + kaddr(s, d0_ + dd))); }
                part += __shfl_xor(part, 16); part += __shfl_xor(part, 32);
                nreg = nreg * decay + part;
            }
            {
#pragma unroll
                for (int r = 0; r < 16; ++r) Cacc[r] *= decay;
                s16x4 l0, l1, l2, l3, h0, h1, h2, h3;
                TRRD(l0, vbE, 0); TRRD(h0, vbE, 2048); TRRD(l1, vbE, 4096); TRRD(h1, vbE, 6144); TRRD(l2, vbE, 8192); TRRD(h2, vbE, 10240); TRRD(l3, vbE, 12288); TRRD(h3, vbE, 14336);
                s16x4 ka[4][2];
                { const int d = 32 * wid + trg * 16 + 4 * trp;
                  const int ad0 = (int)(uintptr_t)lds + L_K + kaddr(8 * hi + trq, d), ad1 = (int)(uintptr_t)lds + L_K + kaddr(8 * hi + 4 + trq, d);
                  TRRD(ka[0][0], ad0, 0); TRRD(ka[0][1], ad1, 0); TRRD(ka[1][0], ad0, 4096); TRRD(ka[1][1], ad1, 4096);
                  TRRD(ka[2][0], ad0, 8192); TRRD(ka[2][1], ad1, 8192); TRRD(ka[3][0], ad0, 12288); TRRD(ka[3][1], ad1, 12288); }
                asm volatile("s_waitcnt lgkmcnt(0)" ::: "memory"); SBAR();
#define KAF(ks) (bf16x8){ka[ks][0][0], ka[ks][0][1], ka[ks][0][2], ka[ks][0][3], ka[ks][1][0], ka[ks][1][1], ka[ks][1][2], ka[ks][1][3]}
                Cacc = __builtin_amdgcn_mfma_f32_32x32x16_bf16(KAF(0), (bf16x8){l0[0], l0[1], l0[2], l0[3], h0[0], h0[1], h0[2], h0[3]}, Cacc, 0, 0, 0);
                Cacc = __builtin_amdgcn_mfma_f32_32x32x16_bf16(KAF(1), (bf16x8){l1[0], l1[1], l1[2], l1[3], h1[0], h1[1], h1[2], h1[3]}, Cacc, 0, 0, 0);
                Cacc = __builtin_amdgcn_mfma_f32_32x32x16_bf16(KAF(2), (bf16x8){l2[0], l2[1], l2[2], l2[3], h2[0], h2[1], h2[2], h2[3]}, Cacc, 0, 0, 0);
                Cacc = __builtin_amdgcn_mfma_f32_32x32x16_bf16(KAF(3), (bf16x8){l3[0], l3[1], l3[2], l3[3], h3[0], h3[1], h3[2], h3[3]}, Cacc, 0, 0, 0);
#undef KAF
            }
            __syncthreads();
            float one = 1.0f; asm volatile("" : "+v"(one));
#pragma unroll
            for (int g = 0; g < 4; ++g) { const int d4 = 32 * wid + 8 * g + 4 * hi; u32x2 w; w.x = cvt_pk_bf16(Cacc[4 * g] * one, Cacc[4 * g + 1] * one); w.y = cvt_pk_bf16(Cacc[4 * g + 2] * one, Cacc[4 * g + 3] * one);
                *(u32x2*)(lds + L_CT + cfrag + ((d4 * 2) ^ csw)) = w; }
            if (wid < 2) {
                const float* G = (const float*)(lds + L_G) + wid * 1024 + lane_o;
                bf16_t* ob = hcat + (size_t)(b * SEQ + t0 + wid * 32) * DM + h * 512 + sl * 32;
                const int lofs = hi * 4 * DM + r32;
#pragma unroll
                for (int r = 0; r < 16; ++r) { const float v = oi[r] + G[r * 64], vn = dpp_xor1(v);
                    if ((r32 & 1) == 0) *(unsigned*)((ob + (size_t)((r & 3) + 8 * (r >> 2)) * DM) + lofs) = cvt_pk_bf16(v, vn); }
                if (sl == 0 && hi == 0) deni[t0 + wid * 32 + r32] = psi;
            }
        }
#undef MC_LOAD
        __syncthreads();
    }
}
#undef TRRD

__device__ __forceinline__ void p5_mlstm_norm(const Args& a) {
    const int tid = threadIdx.x, lane = tid & 63, wid = tid >> 6;
    const int gw = blockIdx.x * 8 + wid, nw = gridDim.x * 8;
    const bf16_t* proj = (const bf16_t*)(a.ws + WS_R); bf16_t* hcat = (bf16_t*)a.out;
    const float* den = (const float*)(a.ws + WS_DEN); const float* fl = (const float*)(a.ws + WS_FLOOR); const float* mn = a.in[4];
    for (int it = gw; it < M_TOK * 4; it += nw) {
        const int tk = it >> 2, h = it & 3, b = tk >> 12, t = tk & (SEQ - 1), bh = b * 4 + h;
        bf16_t* hp = hcat + (size_t)tk * DM + h * 512 + lane * 8;
        float x[8], og[8];
        unpack8(*(const bf16x8*)hp, x); unpack8(*(const bf16x8*)(proj + (size_t)tk * AB_NP + AB_OG + h * 512 + lane * 8), og);
#if MLSTM_CHUNK && !MLSTM_BOTH && (DEBUG_CMP < 0)
        float dsum = ((const float*)(a.ws + WS_DENI))[(size_t)bh * SEQ + t];
#pragma unroll
        for (int q = 0; q < 16; ++q) dsum += ((const float*)(a.ws + WS_DENP))[(size_t)(bh * 16 + q) * SEQ + t];
#else
        const float dsum = den[(size_t)bh * SEQ + t];
#endif
        const float dd = fmaxf(fabsf(dsum), fl[(size_t)bh * SEQ + t]); const float inv = 1.0f / dd;
        float s = 0.f;
#pragma unroll
        for (int j = 0; j < 8; ++j) { x[j] *= inv; s += x[j] * x[j]; }
        s = wave_sum(s);
        const float r = rsqrtf(s * (1.0f / 512.0f) + RMS_EPS);
#pragma unroll
        for (int j = 0; j < 8; ++j) x[j] = x[j] * r * mn[h * 512 + lane * 8 + j] * sigmoid_f(og[j]);
        *(bf16x8*)hp = pack8f(x);
    }
}
__device__ __forceinline__ int xcd_unit(int k, int per, int groups, int upg) {
    const int w = blockIdx.x, G = gridDim.x;
    if (G != 256 || per * 256 != groups * upg) return w + k * G;
    const int j = w & 7, s = w >> 3, lu = k * 32 + s;
    return (j * (groups >> 3) + lu / upg) * upg + lu % upg;
}
__device__ __forceinline__ void p5_mla(char* lds, const Args& a) {
    const int tid = threadIdx.x, wid = __builtin_amdgcn_readfirstlane(tid >> 6), lane = tid & 63, r32 = lane & 31, hi = lane >> 5;
    const bf16_t* qb = (const bf16_t*)(a.ws + WS_QB); const bf16_t* kvb = (const bf16_t*)(a.ws + WS_KVB); const bf16_t* krope = (const bf16_t*)(a.ws + WS_KROPE);
    bf16_t* hcat = (bf16_t*)a.out;     const f32x2* rp = (const f32x2*)(a.ws + WS_ROPE);
    for (int kk = 0; kk * (int)gridDim.x < 64 * 8 * 2; ++kk) {
        const int it2 = xcd_unit(kk >> 1, 2, 64, 8), pass = kk & 1; if (it2 >= 512) break;
        const int bh = it2 >> 3, x = it2 & 7, b = bh >> 4, h = bh & 15;
        const int qblk = pass ? 15 - x : x, t0 = qblk * 256, pos = t0 + wid * 32 + r32;
        const bf16_t* qrow = qb + (size_t)(b * SEQ + pos) * 3072 + h * 192;
        bf16x8 qr[8], qrr[4];
#pragma unroll
        for (int d0 = 0; d0 < 8; ++d0) qr[d0] = *(const bf16x8*)(qrow + d0 * 16 + hi * 8);
#pragma unroll
        for (int d0 = 0; d0 < 4; ++d0) qrr[d0] = *(const bf16x8*)(qrow + 128 + d0 * 16 + hi * 8);
#pragma unroll
        for (int g = 0; g < 2; ++g) { float x1[8], x2[8], o1[8], o2[8]; unpack8(qrr[g], x1); unpack8(qrr[2 + g], x2);
#pragma unroll
            for (int j = 0; j < 8; ++j) { const f32x2 cs = rp[(size_t)pos * 32 + g * 16 + hi * 8 + j]; o1[j] = x1[j] * cs.x - x2[j] * cs.y; o2[j] = x1[j] * cs.y + x2[j] * cs.x; }
            char* qpark = lds + fa::OFF_QPARK + wid * 4096 + lane * 16;
            *(bf16x8*)(qpark + g * 1024) = pack8f(o1); *(bf16x8*)(qpark + (2 + g) * 1024) = pack8f(o2); }
        fa::FUnit u; u.Kb = kvb + (size_t)(b * SEQ) * 4096 + h * 256; u.ldk = 4096; u.Vb = u.Kb + 128; u.ldv = 4096; u.KRb = krope + (size_t)(b * SEQ) * 64;
        u.j_lo = 0; u.j_hi = (t0 + 255) / 64 + 1; u.qlo = t0 + wid * 32; u.qhi = u.qlo + 31; u.qpos = pos; u.sel = 0ull;
        f32x16 o[4]; float m_reg, l_reg;
        fa::flash_core<0>(lds, u, qr, 0.07216878364870322f, o, m_reg, l_reg);
        float rf[16]; fa::row_factors(lds, wid, r32, hi, 1.0f / l_reg, rf);
        bf16_t* ob = hcat + (size_t)(b * SEQ + t0 + wid * 32) * DM + 2048 + h * 128;
#pragma unroll
        for (int r = 0; r < 16; ++r) { const int orow = fa::crow(r, hi);
#pragma unroll
            for (int d0 = 0; d0 < 4; ++d0) { const float v = o[d0][r] * rf[r]; const float vn = __shfl_xor(v, 1);
                if ((r32 & 1) == 0) *(unsigned*)(ob + (size_t)orow * DM + d0 * 32 + r32) = cvt_pk_bf16(v, vn); } }
        __syncthreads();
    }
}

__device__ __forceinline__ void p7_layernorm(const Args& a, int layer_idx, bool mix, const float* z, float* outf, bf16_t* outb, f32x2* stats) {
    const int tid = threadIdx.x, lane = tid & 63, wid = tid >> 6;
    const int gw = blockIdx.x * 8 + wid, nw = gridDim.x * 8;
    const float* g = (mix ? a.in[22] : a.in[24]) + (size_t)layer_idx * DM; const float* bb = (mix ? a.in[23] : a.in[25]) + (size_t)layer_idx * DM;
    for (int row = gw; row < M_TOK; row += nw) {
        const float* zr = z + (size_t)row * DM;
        f32x4 v[16]; float s = 0.f;
#pragma unroll
        for (int i = 0; i < 16; ++i) { v[i] = *(const f32x4*)(zr + i * 256 + lane * 4); s += (v[i][0] + v[i][1]) + (v[i][2] + v[i][3]); }
        s = wave_sum(s); const float mu = s * (1.0f / DM);
        float q = 0.f;
#pragma unroll
        for (int i = 0; i < 16; ++i) { const f32x4 d = v[i] - mu; q += (d[0] * d[0] + d[1] * d[1]) + (d[2] * d[2] + d[3] * d[3]); }
        q = wave_sum(q); const float rs = rsqrtf(q * (1.0f / DM) + LN_EPS);
        if (stats && lane == 0) stats[row] = (f32x2){mu, rs};
#pragma unroll
        for (int i = 0; i < 16; ++i) { const int c = i * 256 + lane * 4; const f32x4 gg = *(const f32x4*)(g + c), be = *(const f32x4*)(bb + c);
            const f32x4 y = (v[i] - mu) * rs * gg + be;
            if (outf) *(f32x4*)(outf + (size_t)row * DM + c) = y;
            if (outb) { u32x2 w; w.x = cvt_pk_bf16(y[0], y[1]); w.y = cvt_pk_bf16(y[2], y[3]); *(u32x2*)(outb + (size_t)row * DM + c) = w; } }
    }
}
__device__ __forceinline__ void p7_layernorm_b(const Args& a, int layer_idx, bool mix, const bf16_t* zb, float* outf, bf16_t* outb, f32x2* stats) {
    const int tid = threadIdx.x, lane = tid & 63, wid = tid >> 6;
    const int gw = blockIdx.x * 8 + wid, nw = gridDim.x * 8;
    const float* g = (mix ? a.in[22] : a.in[24]) + (size_t)layer_idx * DM; const float* bb = (mix ? a.in[23] : a.in[25]) + (size_t)layer_idx * DM;
    bf16x8 nx[8];
    if (gw < M_TOK) {
#pragma unroll
        for (int i = 0; i < 8; ++i) nx[i] = *(const bf16x8*)(zb + (size_t)gw * DM + i * 512 + lane * 8); }
    for (int row = gw; row < M_TOK; row += nw) {
        float v[8][8]; float s = 0.f;
#pragma unroll
        for (int i = 0; i < 8; ++i) { unpack8h(nx[i], v[i]); s += ((v[i][0] + v[i][1]) + (v[i][2] + v[i][3])) + ((v[i][4] + v[i][5]) + (v[i][6] + v[i][7])); }
        { const int rn = row + nw < M_TOK ? row + nw : row;
#pragma unroll
          for (int i = 0; i < 8; ++i) nx[i] = *(const bf16x8*)(zb + (size_t)rn * DM + i * 512 + lane * 8); }
        s = wave_sum(s); const float mu = s * (1.0f / DM);
        float q = 0.f;
#pragma unroll
        for (int i = 0; i < 8; ++i)
#pragma unroll
            for (int j = 0; j < 8; ++j) { const float d = v[i][j] - mu; q += d * d; }
        q = wave_sum(q); const float rs = rsqrtf(q * (1.0f / DM) + LN_EPS);
        if (stats && lane == 0) stats[row] = (f32x2){mu, rs};
#pragma unroll
        for (int i = 0; i < 8; ++i) { const int c = i * 512 + lane * 8; const f32x4 g0 = *(const f32x4*)(g + c), g1 = *(const f32x4*)(g + c + 4), b0 = *(const f32x4*)(bb + c), b1 = *(const f32x4*)(bb + c + 4);
            float y[8];
#pragma unroll
            for (int j = 0; j < 4; ++j) { y[j] = (v[i][j] - mu) * rs * g0[j] + b0[j]; y[4 + j] = (v[i][4 + j] - mu) * rs * g1[j] + b1[j]; }
            if (outf) { *(f32x4*)(outf + (size_t)row * DM + c) = (f32x4){y[0], y[1], y[2], y[3]}; *(f32x4*)(outf + (size_t)row * DM + c + 4) = (f32x4){y[4], y[5], y[6], y[7]}; }
            if (outb) *(bf16x8*)(outb + (size_t)row * DM + c) = pack8f(y); }
    }
}
__device__ __forceinline__ void p12_blocks(const Args& a) {
    const bf16_t* projc = (const bf16_t*)(a.ws + WS_R);
    const size_t gt = (size_t)blockIdx.x * NTHREADS + threadIdx.x, gs = (size_t)gridDim.x * NTHREADS;
    for (size_t i = gt; i < (size_t)2 * 4096 * 512; i += gs) {
        const int which = (int)(i / ((size_t)4096 * 512)); const int rem = (int)(i % ((size_t)4096 * 512));
        const int r = rem >> 9, l = (rem >> 4) & 31, d8 = rem & 15, g = r & 3, n = (r >> 2) & 255, b = r >> 10;
        bf16_t* A = (bf16_t*)(a.ws + (which ? WS_AV : WS_AK)); const float* pe = which ? a.in[13] : a.in[12];
        float f[8];
        if (n < 255) { unpack8(*(const bf16x8*)(projc + (size_t)(b * SEQ + 16 * n + l) * C_NP + (which ? C_VC : C_KC) + g * 128 + d8 * 8), f);
#pragma unroll
            for (int j = 0; j < 8; ++j) f[j] += pe[l * 128 + d8 * 8 + j]; }
        else {
#pragma unroll
            for (int j = 0; j < 8; ++j) f[j] = 0.f; }
        *(bf16x8*)(A + (size_t)r * 4096 + l * 128 + d8 * 8) = pack8f(f);
    }
}
__device__ __forceinline__ float nsa_gate(const Args& a, int token, int br, int head) {
    const bf16_t* projc = (const bf16_t*)(a.ws + WS_R);
    return sigmoid_f(bf2f(projc[(size_t)token * C_NP + C_GATE + br * 32 + head]) + a.in[11][br * 32 + head]);
}
__device__ __forceinline__ void p15_cmp_attn(char* lds, const Args& a) {
    const int tid = threadIdx.x, wid = __builtin_amdgcn_readfirstlane(tid >> 6), lane = tid & 63, r32 = lane & 31, hi = lane >> 5;
    const bf16_t* projc = (const bf16_t*)(a.ws + WS_R); const bf16_t* kcmp = (const bf16_t*)(a.ws + WS_KCMP); const bf16_t* vcmp = (const bf16_t*)(a.ws + WS_VCMP);
    float* acc = (float*)(a.ws + WS_Z); unsigned long long* selp = (unsigned long long*)(a.ws + WS_SEL);
    const float scale = 0.08838834764831845f, C2 = 1.4426950408889634f * scale;
    float* IMP = (float*)(lds + fa::OFF_IMP);
    for (int kk = 0; kk * (int)gridDim.x < 2048; ++kk) {
        const int unit = xcd_unit(kk, 8, 16, 128); if (unit >= 2048) break;
        const int bg = unit >> 7, xb = unit & 127, b = bg >> 2, g = bg & 3, t0 = xb * 32;
        const int tokl = wid * 4 + (r32 >> 3), head = g * 8 + (r32 & 7), tq = t0 + tokl;
        const bf16_t* qrow = projc + (size_t)(b * SEQ + tq) * C_NP + C_Q + head * 128;
        bf16x8 qr[8];
#pragma unroll
        for (int d0 = 0; d0 < 8; ++d0) qr[d0] = *(const bf16x8*)(qrow + d0 * 16 + hi * 8);
        fa::FUnit u; u.Kb = kcmp + (size_t)(b * 256 * 4 + g) * 256; u.ldk = 1024; u.Vb = vcmp + (size_t)(b * 256 * 4 + g) * 256; u.ldv = 1024; u.KRb = nullptr;
        const int nmax_hi = (t0 + 31 - 31) >> 4;
        u.j_lo = 0; u.j_hi = (nmax_hi >> 6) + 1; u.qlo = (t0 + wid * 4 - 31) >> 4; u.qhi = (t0 + wid * 4 + 3 - 31) >> 4; u.qpos = (tq - 31) >> 4; u.sel = 0ull;
        f32x16 o[4]; float m_reg, l_reg;
        fa::flash_core<3>(lds, u, qr, scale, o, m_reg, l_reg);
        const float inv_l = l_reg > 0.f ? 1.0f / l_reg : 0.f;
        { float rf[16]; fa::row_factors(lds, wid, r32, hi, inv_l * nsa_gate(a, b * SEQ + tq, 0, head), rf);
#pragma unroll
          for (int r = 0; r < 16; ++r) { const int orow = fa::crow(r, hi); const int tk = t0 + wid * 4 + (orow >> 3), hd = g * 8 + (orow & 7);
              float* op = acc + (size_t)(b * SEQ + tk) * DM + hd * 128 + r32;
#pragma unroll
              for (int d0 = 0; d0 < 4; ++d0) op[d0 * 32] = o[d0][r] * rf[r]; } }
        __syncthreads();
        const float mL = -m_reg * C2;
        const int sr = tid >> 4, sc = (tid & 15) * 8, kws = KSWZ(sr, sc * 2);
        for (int t = 0; t < u.j_hi; ++t) {
            const int kb = t * 64;
            const bf16x8 k0 = *(const bf16x8*)(u.Kb + (long)(kb + sr) * u.ldk + sc), k1 = *(const bf16x8*)(u.Kb + (long)(kb + 32 + sr) * u.ldk + sc);
            *(bf16x8*)(lds + fa::OFF_K + kws) = k0; *(bf16x8*)(lds + fa::OFF_K + kws + 32 * 256) = k1;
            __syncthreads();
            f32x16 p0, p1; fa::qkt<0, false, true>(p0, p1, lds, r32, hi, qr);
            fa::mask_tile(p0, p1, u.qpos - kb - 4 * hi, 0x80000000u);
#pragma unroll
            for (int r = 0; r < 16; ++r) {
                float a0 = __builtin_amdgcn_exp2f(fmaf(p0[r], C2, mL)) * inv_l, a1 = __builtin_amdgcn_exp2f(fmaf(p1[r], C2, mL)) * inv_l;
                a0 += dpp_xor1(a0); a0 += dpp_xor2(a0); a0 += dpp_hmir(a0);
                a1 += dpp_xor1(a1); a1 += dpp_xor2(a1); a1 += dpp_hmir(a1);
                if ((r32 & 7) == 0) { const int n = kb + fa::crow(r, hi); IMP[tokl * fa::IMP_LD + n] = a0; IMP[tokl * fa::IMP_LD + n + 32] = a1; }
            }
            __syncthreads();
        }
        for (int q4 = 0; q4 < 4; ++q4) {
            const int tl = wid * 4 + q4, tqq = t0 + tl, cur = tqq >> 6, s = lane;
            float v = 0.f;
#pragma unroll
            for (int dn = -1; dn <= 3; ++dn) { const int n = 4 * s + dn; if (n >= 0 && n <= 254 && n < u.j_hi * 64) v += IMP[tl * fa::IMP_LD + n]; }
            if (s == 0 || s == cur || s == cur - 1) v = 1e9f;
            if (s > cur) v = -1e30f;
            int rank = 0;
#pragma nounroll
            for (int j = 0; j < 64; ++j) { const float vj = __int_as_float(__builtin_amdgcn_readlane(__float_as_int(v), j)); rank += (vj > v || (vj == v && j < s)) ? 1 : 0; }
            const unsigned long long msk = __ballot(rank < 16);
            if (lane == 0) selp[(size_t)bg * SEQ + tqq] = msk;
        }
        __syncthreads();
    }
}
template <int MODE, int VAR = 0>
__device__ __forceinline__ void p16_nsa_attn(char* lds, const Args& a) {
    const int tid = threadIdx.x, wid = __builtin_amdgcn_readfirstlane(tid >> 6), lane = tid & 63, r32 = lane & 31, hi = lane >> 5;
    const bf16_t* projc = (const bf16_t*)(a.ws + WS_R); float* acc = (float*)(a.ws + WS_Z); bf16_t* hcat = (bf16_t*)a.out;
    const unsigned long long* selp = (const unsigned long long*)(a.ws + WS_SEL);
    const float scale = 0.08838834764831845f;
    const int nitems = (MODE == 2) ? 2048 : 2048;
    for (int kk = 0; kk * (int)gridDim.x < nitems; ++kk) {
        int bg, xb;
        if (MODE == 2) { const int pass = kk & 1, it2 = xcd_unit(kk >> 1, 4, 16, 64); if (it2 >= 1024) break; bg = it2 >> 6; const int x = it2 & 63; xb = pass ? 127 - x : x; }
        else { const int item = xcd_unit(kk, 8, 16, 128); if (item >= 2048) break; bg = item >> 7; xb = item & 127; }
        const int b = bg >> 2, g = bg & 3, t0 = xb * 32, head = g * 8 + wid, tq = t0 + r32;
        const bf16_t* qrow = projc + (size_t)(b * SEQ + tq) * C_NP + C_Q + head * 128;
        bf16x8 qr[8];
#pragma unroll
        for (int d0 = 0; d0 < 8; ++d0) qr[d0] = *(const bf16x8*)(qrow + d0 * 16 + hi * 8);
        fa::FUnit u; u.KRb = nullptr; u.ldk = C_NP; u.ldv = C_NP; u.qlo = t0; u.qhi = t0 + 31; u.qpos = tq; u.sel = 0ull;
        if (MODE == 1) { u.Kb = projc + (size_t)(b * SEQ) * C_NP + C_KW + g * 128; u.Vb = projc + (size_t)(b * SEQ) * C_NP + C_VW + g * 128;
            const int lowk = t0 - 511; u.j_lo = lowk > 0 ? lowk / 64 : 0; u.j_hi = (t0 + 31) / 64 + 1; }
        else { u.Kb = projc + (size_t)(b * SEQ) * C_NP + C_KS + g * 128; u.Vb = projc + (size_t)(b * SEQ) * C_NP + C_VS + g * 128;
            u.j_lo = 0; u.j_hi = (t0 + 31) / 64 + 1; u.sel = selp[(size_t)bg * SEQ + tq]; }
        f32x16 o[4]; float m_reg, l_reg;
#if FLASH2
        fa::flash_core2<MODE>(lds, u, qr, scale, o, m_reg, l_reg);
#else
        fa::flash_core<MODE, VAR>(lds, u, qr, scale, o, m_reg, l_reg);
#endif
        float rf[16]; fa::row_factors(lds, wid, r32, hi, nsa_gate(a, b * SEQ + tq, MODE == 1 ? 2 : 1, head) / l_reg, rf);
        if (VAR != 0) { float sink = 0.f; for (int d0 = 0; d0 < 4; ++d0) for (int r = 0; r < 16; ++r) sink += o[d0][r] * rf[r]; if (sink == 1.2345e-30f) acc[0] = sink; __syncthreads(); continue; }
        const size_t off0 = (size_t)(b * SEQ + t0 + 4 * hi) * DM + head * 128 + r32;
        float av[16][4];
#pragma unroll
        for (int r = 0; r < 16; ++r)
#pragma unroll
            for (int d0 = 0; d0 < 4; ++d0) av[r][d0] = acc[off0 + (size_t)((r & 3) + 8 * (r >> 2)) * DM + d0 * 32];
        asm volatile("" ::: "memory");
#pragma unroll
        for (int r = 0; r < 16; ++r) { const size_t off = off0 + (size_t)((r & 3) + 8 * (r >> 2)) * DM;
#pragma unroll
            for (int d0 = 0; d0 < 4; ++d0) { const float v = av[r][d0] + o[d0][r] * rf[r];
                if (MODE == 1) acc[off + d0 * 32] = v;
                else { const float vn = dpp_xor1(v); if ((r32 & 1) == 0) *(unsigned*)(hcat + off + d0 * 32) = cvt_pk_bf16(v, vn); } } }
        __syncthreads();
    }
}
__device__ __forceinline__ void p1617_nsa_attn(char* lds, const Args& a) {
    const int tid = threadIdx.x, wid = __builtin_amdgcn_readfirstlane(tid >> 6), lane = tid & 63, r32 = lane & 31, hi = lane >> 5;
    const bf16_t* projc = (const bf16_t*)(a.ws + WS_R); const float* acc = (const float*)(a.ws + WS_Z); bf16_t* hcat = (bf16_t*)a.out;
    const unsigned long long* selp = (const unsigned long long*)(a.ws + WS_SEL);
    const float scale = 0.08838834764831845f;
    unsigned* park = (unsigned*)(lds + fa::OFF_IMP) + wid * 2048 + lane;
    static_assert(fa::OFF_IMP + 8 * 8192 <= fa::LDS_END, "park region");
    for (int kk = 0; kk * (int)gridDim.x < 2048; ++kk) {
        const int pass = kk & 1, it2 = xcd_unit(kk >> 1, 4, 16, 64); if (it2 >= 1024) break;
        const int bg = it2 >> 6, x = it2 & 63, xb = pass ? 127 - x : x;
        const int b = bg >> 2, g = bg & 3, t0 = xb * 32, head = g * 8 + wid, tq = t0 + r32;
        const bf16_t* qrow = projc + (size_t)(b * SEQ + tq) * C_NP + C_Q + head * 128;
        bf16x8 qr[8];
#pragma unroll
        for (int d0 = 0; d0 < 8; ++d0) qr[d0] = *(const bf16x8*)(qrow + d0 * 16 + hi * 8);
        fa::FUnit u; u.KRb = nullptr; u.ldk = C_NP; u.ldv = C_NP; u.qlo = t0; u.qhi = t0 + 31; u.qpos = tq; u.sel = 0ull;
        f32x16 o[4]; float m_reg, l_reg; float rf[16];
        { u.Kb = projc + (size_t)(b * SEQ) * C_NP + C_KW + g * 128; u.Vb = projc + (size_t)(b * SEQ) * C_NP + C_VW + g * 128;
          const int lowk = t0 - 511; u.j_lo = lowk > 0 ? lowk / 64 : 0; u.j_hi = (t0 + 31) / 64 + 1; }
        fa::flash_core<1, 0>(lds, u, qr, scale, o, m_reg, l_reg);
        fa::row_factors(lds, wid, r32, hi, nsa_gate(a, b * SEQ + tq, 2, head) / l_reg, rf);
#pragma unroll
        for (int d0 = 0; d0 < 4; ++d0)
#pragma unroll
            for (int r = 0; r < 16; r += 2) park[(d0 * 8 + (r >> 1)) * 64] = cvt_pk_bf16(o[d0][r] * rf[r], o[d0][r + 1] * rf[r + 1]);
        __syncthreads();
        u.Kb = projc + (size_t)(b * SEQ) * C_NP + C_KS + g * 128; u.Vb = projc + (size_t)(b * SEQ) * C_NP + C_VS + g * 128;
        u.j_lo = 0; u.j_hi = (t0 + 31) / 64 + 1; u.sel = selp[(size_t)bg * SEQ + tq];
        fa::flash_core<2, 0>(lds, u, qr, scale, o, m_reg, l_reg);
        fa::row_factors(lds, wid, r32, hi, nsa_gate(a, b * SEQ + tq, 1, head) / l_reg, rf);
        const size_t off0 = (size_t)(b * SEQ + t0 + 4 * hi) * DM + head * 128 + r32;
        float av[16][4];
#pragma unroll
        for (int r = 0; r < 16; ++r)
#pragma unroll
            for (int d0 = 0; d0 < 4; ++d0) av[r][d0] = acc[off0 + (size_t)((r & 3) + 8 * (r >> 2)) * DM + d0 * 32];
        asm volatile("" ::: "memory");
#pragma unroll
        for (int r = 0; r < 16; r += 2) {
#pragma unroll
            for (int d0 = 0; d0 < 4; ++d0) { const unsigned pw = park[(d0 * 8 + (r >> 1)) * 64];
#pragma unroll
                for (int e = 0; e < 2; ++e) { const int rr = r + e; const size_t off = off0 + (size_t)((rr & 3) + 8 * (rr >> 2)) * DM;
                    const float v = av[rr][d0] + __uint_as_float(e ? (pw & 0xffff0000u) : (pw << 16)) + o[d0][rr] * rf[rr];
                    const float vn = dpp_xor1(v); if ((r32 & 1) == 0) *(unsigned*)(hcat + off + d0 * 32) = cvt_pk_bf16(v, vn); } } }
        __syncthreads();
    }
}


#ifndef DEBUG_CMP
#define DEBUG_CMP -1
#endif
#if DEBUG_CMP >= 0
__device__ __forceinline__ void dbg_copy(const Args& a) {
    const bf16_t* hcat = (const bf16_t*)(a.ws + WS_XB); bf16_t* dbg = (bf16_t*)(a.ws + WS_Z);
    const size_t gt = (size_t)blockIdx.x * NTHREADS + threadIdx.x, gs = (size_t)gridDim.x * NTHREADS;
    for (size_t i = gt; i < (size_t)M_TOK * 256; i += gs) { const size_t row = i >> 8, c8 = i & 255; *(bf16x8*)(dbg + row * 2048 + c8 * 8) = *(const bf16x8*)(hcat + row * DM + c8 * 8); }
}
__device__ __forceinline__ void dbg_compare(const Args& a) {
    const bf16_t* hcat = (const bf16_t*)(a.ws + WS_XB); const bf16_t* dbg = (const bf16_t*)(a.ws + WS_Z);
    float* accum = (float*)(a.ws + WS_CTL + 32 * 1024);
    const size_t gt = (size_t)blockIdx.x * NTHREADS + threadIdx.x, gs = (size_t)gridDim.x * NTHREADS;
    float sd = 0.f, sr = 0.f;
    for (size_t i = gt; i < (size_t)M_TOK * 256; i += gs) { const size_t row = i >> 8, c8 = i & 255; const int t = (int)(row & (SEQ - 1));
        bool in = false;
        if (DEBUG_CMP == 0) in = t < 32; if (DEBUG_CMP == 1) in = t >= 32 && t < 64; if (DEBUG_CMP == 2) in = t >= 64 && t < 128; if (DEBUG_CMP == 3) in = true;
        if (DEBUG_CMP == 4) in = (t & 63) < 32; if (DEBUG_CMP == 5) in = (t & 63) >= 32;
        if (!in) continue;
        float x[8], y[8]; unpack8(*(const bf16x8*)(hcat + row * DM + c8 * 8), x); unpack8(*(const bf16x8*)(dbg + row * 2048 + c8 * 8), y);
#pragma unroll
        for (int j = 0; j < 8; ++j) { const float d = x[j] - y[j]; sd += d * d; sr += x[j] * x[j]; } }
    sd = wave_sum(sd); sr = wave_sum(sr);
    if ((threadIdx.x & 63) == 0) { atomicAdd((unsigned long long*)accum, (unsigned long long)(sd * 1048576.0f)); atomicAdd((unsigned long long*)accum + 1, (unsigned long long)(sr * 1048576.0f)); }
}
#endif

constexpr int N_PHASES = 23;
__global__ void __launch_bounds__(NTHREADS, 2) fwd(Args args) {
    extern __shared__ __attribute__((aligned(16))) unsigned char shm[];
    char* lds = (char*)shm;
    PG8_LAS unsigned char* ldsg = (PG8_LAS unsigned char*)shm;
    unsigned char* ws = args.ws;
    if (threadIdx.x < 64) ((volatile LAS unsigned*)(ldsg + LDS_CTL_OFF))[threadIdx.x] = 0u;
    __syncthreads();
    XcdBarrier bar = xcd_barrier_post((unsigned*)(ws + WS_CTL), (volatile LAS unsigned*)(ldsg + LDS_CTL_OFF));
    const int lo = args.ph_lo, hi = args.ph_hi, G = gridDim.x, bx = blockIdx.x;
#define IN(k) (lo <= (k) && (k) < hi)
#define SEAM(k) do { if (IN(k) && IN((k) + 1)) xcd_barrier(bar); } while (0)
#define GEMMC(EPI, cidx, Aoff, Boff, Mr, Nr, Kr, ...) do { pg8::Gemm g_{(const pg8::bf16_t*)(ws + (Aoff)), (const pg8::bf16_t*)(ws + (Boff)), (Mr), (Nr), (Kr)}; pg8::StaticOrder S_; S_.init((Mr), (Nr), G, (cidx)); S_.WGM = GEMM_WGM; \
        EPI E_{__VA_ARGS__}; pg8::gemm_phase<EPI, pg8::StaticOrder, true, true>(ldsg, g_, S_, E_); } while (0)
#define GEMM(EPI, ...) GEMMC(EPI, bx, __VA_ARGS__)
#define GEMMA(EPI, Aptr, Boff, Mr, Nr, Kr, ...) do { pg8::Gemm g_{(const pg8::bf16_t*)(Aptr), (const pg8::bf16_t*)(ws + (Boff)), (Mr), (Nr), (Kr)}; pg8::StaticOrder S_; S_.init((Mr), (Nr), G, bx); S_.WGM = GEMM_WGM; \
        EPI E_{__VA_ARGS__}; pg8::gemm_phase<EPI, pg8::StaticOrder, true, true>(ldsg, g_, S_, E_); } while (0)
#define GEMM_WGM gemm_wgm
    float* xres = args.out;
    bf16_t* xb = (bf16_t*)(ws + WS_XB); const bf16_t* hcat = (const bf16_t*)args.out; f32x2* stats = (f32x2*)(ws + WS_STATS);
    bf16_t* zA = (bf16_t*)(ws + WS_Z); bf16_t* zB = (bf16_t*)args.out + (size_t)M_TOK * DM; bf16_t* zC = zA; bf16_t* zD = zA + (size_t)M_TOK * DM;

#ifndef FFN_CHUNKED
#define FFN_CHUNKED 0
#endif
#ifndef WGM_IN
#define WGM_IN 8
#endif
#ifndef WGM_WO
#define WGM_WO 4
#endif
#ifndef WGM_UP
#define WGM_UP 8
#endif
#ifndef WGM_DOWN
#define WGM_DOWN 2
#endif
    int gemm_wgm = 8;
#ifndef PROBE_MASK
#define PROBE_MASK 0u
#endif
#define PB(k) (((PROBE_MASK) >> (k)) & 1u)
#define PH(k, ...) do { if (IN(k)) { __VA_ARGS__; if (PB(k)) { xcd_barrier(bar); __VA_ARGS__; } } SEAM(k); } while (0)
    PH(0, p0_prologue(lds, args));
    gemm_wgm = WGM_IN; PH(1, GEMM(pg8::EpiProj, WS_XB, W_AB, M_TOK, AB_NP, DM, (bf16_t*)(ws + WS_R), AB_NP, (float*)(ws + WS_GATES), AB_IG / 256); if (bx >= 192 && G == 256) transpose_late(lds, args, bx - 192));
    PH(2, p2_prep(args));
    gemm_wgm = 8; if (IN(3)) { GEMM(pg8::EpiB<0>, WS_CQN, W_UQ, M_TOK, 3072, 1024, (bf16_t*)(ws + WS_QB), 3072); GEMM(pg8::EpiB<0>, WS_CKVN, W_UKV, M_TOK, 4096, 512, (bf16_t*)(ws + WS_KVB), 4096); }
    if (!(IN(3) && IN(4))) SEAM(3);
#if DEBUG_CMP >= 0
#if MC_VALU_STATE == 4
    PH(4, p4_mlstm_chunk(lds, args); xcd_barrier(bar); p4_mlstm(lds, args));
#else
    PH(4, p4_mlstm_chunk(lds, args); xcd_barrier(bar); dbg_copy(args); xcd_barrier(bar); p4_mlstm(lds, args); xcd_barrier(bar); dbg_compare(args));
#endif
#elif MLSTM_BOTH
    PH(4, p4_mlstm_chunk(lds, args); xcd_barrier(bar); p4_mlstm(lds, args));
#elif MLSTM_CHUNK
    PH(4, p4_mlstm_chunk(lds, args));
#else
    PH(4, p4_mlstm(lds, args));
#endif
    if (IN(5)) { p5_mlstm_norm(args); p5_mla(lds, args); if (PB(5)) { xcd_barrier(bar); p5_mla(lds, args); } } SEAM(5);
    gemm_wgm = WGM_WO; PH(6, GEMMA(pg8::EpiResidB, hcat, W_O0, M_TOK, DM, DM, zA, xb));
    PH(7, p7_layernorm_b(args, 0, true, zA, nullptr, xb, stats));
#if FFN_CHUNKED
#define FFN_UP(WGU, half) GEMM(pg8::EpiSwiGLU, WS_XB + (size_t)(half) * 8192 * DM * 2, WGU, 8192, GU_N, DM, (bf16_t*)(ws + WS_R) + (size_t)(half) * 8192 * FFH, FFH)
#define FFN_DOWN(WD, half, Cp, Zpp, lg, lb) GEMM(pg8::EpiResidLN, WS_R + (size_t)(half) * 8192 * FFH * 2, WD, 8192, DM, FFH, (Cp) + (size_t)(half) * 8192 * DM, (Zpp) + (size_t)(half) * 8192 * DM, stats + (half) * 8192, lg, lb, DM, DN_ALPHA)
    if (IN(8)) { gemm_wgm = WGM_UP; FFN_UP(W_GU0, 0); if (bx >= 192 && G == 256) transpose_late(lds, args, 64 + bx - 192); } SEAM(8);
    if (IN(9)) { gemm_wgm = WGM_DOWN; FFN_DOWN(W_D0, 0, xres, z, args.in[22], args.in[23]); gemm_wgm = WGM_UP; FFN_UP(W_GU0, 1); if (bx >= 192 && G == 256) transpose_late(lds, args, 128 + bx - 192);
                 xcd_barrier(bar); gemm_wgm = WGM_DOWN; FFN_DOWN(W_D0, 1, xres, z, args.in[22], args.in[23]); } SEAM(9);
#else
    gemm_wgm = WGM_UP; PH(8, GEMM(pg8::EpiSwiGLU, WS_XB, W_GU0, M_TOK, GU_N, DM, (bf16_t*)(ws + WS_R), FFH); if (bx >= 128 && G == 256) transpose_late(lds, args, 64 + bx - 128));
    gemm_wgm = WGM_DOWN; PH(9, GEMM(pg8::EpiResidLNB, WS_R, W_D0, M_TOK, DM, FFH, zB, zA, stats, args.in[22], args.in[23]));
#endif
    PH(10, p7_layernorm_b(args, 0, false, zB, nullptr, xb, stats));
    gemm_wgm = WGM_IN; PH(11, GEMM(pg8::EpiB<0>, WS_XB, W_C, M_TOK, C_NP, DM, (bf16_t*)(ws + WS_R), C_NP); if (bx >= 64 && G == 256) transpose_late(lds, args, 192 + bx - 64));
    PH(12, p12_blocks(args));
    gemm_wgm = 8; PH(13, GEMM(pg8::EpiB<1>, WS_AK, W_C1K, 4096, 256, 4096, (bf16_t*)(ws + WS_HK), 256);
           GEMMC(pg8::EpiB<1>, (bx + G - 16) % G, WS_AV, W_C1V, 4096, 256, 4096, (bf16_t*)(ws + WS_HV), 256);
           if (G == 256) { if (bx >= 32) transpose_late(lds, args, 384 + bx - 32); } else { for (int sl_ = bx; sl_ < LATE_SLOTS; sl_ += G) transpose_late(lds, args, sl_); });
    PH(14, GEMM(pg8::EpiB<0>, WS_HK, W_C2K, 4096, 256, 256, (bf16_t*)(ws + WS_KCMP), 256);
           GEMMC(pg8::EpiB<0>, (bx + G - 16) % G, WS_HV, W_C2V, 4096, 256, 256, (bf16_t*)(ws + WS_VCMP), 256));
    if (IN(15)) { p15_cmp_attn(lds, args); } SEAM(15);
#ifndef NSA_MERGED
#define NSA_MERGED 1
#endif
#if NSA_MERGED
    if (IN(16)) { p1617_nsa_attn(lds, args); } SEAM(16);
#else
    if (IN(16)) { p16_nsa_attn<1>(lds, args); if (PB(16)) { xcd_barrier(bar); p15_cmp_attn(lds, args); xcd_barrier(bar); p16_nsa_attn<1>(lds, args); } } SEAM(16);
#ifndef PROBE_VAR
#define PROBE_VAR 0
#endif
    if (IN(17)) { p16_nsa_attn<2>(lds, args); if (PB(17)) { xcd_barrier(bar); p16_nsa_attn<2, PROBE_VAR>(lds, args); } } SEAM(17);
#endif
    gemm_wgm = WGM_WO; PH(18, GEMMA(pg8::EpiResidLNB, hcat, W_O1, M_TOK, DM, DM, zC, zB, stats, args.in[24], args.in[25]));
    PH(19, p7_layernorm_b(args, 1, true, zC, nullptr, xb, stats));
#if FFN_CHUNKED
    if (IN(20)) { gemm_wgm = WGM_UP; FFN_UP(W_GU1, 0); } SEAM(20);
    if (IN(21)) { gemm_wgm = WGM_DOWN; FFN_DOWN(W_D1, 0, xres, z, args.in[22] + DM, args.in[23] + DM); gemm_wgm = WGM_UP; FFN_UP(W_GU1, 1);
                  xcd_barrier(bar); gemm_wgm = WGM_DOWN; FFN_DOWN(W_D1, 1, xres, z, args.in[22] + DM, args.in[23] + DM); } SEAM(21);
#else
    gemm_wgm = WGM_UP; PH(20, GEMM(pg8::EpiSwiGLU, WS_XB, W_GU1, M_TOK, GU_N, DM, (bf16_t*)(ws + WS_R), FFH));
    gemm_wgm = WGM_DOWN; PH(21, GEMM(pg8::EpiResidLNB, WS_R, W_D1, M_TOK, DM, FFH, zD, zC, stats, args.in[22] + DM, args.in[23] + DM));
#endif
    PH(22, p7_layernorm_b(args, 1, false, zD, xres, nullptr, nullptr));
#if DEBUG_CMP >= 0
    if (IN(22)) { xcd_barrier(bar); if (bx == 0 && threadIdx.x == 0) { const unsigned long long* accum = (const unsigned long long*)(ws + WS_CTL + 32 * 1024); const float rel = sqrtf((float)((double)accum[0] / fmax((double)accum[1], 1.0)));
        float k = -20.0f * log10f(fmaxf(rel, 1e-6f)); k = fminf(fmaxf(rintf(k), 0.f), 89.f); xres[0] = 1000.0f + 100.0f * k; } }
#endif
#undef PH
#undef PB
#undef IN
#undef SEAM
#undef GEMM
#undef GEMMC
}

#ifndef MK_N_LAUNCHES
#define MK_N_LAUNCHES 1
#endif
extern "C" void kernel_launch(void* const* d_in, const int* in_sizes, int n_in, void* d_out, int out_size, void* d_ws, size_t ws_size, hipStream_t stream) {
    static int grid = 0;
    if (grid == 0) {
        if (n_in != 26 || in_sizes[0] != M_TOK * DM || out_size != M_TOK * DM || ws_size < WS_END) {
            fprintf(stderr, "kernel_launch: unexpected shapes (n_in %d, in0 %d, out %d, ws %zu, need %zu); nothing launched\n", n_in, n_in > 0 ? in_sizes[0] : -1, out_size, ws_size, (size_t)WS_END); grid = -1; return; }
        int dev = 0, cus = 0, per_cu = 0;
        if (hipGetDevice(&dev) != hipSuccess || hipDeviceGetAttribute(&cus, hipDeviceAttributeMultiprocessorCount, dev) != hipSuccess) { grid = -1; return; }
        if (hipFuncSetAttribute((const void*)fwd, hipFuncAttributeMaxDynamicSharedMemorySize, LDS_BYTES) != hipSuccess) { fprintf(stderr, "kernel_launch: hipFuncSetAttribute failed\n"); grid = -1; return; }
        if (hipOccupancyMaxActiveBlocksPerMultiprocessor(&per_cu, (const void*)fwd, NTHREADS, LDS_BYTES) != hipSuccess || per_cu < 1) { fprintf(stderr, "kernel_launch: occupancy query says %d blocks per CU\n", per_cu); (void)hipGetLastError(); grid = -1; return; }
        grid = cus;
    }
    if (grid < 0) return;
    (void)hipMemsetAsync((char*)d_ws + WS_CTL, 0, 64 * 1024, stream);
    Args a{};
    for (int i = 0; i < 26; ++i) a.in[i] = (const float*)d_in[i];
    a.out = (float*)d_out; a.ws = (unsigned char*)d_ws;
    unsigned char* ws = (unsigned char*)d_ws;
    const float* fg = a.in[19]; const float* fu = a.in[20]; const float* fd = a.in[21];
    const size_t LW = (size_t)DM * FFH;
    int j = 0;
    a.tj[j++] = TJob{a.in[1], nullptr, (bf16_t*)(ws + W_AB), DM, AB_IN, AB_NP, 0};
    a.tj[j++] = TJob{a.in[7], nullptr, (bf16_t*)(ws + W_UQ), 1024, 3072, 3072, 0};
    a.tj[j++] = TJob{a.in[8], nullptr, (bf16_t*)(ws + W_UKV), 512, 4096, 4096, 0};
    a.tj[j++] = TJob{a.in[9], nullptr, (bf16_t*)(ws + W_O0), DM, DM, DM, 0};
    a.tj[j++] = TJob{fg, fu, (bf16_t*)(ws + W_GU0), DM, FFH, GU_N, 1};
    a.tj[j++] = TJob{fd, nullptr, (bf16_t*)(ws + W_D0), FFH, DM, DM, 0};
    a.tj[j++] = TJob{a.in[10], nullptr, (bf16_t*)(ws + W_C), DM, C_IN, C_NP, 0};
    a.tj[j++] = TJob{a.in[14], nullptr, (bf16_t*)(ws + W_C1K), 4096, 256, 256, 0};
    a.tj[j++] = TJob{a.in[16], nullptr, (bf16_t*)(ws + W_C1V), 4096, 256, 256, 0};
    a.tj[j++] = TJob{a.in[15], nullptr, (bf16_t*)(ws + W_C2K), 256, 128, 256, 0};
    a.tj[j++] = TJob{a.in[17], nullptr, (bf16_t*)(ws + W_C2V), 256, 128, 256, 0};
    a.tj[j++] = TJob{a.in[18], nullptr, (bf16_t*)(ws + W_O1), DM, DM, DM, 0};
    a.tj[j++] = TJob{fg + LW, fu + LW, (bf16_t*)(ws + W_GU1), DM, FFH, GU_N, 1};
    a.tj[j++] = TJob{fd + LW, nullptr, (bf16_t*)(ws + W_D1), FFH, DM, DM, 0};
#if MK_N_LAUNCHES == 1
    a.ph_lo = 0; a.ph_hi = N_PHASES;
    hipLaunchKernelGGL(fwd, dim3(grid), dim3(NTHREADS), LDS_BYTES, stream, a);
#else
    for (int p = 0; p < N_PHASES; ++p) { a.ph_lo = p; a.ph_hi = p + 1; hipLaunchKernelGGL(fwd, dim3(grid), dim3(NTHREADS), LDS_BYTES, stream, a); }
#endif
    const hipError_t le = hipPeekAtLastError();
    if (le != hipSuccess) fprintf(stderr, "kernel_launch: launch failed: %s\n", hipGetErrorName(le));
}
```

```cpp
#include <hip/hip_runtime.h>
#include <stdint.h>
#include <stdio.h>
#ifndef FLASH2
#define FLASH2 0
#endif
#ifndef DEBUG_CMP
#define DEBUG_CMP -1
#endif
#ifndef MLSTM_BOTH
#define MLSTM_BOTH 0
#endif
#ifndef MLSTM_CHUNK
#define MLSTM_CHUNK 1
#endif

typedef unsigned short bf16_t;
typedef short bf16x8 __attribute__((ext_vector_type(8)));
typedef short s16x4 __attribute__((ext_vector_type(4)));
typedef float f32x2 __attribute__((ext_vector_type(2)));
typedef float f32x4 __attribute__((ext_vector_type(4)));
typedef float f32x16 __attribute__((ext_vector_type(16)));
typedef unsigned u32x2 __attribute__((ext_vector_type(2)));
typedef unsigned u32x4 __attribute__((ext_vector_type(4)));

constexpr int M_TOK = 16384, SEQ = 4096, NBATCH = 4, DM = 4096;
constexpr int AB_IN = 7752, AB_NP = 7936, C_IN = 7264, C_NP = 7424, FFH = 11008, GU_N = 22016;
constexpr float DN_ALPHA = 1.4142135623730951f;
constexpr float LN_EPS = 1e-5f, RMS_EPS = 1e-6f;
constexpr int AB_Q = 0, AB_K = 1024, AB_V = 2048, AB_IG = 4096, AB_FG = 4100, AB_OG = 4104, AB_CQ = 6152, AB_CKV = 7176, AB_KR = 7688;
constexpr int C_Q = 0, C_KC = 4096, C_VC = 4608, C_KS = 5120, C_VS = 5632, C_KW = 6144, C_VW = 6656, C_GATE = 7168;

__device__ __forceinline__ float bf2f(bf16_t b) { return __uint_as_float(((unsigned)b) << 16); }
__device__ __forceinline__ unsigned cvt_pk_bf16(float lo, float hi) { unsigned r; asm volatile("v_cvt_pk_bf16_f32 %0, %1, %2" : "=v"(r) : "v"(lo), "v"(hi)); return r; }
__device__ __forceinline__ bf16_t f2bf(float f) { return (bf16_t)(cvt_pk_bf16(f, 0.f) & 0xffffu); }
__device__ __forceinline__ void unpack8(const bf16x8 v, float (&f)[8]) {
#pragma unroll
    for (int j = 0; j < 8; ++j) f[j] = bf2f((bf16_t)v[j]);
}
__device__ __forceinline__ bf16x8 pack8f(const float (&f)[8]) {
    u32x4 w = {cvt_pk_bf16(f[0], f[1]), cvt_pk_bf16(f[2], f[3]), cvt_pk_bf16(f[4], f[5]), cvt_pk_bf16(f[6], f[7])};
    return *reinterpret_cast<bf16x8*>(&w);
}
typedef _Float16 f16x2_t __attribute__((ext_vector_type(2)));
__device__ __forceinline__ unsigned cvt_pk_f16(float lo, float hi) { const f16x2_t h = {(_Float16)lo, (_Float16)hi}; return __builtin_bit_cast(unsigned, h); }
__device__ __forceinline__ void unpack8h(const bf16x8 v, float (&f)[8]) {
#pragma unroll
    for (int j = 0; j < 8; ++j) f[j] = (float)__builtin_bit_cast(_Float16, (short)v[j]);
}
__device__ __forceinline__ bf16x8 pack8h(const float (&f)[8]) {
    u32x4 w = {cvt_pk_f16(f[0], f[1]), cvt_pk_f16(f[2], f[3]), cvt_pk_f16(f[4], f[5]), cvt_pk_f16(f[6], f[7])};
    return *reinterpret_cast<bf16x8*>(&w);
}
__device__ __forceinline__ float wave_sum(float v) {
#pragma unroll
    for (int o = 32; o >= 1; o >>= 1) v += __shfl_xor(v, o);
    return v;
}
__device__ __forceinline__ float sigmoid_f(float x) { return __builtin_amdgcn_rcpf(1.0f + __expf(-x)); }

#define XB_TMO      128
#define XB_XCNT(j)  (256  + 64 * (j))
#define XB_XSUB(j)  (1280 + 64 * (j))
#define XB_XGEN(j)  (2304 + 64 * (j))
#define XB_TOP      3328
#define XB_TOPGEN   3392
#define XCD_BAR_WORDS 3456
#define XB_SPIN_CAP (1u << 22)
#define LAS __attribute__((address_space(3)))

__device__ __forceinline__ unsigned xb_ld(unsigned* p)              { return __hip_atomic_load(p, __ATOMIC_RELAXED, __HIP_MEMORY_SCOPE_AGENT); }
__device__ __forceinline__ unsigned xb_add(unsigned* p, unsigned v) { return __hip_atomic_fetch_add(p, v, __ATOMIC_RELAXED, __HIP_MEMORY_SCOPE_AGENT); }
__device__ __forceinline__ unsigned xb_xcc_id() { return (unsigned)__builtin_amdgcn_s_getreg((3 << 11) | 20) & 0xFu; }
#define XB_SPIN(cond, bar) do { unsigned _sp = 0; while (cond) { __builtin_amdgcn_s_sleep(1); \
    if ((++_sp & 255u) == 0u) { if (xb_ld(&(bar)[XB_TMO])) break; if (_sp > XB_SPIN_CAP) { atomicAdd(&(bar)[XB_TMO], 1u); break; } } } } while (0)

struct XcdBarrier {
    unsigned* bar; unsigned x;
    volatile LAS unsigned* st;
};

__device__ __forceinline__ XcdBarrier xcd_barrier_post(unsigned* bar, volatile LAS unsigned* st) {
    XcdBarrier b; b.bar = bar; b.x = xb_xcc_id(); b.st = st;
    if (threadIdx.x == 0) (void)xb_add(&bar[XB_XCNT(b.x)], 1u);
    return b;
}
__device__ __forceinline__ void xcd_barrier_complete(unsigned* bar, unsigned x, unsigned& nloc, unsigned& nx) {
    const unsigned G = gridDim.x * gridDim.y * gridDim.z;
    unsigned sum, cnt, mine, sp = 0u;
    for (;;) {
        sum = 0u; cnt = 0u; mine = 0u;
#pragma unroll
        for (unsigned j = 0; j < 16; ++j) { const unsigned c = xb_ld(&bar[XB_XCNT(j)]); sum += c; cnt += (c > 0u) ? 1u : 0u; mine = (j == x) ? c : mine; }
        if (sum == G) break;
        __builtin_amdgcn_s_sleep(1);
        if ((++sp & 255u) == 0u) { if (xb_ld(&bar[XB_TMO])) break; if (sp > XB_SPIN_CAP) { atomicAdd(&bar[XB_TMO], 1u); break; } }
    }
    nloc = mine > 0u ? mine : 1u; nx = cnt > 0u ? cnt : 1u;
}

__device__ __forceinline__ void xcd_barrier(const XcdBarrier& b) {
    asm volatile("s_waitcnt vmcnt(0)" ::: "memory");
    __syncthreads();
    if (threadIdx.x == 0) {
        unsigned* bar = b.bar;
        __builtin_amdgcn_s_waitcnt(0);
        unsigned nloc = b.st[0], nx = b.st[1];
        if (nloc == 0u) { xcd_barrier_complete(bar, b.x, nloc, nx); b.st[0] = nloc; b.st[1] = nx; }
        const unsigned old = xb_add(&bar[XB_XSUB(b.x)], 1u);
        const unsigned gen = old / nloc;
        if (old + 1u == (gen + 1u) * nloc) {
            __builtin_amdgcn_fence(__ATOMIC_RELEASE, "agent");
            asm volatile("s_waitcnt vmcnt(0)" ::: "memory");
            const unsigned og = xb_add(&bar[XB_TOP], 1u);
            const unsigned tg = og / nx;
            if (og + 1u == (tg + 1u) * nx) xb_add(&bar[XB_TOPGEN], 1u);
            else XB_SPIN(xb_ld(&bar[XB_TOPGEN]) == tg, bar);
            __builtin_amdgcn_fence(__ATOMIC_ACQUIRE, "agent");
            xb_add(&bar[XB_XGEN(b.x)], 1u);
            asm volatile("s_waitcnt vmcnt(0)" ::: "memory");
        } else {
            XB_SPIN(xb_ld(&bar[XB_XGEN(b.x)]) == gen, bar);
            __builtin_amdgcn_fence(__ATOMIC_ACQUIRE, "agent");
            asm volatile("s_waitcnt vmcnt(0)" ::: "memory");
        }
    }
    __syncthreads();
}namespace pg8 {
#define PG8_LAS __attribute__((address_space(3)))
typedef unsigned short bf16_t;
typedef short bf16x8 __attribute__((ext_vector_type(8)));
typedef float f32x4 __attribute__((ext_vector_type(4)));
typedef unsigned u32x4 __attribute__((ext_vector_type(4)));
constexpr int BM = 256, BK = 64, HALF = 128, HTB = HALF * BK * 2  , STAGE_BYTES = 8 * HTB, NXCD = 8;

__host__ __device__ __forceinline__ int lds_byte(int r, int c) { const int st = (r >> 4) * 2 + (c >> 5), rr = r & 15, cc = c & 31, ob = rr * 64 + cc * 2; return st * 1024 + (ob ^ (((ob >> 9) & 1) << 5)); }
__host__ __device__ __forceinline__ void stage_rc(int b, int& R, int& C) { const int st = b / 1024, sb = b % 1024, swz = sb ^ (((sb >> 9) & 1) << 5); R = (st >> 1) * 16 + swz / 64; C = (st & 1) * 32 + (swz % 64) / 2; }
__host__ __device__ __forceinline__ int perm32(int rho) { const int n = rho >> 4, i = rho & 15; return 8 * (i >> 2) + 4 * n + (i & 3); }

struct Unit { int pm, pn; };
struct Gemm { const bf16_t* A; const bf16_t* Bt; int M, N, K; };

struct StaticOrder {
    int nM, nN, nwg, G, c, WGM = 8;
    __host__ __device__ void init(int M, int N, int G_, int c_) { nM = M / BM; nN = N / BM; nwg = nM * nN; G = G_; c = c_; }
    __host__ __device__ bool next(int i, Unit& u) const {
        const long L = (long)i * G + c; if (L >= nwg) return false;
        int wgid = (int)L; { const int q = nwg / NXCD, r = nwg % NXCD, xcd = wgid % NXCD, off = wgid / NXCD; wgid = (xcd < r ? xcd * (q + 1) : r * (q + 1) + (xcd - r) * q) + off; }
        const int nig = WGM * nN, gid = wgid / nig, fm = gid * WGM, gsz = (nM - fm) < WGM ? (nM - fm) : WGM;
        u.pm = fm + ((wgid % nig) % gsz); u.pn = (wgid % nig) / gsz; return true;
    }
    __device__ __forceinline__ void a_ready(const Unit&) const {}
    __device__ __forceinline__ void done(const Unit&) const {}
};
struct CountedOrder : StaticOrder {
    const unsigned* ready; unsigned need; unsigned* tmo;
    __device__ __forceinline__ void a_ready(const Unit& u) const {
        if (threadIdx.x < 64) {
            const unsigned long long t0 = __builtin_amdgcn_s_memrealtime(); unsigned polls = 0;
            while ((unsigned)__builtin_amdgcn_readfirstlane(__hip_atomic_load(ready + 64 * u.pm, __ATOMIC_RELAXED, __HIP_MEMORY_SCOPE_AGENT)) < need) {
                if ((++polls & 255u) == 0u && __builtin_amdgcn_readfirstlane(__hip_atomic_load(tmo, __ATOMIC_RELAXED, __HIP_MEMORY_SCOPE_AGENT)) != 0u) break;
                if (__builtin_amdgcn_s_memrealtime() - t0 > 2000000ull) {
                    if (threadIdx.x == 0) { unsigned expect = 0u; __hip_atomic_compare_exchange_strong(tmo + 1, &expect, 0x600u | (unsigned)(u.pm & 0xff), __ATOMIC_RELAXED, __ATOMIC_RELAXED, __HIP_MEMORY_SCOPE_AGENT); __hip_atomic_store(tmo, 1u, __ATOMIC_RELAXED, __HIP_MEMORY_SCOPE_AGENT); }
                    break; }
                __builtin_amdgcn_s_sleep(2); }
            __builtin_amdgcn_fence(__ATOMIC_ACQUIRE, "agent");
            asm volatile("s_waitcnt vmcnt(0)" ::: "memory");
        }
#if !defined(BROKEN_HOOK_NO_BARRIER)
        asm volatile("" ::: "memory"); __builtin_amdgcn_s_barrier(); asm volatile("" ::: "memory");
#endif
    }
};

__device__ __forceinline__ unsigned cvt_pk_bf16(float lo, float hi) { unsigned r; asm volatile("v_cvt_pk_bf16_f32 %0, %1, %2" : "=v"(r) : "v"(lo), "v"(hi)); return r; }
typedef float f32x2 __attribute__((ext_vector_type(2)));
__device__ __forceinline__ f32x2 gelu_pk(f32x2 v) {
    const f32x2 av = __builtin_elementwise_abs(v), d = av * 0.2316418882f + 1.0f;
    f32x2 t; t.x = __builtin_amdgcn_rcpf(d.x); t.y = __builtin_amdgcn_rcpf(d.y);
    f32x2 q = t * 0.5307027145f + (-0.7265760135f); q = q * t + 0.7107068705f; q = q * t + (-0.142248368f); q = q * t + 0.127414796f; q = q * t;
    const f32x2 s = (v * v) * (-0.72134752044f);
    f32x2 e; e.x = __builtin_amdgcn_exp2f(s.x); e.y = __builtin_amdgcn_exp2f(s.y);
    const f32x2 m = v * (q * e), r = v - m;
    f32x2 o; o.x = v.x < 0.f ? m.x : r.x; o.y = v.y < 0.f ? m.y : r.y; return o;
}

struct EpiF32 {
    static constexpr bool PERM = false, AFTER_DRAIN = false, PREFETCH = false;
    float* C; int ldc; const float* bias;
    __device__ __forceinline__ void operator()(const f32x4 (&acc)[2][2][4][2], const Unit& u, int wr, int wc, int fr, int fq) const {
        const int row0 = u.pm * BM + wr * 64 + fr, col0 = u.pn * BM + wc * 32 + 4 * fq;
        f32x4 bv[2][2];
#pragma unroll
        for (int bj = 0; bj < 2; ++bj)
#pragma unroll
            for (int n = 0; n < 2; ++n) bv[bj][n] = bias ? *(const f32x4*)(bias + col0 + bj * HALF + n * 16) : (f32x4){0.f, 0.f, 0.f, 0.f};
#pragma unroll
        for (int ai = 0; ai < 2; ++ai)
#pragma unroll
            for (int m = 0; m < 4; ++m) { float* rowp = C + (size_t)(row0 + ai * HALF + m * 16) * ldc + col0;
#pragma unroll
                for (int bj = 0; bj < 2; ++bj)
#pragma unroll
                    for (int n = 0; n < 2; ++n) *(f32x4*)(rowp + bj * HALF + n * 16) = acc[ai][bj][m][n] + bv[bj][n]; }
    }
};
template <int ACT  > struct EpiBf16 {
    static constexpr bool PERM = true, AFTER_DRAIN = false, PREFETCH = false;
    bf16_t* O; int ldc; const float* bias; int split_cols; size_t split_stride;
    __device__ __forceinline__ void operator()(const f32x4 (&acc)[2][2][4][2], const Unit& u, int wr, int wc, int fr, int fq) const {
        const int row0 = u.pm * BM + wr * 64 + fr; int colt = u.pn * BM; bf16_t* base = O;
        if (split_cols) { const int t = colt / split_cols; base += (size_t)t * split_stride; colt -= t * split_cols; }
        const int col0 = colt + wc * 32 + 8 * fq, bcol0 = u.pn * BM + wc * 32 + 8 * fq;
        f32x4 bv[2][2];
#pragma unroll
        for (int bj = 0; bj < 2; ++bj)
#pragma unroll
            for (int n = 0; n < 2; ++n) bv[bj][n] = bias ? *(const f32x4*)(bias + bcol0 + bj * HALF + 4 * n) : (f32x4){0.f, 0.f, 0.f, 0.f};
#pragma unroll
        for (int ai = 0; ai < 2; ++ai)
#pragma unroll
            for (int m = 0; m < 4; ++m) { bf16_t* rowp = base + (size_t)(row0 + ai * HALF + m * 16) * ldc + col0;
#pragma unroll
                for (int bj = 0; bj < 2; ++bj) { f32x4 v0 = acc[ai][bj][m][0] + bv[bj][0], v1 = acc[ai][bj][m][1] + bv[bj][1];
                    if (ACT == 1) { f32x2 a = gelu_pk((f32x2){v0[0], v0[1]}), b = gelu_pk((f32x2){v0[2], v0[3]}), c = gelu_pk((f32x2){v1[0], v1[1]}), d = gelu_pk((f32x2){v1[2], v1[3]});
                        v0 = (f32x4){a.x, a.y, b.x, b.y}; v1 = (f32x4){c.x, c.y, d.x, d.y}; }
                    if (ACT == 2) {
#pragma unroll
                        for (int j = 0; j < 4; ++j) { v0[j] = 0.5f * v0[j] * (1.0f + erff(v0[j] * 0.70710678f)); v1[j] = 0.5f * v1[j] * (1.0f + erff(v1[j] * 0.70710678f)); } }
                    u32x4 w; w.x = cvt_pk_bf16(v0[0], v0[1]); w.y = cvt_pk_bf16(v0[2], v0[3]); w.z = cvt_pk_bf16(v1[0], v1[1]); w.w = cvt_pk_bf16(v1[2], v1[3]);
                    *(u32x4*)(rowp + bj * HALF) = w; } }
    }
};
#ifndef EPI_PREFETCH
#define EPI_PREFETCH false
#endif
#ifndef EPI_PF_TILES
#define EPI_PF_TILES 16
#endif
__device__ __forceinline__ float silu_f(float g) { return g * __builtin_amdgcn_rcpf(1.0f + __expf(-g)); }
__device__ __forceinline__ float gelu_tanh_f(float x) { const float y = 0.7978845608028654f * (x + 0.044715f * x * x * x); const float e = __expf(2.0f * y); const float t = 1.0f - 2.0f * __builtin_amdgcn_rcpf(e + 1.0f); return 0.5f * x * (1.0f + t); }
template <int ACT> struct EpiB {
    static constexpr bool PERM = true, AFTER_DRAIN = false, PREFETCH = false;
    bf16_t* O; int ldc;
    __device__ __forceinline__ void operator()(const f32x4 (&acc)[2][2][4][2], const Unit& u, int wr, int wc, int fr, int fq) const {
        const int row0 = u.pm * BM + wr * 64 + fr, col0 = u.pn * BM + wc * 32 + 8 * fq;
        float one = 1.0f; asm volatile("" : "+v"(one));
#pragma unroll
        for (int ai = 0; ai < 2; ++ai)
#pragma unroll
            for (int m = 0; m < 4; ++m) { bf16_t* rowp = O + (size_t)(row0 + ai * HALF + m * 16) * ldc + col0;
#pragma unroll
                for (int bj = 0; bj < 2; ++bj) { f32x4 v0 = acc[ai][bj][m][0] * one, v1 = acc[ai][bj][m][1] * one;
                    if (ACT == 1) {
#pragma unroll
                        for (int j = 0; j < 4; ++j) { v0[j] = gelu_tanh_f(v0[j]); v1[j] = gelu_tanh_f(v1[j]); } }
                    u32x4 w; w.x = cvt_pk_bf16(v0[0], v0[1]); w.y = cvt_pk_bf16(v0[2], v0[3]); w.z = cvt_pk_bf16(v1[0], v1[1]); w.w = cvt_pk_bf16(v1[2], v1[3]);
                    *(u32x4*)(rowp + bj * HALF) = w; } }
    }
};
struct EpiProj {
    static constexpr bool PERM = true, AFTER_DRAIN = false, PREFETCH = false;
    bf16_t* O; int ldc; float* gates; int gate_pn;
    __device__ __forceinline__ void operator()(const f32x4 (&acc)[2][2][4][2], const Unit& u, int wr, int wc, int fr, int fq) const {
        const int row0 = u.pm * BM + wr * 64 + fr, col0 = u.pn * BM + wc * 32 + 8 * fq;
        float one = 1.0f; asm volatile("" : "+v"(one));
#pragma unroll
        for (int ai = 0; ai < 2; ++ai)
#pragma unroll
            for (int m = 0; m < 4; ++m) { bf16_t* rowp = O + (size_t)(row0 + ai * HALF + m * 16) * ldc + col0;
#pragma unroll
                for (int bj = 0; bj < 2; ++bj) { const f32x4 v0 = acc[ai][bj][m][0] * one, v1 = acc[ai][bj][m][1] * one;
                    u32x4 w; w.x = cvt_pk_bf16(v0[0], v0[1]); w.y = cvt_pk_bf16(v0[2], v0[3]); w.z = cvt_pk_bf16(v1[0], v1[1]); w.w = cvt_pk_bf16(v1[2], v1[3]);
                    *(u32x4*)(rowp + bj * HALF) = w; } }
        if (u.pn == gate_pn && wc == 0 && fq == 0) {
#pragma unroll
            for (int ai = 0; ai < 2; ++ai)
#pragma unroll
                for (int m = 0; m < 4; ++m) { float* g = gates + (size_t)(row0 + ai * HALF + m * 16) * 8;
                    *(f32x4*)g = acc[ai][0][m][0]; *(f32x4*)(g + 4) = acc[ai][0][m][1]; }
        }
    }
};
struct EpiSwiGLU {
    static constexpr bool PERM = true, AFTER_DRAIN = false, PREFETCH = false;
    bf16_t* H; int ldh;
    __device__ __forceinline__ void operator()(const f32x4 (&acc)[2][2][4][2], const Unit& u, int wr, int wc, int fr, int fq) const {
        const int row0 = u.pm * BM + wr * 64 + fr, col0 = u.pn * HALF + wc * 32 + 8 * fq;
#pragma unroll
        for (int ai = 0; ai < 2; ++ai)
#pragma unroll
            for (int m = 0; m < 4; ++m) { bf16_t* rowp = H + (size_t)(row0 + ai * HALF + m * 16) * ldh + col0;
                const f32x4 g0 = acc[ai][0][m][0], g1 = acc[ai][0][m][1], u0 = acc[ai][1][m][0], u1 = acc[ai][1][m][1];
                float h[8];
#pragma unroll
                for (int j = 0; j < 4; ++j) { h[j] = silu_f(g0[j]) * u0[j]; h[4 + j] = silu_f(g1[j]) * u1[j]; }
                u32x4 w; w.x = cvt_pk_bf16(h[0], h[1]); w.y = cvt_pk_bf16(h[2], h[3]); w.z = cvt_pk_bf16(h[4], h[5]); w.w = cvt_pk_bf16(h[6], h[7]);
                *(u32x4*)rowp = w; }
    }
};
struct EpiResid {
    static constexpr bool PERM = false, AFTER_DRAIN = false, PREFETCH = false;
    float* C; const float* R; int ldc; float alpha;
    __device__ __forceinline__ void operator()(const f32x4 (&acc)[2][2][4][2], const Unit& u, int wr, int wc, int fr, int fq) const {
        const int row0 = u.pm * BM + wr * 64 + fr, col0 = u.pn * BM + wc * 32 + 4 * fq;
#pragma unroll
        for (int ai = 0; ai < 2; ++ai) {
            f32x4 r[4][2][2];
#pragma unroll
            for (int m = 0; m < 4; ++m) { const size_t off = (size_t)(row0 + ai * HALF + m * 16) * ldc + col0;
#pragma unroll
                for (int bj = 0; bj < 2; ++bj)
#pragma unroll
                    for (int n = 0; n < 2; ++n) r[m][bj][n] = *(const f32x4*)(R + off + bj * HALF + n * 16); }
            asm volatile("" ::: "memory");
#pragma unroll
            for (int m = 0; m < 4; ++m) { const size_t off = (size_t)(row0 + ai * HALF + m * 16) * ldc + col0;
#pragma unroll
                for (int bj = 0; bj < 2; ++bj)
#pragma unroll
                    for (int n = 0; n < 2; ++n) *(f32x4*)(C + off + bj * HALF + n * 16) = acc[ai][bj][m][n] + alpha * r[m][bj][n]; }
            asm volatile("" ::: "memory");
        }
    }
};
struct EpiResidLN {
    static constexpr bool PERM = false, AFTER_DRAIN = false, PREFETCH = false;
    float* C; const float* Zp; const f32x2* st; const float* g; const float* b; int ldc; float alpha;
    __device__ __forceinline__ void operator()(const f32x4 (&acc)[2][2][4][2], const Unit& u, int wr, int wc, int fr, int fq) const {
        const int row0 = u.pm * BM + wr * 64 + fr, col0 = u.pn * BM + wc * 32 + 4 * fq;
#pragma unroll
        for (int bj = 0; bj < 2; ++bj)
#pragma unroll
            for (int n = 0; n < 2; ++n) {
                const int cc = col0 + bj * HALF + n * 16;
                const f32x4 gv = *(const f32x4*)(g + cc) * alpha, bv = *(const f32x4*)(b + cc) * alpha;
                f32x4 r[2][4]; f32x2 ms[2][4];
#pragma unroll
                for (int ai = 0; ai < 2; ++ai)
#pragma unroll
                    for (int m = 0; m < 4; ++m) { const int row = row0 + ai * HALF + m * 16; ms[ai][m] = st[row]; r[ai][m] = *(const f32x4*)(Zp + (size_t)row * ldc + cc); }
                asm volatile("" ::: "memory");
#pragma unroll
                for (int ai = 0; ai < 2; ++ai)
#pragma unroll
                    for (int m = 0; m < 4; ++m) { const int row = row0 + ai * HALF + m * 16;
                        *(f32x4*)(C + (size_t)row * ldc + cc) = acc[ai][bj][m][n] + ((r[ai][m] - ms[ai][m].x) * ms[ai][m].y) * gv + bv; }
                asm volatile("" ::: "memory");
            }
    }
};
struct EpiResidB {
    static constexpr bool PERM = true, AFTER_DRAIN = false, PREFETCH = EPI_PREFETCH;
    bf16_t* C; const bf16_t* R;
    __device__ __forceinline__ void prefetch(const Unit& u, PG8_LAS unsigned char* dummy, int wid, int lane) const {
#pragma unroll
        for (int i = 0; i < 2; ++i) { const int L = wid * 128 + i * 64 + lane;
            __builtin_amdgcn_global_load_lds((const unsigned*)((const char*)R + (unsigned)((u.pm * BM + (L >> 2)) * DM + u.pn * BM + (L & 3) * 64) * 2u), (PG8_LAS unsigned*)dummy, 4, 0, 0); }
    }
    __device__ __forceinline__ void operator()(const f32x4 (&acc)[2][2][4][2], const Unit& u, int wr, int wc, int fr, int fq) const {
        const int row0 = u.pm * BM + wr * 64 + fr, col0 = u.pn * BM + wc * 32 + 8 * fq;
#pragma unroll
        for (int ai = 0; ai < 2; ++ai) {
            bf16x8 r[4][2];
#pragma unroll
            for (int m = 0; m < 4; ++m)
#pragma unroll
                for (int bj = 0; bj < 2; ++bj) r[m][bj] = *(const bf16x8*)((const char*)R + (unsigned)((row0 + ai * HALF + m * 16) * DM + col0 + bj * HALF) * 2u);
            asm volatile("" ::: "memory");
#pragma unroll
            for (int m = 0; m < 4; ++m)
#pragma unroll
                for (int bj = 0; bj < 2; ++bj) { float x[8]; unpack8(r[m][bj], x);
                    const f32x4 a0 = acc[ai][bj][m][0], a1 = acc[ai][bj][m][1];
                    float v[8];
#pragma unroll
                    for (int j = 0; j < 4; ++j) { v[j] = a0[j] + DN_ALPHA * x[j]; v[4 + j] = a1[j] + DN_ALPHA * x[4 + j]; }
                    *(bf16x8*)((char*)C + (unsigned)((row0 + ai * HALF + m * 16) * DM + col0 + bj * HALF) * 2u) = pack8h(v); }
            asm volatile("" ::: "memory");
        }
    }
};
struct EpiResidLNB {
    static constexpr bool PERM = true, AFTER_DRAIN = false, PREFETCH = EPI_PREFETCH;
    bf16_t* C; const bf16_t* Zp; const f32x2* st; const float* g; const float* b;
    __device__ __forceinline__ void prefetch(const Unit& u, PG8_LAS unsigned char* dummy, int wid, int lane) const {
#pragma unroll
        for (int i = 0; i < 2; ++i) { const int L = wid * 128 + i * 64 + lane;
            __builtin_amdgcn_global_load_lds((const unsigned*)((const char*)Zp + (unsigned)((u.pm * BM + (L >> 2)) * DM + u.pn * BM + (L & 3) * 64) * 2u), (PG8_LAS unsigned*)dummy, 4, 0, 0); }
    }
    __device__ __forceinline__ void operator()(const f32x4 (&acc)[2][2][4][2], const Unit& u, int wr, int wc, int fr, int fq) const {
        const int row0 = u.pm * BM + wr * 64 + fr, col0 = u.pn * BM + wc * 32 + 8 * fq;
#pragma unroll
        for (int bj = 0; bj < 2; ++bj) {
            const int cc = col0 + bj * HALF;
            const f32x4 g0 = *(const f32x4*)(g + cc) * DN_ALPHA, g1 = *(const f32x4*)(g + cc + 4) * DN_ALPHA, b0 = *(const f32x4*)(b + cc) * DN_ALPHA, b1 = *(const f32x4*)(b + cc + 4) * DN_ALPHA;
            bf16x8 r[2][4]; f32x2 ms[2][4];
#pragma unroll
            for (int ai = 0; ai < 2; ++ai)
#pragma unroll
                for (int m = 0; m < 4; ++m) { const int row = row0 + ai * HALF + m * 16; ms[ai][m] = *(const f32x2*)((const char*)st + (unsigned)row * 8u); r[ai][m] = *(const bf16x8*)((const char*)Zp + (unsigned)(row * DM + cc) * 2u); }
            asm volatile("" ::: "memory");
#pragma unroll
            for (int ai = 0; ai < 2; ++ai)
#pragma unroll
                for (int m = 0; m < 4; ++m) { const int row = row0 + ai * HALF + m * 16; float x[8]; unpack8h(r[ai][m], x);
                    const f32x4 a0 = acc[ai][bj][m][0], a1 = acc[ai][bj][m][1]; const float mu = ms[ai][m].x, rs = ms[ai][m].y;
                    float v[8];
#pragma unroll
                    for (int j = 0; j < 4; ++j) { v[j] = a0[j] + (((x[j] - mu) * rs) * g0[j] + b0[j]); v[4 + j] = a1[j] + (((x[4 + j] - mu) * rs) * g1[j] + b1[j]); }
                    *(bf16x8*)((char*)C + (unsigned)(row * DM + cc) * 2u) = pack8h(v); __builtin_amdgcn_sched_barrier(0); }
            asm volatile("" ::: "memory");
        }
    }
};
template <class Epi, class Sched, bool ALIGN_EPI = false, bool SP2 = false>
__device__ __forceinline__ void gemm_phase(PG8_LAS unsigned char* lds, const Gemm g, const Sched& S, const Epi& E) {
    const int tid = threadIdx.x, wid = __builtin_amdgcn_readfirstlane(tid >> 6), lane = tid & 63, wr = wid >> 2, wc = wid & 3, fr = lane & 15, fq = lane >> 4;
    const int K = g.K, nt = K / BK;
    unsigned voffA[2], voffB[2];
#pragma unroll
    for (int i = 0; i < 2; ++i) { int R, C; stage_rc(tid * 16 + i * 8192, R, C); const int Rb = Epi::PERM ? ((R & ~31) + perm32(R & 31)) : R;
        voffA[i] = (unsigned)(R * K + C) * 2u; voffB[i] = (unsigned)(Rb * K + C) * 2u; }
    const size_t kstep = (size_t)(BK * 2);
    const size_t hstep = (size_t)HALF * K * 2;
    const size_t tstep = 2 * hstep;
    const unsigned ldsw = (unsigned)wid * 1024u;
    const int aoff = lds_byte(wr * 64 + fr, fq * 8), boff = lds_byte(wc * 32 + fr, fq * 8);
#define PG8_SA(b, h) (((b) * 2 + (h)) * HTB)
#define PG8_SB(b, h) ((4 + (b) * 2 + (h)) * HTB)
#define PG8_STAGE(bufoff, gbase, voff) do { _Pragma("unroll") for (int _i = 0; _i < 2; ++_i) \
        __builtin_amdgcn_global_load_lds((const unsigned*)((const char*)(gbase) + (voff)[_i]), (PG8_LAS unsigned*)(lds + (bufoff) + ldsw + _i * 8192), 16, 0, 0); } while (0)
#define PG8_LDA(dst, b, h) do { _Pragma("unroll") for (int m = 0; m < 4; ++m) _Pragma("unroll") for (int k = 0; k < 2; ++k) dst[m][k] = *(const PG8_LAS bf16x8*)(lds + PG8_SA(b, h) + aoff + m * 2048 + k * 1024); } while (0)
#define PG8_LDB(dst, b, h) do { _Pragma("unroll") for (int n = 0; n < 2; ++n) _Pragma("unroll") for (int k = 0; k < 2; ++k) dst[n][k] = *(const PG8_LAS bf16x8*)(lds + PG8_SB(b, h) + boff + n * 2048 + k * 1024); } while (0)
#define PG8_MMA(ai, bj, At, Bt) do { __builtin_amdgcn_s_setprio(1); _Pragma("unroll") for (int m = 0; m < 4; ++m) _Pragma("unroll") for (int n = 0; n < 2; ++n) _Pragma("unroll") for (int k = 0; k < 2; ++k) \
        acc[ai][bj][m][n] = __builtin_amdgcn_mfma_f32_16x16x32_bf16(Bt[n][k], At[m][k], acc[ai][bj][m][n], 0, 0, 0); __builtin_amdgcn_s_setprio(0); } while (0)
#define PG8_WAIT_V(n) asm volatile("s_waitcnt vmcnt(" #n ")" ::: "memory")
#define PG8_WAIT_L(n) asm volatile("s_waitcnt lgkmcnt(" #n ")" ::: "memory")
#define PG8_BAR __builtin_amdgcn_s_barrier()
#define PG8_SCHED __builtin_amdgcn_sched_barrier(0)
    Unit cur, nxt; int ui = 0;
    if (!S.next(0, cur)) return;
    f32x4 acc[2][2][4][2];
#pragma unroll
    for (int a = 0; a < 2; ++a)
#pragma unroll
        for (int b = 0; b < 2; ++b)
#pragma unroll
            for (int m = 0; m < 4; ++m)
#pragma unroll
                for (int n = 0; n < 2; ++n) acc[a][b][m][n] = (f32x4){0.f, 0.f, 0.f, 0.f};
    bf16x8 At[4][2], B0[2][2], B1[2][2];
    const char* cA = (const char*)g.A + (size_t)cur.pm * tstep; const char* cB = (const char*)g.Bt + (size_t)cur.pn * tstep;
    S.a_ready(cur);
    if constexpr (SP2) {
        PG8_STAGE(PG8_SB(0, 0), cB, voffB); PG8_STAGE(PG8_SB(0, 1), cB + hstep, voffB); PG8_STAGE(PG8_SA(0, 0), cA, voffA); PG8_STAGE(PG8_SA(0, 1), cA + hstep, voffA);
        if (wr == 1) PG8_BAR;
        PG8_WAIT_V(2); PG8_BAR;
        PG8_STAGE(PG8_SB(1, 0), cB + kstep, voffB); PG8_STAGE(PG8_SA(1, 0), cA + kstep, voffA); PG8_STAGE(PG8_SB(1, 1), cB + hstep + kstep, voffB);
        PG8_WAIT_V(6); PG8_BAR;
    } else {
        PG8_STAGE(PG8_SB(0, 0), cB, voffB); PG8_STAGE(PG8_SA(0, 0), cA, voffA); PG8_STAGE(PG8_SB(0, 1), cB + hstep, voffB); PG8_STAGE(PG8_SA(0, 1), cA + hstep, voffA);
        if (wr == 1) PG8_BAR;
        PG8_WAIT_V(4); PG8_BAR;
        PG8_STAGE(PG8_SB(1, 0), cB + kstep, voffB); PG8_STAGE(PG8_SA(1, 0), cA + kstep, voffA); PG8_STAGE(PG8_SB(1, 1), cB + hstep + kstep, voffB);
        PG8_WAIT_V(6); PG8_BAR;
    }
    for (;;) {
        const bool has_next = S.next(ui + 1, nxt);
        const char* nA = has_next ? (const char*)g.A + (size_t)nxt.pm * tstep : cA; const char* nB = has_next ? (const char*)g.Bt + (size_t)nxt.pn * tstep : cB;
        for (int t = 0; t < nt; t += 2) {
            const bool last = (t == nt - 2);
            const char* a1 = cA + (size_t)(t + 1) * kstep;
            const char* a2 = last ? nA : cA + (size_t)(t + 2) * kstep; const char* b2 = last ? nB : cB + (size_t)(t + 2) * kstep;
            const char* a3 = a2 + kstep; const char* b3 = b2 + kstep;
            if (last && has_next) S.a_ready(nxt);
            if constexpr (Epi::PREFETCH) { if (t == nt - EPI_PF_TILES) E.prefetch(cur, lds + STAGE_BYTES + wid * 256, wid, lane); }
            if constexpr (SP2) {
            PG8_LDB(B0, 0, 0); PG8_LDB(B1, 0, 1); PG8_SCHED; PG8_LDA(At, 0, 0); PG8_STAGE(PG8_SA(1, 1), a1 + hstep, voffA);
            PG8_WAIT_V(8); PG8_WAIT_L(0); PG8_BAR; PG8_MMA(0, 0, At, B0); PG8_MMA(0, 1, At, B1); PG8_BAR; PG8_SCHED;
            PG8_LDA(At, 0, 1); PG8_STAGE(PG8_SB(0, 0), b2, voffB); PG8_STAGE(PG8_SB(0, 1), b2 + hstep, voffB); PG8_STAGE(PG8_SA(0, 0), a2, voffA);
            PG8_WAIT_V(8); PG8_WAIT_L(0); PG8_BAR; PG8_MMA(1, 0, At, B0); PG8_MMA(1, 1, At, B1); PG8_BAR; PG8_SCHED;
            PG8_LDB(B0, 1, 0); PG8_LDB(B1, 1, 1); PG8_SCHED; PG8_LDA(At, 1, 0); PG8_STAGE(PG8_SA(0, 1), a2 + hstep, voffA);
            PG8_WAIT_V(8); PG8_WAIT_L(0); PG8_BAR; PG8_MMA(0, 0, At, B0); PG8_MMA(0, 1, At, B1); PG8_BAR; PG8_SCHED;
            PG8_LDA(At, 1, 1); PG8_STAGE(PG8_SB(1, 0), b3, voffB); PG8_STAGE(PG8_SB(1, 1), b3 + hstep, voffB); PG8_STAGE(PG8_SA(1, 0), a3, voffA);
            PG8_WAIT_V(8); PG8_WAIT_L(0); PG8_BAR; PG8_MMA(1, 0, At, B0); PG8_MMA(1, 1, At, B1); PG8_BAR; PG8_SCHED;
            } else {
            PG8_LDB(B0, 0, 0); PG8_SCHED; PG8_LDA(At, 0, 0); PG8_STAGE(PG8_SA(1, 1), a1 + hstep, voffA);
            PG8_WAIT_L(8); PG8_BAR; PG8_WAIT_L(0); PG8_MMA(0, 0, At, B0); PG8_BAR; PG8_SCHED;
            PG8_LDB(B1, 0, 1); PG8_STAGE(PG8_SB(0, 0), b2, voffB);
            PG8_BAR; PG8_WAIT_L(0); PG8_MMA(0, 1, At, B1); PG8_BAR;
            PG8_LDA(At, 0, 1); PG8_STAGE(PG8_SA(0, 0), a2, voffA);
            PG8_BAR; PG8_WAIT_L(0); PG8_MMA(1, 0, At, B0); PG8_BAR; PG8_SCHED;
            PG8_STAGE(PG8_SB(0, 1), b2 + hstep, voffB);
            PG8_WAIT_V(6); PG8_BAR; PG8_MMA(1, 1, At, B1); PG8_BAR;
            PG8_LDB(B0, 1, 0); PG8_SCHED; PG8_LDA(At, 1, 0); PG8_STAGE(PG8_SA(0, 1), a2 + hstep, voffA);
            PG8_WAIT_L(8); PG8_BAR; PG8_WAIT_L(0); PG8_MMA(0, 0, At, B0); PG8_BAR; PG8_SCHED;
            PG8_LDB(B1, 1, 1); PG8_STAGE(PG8_SB(1, 0), b3, voffB);
            PG8_BAR; PG8_WAIT_L(0); PG8_MMA(0, 1, At, B1); PG8_BAR;
            PG8_LDA(At, 1, 1); PG8_STAGE(PG8_SA(1, 0), a3, voffA);
            PG8_BAR; PG8_WAIT_L(0); PG8_MMA(1, 0, At, B0); PG8_BAR; PG8_SCHED;
            PG8_STAGE(PG8_SB(1, 1), b3 + hstep, voffB);
            PG8_WAIT_V(6); PG8_BAR; PG8_MMA(1, 1, At, B1); PG8_BAR;
            }
        }
        if constexpr (ALIGN_EPI) { if (wr == 0) PG8_BAR; }
        if constexpr (!Epi::AFTER_DRAIN) { E(acc, cur, wr, wc, fr, fq); S.done(cur); }
        if (!has_next) break;
#pragma unroll
        for (int a = 0; a < 2; ++a)
#pragma unroll
            for (int b = 0; b < 2; ++b)
#pragma unroll
                for (int m = 0; m < 4; ++m)
#pragma unroll
                    for (int n = 0; n < 2; ++n) acc[a][b][m][n] = (f32x4){0.f, 0.f, 0.f, 0.f};
        cur = nxt; cA = nA; cB = nB; ++ui;
        if constexpr (ALIGN_EPI) { if (wr == 1) PG8_BAR; }
    }
    PG8_WAIT_V(0);
    if constexpr (!ALIGN_EPI) { if (wr == 0) PG8_BAR; }
    PG8_BAR;
    if constexpr (Epi::AFTER_DRAIN) { E.fused(acc, cur, wr, wc, fr, fq, lds, wid, lane); S.done(cur); }
#undef PG8_SA
#undef PG8_SB
#undef PG8_STAGE
#undef PG8_LDA
#undef PG8_LDB
#undef PG8_MMA
#undef PG8_WAIT_V
#undef PG8_WAIT_L
#undef PG8_BAR
#undef PG8_SCHED
}
}
namespace fa {
constexpr int KVBLK = 64, SHM_V = 16384, SHM_K = 16384, SHM_KR = 8192;
constexpr int OFF_V = 0, OFF_K = 2 * SHM_V, OFF_KR = OFF_K + 2 * SHM_K, OFF_WS = OFF_KR + 2 * SHM_KR, OFF_IMP = OFF_WS + 8 * 64 * 4, IMP_LD = 257, OFF_QPARK = OFF_IMP + 32 * IMP_LD * 4 + 128  , LDS_END = OFF_QPARK + 8 * 4096;
#define KSWZ(row, colB) ((row) * 256 + ((colB) ^ (((row) & 7) << 4)))
#define KSWZ16(row, colB) ((row) * 256 + ((colB) ^ (((row) & 15) << 4)))
#define SBAR() __builtin_amdgcn_sched_barrier(0)
__device__ __forceinline__ int v_st(int k, int c) { const int kk = (k & ~0xC) | ((k & 4) << 1) | ((k & 8) >> 1); return ((kk >> 3) * 4 + (c >> 5)) * 512 + ((kk & 7) * 32 + (c & 31)) * 2; }
__device__ __forceinline__ int v_rd_base(int lane) { return ((lane & 3) << 3) | (((lane >> 2) & 3) << 6) | (((lane >> 4) & 1) << 5) | (((lane >> 5) & 1) << 8); }
constexpr int v_rd_off(int d0, int ks, int half) { return d0 * 512 + ks * 4096 + half * 2048; }
__device__ __forceinline__ int crow(int r, int hi) { return (r & 3) + 8 * (r >> 2) + 4 * hi; }
__device__ __forceinline__ unsigned cvtpk(float lo, float hi) { unsigned r; asm volatile("v_cvt_pk_bf16_f32 %0, %1, %2" : "=v"(r) : "v"(lo), "v"(hi)); return r; }
__device__ __forceinline__ bf16x8 pack8(f32x4 a, f32x4 b) { u32x4 w = {cvtpk(a[0], a[1]), cvtpk(a[2], a[3]), cvtpk(b[0], b[1]), cvtpk(b[2], b[3])}; return *reinterpret_cast<bf16x8*>(&w); }
__device__ __forceinline__ void mask_tile(f32x16& p0, f32x16& p1, int dq, unsigned W) {
    const float NEG = -__builtin_inff();
#pragma unroll
    for (int r = 0; r < 16; ++r) {
        const int c = (r & 3) + 8 * (r >> 2);
        if ((unsigned)(dq - c) >= W) p0[r] = NEG;
        if ((unsigned)(dq - c - 32) >= W) p1[r] = NEG;
    }
}
__device__ __forceinline__ void mask_all(f32x16& p0, f32x16& p1, bool kill) {
    const float NEG = -__builtin_inff();
#pragma unroll
    for (int r = 0; r < 16; ++r) { if (kill) { p0[r] = NEG; p1[r] = NEG; } }
}
__device__ __forceinline__ void partialSM(f32x16& p0, f32x16& p1, float& m_reg, float& mn, float& alpha, float scale, float C2, bool kill = false) {
    float pmax = p0[0];
#pragma unroll
    for (int r = 1; r < 16; ++r) pmax = fmaxf(pmax, p0[r]);
#pragma unroll
    for (int r = 0; r < 16; ++r) pmax = fmaxf(pmax, p1[r]);
    { auto rr = __builtin_amdgcn_permlane32_swap(__float_as_uint(pmax), __float_as_uint(pmax), false, false);
      pmax = fmaxf(__uint_as_float(rr[0]), __uint_as_float(rr[1])); }
    if (__builtin_expect(__all((pmax - m_reg) * scale <= 8.0f), 1)) { mn = m_reg; alpha = 1.f; }
    else { mn = fmaxf(m_reg, pmax); alpha = __builtin_amdgcn_exp2f((m_reg - mn) * C2); m_reg = mn; }
    const float mnL = kill ? -__builtin_inff() : -mn * C2;
#pragma unroll
    for (int r = 0; r < 16; ++r) p0[r] = fmaf(p0[r], C2, mnL);
#pragma unroll
    for (int r = 0; r < 16; ++r) p1[r] = fmaf(p1[r], C2, mnL);
#pragma unroll
    for (int r = 0; r < 16; ++r) p0[r] = __builtin_amdgcn_exp2f(p0[r]);
}
__device__ __forceinline__ void finishSM(f32x16& p0, f32x16& p1, float alpha, float& l_reg, bf16x8& pa0, bf16x8& pa1, bf16x8& pa2, bf16x8& pa3) {
#pragma unroll
    for (int r = 0; r < 16; ++r) p1[r] = __builtin_amdgcn_exp2f(p1[r]);
    float ps = 0;
#pragma unroll
    for (int r = 0; r < 16; ++r) ps += p0[r];
#pragma unroll
    for (int r = 0; r < 16; ++r) ps += p1[r];
    { auto rr = __builtin_amdgcn_permlane32_swap(__float_as_uint(ps), __float_as_uint(ps), false, false);
      ps = __uint_as_float(rr[0]) + __uint_as_float(rr[1]); }
    l_reg = l_reg * alpha + ps;
#define PK4(P, B_, OUT) do { unsigned a0 = cvtpk(P[B_+0], P[B_+1]), a1 = cvtpk(P[B_+2], P[B_+3]);                          \
        unsigned b0 = cvtpk(P[B_+4], P[B_+5]), b1 = cvtpk(P[B_+6], P[B_+7]);                                             \
        auto r0 = __builtin_amdgcn_permlane32_swap(a0, b0, false, false); auto r1 = __builtin_amdgcn_permlane32_swap(a1, b1, false, false); \
        u32x4 w = {r0[0], r1[0], r0[1], r1[1]}; OUT = *reinterpret_cast<bf16x8*>(&w); } while (0)
    PK4(p0, 0, pa0); PK4(p0, 8, pa1); PK4(p1, 0, pa2); PK4(p1, 8, pa3);
#undef PK4
}
template <int KB, bool ROPE, bool LIGHT = false>
__device__ __forceinline__ void qkt(f32x16& p0, f32x16& p1, const char* lds, int r32, int hi, const bf16x8* qr, const char* qpark = nullptr) {
    p0 = f32x16{}; p1 = f32x16{};
    const char* K_lds = lds + OFF_K;
    const char* kb[4];
#pragma unroll
    for (int dd = 0; dd < 4; ++dd) kb[dd] = K_lds + KB * SHM_K + KSWZ(r32, (dd * 16 + hi * 8) * 2);
    bf16x8 f[4][4];
#define QK_LD(g) do { const char* a0_ = kb[(2 * (g)) & 3] + ((2 * (g)) >> 2) * 128; const char* a1_ = kb[(2 * (g) + 1) & 3] + ((2 * (g) + 1) >> 2) * 128; \
        f[(g) & 3][0] = *reinterpret_cast<const bf16x8*>(a0_); f[(g) & 3][1] = *reinterpret_cast<const bf16x8*>(a0_ + 32 * 256); \
        f[(g) & 3][2] = *reinterpret_cast<const bf16x8*>(a1_); f[(g) & 3][3] = *reinterpret_cast<const bf16x8*>(a1_ + 32 * 256); } while (0)
#define QK_MM(g) do { p0 = __builtin_amdgcn_mfma_f32_32x32x16_bf16(f[(g) & 3][0], qr[2 * (g)], p0, 0, 0, 0); p1 = __builtin_amdgcn_mfma_f32_32x32x16_bf16(f[(g) & 3][1], qr[2 * (g)], p1, 0, 0, 0); \
        p0 = __builtin_amdgcn_mfma_f32_32x32x16_bf16(f[(g) & 3][2], qr[2 * (g) + 1], p0, 0, 0, 0); p1 = __builtin_amdgcn_mfma_f32_32x32x16_bf16(f[(g) & 3][3], qr[2 * (g) + 1], p1, 0, 0, 0); } while (0)
    if constexpr (ROPE) {
        QK_LD(0); SBAR();
        QK_LD(1); SBAR(); QK_MM(0); SBAR();
        QK_LD(2); SBAR(); QK_MM(1); SBAR();
        QK_LD(3); SBAR(); QK_MM(2); SBAR();
        const char* KR_lds = lds + OFF_KR + KB * SHM_KR + r32 * 128;
        bf16x8 ra[2], rb[2], qa, qb_;
#define QR_LD(d0, R, Q) do { const char* a = KR_lds + (((d0) * 32 + hi * 16) ^ ((r32 & 7) << 4)); R[0] = *reinterpret_cast<const bf16x8*>(a); R[1] = *reinterpret_cast<const bf16x8*>(a + 32 * 128); Q = *reinterpret_cast<const bf16x8*>(qpark + (d0) * 1024); } while (0)
#define QR_MM(R, Q) do { p0 = __builtin_amdgcn_mfma_f32_32x32x16_bf16(R[0], Q, p0, 0, 0, 0); p1 = __builtin_amdgcn_mfma_f32_32x32x16_bf16(R[1], Q, p1, 0, 0, 0); } while (0)
        QR_LD(0, ra, qa); SBAR(); QK_MM(3); SBAR();
        QR_LD(1, rb, qb_); SBAR(); QR_MM(ra, qa); SBAR();
        QR_LD(2, ra, qa); SBAR(); QR_MM(rb, qb_); SBAR();
        QR_LD(3, rb, qb_); SBAR(); QR_MM(ra, qa); SBAR();
        QR_MM(rb, qb_);
#undef QR_LD
#undef QR_MM
    } else if constexpr (LIGHT) {
        QK_LD(0); SBAR();
        QK_LD(1); SBAR(); QK_MM(0); SBAR();
        QK_LD(2); SBAR(); QK_MM(1); SBAR();
        QK_LD(3); SBAR(); QK_MM(2); SBAR();
        QK_MM(3);
    } else {
        QK_LD(0); QK_LD(1); SBAR();
        QK_LD(2); SBAR(); QK_MM(0); SBAR();
        QK_LD(3); SBAR(); QK_MM(1); SBAR();
        QK_MM(2); QK_MM(3);
    }
#undef QK_LD
#undef QK_MM
}
template <int VB, bool PIPE>
__device__ __forceinline__ void pv_tile(f32x16* o, int vb0, bf16x8 pa0, bf16x8 pa1, bf16x8 pa2, bf16x8 pa3) {
#define TRRD(dst, off) asm volatile("ds_read_b64_tr_b16 %0, %1 offset:%2" : "=&v"(dst) : "v"(vb0), "i"(off) : "memory")
#define PV_LD(S, d0) do { constexpr int b_ = OFF_V + VB * SHM_V + v_rd_off(d0, 0, 0); TRRD(S[0], b_); TRRD(S[1], b_ + 2048); TRRD(S[2], b_ + 4096); TRRD(S[3], b_ + 6144); TRRD(S[4], b_ + 8192); TRRD(S[5], b_ + 10240); TRRD(S[6], b_ + 12288); TRRD(S[7], b_ + 14336); } while (0)
#define PV_MM(S, d0) do { \
        o[d0] = __builtin_amdgcn_mfma_f32_32x32x16_bf16(pa0, (bf16x8){S[0][0], S[0][1], S[0][2], S[0][3], S[1][0], S[1][1], S[1][2], S[1][3]}, o[d0], 0, 0, 0);   \
        o[d0] = __builtin_amdgcn_mfma_f32_32x32x16_bf16(pa1, (bf16x8){S[2][0], S[2][1], S[2][2], S[2][3], S[3][0], S[3][1], S[3][2], S[3][3]}, o[d0], 0, 0, 0);   \
        o[d0] = __builtin_amdgcn_mfma_f32_32x32x16_bf16(pa2, (bf16x8){S[4][0], S[4][1], S[4][2], S[4][3], S[5][0], S[5][1], S[5][2], S[5][3]}, o[d0], 0, 0, 0);   \
        o[d0] = __builtin_amdgcn_mfma_f32_32x32x16_bf16(pa3, (bf16x8){S[6][0], S[6][1], S[6][2], S[6][3], S[7][0], S[7][1], S[7][2], S[7][3]}, o[d0], 0, 0, 0); } while (0)
#define PV_W(n) do { asm volatile("s_waitcnt lgkmcnt(" #n ")" ::: "memory"); SBAR(); } while (0)
    if constexpr (PIPE) {
        s16x4 A[8], B[8];
        PV_LD(A, 0); PV_LD(B, 1); PV_W(8); PV_MM(A, 0);
        PV_LD(A, 2); PV_W(8); PV_MM(B, 1);
        PV_LD(B, 3); PV_W(8); PV_MM(A, 2);
        PV_W(0); PV_MM(B, 3);
    } else {
        s16x4 A[8];
        PV_LD(A, 0); PV_W(0); PV_MM(A, 0); PV_LD(A, 1); PV_W(0); PV_MM(A, 1); PV_LD(A, 2); PV_W(0); PV_MM(A, 2); PV_LD(A, 3); PV_W(0); PV_MM(A, 3);
    }
#undef PV_W
#undef PV_MM
#undef PV_LD
#undef TRRD
}

struct FUnit {
    const bf16_t* Kb; long ldk; const bf16_t* Vb; long ldv; const bf16_t* KRb;
    int j_lo, j_hi;
    int qlo, qhi;
    int qpos;
    unsigned long long sel;
};
template <int MODE, int VAR = 0>
__device__ __forceinline__ void flash_core(char* lds, const FUnit& u, const bf16x8* qr, float scale, f32x16 (&o)[4], float& m_reg, float& l_reg) {
    constexpr bool ROPE = (MODE == 0);
    const int tid = threadIdx.x, wid = __builtin_amdgcn_readfirstlane(tid >> 6), lane = tid & 63, r32 = lane & 31, hi = lane >> 5;
    const int grp = wid >> 2;
    const float C2 = 1.4426950408889634f * scale;
    char* V_lds = lds + OFF_V; char* K_lds = lds + OFF_K; char* KR_lds = lds + OFF_KR;
    float* ws = (float*)(lds + OFF_WS) + wid * 64; float* al_l = ws + 32;
    const int sr = tid >> 4, sc = (tid & 15) * 8, vst0 = v_st(sr, sc), vst1 = v_st(32 + sr, sc), kws = KSWZ(sr, sc * 2);
    const int rr = tid >> 3, rc = (tid & 7) * 8, krws = rr * 128 + ((rc * 2) ^ ((rr & 7) << 4));
    const int vb0 = (int)(uintptr_t)lds + v_rd_base(lane);
    const char* qpark = lds + OFF_QPARK + wid * 4096 + lane * 16;
    m_reg = -1e30f; l_reg = 0.f;
#pragma unroll
    for (int d = 0; d < 4; ++d) o[d] = f32x16{};
    const int NT = u.j_hi - u.j_lo;
    if (NT <= 0) return;
    bf16x8 st_k0, st_k1, st_v0, st_v1, st_kr;
    f32x16 p0, p1; float mn, al; bf16x8 pa0, pa1, pa2, pa3;
    const unsigned W = (MODE == 1) ? 512u : ((MODE == 3) ? 0x80000000u : 0x7fffffffu);
#define FA_KBASE(t) ((u.j_lo + (t)) * KVBLK)
#define FA_KLOAD(k0) do { st_k0 = *(const bf16x8*)(u.Kb + (long)((k0) + sr) * u.ldk + sc); st_k1 = *(const bf16x8*)(u.Kb + (long)((k0) + 32 + sr) * u.ldk + sc);   \
                          if constexpr (ROPE) st_kr = *(const bf16x8*)(u.KRb + (long)((k0) + rr) * 64 + rc); } while (0)
#define FA_VLOAD(k0) do { st_v0 = *(const bf16x8*)(u.Vb + (long)((k0) + sr) * u.ldv + sc); st_v1 = *(const bf16x8*)(u.Vb + (long)((k0) + 32 + sr) * u.ldv + sc); } while (0)
#define FA_KWRITE(bf) do { *(bf16x8*)(K_lds + (bf) * SHM_K + kws) = st_k0; *(bf16x8*)(K_lds + (bf) * SHM_K + kws + 32 * 256) = st_k1;   \
                           if constexpr (ROPE) *(bf16x8*)(KR_lds + (bf) * SHM_KR + krws) = st_kr; } while (0)
#define FA_VWRITE(bf) do { *(bf16x8*)(V_lds + (bf) * SHM_V + vst0) = st_v0; *(bf16x8*)(V_lds + (bf) * SHM_V + vst1) = st_v1; } while (0)
#define FA_BAR() do { asm volatile("s_waitcnt lgkmcnt(0)" ::: "memory"); __builtin_amdgcn_s_barrier(); asm volatile("" ::: "memory"); } while (0)
#define FA_RESC(a) do { if (__any((a) < 1.f)) { if (hi == 0) al_l[r32] = (a); asm volatile("s_waitcnt lgkmcnt(0)" ::: "memory");              \
                     _Pragma("unroll") for (int d_ = 0; d_ < 4; ++d_) { _Pragma("unroll") for (int r = 0; r < 16; ++r) o[d_][r] *= al_l[crow(r, hi)]; } asm volatile("" ::: "memory"); } } while (0)
#define FA_MASK(t) do { const int kb_ = FA_KBASE(t);                                                                             \
        if (MODE == 1) { if (kb_ + KVBLK - 1 > u.qlo || kb_ <= u.qhi - 512) mask_tile(p0, p1, u.qpos - kb_ - 4 * hi, W); }       \
        else { if (kb_ + KVBLK - 1 > u.qlo) mask_tile(p0, p1, u.qpos - kb_ - 4 * hi, W); }                                       \
        } while (0)
#define FA_KILL(t) ((MODE == 2) && (((u.sel >> (u.j_lo + (t))) & 1ull) == 0ull))
    const int kb_last = FA_KBASE(NT - 1);
    FA_KLOAD(FA_KBASE(0)); FA_VLOAD(FA_KBASE(0));
    FA_KWRITE(0); FA_VWRITE(0);
    { const int k1 = FA_KBASE(1); FA_KLOAD(k1 < kb_last ? k1 : kb_last); }
    FA_BAR();
    if (grp == 1) FA_BAR();
#define FA_STEP(BF, t) do {                                                                                                      \
        if (!(VAR & 8)) { const int k1 = FA_KBASE((t) + 1); FA_VLOAD(k1 < kb_last ? k1 : kb_last); }                             \
        SBAR(); if (!(VAR & 1)) qkt<BF, ROPE, MODE == 3>(p0, p1, lds, r32, hi, qr, qpark); else { p0 = f32x16{}; p1 = f32x16{}; p0[0] = (float)(t); }   \
        if (!(VAR & 2)) { FA_MASK(t); partialSM(p0, p1, m_reg, mn, al, scale, C2, FA_KILL(t)); FA_RESC(al); } else { al = 1.f; }   \
        if (!(VAR & 8)) FA_KWRITE((BF) ^ 1);                                                                                     \
        if (!(VAR & 16)) FA_BAR();                                                                                               \
        if (!(VAR & 8)) { const int k2 = FA_KBASE((t) + 2); FA_KLOAD(k2 < kb_last ? k2 : kb_last); }                             \
        if (!(VAR & 2)) finishSM(p0, p1, al, l_reg, pa0, pa1, pa2, pa3); else { l_reg += p0[0]; pa0 = pack8(f32x4{p0[0], p0[1], p0[2], p0[3]}, f32x4{p1[0], p1[1], p1[2], p1[3]}); pa1 = pa0; pa2 = pa0; pa3 = pa0; } \
        SBAR();                                                                                                                  \
        if (!(VAR & 4)) pv_tile<BF, (MODE == 1 || MODE == 2)>(o, vb0, pa0, pa1, pa2, pa3); else { o[0][0] += __builtin_bit_cast(float, (int)pa0[0]); }      \
        if (!(VAR & 8)) FA_VWRITE((BF) ^ 1);                                                                                     \
        if (!(VAR & 16)) FA_BAR(); } while (0)
    int t = 0;
    for (; t + 1 < NT; t += 2) {
        FA_STEP(0, t);
        FA_STEP(1, t + 1);
    }
    if (NT & 1) {
        SBAR(); if (!(VAR & 1)) qkt<0, ROPE, MODE == 3>(p0, p1, lds, r32, hi, qr, qpark); else { p0 = f32x16{}; p1 = f32x16{}; }
        if (!(VAR & 2)) { FA_MASK(t); partialSM(p0, p1, m_reg, mn, al, scale, C2, FA_KILL(t)); FA_RESC(al); } else { al = 1.f; }
        if (!(VAR & 16)) FA_BAR();
        if (!(VAR & 2)) finishSM(p0, p1, al, l_reg, pa0, pa1, pa2, pa3); else { pa0 = pack8(f32x4{p0[0], p0[1], p0[2], p0[3]}, f32x4{p1[0], p1[1], p1[2], p1[3]}); pa1 = pa0; pa2 = pa0; pa3 = pa0; }
        SBAR();
        if (!(VAR & 4)) pv_tile<0, (MODE == 1 || MODE == 2)>(o, vb0, pa0, pa1, pa2, pa3);
        if (!(VAR & 16)) FA_BAR();
    }
#undef FA_STEP
    if (grp == 0) FA_BAR();
#undef FA_MASK
#undef FA_KILL
#undef FA_RESC
#undef FA_BAR
#undef FA_VWRITE
#undef FA_KWRITE
#undef FA_VLOAD
#undef FA_KLOAD
#undef FA_KBASE
}
template <int MODE>
__device__ __forceinline__ void flash_core2(char* lds, const FUnit& u, const bf16x8* qr, float scale, f32x16 (&o)[4], float& m_reg, float& l_reg) {
    const int tid = threadIdx.x, wid = __builtin_amdgcn_readfirstlane(tid >> 6), lane = tid & 63, r32 = lane & 31, hi = lane >> 5;
    const float C2 = 1.4426950408889634f * scale;
    char* V_lds = lds + OFF_V; char* K_lds = lds + OFF_K;
    float* ws = (float*)(lds + OFF_WS) + wid * 64; float* al_l = ws + 32;
    const int sr = tid >> 4, sc = (tid & 15) * 8, vst0 = v_st(sr, sc), vst1 = v_st(32 + sr, sc), kws = KSWZ(sr, sc * 2);
    const int vb0 = (int)(uintptr_t)lds + v_rd_base(lane);
    m_reg = -1e30f; l_reg = 0.f;
#pragma unroll
    for (int d = 0; d < 4; ++d) o[d] = f32x16{};
    const int NT = u.j_hi - u.j_lo;
    if (NT <= 0) return;
    bf16x8 st_k0, st_k1, st_v0, st_v1;
    f32x16 pA0, pA1, pB0, pB1; float mnA, mnB, alA, alB; bf16x8 pa0, pa1, pa2, pa3;
    const unsigned W = (MODE == 1) ? 512u : 0x7fffffffu;
#define F2_KBASE(t) ((u.j_lo + (t)) * KVBLK)
#define F2_LOAD(k0) do { st_v0 = *(const bf16x8*)(u.Vb + (long)((k0) + sr) * u.ldv + sc); st_v1 = *(const bf16x8*)(u.Vb + (long)((k0) + 32 + sr) * u.ldv + sc);   \
                         st_k0 = *(const bf16x8*)(u.Kb + (long)((k0) + sr) * u.ldk + sc); st_k1 = *(const bf16x8*)(u.Kb + (long)((k0) + 32 + sr) * u.ldk + sc); } while (0)
#define F2_WRITE(bf) do { *(bf16x8*)(V_lds + (bf) * SHM_V + vst0) = st_v0; *(bf16x8*)(V_lds + (bf) * SHM_V + vst1) = st_v1;   \
                          *(bf16x8*)(K_lds + (bf) * SHM_K + kws) = st_k0; *(bf16x8*)(K_lds + (bf) * SHM_K + kws + 32 * 256) = st_k1; } while (0)
#define F2_VMW() asm volatile("s_waitcnt vmcnt(0)" ::: "memory")
#define F2_RESC(a) do { if (__any((a) < 1.f)) { if (hi == 0) al_l[r32] = (a); asm volatile("s_waitcnt lgkmcnt(0)" ::: "memory");              \
                     _Pragma("unroll") for (int d_ = 0; d_ < 4; ++d_) { _Pragma("unroll") for (int r = 0; r < 16; ++r) o[d_][r] *= al_l[crow(r, hi)]; } asm volatile("" ::: "memory"); } } while (0)
#define F2_MASK(P0_, P1_, t) do { const int kb_ = F2_KBASE(t);                                                                    \
        if (MODE == 1) { if (kb_ + KVBLK - 1 > u.qlo || kb_ <= u.qhi - 512) mask_tile(P0_, P1_, u.qpos - kb_ - 4 * hi, W); }      \
        else { if (kb_ + KVBLK - 1 > u.qlo) mask_tile(P0_, P1_, u.qpos - kb_ - 4 * hi, W); } } while (0)
#define F2_KILL(t) ((MODE == 2) && (((u.sel >> (u.j_lo + (t))) & 1ull) == 0ull))
#define F2_HALF(PX0, PX1, mnX, alX, PY0, PY1, alY, t, KB, VB, SB) do {                                                            \
        SBAR(); qkt<KB, false, true>(PX0, PX1, lds, r32, hi, qr);                                                                 \
        finishSM(PY0, PY1, alY, l_reg, pa0, pa1, pa2, pa3); SBAR();                                                               \
        if ((t) + 1 < NT) { F2_LOAD(F2_KBASE((t) + 1)); SBAR(); }                                                                 \
        pv_tile<VB, false>(o, vb0, pa0, pa1, pa2, pa3); F2_MASK(PX0, PX1, (t)); partialSM(PX0, PX1, m_reg, mnX, alX, scale, C2, F2_KILL(t)); \
        __syncthreads();                                                                                                          \
        if ((t) + 1 < NT) { F2_VMW(); F2_WRITE(SB); }                                                                             \
        F2_RESC(alX); __syncthreads(); } while (0)
    F2_LOAD(F2_KBASE(0)); F2_VMW(); F2_WRITE(0); __syncthreads();
    if (NT > 1) F2_LOAD(F2_KBASE(1));
    SBAR(); qkt<0, false, true>(pA0, pA1, lds, r32, hi, qr);
    F2_MASK(pA0, pA1, 0); partialSM(pA0, pA1, m_reg, mnA, alA, scale, C2, F2_KILL(0));
    if (NT > 1) { F2_VMW(); F2_WRITE(1); }
    __syncthreads();
    for (int t = 1; t + 1 < NT; t += 2) {
        F2_HALF(pB0, pB1, mnB, alB, pA0, pA1, alA, t, 1, 0, 0);
        F2_HALF(pA0, pA1, mnA, alA, pB0, pB1, alB, t + 1, 0, 1, 1);
    }
    const bool even = (NT & 1) == 0;
    if (even) { SBAR(); qkt<1, false, true>(pB0, pB1, lds, r32, hi, qr); SBAR(); }
    finishSM(pA0, pA1, alA, l_reg, pa0, pa1, pa2, pa3); SBAR();
    pv_tile<0, false>(o, vb0, pa0, pa1, pa2, pa3);
    if (even) { F2_MASK(pB0, pB1, NT - 1); partialSM(pB0, pB1, m_reg, mnB, alB, scale, C2, F2_KILL(NT - 1)); F2_RESC(alB);
        finishSM(pB0, pB1, alB, l_reg, pa0, pa1, pa2, pa3); SBAR(); pv_tile<1, false>(o, vb0, pa0, pa1, pa2, pa3); }
#undef F2_HALF
#undef F2_KILL
#undef F2_MASK
#undef F2_RESC
#undef F2_VMW
#undef F2_WRITE
#undef F2_LOAD
#undef F2_KBASE
}
__device__ __forceinline__ void row_factors(char* lds, int wid, int r32, int hi, float f, float (&rf)[16]) {
    float* li_l = (float*)(lds + OFF_WS) + wid * 64;
    asm volatile("" ::: "memory");
    if (hi == 0) li_l[r32] = f;
    asm volatile("s_waitcnt lgkmcnt(0)" ::: "memory");
#pragma unroll
    for (int r = 0; r < 16; ++r) rf[r] = li_l[crow(r, hi)];
    asm volatile("s_waitcnt lgkmcnt(0)" ::: "memory");
}
}

constexpr size_t MiB = 1ull << 20, KiB = 1ull << 10;
constexpr size_t WS_CTL = 0;
constexpr size_t WS_ROPE = 64 * KiB;
constexpr size_t WS_MG = WS_ROPE + 1 * MiB;
constexpr size_t WS_FLOOR = WS_MG + 512 * KiB;
constexpr size_t WS_DEN = WS_FLOOR + 256 * KiB;
constexpr size_t WS_GATES = WS_DEN + 256 * KiB;
constexpr size_t WS_SEL = WS_GATES + 512 * KiB;
constexpr size_t WS_KROPE = WS_SEL + 512 * KiB;
constexpr size_t WS_CQN = WS_KROPE + 2 * MiB;
constexpr size_t WS_CKVN = WS_CQN + 32 * MiB;
constexpr size_t WS_KVB = WS_CKVN + 16 * MiB;
constexpr size_t WS_XB = WS_KVB + 128 * MiB;
constexpr size_t WS_Z = WS_XB + 128 * MiB;
constexpr size_t WS_R = WS_Z + 256 * MiB;
constexpr size_t WS_W = WS_R + 344 * MiB;
constexpr size_t W_AB = WS_W, W_UQ = W_AB + 62 * MiB, W_UKV = W_UQ + 6 * MiB, W_O0 = W_UKV + 4 * MiB, W_GU0 = W_O0 + 32 * MiB, W_D0 = W_GU0 + 172 * MiB;
constexpr size_t W_C = W_D0 + 86 * MiB, W_C1K = W_C + 58 * MiB, W_C1V = W_C1K + 2 * MiB, W_C2K = W_C1V + 2 * MiB, W_C2V = W_C2K + 128 * KiB, W_O1 = W_C2V + 128 * KiB;
constexpr size_t W_GU1 = W_O1 + 32 * MiB, W_D1 = W_GU1 + 172 * MiB, WS_AT = W_D1 + 86 * MiB;
constexpr size_t WS_AA = WS_AT + 256 * KiB;
constexpr size_t WS_DENI = WS_AA + 256 * KiB;
constexpr size_t WS_DENP = WS_DENI + 256 * KiB;
constexpr size_t WS_STATS = WS_DENP + 4 * MiB;
constexpr size_t WS_END = WS_STATS + 128 * KiB;
constexpr size_t WS_AK = WS_KVB, WS_AV = WS_AK + 32 * MiB, WS_HK = WS_AV + 32 * MiB, WS_HV = WS_HK + 2 * MiB, WS_KCMP = WS_HV + 2 * MiB, WS_VCMP = WS_KCMP + 2 * MiB;
constexpr size_t WS_QB = WS_R + (size_t)M_TOK * AB_NP * 2;

constexpr int NTHREADS = 512;
constexpr int LDS_BYTES = 152 * 1024, LDS_CTL_OFF = LDS_BYTES - 256;
constexpr int N_TJOBS = 14;
struct TJob { const float* s; const float* s2; bf16_t* d; int K, N, Np, mode; };
struct Args { const float* in[26]; float* out; unsigned char* ws; TJob tj[N_TJOBS]; int ph_lo, ph_hi; };

__device__ __forceinline__ void transpose_tile(char* lds, const TJob& jb, int t) {
    float* T = (float*)lds;
    const int tid = threadIdx.x;
    const int tn = jb.Np >> 6;
    const int in_ = t % tn, ik = t / tn, n0 = in_ * 64, k0 = ik * 64;
    const float* sp = jb.s; int c0 = n0; const int ncols = jb.N;
    if (jb.mode == 1) { const int tile = n0 >> 8, j = n0 & 255; sp = (j < 128) ? jb.s : jb.s2; c0 = tile * 128 + (j & 127); }
    const int kk = tid >> 4, nc = (tid & 15) * 4;
    f32x4 v0 = {0.f, 0.f, 0.f, 0.f}, v1 = v0;
    if (c0 + nc < ncols) { v0 = *(const f32x4*)(sp + (size_t)(k0 + kk) * ncols + c0 + nc); v1 = *(const f32x4*)(sp + (size_t)(k0 + kk + 32) * ncols + c0 + nc); }
#pragma unroll
    for (int j = 0; j < 4; ++j) { T[(nc + j) * 65 + kk] = v0[j]; T[(nc + j) * 65 + kk + 32] = v1[j]; }
    __syncthreads();
    const int n = tid >> 3, kc = (tid & 7) * 8;
    float f[8];
#pragma unroll
    for (int j = 0; j < 8; ++j) f[j] = T[n * 65 + kc + j];
    *(bf16x8*)(jb.d + (size_t)(n0 + n) * jb.K + k0 + kc) = pack8f(f);
    __syncthreads();
}
constexpr int N_TJOBS_PRO = 11;
__device__ __forceinline__ void transpose_jobs(char* lds, const Args& a) {
    for (int ji = 0; ji < N_TJOBS_PRO; ++ji) {
        const TJob jb = a.tj[ji];
        const int nt = (jb.K >> 6) * (jb.Np >> 6);
        for (int t = blockIdx.x; t < nt; t += gridDim.x) transpose_tile(lds, jb, t);
    }
}
constexpr int LATE_T0 = 64 * 64, LATE_T1 = 64 * 344, LATE_T2 = 172 * 64, LATE_TOTAL = LATE_T0 + LATE_T1 + LATE_T2, LATE_SLOTS = 64 + 128 + 192 + 224, LATE_PER = (LATE_TOTAL + LATE_SLOTS - 1) / LATE_SLOTS;
struct TTile { const float* sp; bf16_t* d; int K, ncols, c0, n0, k0; };
__device__ __forceinline__ TTile late_tile(const Args& a, int g) {
    const int ji = g < LATE_T0 ? 11 : (g < LATE_T0 + LATE_T1 ? 12 : 13); const int t = g - (ji == 11 ? 0 : (ji == 12 ? LATE_T0 : LATE_T0 + LATE_T1));
    const TJob jb = a.tj[ji]; const int tn = jb.Np >> 6; TTile r; r.n0 = (t % tn) * 64; r.k0 = (t / tn) * 64; r.sp = jb.s; r.c0 = r.n0; r.ncols = jb.N; r.d = jb.d; r.K = jb.K;
    if (jb.mode == 1) { const int tile = r.n0 >> 8, j = r.n0 & 255; r.sp = (j < 128) ? jb.s : jb.s2; r.c0 = tile * 128 + (j & 127); }
    return r;
}
__device__ __forceinline__ void transpose_late(char* lds, const Args& a, int slot) {
    float* T = (float*)lds;
    const int tid = threadIdx.x, kk = tid >> 4, nc = (tid & 15) * 4, n = tid >> 3, kc = (tid & 7) * 8;
    const int g0 = slot * LATE_PER, g1 = (slot + 1) * LATE_PER < LATE_TOTAL ? (slot + 1) * LATE_PER : LATE_TOTAL;
    if (g0 >= g1) return;
    __syncthreads();
    TTile cur = late_tile(a, g0);
    f32x4 v0 = {0.f, 0.f, 0.f, 0.f}, v1 = v0;
    if (cur.c0 + nc < cur.ncols) { v0 = *(const f32x4*)(cur.sp + (size_t)(cur.k0 + kk) * cur.ncols + cur.c0 + nc); v1 = *(const f32x4*)(cur.sp + (size_t)(cur.k0 + kk + 32) * cur.ncols + cur.c0 + nc); }
    for (int g = g0; g < g1; ++g) {
        const TTile nxt = late_tile(a, g + 1 < g1 ? g + 1 : g);
        f32x4 w0 = {0.f, 0.f, 0.f, 0.f}, w1 = w0;
        if (nxt.c0 + nc < nxt.ncols) { w0 = *(const f32x4*)(nxt.sp + (size_t)(nxt.k0 + kk) * nxt.ncols + nxt.c0 + nc); w1 = *(const f32x4*)(nxt.sp + (size_t)(nxt.k0 + kk + 32) * nxt.ncols + nxt.c0 + nc); }
#pragma unroll
        for (int j = 0; j < 4; ++j) { T[(nc + j) * 65 + kk] = v0[j]; T[(nc + j) * 65 + kk + 32] = v1[j]; }
        __syncthreads();
        float f[8];
#pragma unroll
        for (int j = 0; j < 8; ++j) f[j] = T[n * 65 + kc + j];
        *(bf16x8*)(cur.d + (size_t)(cur.n0 + n) * cur.K + cur.k0 + kc) = pack8f(f);
        __syncthreads();
        cur = nxt; v0 = w0; v1 = w1;
    }
}
__device__ __forceinline__ void p0_prologue(char* lds, const Args& a) {
    const int tid = threadIdx.x;
    const size_t gt = (size_t)blockIdx.x * NTHREADS + tid, gs = (size_t)gridDim.x * NTHREADS;
    { const float* x = a.in[0]; bf16_t* xb = (bf16_t*)(a.ws + WS_XB);
      for (size_t i = gt; i < (size_t)M_TOK * DM / 8; i += gs) { const f32x4 v0 = *(const f32x4*)(x + i * 8), v1 = *(const f32x4*)(x + i * 8 + 4);
          float f[8] = {v0[0], v0[1], v0[2], v0[3], v1[0], v1[1], v1[2], v1[3]}; *(bf16x8*)(xb + i * 8) = pack8f(f); } }
    { f32x2* rp = (f32x2*)(a.ws + WS_ROPE);
      for (size_t i = gt; i < (size_t)SEQ * 32; i += gs) { const int pos = (int)(i >> 5), j = (int)(i & 31);
          const double inv = exp(-(double)j / 32.0 * 9.210340371976184  ); const double ang = (double)pos * inv; rp[i] = (f32x2){(float)cos(ang), (float)sin(ang)}; } }
    transpose_jobs(lds, a);
}

__device__ __forceinline__ float softcap15(float z) { return 15.0f * tanhf(z * (1.0f / 15.0f)); }
__device__ __forceinline__ float logsigmoid_f(float z) { return fminf(z, 0.f) - log1pf(__expf(-fabsf(z))); }
__device__ __forceinline__ void p2_prep(const Args& a) {
    const int tid = threadIdx.x, lane = tid & 63, wid = tid >> 6;
    const int gw = blockIdx.x * 8 + wid, nw = gridDim.x * 8;
    const bf16_t* proj = (const bf16_t*)(a.ws + WS_R);
    if (gw < 16) {
        const int bh = gw, b = bh >> 2, h = bh & 3;
        const float* gates = (const float*)(a.ws + WS_GATES);
        f32x2* mg = (f32x2*)(a.ws + WS_MG) + (size_t)bh * SEQ; float* fl = (float*)(a.ws + WS_FLOOR) + (size_t)bh * SEQ;
        const float bi = a.in[2][h], bfg = a.in[3][h];
        float Fc = 0.f, Ac = 0.f, mprev = 0.f;
        for (int c = 0; c < SEQ / 64; ++c) {
            const int t = c * 64 + lane; const float* g = gates + (size_t)(b * SEQ + t) * 8;
            const float li = softcap15(g[h] + bi), lf = logsigmoid_f(softcap15(g[4 + h] + bfg));
            float F = lf;
#pragma unroll
            for (int o = 1; o < 64; o <<= 1) { const float y = __shfl_up(F, o); if (lane >= o) F += y; }
            F += Fc;
            float A = li - F;
#pragma unroll
            for (int o = 1; o < 64; o <<= 1) { const float y = __shfl_up(A, o); if (lane >= o) A = fmaxf(A, y); }
            A = fmaxf(A, Ac);
            const float m = F + A;
            float mp = __shfl_up(m, 1); if (lane == 0) mp = mprev;
            mg[t] = (f32x2){__expf(lf + mp - m), __expf(li - m)}; fl[t] = __expf(-m);
            ((float*)(a.ws + WS_AT))[(size_t)bh * SEQ + t] = li - F; ((float*)(a.ws + WS_AA))[(size_t)bh * SEQ + t] = A;
            Fc = __shfl(F, 63); Ac = __shfl(A, 63); mprev = __shfl(m, 63);
        }
    }
    const float* qn = a.in[5]; const float* kvn = a.in[6];
    bf16_t* cqn = (bf16_t*)(a.ws + WS_CQN); bf16_t* ckvn = (bf16_t*)(a.ws + WS_CKVN); bf16_t* krope = (bf16_t*)(a.ws + WS_KROPE);
    const f32x2* rp = (const f32x2*)(a.ws + WS_ROPE);
    for (int tk = gw; tk < M_TOK; tk += nw) {
        const bf16_t* row = proj + (size_t)tk * AB_NP;
        float x0[8], x1[8], y[8];
        unpack8(*(const bf16x8*)(row + AB_CQ + lane * 8), x0); unpack8(*(const bf16x8*)(row + AB_CQ + 512 + lane * 8), x1); unpack8(*(const bf16x8*)(row + AB_CKV + lane * 8), y);
        const float kr = bf2f(row[AB_KR + lane]);
        float s = 0.f, s2 = 0.f;
#pragma unroll
        for (int j = 0; j < 8; ++j) { s += x0[j] * x0[j] + x1[j] * x1[j]; s2 += y[j] * y[j]; }
        s = wave_sum(s); s2 = wave_sum(s2);
        const float r1 = rsqrtf(s * (1.0f / 1024.0f) + RMS_EPS), r2 = rsqrtf(s2 * (1.0f / 512.0f) + RMS_EPS);
#pragma unroll
        for (int j = 0; j < 8; ++j) { x0[j] *= r1 * qn[lane * 8 + j]; x1[j] *= r1 * qn[512 + lane * 8 + j]; y[j] *= r2 * kvn[lane * 8 + j]; }
        *(bf16x8*)(cqn + (size_t)tk * 1024 + lane * 8) = pack8f(x0); *(bf16x8*)(cqn + (size_t)tk * 1024 + 512 + lane * 8) = pack8f(x1);
        *(bf16x8*)(ckvn + (size_t)tk * 512 + lane * 8) = pack8f(y);
        const float pr = __shfl_xor(kr, 32); const f32x2 cs = rp[(size_t)(tk & (SEQ - 1)) * 32 + (lane & 31)];
        const float out = lane < 32 ? kr * cs.x - pr * cs.y : pr * cs.y + kr * cs.x;
        krope[(size_t)tk * 64 + lane] = f2bf(out);
    }
}

__device__ __forceinline__ float dpp_xor1(float v) { return __int_as_float(__builtin_amdgcn_update_dpp(0, __float_as_int(v), 0xB1, 0xF, 0xF, true)); }
__device__ __forceinline__ float dpp_xor2(float v) { return __int_as_float(__builtin_amdgcn_update_dpp(0, __float_as_int(v), 0x4E, 0xF, 0xF, true)); }
__device__ __forceinline__ float dpp_hmir(float v) { return __int_as_float(__builtin_amdgcn_update_dpp(0, __float_as_int(v), 0x141, 0xF, 0xF, true)); }
__device__ __forceinline__ float dpp_mir(float v)  { return __int_as_float(__builtin_amdgcn_update_dpp(0, __float_as_int(v), 0x140, 0xF, 0xF, true)); }
__device__ __forceinline__ float row16_sum(float v) { v += dpp_xor1(v); v += dpp_xor2(v); v += dpp_hmir(v); v += dpp_mir(v); return v; }
__device__ __forceinline__ float swap32_sum(float a, float b) {
    auto rr = __builtin_amdgcn_permlane32_swap(__float_as_uint(a), __float_as_uint(b), false, false); return __uint_as_float(rr[0]) + __uint_as_float(rr[1]); }
constexpr int ML_CH = 32;
constexpr int ML_Q = 0, ML_K = ML_CH * 256 * 4, ML_V = 2 * ML_CH * 256 * 4, ML_FI = ML_V + ML_CH * 32 * 4, ML_BUF = ML_FI + ML_CH * 8;
constexpr int ML_OUT = 2 * ML_BUF, ML_DEN = ML_OUT + ML_CH * 32 * 4, ML_END = ML_DEN + ML_CH * 4;
static_assert(ML_END <= LDS_CTL_OFF, "mLSTM LDS");
__device__ __forceinline__ void p4_mlstm(char* lds, const Args& a) {
    const int tid = threadIdx.x, lane = tid & 63, wid = __builtin_amdgcn_readfirstlane(tid >> 6);
    const bf16_t* proj = (const bf16_t*)(a.ws + WS_R); bf16_t* hcat = (bf16_t*)a.out;
    for (int unit = blockIdx.x; unit < 256; unit += gridDim.x) {
        const int bh = unit >> 4, sl = unit & 15, b = bh >> 2, h = bh & 3;
        const f32x2* mg = (const f32x2*)(a.ws + WS_MG) + (size_t)bh * SEQ;
        float* den = (float*)(a.ws + WS_DEN) + (size_t)bh * SEQ;
        const bool denw = (wid == 0) && (sl == 0);
        const int st = tid >> 4, sp = (tid & 15) * 16, vt = tid >> 2, vp = (tid & 3) * 8;
        const bf16_t* qsrc = proj + (size_t)(b * SEQ + st) * AB_NP + AB_Q + h * 256 + sp;
        const bf16_t* ksrc = proj + (size_t)(b * SEQ + st) * AB_NP + AB_K + h * 256 + sp;
        const bf16_t* vsrc = proj + (size_t)(b * SEQ + vt) * AB_NP + AB_V + h * 512 + sl * 32 + vp;
        bf16x8 rq0, rq1, rk0, rk1, rv; f32x2 rfi;
#define ML_LOAD(c) do { const size_t o_ = (size_t)(c) * ML_CH * AB_NP; rq0 = *(const bf16x8*)(qsrc + o_); rq1 = *(const bf16x8*)(qsrc + o_ + 8); rk0 = *(const bf16x8*)(ksrc + o_); rk1 = *(const bf16x8*)(ksrc + o_ + 8); \
        if (tid < 128) rv = *(const bf16x8*)(vsrc + o_); if (tid < ML_CH) rfi = mg[(c) * ML_CH + tid]; } while (0)
#define ML_STORE(bufp) do { float f_[8]; float* Q_ = (float*)((bufp) + ML_Q) + st * 256 + sp; float* K_ = (float*)((bufp) + ML_K) + st * 256 + sp; \
        unpack8(rq0, f_); *(f32x4*)(Q_) = (f32x4){f_[0], f_[1], f_[2], f_[3]}; *(f32x4*)(Q_ + 4) = (f32x4){f_[4], f_[5], f_[6], f_[7]}; \
        unpack8(rq1, f_); *(f32x4*)(Q_ + 8) = (f32x4){f_[0], f_[1], f_[2], f_[3]}; *(f32x4*)(Q_ + 12) = (f32x4){f_[4], f_[5], f_[6], f_[7]}; \
        unpack8(rk0, f_); *(f32x4*)(K_) = (f32x4){f_[0], f_[1], f_[2], f_[3]} * 0.0625f; *(f32x4*)(K_ + 4) = (f32x4){f_[4], f_[5], f_[6], f_[7]} * 0.0625f; \
        unpack8(rk1, f_); *(f32x4*)(K_ + 8) = (f32x4){f_[0], f_[1], f_[2], f_[3]} * 0.0625f; *(f32x4*)(K_ + 12) = (f32x4){f_[4], f_[5], f_[6], f_[7]} * 0.0625f; \
        if (tid < 128) { float* V_ = (float*)((bufp) + ML_V) + vt * 32 + vp; unpack8(rv, f_); *(f32x4*)(V_) = (f32x4){f_[0], f_[1], f_[2], f_[3]}; *(f32x4*)(V_ + 4) = (f32x4){f_[4], f_[5], f_[6], f_[7]}; } \
        if (tid < ML_CH) ((f32x2*)((bufp) + ML_FI))[tid] = rfi; } while (0)
        f32x4 C0 = {0.f, 0.f, 0.f, 0.f}, C1 = C0, C2 = C0, C3 = C0, n4 = C0;
        __syncthreads();
        ML_LOAD(0); ML_STORE(lds); __syncthreads();
        float* OUT = (float*)(lds + ML_OUT); float* DENs = (float*)(lds + ML_DEN);
        for (int c = 0; c < SEQ / ML_CH; ++c) {
            char* buf = lds + (c & 1) * ML_BUF;
            if (c + 1 < SEQ / ML_CH) ML_LOAD(c + 1);
            const float* Qs = (const float*)(buf + ML_Q) + lane * 4; const float* Ks = (const float*)(buf + ML_K) + lane * 4;
            const float* Vs = (const float*)(buf + ML_V) + wid * 4; const f32x2* FIs = (const f32x2*)(buf + ML_FI);
#pragma unroll 4
            for (int s = 0; s < ML_CH; ++s) {
                const f32x4 q4 = *(const f32x4*)(Qs + s * 256), k4 = *(const f32x4*)(Ks + s * 256), v4 = *(const f32x4*)(Vs + s * 32); const f32x2 fi = FIs[s];
                const f32x4 iv = v4 * fi.y;
                C0 = C0 * fi.x + iv * k4[0]; C1 = C1 * fi.x + iv * k4[1]; C2 = C2 * fi.x + iv * k4[2]; C3 = C3 * fi.x + iv * k4[3];
                f32x4 d = C0 * q4[0] + C1 * q4[1] + C2 * q4[2] + C3 * q4[3];
                float e0 = swap32_sum(d[0], d[2]), e1 = swap32_sum(d[1], d[3]);
                const float other = __shfl_xor((lane & 16) ? e0 : e1, 16);
                float r = ((lane & 16) ? e1 : e0) + other;
                r = row16_sum(r);
                if ((lane & 15) == 0) OUT[s * 32 + wid * 4 + (lane >> 5) * 2 + ((lane >> 4) & 1)] = r;
                if (denw) { n4 = n4 * fi.x + k4 * fi.y; float dn = n4[0] * q4[0] + n4[1] * q4[1] + n4[2] * q4[2] + n4[3] * q4[3];
                    dn = swap32_sum(dn, dn); dn += __shfl_xor(dn, 16); dn = row16_sum(dn); if (lane == 0) DENs[s] = dn; }
            }
            __syncthreads();
            if (tid < 128) { const float* o_ = OUT + vt * 32 + vp; float f[8];
#pragma unroll
                for (int j = 0; j < 8; ++j) f[j] = o_[j];
                *(bf16x8*)(hcat + (size_t)(b * SEQ + c * ML_CH + vt) * DM + h * 512 + sl * 32 + vp) = pack8f(f); }
            if (sl == 0 && tid < ML_CH) den[c * ML_CH + tid] = DENs[tid];
            if (c + 1 < SEQ / ML_CH) ML_STORE(lds + ((c + 1) & 1) * ML_BUF);
            __syncthreads();
        }
#undef ML_LOAD
#undef ML_STORE
    }
}

#define TRRD(dst, base, off) asm volatile("ds_read_b64_tr_b16 %0, %1 offset:%2" : "=&v"(dst) : "v"(base), "i"(off) : "memory")
#define TRRD(dst, base, off) asm volatile("ds_read_b64_tr_b16 %0, %1 offset:%2" : "=&v"(dst) : "v"(base), "i"(off) : "memory")
namespace mc {
constexpr int L_K = 0, L_Q = 32768, L_V = 65536, L_EV = 81920, L_CT = 98304, L_TAB = 114688, L_G = 116736;
constexpr int T_A = 0, T_AA = 64, T_INT = 128, T_E = 192;
__device__ __forceinline__ int kaddr(int s, int d) { return (d >> 7) * 16384 + s * 256 + (((d & 127) * 2) ^ ((s & 7) << 4)); }
}
#define MC_QF(d0) (*(const bf16x8*)(lds + L_Q + ((d0) >> 3) * 16384 + TB * 8192 + kq[(d0) & 3] + (((d0) >> 2) & 1) * 128))
template <int TB>
__device__ __forceinline__ void mc_inter(char* lds, float* TAB, const int (&kq)[4], int cfrag, int csw, int lane, int hi) {
    using namespace mc;
    f32x16 o = f32x16{};
    bf16x8 fq[2][2], fc[2][2];
#define MJ_LD(g) do { _Pragma("unroll") for (int e = 0; e < 2; ++e) { const int d0 = 2 * (g) + e; fq[(g) & 1][e] = MC_QF(d0); fc[(g) & 1][e] = *(const bf16x8*)(lds + L_CT + cfrag + (((d0 * 16 + hi * 8) * 2) ^ csw)); } } while (0)
#define MJ_MM(g) do { _Pragma("unroll") for (int e = 0; e < 2; ++e) o = __builtin_amdgcn_mfma_f32_32x32x16_bf16(fq[(g) & 1][e], fc[(g) & 1][e], o, 0, 0, 0); } while (0)
    MJ_LD(0); SBAR();
#pragma unroll
    for (int g = 0; g < 8; ++g) { if (g + 1 < 8) { MJ_LD(g + 1); } SBAR(); MJ_MM(g); SBAR(); }
#undef MJ_LD
#undef MJ_MM
    const float* ti = TAB + T_INT + TB * 32 + 4 * hi; float* G = (float*)(lds + L_G) + TB * 1024 + lane;
#pragma unroll
    for (int r = 0; r < 16; ++r) G[r * 64] = o[r] * ti[(r & 3) + 8 * (r >> 2)];
}
template <int TB>
__device__ __forceinline__ void mc_intra(char* lds, float* TAB, const int (&kq)[4], int vbV, int r32, int hi, f32x16& o, float& ps) {
    using namespace mc;
    const float LOG2E = 1.4426950408889634f;
    const int tl = TB * 32 + r32;
    f32x16 p0 = f32x16{}, p1 = f32x16{};
    bf16x8 fq[2][2], fa0[2][2], fa1[2][2];
#define MI_LD(g) do { _Pragma("unroll") for (int e = 0; e < 2; ++e) { const int d0 = 2 * (g) + e; const char* ap = lds + L_K + (d0 >> 3) * 16384 + kq[d0 & 3] + ((d0 >> 2) & 1) * 128; \
        fq[(g) & 1][e] = MC_QF(d0); fa0[(g) & 1][e] = *(const bf16x8*)ap; if constexpr (TB == 1) fa1[(g) & 1][e] = *(const bf16x8*)(ap + 8192); } } while (0)
#define MI_MM(g) do { _Pragma("unroll") for (int e = 0; e < 2; ++e) { p0 = __builtin_amdgcn_mfma_f32_32x32x16_bf16(fa0[(g) & 1][e], fq[(g) & 1][e], p0, 0, 0, 0); \
        if constexpr (TB == 1) p1 = __builtin_amdgcn_mfma_f32_32x32x16_bf16(fa1[(g) & 1][e], fq[(g) & 1][e], p1, 0, 0, 0); } } while (0)
    MI_LD(0); SBAR();
#pragma unroll
    for (int g = 0; g < 8; ++g) { if (g + 1 < 8) { MI_LD(g + 1); } SBAR(); MI_MM(g); SBAR(); }
#undef MI_LD
#undef MI_MM
    const float At = TAB[T_AA + tl];
    ps = 0.f;
    const float* ta = TAB + T_A + 4 * hi;
#pragma unroll
    for (int r = 0; r < 16; ++r) { const int s0 = fa::crow(r, hi), c0 = (r & 3) + 8 * (r >> 2);
        const float e0 = __builtin_amdgcn_exp2f((ta[c0] - At) * LOG2E) * 0.0625f; const float w0 = (s0 <= tl) ? e0 : 0.f; p0[r] *= w0; ps += p0[r];
        if constexpr (TB == 1) { const float e1 = __builtin_amdgcn_exp2f((ta[32 + c0] - At) * LOG2E) * 0.0625f; const float w1 = (s0 + 32 <= tl) ? e1 : 0.f; p1[r] *= w1; ps += p1[r]; } }
    { auto rr = __builtin_amdgcn_permlane32_swap(__float_as_uint(ps), __float_as_uint(ps), false, false); ps = __uint_as_float(rr[0]) + __uint_as_float(rr[1]); }
    bf16x8 pa0, pa1, pa2, pa3;
#define PK4(P, B_, OUT) do { unsigned a0 = fa::cvtpk(P[B_+0], P[B_+1]), a1 = fa::cvtpk(P[B_+2], P[B_+3]);                  \
        unsigned b0_ = fa::cvtpk(P[B_+4], P[B_+5]), b1_ = fa::cvtpk(P[B_+6], P[B_+7]);                                   \
        auto r0 = __builtin_amdgcn_permlane32_swap(a0, b0_, false, false); auto r1 = __builtin_amdgcn_permlane32_swap(a1, b1_, false, false); \
        u32x4 w = {r0[0], r1[0], r0[1], r1[1]}; OUT = *reinterpret_cast<bf16x8*>(&w); } while (0)
    PK4(p0, 0, pa0); PK4(p0, 8, pa1); PK4(p1, 0, pa2); PK4(p1, 8, pa3);
#undef PK4
    o = f32x16{};
    { s16x4 l0, l1, l2, l3, h0, h1, h2, h3;
      TRRD(l0, vbV, 0); TRRD(h0, vbV, 2048); TRRD(l1, vbV, 4096); TRRD(h1, vbV, 6144); TRRD(l2, vbV, 8192); TRRD(h2, vbV, 10240); TRRD(l3, vbV, 12288); TRRD(h3, vbV, 14336);
      asm volatile("s_waitcnt lgkmcnt(0)" ::: "memory"); SBAR();
      o = __builtin_amdgcn_mfma_f32_32x32x16_bf16(pa0, (bf16x8){l0[0], l0[1], l0[2], l0[3], h0[0], h0[1], h0[2], h0[3]}, o, 0, 0, 0);
      o = __builtin_amdgcn_mfma_f32_32x32x16_bf16(pa1, (bf16x8){l1[0], l1[1], l1[2], l1[3], h1[0], h1[1], h1[2], h1[3]}, o, 0, 0, 0);
      if constexpr (TB == 1) { o = __builtin_amdgcn_mfma_f32_32x32x16_bf16(pa2, (bf16x8){l2[0], l2[1], l2[2], l2[3], h2[0], h2[1], h2[2], h2[3]}, o, 0, 0, 0);
                               o = __builtin_amdgcn_mfma_f32_32x32x16_bf16(pa3, (bf16x8){l3[0], l3[1], l3[2], l3[3], h3[0], h3[1], h3[2], h3[3]}, o, 0, 0, 0); } }
}
#undef MC_QF
__device__ __forceinline__ void p4_mlstm_chunk(char* lds, const Args& a) {
    using namespace mc;
    const int tid = threadIdx.x, lane = tid & 63, wid = __builtin_amdgcn_readfirstlane(tid >> 6);
    const bf16_t* proj = (const bf16_t*)(a.ws + WS_R); bf16_t* hcat = (bf16_t*)a.out;
    float* TAB = (float*)(lds + L_TAB);
    const float LOG2E = 1.4426950408889634f;
    for (int unit = blockIdx.x; unit < 256; unit += gridDim.x) {
        const int bh = (gridDim.x == 256) ? 2 * (unit & 7) + (unit >> 7) : unit >> 4, sl = (gridDim.x == 256) ? (unit >> 3) & 15 : unit & 15, b = bh >> 2, h = bh & 3;
        const float* AT = (const float*)(a.ws + WS_AT) + (size_t)bh * SEQ; const float* AA = (const float*)(a.ws + WS_AA) + (size_t)bh * SEQ;
        float* deni = (float*)(a.ws + WS_DENI) + (size_t)bh * SEQ; float* denp = (float*)(a.ws + WS_DENP) + (size_t)(bh * 16 + sl) * SEQ;
        const int krow = tid >> 3, kch = (tid & 7) * 4, vrow = (tid >> 2) & 63, vch = tid & 3;
        const bf16_t* ksrc = proj + (size_t)(b * SEQ + krow) * AB_NP + AB_K + h * 256 + kch * 8;
        const bf16_t* qsrc = proj + (size_t)(b * SEQ + krow) * AB_NP + AB_Q + h * 256 + kch * 8;
        const bf16_t* vsrc = proj + (size_t)(b * SEQ + vrow) * AB_NP + AB_V + h * 512 + sl * 32 + vch * 8;
        int kdst[4];
#pragma unroll
        for (int i = 0; i < 4; ++i) { const int ch = kch + i; kdst[i] = (ch >> 4) * 16384 + KSWZ(krow, (ch & 15) * 16); }
        const int vdst = fa::v_st(vrow, vch * 8);
        bf16x8 rk[4], rq[4], rv; float pa_t = 0.f, pA_t = 0.f, pa_v = 0.f, pA_prev = 0.f, pA_end = 0.f;
#define MC_LOAD(c) do { const size_t o_ = (size_t)(c) * 64 * AB_NP; _Pragma("unroll") for (int i = 0; i < 4; ++i) { rk[i] = *(const bf16x8*)(ksrc + o_ + i * 8); rq[i] = *(const bf16x8*)(qsrc + o_ + i * 8); } \
        if (tid < 256) { rv = *(const bf16x8*)(vsrc + o_); pa_v = AT[(c) * 64 + vrow]; } if (tid < 64) { pa_t = AT[(c) * 64 + tid]; pA_t = AA[(c) * 64 + tid]; } \
        pA_end = AA[(c) * 64 + 63]; pA_prev = (c) > 0 ? AA[(c) * 64 - 1] : 0.f; } while (0)
        f32x16 Cacc = f32x16{};
        f32x16 oi = f32x16{}; float psi = 0.f;
        float nreg = 0.f;
        __syncthreads();
        for (int i = tid; i < 16384 / 16; i += NTHREADS) *(u32x4*)(lds + L_CT + i * 16) = (u32x4){0u, 0u, 0u, 0u};
        MC_LOAD(0);
        for (int c = 0; c < SEQ / 64; ++c) {
            const int t0 = c * 64;
            const float A_prev = pA_prev, A_end = pA_end;
            asm volatile("s_waitcnt vmcnt(0)" ::: "memory");
#pragma unroll
            for (int i = 0; i < 4; ++i) { *(bf16x8*)(lds + L_K + kdst[i]) = rk[i]; *(bf16x8*)(lds + L_Q + kdst[i]) = rq[i]; }
            if (tid < 256) { *(bf16x8*)(lds + L_V + vdst) = rv; const float e = __builtin_amdgcn_exp2f((pa_v - A_end) * LOG2E) * 0.0625f;
                float f[8]; unpack8(rv, f);
#pragma unroll
                for (int j = 0; j < 8; ++j) f[j] *= e;
                *(bf16x8*)(lds + L_EV + vdst) = pack8f(f); }
            if (tid < 64) { TAB[T_A + tid] = pa_t; TAB[T_AA + tid] = pA_t; TAB[T_INT + tid] = __builtin_amdgcn_exp2f((A_prev - pA_t) * LOG2E); TAB[T_E + tid] = __builtin_amdgcn_exp2f((pa_t - A_end) * LOG2E) * 0.0625f; }
            __syncthreads();
            if (c + 1 < SEQ / 64) MC_LOAD(c + 1);
            const float decay = __builtin_amdgcn_exp2f((A_prev - A_end) * LOG2E);
            int lane_o = lane; asm volatile("" : "+v"(lane_o));
            const int r32 = lane_o & 31, hi = lane_o >> 5;
            int kq[4];
#pragma unroll
            for (int dd = 0; dd < 4; ++dd) kq[dd] = KSWZ(r32, dd * 32 + hi * 16);
            const int cfrag = r32 * 512, csw = (r32 & 15) << 4;
            const int trq = (lane_o & 15) >> 2, trp = lane_o & 3, trg = (lane_o >> 4) & 1;
            const int vbV = (int)(uintptr_t)lds + L_V + fa::v_rd_base(lane_o), vbE = (int)(uintptr_t)lds + L_EV + fa::v_rd_base(lane_o);
            if (wid == 0) mc_intra<0>(lds, TAB, kq, vbV, r32, hi, oi, psi);
            else if (wid == 1) mc_intra<1>(lds, TAB, kq, vbV, r32, hi, oi, psi);
            else if (wid == 2) mc_inter<0>(lds, TAB, kq, cfrag, csw, lane_o, hi);
            else if (wid == 3) mc_inter<1>(lds, TAB, kq, cfrag, csw, lane_o, hi);
            if (wid == 7) {
                const int d0_ = 16 * sl;
                float qv[16]; { float f[8]; unpack8(*(const bf16x8*)(lds + L_Q + kaddr(lane, d0_)), f);
#pragma unroll
                    for (int j = 0; j < 8; ++j) qv[j] = f[j];
                    unpack8(*(const bf16x8*)(lds + L_Q + kaddr(lane, d0_ + 8)), f);
#pragma unroll
                    for (int j = 0; j < 8; ++j) qv[8 + j] = f[j]; }
                float dsum = 0.f;
#pragma unroll
                for (int d = 0; d < 16; ++d) dsum += qv[d] * __int_as_float(__builtin_amdgcn_readlane(__float_as_int(nreg), d));
                denp[t0 + lane] = dsum * TAB[T_INT + lane];
                const int dd = lane & 15, sq = lane >> 4; float part = 0.f;
#pragma unroll
                for (int j = 0; j < 16; ++j) { const int s = sq * 16 + j; part += TAB[T_E + s] * bf2f(*(const bf16_t*)(lds + L_K + kaddr(s, d0_ + dd))); }
                part += __shfl_xor(part, 16); part += __shfl_xor(part, 32);
                nreg = nreg * decay + part;
            }
            {
#pragma unroll
                for (int r = 0; r < 16; ++r) Cacc[r] *= decay;
                s16x4 l0, l1, l2, l3, h0, h1, h2, h3;
                TRRD(l0, vbE, 0); TRRD(h0, vbE, 2048); TRRD(l1, vbE, 4096); TRRD(h1, vbE, 6144); TRRD(l2, vbE, 8192); TRRD(h2, vbE, 10240); TRRD(l3, vbE, 12288); TRRD(h3, vbE, 14336);
                s16x4 ka[4][2];
                { const int d = 32 * wid + trg * 16 + 4 * trp;
                  const int ad0 = (int)(uintptr_t)lds + L_K + kaddr(8 * hi + trq, d), ad1 = (int)(uintptr_t)lds + L_K + kaddr(8 * hi + 4 + trq, d);
                  TRRD(ka[0][0], ad0, 0); TRRD(ka[0][1], ad1, 0); TRRD(ka[1][0], ad0, 4096); TRRD(ka[1][1], ad1, 4096);
                  TRRD(ka[2][0], ad0, 8192); TRRD(ka[2][1], ad1, 8192); TRRD(ka[3][0], ad0, 12288); TRRD(ka[3][1], ad1, 12288); }
                asm volatile("s_waitcnt lgkmcnt(0)" ::: "memory"); SBAR();
#define KAF(ks) (bf16x8){ka[ks][0][0], ka[ks][0][1], ka[ks][0][2], ka[ks][0][3], ka[ks][1][0], ka[ks][1][1], ka[ks][1][2], ka[ks][1][3]}
                Cacc = __builtin_amdgcn_mfma_f32_32x32x16_bf16(KAF(0), (bf16x8){l0[0], l0[1], l0[2], l0[3], h0[0], h0[1], h0[2], h0[3]}, Cacc, 0, 0, 0);
                Cacc = __builtin_amdgcn_mfma_f32_32x32x16_bf16(KAF(1), (bf16x8){l1[0], l1[1], l1[2], l1[3], h1[0], h1[1], h1[2], h1[3]}, Cacc, 0, 0, 0);
                Cacc = __builtin_amdgcn_mfma_f32_32x32x16_bf16(KAF(2), (bf16x8){l2[0], l2[1], l2[2], l2[3], h2[0], h2[1], h2[2], h2[3]}, Cacc, 0, 0, 0);
                Cacc = __builtin_amdgcn_mfma_f32_32x32x16_bf16(KAF(3), (bf16x8){l3[0], l3[1], l3[2], l3[3], h3[0], h3[1], h3[2], h3[3]}, Cacc, 0, 0, 0);
#undef KAF
            }
            __syncthreads();
            float one = 1.0f; asm volatile("" : "+v"(one));
#pragma unroll
            for (int g = 0; g < 4; ++g) { const int d4 = 32 * wid + 8 * g + 4 * hi; u32x2 w; w.x = cvt_pk_bf16(Cacc[4 * g] * one, Cacc[4 * g + 1] * one); w.y = cvt_pk_bf16(Cacc[4 * g + 2] * one, Cacc[4 * g + 3] * one);
                *(u32x2*)(lds + L_CT + cfrag + ((d4 * 2) ^ csw)) = w; }
            if (wid < 2) {
                const float* G = (const float*)(lds + L_G) + wid * 1024 + lane_o;
                bf16_t* ob = hcat + (size_t)(b * SEQ + t0 + wid * 32) * DM + h * 512 + sl * 32;
                const int lofs = hi * 4 * DM + r32;
#pragma unroll
                for (int r = 0; r < 16; ++r) { const float v = oi[r] + G[r * 64], vn = dpp_xor1(v);
                    if ((r32 & 1) == 0) *(unsigned*)((ob + (size_t)((r & 3) + 8 * (r >> 2)) * DM) + lofs) = cvt_pk_bf16(v, vn); }
                if (sl == 0 && hi == 0) deni[t0 + wid * 32 + r32] = psi;
            }
        }
#undef MC_LOAD
        __syncthreads();
    }
}
#undef TRRD

__device__ __forceinline__ void p5_mlstm_norm(const Args& a) {
    const int tid = threadIdx.x, lane = tid & 63, wid = tid >> 6;
    const int gw = blockIdx.x * 8 + wid, nw = gridDim.x * 8;
    const bf16_t* proj = (const bf16_t*)(a.ws + WS_R); bf16_t* hcat = (bf16_t*)a.out;
    const float* den = (const float*)(a.ws + WS_DEN); const float* fl = (const float*)(a.ws + WS_FLOOR); const float* mn = a.in[4];
    for (int it = gw; it < M_TOK * 4; it += nw) {
        const int tk = it >> 2, h = it & 3, b = tk >> 12, t = tk & (SEQ - 1), bh = b * 4 + h;
        bf16_t* hp = hcat + (size_t)tk * DM + h * 512 + lane * 8;
        float x[8], og[8];
        unpack8(*(const bf16x8*)hp, x); unpack8(*(const bf16x8*)(proj + (size_t)tk * AB_NP + AB_OG + h * 512 + lane * 8), og);
#if MLSTM_CHUNK && !MLSTM_BOTH && (DEBUG_CMP < 0)
        float dsum = ((const float*)(a.ws + WS_DENI))[(size_t)bh * SEQ + t];
#pragma unroll
        for (int q = 0; q < 16; ++q) dsum += ((const float*)(a.ws + WS_DENP))[(size_t)(bh * 16 + q) * SEQ + t];
#else
        const float dsum = den[(size_t)bh * SEQ + t];
#endif
        const float dd = fmaxf(fabsf(dsum), fl[(size_t)bh * SEQ + t]); const float inv = 1.0f / dd;
        float s = 0.f;
#pragma unroll
        for (int j = 0; j < 8; ++j) { x[j] *= inv; s += x[j] * x[j]; }
        s = wave_sum(s);
        const float r = rsqrtf(s * (1.0f / 512.0f) + RMS_EPS);
#pragma unroll
        for (int j = 0; j < 8; ++j) x[j] = x[j] * r * mn[h * 512 + lane * 8 + j] * sigmoid_f(og[j]);
        *(bf16x8*)hp = pack8f(x);
    }
}
__device__ __forceinline__ int xcd_unit(int k, int per, int groups, int upg) {
    const int w = blockIdx.x, G = gridDim.x;
    if (G != 256 || per * 256 != groups * upg) return w + k * G;
    const int j = w & 7, s = w >> 3, lu = k * 32 + s;
    return (j * (groups >> 3) + lu / upg) * upg + lu % upg;
}
__device__ __forceinline__ void p5_mla(char* lds, const Args& a) {
    const int tid = threadIdx.x, wid = __builtin_amdgcn_readfirstlane(tid >> 6), lane = tid & 63, r32 = lane & 31, hi = lane >> 5;
    const bf16_t* qb = (const bf16_t*)(a.ws + WS_QB); const bf16_t* kvb = (const bf16_t*)(a.ws + WS_KVB); const bf16_t* krope = (const bf16_t*)(a.ws + WS_KROPE);
    bf16_t* hcat = (bf16_t*)a.out;     const f32x2* rp = (const f32x2*)(a.ws + WS_ROPE);
    for (int kk = 0; kk * (int)gridDim.x < 64 * 8 * 2; ++kk) {
        const int it2 = xcd_unit(kk >> 1, 2, 64, 8), pass = kk & 1; if (it2 >= 512) break;
        const int bh = it2 >> 3, x = it2 & 7, b = bh >> 4, h = bh & 15;
        const int qblk = pass ? 15 - x : x, t0 = qblk * 256, pos = t0 + wid * 32 + r32;
        const bf16_t* qrow = qb + (size_t)(b * SEQ + pos) * 3072 + h * 192;
        bf16x8 qr[8], qrr[4];
#pragma unroll
        for (int d0 = 0; d0 < 8; ++d0) qr[d0] = *(const bf16x8*)(qrow + d0 * 16 + hi * 8);
#pragma unroll
        for (int d0 = 0; d0 < 4; ++d0) qrr[d0] = *(const bf16x8*)(qrow + 128 + d0 * 16 + hi * 8);
#pragma unroll
        for (int g = 0; g < 2; ++g) { float x1[8], x2[8], o1[8], o2[8]; unpack8(qrr[g], x1); unpack8(qrr[2 + g], x2);
#pragma unroll
            for (int j = 0; j < 8; ++j) { const f32x2 cs = rp[(size_t)pos * 32 + g * 16 + hi * 8 + j]; o1[j] = x1[j] * cs.x - x2[j] * cs.y; o2[j] = x1[j] * cs.y + x2[j] * cs.x; }
            char* qpark = lds + fa::OFF_QPARK + wid * 4096 + lane * 16;
            *(bf16x8*)(qpark + g * 1024) = pack8f(o1); *(bf16x8*)(qpark + (2 + g) * 1024) = pack8f(o2); }
        fa::FUnit u; u.Kb = kvb + (size_t)(b * SEQ) * 4096 + h * 256; u.ldk = 4096; u.Vb = u.Kb + 128; u.ldv = 4096; u.KRb = krope + (size_t)(b * SEQ) * 64;
        u.j_lo = 0; u.j_hi = (t0 + 255) / 64 + 1; u.qlo = t0 + wid * 32; u.qhi = u.qlo + 31; u.qpos = pos; u.sel = 0ull;
        f32x16 o[4]; float m_reg, l_reg;
        fa::flash_core<0>(lds, u, qr, 0.07216878364870322f, o, m_reg, l_reg);
        float rf[16]; fa::row_factors(lds, wid, r32, hi, 1.0f / l_reg, rf);
        bf16_t* ob = hcat + (size_t)(b * SEQ + t0 + wid * 32) * DM + 2048 + h * 128;
#pragma unroll
        for (int r = 0; r < 16; ++r) { const int orow = fa::crow(r, hi);
#pragma unroll
            for (int d0 = 0; d0 < 4; ++d0) { const float v = o[d0][r] * rf[r]; const float vn = __shfl_xor(v, 1);
                if ((r32 & 1) == 0) *(unsigned*)(ob + (size_t)orow * DM + d0 * 32 + r32) = cvt_pk_bf16(v, vn); } }
        __syncthreads();
    }
}

__device__ __forceinline__ void p7_layernorm(const Args& a, int layer_idx, bool mix, const float* z, float* outf, bf16_t* outb, f32x2* stats) {
    const int tid = threadIdx.x, lane = tid & 63, wid = tid >> 6;
    const int gw = blockIdx.x * 8 + wid, nw = gridDim.x * 8;
    const float* g = (mix ? a.in[22] : a.in[24]) + (size_t)layer_idx * DM; const float* bb = (mix ? a.in[23] : a.in[25]) + (size_t)layer_idx * DM;
    for (int row = gw; row < M_TOK; row += nw) {
        const float* zr = z + (size_t)row * DM;
        f32x4 v[16]; float s = 0.f;
#pragma unroll
        for (int i = 0; i < 16; ++i) { v[i] = *(const f32x4*)(zr + i * 256 + lane * 4); s += (v[i][0] + v[i][1]) + (v[i][2] + v[i][3]); }
        s = wave_sum(s); const float mu = s * (1.0f / DM);
        float q = 0.f;
#pragma unroll
        for (int i = 0; i < 16; ++i) { const f32x4 d = v[i] - mu; q += (d[0] * d[0] + d[1] * d[1]) + (d[2] * d[2] + d[3] * d[3]); }
        q = wave_sum(q); const float rs = rsqrtf(q * (1.0f / DM) + LN_EPS);
        if (stats && lane == 0) stats[row] = (f32x2){mu, rs};
#pragma unroll
        for (int i = 0; i < 16; ++i) { const int c = i * 256 + lane * 4; const f32x4 gg = *(const f32x4*)(g + c), be = *(const f32x4*)(bb + c);
            const f32x4 y = (v[i] - mu) * rs * gg + be;
            if (outf) *(f32x4*)(outf + (size_t)row * DM + c) = y;
            if (outb) { u32x2 w; w.x = cvt_pk_bf16(y[0], y[1]); w.y = cvt_pk_bf16(y[2], y[3]); *(u32x2*)(outb + (size_t)row * DM + c) = w; } }
    }
}
__device__ __forceinline__ void p7_layernorm_b(const Args& a, int layer_idx, bool mix, const bf16_t* zb, float* outf, bf16_t* outb, f32x2* stats) {
    const int tid = threadIdx.x, lane = tid & 63, wid = tid >> 6;
    const int gw = blockIdx.x * 8 + wid, nw = gridDim.x * 8;
    const float* g = (mix ? a.in[22] : a.in[24]) + (size_t)layer_idx * DM; const float* bb = (mix ? a.in[23] : a.in[25]) + (size_t)layer_idx * DM;
    bf16x8 nx[8];
    if (gw < M_TOK) {
#pragma unroll
        for (int i = 0; i < 8; ++i) nx[i] = *(const bf16x8*)(zb + (size_t)gw * DM + i * 512 + lane * 8); }
    for (int row = gw; row < M_TOK; row += nw) {
        float v[8][8]; float s = 0.f;
#pragma unroll
        for (int i = 0; i < 8; ++i) { unpack8h(nx[i], v[i]); s += ((v[i][0] + v[i][1]) + (v[i][2] + v[i][3])) + ((v[i][4] + v[i][5]) + (v[i][6] + v[i][7])); }
        { const int rn = row + nw < M_TOK ? row + nw : row;
#pragma unroll
          for (int i = 0; i < 8; ++i) nx[i] = *(const bf16x8*)(zb + (size_t)rn * DM + i * 512 + lane * 8); }
        s = wave_sum(s); const float mu = s * (1.0f / DM);
        float q = 0.f;
#pragma unroll
        for (int i = 0; i < 8; ++i)
#pragma unroll
            for (int j = 0; j < 8; ++j) { const float d = v[i][j] - mu; q += d * d; }
        q = wave_sum(q); const float rs = rsqrtf(q * (1.0f / DM) + LN_EPS);
        if (stats && lane == 0) stats[row] = (f32x2){mu, rs};
#pragma unroll
        for (int i = 0; i < 8; ++i) { const int c = i * 512 + lane * 8; const f32x4 g0 = *(const f32x4*)(g + c), g1 = *(const f32x4*)(g + c + 4), b0 = *(const f32x4*)(bb + c), b1 = *(const f32x4*)(bb + c + 4);
            float y[8];
#pragma unroll
            for (int j = 0; j < 4; ++j) { y[j] = (v[i][j] - mu) * rs * g0[j] + b0[j]; y[4 + j] = (v[i][4 + j] - mu) * rs * g1[j] + b1[j]; }
            if (outf) { *(f32x4*)(outf + (size_t)row * DM + c) = (f32x4){y[0], y[1], y[2], y[3]}; *(f32x4*)(outf + (size_t)row * DM + c + 4) = (f32x4){y[4], y[5], y[6], y[7]}; }
            if (outb) *(bf16x8*)(outb + (size_t)row * DM + c) = pack8f(y); }
    }
}
__device__ __forceinline__ void p12_blocks(const Args& a) {
    const bf16_t* projc = (const bf16_t*)(a.ws + WS_R);
    const size_t gt = (size_t)blockIdx.x * NTHREADS + threadIdx.x, gs = (size_t)gridDim.x * NTHREADS;
    for (size_t i = gt; i < (size_t)2 * 4096 * 512; i += gs) {
        const int which = (int)(i / ((size_t)4096 * 512)); const int rem = (int)(i % ((size_t)4096 * 512));
        const int r = rem >> 9, l = (rem >> 4) & 31, d8 = rem & 15, g = r & 3, n = (r >> 2) & 255, b = r >> 10;
        bf16_t* A = (bf16_t*)(a.ws + (which ? WS_AV : WS_AK)); const float* pe = which ? a.in[13] : a.in[12];
        float f[8];
        if (n < 255) { unpack8(*(const bf16x8*)(projc + (size_t)(b * SEQ + 16 * n + l) * C_NP + (which ? C_VC : C_KC) + g * 128 + d8 * 8), f);
#pragma unroll
            for (int j = 0; j < 8; ++j) f[j] += pe[l * 128 + d8 * 8 + j]; }
        else {
#pragma unroll
            for (int j = 0; j < 8; ++j) f[j] = 0.f; }
        *(bf16x8*)(A + (size_t)r * 4096 + l * 128 + d8 * 8) = pack8f(f);
    }
}
__device__ __forceinline__ float nsa_gate(const Args& a, int token, int br, int head) {
    const bf16_t* projc = (const bf16_t*)(a.ws + WS_R);
    return sigmoid_f(bf2f(projc[(size_t)token * C_NP + C_GATE + br * 32 + head]) + a.in[11][br * 32 + head]);
}
__device__ __forceinline__ void p15_cmp_attn(char* lds, const Args& a) {
    const int tid = threadIdx.x, wid = __builtin_amdgcn_readfirstlane(tid >> 6), lane = tid & 63, r32 = lane & 31, hi = lane >> 5;
    const bf16_t* projc = (const bf16_t*)(a.ws + WS_R); const bf16_t* kcmp = (const bf16_t*)(a.ws + WS_KCMP); const bf16_t* vcmp = (const bf16_t*)(a.ws + WS_VCMP);
    float* acc = (float*)(a.ws + WS_Z); unsigned long long* selp = (unsigned long long*)(a.ws + WS_SEL);
    const float scale = 0.08838834764831845f, C2 = 1.4426950408889634f * scale;
    float* IMP = (float*)(lds + fa::OFF_IMP);
    for (int kk = 0; kk * (int)gridDim.x < 2048; ++kk) {
        const int unit = xcd_unit(kk, 8, 16, 128); if (unit >= 2048) break;
        const int bg = unit >> 7, xb = unit & 127, b = bg >> 2, g = bg & 3, t0 = xb * 32;
        const int tokl = wid * 4 + (r32 >> 3), head = g * 8 + (r32 & 7), tq = t0 + tokl;
        const bf16_t* qrow = projc + (size_t)(b * SEQ + tq) * C_NP + C_Q + head * 128;
        bf16x8 qr[8];
#pragma unroll
        for (int d0 = 0; d0 < 8; ++d0) qr[d0] = *(const bf16x8*)(qrow + d0 * 16 + hi * 8);
        fa::FUnit u; u.Kb = kcmp + (size_t)(b * 256 * 4 + g) * 256; u.ldk = 1024; u.Vb = vcmp + (size_t)(b * 256 * 4 + g) * 256; u.ldv = 1024; u.KRb = nullptr;
        const int nmax_hi = (t0 + 31 - 31) >> 4;
        u.j_lo = 0; u.j_hi = (nmax_hi >> 6) + 1; u.qlo = (t0 + wid * 4 - 31) >> 4; u.qhi = (t0 + wid * 4 + 3 - 31) >> 4; u.qpos = (tq - 31) >> 4; u.sel = 0ull;
        f32x16 o[4]; float m_reg, l_reg;
        fa::flash_core<3>(lds, u, qr, scale, o, m_reg, l_reg);
        const float inv_l = l_reg > 0.f ? 1.0f / l_reg : 0.f;
        { float rf[16]; fa::row_factors(lds, wid, r32, hi, inv_l * nsa_gate(a, b * SEQ + tq, 0, head), rf);
#pragma unroll
          for (int r = 0; r < 16; ++r) { const int orow = fa::crow(r, hi); const int tk = t0 + wid * 4 + (orow >> 3), hd = g * 8 + (orow & 7);
              float* op = acc + (size_t)(b * SEQ + tk) * DM + hd * 128 + r32;
#pragma unroll
              for (int d0 = 0; d0 < 4; ++d0) op[d0 * 32] = o[d0][r] * rf[r]; } }
        __syncthreads();
        const float mL = -m_reg * C2;
        const int sr = tid >> 4, sc = (tid & 15) * 8, kws = KSWZ(sr, sc * 2);
        for (int t = 0; t < u.j_hi; ++t) {
            const int kb = t * 64;
            const bf16x8 k0 = *(const bf16x8*)(u.Kb + (long)(kb + sr) * u.ldk + sc), k1 = *(const bf16x8*)(u.Kb + (long)(kb + 32 + sr) * u.ldk + sc);
            *(bf16x8*)(lds + fa::OFF_K + kws) = k0; *(bf16x8*)(lds + fa::OFF_K + kws + 32 * 256) = k1;
            __syncthreads();
            f32x16 p0, p1; fa::qkt<0, false, true>(p0, p1, lds, r32, hi, qr);
            fa::mask_tile(p0, p1, u.qpos - kb - 4 * hi, 0x80000000u);
#pragma unroll
            for (int r = 0; r < 16; ++r) {
                float a0 = __builtin_amdgcn_exp2f(fmaf(p0[r], C2, mL)) * inv_l, a1 = __builtin_amdgcn_exp2f(fmaf(p1[r], C2, mL)) * inv_l;
                a0 += dpp_xor1(a0); a0 += dpp_xor2(a0); a0 += dpp_hmir(a0);
                a1 += dpp_xor1(a1); a1 += dpp_xor2(a1); a1 += dpp_hmir(a1);
                if ((r32 & 7) == 0) { const int n = kb + fa::crow(r, hi); IMP[tokl * fa::IMP_LD + n] = a0; IMP[tokl * fa::IMP_LD + n + 32] = a1; }
            }
            __syncthreads();
        }
        for (int q4 = 0; q4 < 4; ++q4) {
            const int tl = wid * 4 + q4, tqq = t0 + tl, cur = tqq >> 6, s = lane;
            float v = 0.f;
#pragma unroll
            for (int dn = -1; dn <= 3; ++dn) { const int n = 4 * s + dn; if (n >= 0 && n <= 254 && n < u.j_hi * 64) v += IMP[tl * fa::IMP_LD + n]; }
            if (s == 0 || s == cur || s == cur - 1) v = 1e9f;
            if (s > cur) v = -1e30f;
            int rank = 0;
#pragma nounroll
            for (int j = 0; j < 64; ++j) { const float vj = __int_as_float(__builtin_amdgcn_readlane(__float_as_int(v), j)); rank += (vj > v || (vj == v && j < s)) ? 1 : 0; }
            const unsigned long long msk = __ballot(rank < 16);
            if (lane == 0) selp[(size_t)bg * SEQ + tqq] = msk;
        }
        __syncthreads();
    }
}
template <int MODE, int VAR = 0>
__device__ __forceinline__ void p16_nsa_attn(char* lds, const Args& a) {
    const int tid = threadIdx.x, wid = __builtin_amdgcn_readfirstlane(tid >> 6), lane = tid & 63, r32 = lane & 31, hi = lane >> 5;
    const bf16_t* projc = (const bf16_t*)(a.ws + WS_R); float* acc = (float*)(a.ws + WS_Z); bf16_t* hcat = (bf16_t*)a.out;
    const unsigned long long* selp = (const unsigned long long*)(a.ws + WS_SEL);
    const float scale = 0.08838834764831845f;
    const int nitems = (MODE == 2) ? 2048 : 2048;
    for (int kk = 0; kk * (int)gridDim.x < nitems; ++kk) {
        int bg, xb;
        if (MODE == 2) { const int pass = kk & 1, it2 = xcd_unit(kk >> 1, 4, 16, 64); if (it2 >= 1024) break; bg = it2 >> 6; const int x = it2 & 63; xb = pass ? 127 - x : x; }
        else { const int item = xcd_unit(kk, 8, 16, 128); if (item >= 2048) break; bg = item >> 7; xb = item & 127; }
        const int b = bg >> 2, g = bg & 3, t0 = xb * 32, head = g * 8 + wid, tq = t0 + r32;
        const bf16_t* qrow = projc + (size_t)(b * SEQ + tq) * C_NP + C_Q + head * 128;
        bf16x8 qr[8];
#pragma unroll
        for (int d0 = 0; d0 < 8; ++d0) qr[d0] = *(const bf16x8*)(qrow + d0 * 16 + hi * 8);
        fa::FUnit u; u.KRb = nullptr; u.ldk = C_NP; u.ldv = C_NP; u.qlo = t0; u.qhi = t0 + 31; u.qpos = tq; u.sel = 0ull;
        if (MODE == 1) { u.Kb = projc + (size_t)(b * SEQ) * C_NP + C_KW + g * 128; u.Vb = projc + (size_t)(b * SEQ) * C_NP + C_VW + g * 128;
            const int lowk = t0 - 511; u.j_lo = lowk > 0 ? lowk / 64 : 0; u.j_hi = (t0 + 31) / 64 + 1; }
        else { u.Kb = projc + (size_t)(b * SEQ) * C_NP + C_KS + g * 128; u.Vb = projc + (size_t)(b * SEQ) * C_NP + C_VS + g * 128;
            u.j_lo = 0; u.j_hi = (t0 + 31) / 64 + 1; u.sel = selp[(size_t)bg * SEQ + tq]; }
        f32x16 o[4]; float m_reg, l_reg;
#if FLASH2
        fa::flash_core2<MODE>(lds, u, qr, scale, o, m_reg, l_reg);
#else
        fa::flash_core<MODE, VAR>(lds, u, qr, scale, o, m_reg, l_reg);
#endif
        float rf[16]; fa::row_factors(lds, wid, r32, hi, nsa_gate(a, b * SEQ + tq, MODE == 1 ? 2 : 1, head) / l_reg, rf);
        if (VAR != 0) { float sink = 0.f; for (int d0 = 0; d0 < 4; ++d0) for (int r = 0; r < 16; ++r) sink += o[d0][r] * rf[r]; if (sink == 1.2345e-30f) acc[0] = sink; __syncthreads(); continue; }
        const size_t off0 = (size_t)(b * SEQ + t0 + 4 * hi) * DM + head * 128 + r32;
        float av[16][4];
#pragma unroll
        for (int r = 0; r < 16; ++r)
#pragma unroll
            for (int d0 = 0; d0 < 4; ++d0) av[r][d0] = acc[off0 + (size_t)((r & 3) + 8 * (r >> 2)) * DM + d0 * 32];
        asm volatile("" ::: "memory");
#pragma unroll
        for (int r = 0; r < 16; ++r) { const size_t off = off0 + (size_t)((r & 3) + 8 * (r >> 2)) * DM;
#pragma unroll
            for (int d0 = 0; d0 < 4; ++d0) { const float v = av[r][d0] + o[d0][r] * rf[r];
                if (MODE == 1) acc[off + d0 * 32] = v;
                else { const float vn = dpp_xor1(v); if ((r32 & 1) == 0) *(unsigned*)(hcat + off + d0 * 32) = cvt_pk_bf16(v, vn); } } }
        __syncthreads();
    }
}
__device__ __forceinline__ void p1617_nsa_attn(char* lds, const Args& a) {
    const int tid = threadIdx.x, wid = __builtin_amdgcn_readfirstlane(tid >> 6), lane = tid & 63, r32 = lane & 31, hi = lane >> 5;
    const bf16_t* projc = (const bf16_t*)(a.ws + WS_R); const float* acc = (const float*)(a.ws + WS_Z); bf16_t* hcat = (bf16_t*)a.out;
    const unsigned long long* selp = (const unsigned long long*)(a.ws + WS_SEL);
    const float scale = 0.08838834764831845f;
    unsigned* park = (unsigned*)(lds + fa::OFF_IMP) + wid * 2048 + lane;
    static_assert(fa::OFF_IMP + 8 * 8192 <= fa::LDS_END, "park region");
    for (int kk = 0; kk * (int)gridDim.x < 2048; ++kk) {
        const int pass = kk & 1, it2 = xcd_unit(kk >> 1, 4, 16, 64); if (it2 >= 1024) break;
        const int bg = it2 >> 6, x = it2 & 63, xb = pass ? 127 - x : x;
        const int b = bg >> 2, g = bg & 3, t0 = xb * 32, head = g * 8 + wid, tq = t0 + r32;
        const bf16_t* qrow = projc + (size_t)(b * SEQ + tq) * C_NP + C_Q + head * 128;
        bf16x8 qr[8];
#pragma unroll
        for (int d0 = 0; d0 < 8; ++d0) qr[d0] = *(const bf16x8*)(qrow + d0 * 16 + hi * 8);
        fa::FUnit u; u.KRb = nullptr; u.ldk = C_NP; u.ldv = C_NP; u.qlo = t0; u.qhi = t0 + 31; u.qpos = tq; u.sel = 0ull;
        f32x16 o[4]; float m_reg, l_reg; float rf[16];
        { u.Kb = projc + (size_t)(b * SEQ) * C_NP + C_KW + g * 128; u.Vb = projc + (size_t)(b * SEQ) * C_NP + C_VW + g * 128;
          const int lowk = t0 - 511; u.j_lo = lowk > 0 ? lowk / 64 : 0; u.j_hi = (t0 + 31) / 64 + 1; }
        fa::flash_core<1, 0>(lds, u, qr, scale, o, m_reg, l_reg);
        fa::row_factors(lds, wid, r32, hi, nsa_gate(a, b * SEQ + tq, 2, head) / l_reg, rf);
#pragma unroll
        for (int d0 = 0; d0 < 4; ++d0)
#pragma unroll
            for (int r = 0; r < 16; r += 2) park[(d0 * 8 + (r >> 1)) * 64] = cvt_pk_bf16(o[d0][r] * rf[r], o[d0][r + 1] * rf[r + 1]);
        __syncthreads();
        u.Kb = projc + (size_t)(b * SEQ) * C_NP + C_KS + g * 128; u.Vb = projc + (size_t)(b * SEQ) * C_NP + C_VS + g * 128;
        u.j_lo = 0; u.j_hi = (t0 + 31) / 64 + 1; u.sel = selp[(size_t)bg * SEQ + tq];
        fa::flash_core<2, 0>(lds, u, qr, scale, o, m_reg, l_reg);
        fa::row_factors(lds, wid, r32, hi, nsa_gate(a, b * SEQ + tq, 1, head) / l_reg, rf);
        const size_t off0 = (size_t)(b * SEQ + t0 + 4 * hi) * DM + head * 128 + r32;
        float av[16][4];
#pragma unroll
        for (int r = 0; r < 16; ++r)
#pragma unroll
            for (int d0 = 0; d0 < 4; ++d0) av[r][d0] = acc[off0 + (size_t)((r & 3) + 8 * (r >> 2)) * DM + d0 * 32];
        asm volatile("" ::: "memory");
#pragma unroll
        for (int r = 0; r < 16; r += 2) {
#pragma unroll
            for (int d0 = 0; d0 < 4; ++d0) { const unsigned pw = park[(d0 * 8 + (r >> 1)) * 64];
#pragma unroll
                for (int e = 0; e < 2; ++e) { const int rr = r + e; const size_t off = off0 + (size_t)((rr & 3) + 8 * (rr >> 2)) * DM;
                    const float v = av[rr][d0] + __uint_as_float(e ? (pw & 0xffff0000u) : (pw << 16)) + o[d0][rr] * rf[rr];
                    const float vn = dpp_xor1(v); if ((r32 & 1) == 0) *(unsigned*)(hcat + off + d0 * 32) = cvt_pk_bf16(v, vn); } } }
        __syncthreads();
    }
}
__device__ __forceinline__ void p15_17_nsa(char* lds, const Args& a) {
    const int tid = threadIdx.x, wid = __builtin_amdgcn_readfirstlane(tid >> 6), lane = tid & 63;
    const bf16_t* projc = (const bf16_t*)(a.ws + WS_R); const bf16_t* kcmp = (const bf16_t*)(a.ws + WS_KCMP); const bf16_t* vcmp = (const bf16_t*)(a.ws + WS_VCMP); bf16_t* hcat = (bf16_t*)a.out;
    const float scale = 0.08838834764831845f, C2 = 1.4426950408889634f * scale;
    constexpr int ILD = 256;
    float* IMP = (float*)(lds + fa::OFF_V);
    unsigned long long* SELM = (unsigned long long*)(lds + fa::OFF_KR);
    char* PARK = lds + fa::OFF_IMP;
    static_assert(fa::OFF_IMP + 8 * 8192 <= fa::LDS_END, "park region");
    for (int kk = 0; kk * (int)gridDim.x < 2048; ++kk) {
        int lk = lane; asm volatile("" : "+v"(lk));
        const int pass = kk & 1, it2 = xcd_unit(kk >> 1, 4, 16, 64); if (it2 >= 1024) break;
        const int bg = it2 >> 6, x = it2 & 63, xb = pass ? 127 - x : x;
        const int b = bg >> 2, g = bg & 3, t0 = xb * 32;
        f32x16 o[4]; float m_reg, l_reg; float rf[16];
        fa::FUnit u;
        {
        const int tokl = wid * 4 + ((lk & 31) >> 3), head = g * 8 + (lk & 7), tq = t0 + tokl;
        const bf16_t* qrow = projc + (size_t)(b * SEQ + tq) * C_NP + C_Q + head * 128;
        bf16x8 qr[8];
#pragma unroll
        for (int d0 = 0; d0 < 8; ++d0) qr[d0] = *(const bf16x8*)(qrow + d0 * 16 + (lk >> 5) * 8);
        u.Kb = kcmp + (size_t)(b * 256 * 4 + g) * 256; u.ldk = 1024; u.Vb = vcmp + (size_t)(b * 256 * 4 + g) * 256; u.ldv = 1024; u.KRb = nullptr;
        const int nmax_hi = (t0 + 31 - 31) >> 4;
        u.j_lo = 0; u.j_hi = (nmax_hi >> 6) + 1; u.qlo = (t0 + wid * 4 - 31) >> 4; u.qhi = (t0 + wid * 4 + 3 - 31) >> 4; u.qpos = (tq - 31) >> 4; u.sel = 0ull;
        fa::flash_core<3>(lds, u, qr, scale, o, m_reg, l_reg);
        int lo_ = lk; asm volatile("" : "+v"(lo_));
        const int r32 = lo_ & 31, hi = lo_ >> 5;
        const float inv_l = l_reg > 0.f ? 1.0f / l_reg : 0.f;
        fa::row_factors(lds, wid, r32, hi, inv_l * nsa_gate(a, b * SEQ + tq, 0, head), rf);
#pragma unroll
        for (int r = 0; r < 16; ++r) { const int orow = fa::crow(r, hi); char* pp = PARK + (orow & 7) * 8192 + (wid * 4 + (orow >> 3)) * 256 + r32 * 2;
#pragma unroll
            for (int d0 = 0; d0 < 4; ++d0) { const float v = o[d0][r] * rf[r]; const float vn = dpp_xor1(v); if ((r32 & 1) == 0) *(unsigned*)(pp + d0 * 64) = cvt_pk_bf16(v, vn); } }
        __syncthreads();
        const float mL = -m_reg * C2;
        const int sr = tid >> 4, sc = (tid & 15) * 8, kws = KSWZ(sr, sc * 2);
        for (int t = 0; t < u.j_hi; ++t) {
            const int kb = t * 64;
            const bf16x8 k0 = *(const bf16x8*)(u.Kb + (long)(kb + sr) * u.ldk + sc), k1 = *(const bf16x8*)(u.Kb + (long)(kb + 32 + sr) * u.ldk + sc);
            *(bf16x8*)(lds + fa::OFF_K + kws) = k0; *(bf16x8*)(lds + fa::OFF_K + kws + 32 * 256) = k1;
            __syncthreads();
            f32x16 p0, p1; fa::qkt<0, false, true>(p0, p1, lds, r32, hi, qr);
            fa::mask_tile(p0, p1, u.qpos - kb - 4 * hi, 0x80000000u);
#pragma unroll
            for (int r = 0; r < 16; ++r) {
                float a0 = __builtin_amdgcn_exp2f(fmaf(p0[r], C2, mL)) * inv_l, a1 = __builtin_amdgcn_exp2f(fmaf(p1[r], C2, mL)) * inv_l;
                a0 += dpp_xor1(a0); a0 += dpp_xor2(a0); a0 += dpp_hmir(a0);
                a1 += dpp_xor1(a1); a1 += dpp_xor2(a1); a1 += dpp_hmir(a1);
                if ((r32 & 7) == 0) { const int n = kb + fa::crow(r, hi); IMP[tokl * ILD + n] = a0; IMP[tokl * ILD + n + 32] = a1; }
            }
            __syncthreads();
        }
        for (int q4 = 0; q4 < 4; ++q4) {
            const int tl = wid * 4 + q4, tqq = t0 + tl, cur = tqq >> 6, sb = lk;
            float v = 0.f;
#pragma unroll
            for (int dn = -1; dn <= 3; ++dn) { const int n = 4 * sb + dn; if (n >= 0 && n <= 254 && n < u.j_hi * 64) v += IMP[tl * ILD + n]; }
            if (sb == 0 || sb == cur || sb == cur - 1) v = 1e9f;
            if (sb > cur) v = -1e30f;
            int rank = 0;
#pragma nounroll
            for (int j = 0; j < 64; ++j) { const float vj = __int_as_float(__builtin_amdgcn_readlane(__float_as_int(v), j)); rank += (vj > v || (vj == v && j < sb)) ? 1 : 0; }
            const unsigned long long msk = __ballot(rank < 16);
            if (lk == 0) SELM[tl] = msk;
        }
        __syncthreads();
        }
        const int head = g * 8 + wid, tq = t0 + (lk & 31);
        const bf16_t* qrow = projc + (size_t)(b * SEQ + tq) * C_NP + C_Q + head * 128;
        bf16x8 qr[8];
#pragma unroll
        for (int d0 = 0; d0 < 8; ++d0) qr[d0] = *(const bf16x8*)(qrow + d0 * 16 + (lk >> 5) * 8);
        u.KRb = nullptr; u.ldk = C_NP; u.ldv = C_NP; u.qlo = t0; u.qhi = t0 + 31; u.qpos = tq; u.sel = 0ull;
        { u.Kb = projc + (size_t)(b * SEQ) * C_NP + C_KW + g * 128; u.Vb = projc + (size_t)(b * SEQ) * C_NP + C_VW + g * 128;
          const int lowk = t0 - 511; u.j_lo = lowk > 0 ? lowk / 64 : 0; u.j_hi = (t0 + 31) / 64 + 1; }
        fa::flash_core<1, 0>(lds, u, qr, scale, o, m_reg, l_reg);
        int lw_ = lk; asm volatile("" : "+v"(lw_));
        { const int r32 = lw_ & 31, hi = lw_ >> 5;
        fa::row_factors(lds, wid, r32, hi, nsa_gate(a, b * SEQ + tq, 2, head) / l_reg, rf);
        char* pw_ = PARK + wid * 8192 + (4 * hi) * 256 + (r32 & ~1) * 2;
#pragma unroll
        for (int r = 0; r < 16; ++r)
#pragma unroll
            for (int d0 = 0; d0 < 4; ++d0) { const float v = o[d0][r] * rf[r]; const float vn = dpp_xor1(v);
                if ((r32 & 1) == 0) { unsigned* q_ = (unsigned*)(pw_ + ((r & 3) + 8 * (r >> 2)) * 256 + d0 * 64); const unsigned pw = *q_;
                    *q_ = cvt_pk_bf16(__uint_as_float(pw << 16) + v, __uint_as_float(pw & 0xffff0000u) + vn); } } }
        __syncthreads();
        u.Kb = projc + (size_t)(b * SEQ) * C_NP + C_KS + g * 128; u.Vb = projc + (size_t)(b * SEQ) * C_NP + C_VS + g * 128;
        u.j_lo = 0; u.j_hi = (t0 + 31) / 64 + 1; u.sel = SELM[lk & 31];
        fa::flash_core<2, 0>(lds, u, qr, scale, o, m_reg, l_reg);
        int ls_ = lk; asm volatile("" : "+v"(ls_));
        const int r32 = ls_ & 31, hi = ls_ >> 5;
        fa::row_factors(lds, wid, r32, hi, nsa_gate(a, b * SEQ + tq, 1, head) / l_reg, rf);
        char* pw_ = PARK + wid * 8192 + (4 * hi) * 256 + (r32 & ~1) * 2;
        bf16_t* ob = hcat + (size_t)(b * SEQ + t0 + 4 * hi) * DM + head * 128 + (r32 & ~1);
#pragma unroll
        for (int r = 0; r < 16; ++r)
#pragma unroll
            for (int d0 = 0; d0 < 4; ++d0) { const float v = o[d0][r] * rf[r]; const float vn = dpp_xor1(v);
                if ((r32 & 1) == 0) { const unsigned pw = *(const unsigned*)(pw_ + ((r & 3) + 8 * (r >> 2)) * 256 + d0 * 64);
                    *(unsigned*)(ob + (size_t)((r & 3) + 8 * (r >> 2)) * DM + d0 * 32) = cvt_pk_bf16(__uint_as_float(pw << 16) + v, __uint_as_float(pw & 0xffff0000u) + vn); } }
        __syncthreads();
    }
}


#ifndef DEBUG_CMP
#define DEBUG_CMP -1
#endif
#if DEBUG_CMP >= 0
__device__ __forceinline__ void dbg_copy(const Args& a) {
    const bf16_t* hcat = (const bf16_t*)(a.ws + WS_XB); bf16_t* dbg = (bf16_t*)(a.ws + WS_Z);
    const size_t gt = (size_t)blockIdx.x * NTHREADS + threadIdx.x, gs = (size_t)gridDim.x * NTHREADS;
    for (size_t i = gt; i < (size_t)M_TOK * 256; i += gs) { const size_t row = i >> 8, c8 = i & 255; *(bf16x8*)(dbg + row * 2048 + c8 * 8) = *(const bf16x8*)(hcat + row * DM + c8 * 8); }
}
__device__ __forceinline__ void dbg_compare(const Args& a) {
    const bf16_t* hcat = (const bf16_t*)(a.ws + WS_XB); const bf16_t* dbg = (const bf16_t*)(a.ws + WS_Z);
    float* accum = (float*)(a.ws + WS_CTL + 32 * 1024);
    const size_t gt = (size_t)blockIdx.x * NTHREADS + threadIdx.x, gs = (size_t)gridDim.x * NTHREADS;
    float sd = 0.f, sr = 0.f;
    for (size_t i = gt; i < (size_t)M_TOK * 256; i += gs) { const size_t row = i >> 8, c8 = i & 255; const int t = (int)(row & (SEQ - 1));
        bool in = false;
        if (DEBUG_CMP == 0) in = t < 32; if (DEBUG_CMP == 1) in = t >= 32 && t < 64; if (DEBUG_CMP == 2) in = t >= 64 && t < 128; if (DEBUG_CMP == 3) in = true;
        if (DEBUG_CMP == 4) in = (t & 63) < 32; if (DEBUG_CMP == 5) in = (t & 63) >= 32;
        if (!in) continue;
        float x[8], y[8]; unpack8(*(const bf16x8*)(hcat + row * DM + c8 * 8), x); unpack8(*(const bf16x8*)(dbg + row * 2048 + c8 * 8), y);
#pragma unroll
        for (int j = 0; j < 8; ++j) { const float d = x[j] - y[j]; sd += d * d; sr += x[j] * x[j]; } }
    sd = wave_sum(sd); sr = wave_sum(sr);
    if ((threadIdx.x & 63) == 0) { atomicAdd((unsigned long long*)accum, (unsigned long long)(sd * 1048576.0f)); atomicAdd((unsigned long long*)accum + 1, (unsigned long long)(sr * 1048576.0f)); }
}
#endif

constexpr int N_PHASES = 23;
__global__ void __launch_bounds__(NTHREADS, 2) fwd(Args args) {
    extern __shared__ __attribute__((aligned(16))) unsigned char shm[];
    char* lds = (char*)shm;
    PG8_LAS unsigned char* ldsg = (PG8_LAS unsigned char*)shm;
    unsigned char* ws = args.ws;
    if (threadIdx.x < 64) ((volatile LAS unsigned*)(ldsg + LDS_CTL_OFF))[threadIdx.x] = 0u;
    __syncthreads();
    XcdBarrier bar = xcd_barrier_post((unsigned*)(ws + WS_CTL), (volatile LAS unsigned*)(ldsg + LDS_CTL_OFF));
    const int lo = args.ph_lo, hi = args.ph_hi, G = gridDim.x, bx = blockIdx.x;
#define IN(k) (lo <= (k) && (k) < hi)
#define SEAM(k) do { if (IN(k) && IN((k) + 1)) xcd_barrier(bar); } while (0)
#define GEMMC(EPI, cidx, Aoff, Boff, Mr, Nr, Kr, ...) do { pg8::Gemm g_{(const pg8::bf16_t*)(ws + (Aoff)), (const pg8::bf16_t*)(ws + (Boff)), (Mr), (Nr), (Kr)}; pg8::StaticOrder S_; S_.init((Mr), (Nr), G, (cidx)); S_.WGM = GEMM_WGM; \
        EPI E_{__VA_ARGS__}; pg8::gemm_phase<EPI, pg8::StaticOrder, true, true>(ldsg, g_, S_, E_); } while (0)
#define GEMM(EPI, ...) GEMMC(EPI, bx, __VA_ARGS__)
#define GEMMA(EPI, Aptr, Boff, Mr, Nr, Kr, ...) do { pg8::Gemm g_{(const pg8::bf16_t*)(Aptr), (const pg8::bf16_t*)(ws + (Boff)), (Mr), (Nr), (Kr)}; pg8::StaticOrder S_; S_.init((Mr), (Nr), G, bx); S_.WGM = GEMM_WGM; \
        EPI E_{__VA_ARGS__}; pg8::gemm_phase<EPI, pg8::StaticOrder, true, true>(ldsg, g_, S_, E_); } while (0)
#define GEMM_WGM gemm_wgm
    float* xres = args.out;
    bf16_t* xb = (bf16_t*)(ws + WS_XB); const bf16_t* hcat = (const bf16_t*)args.out; f32x2* stats = (f32x2*)(ws + WS_STATS);
    bf16_t* zA = (bf16_t*)(ws + WS_Z); bf16_t* zB = (bf16_t*)args.out + (size_t)M_TOK * DM; bf16_t* zC = zA; bf16_t* zD = zA + (size_t)M_TOK * DM;

#ifndef FFN_CHUNKED
#define FFN_CHUNKED 0
#endif
#ifndef WGM_IN
#define WGM_IN 8
#endif
#ifndef WGM_WO
#define WGM_WO 4
#endif
#ifndef WGM_UP
#define WGM_UP 8
#endif
#ifndef WGM_DOWN
#define WGM_DOWN 2
#endif
    int gemm_wgm = 8;
#ifndef PROBE_MASK
#define PROBE_MASK 0u
#endif
#define PB(k) (((PROBE_MASK) >> (k)) & 1u)
#define PH(k, ...) do { if (IN(k)) { __VA_ARGS__; if (PB(k)) { xcd_barrier(bar); __VA_ARGS__; } } SEAM(k); } while (0)
    PH(0, p0_prologue(lds, args));
    gemm_wgm = WGM_IN; PH(1, GEMM(pg8::EpiProj, WS_XB, W_AB, M_TOK, AB_NP, DM, (bf16_t*)(ws + WS_R), AB_NP, (float*)(ws + WS_GATES), AB_IG / 256); if (bx >= 192 && G == 256) transpose_late(lds, args, bx - 192));
    PH(2, p2_prep(args));
    gemm_wgm = 8; if (IN(3)) { GEMM(pg8::EpiB<0>, WS_CQN, W_UQ, M_TOK, 3072, 1024, (bf16_t*)(ws + WS_QB), 3072); GEMM(pg8::EpiB<0>, WS_CKVN, W_UKV, M_TOK, 4096, 512, (bf16_t*)(ws + WS_KVB), 4096); }
    if (!(IN(3) && IN(4))) SEAM(3);
#if DEBUG_CMP >= 0
#if MC_VALU_STATE == 4
    PH(4, p4_mlstm_chunk(lds, args); xcd_barrier(bar); p4_mlstm(lds, args));
#else
    PH(4, p4_mlstm_chunk(lds, args); xcd_barrier(bar); dbg_copy(args); xcd_barrier(bar); p4_mlstm(lds, args); xcd_barrier(bar); dbg_compare(args));
#endif
#elif MLSTM_BOTH
    PH(4, p4_mlstm_chunk(lds, args); xcd_barrier(bar); p4_mlstm(lds, args));
#elif MLSTM_CHUNK
    PH(4, p4_mlstm_chunk(lds, args));
#else
    PH(4, p4_mlstm(lds, args));
#endif
    if (IN(5)) { p5_mlstm_norm(args); p5_mla(lds, args); if (PB(5)) { xcd_barrier(bar); p5_mla(lds, args); } } SEAM(5);
    gemm_wgm = WGM_WO; PH(6, GEMMA(pg8::EpiResidB, hcat, W_O0, M_TOK, DM, DM, zA, xb));
    PH(7, p7_layernorm_b(args, 0, true, zA, nullptr, xb, stats));
#if FFN_CHUNKED
#define FFN_UP(WGU, half) GEMM(pg8::EpiSwiGLU, WS_XB + (size_t)(half) * 8192 * DM * 2, WGU, 8192, GU_N, DM, (bf16_t*)(ws + WS_R) + (size_t)(half) * 8192 * FFH, FFH)
#define FFN_DOWN(WD, half, Cp, Zpp, lg, lb) GEMM(pg8::EpiResidLN, WS_R + (size_t)(half) * 8192 * FFH * 2, WD, 8192, DM, FFH, (Cp) + (size_t)(half) * 8192 * DM, (Zpp) + (size_t)(half) * 8192 * DM, stats + (half) * 8192, lg, lb, DM, DN_ALPHA)
    if (IN(8)) { gemm_wgm = WGM_UP; FFN_UP(W_GU0, 0); if (bx >= 192 && G == 256) transpose_late(lds, args, 64 + bx - 192); } SEAM(8);
    if (IN(9)) { gemm_wgm = WGM_DOWN; FFN_DOWN(W_D0, 0, xres, z, args.in[22], args.in[23]); gemm_wgm = WGM_UP; FFN_UP(W_GU0, 1); if (bx >= 192 && G == 256) transpose_late(lds, args, 128 + bx - 192);
                 xcd_barrier(bar); gemm_wgm = WGM_DOWN; FFN_DOWN(W_D0, 1, xres, z, args.in[22], args.in[23]); } SEAM(9);
#else
    gemm_wgm = WGM_UP; PH(8, GEMM(pg8::EpiSwiGLU, WS_XB, W_GU0, M_TOK, GU_N, DM, (bf16_t*)(ws + WS_R), FFH); if (bx >= 128 && G == 256) transpose_late(lds, args, 64 + bx - 128));
    gemm_wgm = WGM_DOWN; PH(9, GEMM(pg8::EpiResidLNB, WS_R, W_D0, M_TOK, DM, FFH, zB, zA, stats, args.in[22], args.in[23]));
#endif
    PH(10, p7_layernorm_b(args, 0, false, zB, nullptr, xb, stats));
    gemm_wgm = WGM_IN; PH(11, GEMM(pg8::EpiB<0>, WS_XB, W_C, M_TOK, C_NP, DM, (bf16_t*)(ws + WS_R), C_NP); if (bx >= 64 && G == 256) transpose_late(lds, args, 192 + bx - 64));
    PH(12, p12_blocks(args));
    gemm_wgm = 8; PH(13, GEMM(pg8::EpiB<1>, WS_AK, W_C1K, 4096, 256, 4096, (bf16_t*)(ws + WS_HK), 256);
           GEMMC(pg8::EpiB<1>, (bx + G - 16) % G, WS_AV, W_C1V, 4096, 256, 4096, (bf16_t*)(ws + WS_HV), 256);
           if (G == 256) { if (bx >= 32) transpose_late(lds, args, 384 + bx - 32); } else { for (int sl_ = bx; sl_ < LATE_SLOTS; sl_ += G) transpose_late(lds, args, sl_); });
    PH(14, GEMM(pg8::EpiB<0>, WS_HK, W_C2K, 4096, 256, 256, (bf16_t*)(ws + WS_KCMP), 256);
           GEMMC(pg8::EpiB<0>, (bx + G - 16) % G, WS_HV, W_C2V, 4096, 256, 256, (bf16_t*)(ws + WS_VCMP), 256));
#ifndef NSA_ALL
#define NSA_ALL 1
#endif
#if NSA_ALL
    if (IN(15)) { p15_17_nsa(lds, args); } SEAM(15);
#else
    if (IN(15)) { p15_cmp_attn(lds, args); } SEAM(15);
#ifndef NSA_MERGED
#define NSA_MERGED 1
#endif
#if NSA_MERGED
    if (IN(16)) { p1617_nsa_attn(lds, args); } SEAM(16);
#else
    if (IN(16)) { p16_nsa_attn<1>(lds, args); if (PB(16)) { xcd_barrier(bar); p15_cmp_attn(lds, args); xcd_barrier(bar); p16_nsa_attn<1>(lds, args); } } SEAM(16);
#ifndef PROBE_VAR
#define PROBE_VAR 0
#endif
    if (IN(17)) { p16_nsa_attn<2>(lds, args); if (PB(17)) { xcd_barrier(bar); p16_nsa_attn<2, PROBE_VAR>(lds, args); } } SEAM(17);
#endif
#endif
    gemm_wgm = WGM_WO; PH(18, GEMMA(pg8::EpiResidLNB, hcat, W_O1, M_TOK, DM, DM, zC, zB, stats, args.in[24], args.in[25]));
    PH(19, p7_layernorm_b(args, 1, true, zC, nullptr, xb, stats));
#if FFN_CHUNKED
    if (IN(20)) { gemm_wgm = WGM_UP; FFN_UP(W_GU1, 0); } SEAM(20);
    if (IN(21)) { gemm_wgm = WGM_DOWN; FFN_DOWN(W_D1, 0, xres, z, args.in[22] + DM, args.in[23] + DM); gemm_wgm = WGM_UP; FFN_UP(W_GU1, 1);
                  xcd_barrier(bar); gemm_wgm = WGM_DOWN; FFN_DOWN(W_D1, 1, xres, z, args.in[22] + DM, args.in[23] + DM); } SEAM(21);
#else
    gemm_wgm = WGM_UP; PH(20, GEMM(pg8::EpiSwiGLU, WS_XB, W_GU1, M_TOK, GU_N, DM, (bf16_t*)(ws + WS_R), FFH));
    gemm_wgm = WGM_DOWN; PH(21, GEMM(pg8::EpiResidLNB, WS_R, W_D1, M_TOK, DM, FFH, zD, zC, stats, args.in[22] + DM, args.in[23] + DM));
#endif
    PH(22, p7_layernorm_b(args, 1, false, zD, xres, nullptr, nullptr));
#if DEBUG_CMP >= 0
    if (IN(22)) { xcd_barrier(bar); if (bx == 0 && threadIdx.x == 0) { const unsigned long long* accum = (const unsigned long long*)(ws + WS_CTL + 32 * 1024); const float rel = sqrtf((float)((double)accum[0] / fmax((double)accum[1], 1.0)));
        float k = -20.0f * log10f(fmaxf(rel, 1e-6f)); k = fminf(fmaxf(rintf(k), 0.f), 89.f); xres[0] = 1000.0f + 100.0f * k; } }
#endif
#undef PH
#undef PB
#undef IN
#undef SEAM
#undef GEMM
#undef GEMMC
}

#ifndef MK_N_LAUNCHES
#define MK_N_LAUNCHES 1
#endif
extern "C" void kernel_launch(void* const* d_in, const int* in_sizes, int n_in, void* d_out, int out_size, void* d_ws, size_t ws_size, hipStream_t stream) {
    static int grid = 0;
    if (grid == 0) {
        if (n_in != 26 || in_sizes[0] != M_TOK * DM || out_size != M_TOK * DM || ws_size < WS_END) {
            fprintf(stderr, "kernel_launch: unexpected shapes (n_in %d, in0 %d, out %d, ws %zu, need %zu); nothing launched\n", n_in, n_in > 0 ? in_sizes[0] : -1, out_size, ws_size, (size_t)WS_END); grid = -1; return; }
        int dev = 0, cus = 0, per_cu = 0;
        if (hipGetDevice(&dev) != hipSuccess || hipDeviceGetAttribute(&cus, hipDeviceAttributeMultiprocessorCount, dev) != hipSuccess) { grid = -1; return; }
        if (hipFuncSetAttribute((const void*)fwd, hipFuncAttributeMaxDynamicSharedMemorySize, LDS_BYTES) != hipSuccess) { fprintf(stderr, "kernel_launch: hipFuncSetAttribute failed\n"); grid = -1; return; }
        if (hipOccupancyMaxActiveBlocksPerMultiprocessor(&per_cu, (const void*)fwd, NTHREADS, LDS_BYTES) != hipSuccess || per_cu < 1) { fprintf(stderr, "kernel_launch: occupancy query says %d blocks per CU\n", per_cu); (void)hipGetLastError(); grid = -1; return; }
        grid = cus;
    }
    if (grid < 0) return;
    (void)hipMemsetAsync((char*)d_ws + WS_CTL, 0, 64 * 1024, stream);
    Args a{};
    for (int i = 0; i < 26; ++i) a.in[i] = (const float*)d_in[i];
    a.out = (float*)d_out; a.ws = (unsigned char*)d_ws;
    unsigned char* ws = (unsigned char*)d_ws;
    const float* fg = a.in[19]; const float* fu = a.in[20]; const float* fd = a.in[21];
    const size_t LW = (size_t)DM * FFH;
    int j = 0;
    a.tj[j++] = TJob{a.in[1], nullptr, (bf16_t*)(ws + W_AB), DM, AB_IN, AB_NP, 0};
    a.tj[j++] = TJob{a.in[7], nullptr, (bf16_t*)(ws + W_UQ), 1024, 3072, 3072, 0};
    a.tj[j++] = TJob{a.in[8], nullptr, (bf16_t*)(ws + W_UKV), 512, 4096, 4096, 0};
    a.tj[j++] = TJob{a.in[9], nullptr, (bf16_t*)(ws + W_O0), DM, DM, DM, 0};
    a.tj[j++] = TJob{fg, fu, (bf16_t*)(ws + W_GU0), DM, FFH, GU_N, 1};
    a.tj[j++] = TJob{fd, nullptr, (bf16_t*)(ws + W_D0), FFH, DM, DM, 0};
    a.tj[j++] = TJob{a.in[10], nullptr, (bf16_t*)(ws + W_C), DM, C_IN, C_NP, 0};
    a.tj[j++] = TJob{a.in[14], nullptr, (bf16_t*)(ws + W_C1K), 4096, 256, 256, 0};
    a.tj[j++] = TJob{a.in[16], nullptr, (bf16_t*)(ws + W_C1V), 4096, 256, 256, 0};
    a.tj[j++] = TJob{a.in[15], nullptr, (bf16_t*)(ws + W_C2K), 256, 128, 256, 0};
    a.tj[j++] = TJob{a.in[17], nullptr, (bf16_t*)(ws + W_C2V), 256, 128, 256, 0};
    a.tj[j++] = TJob{a.in[18], nullptr, (bf16_t*)(ws + W_O1), DM, DM, DM, 0};
    a.tj[j++] = TJob{fg + LW, fu + LW, (bf16_t*)(ws + W_GU1), DM, FFH, GU_N, 1};
    a.tj[j++] = TJob{fd + LW, nullptr, (bf16_t*)(ws + W_D1), FFH, DM, DM, 0};
#if MK_N_LAUNCHES == 1
    a.ph_lo = 0; a.ph_hi = N_PHASES;
    hipLaunchKernelGGL(fwd, dim3(grid), dim3(NTHREADS), LDS_BYTES, stream, a);
#else
    for (int p = 0; p < N_PHASES; ++p) { a.ph_lo = p; a.ph_hi = p + 1; hipLaunchKernelGGL(fwd, dim3(grid), dim3(NTHREADS), LDS_BYTES, stream, a); }
#endif
    const hipError_t le = hipPeekAtLastError();
    if (le != hipSuccess) fprintf(stderr, "kernel_launch: launch failed: %s\n", hipGetErrorName(le));
}
```

```cpp
#include <hip/hip_runtime.h>
#include <stdint.h>
#include <stdio.h>
#ifndef FLASH2
#define FLASH2 0
#endif
#ifndef DEBUG_CMP
#define DEBUG_CMP -1
#endif
#ifndef MLSTM_BOTH
#define MLSTM_BOTH 0
#endif
#ifndef MLSTM_CHUNK
#define MLSTM_CHUNK 1
#endif

typedef unsigned short bf16_t;
typedef short bf16x8 __attribute__((ext_vector_type(8)));
typedef short s16x4 __attribute__((ext_vector_type(4)));
typedef float f32x2 __attribute__((ext_vector_type(2)));
typedef float f32x4 __attribute__((ext_vector_type(4)));
typedef float f32x16 __attribute__((ext_vector_type(16)));
typedef unsigned u32x2 __attribute__((ext_vector_type(2)));
typedef unsigned u32x4 __attribute__((ext_vector_type(4)));

constexpr int M_TOK = 16384, SEQ = 4096, NBATCH = 4, DM = 4096;
constexpr int AB_IN = 7752, AB_NP = 7936, C_IN = 7264, C_NP = 7424, FFH = 11008, GU_N = 22016;
constexpr float DN_ALPHA = 1.4142135623730951f;
constexpr float LN_EPS = 1e-5f, RMS_EPS = 1e-6f;
constexpr int AB_Q = 0, AB_K = 1024, AB_V = 2048, AB_IG = 4096, AB_FG = 4100, AB_OG = 4104, AB_CQ = 6152, AB_CKV = 7176, AB_KR = 7688;
constexpr int C_Q = 0, C_KC = 4096, C_VC = 4608, C_KS = 5120, C_VS = 5632, C_KW = 6144, C_VW = 6656, C_GATE = 7168;

__device__ __forceinline__ float bf2f(bf16_t b) { return __uint_as_float(((unsigned)b) << 16); }
__device__ __forceinline__ unsigned cvt_pk_bf16(float lo, float hi) { unsigned r; asm volatile("v_cvt_pk_bf16_f32 %0, %1, %2" : "=v"(r) : "v"(lo), "v"(hi)); return r; }
__device__ __forceinline__ bf16_t f2bf(float f) { return (bf16_t)(cvt_pk_bf16(f, 0.f) & 0xffffu); }
__device__ __forceinline__ void unpack8(const bf16x8 v, float (&f)[8]) {
#pragma unroll
    for (int j = 0; j < 8; ++j) f[j] = bf2f((bf16_t)v[j]);
}
__device__ __forceinline__ bf16x8 pack8f(const float (&f)[8]) {
    u32x4 w = {cvt_pk_bf16(f[0], f[1]), cvt_pk_bf16(f[2], f[3]), cvt_pk_bf16(f[4], f[5]), cvt_pk_bf16(f[6], f[7])};
    return *reinterpret_cast<bf16x8*>(&w);
}
typedef _Float16 f16x2_t __attribute__((ext_vector_type(2)));
__device__ __forceinline__ unsigned cvt_pk_f16(float lo, float hi) { const f16x2_t h = {(_Float16)lo, (_Float16)hi}; return __builtin_bit_cast(unsigned, h); }
__device__ __forceinline__ void unpack8h(const bf16x8 v, float (&f)[8]) {
#pragma unroll
    for (int j = 0; j < 8; ++j) f[j] = (float)__builtin_bit_cast(_Float16, (short)v[j]);
}
__device__ __forceinline__ bf16x8 pack8h(const float (&f)[8]) {
    u32x4 w = {cvt_pk_f16(f[0], f[1]), cvt_pk_f16(f[2], f[3]), cvt_pk_f16(f[4], f[5]), cvt_pk_f16(f[6], f[7])};
    return *reinterpret_cast<bf16x8*>(&w);
}
__device__ __forceinline__ float wave_sum(float v) {
#pragma unroll
    for (int o = 32; o >= 1; o >>= 1) v += __shfl_xor(v, o);
    return v;
}
__device__ __forceinline__ float sigmoid_f(float x) { return __builtin_amdgcn_rcpf(1.0f + __expf(-x)); }

#define XB_TMO      128
#define XB_XCNT(j)  (256  + 64 * (j))
#define XB_XSUB(j)  (1280 + 64 * (j))
#define XB_XGEN(j)  (2304 + 64 * (j))
#define XB_TOP      3328
#define XB_TOPGEN   3392
#define XCD_BAR_WORDS 3456
#define XB_SPIN_CAP (1u << 22)
#define LAS __attribute__((address_space(3)))

__device__ __forceinline__ unsigned xb_ld(unsigned* p)              { return __hip_atomic_load(p, __ATOMIC_RELAXED, __HIP_MEMORY_SCOPE_AGENT); }
__device__ __forceinline__ unsigned xb_add(unsigned* p, unsigned v) { return __hip_atomic_fetch_add(p, v, __ATOMIC_RELAXED, __HIP_MEMORY_SCOPE_AGENT); }
__device__ __forceinline__ unsigned xb_xcc_id() { return (unsigned)__builtin_amdgcn_s_getreg((3 << 11) | 20) & 0xFu; }
#define XB_SPIN(cond, bar) do { unsigned _sp = 0; while (cond) { __builtin_amdgcn_s_sleep(1); \
    if ((++_sp & 255u) == 0u) { if (xb_ld(&(bar)[XB_TMO])) break; if (_sp > XB_SPIN_CAP) { atomicAdd(&(bar)[XB_TMO], 1u); break; } } } } while (0)

struct XcdBarrier {
    unsigned* bar; unsigned x;
    volatile LAS unsigned* st;
};

__device__ __forceinline__ XcdBarrier xcd_barrier_post(unsigned* bar, volatile LAS unsigned* st) {
    XcdBarrier b; b.bar = bar; b.x = xb_xcc_id(); b.st = st;
    if (threadIdx.x == 0) (void)xb_add(&bar[XB_XCNT(b.x)], 1u);
    return b;
}
__device__ __forceinline__ void xcd_barrier_complete(unsigned* bar, unsigned x, unsigned& nloc, unsigned& nx) {
    const unsigned G = gridDim.x * gridDim.y * gridDim.z;
    unsigned sum, cnt, mine, sp = 0u;
    for (;;) {
        sum = 0u; cnt = 0u; mine = 0u;
#pragma unroll
        for (unsigned j = 0; j < 16; ++j) { const unsigned c = xb_ld(&bar[XB_XCNT(j)]); sum += c; cnt += (c > 0u) ? 1u : 0u; mine = (j == x) ? c : mine; }
        if (sum == G) break;
        __builtin_amdgcn_s_sleep(1);
        if ((++sp & 255u) == 0u) { if (xb_ld(&bar[XB_TMO])) break; if (sp > XB_SPIN_CAP) { atomicAdd(&bar[XB_TMO], 1u); break; } }
    }
    nloc = mine > 0u ? mine : 1u; nx = cnt > 0u ? cnt : 1u;
}

__device__ __forceinline__ void xcd_barrier(const XcdBarrier& b) {
    asm volatile("s_waitcnt vmcnt(0)" ::: "memory");
    __syncthreads();
    if (threadIdx.x == 0) {
        unsigned* bar = b.bar;
        __builtin_amdgcn_s_waitcnt(0);
        unsigned nloc = b.st[0], nx = b.st[1];
        if (nloc == 0u) { xcd_barrier_complete(bar, b.x, nloc, nx); b.st[0] = nloc; b.st[1] = nx; }
        const unsigned old = xb_add(&bar[XB_XSUB(b.x)], 1u);
        const unsigned gen = old / nloc;
        if (old + 1u == (gen + 1u) * nloc) {
            __builtin_amdgcn_fence(__ATOMIC_RELEASE, "agent");
            asm volatile("s_waitcnt vmcnt(0)" ::: "memory");
            const unsigned og = xb_add(&bar[XB_TOP], 1u);
            const unsigned tg = og / nx;
            if (og + 1u == (tg + 1u) * nx) xb_add(&bar[XB_TOPGEN], 1u);
            else XB_SPIN(xb_ld(&bar[XB_TOPGEN]) == tg, bar);
            __builtin_amdgcn_fence(__ATOMIC_ACQUIRE, "agent");
            xb_add(&bar[XB_XGEN(b.x)], 1u);
            asm volatile("s_waitcnt vmcnt(0)" ::: "memory");
        } else {
            XB_SPIN(xb_ld(&bar[XB_XGEN(b.x)]) == gen, bar);
            __builtin_amdgcn_fence(__ATOMIC_ACQUIRE, "agent");
            asm volatile("s_waitcnt vmcnt(0)" ::: "memory");
        }
    }
    __syncthreads();
}namespace pg8 {
#define PG8_LAS __attribute__((address_space(3)))
typedef unsigned short bf16_t;
typedef short bf16x8 __attribute__((ext_vector_type(8)));
typedef float f32x4 __attribute__((ext_vector_type(4)));
typedef unsigned u32x4 __attribute__((ext_vector_type(4)));
constexpr int BM = 256, BK = 64, HALF = 128, HTB = HALF * BK * 2  , STAGE_BYTES = 8 * HTB, NXCD = 8;

__host__ __device__ __forceinline__ int lds_byte(int r, int c) { const int st = (r >> 4) * 2 + (c >> 5), rr = r & 15, cc = c & 31, ob = rr * 64 + cc * 2; return st * 1024 + (ob ^ (((ob >> 9) & 1) << 5)); }
__host__ __device__ __forceinline__ void stage_rc(int b, int& R, int& C) { const int st = b / 1024, sb = b % 1024, swz = sb ^ (((sb >> 9) & 1) << 5); R = (st >> 1) * 16 + swz / 64; C = (st & 1) * 32 + (swz % 64) / 2; }
__host__ __device__ __forceinline__ int perm32(int rho) { const int n = rho >> 4, i = rho & 15; return 8 * (i >> 2) + 4 * n + (i & 3); }

struct Unit { int pm, pn; };
struct Gemm { const bf16_t* A; const bf16_t* Bt; int M, N, K; };

struct StaticOrder {
    int nM, nN, nwg, G, c, WGM = 8;
    __host__ __device__ void init(int M, int N, int G_, int c_) { nM = M / BM; nN = N / BM; nwg = nM * nN; G = G_; c = c_; }
    __host__ __device__ bool next(int i, Unit& u) const {
        const long L = (long)i * G + c; if (L >= nwg) return false;
        int wgid = (int)L; { const int q = nwg / NXCD, r = nwg % NXCD, xcd = wgid % NXCD, off = wgid / NXCD; wgid = (xcd < r ? xcd * (q + 1) : r * (q + 1) + (xcd - r) * q) + off; }
        const int nig = WGM * nN, gid = wgid / nig, fm = gid * WGM, gsz = (nM - fm) < WGM ? (nM - fm) : WGM;
        u.pm = fm + ((wgid % nig) % gsz); u.pn = (wgid % nig) / gsz; return true;
    }
    __device__ __forceinline__ void a_ready(const Unit&) const {}
    __device__ __forceinline__ void done(const Unit&) const {}
};
struct CountedOrder : StaticOrder {
    const unsigned* ready; unsigned need; unsigned* tmo;
    __device__ __forceinline__ void a_ready(const Unit& u) const {
        if (threadIdx.x < 64) {
            const unsigned long long t0 = __builtin_amdgcn_s_memrealtime(); unsigned polls = 0;
            while ((unsigned)__builtin_amdgcn_readfirstlane(__hip_atomic_load(ready + 64 * u.pm, __ATOMIC_RELAXED, __HIP_MEMORY_SCOPE_AGENT)) < need) {
                if ((++polls & 255u) == 0u && __builtin_amdgcn_readfirstlane(__hip_atomic_load(tmo, __ATOMIC_RELAXED, __HIP_MEMORY_SCOPE_AGENT)) != 0u) break;
                if (__builtin_amdgcn_s_memrealtime() - t0 > 2000000ull) {
                    if (threadIdx.x == 0) { unsigned expect = 0u; __hip_atomic_compare_exchange_strong(tmo + 1, &expect, 0x600u | (unsigned)(u.pm & 0xff), __ATOMIC_RELAXED, __ATOMIC_RELAXED, __HIP_MEMORY_SCOPE_AGENT); __hip_atomic_store(tmo, 1u, __ATOMIC_RELAXED, __HIP_MEMORY_SCOPE_AGENT); }
                    break; }
                __builtin_amdgcn_s_sleep(2); }
            __builtin_amdgcn_fence(__ATOMIC_ACQUIRE, "agent");
            asm volatile("s_waitcnt vmcnt(0)" ::: "memory");
        }
#if !defined(BROKEN_HOOK_NO_BARRIER)
        asm volatile("" ::: "memory"); __builtin_amdgcn_s_barrier(); asm volatile("" ::: "memory");
#endif
    }
};

__device__ __forceinline__ unsigned cvt_pk_bf16(float lo, float hi) { unsigned r; asm volatile("v_cvt_pk_bf16_f32 %0, %1, %2" : "=v"(r) : "v"(lo), "v"(hi)); return r; }
typedef float f32x2 __attribute__((ext_vector_type(2)));
__device__ __forceinline__ f32x2 gelu_pk(f32x2 v) {
    const f32x2 av = __builtin_elementwise_abs(v), d = av * 0.2316418882f + 1.0f;
    f32x2 t; t.x = __builtin_amdgcn_rcpf(d.x); t.y = __builtin_amdgcn_rcpf(d.y);
    f32x2 q = t * 0.5307027145f + (-0.7265760135f); q = q * t + 0.7107068705f; q = q * t + (-0.142248368f); q = q * t + 0.127414796f; q = q * t;
    const f32x2 s = (v * v) * (-0.72134752044f);
    f32x2 e; e.x = __builtin_amdgcn_exp2f(s.x); e.y = __builtin_amdgcn_exp2f(s.y);
    const f32x2 m = v * (q * e), r = v - m;
    f32x2 o; o.x = v.x < 0.f ? m.x : r.x; o.y = v.y < 0.f ? m.y : r.y; return o;
}

struct EpiF32 {
    static constexpr bool PERM = false, AFTER_DRAIN = false, PREFETCH = false;
    float* C; int ldc; const float* bias;
    __device__ __forceinline__ void operator()(const f32x4 (&acc)[2][2][4][2], const Unit& u, int wr, int wc, int fr, int fq) const {
        const int row0 = u.pm * BM + wr * 64 + fr, col0 = u.pn * BM + wc * 32 + 4 * fq;
        f32x4 bv[2][2];
#pragma unroll
        for (int bj = 0; bj < 2; ++bj)
#pragma unroll
            for (int n = 0; n < 2; ++n) bv[bj][n] = bias ? *(const f32x4*)(bias + col0 + bj * HALF + n * 16) : (f32x4){0.f, 0.f, 0.f, 0.f};
#pragma unroll
        for (int ai = 0; ai < 2; ++ai)
#pragma unroll
            for (int m = 0; m < 4; ++m) { float* rowp = C + (size_t)(row0 + ai * HALF + m * 16) * ldc + col0;
#pragma unroll
                for (int bj = 0; bj < 2; ++bj)
#pragma unroll
                    for (int n = 0; n < 2; ++n) *(f32x4*)(rowp + bj * HALF + n * 16) = acc[ai][bj][m][n] + bv[bj][n]; }
    }
};
template <int ACT  > struct EpiBf16 {
    static constexpr bool PERM = true, AFTER_DRAIN = false, PREFETCH = false;
    bf16_t* O; int ldc; const float* bias; int split_cols; size_t split_stride;
    __device__ __forceinline__ void operator()(const f32x4 (&acc)[2][2][4][2], const Unit& u, int wr, int wc, int fr, int fq) const {
        const int row0 = u.pm * BM + wr * 64 + fr; int colt = u.pn * BM; bf16_t* base = O;
        if (split_cols) { const int t = colt / split_cols; base += (size_t)t * split_stride; colt -= t * split_cols; }
        const int col0 = colt + wc * 32 + 8 * fq, bcol0 = u.pn * BM + wc * 32 + 8 * fq;
        f32x4 bv[2][2];
#pragma unroll
        for (int bj = 0; bj < 2; ++bj)
#pragma unroll
            for (int n = 0; n < 2; ++n) bv[bj][n] = bias ? *(const f32x4*)(bias + bcol0 + bj * HALF + 4 * n) : (f32x4){0.f, 0.f, 0.f, 0.f};
#pragma unroll
        for (int ai = 0; ai < 2; ++ai)
#pragma unroll
            for (int m = 0; m < 4; ++m) { bf16_t* rowp = base + (size_t)(row0 + ai * HALF + m * 16) * ldc + col0;
#pragma unroll
                for (int bj = 0; bj < 2; ++bj) { f32x4 v0 = acc[ai][bj][m][0] + bv[bj][0], v1 = acc[ai][bj][m][1] + bv[bj][1];
                    if (ACT == 1) { f32x2 a = gelu_pk((f32x2){v0[0], v0[1]}), b = gelu_pk((f32x2){v0[2], v0[3]}), c = gelu_pk((f32x2){v1[0], v1[1]}), d = gelu_pk((f32x2){v1[2], v1[3]});
                        v0 = (f32x4){a.x, a.y, b.x, b.y}; v1 = (f32x4){c.x, c.y, d.x, d.y}; }
                    if (ACT == 2) {
#pragma unroll
                        for (int j = 0; j < 4; ++j) { v0[j] = 0.5f * v0[j] * (1.0f + erff(v0[j] * 0.70710678f)); v1[j] = 0.5f * v1[j] * (1.0f + erff(v1[j] * 0.70710678f)); } }
                    u32x4 w; w.x = cvt_pk_bf16(v0[0], v0[1]); w.y = cvt_pk_bf16(v0[2], v0[3]); w.z = cvt_pk_bf16(v1[0], v1[1]); w.w = cvt_pk_bf16(v1[2], v1[3]);
                    *(u32x4*)(rowp + bj * HALF) = w; } }
    }
};
#ifndef EPI_PREFETCH
#define EPI_PREFETCH false
#endif
#ifndef EPI_PF_TILES
#define EPI_PF_TILES 16
#endif
__device__ __forceinline__ float silu_f(float g) { return g * __builtin_amdgcn_rcpf(1.0f + __expf(-g)); }
__device__ __forceinline__ float gelu_tanh_f(float x) { const float y = 0.7978845608028654f * (x + 0.044715f * x * x * x); const float e = __expf(2.0f * y); const float t = 1.0f - 2.0f * __builtin_amdgcn_rcpf(e + 1.0f); return 0.5f * x * (1.0f + t); }
template <int ACT> struct EpiB {
    static constexpr bool PERM = true, AFTER_DRAIN = false, PREFETCH = false;
    bf16_t* O; int ldc;
    __device__ __forceinline__ void operator()(const f32x4 (&acc)[2][2][4][2], const Unit& u, int wr, int wc, int fr, int fq) const {
        const int row0 = u.pm * BM + wr * 64 + fr, col0 = u.pn * BM + wc * 32 + 8 * fq;
        float one = 1.0f; asm volatile("" : "+v"(one));
#pragma unroll
        for (int ai = 0; ai < 2; ++ai)
#pragma unroll
            for (int m = 0; m < 4; ++m) { bf16_t* rowp = O + (size_t)(row0 + ai * HALF + m * 16) * ldc + col0;
#pragma unroll
                for (int bj = 0; bj < 2; ++bj) { f32x4 v0 = acc[ai][bj][m][0] * one, v1 = acc[ai][bj][m][1] * one;
                    if (ACT == 1) {
#pragma unroll
                        for (int j = 0; j < 4; ++j) { v0[j] = gelu_tanh_f(v0[j]); v1[j] = gelu_tanh_f(v1[j]); } }
                    u32x4 w; w.x = cvt_pk_bf16(v0[0], v0[1]); w.y = cvt_pk_bf16(v0[2], v0[3]); w.z = cvt_pk_bf16(v1[0], v1[1]); w.w = cvt_pk_bf16(v1[2], v1[3]);
                    *(u32x4*)(rowp + bj * HALF) = w; } }
    }
};
struct EpiProj {
    static constexpr bool PERM = true, AFTER_DRAIN = false, PREFETCH = false;
    bf16_t* O; int ldc; float* gates; int gate_pn;
    __device__ __forceinline__ void operator()(const f32x4 (&acc)[2][2][4][2], const Unit& u, int wr, int wc, int fr, int fq) const {
        const int row0 = u.pm * BM + wr * 64 + fr, col0 = u.pn * BM + wc * 32 + 8 * fq;
        float one = 1.0f; asm volatile("" : "+v"(one));
#pragma unroll
        for (int ai = 0; ai < 2; ++ai)
#pragma unroll
            for (int m = 0; m < 4; ++m) { bf16_t* rowp = O + (size_t)(row0 + ai * HALF + m * 16) * ldc + col0;
#pragma unroll
                for (int bj = 0; bj < 2; ++bj) { const f32x4 v0 = acc[ai][bj][m][0] * one, v1 = acc[ai][bj][m][1] * one;
                    u32x4 w; w.x = cvt_pk_bf16(v0[0], v0[1]); w.y = cvt_pk_bf16(v0[2], v0[3]); w.z = cvt_pk_bf16(v1[0], v1[1]); w.w = cvt_pk_bf16(v1[2], v1[3]);
                    *(u32x4*)(rowp + bj * HALF) = w; } }
        if (u.pn == gate_pn && wc == 0 && fq == 0) {
#pragma unroll
            for (int ai = 0; ai < 2; ++ai)
#pragma unroll
                for (int m = 0; m < 4; ++m) { float* g = gates + (size_t)(row0 + ai * HALF + m * 16) * 8;
                    *(f32x4*)g = acc[ai][0][m][0]; *(f32x4*)(g + 4) = acc[ai][0][m][1]; }
        }
    }
};
struct EpiSwiGLU {
    static constexpr bool PERM = true, AFTER_DRAIN = false, PREFETCH = false;
    bf16_t* H; int ldh;
    __device__ __forceinline__ void operator()(const f32x4 (&acc)[2][2][4][2], const Unit& u, int wr, int wc, int fr, int fq) const {
        const int row0 = u.pm * BM + wr * 64 + fr, col0 = u.pn * HALF + wc * 32 + 8 * fq;
#pragma unroll
        for (int ai = 0; ai < 2; ++ai)
#pragma unroll
            for (int m = 0; m < 4; ++m) { bf16_t* rowp = H + (size_t)(row0 + ai * HALF + m * 16) * ldh + col0;
                const f32x4 g0 = acc[ai][0][m][0], g1 = acc[ai][0][m][1], u0 = acc[ai][1][m][0], u1 = acc[ai][1][m][1];
                float h[8];
#pragma unroll
                for (int j = 0; j < 4; ++j) { h[j] = silu_f(g0[j]) * u0[j]; h[4 + j] = silu_f(g1[j]) * u1[j]; }
                u32x4 w; w.x = cvt_pk_bf16(h[0], h[1]); w.y = cvt_pk_bf16(h[2], h[3]); w.z = cvt_pk_bf16(h[4], h[5]); w.w = cvt_pk_bf16(h[6], h[7]);
                *(u32x4*)rowp = w; }
    }
};
struct EpiResid {
    static constexpr bool PERM = false, AFTER_DRAIN = false, PREFETCH = false;
    float* C; const float* R; int ldc; float alpha;
    __device__ __forceinline__ void operator()(const f32x4 (&acc)[2][2][4][2], const Unit& u, int wr, int wc, int fr, int fq) const {
        const int row0 = u.pm * BM + wr * 64 + fr, col0 = u.pn * BM + wc * 32 + 4 * fq;
#pragma unroll
        for (int ai = 0; ai < 2; ++ai) {
            f32x4 r[4][2][2];
#pragma unroll
            for (int m = 0; m < 4; ++m) { const size_t off = (size_t)(row0 + ai * HALF + m * 16) * ldc + col0;
#pragma unroll
                for (int bj = 0; bj < 2; ++bj)
#pragma unroll
                    for (int n = 0; n < 2; ++n) r[m][bj][n] = *(const f32x4*)(R + off + bj * HALF + n * 16); }
            asm volatile("" ::: "memory");
#pragma unroll
            for (int m = 0; m < 4; ++m) { const size_t off = (size_t)(row0 + ai * HALF + m * 16) * ldc + col0;
#pragma unroll
                for (int bj = 0; bj < 2; ++bj)
#pragma unroll
                    for (int n = 0; n < 2; ++n) *(f32x4*)(C + off + bj * HALF + n * 16) = acc[ai][bj][m][n] + alpha * r[m][bj][n]; }
            asm volatile("" ::: "memory");
        }
    }
};
struct EpiResidLN {
    static constexpr bool PERM = false, AFTER_DRAIN = false, PREFETCH = false;
    float* C; const float* Zp; const f32x2* st; const float* g; const float* b; int ldc; float alpha;
    __device__ __forceinline__ void operator()(const f32x4 (&acc)[2][2][4][2], const Unit& u, int wr, int wc, int fr, int fq) const {
        const int row0 = u.pm * BM + wr * 64 + fr, col0 = u.pn * BM + wc * 32 + 4 * fq;
#pragma unroll
        for (int bj = 0; bj < 2; ++bj)
#pragma unroll
            for (int n = 0; n < 2; ++n) {
                const int cc = col0 + bj * HALF + n * 16;
                const f32x4 gv = *(const f32x4*)(g + cc) * alpha, bv = *(const f32x4*)(b + cc) * alpha;
                f32x4 r[2][4]; f32x2 ms[2][4];
#pragma unroll
                for (int ai = 0; ai < 2; ++ai)
#pragma unroll
                    for (int m = 0; m < 4; ++m) { const int row = row0 + ai * HALF + m * 16; ms[ai][m] = st[row]; r[ai][m] = *(const f32x4*)(Zp + (size_t)row * ldc + cc); }
                asm volatile("" ::: "memory");
#pragma unroll
                for (int ai = 0; ai < 2; ++ai)
#pragma unroll
                    for (int m = 0; m < 4; ++m) { const int row = row0 + ai * HALF + m * 16;
                        *(f32x4*)(C + (size_t)row * ldc + cc) = acc[ai][bj][m][n] + ((r[ai][m] - ms[ai][m].x) * ms[ai][m].y) * gv + bv; }
                asm volatile("" ::: "memory");
            }
    }
};
struct EpiResidB {
    static constexpr bool PERM = true, AFTER_DRAIN = false, PREFETCH = EPI_PREFETCH;
    bf16_t* C; const bf16_t* R;
    __device__ __forceinline__ void prefetch(const Unit& u, PG8_LAS unsigned char* dummy, int wid, int lane) const {
#pragma unroll
        for (int i = 0; i < 2; ++i) { const int L = wid * 128 + i * 64 + lane;
            __builtin_amdgcn_global_load_lds((const unsigned*)((const char*)R + (unsigned)((u.pm * BM + (L >> 2)) * DM + u.pn * BM + (L & 3) * 64) * 2u), (PG8_LAS unsigned*)dummy, 4, 0, 0); }
    }
    __device__ __forceinline__ void operator()(const f32x4 (&acc)[2][2][4][2], const Unit& u, int wr, int wc, int fr, int fq) const {
        const int row0 = u.pm * BM + wr * 64 + fr, col0 = u.pn * BM + wc * 32 + 8 * fq;
#pragma unroll
        for (int ai = 0; ai < 2; ++ai) {
            bf16x8 r[4][2];
#pragma unroll
            for (int m = 0; m < 4; ++m)
#pragma unroll
                for (int bj = 0; bj < 2; ++bj) r[m][bj] = *(const bf16x8*)((const char*)R + (unsigned)((row0 + ai * HALF + m * 16) * DM + col0 + bj * HALF) * 2u);
            asm volatile("" ::: "memory");
#pragma unroll
            for (int m = 0; m < 4; ++m)
#pragma unroll
                for (int bj = 0; bj < 2; ++bj) { float x[8]; unpack8(r[m][bj], x);
                    const f32x4 a0 = acc[ai][bj][m][0], a1 = acc[ai][bj][m][1];
                    float v[8];
#pragma unroll
                    for (int j = 0; j < 4; ++j) { v[j] = a0[j] + DN_ALPHA * x[j]; v[4 + j] = a1[j] + DN_ALPHA * x[4 + j]; }
                    *(bf16x8*)((char*)C + (unsigned)((row0 + ai * HALF + m * 16) * DM + col0 + bj * HALF) * 2u) = pack8h(v); }
            asm volatile("" ::: "memory");
        }
    }
};
struct EpiResidLNB {
    static constexpr bool PERM = true, AFTER_DRAIN = false, PREFETCH = EPI_PREFETCH;
    bf16_t* C; const bf16_t* Zp; const f32x2* st; const float* g; const float* b;
    __device__ __forceinline__ void prefetch(const Unit& u, PG8_LAS unsigned char* dummy, int wid, int lane) const {
#pragma unroll
        for (int i = 0; i < 2; ++i) { const int L = wid * 128 + i * 64 + lane;
            __builtin_amdgcn_global_load_lds((const unsigned*)((const char*)Zp + (unsigned)((u.pm * BM + (L >> 2)) * DM + u.pn * BM + (L & 3) * 64) * 2u), (PG8_LAS unsigned*)dummy, 4, 0, 0); }
    }
    __device__ __forceinline__ void operator()(const f32x4 (&acc)[2][2][4][2], const Unit& u, int wr, int wc, int fr, int fq) const {
        const int row0 = u.pm * BM + wr * 64 + fr, col0 = u.pn * BM + wc * 32 + 8 * fq;
#pragma unroll
        for (int bj = 0; bj < 2; ++bj) {
            const int cc = col0 + bj * HALF;
            const f32x4 g0 = *(const f32x4*)(g + cc) * DN_ALPHA, g1 = *(const f32x4*)(g + cc + 4) * DN_ALPHA, b0 = *(const f32x4*)(b + cc) * DN_ALPHA, b1 = *(const f32x4*)(b + cc + 4) * DN_ALPHA;
            bf16x8 r[2][4]; f32x2 ms[2][4];
#pragma unroll
            for (int ai = 0; ai < 2; ++ai)
#pragma unroll
                for (int m = 0; m < 4; ++m) { const int row = row0 + ai * HALF + m * 16; ms[ai][m] = *(const f32x2*)((const char*)st + (unsigned)row * 8u); r[ai][m] = *(const bf16x8*)((const char*)Zp + (unsigned)(row * DM + cc) * 2u); }
            asm volatile("" ::: "memory");
#pragma unroll
            for (int ai = 0; ai < 2; ++ai)
#pragma unroll
                for (int m = 0; m < 4; ++m) { const int row = row0 + ai * HALF + m * 16; float x[8]; unpack8h(r[ai][m], x);
                    const f32x4 a0 = acc[ai][bj][m][0], a1 = acc[ai][bj][m][1]; const float mu = ms[ai][m].x, rs = ms[ai][m].y;
                    float v[8];
#pragma unroll
                    for (int j = 0; j < 4; ++j) { v[j] = a0[j] + (((x[j] - mu) * rs) * g0[j] + b0[j]); v[4 + j] = a1[j] + (((x[4 + j] - mu) * rs) * g1[j] + b1[j]); }
                    *(bf16x8*)((char*)C + (unsigned)(row * DM + cc) * 2u) = pack8h(v); __builtin_amdgcn_sched_barrier(0); }
            asm volatile("" ::: "memory");
        }
    }
};
template <class Epi, class Sched, bool ALIGN_EPI = false, bool SP2 = false>
__device__ __forceinline__ void gemm_phase(PG8_LAS unsigned char* lds, const Gemm g, const Sched& S, const Epi& E) {
    const int tid = threadIdx.x, wid = __builtin_amdgcn_readfirstlane(tid >> 6), lane = tid & 63, wr = wid >> 2, wc = wid & 3, fr = lane & 15, fq = lane >> 4;
    const int K = g.K, nt = K / BK;
    unsigned voffA[2], voffB[2];
#pragma unroll
    for (int i = 0; i < 2; ++i) { int R, C; stage_rc(tid * 16 + i * 8192, R, C); const int Rb = Epi::PERM ? ((R & ~31) + perm32(R & 31)) : R;
        voffA[i] = (unsigned)(R * K + C) * 2u; voffB[i] = (unsigned)(Rb * K + C) * 2u; }
    const size_t kstep = (size_t)(BK * 2);
    const size_t hstep = (size_t)HALF * K * 2;
    const size_t tstep = 2 * hstep;
    const unsigned ldsw = (unsigned)wid * 1024u;
    const int aoff = lds_byte(wr * 64 + fr, fq * 8), boff = lds_byte(wc * 32 + fr, fq * 8);
#define PG8_SA(b, h) (((b) * 2 + (h)) * HTB)
#define PG8_SB(b, h) ((4 + (b) * 2 + (h)) * HTB)
#define PG8_STAGE(bufoff, gbase, voff) do { _Pragma("unroll") for (int _i = 0; _i < 2; ++_i) \
        __builtin_amdgcn_global_load_lds((const unsigned*)((const char*)(gbase) + (voff)[_i]), (PG8_LAS unsigned*)(lds + (bufoff) + ldsw + _i * 8192), 16, 0, 0); } while (0)
#define PG8_LDA(dst, b, h) do { _Pragma("unroll") for (int m = 0; m < 4; ++m) _Pragma("unroll") for (int k = 0; k < 2; ++k) dst[m][k] = *(const PG8_LAS bf16x8*)(lds + PG8_SA(b, h) + aoff + m * 2048 + k * 1024); } while (0)
#define PG8_LDB(dst, b, h) do { _Pragma("unroll") for (int n = 0; n < 2; ++n) _Pragma("unroll") for (int k = 0; k < 2; ++k) dst[n][k] = *(const PG8_LAS bf16x8*)(lds + PG8_SB(b, h) + boff + n * 2048 + k * 1024); } while (0)
#define PG8_MMA(ai, bj, At, Bt) do { __builtin_amdgcn_s_setprio(1); _Pragma("unroll") for (int m = 0; m < 4; ++m) _Pragma("unroll") for (int n = 0; n < 2; ++n) _Pragma("unroll") for (int k = 0; k < 2; ++k) \
        acc[ai][bj][m][n] = __builtin_amdgcn_mfma_f32_16x16x32_bf16(Bt[n][k], At[m][k], acc[ai][bj][m][n], 0, 0, 0); __builtin_amdgcn_s_setprio(0); } while (0)
#define PG8_WAIT_V(n) asm volatile("s_waitcnt vmcnt(" #n ")" ::: "memory")
#define PG8_WAIT_L(n) asm volatile("s_waitcnt lgkmcnt(" #n ")" ::: "memory")
#define PG8_BAR __builtin_amdgcn_s_barrier()
#define PG8_SCHED __builtin_amdgcn_sched_barrier(0)
    Unit cur, nxt; int ui = 0;
    if (!S.next(0, cur)) return;
    f32x4 acc[2][2][4][2];
#pragma unroll
    for (int a = 0; a < 2; ++a)
#pragma unroll
        for (int b = 0; b < 2; ++b)
#pragma unroll
            for (int m = 0; m < 4; ++m)
#pragma unroll
                for (int n = 0; n < 2; ++n) acc[a][b][m][n] = (f32x4){0.f, 0.f, 0.f, 0.f};
    bf16x8 At[4][2], B0[2][2], B1[2][2];
    const char* cA = (const char*)g.A + (size_t)cur.pm * tstep; const char* cB = (const char*)g.Bt + (size_t)cur.pn * tstep;
    S.a_ready(cur);
    if constexpr (SP2) {
        PG8_STAGE(PG8_SB(0, 0), cB, voffB); PG8_STAGE(PG8_SB(0, 1), cB + hstep, voffB); PG8_STAGE(PG8_SA(0, 0), cA, voffA); PG8_STAGE(PG8_SA(0, 1), cA + hstep, voffA);
        if (wr == 1) PG8_BAR;
        PG8_WAIT_V(2); PG8_BAR;
        PG8_STAGE(PG8_SB(1, 0), cB + kstep, voffB); PG8_STAGE(PG8_SA(1, 0), cA + kstep, voffA); PG8_STAGE(PG8_SB(1, 1), cB + hstep + kstep, voffB);
        PG8_WAIT_V(6); PG8_BAR;
    } else {
        PG8_STAGE(PG8_SB(0, 0), cB, voffB); PG8_STAGE(PG8_SA(0, 0), cA, voffA); PG8_STAGE(PG8_SB(0, 1), cB + hstep, voffB); PG8_STAGE(PG8_SA(0, 1), cA + hstep, voffA);
        if (wr == 1) PG8_BAR;
        PG8_WAIT_V(4); PG8_BAR;
        PG8_STAGE(PG8_SB(1, 0), cB + kstep, voffB); PG8_STAGE(PG8_SA(1, 0), cA + kstep, voffA); PG8_STAGE(PG8_SB(1, 1), cB + hstep + kstep, voffB);
        PG8_WAIT_V(6); PG8_BAR;
    }
    for (;;) {
        const bool has_next = S.next(ui + 1, nxt);
        const char* nA = has_next ? (const char*)g.A + (size_t)nxt.pm * tstep : cA; const char* nB = has_next ? (const char*)g.Bt + (size_t)nxt.pn * tstep : cB;
        for (int t = 0; t < nt; t += 2) {
            const bool last = (t == nt - 2);
            const char* a1 = cA + (size_t)(t + 1) * kstep;
            const char* a2 = last ? nA : cA + (size_t)(t + 2) * kstep; const char* b2 = last ? nB : cB + (size_t)(t + 2) * kstep;
            const char* a3 = a2 + kstep; const char* b3 = b2 + kstep;
            if (last && has_next) S.a_ready(nxt);
            if constexpr (Epi::PREFETCH) { if (t == nt - EPI_PF_TILES) E.prefetch(cur, lds + STAGE_BYTES + wid * 256, wid, lane); }
            if constexpr (SP2) {
            PG8_LDB(B0, 0, 0); PG8_LDB(B1, 0, 1); PG8_SCHED; PG8_LDA(At, 0, 0); PG8_STAGE(PG8_SA(1, 1), a1 + hstep, voffA);
            PG8_WAIT_V(8); PG8_WAIT_L(0); PG8_BAR; PG8_MMA(0, 0, At, B0); PG8_MMA(0, 1, At, B1); PG8_BAR; PG8_SCHED;
            PG8_LDA(At, 0, 1); PG8_STAGE(PG8_SB(0, 0), b2, voffB); PG8_STAGE(PG8_SB(0, 1), b2 + hstep, voffB); PG8_STAGE(PG8_SA(0, 0), a2, voffA);
            PG8_WAIT_V(8); PG8_WAIT_L(0); PG8_BAR; PG8_MMA(1, 0, At, B0); PG8_MMA(1, 1, At, B1); PG8_BAR; PG8_SCHED;
            PG8_LDB(B0, 1, 0); PG8_LDB(B1, 1, 1); PG8_SCHED; PG8_LDA(At, 1, 0); PG8_STAGE(PG8_SA(0, 1), a2 + hstep, voffA);
            PG8_WAIT_V(8); PG8_WAIT_L(0); PG8_BAR; PG8_MMA(0, 0, At, B0); PG8_MMA(0, 1, At, B1); PG8_BAR; PG8_SCHED;
            PG8_LDA(At, 1, 1); PG8_STAGE(PG8_SB(1, 0), b3, voffB); PG8_STAGE(PG8_SB(1, 1), b3 + hstep, voffB); PG8_STAGE(PG8_SA(1, 0), a3, voffA);
            PG8_WAIT_V(8); PG8_WAIT_L(0); PG8_BAR; PG8_MMA(1, 0, At, B0); PG8_MMA(1, 1, At, B1); PG8_BAR; PG8_SCHED;
            } else {
            PG8_LDB(B0, 0, 0); PG8_SCHED; PG8_LDA(At, 0, 0); PG8_STAGE(PG8_SA(1, 1), a1 + hstep, voffA);
            PG8_WAIT_L(8); PG8_BAR; PG8_WAIT_L(0); PG8_MMA(0, 0, At, B0); PG8_BAR; PG8_SCHED;
            PG8_LDB(B1, 0, 1); PG8_STAGE(PG8_SB(0, 0), b2, voffB);
            PG8_BAR; PG8_WAIT_L(0); PG8_MMA(0, 1, At, B1); PG8_BAR;
            PG8_LDA(At, 0, 1); PG8_STAGE(PG8_SA(0, 0), a2, voffA);
            PG8_BAR; PG8_WAIT_L(0); PG8_MMA(1, 0, At, B0); PG8_BAR; PG8_SCHED;
            PG8_STAGE(PG8_SB(0, 1), b2 + hstep, voffB);
            PG8_WAIT_V(6); PG8_BAR; PG8_MMA(1, 1, At, B1); PG8_BAR;
            PG8_LDB(B0, 1, 0); PG8_SCHED; PG8_LDA(At, 1, 0); PG8_STAGE(PG8_SA(0, 1), a2 + hstep, voffA);
            PG8_WAIT_L(8); PG8_BAR; PG8_WAIT_L(0); PG8_MMA(0, 0, At, B0); PG8_BAR; PG8_SCHED;
            PG8_LDB(B1, 1, 1); PG8_STAGE(PG8_SB(1, 0), b3, voffB);
            PG8_BAR; PG8_WAIT_L(0); PG8_MMA(0, 1, At, B1); PG8_BAR;
            PG8_LDA(At, 1, 1); PG8_STAGE(PG8_SA(1, 0), a3, voffA);
            PG8_BAR; PG8_WAIT_L(0); PG8_MMA(1, 0, At, B0); PG8_BAR; PG8_SCHED;
            PG8_STAGE(PG8_SB(1, 1), b3 + hstep, voffB);
            PG8_WAIT_V(6); PG8_BAR; PG8_MMA(1, 1, At, B1); PG8_BAR;
            }
        }
        if constexpr (ALIGN_EPI) { if (wr == 0) PG8_BAR; }
        if constexpr (!Epi::AFTER_DRAIN) { E(acc, cur, wr, wc, fr, fq); S.done(cur); }
        if (!has_next) break;
#pragma unroll
        for (int a = 0; a < 2; ++a)
#pragma unroll
            for (int b = 0; b < 2; ++b)
#pragma unroll
                for (int m = 0; m < 4; ++m)
#pragma unroll
                    for (int n = 0; n < 2; ++n) acc[a][b][m][n] = (f32x4){0.f, 0.f, 0.f, 0.f};
        cur = nxt; cA = nA; cB = nB; ++ui;
        if constexpr (ALIGN_EPI) { if (wr == 1) PG8_BAR; }
    }
    PG8_WAIT_V(0);
    if constexpr (!ALIGN_EPI) { if (wr == 0) PG8_BAR; }
    PG8_BAR;
    if constexpr (Epi::AFTER_DRAIN) { E.fused(acc, cur, wr, wc, fr, fq, lds, wid, lane); S.done(cur); }
#undef PG8_SA
#undef PG8_SB
#undef PG8_STAGE
#undef PG8_LDA
#undef PG8_LDB
#undef PG8_MMA
#undef PG8_WAIT_V
#undef PG8_WAIT_L
#undef PG8_BAR
#undef PG8_SCHED
}
}
namespace fa {
constexpr int KVBLK = 64, SHM_V = 16384, SHM_K = 16384, SHM_KR = 8192;
constexpr int OFF_V = 0, OFF_K = 2 * SHM_V, OFF_KR = OFF_K + 2 * SHM_K, OFF_WS = OFF_KR + 2 * SHM_KR, OFF_IMP = OFF_WS + 8 * 64 * 4, IMP_LD = 257, OFF_QPARK = OFF_IMP + 32 * IMP_LD * 4 + 128  , LDS_END = OFF_QPARK + 8 * 4096;
#define KSWZ(row, colB) ((row) * 256 + ((colB) ^ (((row) & 7) << 4)))
#define KSWZ16(row, colB) ((row) * 256 + ((colB) ^ (((row) & 15) << 4)))
#define SBAR() __builtin_amdgcn_sched_barrier(0)
__device__ __forceinline__ int v_st(int k, int c) { const int kk = (k & ~0xC) | ((k & 4) << 1) | ((k & 8) >> 1); return ((kk >> 3) * 4 + (c >> 5)) * 512 + ((kk & 7) * 32 + (c & 31)) * 2; }
__device__ __forceinline__ int v_rd_base(int lane) { return ((lane & 3) << 3) | (((lane >> 2) & 3) << 6) | (((lane >> 4) & 1) << 5) | (((lane >> 5) & 1) << 8); }
constexpr int v_rd_off(int d0, int ks, int half) { return d0 * 512 + ks * 4096 + half * 2048; }
__device__ __forceinline__ int crow(int r, int hi) { return (r & 3) + 8 * (r >> 2) + 4 * hi; }
__device__ __forceinline__ unsigned cvtpk(float lo, float hi) { unsigned r; asm volatile("v_cvt_pk_bf16_f32 %0, %1, %2" : "=v"(r) : "v"(lo), "v"(hi)); return r; }
__device__ __forceinline__ bf16x8 pack8(f32x4 a, f32x4 b) { u32x4 w = {cvtpk(a[0], a[1]), cvtpk(a[2], a[3]), cvtpk(b[0], b[1]), cvtpk(b[2], b[3])}; return *reinterpret_cast<bf16x8*>(&w); }
__device__ __forceinline__ void mask_tile(f32x16& p0, f32x16& p1, int dq, unsigned W) {
    const float NEG = -__builtin_inff();
#pragma unroll
    for (int r = 0; r < 16; ++r) {
        const int c = (r & 3) + 8 * (r >> 2);
        if ((unsigned)(dq - c) >= W) p0[r] = NEG;
        if ((unsigned)(dq - c - 32) >= W) p1[r] = NEG;
    }
}
__device__ __forceinline__ void mask_all(f32x16& p0, f32x16& p1, bool kill) {
    const float NEG = -__builtin_inff();
#pragma unroll
    for (int r = 0; r < 16; ++r) { if (kill) { p0[r] = NEG; p1[r] = NEG; } }
}
__device__ __forceinline__ void partialSM(f32x16& p0, f32x16& p1, float& m_reg, float& mn, float& alpha, float scale, float C2, bool kill = false) {
    float pmax = p0[0];
#pragma unroll
    for (int r = 1; r < 16; ++r) pmax = fmaxf(pmax, p0[r]);
#pragma unroll
    for (int r = 0; r < 16; ++r) pmax = fmaxf(pmax, p1[r]);
    { auto rr = __builtin_amdgcn_permlane32_swap(__float_as_uint(pmax), __float_as_uint(pmax), false, false);
      pmax = fmaxf(__uint_as_float(rr[0]), __uint_as_float(rr[1])); }
    if (__builtin_expect(__all((pmax - m_reg) * scale <= 8.0f), 1)) { mn = m_reg; alpha = 1.f; }
    else { mn = fmaxf(m_reg, pmax); alpha = __builtin_amdgcn_exp2f((m_reg - mn) * C2); m_reg = mn; }
    const float mnL = kill ? -__builtin_inff() : -mn * C2;
#pragma unroll
    for (int r = 0; r < 16; ++r) p0[r] = fmaf(p0[r], C2, mnL);
#pragma unroll
    for (int r = 0; r < 16; ++r) p1[r] = fmaf(p1[r], C2, mnL);
#pragma unroll
    for (int r = 0; r < 16; ++r) p0[r] = __builtin_amdgcn_exp2f(p0[r]);
}
__device__ __forceinline__ void finishSM(f32x16& p0, f32x16& p1, float alpha, float& l_reg, bf16x8& pa0, bf16x8& pa1, bf16x8& pa2, bf16x8& pa3) {
#pragma unroll
    for (int r = 0; r < 16; ++r) p1[r] = __builtin_amdgcn_exp2f(p1[r]);
    float ps = 0;
#pragma unroll
    for (int r = 0; r < 16; ++r) ps += p0[r];
#pragma unroll
    for (int r = 0; r < 16; ++r) ps += p1[r];
    { auto rr = __builtin_amdgcn_permlane32_swap(__float_as_uint(ps), __float_as_uint(ps), false, false);
      ps = __uint_as_float(rr[0]) + __uint_as_float(rr[1]); }
    l_reg = l_reg * alpha + ps;
#define PK4(P, B_, OUT) do { unsigned a0 = cvtpk(P[B_+0], P[B_+1]), a1 = cvtpk(P[B_+2], P[B_+3]);                          \
        unsigned b0 = cvtpk(P[B_+4], P[B_+5]), b1 = cvtpk(P[B_+6], P[B_+7]);                                             \
        auto r0 = __builtin_amdgcn_permlane32_swap(a0, b0, false, false); auto r1 = __builtin_amdgcn_permlane32_swap(a1, b1, false, false); \
        u32x4 w = {r0[0], r1[0], r0[1], r1[1]}; OUT = *reinterpret_cast<bf16x8*>(&w); } while (0)
    PK4(p0, 0, pa0); PK4(p0, 8, pa1); PK4(p1, 0, pa2); PK4(p1, 8, pa3);
#undef PK4
}
template <int KB, bool ROPE, bool LIGHT = false>
__device__ __forceinline__ void qkt(f32x16& p0, f32x16& p1, const char* lds, int r32, int hi, const bf16x8* qr, const char* qpark = nullptr) {
    p0 = f32x16{}; p1 = f32x16{};
    const char* K_lds = lds + OFF_K;
    const char* kb[4];
#pragma unroll
    for (int dd = 0; dd < 4; ++dd) kb[dd] = K_lds + KB * SHM_K + KSWZ(r32, (dd * 16 + hi * 8) * 2);
    bf16x8 f[4][4];
#define QK_LD(g) do { const char* a0_ = kb[(2 * (g)) & 3] + ((2 * (g)) >> 2) * 128; const char* a1_ = kb[(2 * (g) + 1) & 3] + ((2 * (g) + 1) >> 2) * 128; \
        f[(g) & 3][0] = *reinterpret_cast<const bf16x8*>(a0_); f[(g) & 3][1] = *reinterpret_cast<const bf16x8*>(a0_ + 32 * 256); \
        f[(g) & 3][2] = *reinterpret_cast<const bf16x8*>(a1_); f[(g) & 3][3] = *reinterpret_cast<const bf16x8*>(a1_ + 32 * 256); } while (0)
#define QK_MM(g) do { p0 = __builtin_amdgcn_mfma_f32_32x32x16_bf16(f[(g) & 3][0], qr[2 * (g)], p0, 0, 0, 0); p1 = __builtin_amdgcn_mfma_f32_32x32x16_bf16(f[(g) & 3][1], qr[2 * (g)], p1, 0, 0, 0); \
        p0 = __builtin_amdgcn_mfma_f32_32x32x16_bf16(f[(g) & 3][2], qr[2 * (g) + 1], p0, 0, 0, 0); p1 = __builtin_amdgcn_mfma_f32_32x32x16_bf16(f[(g) & 3][3], qr[2 * (g) + 1], p1, 0, 0, 0); } while (0)
    if constexpr (ROPE) {
        QK_LD(0); SBAR();
        QK_LD(1); SBAR(); QK_MM(0); SBAR();
        QK_LD(2); SBAR(); QK_MM(1); SBAR();
        QK_LD(3); SBAR(); QK_MM(2); SBAR();
        const char* KR_lds = lds + OFF_KR + KB * SHM_KR + r32 * 128;
        bf16x8 ra[2], rb[2], qa, qb_;
#define QR_LD(d0, R, Q) do { const char* a = KR_lds + (((d0) * 32 + hi * 16) ^ ((r32 & 7) << 4)); R[0] = *reinterpret_cast<const bf16x8*>(a); R[1] = *reinterpret_cast<const bf16x8*>(a + 32 * 128); Q = *reinterpret_cast<const bf16x8*>(qpark + (d0) * 1024); } while (0)
#define QR_MM(R, Q) do { p0 = __builtin_amdgcn_mfma_f32_32x32x16_bf16(R[0], Q, p0, 0, 0, 0); p1 = __builtin_amdgcn_mfma_f32_32x32x16_bf16(R[1], Q, p1, 0, 0, 0); } while (0)
        QR_LD(0, ra, qa); SBAR(); QK_MM(3); SBAR();
        QR_LD(1, rb, qb_); SBAR(); QR_MM(ra, qa); SBAR();
        QR_LD(2, ra, qa); SBAR(); QR_MM(rb, qb_); SBAR();
        QR_LD(3, rb, qb_); SBAR(); QR_MM(ra, qa); SBAR();
        QR_MM(rb, qb_);
#undef QR_LD
#undef QR_MM
    } else if constexpr (LIGHT) {
        QK_LD(0); SBAR();
        QK_LD(1); SBAR(); QK_MM(0); SBAR();
        QK_LD(2); SBAR(); QK_MM(1); SBAR();
        QK_LD(3); SBAR(); QK_MM(2); SBAR();
        QK_MM(3);
    } else {
        QK_LD(0); QK_LD(1); SBAR();
        QK_LD(2); SBAR(); QK_MM(0); SBAR();
        QK_LD(3); SBAR(); QK_MM(1); SBAR();
        QK_MM(2); QK_MM(3);
    }
#undef QK_LD
#undef QK_MM
}
template <int VB, bool PIPE>
__device__ __forceinline__ void pv_tile(f32x16* o, int vb0, bf16x8 pa0, bf16x8 pa1, bf16x8 pa2, bf16x8 pa3) {
#define TRRD(dst, off) asm volatile("ds_read_b64_tr_b16 %0, %1 offset:%2" : "=&v"(dst) : "v"(vb0), "i"(off) : "memory")
#define PV_LD(S, d0) do { constexpr int b_ = OFF_V + VB * SHM_V + v_rd_off(d0, 0, 0); TRRD(S[0], b_); TRRD(S[1], b_ + 2048); TRRD(S[2], b_ + 4096); TRRD(S[3], b_ + 6144); TRRD(S[4], b_ + 8192); TRRD(S[5], b_ + 10240); TRRD(S[6], b_ + 12288); TRRD(S[7], b_ + 14336); } while (0)
#define PV_MM(S, d0) do { \
        o[d0] = __builtin_amdgcn_mfma_f32_32x32x16_bf16(pa0, (bf16x8){S[0][0], S[0][1], S[0][2], S[0][3], S[1][0], S[1][1], S[1][2], S[1][3]}, o[d0], 0, 0, 0);   \
        o[d0] = __builtin_amdgcn_mfma_f32_32x32x16_bf16(pa1, (bf16x8){S[2][0], S[2][1], S[2][2], S[2][3], S[3][0], S[3][1], S[3][2], S[3][3]}, o[d0], 0, 0, 0);   \
        o[d0] = __builtin_amdgcn_mfma_f32_32x32x16_bf16(pa2, (bf16x8){S[4][0], S[4][1], S[4][2], S[4][3], S[5][0], S[5][1], S[5][2], S[5][3]}, o[d0], 0, 0, 0);   \
        o[d0] = __builtin_amdgcn_mfma_f32_32x32x16_bf16(pa3, (bf16x8){S[6][0], S[6][1], S[6][2], S[6][3], S[7][0], S[7][1], S[7][2], S[7][3]}, o[d0], 0, 0, 0); } while (0)
#define PV_W(n) do { asm volatile("s_waitcnt lgkmcnt(" #n ")" ::: "memory"); SBAR(); } while (0)
    if constexpr (PIPE) {
        s16x4 A[8], B[8];
        PV_LD(A, 0); PV_LD(B, 1); PV_W(8); PV_MM(A, 0);
        PV_LD(A, 2); PV_W(8); PV_MM(B, 1);
        PV_LD(B, 3); PV_W(8); PV_MM(A, 2);
        PV_W(0); PV_MM(B, 3);
    } else {
        s16x4 A[8];
        PV_LD(A, 0); PV_W(0); PV_MM(A, 0); PV_LD(A, 1); PV_W(0); PV_MM(A, 1); PV_LD(A, 2); PV_W(0); PV_MM(A, 2); PV_LD(A, 3); PV_W(0); PV_MM(A, 3);
    }
#undef PV_W
#undef PV_MM
#undef PV_LD
#undef TRRD
}

struct FUnit {
    const bf16_t* Kb; long ldk; const bf16_t* Vb; long ldv; const bf16_t* KRb;
    int j_lo, j_hi;
    int qlo, qhi;
    int qpos;
    unsigned long long sel;
};
template <int MODE, int VAR = 0>
__device__ __forceinline__ void flash_core(char* lds, const FUnit& u, const bf16x8* qr, float scale, f32x16 (&o)[4], float& m_reg, float& l_reg) {
    constexpr bool ROPE = (MODE == 0);
    const int tid = threadIdx.x, wid = __builtin_amdgcn_readfirstlane(tid >> 6), lane = tid & 63, r32 = lane & 31, hi = lane >> 5;
    const int grp = wid >> 2;
    const float C2 = 1.4426950408889634f * scale;
    char* V_lds = lds + OFF_V; char* K_lds = lds + OFF_K; char* KR_lds = lds + OFF_KR;
    float* ws = (float*)(lds + OFF_WS) + wid * 64; float* al_l = ws + 32;
    const int sr = tid >> 4, sc = (tid & 15) * 8, vst0 = v_st(sr, sc), vst1 = v_st(32 + sr, sc), kws = KSWZ(sr, sc * 2);
    const int rr = tid >> 3, rc = (tid & 7) * 8, krws = rr * 128 + ((rc * 2) ^ ((rr & 7) << 4));
    const int vb0 = (int)(uintptr_t)lds + v_rd_base(lane);
    const char* qpark = lds + OFF_QPARK + wid * 4096 + lane * 16;
    m_reg = -1e30f; l_reg = 0.f;
#pragma unroll
    for (int d = 0; d < 4; ++d) o[d] = f32x16{};
    const int NT = u.j_hi - u.j_lo;
    if (NT <= 0) return;
    bf16x8 st_k0, st_k1, st_v0, st_v1, st_kr;
    f32x16 p0, p1; float mn, al; bf16x8 pa0, pa1, pa2, pa3;
    const unsigned W = (MODE == 1) ? 512u : ((MODE == 3) ? 0x80000000u : 0x7fffffffu);
#define FA_KBASE(t) ((u.j_lo + (t)) * KVBLK)
#define FA_KLOAD(k0) do { st_k0 = *(const bf16x8*)(u.Kb + (long)((k0) + sr) * u.ldk + sc); st_k1 = *(const bf16x8*)(u.Kb + (long)((k0) + 32 + sr) * u.ldk + sc);   \
                          if constexpr (ROPE) st_kr = *(const bf16x8*)(u.KRb + (long)((k0) + rr) * 64 + rc); } while (0)
#define FA_VLOAD(k0) do { st_v0 = *(const bf16x8*)(u.Vb + (long)((k0) + sr) * u.ldv + sc); st_v1 = *(const bf16x8*)(u.Vb + (long)((k0) + 32 + sr) * u.ldv + sc); } while (0)
#define FA_KWRITE(bf) do { *(bf16x8*)(K_lds + (bf) * SHM_K + kws) = st_k0; *(bf16x8*)(K_lds + (bf) * SHM_K + kws + 32 * 256) = st_k1;   \
                           if constexpr (ROPE) *(bf16x8*)(KR_lds + (bf) * SHM_KR + krws) = st_kr; } while (0)
#define FA_VWRITE(bf) do { *(bf16x8*)(V_lds + (bf) * SHM_V + vst0) = st_v0; *(bf16x8*)(V_lds + (bf) * SHM_V + vst1) = st_v1; } while (0)
#define FA_BAR() do { asm volatile("s_waitcnt lgkmcnt(0)" ::: "memory"); __builtin_amdgcn_s_barrier(); asm volatile("" ::: "memory"); } while (0)
#define FA_RESC(a) do { if (__any((a) < 1.f)) { if (hi == 0) al_l[r32] = (a); asm volatile("s_waitcnt lgkmcnt(0)" ::: "memory");              \
                     _Pragma("unroll") for (int d_ = 0; d_ < 4; ++d_) { _Pragma("unroll") for (int r = 0; r < 16; ++r) o[d_][r] *= al_l[crow(r, hi)]; } asm volatile("" ::: "memory"); } } while (0)
#define FA_MASK(t) do { const int kb_ = FA_KBASE(t);                                                                             \
        if (MODE == 1) { if (kb_ + KVBLK - 1 > u.qlo || kb_ <= u.qhi - 512) mask_tile(p0, p1, u.qpos - kb_ - 4 * hi, W); }       \
        else { if (kb_ + KVBLK - 1 > u.qlo) mask_tile(p0, p1, u.qpos - kb_ - 4 * hi, W); }                                       \
        } while (0)
#define FA_KILL(t) ((MODE == 2) && (((u.sel >> (u.j_lo + (t))) & 1ull) == 0ull))
    const int kb_last = FA_KBASE(NT - 1);
    FA_KLOAD(FA_KBASE(0)); FA_VLOAD(FA_KBASE(0));
    FA_KWRITE(0); FA_VWRITE(0);
    { const int k1 = FA_KBASE(1); FA_KLOAD(k1 < kb_last ? k1 : kb_last); }
    FA_BAR();
    if (grp == 1) FA_BAR();
#define FA_STEP(BF, t) do {                                                                                                      \
        if (!(VAR & 8)) { const int k1 = FA_KBASE((t) + 1); FA_VLOAD(k1 < kb_last ? k1 : kb_last); }                             \
        SBAR(); if (!(VAR & 1)) qkt<BF, ROPE, MODE == 3>(p0, p1, lds, r32, hi, qr, qpark); else { p0 = f32x16{}; p1 = f32x16{}; p0[0] = (float)(t); }   \
        if (!(VAR & 2)) { FA_MASK(t); partialSM(p0, p1, m_reg, mn, al, scale, C2, FA_KILL(t)); FA_RESC(al); } else { al = 1.f; }   \
        if (!(VAR & 8)) FA_KWRITE((BF) ^ 1);                                                                                     \
        if (!(VAR & 16)) FA_BAR();                                                                                               \
        if (!(VAR & 8)) { const int k2 = FA_KBASE((t) + 2); FA_KLOAD(k2 < kb_last ? k2 : kb_last); }                             \
        if (!(VAR & 2)) finishSM(p0, p1, al, l_reg, pa0, pa1, pa2, pa3); else { l_reg += p0[0]; pa0 = pack8(f32x4{p0[0], p0[1], p0[2], p0[3]}, f32x4{p1[0], p1[1], p1[2], p1[3]}); pa1 = pa0; pa2 = pa0; pa3 = pa0; } \
        SBAR();                                                                                                                  \
        if (!(VAR & 4)) pv_tile<BF, (MODE == 1 || MODE == 2)>(o, vb0, pa0, pa1, pa2, pa3); else { o[0][0] += __builtin_bit_cast(float, (int)pa0[0]); }      \
        if (!(VAR & 8)) FA_VWRITE((BF) ^ 1);                                                                                     \
        if (!(VAR & 16)) FA_BAR(); } while (0)
    int t = 0;
    for (; t + 1 < NT; t += 2) {
        FA_STEP(0, t);
        FA_STEP(1, t + 1);
    }
    if (NT & 1) {
        SBAR(); if (!(VAR & 1)) qkt<0, ROPE, MODE == 3>(p0, p1, lds, r32, hi, qr, qpark); else { p0 = f32x16{}; p1 = f32x16{}; }
        if (!(VAR & 2)) { FA_MASK(t); partialSM(p0, p1, m_reg, mn, al, scale, C2, FA_KILL(t)); FA_RESC(al); } else { al = 1.f; }
        if (!(VAR & 16)) FA_BAR();
        if (!(VAR & 2)) finishSM(p0, p1, al, l_reg, pa0, pa1, pa2, pa3); else { pa0 = pack8(f32x4{p0[0], p0[1], p0[2], p0[3]}, f32x4{p1[0], p1[1], p1[2], p1[3]}); pa1 = pa0; pa2 = pa0; pa3 = pa0; }
        SBAR();
        if (!(VAR & 4)) pv_tile<0, (MODE == 1 || MODE == 2)>(o, vb0, pa0, pa1, pa2, pa3);
        if (!(VAR & 16)) FA_BAR();
    }
#undef FA_STEP
    if (grp == 0) FA_BAR();
#undef FA_MASK
#undef FA_KILL
#undef FA_RESC
#undef FA_BAR
#undef FA_VWRITE
#undef FA_KWRITE
#undef FA_VLOAD
#undef FA_KLOAD
#undef FA_KBASE
}
template <int MODE>
__device__ __forceinline__ void flash_core2(char* lds, const FUnit& u, const bf16x8* qr, float scale, f32x16 (&o)[4], float& m_reg, float& l_reg) {
    const int tid = threadIdx.x, wid = __builtin_amdgcn_readfirstlane(tid >> 6), lane = tid & 63, r32 = lane & 31, hi = lane >> 5;
    const float C2 = 1.4426950408889634f * scale;
    char* V_lds = lds + OFF_V; char* K_lds = lds + OFF_K;
    float* ws = (float*)(lds + OFF_WS) + wid * 64; float* al_l = ws + 32;
    const int sr = tid >> 4, sc = (tid & 15) * 8, vst0 = v_st(sr, sc), vst1 = v_st(32 + sr, sc), kws = KSWZ(sr, sc * 2);
    const int vb0 = (int)(uintptr_t)lds + v_rd_base(lane);
    m_reg = -1e30f; l_reg = 0.f;
#pragma unroll
    for (int d = 0; d < 4; ++d) o[d] = f32x16{};
    const int NT = u.j_hi - u.j_lo;
    if (NT <= 0) return;
    bf16x8 st_k0, st_k1, st_v0, st_v1;
    f32x16 pA0, pA1, pB0, pB1; float mnA, mnB, alA, alB; bf16x8 pa0, pa1, pa2, pa3;
    const unsigned W = (MODE == 1) ? 512u : 0x7fffffffu;
#define F2_KBASE(t) ((u.j_lo + (t)) * KVBLK)
#define F2_LOAD(k0) do { st_v0 = *(const bf16x8*)(u.Vb + (long)((k0) + sr) * u.ldv + sc); st_v1 = *(const bf16x8*)(u.Vb + (long)((k0) + 32 + sr) * u.ldv + sc);   \
                         st_k0 = *(const bf16x8*)(u.Kb + (long)((k0) + sr) * u.ldk + sc); st_k1 = *(const bf16x8*)(u.Kb + (long)((k0) + 32 + sr) * u.ldk + sc); } while (0)
#define F2_WRITE(bf) do { *(bf16x8*)(V_lds + (bf) * SHM_V + vst0) = st_v0; *(bf16x8*)(V_lds + (bf) * SHM_V + vst1) = st_v1;   \
                          *(bf16x8*)(K_lds + (bf) * SHM_K + kws) = st_k0; *(bf16x8*)(K_lds + (bf) * SHM_K + kws + 32 * 256) = st_k1; } while (0)
#define F2_VMW() asm volatile("s_waitcnt vmcnt(0)" ::: "memory")
#define F2_RESC(a) do { if (__any((a) < 1.f)) { if (hi == 0) al_l[r32] = (a); asm volatile("s_waitcnt lgkmcnt(0)" ::: "memory");              \
                     _Pragma("unroll") for (int d_ = 0; d_ < 4; ++d_) { _Pragma("unroll") for (int r = 0; r < 16; ++r) o[d_][r] *= al_l[crow(r, hi)]; } asm volatile("" ::: "memory"); } } while (0)
#define F2_MASK(P0_, P1_, t) do { const int kb_ = F2_KBASE(t);                                                                    \
        if (MODE == 1) { if (kb_ + KVBLK - 1 > u.qlo || kb_ <= u.qhi - 512) mask_tile(P0_, P1_, u.qpos - kb_ - 4 * hi, W); }      \
        else { if (kb_ + KVBLK - 1 > u.qlo) mask_tile(P0_, P1_, u.qpos - kb_ - 4 * hi, W); } } while (0)
#define F2_KILL(t) ((MODE == 2) && (((u.sel >> (u.j_lo + (t))) & 1ull) == 0ull))
#define F2_HALF(PX0, PX1, mnX, alX, PY0, PY1, alY, t, KB, VB, SB) do {                                                            \
        SBAR(); qkt<KB, false, true>(PX0, PX1, lds, r32, hi, qr);                                                                 \
        finishSM(PY0, PY1, alY, l_reg, pa0, pa1, pa2, pa3); SBAR();                                                               \
        if ((t) + 1 < NT) { F2_LOAD(F2_KBASE((t) + 1)); SBAR(); }                                                                 \
        pv_tile<VB, false>(o, vb0, pa0, pa1, pa2, pa3); F2_MASK(PX0, PX1, (t)); partialSM(PX0, PX1, m_reg, mnX, alX, scale, C2, F2_KILL(t)); \
        __syncthreads();                                                                                                          \
        if ((t) + 1 < NT) { F2_VMW(); F2_WRITE(SB); }                                                                             \
        F2_RESC(alX); __syncthreads(); } while (0)
    F2_LOAD(F2_KBASE(0)); F2_VMW(); F2_WRITE(0); __syncthreads();
    if (NT > 1) F2_LOAD(F2_KBASE(1));
    SBAR(); qkt<0, false, true>(pA0, pA1, lds, r32, hi, qr);
    F2_MASK(pA0, pA1, 0); partialSM(pA0, pA1, m_reg, mnA, alA, scale, C2, F2_KILL(0));
    if (NT > 1) { F2_VMW(); F2_WRITE(1); }
    __syncthreads();
    for (int t = 1; t + 1 < NT; t += 2) {
        F2_HALF(pB0, pB1, mnB, alB, pA0, pA1, alA, t, 1, 0, 0);
        F2_HALF(pA0, pA1, mnA, alA, pB0, pB1, alB, t + 1, 0, 1, 1);
    }
    const bool even = (NT & 1) == 0;
    if (even) { SBAR(); qkt<1, false, true>(pB0, pB1, lds, r32, hi, qr); SBAR(); }
    finishSM(pA0, pA1, alA, l_reg, pa0, pa1, pa2, pa3); SBAR();
    pv_tile<0, false>(o, vb0, pa0, pa1, pa2, pa3);
    if (even) { F2_MASK(pB0, pB1, NT - 1); partialSM(pB0, pB1, m_reg, mnB, alB, scale, C2, F2_KILL(NT - 1)); F2_RESC(alB);
        finishSM(pB0, pB1, alB, l_reg, pa0, pa1, pa2, pa3); SBAR(); pv_tile<1, false>(o, vb0, pa0, pa1, pa2, pa3); }
#undef F2_HALF
#undef F2_KILL
#undef F2_MASK
#undef F2_RESC
#undef F2_VMW
#undef F2_WRITE
#undef F2_LOAD
#undef F2_KBASE
}
__device__ __forceinline__ void row_factors(char* lds, int wid, int r32, int hi, float f, float (&rf)[16]) {
    float* li_l = (float*)(lds + OFF_WS) + wid * 64;
    asm volatile("" ::: "memory");
    if (hi == 0) li_l[r32] = f;
    asm volatile("s_waitcnt lgkmcnt(0)" ::: "memory");
#pragma unroll
    for (int r = 0; r < 16; ++r) rf[r] = li_l[crow(r, hi)];
    asm volatile("s_waitcnt lgkmcnt(0)" ::: "memory");
}
}

constexpr size_t MiB = 1ull << 20, KiB = 1ull << 10;
constexpr size_t WS_CTL = 0;
constexpr size_t WS_ROPE = 64 * KiB;
constexpr size_t WS_MG = WS_ROPE + 1 * MiB;
constexpr size_t WS_FLOOR = WS_MG + 512 * KiB;
constexpr size_t WS_DEN = WS_FLOOR + 256 * KiB;
constexpr size_t WS_GATES = WS_DEN + 256 * KiB;
constexpr size_t WS_SEL = WS_GATES + 512 * KiB;
constexpr size_t WS_KROPE = WS_SEL + 512 * KiB;
constexpr size_t WS_CQN = WS_KROPE + 2 * MiB;
constexpr size_t WS_CKVN = WS_CQN + 32 * MiB;
constexpr size_t WS_KVB = WS_CKVN + 16 * MiB;
constexpr size_t WS_XB = WS_KVB + 128 * MiB;
constexpr size_t WS_Z = WS_XB + 128 * MiB;
constexpr size_t WS_R = WS_Z + 256 * MiB;
constexpr size_t WS_W = WS_R + 344 * MiB;
constexpr size_t W_AB = WS_W, W_UQ = W_AB + 62 * MiB, W_UKV = W_UQ + 6 * MiB, W_O0 = W_UKV + 4 * MiB, W_GU0 = W_O0 + 32 * MiB, W_D0 = W_GU0 + 172 * MiB;
constexpr size_t W_C = W_D0 + 86 * MiB, W_C1K = W_C + 58 * MiB, W_C1V = W_C1K + 2 * MiB, W_C2K = W_C1V + 2 * MiB, W_C2V = W_C2K + 128 * KiB, W_O1 = W_C2V + 128 * KiB;
constexpr size_t W_GU1 = W_O1 + 32 * MiB, W_D1 = W_GU1 + 172 * MiB, WS_AT = W_D1 + 86 * MiB;
constexpr size_t WS_AA = WS_AT + 256 * KiB;
constexpr size_t WS_DENI = WS_AA + 256 * KiB;
constexpr size_t WS_DENP = WS_DENI + 256 * KiB;
constexpr size_t WS_STATS = WS_DENP + 4 * MiB;
constexpr size_t WS_END = WS_STATS + 128 * KiB;
constexpr size_t WS_AK = WS_KVB, WS_AV = WS_AK + 32 * MiB, WS_HK = WS_AV + 32 * MiB, WS_HV = WS_HK + 2 * MiB, WS_KCMP = WS_HV + 2 * MiB, WS_VCMP = WS_KCMP + 2 * MiB;
constexpr size_t WS_QB = WS_R + (size_t)M_TOK * AB_NP * 2;

constexpr int NTHREADS = 512;
constexpr int LDS_BYTES = 152 * 1024, LDS_CTL_OFF = LDS_BYTES - 256;
constexpr int N_TJOBS = 14;
struct TJob { const float* s; const float* s2; bf16_t* d; int K, N, Np, mode; };
struct Args { const float* in[26]; float* out; unsigned char* ws; TJob tj[N_TJOBS]; int ph_lo, ph_hi; };

__device__ __forceinline__ void transpose_tile(char* lds, const TJob& jb, int t) {
    float* T = (float*)lds;
    const int tid = threadIdx.x;
    const int tn = jb.Np >> 6;
    const int in_ = t % tn, ik = t / tn, n0 = in_ * 64, k0 = ik * 64;
    const float* sp = jb.s; int c0 = n0; const int ncols = jb.N;
    if (jb.mode == 1) { const int tile = n0 >> 8, j = n0 & 255; sp = (j < 128) ? jb.s : jb.s2; c0 = tile * 128 + (j & 127); }
    const int kk = tid >> 4, nc = (tid & 15) * 4;
    f32x4 v0 = {0.f, 0.f, 0.f, 0.f}, v1 = v0;
    if (c0 + nc < ncols) { v0 = *(const f32x4*)(sp + (size_t)(k0 + kk) * ncols + c0 + nc); v1 = *(const f32x4*)(sp + (size_t)(k0 + kk + 32) * ncols + c0 + nc); }
#pragma unroll
    for (int j = 0; j < 4; ++j) { T[(nc + j) * 65 + kk] = v0[j]; T[(nc + j) * 65 + kk + 32] = v1[j]; }
    __syncthreads();
    const int n = tid >> 3, kc = (tid & 7) * 8;
    float f[8];
#pragma unroll
    for (int j = 0; j < 8; ++j) f[j] = T[n * 65 + kc + j];
    *(bf16x8*)(jb.d + (size_t)(n0 + n) * jb.K + k0 + kc) = pack8f(f);
    __syncthreads();
}
constexpr int N_TJOBS_PRO = 11;
__device__ __forceinline__ void transpose_jobs(char* lds, const Args& a) {
    for (int ji = 0; ji < N_TJOBS_PRO; ++ji) {
        const TJob jb = a.tj[ji];
        const int nt = (jb.K >> 6) * (jb.Np >> 6);
        for (int t = blockIdx.x; t < nt; t += gridDim.x) transpose_tile(lds, jb, t);
    }
}
constexpr int LATE_T0 = 64 * 64, LATE_T1 = 64 * 344, LATE_T2 = 172 * 64, LATE_A = LATE_T0 + LATE_T1, LATE_TOTAL = LATE_A + LATE_T2, LATE_SLOTS = 64 + 128 + 192 + 224, LATE_PER = (LATE_A + LATE_SLOTS - 1) / LATE_SLOTS;
constexpr int LATE_D_SLOTS = 128, LATE_D_PER = LATE_T2 / LATE_D_SLOTS;
static_assert(LATE_D_PER * LATE_D_SLOTS == LATE_T2, "down-weight tiles per slot");
struct TTile { const float* sp; bf16_t* d; int K, ncols, c0, n0, k0; };
__device__ __forceinline__ TTile late_tile(const Args& a, int g) {
    const int ji = g < LATE_T0 ? 11 : (g < LATE_T0 + LATE_T1 ? 12 : 13); const int t = g - (ji == 11 ? 0 : (ji == 12 ? LATE_T0 : LATE_T0 + LATE_T1));
    const TJob jb = a.tj[ji]; const int tn = jb.Np >> 6; TTile r; r.n0 = (t % tn) * 64; r.k0 = (t / tn) * 64; r.sp = jb.s; r.c0 = r.n0; r.ncols = jb.N; r.d = jb.d; r.K = jb.K;
    if (jb.mode == 1) { const int tile = r.n0 >> 8, j = r.n0 & 255; r.sp = (j < 128) ? jb.s : jb.s2; r.c0 = tile * 128 + (j & 127); }
    return r;
}
__device__ __forceinline__ void transpose_span(char* lds, const Args& a, int g0, int g1) {
    float* T = (float*)lds;
    const int tid = threadIdx.x, kk = tid >> 4, nc = (tid & 15) * 4, n = tid >> 3, kc = (tid & 7) * 8;
    if (g0 >= g1) return;
    __syncthreads();
    TTile cur = late_tile(a, g0);
    f32x4 v0 = {0.f, 0.f, 0.f, 0.f}, v1 = v0;
    if (cur.c0 + nc < cur.ncols) { v0 = *(const f32x4*)(cur.sp + (size_t)(cur.k0 + kk) * cur.ncols + cur.c0 + nc); v1 = *(const f32x4*)(cur.sp + (size_t)(cur.k0 + kk + 32) * cur.ncols + cur.c0 + nc); }
    for (int g = g0; g < g1; ++g) {
        const TTile nxt = late_tile(a, g + 1 < g1 ? g + 1 : g);
        f32x4 w0 = {0.f, 0.f, 0.f, 0.f}, w1 = w0;
        if (nxt.c0 + nc < nxt.ncols) { w0 = *(const f32x4*)(nxt.sp + (size_t)(nxt.k0 + kk) * nxt.ncols + nxt.c0 + nc); w1 = *(const f32x4*)(nxt.sp + (size_t)(nxt.k0 + kk + 32) * nxt.ncols + nxt.c0 + nc); }
#pragma unroll
        for (int j = 0; j < 4; ++j) { T[(nc + j) * 65 + kk] = v0[j]; T[(nc + j) * 65 + kk + 32] = v1[j]; }
        __syncthreads();
        float f[8];
#pragma unroll
        for (int j = 0; j < 8; ++j) f[j] = T[n * 65 + kc + j];
        *(bf16x8*)(cur.d + (size_t)(cur.n0 + n) * cur.K + cur.k0 + kc) = pack8f(f);
        __syncthreads();
        cur = nxt; v0 = w0; v1 = w1;
    }
}
__device__ __forceinline__ void transpose_late(char* lds, const Args& a, int slot) { const int g0 = slot * LATE_PER, g1 = (slot + 1) * LATE_PER < LATE_A ? (slot + 1) * LATE_PER : LATE_A; transpose_span(lds, a, g0, g1); }
__device__ __forceinline__ void transpose_late_d(char* lds, const Args& a, int slot) { transpose_span(lds, a, LATE_A + slot * LATE_D_PER, LATE_A + (slot + 1) * LATE_D_PER); }
__device__ __forceinline__ void p0_prologue(char* lds, const Args& a) {
    const int tid = threadIdx.x;
    const size_t gt = (size_t)blockIdx.x * NTHREADS + tid, gs = (size_t)gridDim.x * NTHREADS;
    { const float* x = a.in[0]; bf16_t* xb = (bf16_t*)(a.ws + WS_XB);
      for (size_t i = gt; i < (size_t)M_TOK * DM / 8; i += gs) { const f32x4 v0 = *(const f32x4*)(x + i * 8), v1 = *(const f32x4*)(x + i * 8 + 4);
          float f[8] = {v0[0], v0[1], v0[2], v0[3], v1[0], v1[1], v1[2], v1[3]}; *(bf16x8*)(xb + i * 8) = pack8f(f); } }
    { f32x2* rp = (f32x2*)(a.ws + WS_ROPE);
      for (size_t i = gt; i < (size_t)SEQ * 32; i += gs) { const int pos = (int)(i >> 5), j = (int)(i & 31);
          const double inv = exp(-(double)j / 32.0 * 9.210340371976184  ); const double ang = (double)pos * inv; rp[i] = (f32x2){(float)cos(ang), (float)sin(ang)}; } }
    transpose_jobs(lds, a);
}

__device__ __forceinline__ float softcap15(float z) { return 15.0f * tanhf(z * (1.0f / 15.0f)); }
__device__ __forceinline__ float logsigmoid_f(float z) { return fminf(z, 0.f) - log1pf(__expf(-fabsf(z))); }
__device__ __forceinline__ void p2_prep(char* lds, const Args& a) {
    const int tid = threadIdx.x, lane = tid & 63, wid = __builtin_amdgcn_readfirstlane(tid >> 6);
    const int gw = blockIdx.x * 8 + wid, nw = gridDim.x * 8;
    const bf16_t* proj = (const bf16_t*)(a.ws + WS_R);
    for (int bh = blockIdx.x; bh < 16; bh += gridDim.x) {
        const int b = bh >> 2, h = bh & 3;
        const float* gates = (const float*)(a.ws + WS_GATES);
        f32x2* mg = (f32x2*)(a.ws + WS_MG) + (size_t)bh * SEQ; float* fl = (float*)(a.ws + WS_FLOOR) + (size_t)bh * SEQ;
        float* at = (float*)(a.ws + WS_AT) + (size_t)bh * SEQ; float* aa = (float*)(a.ws + WS_AA) + (size_t)bh * SEQ;
        const float bi = a.in[2][h], bfg = a.in[3][h];
        float* S = (float*)lds;
        float li[8], lf[8], Fl[8], Al[8];
#pragma unroll
        for (int i = 0; i < 8; ++i) { const int c = wid * 8 + i, t = c * 64 + lane; const float* g = gates + (size_t)(b * SEQ + t) * 8;
            li[i] = softcap15(g[h] + bi); lf[i] = logsigmoid_f(softcap15(g[4 + h] + bfg));
            float F = lf[i];
#pragma unroll
            for (int o = 1; o < 64; o <<= 1) { const float y = __shfl_up(F, o); if (lane >= o) F += y; }
            float A = li[i] - F;
#pragma unroll
            for (int o = 1; o < 64; o <<= 1) { const float y = __shfl_up(A, o); if (lane >= o) A = fmaxf(A, y); }
            Fl[i] = F; Al[i] = A;
            if (lane == 63) { S[c] = F; S[64 + c] = A; } }
        __syncthreads();
        float Fc_all, Ac_all;
        { const float sF = S[lane], mA = S[64 + lane];
          float inc = sF;
#pragma unroll
          for (int o = 1; o < 64; o <<= 1) { const float y = __shfl_up(inc, o); if (lane >= o) inc += y; }
          Fc_all = inc - sF;
          float X = mA - Fc_all;
#pragma unroll
          for (int o = 1; o < 64; o <<= 1) { const float y = __shfl_up(X, o); if (lane >= o) X = fmaxf(X, y); }
          const float xp = __shfl_up(X, 1); Ac_all = lane == 0 ? 0.f : fmaxf(xp, 0.f); }
        __syncthreads();
#pragma unroll
        for (int i = 0; i < 8; ++i) { const int c = wid * 8 + i, t = c * 64 + lane;
            const float Fc = __shfl(Fc_all, c), Ac = __shfl(Ac_all, c);
            const float F = Fl[i] + Fc, A = fmaxf(Al[i] - Fc, Ac), m = F + A;
            float mp = __shfl_up(m, 1); if (lane == 0) mp = Fc + Ac;
            mg[t] = (f32x2){__expf(lf[i] + mp - m), __expf(li[i] - m)}; fl[t] = __expf(-m);
            at[t] = li[i] - F; aa[t] = A; }
    }
    const float* qn = a.in[5]; const float* kvn = a.in[6];
    bf16_t* cqn = (bf16_t*)(a.ws + WS_CQN); bf16_t* ckvn = (bf16_t*)(a.ws + WS_CKVN); bf16_t* krope = (bf16_t*)(a.ws + WS_KROPE);
    const f32x2* rp = (const f32x2*)(a.ws + WS_ROPE);
    for (int tk = gw; tk < M_TOK; tk += nw) {
        const bf16_t* row = proj + (size_t)tk * AB_NP;
        float x0[8], x1[8], y[8];
        unpack8(*(const bf16x8*)(row + AB_CQ + lane * 8), x0); unpack8(*(const bf16x8*)(row + AB_CQ + 512 + lane * 8), x1); unpack8(*(const bf16x8*)(row + AB_CKV + lane * 8), y);
        const float kr = bf2f(row[AB_KR + lane]);
        float s = 0.f, s2 = 0.f;
#pragma unroll
        for (int j = 0; j < 8; ++j) { s += x0[j] * x0[j] + x1[j] * x1[j]; s2 += y[j] * y[j]; }
        s = wave_sum(s); s2 = wave_sum(s2);
        const float r1 = rsqrtf(s * (1.0f / 1024.0f) + RMS_EPS), r2 = rsqrtf(s2 * (1.0f / 512.0f) + RMS_EPS);
#pragma unroll
        for (int j = 0; j < 8; ++j) { x0[j] *= r1 * qn[lane * 8 + j]; x1[j] *= r1 * qn[512 + lane * 8 + j]; y[j] *= r2 * kvn[lane * 8 + j]; }
        *(bf16x8*)(cqn + (size_t)tk * 1024 + lane * 8) = pack8f(x0); *(bf16x8*)(cqn + (size_t)tk * 1024 + 512 + lane * 8) = pack8f(x1);
        *(bf16x8*)(ckvn + (size_t)tk * 512 + lane * 8) = pack8f(y);
        const float pr = __shfl_xor(kr, 32); const f32x2 cs = rp[(size_t)(tk & (SEQ - 1)) * 32 + (lane & 31)];
        const float out = lane < 32 ? kr * cs.x - pr * cs.y : pr * cs.y + kr * cs.x;
        krope[(size_t)tk * 64 + lane] = f2bf(out);
    }
}

__device__ __forceinline__ float dpp_xor1(float v) { return __int_as_float(__builtin_amdgcn_update_dpp(0, __float_as_int(v), 0xB1, 0xF, 0xF, true)); }
__device__ __forceinline__ float dpp_xor2(float v) { return __int_as_float(__builtin_amdgcn_update_dpp(0, __float_as_int(v), 0x4E, 0xF, 0xF, true)); }
__device__ __forceinline__ float dpp_hmir(float v) { return __int_as_float(__builtin_amdgcn_update_dpp(0, __float_as_int(v), 0x141, 0xF, 0xF, true)); }
__device__ __forceinline__ float dpp_mir(float v)  { return __int_as_float(__builtin_amdgcn_update_dpp(0, __float_as_int(v), 0x140, 0xF, 0xF, true)); }
__device__ __forceinline__ float row16_sum(float v) { v += dpp_xor1(v); v += dpp_xor2(v); v += dpp_hmir(v); v += dpp_mir(v); return v; }
__device__ __forceinline__ float swap32_sum(float a, float b) {
    auto rr = __builtin_amdgcn_permlane32_swap(__float_as_uint(a), __float_as_uint(b), false, false); return __uint_as_float(rr[0]) + __uint_as_float(rr[1]); }
constexpr int ML_CH = 32;
constexpr int ML_Q = 0, ML_K = ML_CH * 256 * 4, ML_V = 2 * ML_CH * 256 * 4, ML_FI = ML_V + ML_CH * 32 * 4, ML_BUF = ML_FI + ML_CH * 8;
constexpr int ML_OUT = 2 * ML_BUF, ML_DEN = ML_OUT + ML_CH * 32 * 4, ML_END = ML_DEN + ML_CH * 4;
static_assert(ML_END <= LDS_CTL_OFF, "mLSTM LDS");
__device__ __forceinline__ void p4_mlstm(char* lds, const Args& a) {
    const int tid = threadIdx.x, lane = tid & 63, wid = __builtin_amdgcn_readfirstlane(tid >> 6);
    const bf16_t* proj = (const bf16_t*)(a.ws + WS_R); bf16_t* hcat = (bf16_t*)a.out;
    for (int unit = blockIdx.x; unit < 256; unit += gridDim.x) {
        const int bh = unit >> 4, sl = unit & 15, b = bh >> 2, h = bh & 3;
        const f32x2* mg = (const f32x2*)(a.ws + WS_MG) + (size_t)bh * SEQ;
        float* den = (float*)(a.ws + WS_DEN) + (size_t)bh * SEQ;
        const bool denw = (wid == 0) && (sl == 0);
        const int st = tid >> 4, sp = (tid & 15) * 16, vt = tid >> 2, vp = (tid & 3) * 8;
        const bf16_t* qsrc = proj + (size_t)(b * SEQ + st) * AB_NP + AB_Q + h * 256 + sp;
        const bf16_t* ksrc = proj + (size_t)(b * SEQ + st) * AB_NP + AB_K + h * 256 + sp;
        const bf16_t* vsrc = proj + (size_t)(b * SEQ + vt) * AB_NP + AB_V + h * 512 + sl * 32 + vp;
        bf16x8 rq0, rq1, rk0, rk1, rv; f32x2 rfi;
#define ML_LOAD(c) do { const size_t o_ = (size_t)(c) * ML_CH * AB_NP; rq0 = *(const bf16x8*)(qsrc + o_); rq1 = *(const bf16x8*)(qsrc + o_ + 8); rk0 = *(const bf16x8*)(ksrc + o_); rk1 = *(const bf16x8*)(ksrc + o_ + 8); \
        if (tid < 128) rv = *(const bf16x8*)(vsrc + o_); if (tid < ML_CH) rfi = mg[(c) * ML_CH + tid]; } while (0)
#define ML_STORE(bufp) do { float f_[8]; float* Q_ = (float*)((bufp) + ML_Q) + st * 256 + sp; float* K_ = (float*)((bufp) + ML_K) + st * 256 + sp; \
        unpack8(rq0, f_); *(f32x4*)(Q_) = (f32x4){f_[0], f_[1], f_[2], f_[3]}; *(f32x4*)(Q_ + 4) = (f32x4){f_[4], f_[5], f_[6], f_[7]}; \
        unpack8(rq1, f_); *(f32x4*)(Q_ + 8) = (f32x4){f_[0], f_[1], f_[2], f_[3]}; *(f32x4*)(Q_ + 12) = (f32x4){f_[4], f_[5], f_[6], f_[7]}; \
        unpack8(rk0, f_); *(f32x4*)(K_) = (f32x4){f_[0], f_[1], f_[2], f_[3]} * 0.0625f; *(f32x4*)(K_ + 4) = (f32x4){f_[4], f_[5], f_[6], f_[7]} * 0.0625f; \
        unpack8(rk1, f_); *(f32x4*)(K_ + 8) = (f32x4){f_[0], f_[1], f_[2], f_[3]} * 0.0625f; *(f32x4*)(K_ + 12) = (f32x4){f_[4], f_[5], f_[6], f_[7]} * 0.0625f; \
        if (tid < 128) { float* V_ = (float*)((bufp) + ML_V) + vt * 32 + vp; unpack8(rv, f_); *(f32x4*)(V_) = (f32x4){f_[0], f_[1], f_[2], f_[3]}; *(f32x4*)(V_ + 4) = (f32x4){f_[4], f_[5], f_[6], f_[7]}; } \
        if (tid < ML_CH) ((f32x2*)((bufp) + ML_FI))[tid] = rfi; } while (0)
        f32x4 C0 = {0.f, 0.f, 0.f, 0.f}, C1 = C0, C2 = C0, C3 = C0, n4 = C0;
        __syncthreads();
        ML_LOAD(0); ML_STORE(lds); __syncthreads();
        float* OUT = (float*)(lds + ML_OUT); float* DENs = (float*)(lds + ML_DEN);
        for (int c = 0; c < SEQ / ML_CH; ++c) {
            char* buf = lds + (c & 1) * ML_BUF;
            if (c + 1 < SEQ / ML_CH) ML_LOAD(c + 1);
            const float* Qs = (const float*)(buf + ML_Q) + lane * 4; const float* Ks = (const float*)(buf + ML_K) + lane * 4;
            const float* Vs = (const float*)(buf + ML_V) + wid * 4; const f32x2* FIs = (const f32x2*)(buf + ML_FI);
#pragma unroll 4
            for (int s = 0; s < ML_CH; ++s) {
                const f32x4 q4 = *(const f32x4*)(Qs + s * 256), k4 = *(const f32x4*)(Ks + s * 256), v4 = *(const f32x4*)(Vs + s * 32); const f32x2 fi = FIs[s];
                const f32x4 iv = v4 * fi.y;
                C0 = C0 * fi.x + iv * k4[0]; C1 = C1 * fi.x + iv * k4[1]; C2 = C2 * fi.x + iv * k4[2]; C3 = C3 * fi.x + iv * k4[3];
                f32x4 d = C0 * q4[0] + C1 * q4[1] + C2 * q4[2] + C3 * q4[3];
                float e0 = swap32_sum(d[0], d[2]), e1 = swap32_sum(d[1], d[3]);
                const float other = __shfl_xor((lane & 16) ? e0 : e1, 16);
                float r = ((lane & 16) ? e1 : e0) + other;
                r = row16_sum(r);
                if ((lane & 15) == 0) OUT[s * 32 + wid * 4 + (lane >> 5) * 2 + ((lane >> 4) & 1)] = r;
                if (denw) { n4 = n4 * fi.x + k4 * fi.y; float dn = n4[0] * q4[0] + n4[1] * q4[1] + n4[2] * q4[2] + n4[3] * q4[3];
                    dn = swap32_sum(dn, dn); dn += __shfl_xor(dn, 16); dn = row16_sum(dn); if (lane == 0) DENs[s] = dn; }
            }
            __syncthreads();
            if (tid < 128) { const float* o_ = OUT + vt * 32 + vp; float f[8];
#pragma unroll
                for (int j = 0; j < 8; ++j) f[j] = o_[j];
                *(bf16x8*)(hcat + (size_t)(b * SEQ + c * ML_CH + vt) * DM + h * 512 + sl * 32 + vp) = pack8f(f); }
            if (sl == 0 && tid < ML_CH) den[c * ML_CH + tid] = DENs[tid];
            if (c + 1 < SEQ / ML_CH) ML_STORE(lds + ((c + 1) & 1) * ML_BUF);
            __syncthreads();
        }
#undef ML_LOAD
#undef ML_STORE
    }
}

#define TRRD(dst, base, off) asm volatile("ds_read_b64_tr_b16 %0, %1 offset:%2" : "=&v"(dst) : "v"(base), "i"(off) : "memory")
#define TRRD(dst, base, off) asm volatile("ds_read_b64_tr_b16 %0, %1 offset:%2" : "=&v"(dst) : "v"(base), "i"(off) : "memory")
namespace mc {
constexpr int L_K = 0, L_Q = 32768, L_V = 65536, L_EV = 81920, L_CT = 98304, L_TAB = 114688, L_G = 116736;
constexpr int T_A = 0, T_AA = 64, T_INT = 128, T_E = 192;
__device__ __forceinline__ int kaddr(int s, int d) { return (d >> 7) * 16384 + s * 256 + (((d & 127) * 2) ^ ((s & 7) << 4)); }
}
#define MC_QF(d0) (*(const bf16x8*)(lds + L_Q + ((d0) >> 3) * 16384 + TB * 8192 + kq[(d0) & 3] + (((d0) >> 2) & 1) * 128))
template <int TB>
__device__ __forceinline__ void mc_inter(char* lds, float* TAB, const int (&kq)[4], int cfrag, int csw, int lane, int hi) {
    using namespace mc;
    f32x16 o = f32x16{};
    bf16x8 fq[2][2], fc[2][2];
#define MJ_LD(g) do { _Pragma("unroll") for (int e = 0; e < 2; ++e) { const int d0 = 2 * (g) + e; fq[(g) & 1][e] = MC_QF(d0); fc[(g) & 1][e] = *(const bf16x8*)(lds + L_CT + cfrag + (((d0 * 16 + hi * 8) * 2) ^ csw)); } } while (0)
#define MJ_MM(g) do { _Pragma("unroll") for (int e = 0; e < 2; ++e) o = __builtin_amdgcn_mfma_f32_32x32x16_bf16(fq[(g) & 1][e], fc[(g) & 1][e], o, 0, 0, 0); } while (0)
    MJ_LD(0); SBAR();
#pragma unroll
    for (int g = 0; g < 8; ++g) { if (g + 1 < 8) { MJ_LD(g + 1); } SBAR(); MJ_MM(g); SBAR(); }
#undef MJ_LD
#undef MJ_MM
    const float* ti = TAB + T_INT + TB * 32 + 4 * hi; float* G = (float*)(lds + L_G) + TB * 1024 + lane;
#pragma unroll
    for (int r = 0; r < 16; ++r) G[r * 64] = o[r] * ti[(r & 3) + 8 * (r >> 2)];
}
template <int TB>
__device__ __forceinline__ void mc_intra(char* lds, float* TAB, const int (&kq)[4], int vbV, int r32, int hi, f32x16& o, float& ps) {
    using namespace mc;
    const float LOG2E = 1.4426950408889634f;
    const int tl = TB * 32 + r32;
    f32x16 p0 = f32x16{}, p1 = f32x16{};
    bf16x8 fq[2][2], fa0[2][2], fa1[2][2];
#define MI_LD(g) do { _Pragma("unroll") for (int e = 0; e < 2; ++e) { const int d0 = 2 * (g) + e; const char* ap = lds + L_K + (d0 >> 3) * 16384 + kq[d0 & 3] + ((d0 >> 2) & 1) * 128; \
        fq[(g) & 1][e] = MC_QF(d0); fa0[(g) & 1][e] = *(const bf16x8*)ap; if constexpr (TB == 1) fa1[(g) & 1][e] = *(const bf16x8*)(ap + 8192); } } while (0)
#define MI_MM(g) do { _Pragma("unroll") for (int e = 0; e < 2; ++e) { p0 = __builtin_amdgcn_mfma_f32_32x32x16_bf16(fa0[(g) & 1][e], fq[(g) & 1][e], p0, 0, 0, 0); \
        if constexpr (TB == 1) p1 = __builtin_amdgcn_mfma_f32_32x32x16_bf16(fa1[(g) & 1][e], fq[(g) & 1][e], p1, 0, 0, 0); } } while (0)
    MI_LD(0); SBAR();
#pragma unroll
    for (int g = 0; g < 8; ++g) { if (g + 1 < 8) { MI_LD(g + 1); } SBAR(); MI_MM(g); SBAR(); }
#undef MI_LD
#undef MI_MM
    const float At = TAB[T_AA + tl];
    ps = 0.f;
    const float* ta = TAB + T_A + 4 * hi;
#pragma unroll
    for (int r = 0; r < 16; ++r) { const int s0 = fa::crow(r, hi), c0 = (r & 3) + 8 * (r >> 2);
        const float e0 = __builtin_amdgcn_exp2f((ta[c0] - At) * LOG2E) * 0.0625f; const float w0 = (s0 <= tl) ? e0 : 0.f; p0[r] *= w0; ps += p0[r];
        if constexpr (TB == 1) { const float e1 = __builtin_amdgcn_exp2f((ta[32 + c0] - At) * LOG2E) * 0.0625f; const float w1 = (s0 + 32 <= tl) ? e1 : 0.f; p1[r] *= w1; ps += p1[r]; } }
    { auto rr = __builtin_amdgcn_permlane32_swap(__float_as_uint(ps), __float_as_uint(ps), false, false); ps = __uint_as_float(rr[0]) + __uint_as_float(rr[1]); }
    bf16x8 pa0, pa1, pa2, pa3;
#define PK4(P, B_, OUT) do { unsigned a0 = fa::cvtpk(P[B_+0], P[B_+1]), a1 = fa::cvtpk(P[B_+2], P[B_+3]);                  \
        unsigned b0_ = fa::cvtpk(P[B_+4], P[B_+5]), b1_ = fa::cvtpk(P[B_+6], P[B_+7]);                                   \
        auto r0 = __builtin_amdgcn_permlane32_swap(a0, b0_, false, false); auto r1 = __builtin_amdgcn_permlane32_swap(a1, b1_, false, false); \
        u32x4 w = {r0[0], r1[0], r0[1], r1[1]}; OUT = *reinterpret_cast<bf16x8*>(&w); } while (0)
    PK4(p0, 0, pa0); PK4(p0, 8, pa1); PK4(p1, 0, pa2); PK4(p1, 8, pa3);
#undef PK4
    o = f32x16{};
    { s16x4 l0, l1, l2, l3, h0, h1, h2, h3;
      TRRD(l0, vbV, 0); TRRD(h0, vbV, 2048); TRRD(l1, vbV, 4096); TRRD(h1, vbV, 6144); TRRD(l2, vbV, 8192); TRRD(h2, vbV, 10240); TRRD(l3, vbV, 12288); TRRD(h3, vbV, 14336);
      asm volatile("s_waitcnt lgkmcnt(0)" ::: "memory"); SBAR();
      o = __builtin_amdgcn_mfma_f32_32x32x16_bf16(pa0, (bf16x8){l0[0], l0[1], l0[2], l0[3], h0[0], h0[1], h0[2], h0[3]}, o, 0, 0, 0);
      o = __builtin_amdgcn_mfma_f32_32x32x16_bf16(pa1, (bf16x8){l1[0], l1[1], l1[2], l1[3], h1[0], h1[1], h1[2], h1[3]}, o, 0, 0, 0);
      if constexpr (TB == 1) { o = __builtin_amdgcn_mfma_f32_32x32x16_bf16(pa2, (bf16x8){l2[0], l2[1], l2[2], l2[3], h2[0], h2[1], h2[2], h2[3]}, o, 0, 0, 0);
                               o = __builtin_amdgcn_mfma_f32_32x32x16_bf16(pa3, (bf16x8){l3[0], l3[1], l3[2], l3[3], h3[0], h3[1], h3[2], h3[3]}, o, 0, 0, 0); } }
}
#undef MC_QF
__device__ __forceinline__ void p4_mlstm_chunk(char* lds, const Args& a) {
    using namespace mc;
    const int tid = threadIdx.x, lane = tid & 63, wid = __builtin_amdgcn_readfirstlane(tid >> 6);
    const bf16_t* proj = (const bf16_t*)(a.ws + WS_R); bf16_t* hcat = (bf16_t*)a.out;
    float* TAB = (float*)(lds + L_TAB);
    const float LOG2E = 1.4426950408889634f;
    for (int unit = blockIdx.x; unit < 256; unit += gridDim.x) {
        const int bh = (gridDim.x == 256) ? 2 * (unit & 7) + (unit >> 7) : unit >> 4, sl = (gridDim.x == 256) ? (unit >> 3) & 15 : unit & 15, b = bh >> 2, h = bh & 3;
        const float* AT = (const float*)(a.ws + WS_AT) + (size_t)bh * SEQ; const float* AA = (const float*)(a.ws + WS_AA) + (size_t)bh * SEQ;
        float* deni = (float*)(a.ws + WS_DENI) + (size_t)bh * SEQ; float* denp = (float*)(a.ws + WS_DENP) + (size_t)(bh * 16 + sl) * SEQ;
        const int krow = tid >> 3, kch = (tid & 7) * 4, vrow = (tid >> 2) & 63, vch = tid & 3;
        const bf16_t* ksrc = proj + (size_t)(b * SEQ + krow) * AB_NP + AB_K + h * 256 + kch * 8;
        const bf16_t* qsrc = proj + (size_t)(b * SEQ + krow) * AB_NP + AB_Q + h * 256 + kch * 8;
        const bf16_t* vsrc = proj + (size_t)(b * SEQ + vrow) * AB_NP + AB_V + h * 512 + sl * 32 + vch * 8;
        int kdst[4];
#pragma unroll
        for (int i = 0; i < 4; ++i) { const int ch = kch + i; kdst[i] = (ch >> 4) * 16384 + KSWZ(krow, (ch & 15) * 16); }
        const int vdst = fa::v_st(vrow, vch * 8);
        bf16x8 rk[4], rq[4], rv; float pa_t = 0.f, pA_t = 0.f, pa_v = 0.f, pA_prev = 0.f, pA_end = 0.f;
#define MC_LOAD(c) do { const size_t o_ = (size_t)(c) * 64 * AB_NP; _Pragma("unroll") for (int i = 0; i < 4; ++i) { rk[i] = *(const bf16x8*)(ksrc + o_ + i * 8); rq[i] = *(const bf16x8*)(qsrc + o_ + i * 8); } \
        if (tid < 256) { rv = *(const bf16x8*)(vsrc + o_); pa_v = AT[(c) * 64 + vrow]; } if (tid < 64) { pa_t = AT[(c) * 64 + tid]; pA_t = AA[(c) * 64 + tid]; } \
        pA_end = AA[(c) * 64 + 63]; pA_prev = (c) > 0 ? AA[(c) * 64 - 1] : 0.f; } while (0)
        f32x16 Cacc = f32x16{};
        f32x16 oi = f32x16{}; float psi = 0.f;
        float nreg = 0.f;
        __syncthreads();
        for (int i = tid; i < 16384 / 16; i += NTHREADS) *(u32x4*)(lds + L_CT + i * 16) = (u32x4){0u, 0u, 0u, 0u};
        MC_LOAD(0);
        for (int c = 0; c < SEQ / 64; ++c) {
            const int t0 = c * 64;
            const float A_prev = pA_prev, A_end = pA_end;
            asm volatile("s_waitcnt vmcnt(0)" ::: "memory");
#pragma unroll
            for (int i = 0; i < 4; ++i) { *(bf16x8*)(lds + L_K + kdst[i]) = rk[i]; *(bf16x8*)(lds + L_Q + kdst[i]) = rq[i]; }
            if (tid < 256) { *(bf16x8*)(lds + L_V + vdst) = rv; const float e = __builtin_amdgcn_exp2f((pa_v - A_end) * LOG2E) * 0.0625f;
                float f[8]; unpack8(rv, f);
#pragma unroll
                for (int j = 0; j < 8; ++j) f[j] *= e;
                *(bf16x8*)(lds + L_EV + vdst) = pack8f(f); }
            if (tid < 64) { TAB[T_A + tid] = pa_t; TAB[T_AA + tid] = pA_t; TAB[T_INT + tid] = __builtin_amdgcn_exp2f((A_prev - pA_t) * LOG2E); TAB[T_E + tid] = __builtin_amdgcn_exp2f((pa_t - A_end) * LOG2E) * 0.0625f; }
            __syncthreads();
            if (c + 1 < SEQ / 64) MC_LOAD(c + 1);
            const float decay = __builtin_amdgcn_exp2f((A_prev - A_end) * LOG2E);
            int lane_o = lane; asm volatile("" : "+v"(lane_o));
            const int r32 = lane_o & 31, hi = lane_o >> 5;
            int kq[4];
#pragma unroll
            for (int dd = 0; dd < 4; ++dd) kq[dd] = KSWZ(r32, dd * 32 + hi * 16);
            const int cfrag = r32 * 512, csw = (r32 & 15) << 4;
            const int trq = (lane_o & 15) >> 2, trp = lane_o & 3, trg = (lane_o >> 4) & 1;
            const int vbV = (int)(uintptr_t)lds + L_V + fa::v_rd_base(lane_o), vbE = (int)(uintptr_t)lds + L_EV + fa::v_rd_base(lane_o);
            if (wid == 0) mc_intra<0>(lds, TAB, kq, vbV, r32, hi, oi, psi);
            else if (wid == 1) mc_intra<1>(lds, TAB, kq, vbV, r32, hi, oi, psi);
            else if (wid == 2) mc_inter<0>(lds, TAB, kq, cfrag, csw, lane_o, hi);
            else if (wid == 3) mc_inter<1>(lds, TAB, kq, cfrag, csw, lane_o, hi);
            if (wid == 7) {
                const int d0_ = 16 * sl;
                float qv[16]; { float f[8]; unpack8(*(const bf16x8*)(lds + L_Q + kaddr(lane, d0_)), f);
#pragma unroll
                    for (int j = 0; j < 8; ++j) qv[j] = f[j];
                    unpack8(*(const bf16x8*)(lds + L_Q + kaddr(lane, d0_ + 8)), f);
#pragma unroll
                    for (int j = 0; j < 8; ++j) qv[8 + j] = f[j]; }
                float dsum = 0.f;
#pragma unroll
                for (int d = 0; d < 16; ++d) dsum += qv[d] * __int_as_float(__builtin_amdgcn_readlane(__float_as_int(nreg), d));
                denp[t0 + lane] = dsum * TAB[T_INT + lane];
                const int dd = lane & 15, sq = lane >> 4; float part = 0.f;
#pragma unroll
                for (int j = 0; j < 16; ++j) { const int s = sq * 16 + j; part += TAB[T_E + s] * bf2f(*(const bf16_t*)(lds + L_K + kaddr(s, d0_ + dd))); }
                part += __shfl_xor(part, 16); part += __shfl_xor(part, 32);
                nreg = nreg * decay + part;
            }
            {
#pragma unroll
                for (int r = 0; r < 16; ++r) Cacc[r] *= decay;
                s16x4 l0, l1, l2, l3, h0, h1, h2, h3;
                TRRD(l0, vbE, 0); TRRD(h0, vbE, 2048); TRRD(l1, vbE, 4096); TRRD(h1, vbE, 6144); TRRD(l2, vbE, 8192); TRRD(h2, vbE, 10240); TRRD(l3, vbE, 12288); TRRD(h3, vbE, 14336);
                s16x4 ka[4][2];
                { const int d = 32 * wid + trg * 16 + 4 * trp;
                  const int ad0 = (int)(uintptr_t)lds + L_K + kaddr(8 * hi + trq, d), ad1 = (int)(uintptr_t)lds + L_K + kaddr(8 * hi + 4 + trq, d);
                  TRRD(ka[0][0], ad0, 0); TRRD(ka[0][1], ad1, 0); TRRD(ka[1][0], ad0, 4096); TRRD(ka[1][1], ad1, 4096);
                  TRRD(ka[2][0], ad0, 8192); TRRD(ka[2][1], ad1, 8192); TRRD(ka[3][0], ad0, 12288); TRRD(ka[3][1], ad1, 12288); }
                asm volatile("s_waitcnt lgkmcnt(0)" ::: "memory"); SBAR();
#define KAF(ks) (bf16x8){ka[ks][0][0], ka[ks][0][1], ka[ks][0][2], ka[ks][0][3], ka[ks][1][0], ka[ks][1][1], ka[ks][1][2], ka[ks][1][3]}
                Cacc = __builtin_amdgcn_mfma_f32_32x32x16_bf16(KAF(0), (bf16x8){l0[0], l0[1], l0[2], l0[3], h0[0], h0[1], h0[2], h0[3]}, Cacc, 0, 0, 0);
                Cacc = __builtin_amdgcn_mfma_f32_32x32x16_bf16(KAF(1), (bf16x8){l1[0], l1[1], l1[2], l1[3], h1[0], h1[1], h1[2], h1[3]}, Cacc, 0, 0, 0);
                Cacc = __builtin_amdgcn_mfma_f32_32x32x16_bf16(KAF(2), (bf16x8){l2[0], l2[1], l2[2], l2[3], h2[0], h2[1], h2[2], h2[3]}, Cacc, 0, 0, 0);
                Cacc = __builtin_amdgcn_mfma_f32_32x32x16_bf16(KAF(3), (bf16x8){l3[0], l3[1], l3[2], l3[3], h3[0], h3[1], h3[2], h3[3]}, Cacc, 0, 0, 0);
#undef KAF
            }
            __syncthreads();
            float one = 1.0f; asm volatile("" : "+v"(one));
#pragma unroll
            for (int g = 0; g < 4; ++g) { const int d4 = 32 * wid + 8 * g + 4 * hi; u32x2 w; w.x = cvt_pk_bf16(Cacc[4 * g] * one, Cacc[4 * g + 1] * one); w.y = cvt_pk_bf16(Cacc[4 * g + 2] * one, Cacc[4 * g + 3] * one);
                *(u32x2*)(lds + L_CT + cfrag + ((d4 * 2) ^ csw)) = w; }
            if (wid < 2) {
                const float* G = (const float*)(lds + L_G) + wid * 1024 + lane_o;
                bf16_t* ob = hcat + (size_t)(b * SEQ + t0 + wid * 32) * DM + h * 512 + sl * 32;
                const int lofs = hi * 4 * DM + r32;
#pragma unroll
                for (int r = 0; r < 16; ++r) { const float v = oi[r] + G[r * 64], vn = dpp_xor1(v);
                    if ((r32 & 1) == 0) *(unsigned*)((ob + (size_t)((r & 3) + 8 * (r >> 2)) * DM) + lofs) = cvt_pk_bf16(v, vn); }
                if (sl == 0 && hi == 0) deni[t0 + wid * 32 + r32] = psi;
            }
        }
#undef MC_LOAD
        __syncthreads();
    }
}
#undef TRRD

__device__ __forceinline__ void p5_mlstm_norm(const Args& a) {
    const int tid = threadIdx.x, lane = tid & 63, wid = tid >> 6;
    const int gw = blockIdx.x * 8 + wid, nw = gridDim.x * 8;
    const bf16_t* proj = (const bf16_t*)(a.ws + WS_R); bf16_t* hcat = (bf16_t*)a.out;
    const float* den = (const float*)(a.ws + WS_DEN); const float* fl = (const float*)(a.ws + WS_FLOOR); const float* mn = a.in[4];
    for (int it = gw; it < M_TOK * 4; it += nw) {
        const int tk = it >> 2, h = it & 3, b = tk >> 12, t = tk & (SEQ - 1), bh = b * 4 + h;
        bf16_t* hp = hcat + (size_t)tk * DM + h * 512 + lane * 8;
        float x[8], og[8];
        unpack8(*(const bf16x8*)hp, x); unpack8(*(const bf16x8*)(proj + (size_t)tk * AB_NP + AB_OG + h * 512 + lane * 8), og);
#if MLSTM_CHUNK && !MLSTM_BOTH && (DEBUG_CMP < 0)
        float dsum = ((const float*)(a.ws + WS_DENI))[(size_t)bh * SEQ + t];
#pragma unroll
        for (int q = 0; q < 16; ++q) dsum += ((const float*)(a.ws + WS_DENP))[(size_t)(bh * 16 + q) * SEQ + t];
#else
        const float dsum = den[(size_t)bh * SEQ + t];
#endif
        const float dd = fmaxf(fabsf(dsum), fl[(size_t)bh * SEQ + t]); const float inv = 1.0f / dd;
        float s = 0.f;
#pragma unroll
        for (int j = 0; j < 8; ++j) { x[j] *= inv; s += x[j] * x[j]; }
        s = wave_sum(s);
        const float r = rsqrtf(s * (1.0f / 512.0f) + RMS_EPS);
#pragma unroll
        for (int j = 0; j < 8; ++j) x[j] = x[j] * r * mn[h * 512 + lane * 8 + j] * sigmoid_f(og[j]);
        *(bf16x8*)hp = pack8f(x);
    }
}
__device__ __forceinline__ int xcd_unit(int k, int per, int groups, int upg) {
    const int w = blockIdx.x, G = gridDim.x;
    if (G != 256 || per * 256 != groups * upg) return w + k * G;
    const int j = w & 7, s = w >> 3, lu = k * 32 + s;
    return (j * (groups >> 3) + lu / upg) * upg + lu % upg;
}
__device__ __forceinline__ void p5_mla(char* lds, const Args& a) {
    const int tid = threadIdx.x, wid = __builtin_amdgcn_readfirstlane(tid >> 6), lane = tid & 63, r32 = lane & 31, hi = lane >> 5;
    const bf16_t* qb = (const bf16_t*)(a.ws + WS_QB); const bf16_t* kvb = (const bf16_t*)(a.ws + WS_KVB); const bf16_t* krope = (const bf16_t*)(a.ws + WS_KROPE);
    bf16_t* hcat = (bf16_t*)a.out;     const f32x2* rp = (const f32x2*)(a.ws + WS_ROPE);
    for (int kk = 0; kk * (int)gridDim.x < 64 * 8 * 2; ++kk) {
        const int it2 = xcd_unit(kk >> 1, 2, 64, 8), pass = kk & 1; if (it2 >= 512) break;
        const int bh = it2 >> 3, x = it2 & 7, b = bh >> 4, h = bh & 15;
        const int qblk = pass ? 15 - x : x, t0 = qblk * 256, pos = t0 + wid * 32 + r32;
        const bf16_t* qrow = qb + (size_t)(b * SEQ + pos) * 3072 + h * 192;
        bf16x8 qr[8], qrr[4];
#pragma unroll
        for (int d0 = 0; d0 < 8; ++d0) qr[d0] = *(const bf16x8*)(qrow + d0 * 16 + hi * 8);
#pragma unroll
        for (int d0 = 0; d0 < 4; ++d0) qrr[d0] = *(const bf16x8*)(qrow + 128 + d0 * 16 + hi * 8);
#pragma unroll
        for (int g = 0; g < 2; ++g) { float x1[8], x2[8], o1[8], o2[8]; unpack8(qrr[g], x1); unpack8(qrr[2 + g], x2);
#pragma unroll
            for (int j = 0; j < 8; ++j) { const f32x2 cs = rp[(size_t)pos * 32 + g * 16 + hi * 8 + j]; o1[j] = x1[j] * cs.x - x2[j] * cs.y; o2[j] = x1[j] * cs.y + x2[j] * cs.x; }
            char* qpark = lds + fa::OFF_QPARK + wid * 4096 + lane * 16;
            *(bf16x8*)(qpark + g * 1024) = pack8f(o1); *(bf16x8*)(qpark + (2 + g) * 1024) = pack8f(o2); }
        fa::FUnit u; u.Kb = kvb + (size_t)(b * SEQ) * 4096 + h * 256; u.ldk = 4096; u.Vb = u.Kb + 128; u.ldv = 4096; u.KRb = krope + (size_t)(b * SEQ) * 64;
        u.j_lo = 0; u.j_hi = (t0 + 255) / 64 + 1; u.qlo = t0 + wid * 32; u.qhi = u.qlo + 31; u.qpos = pos; u.sel = 0ull;
        f32x16 o[4]; float m_reg, l_reg;
        fa::flash_core<0>(lds, u, qr, 0.07216878364870322f, o, m_reg, l_reg);
        float rf[16]; fa::row_factors(lds, wid, r32, hi, 1.0f / l_reg, rf);
        bf16_t* ob = hcat + (size_t)(b * SEQ + t0 + wid * 32) * DM + 2048 + h * 128;
#pragma unroll
        for (int r = 0; r < 16; ++r) { const int orow = fa::crow(r, hi);
#pragma unroll
            for (int d0 = 0; d0 < 4; ++d0) { const float v = o[d0][r] * rf[r]; const float vn = __shfl_xor(v, 1);
                if ((r32 & 1) == 0) *(unsigned*)(ob + (size_t)orow * DM + d0 * 32 + r32) = cvt_pk_bf16(v, vn); } }
        __syncthreads();
    }
}

__device__ __forceinline__ void p7_layernorm(const Args& a, int layer_idx, bool mix, const float* z, float* outf, bf16_t* outb, f32x2* stats) {
    const int tid = threadIdx.x, lane = tid & 63, wid = tid >> 6;
    const int gw = blockIdx.x * 8 + wid, nw = gridDim.x * 8;
    const float* g = (mix ? a.in[22] : a.in[24]) + (size_t)layer_idx * DM; const float* bb = (mix ? a.in[23] : a.in[25]) + (size_t)layer_idx * DM;
    for (int row = gw; row < M_TOK; row += nw) {
        const float* zr = z + (size_t)row * DM;
        f32x4 v[16]; float s = 0.f;
#pragma unroll
        for (int i = 0; i < 16; ++i) { v[i] = *(const f32x4*)(zr + i * 256 + lane * 4); s += (v[i][0] + v[i][1]) + (v[i][2] + v[i][3]); }
        s = wave_sum(s); const float mu = s * (1.0f / DM);
        float q = 0.f;
#pragma unroll
        for (int i = 0; i < 16; ++i) { const f32x4 d = v[i] - mu; q += (d[0] * d[0] + d[1] * d[1]) + (d[2] * d[2] + d[3] * d[3]); }
        q = wave_sum(q); const float rs = rsqrtf(q * (1.0f / DM) + LN_EPS);
        if (stats && lane == 0) stats[row] = (f32x2){mu, rs};
#pragma unroll
        for (int i = 0; i < 16; ++i) { const int c = i * 256 + lane * 4; const f32x4 gg = *(const f32x4*)(g + c), be = *(const f32x4*)(bb + c);
            const f32x4 y = (v[i] - mu) * rs * gg + be;
            if (outf) *(f32x4*)(outf + (size_t)row * DM + c) = y;
            if (outb) { u32x2 w; w.x = cvt_pk_bf16(y[0], y[1]); w.y = cvt_pk_bf16(y[2], y[3]); *(u32x2*)(outb + (size_t)row * DM + c) = w; } }
    }
}
__device__ __forceinline__ void p7_layernorm_b(const Args& a, int layer_idx, bool mix, const bf16_t* zb, float* outf, bf16_t* outb, f32x2* stats) {
    const int tid = threadIdx.x, lane = tid & 63, wid = tid >> 6;
    const int gw = blockIdx.x * 8 + wid, nw = gridDim.x * 8;
    const float* g = (mix ? a.in[22] : a.in[24]) + (size_t)layer_idx * DM; const float* bb = (mix ? a.in[23] : a.in[25]) + (size_t)layer_idx * DM;
    bf16x8 nx[8];
    if (gw < M_TOK) {
#pragma unroll
        for (int i = 0; i < 8; ++i) nx[i] = *(const bf16x8*)(zb + (size_t)gw * DM + i * 512 + lane * 8); }
    for (int row = gw; row < M_TOK; row += nw) {
        float v[8][8]; float s = 0.f;
#pragma unroll
        for (int i = 0; i < 8; ++i) { unpack8h(nx[i], v[i]); s += ((v[i][0] + v[i][1]) + (v[i][2] + v[i][3])) + ((v[i][4] + v[i][5]) + (v[i][6] + v[i][7])); }
        { const int rn = row + nw < M_TOK ? row + nw : row;
#pragma unroll
          for (int i = 0; i < 8; ++i) nx[i] = *(const bf16x8*)(zb + (size_t)rn * DM + i * 512 + lane * 8); }
        s = wave_sum(s); const float mu = s * (1.0f / DM);
        float q = 0.f;
#pragma unroll
        for (int i = 0; i < 8; ++i)
#pragma unroll
            for (int j = 0; j < 8; ++j) { const float d = v[i][j] - mu; q += d * d; }
        q = wave_sum(q); const float rs = rsqrtf(q * (1.0f / DM) + LN_EPS);
        if (stats && lane == 0) stats[row] = (f32x2){mu, rs};
#pragma unroll
        for (int i = 0; i < 8; ++i) { const int c = i * 512 + lane * 8; const f32x4 g0 = *(const f32x4*)(g + c), g1 = *(const f32x4*)(g + c + 4), b0 = *(const f32x4*)(bb + c), b1 = *(const f32x4*)(bb + c + 4);
            float y[8];
#pragma unroll
            for (int j = 0; j < 4; ++j) { y[j] = (v[i][j] - mu) * rs * g0[j] + b0[j]; y[4 + j] = (v[i][4 + j] - mu) * rs * g1[j] + b1[j]; }
            if (outf) { *(f32x4*)(outf + (size_t)row * DM + c) = (f32x4){y[0], y[1], y[2], y[3]}; *(f32x4*)(outf + (size_t)row * DM + c + 4) = (f32x4){y[4], y[5], y[6], y[7]}; }
            if (outb) *(bf16x8*)(outb + (size_t)row * DM + c) = pack8f(y); }
    }
}
__device__ __forceinline__ void p12_blocks(const Args& a) {
    const bf16_t* projc = (const bf16_t*)(a.ws + WS_R);
    const size_t gt = (size_t)blockIdx.x * NTHREADS + threadIdx.x, gs = (size_t)gridDim.x * NTHREADS;
    for (size_t i = gt; i < (size_t)2 * 4096 * 512; i += gs) {
        const int which = (int)(i / ((size_t)4096 * 512)); const int rem = (int)(i % ((size_t)4096 * 512));
        const int r = rem >> 9, l = (rem >> 4) & 31, d8 = rem & 15, g = r & 3, n = (r >> 2) & 255, b = r >> 10;
        bf16_t* A = (bf16_t*)(a.ws + (which ? WS_AV : WS_AK)); const float* pe = which ? a.in[13] : a.in[12];
        float f[8];
        if (n < 255) { unpack8(*(const bf16x8*)(projc + (size_t)(b * SEQ + 16 * n + l) * C_NP + (which ? C_VC : C_KC) + g * 128 + d8 * 8), f);
#pragma unroll
            for (int j = 0; j < 8; ++j) f[j] += pe[l * 128 + d8 * 8 + j]; }
        else {
#pragma unroll
            for (int j = 0; j < 8; ++j) f[j] = 0.f; }
        *(bf16x8*)(A + (size_t)r * 4096 + l * 128 + d8 * 8) = pack8f(f);
    }
}
__device__ __forceinline__ float nsa_gate(const Args& a, int token, int br, int head) {
    const bf16_t* projc = (const bf16_t*)(a.ws + WS_R);
    return sigmoid_f(bf2f(projc[(size_t)token * C_NP + C_GATE + br * 32 + head]) + a.in[11][br * 32 + head]);
}
__device__ __forceinline__ void p15_cmp_attn(char* lds, const Args& a) {
    const int tid = threadIdx.x, wid = __builtin_amdgcn_readfirstlane(tid >> 6), lane = tid & 63, r32 = lane & 31, hi = lane >> 5;
    const bf16_t* projc = (const bf16_t*)(a.ws + WS_R); const bf16_t* kcmp = (const bf16_t*)(a.ws + WS_KCMP); const bf16_t* vcmp = (const bf16_t*)(a.ws + WS_VCMP);
    float* acc = (float*)(a.ws + WS_Z); unsigned long long* selp = (unsigned long long*)(a.ws + WS_SEL);
    const float scale = 0.08838834764831845f, C2 = 1.4426950408889634f * scale;
    float* IMP = (float*)(lds + fa::OFF_IMP);
    for (int kk = 0; kk * (int)gridDim.x < 2048; ++kk) {
        const int unit = xcd_unit(kk, 8, 16, 128); if (unit >= 2048) break;
        const int bg = unit >> 7, xb = unit & 127, b = bg >> 2, g = bg & 3, t0 = xb * 32;
        const int tokl = wid * 4 + (r32 >> 3), head = g * 8 + (r32 & 7), tq = t0 + tokl;
        const bf16_t* qrow = projc + (size_t)(b * SEQ + tq) * C_NP + C_Q + head * 128;
        bf16x8 qr[8];
#pragma unroll
        for (int d0 = 0; d0 < 8; ++d0) qr[d0] = *(const bf16x8*)(qrow + d0 * 16 + hi * 8);
        fa::FUnit u; u.Kb = kcmp + (size_t)(b * 256 * 4 + g) * 256; u.ldk = 1024; u.Vb = vcmp + (size_t)(b * 256 * 4 + g) * 256; u.ldv = 1024; u.KRb = nullptr;
        const int nmax_hi = (t0 + 31 - 31) >> 4;
        u.j_lo = 0; u.j_hi = (nmax_hi >> 6) + 1; u.qlo = (t0 + wid * 4 - 31) >> 4; u.qhi = (t0 + wid * 4 + 3 - 31) >> 4; u.qpos = (tq - 31) >> 4; u.sel = 0ull;
        f32x16 o[4]; float m_reg, l_reg;
        fa::flash_core<3>(lds, u, qr, scale, o, m_reg, l_reg);
        const float inv_l = l_reg > 0.f ? 1.0f / l_reg : 0.f;
        { float rf[16]; fa::row_factors(lds, wid, r32, hi, inv_l * nsa_gate(a, b * SEQ + tq, 0, head), rf);
#pragma unroll
          for (int r = 0; r < 16; ++r) { const int orow = fa::crow(r, hi); const int tk = t0 + wid * 4 + (orow >> 3), hd = g * 8 + (orow & 7);
              float* op = acc + (size_t)(b * SEQ + tk) * DM + hd * 128 + r32;
#pragma unroll
              for (int d0 = 0; d0 < 4; ++d0) op[d0 * 32] = o[d0][r] * rf[r]; } }
        __syncthreads();
        const float mL = -m_reg * C2;
        const int sr = tid >> 4, sc = (tid & 15) * 8, kws = KSWZ(sr, sc * 2);
        for (int t = 0; t < u.j_hi; ++t) {
            const int kb = t * 64;
            const bf16x8 k0 = *(const bf16x8*)(u.Kb + (long)(kb + sr) * u.ldk + sc), k1 = *(const bf16x8*)(u.Kb + (long)(kb + 32 + sr) * u.ldk + sc);
            *(bf16x8*)(lds + fa::OFF_K + kws) = k0; *(bf16x8*)(lds + fa::OFF_K + kws + 32 * 256) = k1;
            __syncthreads();
            f32x16 p0, p1; fa::qkt<0, false, true>(p0, p1, lds, r32, hi, qr);
            fa::mask_tile(p0, p1, u.qpos - kb - 4 * hi, 0x80000000u);
#pragma unroll
            for (int r = 0; r < 16; ++r) {
                float a0 = __builtin_amdgcn_exp2f(fmaf(p0[r], C2, mL)) * inv_l, a1 = __builtin_amdgcn_exp2f(fmaf(p1[r], C2, mL)) * inv_l;
                a0 += dpp_xor1(a0); a0 += dpp_xor2(a0); a0 += dpp_hmir(a0);
                a1 += dpp_xor1(a1); a1 += dpp_xor2(a1); a1 += dpp_hmir(a1);
                if ((r32 & 7) == 0) { const int n = kb + fa::crow(r, hi); IMP[tokl * fa::IMP_LD + n] = a0; IMP[tokl * fa::IMP_LD + n + 32] = a1; }
            }
            __syncthreads();
        }
        for (int q4 = 0; q4 < 4; ++q4) {
            const int tl = wid * 4 + q4, tqq = t0 + tl, cur = tqq >> 6, s = lane;
            float v = 0.f;
#pragma unroll
            for (int dn = -1; dn <= 3; ++dn) { const int n = 4 * s + dn; if (n >= 0 && n <= 254 && n < u.j_hi * 64) v += IMP[tl * fa::IMP_LD + n]; }
            if (s == 0 || s == cur || s == cur - 1) v = 1e9f;
            if (s > cur) v = -1e30f;
            int rank = 0;
#pragma nounroll
            for (int j = 0; j < 64; ++j) { const float vj = __int_as_float(__builtin_amdgcn_readlane(__float_as_int(v), j)); rank += (vj > v || (vj == v && j < s)) ? 1 : 0; }
            const unsigned long long msk = __ballot(rank < 16);
            if (lane == 0) selp[(size_t)bg * SEQ + tqq] = msk;
        }
        __syncthreads();
    }
}
template <int MODE, int VAR = 0>
__device__ __forceinline__ void p16_nsa_attn(char* lds, const Args& a) {
    const int tid = threadIdx.x, wid = __builtin_amdgcn_readfirstlane(tid >> 6), lane = tid & 63, r32 = lane & 31, hi = lane >> 5;
    const bf16_t* projc = (const bf16_t*)(a.ws + WS_R); float* acc = (float*)(a.ws + WS_Z); bf16_t* hcat = (bf16_t*)a.out;
    const unsigned long long* selp = (const unsigned long long*)(a.ws + WS_SEL);
    const float scale = 0.08838834764831845f;
    const int nitems = (MODE == 2) ? 2048 : 2048;
    for (int kk = 0; kk * (int)gridDim.x < nitems; ++kk) {
        int bg, xb;
        if (MODE == 2) { const int pass = kk & 1, it2 = xcd_unit(kk >> 1, 4, 16, 64); if (it2 >= 1024) break; bg = it2 >> 6; const int x = it2 & 63; xb = pass ? 127 - x : x; }
        else { const int item = xcd_unit(kk, 8, 16, 128); if (item >= 2048) break; bg = item >> 7; xb = item & 127; }
        const int b = bg >> 2, g = bg & 3, t0 = xb * 32, head = g * 8 + wid, tq = t0 + r32;
        const bf16_t* qrow = projc + (size_t)(b * SEQ + tq) * C_NP + C_Q + head * 128;
        bf16x8 qr[8];
#pragma unroll
        for (int d0 = 0; d0 < 8; ++d0) qr[d0] = *(const bf16x8*)(qrow + d0 * 16 + hi * 8);
        fa::FUnit u; u.KRb = nullptr; u.ldk = C_NP; u.ldv = C_NP; u.qlo = t0; u.qhi = t0 + 31; u.qpos = tq; u.sel = 0ull;
        if (MODE == 1) { u.Kb = projc + (size_t)(b * SEQ) * C_NP + C_KW + g * 128; u.Vb = projc + (size_t)(b * SEQ) * C_NP + C_VW + g * 128;
            const int lowk = t0 - 511; u.j_lo = lowk > 0 ? lowk / 64 : 0; u.j_hi = (t0 + 31) / 64 + 1; }
        else { u.Kb = projc + (size_t)(b * SEQ) * C_NP + C_KS + g * 128; u.Vb = projc + (size_t)(b * SEQ) * C_NP + C_VS + g * 128;
            u.j_lo = 0; u.j_hi = (t0 + 31) / 64 + 1; u.sel = selp[(size_t)bg * SEQ + tq]; }
        f32x16 o[4]; float m_reg, l_reg;
#if FLASH2
        fa::flash_core2<MODE>(lds, u, qr, scale, o, m_reg, l_reg);
#else
        fa::flash_core<MODE, VAR>(lds, u, qr, scale, o, m_reg, l_reg);
#endif
        float rf[16]; fa::row_factors(lds, wid, r32, hi, nsa_gate(a, b * SEQ + tq, MODE == 1 ? 2 : 1, head) / l_reg, rf);
        if (VAR != 0) { float sink = 0.f; for (int d0 = 0; d0 < 4; ++d0) for (int r = 0; r < 16; ++r) sink += o[d0][r] * rf[r]; if (sink == 1.2345e-30f) acc[0] = sink; __syncthreads(); continue; }
        const size_t off0 = (size_t)(b * SEQ + t0 + 4 * hi) * DM + head * 128 + r32;
        float av[16][4];
#pragma unroll
        for (int r = 0; r < 16; ++r)
#pragma unroll
            for (int d0 = 0; d0 < 4; ++d0) av[r][d0] = acc[off0 + (size_t)((r & 3) + 8 * (r >> 2)) * DM + d0 * 32];
        asm volatile("" ::: "memory");
#pragma unroll
        for (int r = 0; r < 16; ++r) { const size_t off = off0 + (size_t)((r & 3) + 8 * (r >> 2)) * DM;
#pragma unroll
            for (int d0 = 0; d0 < 4; ++d0) { const float v = av[r][d0] + o[d0][r] * rf[r];
                if (MODE == 1) acc[off + d0 * 32] = v;
                else { const float vn = dpp_xor1(v); if ((r32 & 1) == 0) *(unsigned*)(hcat + off + d0 * 32) = cvt_pk_bf16(v, vn); } } }
        __syncthreads();
    }
}
__device__ __forceinline__ void p1617_nsa_attn(char* lds, const Args& a) {
    const int tid = threadIdx.x, wid = __builtin_amdgcn_readfirstlane(tid >> 6), lane = tid & 63, r32 = lane & 31, hi = lane >> 5;
    const bf16_t* projc = (const bf16_t*)(a.ws + WS_R); const float* acc = (const float*)(a.ws + WS_Z); bf16_t* hcat = (bf16_t*)a.out;
    const unsigned long long* selp = (const unsigned long long*)(a.ws + WS_SEL);
    const float scale = 0.08838834764831845f;
    unsigned* park = (unsigned*)(lds + fa::OFF_IMP) + wid * 2048 + lane;
    static_assert(fa::OFF_IMP + 8 * 8192 <= fa::LDS_END, "park region");
    for (int kk = 0; kk * (int)gridDim.x < 2048; ++kk) {
        const int pass = kk & 1, it2 = xcd_unit(kk >> 1, 4, 16, 64); if (it2 >= 1024) break;
        const int bg = it2 >> 6, x = it2 & 63, xb = pass ? 127 - x : x;
        const int b = bg >> 2, g = bg & 3, t0 = xb * 32, head = g * 8 + wid, tq = t0 + r32;
        const bf16_t* qrow = projc + (size_t)(b * SEQ + tq) * C_NP + C_Q + head * 128;
        bf16x8 qr[8];
#pragma unroll
        for (int d0 = 0; d0 < 8; ++d0) qr[d0] = *(const bf16x8*)(qrow + d0 * 16 + hi * 8);
        fa::FUnit u; u.KRb = nullptr; u.ldk = C_NP; u.ldv = C_NP; u.qlo = t0; u.qhi = t0 + 31; u.qpos = tq; u.sel = 0ull;
        f32x16 o[4]; float m_reg, l_reg; float rf[16];
        { u.Kb = projc + (size_t)(b * SEQ) * C_NP + C_KW + g * 128; u.Vb = projc + (size_t)(b * SEQ) * C_NP + C_VW + g * 128;
          const int lowk = t0 - 511; u.j_lo = lowk > 0 ? lowk / 64 : 0; u.j_hi = (t0 + 31) / 64 + 1; }
        fa::flash_core<1, 0>(lds, u, qr, scale, o, m_reg, l_reg);
        fa::row_factors(lds, wid, r32, hi, nsa_gate(a, b * SEQ + tq, 2, head) / l_reg, rf);
#pragma unroll
        for (int d0 = 0; d0 < 4; ++d0)
#pragma unroll
            for (int r = 0; r < 16; r += 2) park[(d0 * 8 + (r >> 1)) * 64] = cvt_pk_bf16(o[d0][r] * rf[r], o[d0][r + 1] * rf[r + 1]);
        __syncthreads();
        u.Kb = projc + (size_t)(b * SEQ) * C_NP + C_KS + g * 128; u.Vb = projc + (size_t)(b * SEQ) * C_NP + C_VS + g * 128;
        u.j_lo = 0; u.j_hi = (t0 + 31) / 64 + 1; u.sel = selp[(size_t)bg * SEQ + tq];
        fa::flash_core<2, 0>(lds, u, qr, scale, o, m_reg, l_reg);
        fa::row_factors(lds, wid, r32, hi, nsa_gate(a, b * SEQ + tq, 1, head) / l_reg, rf);
        const size_t off0 = (size_t)(b * SEQ + t0 + 4 * hi) * DM + head * 128 + r32;
        float av[16][4];
#pragma unroll
        for (int r = 0; r < 16; ++r)
#pragma unroll
            for (int d0 = 0; d0 < 4; ++d0) av[r][d0] = acc[off0 + (size_t)((r & 3) + 8 * (r >> 2)) * DM + d0 * 32];
        asm volatile("" ::: "memory");
#pragma unroll
        for (int r = 0; r < 16; r += 2) {
#pragma unroll
            for (int d0 = 0; d0 < 4; ++d0) { const unsigned pw = park[(d0 * 8 + (r >> 1)) * 64];
#pragma unroll
                for (int e = 0; e < 2; ++e) { const int rr = r + e; const size_t off = off0 + (size_t)((rr & 3) + 8 * (rr >> 2)) * DM;
                    const float v = av[rr][d0] + __uint_as_float(e ? (pw & 0xffff0000u) : (pw << 16)) + o[d0][rr] * rf[rr];
                    const float vn = dpp_xor1(v); if ((r32 & 1) == 0) *(unsigned*)(hcat + off + d0 * 32) = cvt_pk_bf16(v, vn); } } }
        __syncthreads();
    }
}
__device__ __forceinline__ void p15_17_nsa(char* lds, const Args& a) {
    const int tid = threadIdx.x, wid = __builtin_amdgcn_readfirstlane(tid >> 6), lane = tid & 63;
    const bf16_t* projc = (const bf16_t*)(a.ws + WS_R); const bf16_t* kcmp = (const bf16_t*)(a.ws + WS_KCMP); const bf16_t* vcmp = (const bf16_t*)(a.ws + WS_VCMP); bf16_t* hcat = (bf16_t*)a.out;
    const float scale = 0.08838834764831845f, C2 = 1.4426950408889634f * scale;
    constexpr int ILD = 256;
    float* IMP = (float*)(lds + fa::OFF_V);
    unsigned long long* SELM = (unsigned long long*)(lds + fa::OFF_KR);
    char* PARK = lds + fa::OFF_IMP;
    static_assert(fa::OFF_IMP + 8 * 8192 <= fa::LDS_END, "park region");
    for (int kk = 0; kk * (int)gridDim.x < 2048; ++kk) {
        int lk = lane; asm volatile("" : "+v"(lk));
        const int pass = kk & 1, it2 = xcd_unit(kk >> 1, 4, 16, 64); if (it2 >= 1024) break;
        const int bg = it2 >> 6, x = it2 & 63, xb = pass ? 127 - x : x;
        const int b = bg >> 2, g = bg & 3, t0 = xb * 32;
        f32x16 o[4]; float m_reg, l_reg; float rf[16];
        fa::FUnit u;
        {
        const int tokl = wid * 4 + ((lk & 31) >> 3), head = g * 8 + (lk & 7), tq = t0 + tokl;
        const bf16_t* qrow = projc + (size_t)(b * SEQ + tq) * C_NP + C_Q + head * 128;
        bf16x8 qr[8];
#pragma unroll
        for (int d0 = 0; d0 < 8; ++d0) qr[d0] = *(const bf16x8*)(qrow + d0 * 16 + (lk >> 5) * 8);
        u.Kb = kcmp + (size_t)(b * 256 * 4 + g) * 256; u.ldk = 1024; u.Vb = vcmp + (size_t)(b * 256 * 4 + g) * 256; u.ldv = 1024; u.KRb = nullptr;
        const int nmax_hi = (t0 + 31 - 31) >> 4;
        u.j_lo = 0; u.j_hi = (nmax_hi >> 6) + 1; u.qlo = (t0 + wid * 4 - 31) >> 4; u.qhi = (t0 + wid * 4 + 3 - 31) >> 4; u.qpos = (tq - 31) >> 4; u.sel = 0ull;
        fa::flash_core<3>(lds, u, qr, scale, o, m_reg, l_reg);
        int lo_ = lk; asm volatile("" : "+v"(lo_));
        const int r32 = lo_ & 31, hi = lo_ >> 5;
        const float inv_l = l_reg > 0.f ? 1.0f / l_reg : 0.f;
        fa::row_factors(lds, wid, r32, hi, inv_l * nsa_gate(a, b * SEQ + tq, 0, head), rf);
#pragma unroll
        for (int r = 0; r < 16; ++r) { const int orow = fa::crow(r, hi); char* pp = PARK + (orow & 7) * 8192 + (wid * 4 + (orow >> 3)) * 256 + r32 * 2;
#pragma unroll
            for (int d0 = 0; d0 < 4; ++d0) { const float v = o[d0][r] * rf[r]; const float vn = dpp_xor1(v); if ((r32 & 1) == 0) *(unsigned*)(pp + d0 * 64) = cvt_pk_bf16(v, vn); } }
        __syncthreads();
        const float mL = -m_reg * C2;
        const int sr = tid >> 4, sc = (tid & 15) * 8, kws = KSWZ(sr, sc * 2);
        for (int t = 0; t < u.j_hi; ++t) {
            const int kb = t * 64;
            const bf16x8 k0 = *(const bf16x8*)(u.Kb + (long)(kb + sr) * u.ldk + sc), k1 = *(const bf16x8*)(u.Kb + (long)(kb + 32 + sr) * u.ldk + sc);
            *(bf16x8*)(lds + fa::OFF_K + kws) = k0; *(bf16x8*)(lds + fa::OFF_K + kws + 32 * 256) = k1;
            __syncthreads();
            f32x16 p0, p1; fa::qkt<0, false, true>(p0, p1, lds, r32, hi, qr);
            fa::mask_tile(p0, p1, u.qpos - kb - 4 * hi, 0x80000000u);
#pragma unroll
            for (int r = 0; r < 16; ++r) {
                float a0 = __builtin_amdgcn_exp2f(fmaf(p0[r], C2, mL)) * inv_l, a1 = __builtin_amdgcn_exp2f(fmaf(p1[r], C2, mL)) * inv_l;
                a0 += dpp_xor1(a0); a0 += dpp_xor2(a0); a0 += dpp_hmir(a0);
                a1 += dpp_xor1(a1); a1 += dpp_xor2(a1); a1 += dpp_hmir(a1);
                if ((r32 & 7) == 0) { const int n = kb + fa::crow(r, hi); IMP[tokl * ILD + n] = a0; IMP[tokl * ILD + n + 32] = a1; }
            }
            __syncthreads();
        }
        for (int q4 = 0; q4 < 4; ++q4) {
            const int tl = wid * 4 + q4, tqq = t0 + tl, cur = tqq >> 6, sb = lk;
            float v = 0.f;
#pragma unroll
            for (int dn = -1; dn <= 3; ++dn) { const int n = 4 * sb + dn; if (n >= 0 && n <= 254 && n < u.j_hi * 64) v += IMP[tl * ILD + n]; }
            if (sb == 0 || sb == cur || sb == cur - 1) v = 1e9f;
            if (sb > cur) v = -1e30f;
            int rank = 0;
#pragma nounroll
            for (int j = 0; j < 64; ++j) { const float vj = __int_as_float(__builtin_amdgcn_readlane(__float_as_int(v), j)); rank += (vj > v || (vj == v && j < sb)) ? 1 : 0; }
            const unsigned long long msk = __ballot(rank < 16);
            if (lk == 0) SELM[tl] = msk;
        }
        __syncthreads();
        }
        const int head = g * 8 + wid, tq = t0 + (lk & 31);
        const bf16_t* qrow = projc + (size_t)(b * SEQ + tq) * C_NP + C_Q + head * 128;
        bf16x8 qr[8];
#pragma unroll
        for (int d0 = 0; d0 < 8; ++d0) qr[d0] = *(const bf16x8*)(qrow + d0 * 16 + (lk >> 5) * 8);
        u.KRb = nullptr; u.ldk = C_NP; u.ldv = C_NP; u.qlo = t0; u.qhi = t0 + 31; u.qpos = tq; u.sel = 0ull;
        { u.Kb = projc + (size_t)(b * SEQ) * C_NP + C_KW + g * 128; u.Vb = projc + (size_t)(b * SEQ) * C_NP + C_VW + g * 128;
          const int lowk = t0 - 511; u.j_lo = lowk > 0 ? lowk / 64 : 0; u.j_hi = (t0 + 31) / 64 + 1; }
        fa::flash_core<1, 0>(lds, u, qr, scale, o, m_reg, l_reg);
        int lw_ = lk; asm volatile("" : "+v"(lw_));
        { const int r32 = lw_ & 31, hi = lw_ >> 5;
        fa::row_factors(lds, wid, r32, hi, nsa_gate(a, b * SEQ + tq, 2, head) / l_reg, rf);
        char* pw_ = PARK + wid * 8192 + (4 * hi) * 256 + (r32 & ~1) * 2;
#pragma unroll
        for (int r = 0; r < 16; ++r)
#pragma unroll
            for (int d0 = 0; d0 < 4; ++d0) { const float v = o[d0][r] * rf[r]; const float vn = dpp_xor1(v);
                if ((r32 & 1) == 0) { unsigned* q_ = (unsigned*)(pw_ + ((r & 3) + 8 * (r >> 2)) * 256 + d0 * 64); const unsigned pw = *q_;
                    *q_ = cvt_pk_bf16(__uint_as_float(pw << 16) + v, __uint_as_float(pw & 0xffff0000u) + vn); } } }
        __syncthreads();
        u.Kb = projc + (size_t)(b * SEQ) * C_NP + C_KS + g * 128; u.Vb = projc + (size_t)(b * SEQ) * C_NP + C_VS + g * 128;
        u.j_lo = 0; u.j_hi = (t0 + 31) / 64 + 1; u.sel = SELM[lk & 31];
        fa::flash_core<2, 0>(lds, u, qr, scale, o, m_reg, l_reg);
        int ls_ = lk; asm volatile("" : "+v"(ls_));
        const int r32 = ls_ & 31, hi = ls_ >> 5;
        fa::row_factors(lds, wid, r32, hi, nsa_gate(a, b * SEQ + tq, 1, head) / l_reg, rf);
        char* pw_ = PARK + wid * 8192 + (4 * hi) * 256 + (r32 & ~1) * 2;
        bf16_t* ob = hcat + (size_t)(b * SEQ + t0 + 4 * hi) * DM + head * 128 + (r32 & ~1);
#pragma unroll
        for (int r = 0; r < 16; ++r)
#pragma unroll
            for (int d0 = 0; d0 < 4; ++d0) { const float v = o[d0][r] * rf[r]; const float vn = dpp_xor1(v);
                if ((r32 & 1) == 0) { const unsigned pw = *(const unsigned*)(pw_ + ((r & 3) + 8 * (r >> 2)) * 256 + d0 * 64);
                    *(unsigned*)(ob + (size_t)((r & 3) + 8 * (r >> 2)) * DM + d0 * 32) = cvt_pk_bf16(__uint_as_float(pw << 16) + v, __uint_as_float(pw & 0xffff0000u) + vn); } }
        __syncthreads();
    }
}


#ifndef DEBUG_CMP
#define DEBUG_CMP -1
#endif
#if DEBUG_CMP >= 0
__device__ __forceinline__ void dbg_copy(const Args& a) {
    const bf16_t* hcat = (const bf16_t*)(a.ws + WS_XB); bf16_t* dbg = (bf16_t*)(a.ws + WS_Z);
    const size_t gt = (size_t)blockIdx.x * NTHREADS + threadIdx.x, gs = (size_t)gridDim.x * NTHREADS;
    for (size_t i = gt; i < (size_t)M_TOK * 256; i += gs) { const size_t row = i >> 8, c8 = i & 255; *(bf16x8*)(dbg + row * 2048 + c8 * 8) = *(const bf16x8*)(hcat + row * DM + c8 * 8); }
}
__device__ __forceinline__ void dbg_compare(const Args& a) {
    const bf16_t* hcat = (const bf16_t*)(a.ws + WS_XB); const bf16_t* dbg = (const bf16_t*)(a.ws + WS_Z);
    float* accum = (float*)(a.ws + WS_CTL + 32 * 1024);
    const size_t gt = (size_t)blockIdx.x * NTHREADS + threadIdx.x, gs = (size_t)gridDim.x * NTHREADS;
    float sd = 0.f, sr = 0.f;
    for (size_t i = gt; i < (size_t)M_TOK * 256; i += gs) { const size_t row = i >> 8, c8 = i & 255; const int t = (int)(row & (SEQ - 1));
        bool in = false;
        if (DEBUG_CMP == 0) in = t < 32; if (DEBUG_CMP == 1) in = t >= 32 && t < 64; if (DEBUG_CMP == 2) in = t >= 64 && t < 128; if (DEBUG_CMP == 3) in = true;
        if (DEBUG_CMP == 4) in = (t & 63) < 32; if (DEBUG_CMP == 5) in = (t & 63) >= 32;
        if (!in) continue;
        float x[8], y[8]; unpack8(*(const bf16x8*)(hcat + row * DM + c8 * 8), x); unpack8(*(const bf16x8*)(dbg + row * 2048 + c8 * 8), y);
#pragma unroll
        for (int j = 0; j < 8; ++j) { const float d = x[j] - y[j]; sd += d * d; sr += x[j] * x[j]; } }
    sd = wave_sum(sd); sr = wave_sum(sr);
    if ((threadIdx.x & 63) == 0) { atomicAdd((unsigned long long*)accum, (unsigned long long)(sd * 1048576.0f)); atomicAdd((unsigned long long*)accum + 1, (unsigned long long)(sr * 1048576.0f)); }
}
#endif

constexpr int N_PHASES = 23;
__global__ void __launch_bounds__(NTHREADS, 2) fwd(Args args) {
    extern __shared__ __attribute__((aligned(16))) unsigned char shm[];
    char* lds = (char*)shm;
    PG8_LAS unsigned char* ldsg = (PG8_LAS unsigned char*)shm;
    unsigned char* ws = args.ws;
    if (threadIdx.x < 64) ((volatile LAS unsigned*)(ldsg + LDS_CTL_OFF))[threadIdx.x] = 0u;
    __syncthreads();
    XcdBarrier bar = xcd_barrier_post((unsigned*)(ws + WS_CTL), (volatile LAS unsigned*)(ldsg + LDS_CTL_OFF));
    const int lo = args.ph_lo, hi = args.ph_hi, G = gridDim.x, bx = blockIdx.x;
#define IN(k) (lo <= (k) && (k) < hi)
#define SEAM(k) do { if (IN(k) && IN((k) + 1)) xcd_barrier(bar); } while (0)
#define GEMMC(EPI, cidx, Aoff, Boff, Mr, Nr, Kr, ...) do { pg8::Gemm g_{(const pg8::bf16_t*)(ws + (Aoff)), (const pg8::bf16_t*)(ws + (Boff)), (Mr), (Nr), (Kr)}; pg8::StaticOrder S_; S_.init((Mr), (Nr), G, (cidx)); S_.WGM = GEMM_WGM; \
        EPI E_{__VA_ARGS__}; pg8::gemm_phase<EPI, pg8::StaticOrder, true, true>(ldsg, g_, S_, E_); } while (0)
#define GEMM(EPI, ...) GEMMC(EPI, bx, __VA_ARGS__)
#define GEMMA(EPI, Aptr, Boff, Mr, Nr, Kr, ...) do { pg8::Gemm g_{(const pg8::bf16_t*)(Aptr), (const pg8::bf16_t*)(ws + (Boff)), (Mr), (Nr), (Kr)}; pg8::StaticOrder S_; S_.init((Mr), (Nr), G, bx); S_.WGM = GEMM_WGM; \
        EPI E_{__VA_ARGS__}; pg8::gemm_phase<EPI, pg8::StaticOrder, true, true>(ldsg, g_, S_, E_); } while (0)
#define GEMM_WGM gemm_wgm
    float* xres = args.out;
    bf16_t* xb = (bf16_t*)(ws + WS_XB); const bf16_t* hcat = (const bf16_t*)args.out; f32x2* stats = (f32x2*)(ws + WS_STATS);
    bf16_t* zA = (bf16_t*)(ws + WS_Z); bf16_t* zB = (bf16_t*)args.out + (size_t)M_TOK * DM; bf16_t* zC = zA; bf16_t* zD = zA + (size_t)M_TOK * DM;

#ifndef FFN_CHUNKED
#define FFN_CHUNKED 0
#endif
#ifndef WGM_IN
#define WGM_IN 8
#endif
#ifndef WGM_WO
#define WGM_WO 4
#endif
#ifndef WGM_UP
#define WGM_UP 8
#endif
#ifndef WGM_DOWN
#define WGM_DOWN 2
#endif
    int gemm_wgm = 8;
#ifndef PROBE_MASK
#define PROBE_MASK 0u
#endif
#define PB(k) (((PROBE_MASK) >> (k)) & 1u)
#define PH(k, ...) do { if (IN(k)) { __VA_ARGS__; if (PB(k)) { xcd_barrier(bar); __VA_ARGS__; } } SEAM(k); } while (0)
    PH(0, p0_prologue(lds, args));
    gemm_wgm = WGM_IN; PH(1, GEMM(pg8::EpiProj, WS_XB, W_AB, M_TOK, AB_NP, DM, (bf16_t*)(ws + WS_R), AB_NP, (float*)(ws + WS_GATES), AB_IG / 256); if (bx >= 192 && G == 256) transpose_late(lds, args, bx - 192));
    PH(2, p2_prep(lds, args));
    gemm_wgm = 8; if (IN(3)) { GEMM(pg8::EpiB<0>, WS_CQN, W_UQ, M_TOK, 3072, 1024, (bf16_t*)(ws + WS_QB), 3072); GEMM(pg8::EpiB<0>, WS_CKVN, W_UKV, M_TOK, 4096, 512, (bf16_t*)(ws + WS_KVB), 4096); }
    if (!(IN(3) && IN(4))) SEAM(3);
#if DEBUG_CMP >= 0
#if MC_VALU_STATE == 4
    PH(4, p4_mlstm_chunk(lds, args); xcd_barrier(bar); p4_mlstm(lds, args));
#else
    PH(4, p4_mlstm_chunk(lds, args); xcd_barrier(bar); dbg_copy(args); xcd_barrier(bar); p4_mlstm(lds, args); xcd_barrier(bar); dbg_compare(args));
#endif
#elif MLSTM_BOTH
    PH(4, p4_mlstm_chunk(lds, args); xcd_barrier(bar); p4_mlstm(lds, args));
#elif MLSTM_CHUNK
    PH(4, p4_mlstm_chunk(lds, args));
#else
    PH(4, p4_mlstm(lds, args));
#endif
    if (IN(5)) { p5_mlstm_norm(args); p5_mla(lds, args); if (PB(5)) { xcd_barrier(bar); p5_mla(lds, args); } } SEAM(5);
    gemm_wgm = WGM_WO; PH(6, GEMMA(pg8::EpiResidB, hcat, W_O0, M_TOK, DM, DM, zA, xb));
    PH(7, p7_layernorm_b(args, 0, true, zA, nullptr, xb, stats));
#if FFN_CHUNKED
#define FFN_UP(WGU, half) GEMM(pg8::EpiSwiGLU, WS_XB + (size_t)(half) * 8192 * DM * 2, WGU, 8192, GU_N, DM, (bf16_t*)(ws + WS_R) + (size_t)(half) * 8192 * FFH, FFH)
#define FFN_DOWN(WD, half, Cp, Zpp, lg, lb) GEMM(pg8::EpiResidLN, WS_R + (size_t)(half) * 8192 * FFH * 2, WD, 8192, DM, FFH, (Cp) + (size_t)(half) * 8192 * DM, (Zpp) + (size_t)(half) * 8192 * DM, stats + (half) * 8192, lg, lb, DM, DN_ALPHA)
    if (IN(8)) { gemm_wgm = WGM_UP; FFN_UP(W_GU0, 0); if (bx >= 192 && G == 256) transpose_late(lds, args, 64 + bx - 192); } SEAM(8);
    if (IN(9)) { gemm_wgm = WGM_DOWN; FFN_DOWN(W_D0, 0, xres, z, args.in[22], args.in[23]); gemm_wgm = WGM_UP; FFN_UP(W_GU0, 1); if (bx >= 192 && G == 256) transpose_late(lds, args, 128 + bx - 192);
                 xcd_barrier(bar); gemm_wgm = WGM_DOWN; FFN_DOWN(W_D0, 1, xres, z, args.in[22], args.in[23]); } SEAM(9);
#else
    gemm_wgm = WGM_UP; PH(8, GEMM(pg8::EpiSwiGLU, WS_XB, W_GU0, M_TOK, GU_N, DM, (bf16_t*)(ws + WS_R), FFH); if (bx >= 128 && G == 256) transpose_late(lds, args, 64 + bx - 128));
    gemm_wgm = WGM_DOWN; PH(9, GEMM(pg8::EpiResidLNB, WS_R, W_D0, M_TOK, DM, FFH, zB, zA, stats, args.in[22], args.in[23]));
#endif
    PH(10, p7_layernorm_b(args, 0, false, zB, nullptr, xb, stats));
    gemm_wgm = WGM_IN; PH(11, GEMM(pg8::EpiB<0>, WS_XB, W_C, M_TOK, C_NP, DM, (bf16_t*)(ws + WS_R), C_NP); if (bx >= 64 && G == 256) transpose_late(lds, args, 192 + bx - 64));
    PH(12, p12_blocks(args));
    gemm_wgm = 8; PH(13, GEMM(pg8::EpiB<1>, WS_AK, W_C1K, 4096, 256, 4096, (bf16_t*)(ws + WS_HK), 256);
           GEMMC(pg8::EpiB<1>, (bx + G - 16) % G, WS_AV, W_C1V, 4096, 256, 4096, (bf16_t*)(ws + WS_HV), 256);
           if (G == 256) { if (bx >= 32) transpose_late(lds, args, 384 + bx - 32); } else { for (int sl_ = bx; sl_ < LATE_SLOTS; sl_ += G) transpose_late(lds, args, sl_); for (int sl_ = bx; sl_ < LATE_D_SLOTS; sl_ += G) transpose_late_d(lds, args, sl_); });
    PH(14, GEMM(pg8::EpiB<0>, WS_HK, W_C2K, 4096, 256, 256, (bf16_t*)(ws + WS_KCMP), 256);
           GEMMC(pg8::EpiB<0>, (bx + G - 16) % G, WS_HV, W_C2V, 4096, 256, 256, (bf16_t*)(ws + WS_VCMP), 256));
#ifndef NSA_ALL
#define NSA_ALL 1
#endif
#if NSA_ALL
    if (IN(15)) { p15_17_nsa(lds, args); } SEAM(15);
#else
    if (IN(15)) { p15_cmp_attn(lds, args); } SEAM(15);
#ifndef NSA_MERGED
#define NSA_MERGED 1
#endif
#if NSA_MERGED
    if (IN(16)) { p1617_nsa_attn(lds, args); } SEAM(16);
#else
    if (IN(16)) { p16_nsa_attn<1>(lds, args); if (PB(16)) { xcd_barrier(bar); p15_cmp_attn(lds, args); xcd_barrier(bar); p16_nsa_attn<1>(lds, args); } } SEAM(16);
#ifndef PROBE_VAR
#define PROBE_VAR 0
#endif
    if (IN(17)) { p16_nsa_attn<2>(lds, args); if (PB(17)) { xcd_barrier(bar); p16_nsa_attn<2, PROBE_VAR>(lds, args); } } SEAM(17);
#endif
#endif
    gemm_wgm = WGM_WO; PH(18, GEMMA(pg8::EpiResidLNB, hcat, W_O1, M_TOK, DM, DM, zC, zB, stats, args.in[24], args.in[25]));
    PH(19, p7_layernorm_b(args, 1, true, zC, nullptr, xb, stats));
#if FFN_CHUNKED
    if (IN(20)) { gemm_wgm = WGM_UP; FFN_UP(W_GU1, 0); } SEAM(20);
    if (IN(21)) { gemm_wgm = WGM_DOWN; FFN_DOWN(W_D1, 0, xres, z, args.in[22] + DM, args.in[23] + DM); gemm_wgm = WGM_UP; FFN_UP(W_GU1, 1);
                  xcd_barrier(bar); gemm_wgm = WGM_DOWN; FFN_DOWN(W_D1, 1, xres, z, args.in[22] + DM, args.in[23] + DM); } SEAM(21);
#else
    gemm_wgm = WGM_UP; PH(20, GEMM(pg8::EpiSwiGLU, WS_XB, W_GU1, M_TOK, GU_N, DM, (bf16_t*)(ws + WS_R), FFH); if (bx >= 128 && G == 256) transpose_late_d(lds, args, bx - 128));
    gemm_wgm = WGM_DOWN; PH(21, GEMM(pg8::EpiResidLNB, WS_R, W_D1, M_TOK, DM, FFH, zD, zC, stats, args.in[22] + DM, args.in[23] + DM));
#endif
    PH(22, p7_layernorm_b(args, 1, false, zD, xres, nullptr, nullptr));
#if DEBUG_CMP >= 0
    if (IN(22)) { xcd_barrier(bar); if (bx == 0 && threadIdx.x == 0) { const unsigned long long* accum = (const unsigned long long*)(ws + WS_CTL + 32 * 1024); const float rel = sqrtf((float)((double)accum[0] / fmax((double)accum[1], 1.0)));
        float k = -20.0f * log10f(fmaxf(rel, 1e-6f)); k = fminf(fmaxf(rintf(k), 0.f), 89.f); xres[0] = 1000.0f + 100.0f * k; } }
#endif
#undef PH
#undef PB
#undef IN
#undef SEAM
#undef GEMM
#undef GEMMC
}

#ifndef MK_N_LAUNCHES
#define MK_N_LAUNCHES 1
#endif
extern "C" void kernel_launch(void* const* d_in, const int* in_sizes, int n_in, void* d_out, int out_size, void* d_ws, size_t ws_size, hipStream_t stream) {
    static int grid = 0;
    if (grid == 0) {
        if (n_in != 26 || in_sizes[0] != M_TOK * DM || out_size != M_TOK * DM || ws_size < WS_END) {
            fprintf(stderr, "kernel_launch: unexpected shapes (n_in %d, in0 %d, out %d, ws %zu, need %zu); nothing launched\n", n_in, n_in > 0 ? in_sizes[0] : -1, out_size, ws_size, (size_t)WS_END); grid = -1; return; }
        int dev = 0, cus = 0, per_cu = 0;
        if (hipGetDevice(&dev) != hipSuccess || hipDeviceGetAttribute(&cus, hipDeviceAttributeMultiprocessorCount, dev) != hipSuccess) { grid = -1; return; }
        if (hipFuncSetAttribute((const void*)fwd, hipFuncAttributeMaxDynamicSharedMemorySize, LDS_BYTES) != hipSuccess) { fprintf(stderr, "kernel_launch: hipFuncSetAttribute failed\n"); grid = -1; return; }
        if (hipOccupancyMaxActiveBlocksPerMultiprocessor(&per_cu, (const void*)fwd, NTHREADS, LDS_BYTES) != hipSuccess || per_cu < 1) { fprintf(stderr, "kernel_launch: occupancy query says %d blocks per CU\n", per_cu); (void)hipGetLastError(); grid = -1; return; }
        grid = cus;
    }
    if (grid < 0) return;
    (void)hipMemsetAsync((char*)d_ws + WS_CTL, 0, 64 * 1024, stream);
    Args a{};
    for (int i = 0; i < 26; ++i) a.in[i] = (const float*)d_in[i];
    a.out = (float*)d_out; a.ws = (unsigned char*)d_ws;
    unsigned char* ws = (unsigned char*)d_ws;
    const float* fg = a.in[19]; const float* fu = a.in[20]; const float* fd = a.in[21];
    const size_t LW = (size_t)DM * FFH;
    int j = 0;
    a.tj[j++] = TJob{a.in[1], nullptr, (bf16_t*)(ws + W_AB), DM, AB_IN, AB_NP, 0};
    a.tj[j++] = TJob{a.in[7], nullptr, (bf16_t*)(ws + W_UQ), 1024, 3072, 3072, 0};
    a.tj[j++] = TJob{a.in[8], nullptr, (bf16_t*)(ws + W_UKV), 512, 4096, 4096, 0};
    a.tj[j++] = TJob{a.in[9], nullptr, (bf16_t*)(ws + W_O0), DM, DM, DM, 0};
    a.tj[j++] = TJob{fg, fu, (bf16_t*)(ws + W_GU0), DM, FFH, GU_N, 1};
    a.tj[j++] = TJob{fd, nullptr, (bf16_t*)(ws + W_D0), FFH, DM, DM, 0};
    a.tj[j++] = TJob{a.in[10], nullptr, (bf16_t*)(ws + W_C), DM, C_IN, C_NP, 0};
    a.tj[j++] = TJob{a.in[14], nullptr, (bf16_t*)(ws + W_C1K), 4096, 256, 256, 0};
    a.tj[j++] = TJob{a.in[16], nullptr, (bf16_t*)(ws + W_C1V), 4096, 256, 256, 0};
    a.tj[j++] = TJob{a.in[15], nullptr, (bf16_t*)(ws + W_C2K), 256, 128, 256, 0};
    a.tj[j++] = TJob{a.in[17], nullptr, (bf16_t*)(ws + W_C2V), 256, 128, 256, 0};
    a.tj[j++] = TJob{a.in[18], nullptr, (bf16_t*)(ws + W_O1), DM, DM, DM, 0};
    a.tj[j++] = TJob{fg + LW, fu + LW, (bf16_t*)(ws + W_GU1), DM, FFH, GU_N, 1};
    a.tj[j++] = TJob{fd + LW, nullptr, (bf16_t*)(ws + W_D1), FFH, DM, DM, 0};
#if MK_N_LAUNCHES == 1
    a.ph_lo = 0; a.ph_hi = N_PHASES;
    hipLaunchKernelGGL(fwd, dim3(grid), dim3(NTHREADS), LDS_BYTES, stream, a);
#else
    for (int p = 0; p < N_PHASES; ++p) { a.ph_lo = p; a.ph_hi = p + 1; hipLaunchKernelGGL(fwd, dim3(grid), dim3(NTHREADS), LDS_BYTES, stream, a); }
#endif
    const hipError_t le = hipPeekAtLastError();
    if (le != hipSuccess) fprintf(stderr, "kernel_launch: launch failed: %s\n", hipGetErrorName(le));
}
```

```cpp
#include <hip/hip_runtime.h>
#include <stdint.h>
#include <stdio.h>
#ifndef FLASH2
#define FLASH2 0
#endif
#ifndef DEBUG_CMP
#define DEBUG_CMP -1
#endif
#ifndef MLSTM_BOTH
#define MLSTM_BOTH 0
#endif
#ifndef MLSTM_CHUNK
#define MLSTM_CHUNK 1
#endif

typedef unsigned short bf16_t;
typedef short bf16x8 __attribute__((ext_vector_type(8)));
typedef short s16x4 __attribute__((ext_vector_type(4)));
typedef float f32x2 __attribute__((ext_vector_type(2)));
typedef float f32x4 __attribute__((ext_vector_type(4)));
typedef float f32x16 __attribute__((ext_vector_type(16)));
typedef unsigned u32x2 __attribute__((ext_vector_type(2)));
typedef unsigned u32x4 __attribute__((ext_vector_type(4)));

constexpr int M_TOK = 16384, SEQ = 4096, NBATCH = 4, DM = 4096;
constexpr int AB_IN = 7752, AB_NP = 7936, C_IN = 7264, C_NP = 7424, FFH = 11008, GU_N = 22016;
constexpr float DN_ALPHA = 1.4142135623730951f;
constexpr float LN_EPS = 1e-5f, RMS_EPS = 1e-6f;
constexpr int AB_Q = 0, AB_K = 1024, AB_V = 2048, AB_IG = 4096, AB_FG = 4100, AB_OG = 4104, AB_CQ = 6152, AB_CKV = 7176, AB_KR = 7688;
constexpr int C_Q = 0, C_KC = 4096, C_VC = 4608, C_KS = 5120, C_VS = 5632, C_KW = 6144, C_VW = 6656, C_GATE = 7168;

__device__ __forceinline__ float bf2f(bf16_t b) { return __uint_as_float(((unsigned)b) << 16); }
__device__ __forceinline__ unsigned cvt_pk_bf16(float lo, float hi) { unsigned r; asm volatile("v_cvt_pk_bf16_f32 %0, %1, %2" : "=v"(r) : "v"(lo), "v"(hi)); return r; }
__device__ __forceinline__ bf16_t f2bf(float f) { return (bf16_t)(cvt_pk_bf16(f, 0.f) & 0xffffu); }
__device__ __forceinline__ void unpack8(const bf16x8 v, float (&f)[8]) {
#pragma unroll
    for (int j = 0; j < 8; ++j) f[j] = bf2f((bf16_t)v[j]);
}
__device__ __forceinline__ bf16x8 pack8f(const float (&f)[8]) {
    u32x4 w = {cvt_pk_bf16(f[0], f[1]), cvt_pk_bf16(f[2], f[3]), cvt_pk_bf16(f[4], f[5]), cvt_pk_bf16(f[6], f[7])};
    return *reinterpret_cast<bf16x8*>(&w);
}
typedef _Float16 f16x2_t __attribute__((ext_vector_type(2)));
__device__ __forceinline__ unsigned cvt_pk_f16(float lo, float hi) { const f16x2_t h = {(_Float16)lo, (_Float16)hi}; return __builtin_bit_cast(unsigned, h); }
__device__ __forceinline__ void unpack8h(const bf16x8 v, float (&f)[8]) {
#pragma unroll
    for (int j = 0; j < 8; ++j) f[j] = (float)__builtin_bit_cast(_Float16, (short)v[j]);
}
__device__ __forceinline__ bf16x8 pack8h(const float (&f)[8]) {
    u32x4 w = {cvt_pk_f16(f[0], f[1]), cvt_pk_f16(f[2], f[3]), cvt_pk_f16(f[4], f[5]), cvt_pk_f16(f[6], f[7])};
    return *reinterpret_cast<bf16x8*>(&w);
}
__device__ __forceinline__ float wave_sum(float v) {
#pragma unroll
    for (int o = 32; o >= 1; o >>= 1) v += __shfl_xor(v, o);
    return v;
}
__device__ __forceinline__ float sigmoid_f(float x) { return __builtin_amdgcn_rcpf(1.0f + __expf(-x)); }

#define XB_TMO      128
#define XB_XCNT(j)  (256  + 64 * (j))
#define XB_XSUB(j)  (1280 + 64 * (j))
#define XB_XGEN(j)  (2304 + 64 * (j))
#define XB_TOP      3328
#define XB_TOPGEN   3392
#define XCD_BAR_WORDS 3456
#define XB_SPIN_CAP (1u << 22)
#define LAS __attribute__((address_space(3)))

__device__ __forceinline__ unsigned xb_ld(unsigned* p)              { return __hip_atomic_load(p, __ATOMIC_RELAXED, __HIP_MEMORY_SCOPE_AGENT); }
__device__ __forceinline__ unsigned xb_add(unsigned* p, unsigned v) { return __hip_atomic_fetch_add(p, v, __ATOMIC_RELAXED, __HIP_MEMORY_SCOPE_AGENT); }
__device__ __forceinline__ unsigned xb_xcc_id() { return (unsigned)__builtin_amdgcn_s_getreg((3 << 11) | 20) & 0xFu; }
#define XB_SPIN(cond, bar) do { unsigned _sp = 0; while (cond) { __builtin_amdgcn_s_sleep(1); \
    if ((++_sp & 255u) == 0u) { if (xb_ld(&(bar)[XB_TMO])) break; if (_sp > XB_SPIN_CAP) { atomicAdd(&(bar)[XB_TMO], 1u); break; } } } } while (0)

struct XcdBarrier {
    unsigned* bar; unsigned x;
    volatile LAS unsigned* st;
};

__device__ __forceinline__ XcdBarrier xcd_barrier_post(unsigned* bar, volatile LAS unsigned* st) {
    XcdBarrier b; b.bar = bar; b.x = xb_xcc_id(); b.st = st;
    if (threadIdx.x == 0) (void)xb_add(&bar[XB_XCNT(b.x)], 1u);
    return b;
}
__device__ __forceinline__ void xcd_barrier_complete(unsigned* bar, unsigned x, unsigned& nloc, unsigned& nx) {
    const unsigned G = gridDim.x * gridDim.y * gridDim.z;
    unsigned sum, cnt, mine, sp = 0u;
    for (;;) {
        sum = 0u; cnt = 0u; mine = 0u;
#pragma unroll
        for (unsigned j = 0; j < 16; ++j) { const unsigned c = xb_ld(&bar[XB_XCNT(j)]); sum += c; cnt += (c > 0u) ? 1u : 0u; mine = (j == x) ? c : mine; }
        if (sum == G) break;
        __builtin_amdgcn_s_sleep(1);
        if ((++sp & 255u) == 0u) { if (xb_ld(&bar[XB_TMO])) break; if (sp > XB_SPIN_CAP) { atomicAdd(&bar[XB_TMO], 1u); break; } }
    }
    nloc = mine > 0u ? mine : 1u; nx = cnt > 0u ? cnt : 1u;
}

__device__ __forceinline__ void xcd_barrier(const XcdBarrier& b) {
    asm volatile("s_waitcnt vmcnt(0)" ::: "memory");
    __syncthreads();
    if (threadIdx.x == 0) {
        unsigned* bar = b.bar;
        __builtin_amdgcn_s_waitcnt(0);
        unsigned nloc = b.st[0], nx = b.st[1];
        if (nloc == 0u) { xcd_barrier_complete(bar, b.x, nloc, nx); b.st[0] = nloc; b.st[1] = nx; }
        const unsigned old = xb_add(&bar[XB_XSUB(b.x)], 1u);
        const unsigned gen = old / nloc;
        if (old + 1u == (gen + 1u) * nloc) {
            __builtin_amdgcn_fence(__ATOMIC_RELEASE, "agent");
            asm volatile("s_waitcnt vmcnt(0)" ::: "memory");
            const unsigned og = xb_add(&bar[XB_TOP], 1u);
            const unsigned tg = og / nx;
            if (og + 1u == (tg + 1u) * nx) xb_add(&bar[XB_TOPGEN], 1u);
            else XB_SPIN(xb_ld(&bar[XB_TOPGEN]) == tg, bar);
            __builtin_amdgcn_fence(__ATOMIC_ACQUIRE, "agent");
            xb_add(&bar[XB_XGEN(b.x)], 1u);
            asm volatile("s_waitcnt vmcnt(0)" ::: "memory");
        } else {
            XB_SPIN(xb_ld(&bar[XB_XGEN(b.x)]) == gen, bar);
            __builtin_amdgcn_fence(__ATOMIC_ACQUIRE, "agent");
            asm volatile("s_waitcnt vmcnt(0)" ::: "memory");
        }
    }
    __syncthreads();
}namespace pg8 {
#define PG8_LAS __attribute__((address_space(3)))
typedef unsigned short bf16_t;
typedef short bf16x8 __attribute__((ext_vector_type(8)));
typedef float f32x4 __attribute__((ext_vector_type(4)));
typedef unsigned u32x4 __attribute__((ext_vector_type(4)));
constexpr int BM = 256, BK = 64, HALF = 128, HTB = HALF * BK * 2  , STAGE_BYTES = 8 * HTB, NXCD = 8;

__host__ __device__ __forceinline__ int lds_byte(int r, int c) { const int st = (r >> 4) * 2 + (c >> 5), rr = r & 15, cc = c & 31, ob = rr * 64 + cc * 2; return st * 1024 + (ob ^ (((ob >> 9) & 1) << 5)); }
__host__ __device__ __forceinline__ void stage_rc(int b, int& R, int& C) { const int st = b / 1024, sb = b % 1024, swz = sb ^ (((sb >> 9) & 1) << 5); R = (st >> 1) * 16 + swz / 64; C = (st & 1) * 32 + (swz % 64) / 2; }
__host__ __device__ __forceinline__ int perm32(int rho) { const int n = rho >> 4, i = rho & 15; return 8 * (i >> 2) + 4 * n + (i & 3); }

struct Unit { int pm, pn; };
struct Gemm { const bf16_t* A; const bf16_t* Bt; int M, N, K; };

struct StaticOrder {
    int nM, nN, nwg, G, c, WGM = 8;
    __host__ __device__ void init(int M, int N, int G_, int c_) { nM = M / BM; nN = N / BM; nwg = nM * nN; G = G_; c = c_; }
    __host__ __device__ bool next(int i, Unit& u) const {
        const long L = (long)i * G + c; if (L >= nwg) return false;
        int wgid = (int)L; { const int q = nwg / NXCD, r = nwg % NXCD, xcd = wgid % NXCD, off = wgid / NXCD; wgid = (xcd < r ? xcd * (q + 1) : r * (q + 1) + (xcd - r) * q) + off; }
        const int nig = WGM * nN, gid = wgid / nig, fm = gid * WGM, gsz = (nM - fm) < WGM ? (nM - fm) : WGM;
        u.pm = fm + ((wgid % nig) % gsz); u.pn = (wgid % nig) / gsz; return true;
    }
    __device__ __forceinline__ void a_ready(const Unit&) const {}
    __device__ __forceinline__ void done(const Unit&) const {}
};
struct CountedOrder : StaticOrder {
    const unsigned* ready; unsigned need; unsigned* tmo;
    __device__ __forceinline__ void a_ready(const Unit& u) const {
        if (threadIdx.x < 64) {
            const unsigned long long t0 = __builtin_amdgcn_s_memrealtime(); unsigned polls = 0;
            while ((unsigned)__builtin_amdgcn_readfirstlane(__hip_atomic_load(ready + 64 * u.pm, __ATOMIC_RELAXED, __HIP_MEMORY_SCOPE_AGENT)) < need) {
                if ((++polls & 255u) == 0u && __builtin_amdgcn_readfirstlane(__hip_atomic_load(tmo, __ATOMIC_RELAXED, __HIP_MEMORY_SCOPE_AGENT)) != 0u) break;
                if (__builtin_amdgcn_s_memrealtime() - t0 > 2000000ull) {
                    if (threadIdx.x == 0) { unsigned expect = 0u; __hip_atomic_compare_exchange_strong(tmo + 1, &expect, 0x600u | (unsigned)(u.pm & 0xff), __ATOMIC_RELAXED, __ATOMIC_RELAXED, __HIP_MEMORY_SCOPE_AGENT); __hip_atomic_store(tmo, 1u, __ATOMIC_RELAXED, __HIP_MEMORY_SCOPE_AGENT); }
                    break; }
                __builtin_amdgcn_s_sleep(2); }
            __builtin_amdgcn_fence(__ATOMIC_ACQUIRE, "agent");
            asm volatile("s_waitcnt vmcnt(0)" ::: "memory");
        }
#if !defined(BROKEN_HOOK_NO_BARRIER)
        asm volatile("" ::: "memory"); __builtin_amdgcn_s_barrier(); asm volatile("" ::: "memory");
#endif
    }
};

__device__ __forceinline__ unsigned cvt_pk_bf16(float lo, float hi) { unsigned r; asm volatile("v_cvt_pk_bf16_f32 %0, %1, %2" : "=v"(r) : "v"(lo), "v"(hi)); return r; }
typedef float f32x2 __attribute__((ext_vector_type(2)));
__device__ __forceinline__ f32x2 gelu_pk(f32x2 v) {
    const f32x2 av = __builtin_elementwise_abs(v), d = av * 0.2316418882f + 1.0f;
    f32x2 t; t.x = __builtin_amdgcn_rcpf(d.x); t.y = __builtin_amdgcn_rcpf(d.y);
    f32x2 q = t * 0.5307027145f + (-0.7265760135f); q = q * t + 0.7107068705f; q = q * t + (-0.142248368f); q = q * t + 0.127414796f; q = q * t;
    const f32x2 s = (v * v) * (-0.72134752044f);
    f32x2 e; e.x = __builtin_amdgcn_exp2f(s.x); e.y = __builtin_amdgcn_exp2f(s.y);
    const f32x2 m = v * (q * e), r = v - m;
    f32x2 o; o.x = v.x < 0.f ? m.x : r.x; o.y = v.y < 0.f ? m.y : r.y; return o;
}

struct EpiF32 {
    static constexpr bool PERM = false, AFTER_DRAIN = false, PREFETCH = false;
    float* C; int ldc; const float* bias;
    __device__ __forceinline__ void operator()(const f32x4 (&acc)[2][2][4][2], const Unit& u, int wr, int wc, int fr, int fq) const {
        const int row0 = u.pm * BM + wr * 64 + fr, col0 = u.pn * BM + wc * 32 + 4 * fq;
        f32x4 bv[2][2];
#pragma unroll
        for (int bj = 0; bj < 2; ++bj)
#pragma unroll
            for (int n = 0; n < 2; ++n) bv[bj][n] = bias ? *(const f32x4*)(bias + col0 + bj * HALF + n * 16) : (f32x4){0.f, 0.f, 0.f, 0.f};
#pragma unroll
        for (int ai = 0; ai < 2; ++ai)
#pragma unroll
            for (int m = 0; m < 4; ++m) { float* rowp = C + (size_t)(row0 + ai * HALF + m * 16) * ldc + col0;
#pragma unroll
                for (int bj = 0; bj < 2; ++bj)
#pragma unroll
                    for (int n = 0; n < 2; ++n) *(f32x4*)(rowp + bj * HALF + n * 16) = acc[ai][bj][m][n] + bv[bj][n]; }
    }
};
template <int ACT  > struct EpiBf16 {
    static constexpr bool PERM = true, AFTER_DRAIN = false, PREFETCH = false;
    bf16_t* O; int ldc; const float* bias; int split_cols; size_t split_stride;
    __device__ __forceinline__ void operator()(const f32x4 (&acc)[2][2][4][2], const Unit& u, int wr, int wc, int fr, int fq) const {
        const int row0 = u.pm * BM + wr * 64 + fr; int colt = u.pn * BM; bf16_t* base = O;
        if (split_cols) { const int t = colt / split_cols; base += (size_t)t * split_stride; colt -= t * split_cols; }
        const int col0 = colt + wc * 32 + 8 * fq, bcol0 = u.pn * BM + wc * 32 + 8 * fq;
        f32x4 bv[2][2];
#pragma unroll
        for (int bj = 0; bj < 2; ++bj)
#pragma unroll
            for (int n = 0; n < 2; ++n) bv[bj][n] = bias ? *(const f32x4*)(bias + bcol0 + bj * HALF + 4 * n) : (f32x4){0.f, 0.f, 0.f, 0.f};
#pragma unroll
        for (int ai = 0; ai < 2; ++ai)
#pragma unroll
            for (int m = 0; m < 4; ++m) { bf16_t* rowp = base + (size_t)(row0 + ai * HALF + m * 16) * ldc + col0;
#pragma unroll
                for (int bj = 0; bj < 2; ++bj) { f32x4 v0 = acc[ai][bj][m][0] + bv[bj][0], v1 = acc[ai][bj][m][1] + bv[bj][1];
                    if (ACT == 1) { f32x2 a = gelu_pk((f32x2){v0[0], v0[1]}), b = gelu_pk((f32x2){v0[2], v0[3]}), c = gelu_pk((f32x2){v1[0], v1[1]}), d = gelu_pk((f32x2){v1[2], v1[3]});
                        v0 = (f32x4){a.x, a.y, b.x, b.y}; v1 = (f32x4){c.x, c.y, d.x, d.y}; }
                    if (ACT == 2) {
#pragma unroll
                        for (int j = 0; j < 4; ++j) { v0[j] = 0.5f * v0[j] * (1.0f + erff(v0[j] * 0.70710678f)); v1[j] = 0.5f * v1[j] * (1.0f + erff(v1[j] * 0.70710678f)); } }
                    u32x4 w; w.x = cvt_pk_bf16(v0[0], v0[1]); w.y = cvt_pk_bf16(v0[2], v0[3]); w.z = cvt_pk_bf16(v1[0], v1[1]); w.w = cvt_pk_bf16(v1[2], v1[3]);
                    *(u32x4*)(rowp + bj * HALF) = w; } }
    }
};
#ifndef EPI_PREFETCH
#define EPI_PREFETCH false
#endif
#ifndef EPI_PF_TILES
#define EPI_PF_TILES 16
#endif
__device__ __forceinline__ float silu_f(float g) { return g * __builtin_amdgcn_rcpf(1.0f + __expf(-g)); }
__device__ __forceinline__ float gelu_tanh_f(float x) { const float y = 0.7978845608028654f * (x + 0.044715f * x * x * x); const float e = __expf(2.0f * y); const float t = 1.0f - 2.0f * __builtin_amdgcn_rcpf(e + 1.0f); return 0.5f * x * (1.0f + t); }
template <int ACT> struct EpiB {
    static constexpr bool PERM = true, AFTER_DRAIN = false, PREFETCH = false;
    bf16_t* O; int ldc;
    __device__ __forceinline__ void operator()(const f32x4 (&acc)[2][2][4][2], const Unit& u, int wr, int wc, int fr, int fq) const {
        const int row0 = u.pm * BM + wr * 64 + fr, col0 = u.pn * BM + wc * 32 + 8 * fq;
        float one = 1.0f; asm volatile("" : "+v"(one));
#pragma unroll
        for (int ai = 0; ai < 2; ++ai)
#pragma unroll
            for (int m = 0; m < 4; ++m) { bf16_t* rowp = O + (size_t)(row0 + ai * HALF + m * 16) * ldc + col0;
#pragma unroll
                for (int bj = 0; bj < 2; ++bj) { f32x4 v0 = acc[ai][bj][m][0] * one, v1 = acc[ai][bj][m][1] * one;
                    if (ACT == 1) {
#pragma unroll
                        for (int j = 0; j < 4; ++j) { v0[j] = gelu_tanh_f(v0[j]); v1[j] = gelu_tanh_f(v1[j]); } }
                    u32x4 w; w.x = cvt_pk_bf16(v0[0], v0[1]); w.y = cvt_pk_bf16(v0[2], v0[3]); w.z = cvt_pk_bf16(v1[0], v1[1]); w.w = cvt_pk_bf16(v1[2], v1[3]);
                    *(u32x4*)(rowp + bj * HALF) = w; } }
    }
};
struct EpiProj {
    static constexpr bool PERM = true, AFTER_DRAIN = false, PREFETCH = false;
    bf16_t* O; int ldc; float* gates; int gate_pn;
    __device__ __forceinline__ void operator()(const f32x4 (&acc)[2][2][4][2], const Unit& u, int wr, int wc, int fr, int fq) const {
        const int row0 = u.pm * BM + wr * 64 + fr, col0 = u.pn * BM + wc * 32 + 8 * fq;
        float one = 1.0f; asm volatile("" : "+v"(one));
#pragma unroll
        for (int ai = 0; ai < 2; ++ai)
#pragma unroll
            for (int m = 0; m < 4; ++m) { bf16_t* rowp = O + (size_t)(row0 + ai * HALF + m * 16) * ldc + col0;
#pragma unroll
                for (int bj = 0; bj < 2; ++bj) { const f32x4 v0 = acc[ai][bj][m][0] * one, v1 = acc[ai][bj][m][1] * one;
                    u32x4 w; w.x = cvt_pk_bf16(v0[0], v0[1]); w.y = cvt_pk_bf16(v0[2], v0[3]); w.z = cvt_pk_bf16(v1[0], v1[1]); w.w = cvt_pk_bf16(v1[2], v1[3]);
                    *(u32x4*)(rowp + bj * HALF) = w; } }
        if (u.pn == gate_pn && wc == 0 && fq == 0) {
#pragma unroll
            for (int ai = 0; ai < 2; ++ai)
#pragma unroll
                for (int m = 0; m < 4; ++m) { float* g = gates + (size_t)(row0 + ai * HALF + m * 16) * 8;
                    *(f32x4*)g = acc[ai][0][m][0]; *(f32x4*)(g + 4) = acc[ai][0][m][1]; }
        }
    }
};
struct EpiSwiGLU {
    static constexpr bool PERM = true, AFTER_DRAIN = false, PREFETCH = false;
    bf16_t* H; int ldh;
    __device__ __forceinline__ void operator()(const f32x4 (&acc)[2][2][4][2], const Unit& u, int wr, int wc, int fr, int fq) const {
        const int row0 = u.pm * BM + wr * 64 + fr, col0 = u.pn * HALF + wc * 32 + 8 * fq;
#pragma unroll
        for (int ai = 0; ai < 2; ++ai)
#pragma unroll
            for (int m = 0; m < 4; ++m) { bf16_t* rowp = H + (size_t)(row0 + ai * HALF + m * 16) * ldh + col0;
                const f32x4 g0 = acc[ai][0][m][0], g1 = acc[ai][0][m][1], u0 = acc[ai][1][m][0], u1 = acc[ai][1][m][1];
                float h[8];
#pragma unroll
                for (int j = 0; j < 4; ++j) { h[j] = silu_f(g0[j]) * u0[j]; h[4 + j] = silu_f(g1[j]) * u1[j]; }
                u32x4 w; w.x = cvt_pk_bf16(h[0], h[1]); w.y = cvt_pk_bf16(h[2], h[3]); w.z = cvt_pk_bf16(h[4], h[5]); w.w = cvt_pk_bf16(h[6], h[7]);
                *(u32x4*)rowp = w; }
    }
};
struct EpiResid {
    static constexpr bool PERM = false, AFTER_DRAIN = false, PREFETCH = false;
    float* C; const float* R; int ldc; float alpha;
    __device__ __forceinline__ void operator()(const f32x4 (&acc)[2][2][4][2], const Unit& u, int wr, int wc, int fr, int fq) const {
        const int row0 = u.pm * BM + wr * 64 + fr, col0 = u.pn * BM + wc * 32 + 4 * fq;
#pragma unroll
        for (int ai = 0; ai < 2; ++ai) {
            f32x4 r[4][2][2];
#pragma unroll
            for (int m = 0; m < 4; ++m) { const size_t off = (size_t)(row0 + ai * HALF + m * 16) * ldc + col0;
#pragma unroll
                for (int bj = 0; bj < 2; ++bj)
#pragma unroll
                    for (int n = 0; n < 2; ++n) r[m][bj][n] = *(const f32x4*)(R + off + bj * HALF + n * 16); }
            asm volatile("" ::: "memory");
#pragma unroll
            for (int m = 0; m < 4; ++m) { const size_t off = (size_t)(row0 + ai * HALF + m * 16) * ldc + col0;
#pragma unroll
                for (int bj = 0; bj < 2; ++bj)
#pragma unroll
                    for (int n = 0; n < 2; ++n) *(f32x4*)(C + off + bj * HALF + n * 16) = acc[ai][bj][m][n] + alpha * r[m][bj][n]; }
            asm volatile("" ::: "memory");
        }
    }
};
struct EpiResidLN {
    static constexpr bool PERM = false, AFTER_DRAIN = false, PREFETCH = false;
    float* C; const float* Zp; const f32x2* st; const float* g; const float* b; int ldc; float alpha;
    __device__ __forceinline__ void operator()(const f32x4 (&acc)[2][2][4][2], const Unit& u, int wr, int wc, int fr, int fq) const {
        const int row0 = u.pm * BM + wr * 64 + fr, col0 = u.pn * BM + wc * 32 + 4 * fq;
#pragma unroll
        for (int bj = 0; bj < 2; ++bj)
#pragma unroll
            for (int n = 0; n < 2; ++n) {
                const int cc = col0 + bj * HALF + n * 16;
                const f32x4 gv = *(const f32x4*)(g + cc) * alpha, bv = *(const f32x4*)(b + cc) * alpha;
                f32x4 r[2][4]; f32x2 ms[2][4];
#pragma unroll
                for (int ai = 0; ai < 2; ++ai)
#pragma unroll
                    for (int m = 0; m < 4; ++m) { const int row = row0 + ai * HALF + m * 16; ms[ai][m] = st[row]; r[ai][m] = *(const f32x4*)(Zp + (size_t)row * ldc + cc); }
                asm volatile("" ::: "memory");
#pragma unroll
                for (int ai = 0; ai < 2; ++ai)
#pragma unroll
                    for (int m = 0; m < 4; ++m) { const int row = row0 + ai * HALF + m * 16;
                        *(f32x4*)(C + (size_t)row * ldc + cc) = acc[ai][bj][m][n] + ((r[ai][m] - ms[ai][m].x) * ms[ai][m].y) * gv + bv; }
                asm volatile("" ::: "memory");
            }
    }
};
struct EpiResidB {
    static constexpr bool PERM = true, AFTER_DRAIN = false, PREFETCH = EPI_PREFETCH;
    bf16_t* C; const bf16_t* R;
    __device__ __forceinline__ void prefetch(const Unit& u, PG8_LAS unsigned char* dummy, int wid, int lane) const {
#pragma unroll
        for (int i = 0; i < 2; ++i) { const int L = wid * 128 + i * 64 + lane;
            __builtin_amdgcn_global_load_lds((const unsigned*)((const char*)R + (unsigned)((u.pm * BM + (L >> 2)) * DM + u.pn * BM + (L & 3) * 64) * 2u), (PG8_LAS unsigned*)dummy, 4, 0, 0); }
    }
    __device__ __forceinline__ void operator()(const f32x4 (&acc)[2][2][4][2], const Unit& u, int wr, int wc, int fr, int fq) const {
        const int row0 = u.pm * BM + wr * 64 + fr, col0 = u.pn * BM + wc * 32 + 8 * fq;
#pragma unroll
        for (int ai = 0; ai < 2; ++ai) {
            bf16x8 r[4][2];
#pragma unroll
            for (int m = 0; m < 4; ++m)
#pragma unroll
                for (int bj = 0; bj < 2; ++bj) r[m][bj] = *(const bf16x8*)((const char*)R + (unsigned)((row0 + ai * HALF + m * 16) * DM + col0 + bj * HALF) * 2u);
            asm volatile("" ::: "memory");
#pragma unroll
            for (int m = 0; m < 4; ++m)
#pragma unroll
                for (int bj = 0; bj < 2; ++bj) { float x[8]; unpack8(r[m][bj], x);
                    const f32x4 a0 = acc[ai][bj][m][0], a1 = acc[ai][bj][m][1];
                    float v[8];
#pragma unroll
                    for (int j = 0; j < 4; ++j) { v[j] = a0[j] + DN_ALPHA * x[j]; v[4 + j] = a1[j] + DN_ALPHA * x[4 + j]; }
                    *(bf16x8*)((char*)C + (unsigned)((row0 + ai * HALF + m * 16) * DM + col0 + bj * HALF) * 2u) = pack8h(v); }
            asm volatile("" ::: "memory");
        }
    }
};
struct EpiResidLNB {
    static constexpr bool PERM = true, AFTER_DRAIN = false, PREFETCH = EPI_PREFETCH;
    bf16_t* C; const bf16_t* Zp; const f32x2* st; const float* g; const float* b;
    __device__ __forceinline__ void prefetch(const Unit& u, PG8_LAS unsigned char* dummy, int wid, int lane) const {
#pragma unroll
        for (int i = 0; i < 2; ++i) { const int L = wid * 128 + i * 64 + lane;
            __builtin_amdgcn_global_load_lds((const unsigned*)((const char*)Zp + (unsigned)((u.pm * BM + (L >> 2)) * DM + u.pn * BM + (L & 3) * 64) * 2u), (PG8_LAS unsigned*)dummy, 4, 0, 0); }
    }
    __device__ __forceinline__ void operator()(const f32x4 (&acc)[2][2][4][2], const Unit& u, int wr, int wc, int fr, int fq) const {
        const int row0 = u.pm * BM + wr * 64 + fr, col0 = u.pn * BM + wc * 32 + 8 * fq;
#pragma unroll
        for (int bj = 0; bj < 2; ++bj) {
            const int cc = col0 + bj * HALF;
            const f32x4 g0 = *(const f32x4*)(g + cc) * DN_ALPHA, g1 = *(const f32x4*)(g + cc + 4) * DN_ALPHA, b0 = *(const f32x4*)(b + cc) * DN_ALPHA, b1 = *(const f32x4*)(b + cc + 4) * DN_ALPHA;
            bf16x8 r[2][4]; f32x2 ms[2][4];
#pragma unroll
            for (int ai = 0; ai < 2; ++ai)
#pragma unroll
                for (int m = 0; m < 4; ++m) { const int row = row0 + ai * HALF + m * 16; ms[ai][m] = *(const f32x2*)((const char*)st + (unsigned)row * 8u); r[ai][m] = *(const bf16x8*)((const char*)Zp + (unsigned)(row * DM + cc) * 2u); }
            asm volatile("" ::: "memory");
#pragma unroll
            for (int ai = 0; ai < 2; ++ai)
#pragma unroll
                for (int m = 0; m < 4; ++m) { const int row = row0 + ai * HALF + m * 16; float x[8]; unpack8h(r[ai][m], x);
                    const f32x4 a0 = acc[ai][bj][m][0], a1 = acc[ai][bj][m][1]; const float mu = ms[ai][m].x, rs = ms[ai][m].y;
                    float v[8];
#pragma unroll
                    for (int j = 0; j < 4; ++j) { v[j] = a0[j] + (((x[j] - mu) * rs) * g0[j] + b0[j]); v[4 + j] = a1[j] + (((x[4 + j] - mu) * rs) * g1[j] + b1[j]); }
                    *(bf16x8*)((char*)C + (unsigned)(row * DM + cc) * 2u) = pack8h(v); __builtin_amdgcn_sched_barrier(0); }
            asm volatile("" ::: "memory");
        }
    }
};
template <class Epi, class Sched, bool ALIGN_EPI = false, bool SP2 = false>
__device__ __forceinline__ void gemm_phase(PG8_LAS unsigned char* lds, const Gemm g, const Sched& S, const Epi& E) {
    const int tid = threadIdx.x, wid = __builtin_amdgcn_readfirstlane(tid >> 6), lane = tid & 63, wr = wid >> 2, wc = wid & 3, fr = lane & 15, fq = lane >> 4;
    const int K = g.K, nt = K / BK;
    unsigned voffA[2], voffB[2];
#pragma unroll
    for (int i = 0; i < 2; ++i) { int R, C; stage_rc(tid * 16 + i * 8192, R, C); const int Rb = Epi::PERM ? ((R & ~31) + perm32(R & 31)) : R;
        voffA[i] = (unsigned)(R * K + C) * 2u; voffB[i] = (unsigned)(Rb * K + C) * 2u; }
    const size_t kstep = (size_t)(BK * 2);
    const size_t hstep = (size_t)HALF * K * 2;
    const size_t tstep = 2 * hstep;
    const unsigned ldsw = (unsigned)wid * 1024u;
    const int aoff = lds_byte(wr * 64 + fr, fq * 8), boff = lds_byte(wc * 32 + fr, fq * 8);
#define PG8_SA(b, h) (((b) * 2 + (h)) * HTB)
#define PG8_SB(b, h) ((4 + (b) * 2 + (h)) * HTB)
#define PG8_STAGE(bufoff, gbase, voff) do { _Pragma("unroll") for (int _i = 0; _i < 2; ++_i) \
        __builtin_amdgcn_global_load_lds((const unsigned*)((const char*)(gbase) + (voff)[_i]), (PG8_LAS unsigned*)(lds + (bufoff) + ldsw + _i * 8192), 16, 0, 0); } while (0)
#define PG8_LDA(dst, b, h) do { _Pragma("unroll") for (int m = 0; m < 4; ++m) _Pragma("unroll") for (int k = 0; k < 2; ++k) dst[m][k] = *(const PG8_LAS bf16x8*)(lds + PG8_SA(b, h) + aoff + m * 2048 + k * 1024); } while (0)
#define PG8_LDB(dst, b, h) do { _Pragma("unroll") for (int n = 0; n < 2; ++n) _Pragma("unroll") for (int k = 0; k < 2; ++k) dst[n][k] = *(const PG8_LAS bf16x8*)(lds + PG8_SB(b, h) + boff + n * 2048 + k * 1024); } while (0)
#define PG8_MMA(ai, bj, At, Bt) do { __builtin_amdgcn_s_setprio(1); _Pragma("unroll") for (int m = 0; m < 4; ++m) _Pragma("unroll") for (int n = 0; n < 2; ++n) _Pragma("unroll") for (int k = 0; k < 2; ++k) \
        acc[ai][bj][m][n] = __builtin_amdgcn_mfma_f32_16x16x32_bf16(Bt[n][k], At[m][k], acc[ai][bj][m][n], 0, 0, 0); __builtin_amdgcn_s_setprio(0); } while (0)
#define PG8_WAIT_V(n) asm volatile("s_waitcnt vmcnt(" #n ")" ::: "memory")
#define PG8_WAIT_L(n) asm volatile("s_waitcnt lgkmcnt(" #n ")" ::: "memory")
#define PG8_BAR __builtin_amdgcn_s_barrier()
#define PG8_SCHED __builtin_amdgcn_sched_barrier(0)
    Unit cur, nxt; int ui = 0;
    if (!S.next(0, cur)) return;
    f32x4 acc[2][2][4][2];
#pragma unroll
    for (int a = 0; a < 2; ++a)
#pragma unroll
        for (int b = 0; b < 2; ++b)
#pragma unroll
            for (int m = 0; m < 4; ++m)
#pragma unroll
                for (int n = 0; n < 2; ++n) acc[a][b][m][n] = (f32x4){0.f, 0.f, 0.f, 0.f};
    bf16x8 At[4][2], B0[2][2], B1[2][2];
    const char* cA = (const char*)g.A + (size_t)cur.pm * tstep; const char* cB = (const char*)g.Bt + (size_t)cur.pn * tstep;
    S.a_ready(cur);
    if constexpr (SP2) {
        PG8_STAGE(PG8_SB(0, 0), cB, voffB); PG8_STAGE(PG8_SB(0, 1), cB + hstep, voffB); PG8_STAGE(PG8_SA(0, 0), cA, voffA); PG8_STAGE(PG8_SA(0, 1), cA + hstep, voffA);
        if (wr == 1) PG8_BAR;
        PG8_WAIT_V(2); PG8_BAR;
        PG8_STAGE(PG8_SB(1, 0), cB + kstep, voffB); PG8_STAGE(PG8_SA(1, 0), cA + kstep, voffA); PG8_STAGE(PG8_SB(1, 1), cB + hstep + kstep, voffB);
        PG8_WAIT_V(6); PG8_BAR;
    } else {
        PG8_STAGE(PG8_SB(0, 0), cB, voffB); PG8_STAGE(PG8_SA(0, 0), cA, voffA); PG8_STAGE(PG8_SB(0, 1), cB + hstep, voffB); PG8_STAGE(PG8_SA(0, 1), cA + hstep, voffA);
        if (wr == 1) PG8_BAR;
        PG8_WAIT_V(4); PG8_BAR;
        PG8_STAGE(PG8_SB(1, 0), cB + kstep, voffB); PG8_STAGE(PG8_SA(1, 0), cA + kstep, voffA); PG8_STAGE(PG8_SB(1, 1), cB + hstep + kstep, voffB);
        PG8_WAIT_V(6); PG8_BAR;
    }
    for (;;) {
        const bool has_next = S.next(ui + 1, nxt);
        const char* nA = has_next ? (const char*)g.A + (size_t)nxt.pm * tstep : cA; const char* nB = has_next ? (const char*)g.Bt + (size_t)nxt.pn * tstep : cB;
        for (int t = 0; t < nt; t += 2) {
            const bool last = (t == nt - 2);
            const char* a1 = cA + (size_t)(t + 1) * kstep;
            const char* a2 = last ? nA : cA + (size_t)(t + 2) * kstep; const char* b2 = last ? nB : cB + (size_t)(t + 2) * kstep;
            const char* a3 = a2 + kstep; const char* b3 = b2 + kstep;
            if (last && has_next) S.a_ready(nxt);
            if constexpr (Epi::PREFETCH) { if (t == nt - EPI_PF_TILES) E.prefetch(cur, lds + STAGE_BYTES + wid * 256, wid, lane); }
            if constexpr (SP2) {
            PG8_LDB(B0, 0, 0); PG8_LDB(B1, 0, 1); PG8_SCHED; PG8_LDA(At, 0, 0); PG8_STAGE(PG8_SA(1, 1), a1 + hstep, voffA);
            PG8_WAIT_V(8); PG8_WAIT_L(0); PG8_BAR; PG8_MMA(0, 0, At, B0); PG8_MMA(0, 1, At, B1); PG8_BAR; PG8_SCHED;
            PG8_LDA(At, 0, 1); PG8_STAGE(PG8_SB(0, 0), b2, voffB); PG8_STAGE(PG8_SB(0, 1), b2 + hstep, voffB); PG8_STAGE(PG8_SA(0, 0), a2, voffA);
            PG8_WAIT_V(8); PG8_WAIT_L(0); PG8_BAR; PG8_MMA(1, 0, At, B0); PG8_MMA(1, 1, At, B1); PG8_BAR; PG8_SCHED;
            PG8_LDB(B0, 1, 0); PG8_LDB(B1, 1, 1); PG8_SCHED; PG8_LDA(At, 1, 0); PG8_STAGE(PG8_SA(0, 1), a2 + hstep, voffA);
            PG8_WAIT_V(8); PG8_WAIT_L(0); PG8_BAR; PG8_MMA(0, 0, At, B0); PG8_MMA(0, 1, At, B1); PG8_BAR; PG8_SCHED;
            PG8_LDA(At, 1, 1); PG8_STAGE(PG8_SB(1, 0), b3, voffB); PG8_STAGE(PG8_SB(1, 1), b3 + hstep, voffB); PG8_STAGE(PG8_SA(1, 0), a3, voffA);
            PG8_WAIT_V(8); PG8_WAIT_L(0); PG8_BAR; PG8_MMA(1, 0, At, B0); PG8_MMA(1, 1, At, B1); PG8_BAR; PG8_SCHED;
            } else {
            PG8_LDB(B0, 0, 0); PG8_SCHED; PG8_LDA(At, 0, 0); PG8_STAGE(PG8_SA(1, 1), a1 + hstep, voffA);
            PG8_WAIT_L(8); PG8_BAR; PG8_WAIT_L(0); PG8_MMA(0, 0, At, B0); PG8_BAR; PG8_SCHED;
            PG8_LDB(B1, 0, 1); PG8_STAGE(PG8_SB(0, 0), b2, voffB);
            PG8_BAR; PG8_WAIT_L(0); PG8_MMA(0, 1, At, B1); PG8_BAR;
            PG8_LDA(At, 0, 1); PG8_STAGE(PG8_SA(0, 0), a2, voffA);
            PG8_BAR; PG8_WAIT_L(0); PG8_MMA(1, 0, At, B0); PG8_BAR; PG8_SCHED;
            PG8_STAGE(PG8_SB(0, 1), b2 + hstep, voffB);
            PG8_WAIT_V(6); PG8_BAR; PG8_MMA(1, 1, At, B1); PG8_BAR;
            PG8_LDB(B0, 1, 0); PG8_SCHED; PG8_LDA(At, 1, 0); PG8_STAGE(PG8_SA(0, 1), a2 + hstep, voffA);
            PG8_WAIT_L(8); PG8_BAR; PG8_WAIT_L(0); PG8_MMA(0, 0, At, B0); PG8_BAR; PG8_SCHED;
            PG8_LDB(B1, 1, 1); PG8_STAGE(PG8_SB(1, 0), b3, voffB);
            PG8_BAR; PG8_WAIT_L(0); PG8_MMA(0, 1, At, B1); PG8_BAR;
            PG8_LDA(At, 1, 1); PG8_STAGE(PG8_SA(1, 0), a3, voffA);
            PG8_BAR; PG8_WAIT_L(0); PG8_MMA(1, 0, At, B0); PG8_BAR; PG8_SCHED;
            PG8_STAGE(PG8_SB(1, 1), b3 + hstep, voffB);
            PG8_WAIT_V(6); PG8_BAR; PG8_MMA(1, 1, At, B1); PG8_BAR;
            }
        }
        if constexpr (ALIGN_EPI) { if (wr == 0) PG8_BAR; }
        if constexpr (!Epi::AFTER_DRAIN) { E(acc, cur, wr, wc, fr, fq); S.done(cur); }
        if (!has_next) break;
#pragma unroll
        for (int a = 0; a < 2; ++a)
#pragma unroll
            for (int b = 0; b < 2; ++b)
#pragma unroll
                for (int m = 0; m < 4; ++m)
#pragma unroll
                    for (int n = 0; n < 2; ++n) acc[a][b][m][n] = (f32x4){0.f, 0.f, 0.f, 0.f};
        cur = nxt; cA = nA; cB = nB; ++ui;
        if constexpr (ALIGN_EPI) { if (wr == 1) PG8_BAR; }
    }
    PG8_WAIT_V(0);
    if constexpr (!ALIGN_EPI) { if (wr == 0) PG8_BAR; }
    PG8_BAR;
    if constexpr (Epi::AFTER_DRAIN) { E.fused(acc, cur, wr, wc, fr, fq, lds, wid, lane); S.done(cur); }
#undef PG8_SA
#undef PG8_SB
#undef PG8_STAGE
#undef PG8_LDA
#undef PG8_LDB
#undef PG8_MMA
#undef PG8_WAIT_V
#undef PG8_WAIT_L
#undef PG8_BAR
#undef PG8_SCHED
}
}
namespace fa {
constexpr int KVBLK = 64, SHM_V = 16384, SHM_K = 16384, SHM_KR = 8192;
constexpr int OFF_V = 0, OFF_K = 2 * SHM_V, OFF_KR = OFF_K + 2 * SHM_K, OFF_WS = OFF_KR + 2 * SHM_KR, OFF_IMP = OFF_WS + 8 * 64 * 4, IMP_LD = 257, OFF_QPARK = OFF_IMP + 32 * IMP_LD * 4 + 128  , LDS_END = OFF_QPARK + 8 * 4096;
#define KSWZ(row, colB) ((row) * 256 + ((colB) ^ (((row) & 7) << 4)))
#define KSWZ16(row, colB) ((row) * 256 + ((colB) ^ (((row) & 15) << 4)))
#define SBAR() __builtin_amdgcn_sched_barrier(0)
__device__ __forceinline__ int v_st(int k, int c) { const int kk = (k & ~0xC) | ((k & 4) << 1) | ((k & 8) >> 1); return ((kk >> 3) * 4 + (c >> 5)) * 512 + ((kk & 7) * 32 + (c & 31)) * 2; }
__device__ __forceinline__ int v_rd_base(int lane) { return ((lane & 3) << 3) | (((lane >> 2) & 3) << 6) | (((lane >> 4) & 1) << 5) | (((lane >> 5) & 1) << 8); }
constexpr int v_rd_off(int d0, int ks, int half) { return d0 * 512 + ks * 4096 + half * 2048; }
__device__ __forceinline__ int crow(int r, int hi) { return (r & 3) + 8 * (r >> 2) + 4 * hi; }
__device__ __forceinline__ unsigned cvtpk(float lo, float hi) { unsigned r; asm volatile("v_cvt_pk_bf16_f32 %0, %1, %2" : "=v"(r) : "v"(lo), "v"(hi)); return r; }
__device__ __forceinline__ bf16x8 pack8(f32x4 a, f32x4 b) { u32x4 w = {cvtpk(a[0], a[1]), cvtpk(a[2], a[3]), cvtpk(b[0], b[1]), cvtpk(b[2], b[3])}; return *reinterpret_cast<bf16x8*>(&w); }
__device__ __forceinline__ void mask_tile(f32x16& p0, f32x16& p1, int dq, unsigned W) {
    const float NEG = -__builtin_inff();
#pragma unroll
    for (int r = 0; r < 16; ++r) {
        const int c = (r & 3) + 8 * (r >> 2);
        if ((unsigned)(dq - c) >= W) p0[r] = NEG;
        if ((unsigned)(dq - c - 32) >= W) p1[r] = NEG;
    }
}
__device__ __forceinline__ void mask_all(f32x16& p0, f32x16& p1, bool kill) {
    const float NEG = -__builtin_inff();
#pragma unroll
    for (int r = 0; r < 16; ++r) { if (kill) { p0[r] = NEG; p1[r] = NEG; } }
}
__device__ __forceinline__ void partialSM(f32x16& p0, f32x16& p1, float& m_reg, float& mn, float& alpha, float scale, float C2, bool kill = false) {
    float pmax = p0[0];
#pragma unroll
    for (int r = 1; r < 16; ++r) pmax = fmaxf(pmax, p0[r]);
#pragma unroll
    for (int r = 0; r < 16; ++r) pmax = fmaxf(pmax, p1[r]);
    { auto rr = __builtin_amdgcn_permlane32_swap(__float_as_uint(pmax), __float_as_uint(pmax), false, false);
      pmax = fmaxf(__uint_as_float(rr[0]), __uint_as_float(rr[1])); }
    if (__builtin_expect(__all((pmax - m_reg) * scale <= 8.0f), 1)) { mn = m_reg; alpha = 1.f; }
    else { mn = fmaxf(m_reg, pmax); alpha = __builtin_amdgcn_exp2f((m_reg - mn) * C2); m_reg = mn; }
    const float mnL = kill ? -__builtin_inff() : -mn * C2;
#pragma unroll
    for (int r = 0; r < 16; ++r) p0[r] = fmaf(p0[r], C2, mnL);
#pragma unroll
    for (int r = 0; r < 16; ++r) p1[r] = fmaf(p1[r], C2, mnL);
#pragma unroll
    for (int r = 0; r < 16; ++r) p0[r] = __builtin_amdgcn_exp2f(p0[r]);
}
__device__ __forceinline__ void finishSM(f32x16& p0, f32x16& p1, float alpha, float& l_reg, bf16x8& pa0, bf16x8& pa1, bf16x8& pa2, bf16x8& pa3) {
#pragma unroll
    for (int r = 0; r < 16; ++r) p1[r] = __builtin_amdgcn_exp2f(p1[r]);
    float ps = 0;
#pragma unroll
    for (int r = 0; r < 16; ++r) ps += p0[r];
#pragma unroll
    for (int r = 0; r < 16; ++r) ps += p1[r];
    { auto rr = __builtin_amdgcn_permlane32_swap(__float_as_uint(ps), __float_as_uint(ps), false, false);
      ps = __uint_as_float(rr[0]) + __uint_as_float(rr[1]); }
    l_reg = l_reg * alpha + ps;
#define PK4(P, B_, OUT) do { unsigned a0 = cvtpk(P[B_+0], P[B_+1]), a1 = cvtpk(P[B_+2], P[B_+3]);                          \
        unsigned b0 = cvtpk(P[B_+4], P[B_+5]), b1 = cvtpk(P[B_+6], P[B_+7]);                                             \
        auto r0 = __builtin_amdgcn_permlane32_swap(a0, b0, false, false); auto r1 = __builtin_amdgcn_permlane32_swap(a1, b1, false, false); \
        u32x4 w = {r0[0], r1[0], r0[1], r1[1]}; OUT = *reinterpret_cast<bf16x8*>(&w); } while (0)
    PK4(p0, 0, pa0); PK4(p0, 8, pa1); PK4(p1, 0, pa2); PK4(p1, 8, pa3);
#undef PK4
}
template <int KB, bool ROPE, bool LIGHT = false>
__device__ __forceinline__ void qkt(f32x16& p0, f32x16& p1, const char* lds, int r32, int hi, const bf16x8* qr, const char* qpark = nullptr) {
    p0 = f32x16{}; p1 = f32x16{};
    const char* K_lds = lds + OFF_K;
    const char* kb[4];
#pragma unroll
    for (int dd = 0; dd < 4; ++dd) kb[dd] = K_lds + KB * SHM_K + KSWZ(r32, (dd * 16 + hi * 8) * 2);
    bf16x8 f[4][4];
#define QK_LD(g) do { const char* a0_ = kb[(2 * (g)) & 3] + ((2 * (g)) >> 2) * 128; const char* a1_ = kb[(2 * (g) + 1) & 3] + ((2 * (g) + 1) >> 2) * 128; \
        f[(g) & 3][0] = *reinterpret_cast<const bf16x8*>(a0_); f[(g) & 3][1] = *reinterpret_cast<const bf16x8*>(a0_ + 32 * 256); \
        f[(g) & 3][2] = *reinterpret_cast<const bf16x8*>(a1_); f[(g) & 3][3] = *reinterpret_cast<const bf16x8*>(a1_ + 32 * 256); } while (0)
#define QK_MM(g) do { p0 = __builtin_amdgcn_mfma_f32_32x32x16_bf16(f[(g) & 3][0], qr[2 * (g)], p0, 0, 0, 0); p1 = __builtin_amdgcn_mfma_f32_32x32x16_bf16(f[(g) & 3][1], qr[2 * (g)], p1, 0, 0, 0); \
        p0 = __builtin_amdgcn_mfma_f32_32x32x16_bf16(f[(g) & 3][2], qr[2 * (g) + 1], p0, 0, 0, 0); p1 = __builtin_amdgcn_mfma_f32_32x32x16_bf16(f[(g) & 3][3], qr[2 * (g) + 1], p1, 0, 0, 0); } while (0)
    if constexpr (ROPE) {
        QK_LD(0); SBAR();
        QK_LD(1); SBAR(); QK_MM(0); SBAR();
        QK_LD(2); SBAR(); QK_MM(1); SBAR();
        QK_LD(3); SBAR(); QK_MM(2); SBAR();
        const char* KR_lds = lds + OFF_KR + KB * SHM_KR + r32 * 128;
        bf16x8 ra[2], rb[2], qa, qb_;
#define QR_LD(d0, R, Q) do { const char* a = KR_lds + (((d0) * 32 + hi * 16) ^ ((r32 & 7) << 4)); R[0] = *reinterpret_cast<const bf16x8*>(a); R[1] = *reinterpret_cast<const bf16x8*>(a + 32 * 128); Q = *reinterpret_cast<const bf16x8*>(qpark + (d0) * 1024); } while (0)
#define QR_MM(R, Q) do { p0 = __builtin_amdgcn_mfma_f32_32x32x16_bf16(R[0], Q, p0, 0, 0, 0); p1 = __builtin_amdgcn_mfma_f32_32x32x16_bf16(R[1], Q, p1, 0, 0, 0); } while (0)
        QR_LD(0, ra, qa); SBAR(); QK_MM(3); SBAR();
        QR_LD(1, rb, qb_); SBAR(); QR_MM(ra, qa); SBAR();
        QR_LD(2, ra, qa); SBAR(); QR_MM(rb, qb_); SBAR();
        QR_LD(3, rb, qb_); SBAR(); QR_MM(ra, qa); SBAR();
        QR_MM(rb, qb_);
#undef QR_LD
#undef QR_MM
    } else if constexpr (LIGHT) {
        QK_LD(0); SBAR();
        QK_LD(1); SBAR(); QK_MM(0); SBAR();
        QK_LD(2); SBAR(); QK_MM(1); SBAR();
        QK_LD(3); SBAR(); QK_MM(2); SBAR();
        QK_MM(3);
    } else {
        QK_LD(0); QK_LD(1); SBAR();
        QK_LD(2); SBAR(); QK_MM(0); SBAR();
        QK_LD(3); SBAR(); QK_MM(1); SBAR();
        QK_MM(2); QK_MM(3);
    }
#undef QK_LD
#undef QK_MM
}
template <int VB, bool PIPE>
__device__ __forceinline__ void pv_tile(f32x16* o, int vb0, bf16x8 pa0, bf16x8 pa1, bf16x8 pa2, bf16x8 pa3) {
#define TRRD(dst, off) asm volatile("ds_read_b64_tr_b16 %0, %1 offset:%2" : "=&v"(dst) : "v"(vb0), "i"(off) : "memory")
#define PV_LD(S, d0) do { constexpr int b_ = OFF_V + VB * SHM_V + v_rd_off(d0, 0, 0); TRRD(S[0], b_); TRRD(S[1], b_ + 2048); TRRD(S[2], b_ + 4096); TRRD(S[3], b_ + 6144); TRRD(S[4], b_ + 8192); TRRD(S[5], b_ + 10240); TRRD(S[6], b_ + 12288); TRRD(S[7], b_ + 14336); } while (0)
#define PV_MM(S, d0) do { \
        o[d0] = __builtin_amdgcn_mfma_f32_32x32x16_bf16(pa0, (bf16x8){S[0][0], S[0][1], S[0][2], S[0][3], S[1][0], S[1][1], S[1][2], S[1][3]}, o[d0], 0, 0, 0);   \
        o[d0] = __builtin_amdgcn_mfma_f32_32x32x16_bf16(pa1, (bf16x8){S[2][0], S[2][1], S[2][2], S[2][3], S[3][0], S[3][1], S[3][2], S[3][3]}, o[d0], 0, 0, 0);   \
        o[d0] = __builtin_amdgcn_mfma_f32_32x32x16_bf16(pa2, (bf16x8){S[4][0], S[4][1], S[4][2], S[4][3], S[5][0], S[5][1], S[5][2], S[5][3]}, o[d0], 0, 0, 0);   \
        o[d0] = __builtin_amdgcn_mfma_f32_32x32x16_bf16(pa3, (bf16x8){S[6][0], S[6][1], S[6][2], S[6][3], S[7][0], S[7][1], S[7][2], S[7][3]}, o[d0], 0, 0, 0); } while (0)
#define PV_W(n) do { asm volatile("s_waitcnt lgkmcnt(" #n ")" ::: "memory"); SBAR(); } while (0)
    if constexpr (PIPE) {
        s16x4 A[8], B[8];
        PV_LD(A, 0); PV_LD(B, 1); PV_W(8); PV_MM(A, 0);
        PV_LD(A, 2); PV_W(8); PV_MM(B, 1);
        PV_LD(B, 3); PV_W(8); PV_MM(A, 2);
        PV_W(0); PV_MM(B, 3);
    } else {
        s16x4 A[8];
        PV_LD(A, 0); PV_W(0); PV_MM(A, 0); PV_LD(A, 1); PV_W(0); PV_MM(A, 1); PV_LD(A, 2); PV_W(0); PV_MM(A, 2); PV_LD(A, 3); PV_W(0); PV_MM(A, 3);
    }
#undef PV_W
#undef PV_MM
#undef PV_LD
#undef TRRD
}

struct FUnit {
    const bf16_t* Kb; long ldk; const bf16_t* Vb; long ldv; const bf16_t* KRb;
    int j_lo, j_hi;
    int qlo, qhi;
    int qpos;
    unsigned long long sel;
};
template <int MODE, int VAR = 0>
__device__ __forceinline__ void flash_core(char* lds, const FUnit& u, const bf16x8* qr, float scale, f32x16 (&o)[4], float& m_reg, float& l_reg) {
    constexpr bool ROPE = (MODE == 0);
    const int tid = threadIdx.x, wid = __builtin_amdgcn_readfirstlane(tid >> 6), lane = tid & 63, r32 = lane & 31, hi = lane >> 5;
    const int grp = wid >> 2;
    const float C2 = 1.4426950408889634f * scale;
    char* V_lds = lds + OFF_V; char* K_lds = lds + OFF_K; char* KR_lds = lds + OFF_KR;
    float* ws = (float*)(lds + OFF_WS) + wid * 64; float* al_l = ws + 32;
    const int sr = tid >> 4, sc = (tid & 15) * 8, vst0 = v_st(sr, sc), vst1 = v_st(32 + sr, sc), kws = KSWZ(sr, sc * 2);
    const int rr = tid >> 3, rc = (tid & 7) * 8, krws = rr * 128 + ((rc * 2) ^ ((rr & 7) << 4));
    const int vb0 = (int)(uintptr_t)lds + v_rd_base(lane);
    const char* qpark = lds + OFF_QPARK + wid * 4096 + lane * 16;
    m_reg = -1e30f; l_reg = 0.f;
#pragma unroll
    for (int d = 0; d < 4; ++d) o[d] = f32x16{};
    const int NT = u.j_hi - u.j_lo;
    if (NT <= 0) return;
    bf16x8 st_k0, st_k1, st_v0, st_v1, st_kr;
    f32x16 p0, p1; float mn, al; bf16x8 pa0, pa1, pa2, pa3;
    const unsigned W = (MODE == 1) ? 512u : ((MODE == 3) ? 0x80000000u : 0x7fffffffu);
#define FA_KBASE(t) ((u.j_lo + (t)) * KVBLK)
#define FA_KLOAD(k0) do { st_k0 = *(const bf16x8*)(u.Kb + (long)((k0) + sr) * u.ldk + sc); st_k1 = *(const bf16x8*)(u.Kb + (long)((k0) + 32 + sr) * u.ldk + sc);   \
                          if constexpr (ROPE) st_kr = *(const bf16x8*)(u.KRb + (long)((k0) + rr) * 64 + rc); } while (0)
#define FA_VLOAD(k0) do { st_v0 = *(const bf16x8*)(u.Vb + (long)((k0) + sr) * u.ldv + sc); st_v1 = *(const bf16x8*)(u.Vb + (long)((k0) + 32 + sr) * u.ldv + sc); } while (0)
#define FA_KWRITE(bf) do { *(bf16x8*)(K_lds + (bf) * SHM_K + kws) = st_k0; *(bf16x8*)(K_lds + (bf) * SHM_K + kws + 32 * 256) = st_k1;   \
                           if constexpr (ROPE) *(bf16x8*)(KR_lds + (bf) * SHM_KR + krws) = st_kr; } while (0)
#define FA_VWRITE(bf) do { *(bf16x8*)(V_lds + (bf) * SHM_V + vst0) = st_v0; *(bf16x8*)(V_lds + (bf) * SHM_V + vst1) = st_v1; } while (0)
#define FA_BAR() do { asm volatile("s_waitcnt lgkmcnt(0)" ::: "memory"); __builtin_amdgcn_s_barrier(); asm volatile("" ::: "memory"); } while (0)
#define FA_RESC(a) do { if (__any((a) < 1.f)) { if (hi == 0) al_l[r32] = (a); asm volatile("s_waitcnt lgkmcnt(0)" ::: "memory");              \
                     _Pragma("unroll") for (int d_ = 0; d_ < 4; ++d_) { _Pragma("unroll") for (int r = 0; r < 16; ++r) o[d_][r] *= al_l[crow(r, hi)]; } asm volatile("" ::: "memory"); } } while (0)
#define FA_MASK(t) do { const int kb_ = FA_KBASE(t);                                                                             \
        if (MODE == 1) { if (kb_ + KVBLK - 1 > u.qlo || kb_ <= u.qhi - 512) mask_tile(p0, p1, u.qpos - kb_ - 4 * hi, W); }       \
        else { if (kb_ + KVBLK - 1 > u.qlo) mask_tile(p0, p1, u.qpos - kb_ - 4 * hi, W); }                                       \
        } while (0)
#define FA_KILL(t) ((MODE == 2) && (((u.sel >> (u.j_lo + (t))) & 1ull) == 0ull))
    const int kb_last = FA_KBASE(NT - 1);
    FA_KLOAD(FA_KBASE(0)); FA_VLOAD(FA_KBASE(0));
    FA_KWRITE(0); FA_VWRITE(0);
    { const int k1 = FA_KBASE(1); FA_KLOAD(k1 < kb_last ? k1 : kb_last); }
    FA_BAR();
    if (grp == 1) FA_BAR();
#define FA_STEP(BF, t) do {                                                                                                      \
        if (!(VAR & 8)) { const int k1 = FA_KBASE((t) + 1); FA_VLOAD(k1 < kb_last ? k1 : kb_last); }                             \
        SBAR(); if (!(VAR & 1)) qkt<BF, ROPE, MODE == 3>(p0, p1, lds, r32, hi, qr, qpark); else { p0 = f32x16{}; p1 = f32x16{}; p0[0] = (float)(t); }   \
        if (!(VAR & 2)) { FA_MASK(t); partialSM(p0, p1, m_reg, mn, al, scale, C2, FA_KILL(t)); FA_RESC(al); } else { al = 1.f; }   \
        if (!(VAR & 8)) FA_KWRITE((BF) ^ 1);                                                                                     \
        if (!(VAR & 16)) FA_BAR();                                                                                               \
        if (!(VAR & 8)) { const int k2 = FA_KBASE((t) + 2); FA_KLOAD(k2 < kb_last ? k2 : kb_last); }                             \
        if (!(VAR & 2)) finishSM(p0, p1, al, l_reg, pa0, pa1, pa2, pa3); else { l_reg += p0[0]; pa0 = pack8(f32x4{p0[0], p0[1], p0[2], p0[3]}, f32x4{p1[0], p1[1], p1[2], p1[3]}); pa1 = pa0; pa2 = pa0; pa3 = pa0; } \
        SBAR();                                                                                                                  \
        if (!(VAR & 4)) pv_tile<BF, (MODE == 1 || MODE == 2)>(o, vb0, pa0, pa1, pa2, pa3); else { o[0][0] += __builtin_bit_cast(float, (int)pa0[0]); }      \
        if (!(VAR & 8)) FA_VWRITE((BF) ^ 1);                                                                                     \
        if (!(VAR & 16)) FA_BAR(); } while (0)
    int t = 0;
    for (; t + 1 < NT; t += 2) {
        FA_STEP(0, t);
        FA_STEP(1, t + 1);
    }
    if (NT & 1) {
        SBAR(); if (!(VAR & 1)) qkt<0, ROPE, MODE == 3>(p0, p1, lds, r32, hi, qr, qpark); else { p0 = f32x16{}; p1 = f32x16{}; }
        if (!(VAR & 2)) { FA_MASK(t); partialSM(p0, p1, m_reg, mn, al, scale, C2, FA_KILL(t)); FA_RESC(al); } else { al = 1.f; }
        if (!(VAR & 16)) FA_BAR();
        if (!(VAR & 2)) finishSM(p0, p1, al, l_reg, pa0, pa1, pa2, pa3); else { pa0 = pack8(f32x4{p0[0], p0[1], p0[2], p0[3]}, f32x4{p1[0], p1[1], p1[2], p1[3]}); pa1 = pa0; pa2 = pa0; pa3 = pa0; }
        SBAR();
        if (!(VAR & 4)) pv_tile<0, (MODE == 1 || MODE == 2)>(o, vb0, pa0, pa1, pa2, pa3);
        if (!(VAR & 16)) FA_BAR();
    }
#undef FA_STEP
    if (grp == 0) FA_BAR();
#undef FA_MASK
#undef FA_KILL
#undef FA_RESC
#undef FA_BAR
#undef FA_VWRITE
#undef FA_KWRITE
#undef FA_VLOAD
#undef FA_KLOAD
#undef FA_KBASE
}
template <int MODE>
__device__ __forceinline__ void flash_core2(char* lds, const FUnit& u, const bf16x8* qr, float scale, f32x16 (&o)[4], float& m_reg, float& l_reg) {
    const int tid = threadIdx.x, wid = __builtin_amdgcn_readfirstlane(tid >> 6), lane = tid & 63, r32 = lane & 31, hi = lane >> 5;
    const float C2 = 1.4426950408889634f * scale;
    char* V_lds = lds + OFF_V; char* K_lds = lds + OFF_K;
    float* ws = (float*)(lds + OFF_WS) + wid * 64; float* al_l = ws + 32;
    const int sr = tid >> 4, sc = (tid & 15) * 8, vst0 = v_st(sr, sc), vst1 = v_st(32 + sr, sc), kws = KSWZ(sr, sc * 2);
    const int vb0 = (int)(uintptr_t)lds + v_rd_base(lane);
    m_reg = -1e30f; l_reg = 0.f;
#pragma unroll
    for (int d = 0; d < 4; ++d) o[d] = f32x16{};
    const int NT = u.j_hi - u.j_lo;
    if (NT <= 0) return;
    bf16x8 st_k0, st_k1, st_v0, st_v1;
    f32x16 pA0, pA1, pB0, pB1; float mnA, mnB, alA, alB; bf16x8 pa0, pa1, pa2, pa3;
    const unsigned W = (MODE == 1) ? 512u : 0x7fffffffu;
#define F2_KBASE(t) ((u.j_lo + (t)) * KVBLK)
#define F2_LOAD(k0) do { st_v0 = *(const bf16x8*)(u.Vb + (long)((k0) + sr) * u.ldv + sc); st_v1 = *(const bf16x8*)(u.Vb + (long)((k0) + 32 + sr) * u.ldv + sc);   \
                         st_k0 = *(const bf16x8*)(u.Kb + (long)((k0) + sr) * u.ldk + sc); st_k1 = *(const bf16x8*)(u.Kb + (long)((k0) + 32 + sr) * u.ldk + sc); } while (0)
#define F2_WRITE(bf) do { *(bf16x8*)(V_lds + (bf) * SHM_V + vst0) = st_v0; *(bf16x8*)(V_lds + (bf) * SHM_V + vst1) = st_v1;   \
                          *(bf16x8*)(K_lds + (bf) * SHM_K + kws) = st_k0; *(bf16x8*)(K_lds + (bf) * SHM_K + kws + 32 * 256) = st_k1; } while (0)
#define F2_VMW() asm volatile("s_waitcnt vmcnt(0)" ::: "memory")
#define F2_RESC(a) do { if (__any((a) < 1.f)) { if (hi == 0) al_l[r32] = (a); asm volatile("s_waitcnt lgkmcnt(0)" ::: "memory");              \
                     _Pragma("unroll") for (int d_ = 0; d_ < 4; ++d_) { _Pragma("unroll") for (int r = 0; r < 16; ++r) o[d_][r] *= al_l[crow(r, hi)]; } asm volatile("" ::: "memory"); } } while (0)
#define F2_MASK(P0_, P1_, t) do { const int kb_ = F2_KBASE(t);                                                                    \
        if (MODE == 1) { if (kb_ + KVBLK - 1 > u.qlo || kb_ <= u.qhi - 512) mask_tile(P0_, P1_, u.qpos - kb_ - 4 * hi, W); }      \
        else { if (kb_ + KVBLK - 1 > u.qlo) mask_tile(P0_, P1_, u.qpos - kb_ - 4 * hi, W); } } while (0)
#define F2_KILL(t) ((MODE == 2) && (((u.sel >> (u.j_lo + (t))) & 1ull) == 0ull))
#define F2_HALF(PX0, PX1, mnX, alX, PY0, PY1, alY, t, KB, VB, SB) do {                                                            \
        SBAR(); qkt<KB, false, true>(PX0, PX1, lds, r32, hi, qr);                                                                 \
        finishSM(PY0, PY1, alY, l_reg, pa0, pa1, pa2, pa3); SBAR();                                                               \
        if ((t) + 1 < NT) { F2_LOAD(F2_KBASE((t) + 1)); SBAR(); }                                                                 \
        pv_tile<VB, false>(o, vb0, pa0, pa1, pa2, pa3); F2_MASK(PX0, PX1, (t)); partialSM(PX0, PX1, m_reg, mnX, alX, scale, C2, F2_KILL(t)); \
        __syncthreads();                                                                                                          \
        if ((t) + 1 < NT) { F2_VMW(); F2_WRITE(SB); }                                                                             \
        F2_RESC(alX); __syncthreads(); } while (0)
    F2_LOAD(F2_KBASE(0)); F2_VMW(); F2_WRITE(0); __syncthreads();
    if (NT > 1) F2_LOAD(F2_KBASE(1));
    SBAR(); qkt<0, false, true>(pA0, pA1, lds, r32, hi, qr);
    F2_MASK(pA0, pA1, 0); partialSM(pA0, pA1, m_reg, mnA, alA, scale, C2, F2_KILL(0));
    if (NT > 1) { F2_VMW(); F2_WRITE(1); }
    __syncthreads();
    for (int t = 1; t + 1 < NT; t += 2) {
        F2_HALF(pB0, pB1, mnB, alB, pA0, pA1, alA, t, 1, 0, 0);
        F2_HALF(pA0, pA1, mnA, alA, pB0, pB1, alB, t + 1, 0, 1, 1);
    }
    const bool even = (NT & 1) == 0;
    if (even) { SBAR(); qkt<1, false, true>(pB0, pB1, lds, r32, hi, qr); SBAR(); }
    finishSM(pA0, pA1, alA, l_reg, pa0, pa1, pa2, pa3); SBAR();
    pv_tile<0, false>(o, vb0, pa0, pa1, pa2, pa3);
    if (even) { F2_MASK(pB0, pB1, NT - 1); partialSM(pB0, pB1, m_reg, mnB, alB, scale, C2, F2_KILL(NT - 1)); F2_RESC(alB);
        finishSM(pB0, pB1, alB, l_reg, pa0, pa1, pa2, pa3); SBAR(); pv_tile<1, false>(o, vb0, pa0, pa1, pa2, pa3); }
#undef F2_HALF
#undef F2_KILL
#undef F2_MASK
#undef F2_RESC
#undef F2_VMW
#undef F2_WRITE
#undef F2_LOAD
#undef F2_KBASE
}
__device__ __forceinline__ void row_factors(char* lds, int wid, int r32, int hi, float f, float (&rf)[16]) {
    float* li_l = (float*)(lds + OFF_WS) + wid * 64;
    asm volatile("" ::: "memory");
    if (hi == 0) li_l[r32] = f;
    asm volatile("s_waitcnt lgkmcnt(0)" ::: "memory");
#pragma unroll
    for (int r = 0; r < 16; ++r) rf[r] = li_l[crow(r, hi)];
    asm volatile("s_waitcnt lgkmcnt(0)" ::: "memory");
}
}

constexpr size_t MiB = 1ull << 20, KiB = 1ull << 10;
constexpr size_t WS_CTL = 0;
constexpr size_t WS_ROPE = 64 * KiB;
constexpr size_t WS_MG = WS_ROPE + 1 * MiB;
constexpr size_t WS_FLOOR = WS_MG + 512 * KiB;
constexpr size_t WS_DEN = WS_FLOOR + 256 * KiB;
constexpr size_t WS_GATES = WS_DEN + 256 * KiB;
constexpr size_t WS_SEL = WS_GATES + 512 * KiB;
constexpr size_t WS_KROPE = WS_SEL + 512 * KiB;
constexpr size_t WS_CQN = WS_KROPE + 2 * MiB;
constexpr size_t WS_CKVN = WS_CQN + 32 * MiB;
constexpr size_t WS_KVB = WS_CKVN + 16 * MiB;
constexpr size_t WS_XB = WS_KVB + 128 * MiB;
constexpr size_t WS_Z = WS_XB + 128 * MiB;
constexpr size_t WS_R = WS_Z + 256 * MiB;
constexpr size_t WS_W = WS_R + 344 * MiB;
constexpr size_t W_AB = WS_W, W_UQ = W_AB + 62 * MiB, W_UKV = W_UQ + 6 * MiB, W_O0 = W_UKV + 4 * MiB, W_GU0 = W_O0 + 32 * MiB, W_D0 = W_GU0 + 172 * MiB;
constexpr size_t W_C = W_D0 + 86 * MiB, W_C1K = W_C + 58 * MiB, W_C1V = W_C1K + 2 * MiB, W_C2K = W_C1V + 2 * MiB, W_C2V = W_C2K + 128 * KiB, W_O1 = W_C2V + 128 * KiB;
constexpr size_t W_GU1 = W_O1 + 32 * MiB, W_D1 = W_GU1 + 172 * MiB, WS_AT = W_D1 + 86 * MiB;
constexpr size_t WS_AA = WS_AT + 256 * KiB;
constexpr size_t WS_DENI = WS_AA + 256 * KiB;
constexpr size_t WS_DENP = WS_DENI + 256 * KiB;
constexpr size_t WS_STATS = WS_DENP + 4 * MiB;
constexpr size_t WS_END = WS_STATS + 128 * KiB;
constexpr size_t WS_AK = WS_KVB, WS_AV = WS_AK + 32 * MiB, WS_HK = WS_AV + 32 * MiB, WS_HV = WS_HK + 2 * MiB, WS_KCMP = WS_HV + 2 * MiB, WS_VCMP = WS_KCMP + 2 * MiB;
constexpr size_t WS_QB = WS_R + (size_t)M_TOK * AB_NP * 2;

constexpr int NTHREADS = 512;
constexpr int LDS_BYTES = 152 * 1024, LDS_CTL_OFF = LDS_BYTES - 256;
constexpr int N_TJOBS = 14;
struct TJob { const float* s; const float* s2; bf16_t* d; int K, N, Np, mode; };
struct Args { const float* in[26]; float* out; unsigned char* ws; TJob tj[N_TJOBS]; int ph_lo, ph_hi; };

__device__ __forceinline__ void transpose_tile(char* lds, const TJob& jb, int t) {
    float* T = (float*)lds;
    const int tid = threadIdx.x;
    const int tn = jb.Np >> 6;
    const int in_ = t % tn, ik = t / tn, n0 = in_ * 64, k0 = ik * 64;
    const float* sp = jb.s; int c0 = n0; const int ncols = jb.N;
    if (jb.mode == 1) { const int tile = n0 >> 8, j = n0 & 255; sp = (j < 128) ? jb.s : jb.s2; c0 = tile * 128 + (j & 127); }
    const int kk = tid >> 4, nc = (tid & 15) * 4;
    f32x4 v0 = {0.f, 0.f, 0.f, 0.f}, v1 = v0;
    if (c0 + nc < ncols) { v0 = *(const f32x4*)(sp + (size_t)(k0 + kk) * ncols + c0 + nc); v1 = *(const f32x4*)(sp + (size_t)(k0 + kk + 32) * ncols + c0 + nc); }
#pragma unroll
    for (int j = 0; j < 4; ++j) { T[(nc + j) * 65 + kk] = v0[j]; T[(nc + j) * 65 + kk + 32] = v1[j]; }
    __syncthreads();
    const int n = tid >> 3, kc = (tid & 7) * 8;
    float f[8];
#pragma unroll
    for (int j = 0; j < 8; ++j) f[j] = T[n * 65 + kc + j];
    *(bf16x8*)(jb.d + (size_t)(n0 + n) * jb.K + k0 + kc) = pack8f(f);
    __syncthreads();
}
constexpr int N_TJOBS_PRO = 11;
__device__ __forceinline__ void transpose_jobs(char* lds, const Args& a) {
    for (int ji = 0; ji < N_TJOBS_PRO; ++ji) {
        const TJob jb = a.tj[ji];
        const int nt = (jb.K >> 6) * (jb.Np >> 6);
        for (int t = blockIdx.x; t < nt; t += gridDim.x) transpose_tile(lds, jb, t);
    }
}
constexpr int LATE_T0 = 64 * 64, LATE_T1 = 64 * 344, LATE_T2 = 172 * 64, LATE_A = LATE_T0 + LATE_T1, LATE_TOTAL = LATE_A + LATE_T2, LATE_SLOTS = 64 + 128 + 192 + 224, LATE_PER = (LATE_A + LATE_SLOTS - 1) / LATE_SLOTS;
constexpr int LATE_D_SLOTS = 128, LATE_D_PER = LATE_T2 / LATE_D_SLOTS;
static_assert(LATE_D_PER * LATE_D_SLOTS == LATE_T2, "down-weight tiles per slot");
struct TTile { const float* sp; bf16_t* d; int K, ncols, c0, n0, k0; };
__device__ __forceinline__ TTile late_tile(const Args& a, int g) {
    const int ji = g < LATE_T0 ? 11 : (g < LATE_T0 + LATE_T1 ? 12 : 13); const int t = g - (ji == 11 ? 0 : (ji == 12 ? LATE_T0 : LATE_T0 + LATE_T1));
    const TJob jb = a.tj[ji]; const int tn = jb.Np >> 6; TTile r; r.n0 = (t % tn) * 64; r.k0 = (t / tn) * 64; r.sp = jb.s; r.c0 = r.n0; r.ncols = jb.N; r.d = jb.d; r.K = jb.K;
    if (jb.mode == 1) { const int tile = r.n0 >> 8, j = r.n0 & 255; r.sp = (j < 128) ? jb.s : jb.s2; r.c0 = tile * 128 + (j & 127); }
    return r;
}
__device__ __forceinline__ void transpose_span(char* lds, const Args& a, int g0, int g1) {
    float* T = (float*)lds;
    const int tid = threadIdx.x, kk = tid >> 4, nc = (tid & 15) * 4, n = tid >> 3, kc = (tid & 7) * 8;
    if (g0 >= g1) return;
    __syncthreads();
    TTile cur = late_tile(a, g0);
    f32x4 v0 = {0.f, 0.f, 0.f, 0.f}, v1 = v0;
    if (cur.c0 + nc < cur.ncols) { v0 = *(const f32x4*)(cur.sp + (size_t)(cur.k0 + kk) * cur.ncols + cur.c0 + nc); v1 = *(const f32x4*)(cur.sp + (size_t)(cur.k0 + kk + 32) * cur.ncols + cur.c0 + nc); }
    for (int g = g0; g < g1; ++g) {
        const TTile nxt = late_tile(a, g + 1 < g1 ? g + 1 : g);
        f32x4 w0 = {0.f, 0.f, 0.f, 0.f}, w1 = w0;
        if (nxt.c0 + nc < nxt.ncols) { w0 = *(const f32x4*)(nxt.sp + (size_t)(nxt.k0 + kk) * nxt.ncols + nxt.c0 + nc); w1 = *(const f32x4*)(nxt.sp + (size_t)(nxt.k0 + kk + 32) * nxt.ncols + nxt.c0 + nc); }
#pragma unroll
        for (int j = 0; j < 4; ++j) { T[(nc + j) * 65 + kk] = v0[j]; T[(nc + j) * 65 + kk + 32] = v1[j]; }
        __syncthreads();
        float f[8];
#pragma unroll
        for (int j = 0; j < 8; ++j) f[j] = T[n * 65 + kc + j];
        *(bf16x8*)(cur.d + (size_t)(cur.n0 + n) * cur.K + cur.k0 + kc) = pack8f(f);
        __syncthreads();
        cur = nxt; v0 = w0; v1 = w1;
    }
}
__device__ __forceinline__ void transpose_late(char* lds, const Args& a, int slot) { const int g0 = slot * LATE_PER, g1 = (slot + 1) * LATE_PER < LATE_A ? (slot + 1) * LATE_PER : LATE_A; transpose_span(lds, a, g0, g1); }
__device__ __forceinline__ void transpose_late_d(char* lds, const Args& a, int slot) { transpose_span(lds, a, LATE_A + slot * LATE_D_PER, LATE_A + (slot + 1) * LATE_D_PER); }
__device__ __forceinline__ void p0_prologue(char* lds, const Args& a) {
    const int tid = threadIdx.x;
    const size_t gt = (size_t)blockIdx.x * NTHREADS + tid, gs = (size_t)gridDim.x * NTHREADS;
    { const float* x = a.in[0]; bf16_t* xb = (bf16_t*)(a.ws + WS_XB);
      for (size_t i = gt; i < (size_t)M_TOK * DM / 8; i += gs) { const f32x4 v0 = *(const f32x4*)(x + i * 8), v1 = *(const f32x4*)(x + i * 8 + 4);
          float f[8] = {v0[0], v0[1], v0[2], v0[3], v1[0], v1[1], v1[2], v1[3]}; *(bf16x8*)(xb + i * 8) = pack8f(f); } }
    { f32x2* rp = (f32x2*)(a.ws + WS_ROPE);
      for (size_t i = gt; i < (size_t)SEQ * 32; i += gs) { const int pos = (int)(i >> 5), j = (int)(i & 31);
          const double inv = exp(-(double)j / 32.0 * 9.210340371976184  ); const double ang = (double)pos * inv; rp[i] = (f32x2){(float)cos(ang), (float)sin(ang)}; } }
    transpose_jobs(lds, a);
}

__device__ __forceinline__ float softcap15(float z) { return 15.0f * tanhf(z * (1.0f / 15.0f)); }
__device__ __forceinline__ float logsigmoid_f(float z) { return fminf(z, 0.f) - log1pf(__expf(-fabsf(z))); }
__device__ __forceinline__ void p2_prep(char* lds, const Args& a) {
    const int tid = threadIdx.x, lane = tid & 63, wid = __builtin_amdgcn_readfirstlane(tid >> 6);
    const int gw = blockIdx.x * 8 + wid, nw = gridDim.x * 8;
    const bf16_t* proj = (const bf16_t*)(a.ws + WS_R);
    for (int bh = blockIdx.x; bh < 16; bh += gridDim.x) {
        const int b = bh >> 2, h = bh & 3;
        const float* gates = (const float*)(a.ws + WS_GATES);
        f32x2* mg = (f32x2*)(a.ws + WS_MG) + (size_t)bh * SEQ; float* fl = (float*)(a.ws + WS_FLOOR) + (size_t)bh * SEQ;
        float* at = (float*)(a.ws + WS_AT) + (size_t)bh * SEQ; float* aa = (float*)(a.ws + WS_AA) + (size_t)bh * SEQ;
        const float bi = a.in[2][h], bfg = a.in[3][h];
        float* S = (float*)lds;
        float li[8], lf[8], Fl[8], Al[8];
#pragma unroll
        for (int i = 0; i < 8; ++i) { const int c = wid * 8 + i, t = c * 64 + lane; const float* g = gates + (size_t)(b * SEQ + t) * 8;
            li[i] = softcap15(g[h] + bi); lf[i] = logsigmoid_f(softcap15(g[4 + h] + bfg));
            float F = lf[i];
#pragma unroll
            for (int o = 1; o < 64; o <<= 1) { const float y = __shfl_up(F, o); if (lane >= o) F += y; }
            float A = li[i] - F;
#pragma unroll
            for (int o = 1; o < 64; o <<= 1) { const float y = __shfl_up(A, o); if (lane >= o) A = fmaxf(A, y); }
            Fl[i] = F; Al[i] = A;
            if (lane == 63) { S[c] = F; S[64 + c] = A; } }
        __syncthreads();
        float Fc_all, Ac_all;
        { const float sF = S[lane], mA = S[64 + lane];
          float inc = sF;
#pragma unroll
          for (int o = 1; o < 64; o <<= 1) { const float y = __shfl_up(inc, o); if (lane >= o) inc += y; }
          Fc_all = inc - sF;
          float X = mA - Fc_all;
#pragma unroll
          for (int o = 1; o < 64; o <<= 1) { const float y = __shfl_up(X, o); if (lane >= o) X = fmaxf(X, y); }
          const float xp = __shfl_up(X, 1); Ac_all = lane == 0 ? 0.f : fmaxf(xp, 0.f); }
        __syncthreads();
#pragma unroll
        for (int i = 0; i < 8; ++i) { const int c = wid * 8 + i, t = c * 64 + lane;
            const float Fc = __shfl(Fc_all, c), Ac = __shfl(Ac_all, c);
            const float F = Fl[i] + Fc, A = fmaxf(Al[i] - Fc, Ac), m = F + A;
            float mp = __shfl_up(m, 1); if (lane == 0) mp = Fc + Ac;
            mg[t] = (f32x2){__expf(lf[i] + mp - m), __expf(li[i] - m)}; fl[t] = __expf(-m);
            at[t] = li[i] - F; aa[t] = A; }
    }
    const float* qn = a.in[5]; const float* kvn = a.in[6];
    bf16_t* cqn = (bf16_t*)(a.ws + WS_CQN); bf16_t* ckvn = (bf16_t*)(a.ws + WS_CKVN); bf16_t* krope = (bf16_t*)(a.ws + WS_KROPE);
    const f32x2* rp = (const f32x2*)(a.ws + WS_ROPE);
    for (int tk = gw; tk < M_TOK; tk += nw) {
        const bf16_t* row = proj + (size_t)tk * AB_NP;
        float x0[8], x1[8], y[8];
        unpack8(*(const bf16x8*)(row + AB_CQ + lane * 8), x0); unpack8(*(const bf16x8*)(row + AB_CQ + 512 + lane * 8), x1); unpack8(*(const bf16x8*)(row + AB_CKV + lane * 8), y);
        const float kr = bf2f(row[AB_KR + lane]);
        float s = 0.f, s2 = 0.f;
#pragma unroll
        for (int j = 0; j < 8; ++j) { s += x0[j] * x0[j] + x1[j] * x1[j]; s2 += y[j] * y[j]; }
        s = wave_sum(s); s2 = wave_sum(s2);
        const float r1 = rsqrtf(s * (1.0f / 1024.0f) + RMS_EPS), r2 = rsqrtf(s2 * (1.0f / 512.0f) + RMS_EPS);
#pragma unroll
        for (int j = 0; j < 8; ++j) { x0[j] *= r1 * qn[lane * 8 + j]; x1[j] *= r1 * qn[512 + lane * 8 + j]; y[j] *= r2 * kvn[lane * 8 + j]; }
        *(bf16x8*)(cqn + (size_t)tk * 1024 + lane * 8) = pack8f(x0); *(bf16x8*)(cqn + (size_t)tk * 1024 + 512 + lane * 8) = pack8f(x1);
        *(bf16x8*)(ckvn + (size_t)tk * 512 + lane * 8) = pack8f(y);
        const float pr = __shfl_xor(kr, 32); const f32x2 cs = rp[(size_t)(tk & (SEQ - 1)) * 32 + (lane & 31)];
        const float out = lane < 32 ? kr * cs.x - pr * cs.y : pr * cs.y + kr * cs.x;
        krope[(size_t)tk * 64 + lane] = f2bf(out);
    }
}

__device__ __forceinline__ float dpp_xor1(float v) { return __int_as_float(__builtin_amdgcn_update_dpp(0, __float_as_int(v), 0xB1, 0xF, 0xF, true)); }
__device__ __forceinline__ float dpp_xor2(float v) { return __int_as_float(__builtin_amdgcn_update_dpp(0, __float_as_int(v), 0x4E, 0xF, 0xF, true)); }
__device__ __forceinline__ float dpp_hmir(float v) { return __int_as_float(__builtin_amdgcn_update_dpp(0, __float_as_int(v), 0x141, 0xF, 0xF, true)); }
__device__ __forceinline__ float dpp_mir(float v)  { return __int_as_float(__builtin_amdgcn_update_dpp(0, __float_as_int(v), 0x140, 0xF, 0xF, true)); }
__device__ __forceinline__ float row16_sum(float v) { v += dpp_xor1(v); v += dpp_xor2(v); v += dpp_hmir(v); v += dpp_mir(v); return v; }
__device__ __forceinline__ float swap32_sum(float a, float b) {
    auto rr = __builtin_amdgcn_permlane32_swap(__float_as_uint(a), __float_as_uint(b), false, false); return __uint_as_float(rr[0]) + __uint_as_float(rr[1]); }
constexpr int ML_CH = 32;
constexpr int ML_Q = 0, ML_K = ML_CH * 256 * 4, ML_V = 2 * ML_CH * 256 * 4, ML_FI = ML_V + ML_CH * 32 * 4, ML_BUF = ML_FI + ML_CH * 8;
constexpr int ML_OUT = 2 * ML_BUF, ML_DEN = ML_OUT + ML_CH * 32 * 4, ML_END = ML_DEN + ML_CH * 4;
static_assert(ML_END <= LDS_CTL_OFF, "mLSTM LDS");
__device__ __forceinline__ void p4_mlstm(char* lds, const Args& a) {
    const int tid = threadIdx.x, lane = tid & 63, wid = __builtin_amdgcn_readfirstlane(tid >> 6);
    const bf16_t* proj = (const bf16_t*)(a.ws + WS_R); bf16_t* hcat = (bf16_t*)a.out;
    for (int unit = blockIdx.x; unit < 256; unit += gridDim.x) {
        const int bh = unit >> 4, sl = unit & 15, b = bh >> 2, h = bh & 3;
        const f32x2* mg = (const f32x2*)(a.ws + WS_MG) + (size_t)bh * SEQ;
        float* den = (float*)(a.ws + WS_DEN) + (size_t)bh * SEQ;
        const bool denw = (wid == 0) && (sl == 0);
        const int st = tid >> 4, sp = (tid & 15) * 16, vt = tid >> 2, vp = (tid & 3) * 8;
        const bf16_t* qsrc = proj + (size_t)(b * SEQ + st) * AB_NP + AB_Q + h * 256 + sp;
        const bf16_t* ksrc = proj + (size_t)(b * SEQ + st) * AB_NP + AB_K + h * 256 + sp;
        const bf16_t* vsrc = proj + (size_t)(b * SEQ + vt) * AB_NP + AB_V + h * 512 + sl * 32 + vp;
        bf16x8 rq0, rq1, rk0, rk1, rv; f32x2 rfi;
#define ML_LOAD(c) do { const size_t o_ = (size_t)(c) * ML_CH * AB_NP; rq0 = *(const bf16x8*)(qsrc + o_); rq1 = *(const bf16x8*)(qsrc + o_ + 8); rk0 = *(const bf16x8*)(ksrc + o_); rk1 = *(const bf16x8*)(ksrc + o_ + 8); \
        if (tid < 128) rv = *(const bf16x8*)(vsrc + o_); if (tid < ML_CH) rfi = mg[(c) * ML_CH + tid]; } while (0)
#define ML_STORE(bufp) do { float f_[8]; float* Q_ = (float*)((bufp) + ML_Q) + st * 256 + sp; float* K_ = (float*)((bufp) + ML_K) + st * 256 + sp; \
        unpack8(rq0, f_); *(f32x4*)(Q_) = (f32x4){f_[0], f_[1], f_[2], f_[3]}; *(f32x4*)(Q_ + 4) = (f32x4){f_[4], f_[5], f_[6], f_[7]}; \
        unpack8(rq1, f_); *(f32x4*)(Q_ + 8) = (f32x4){f_[0], f_[1], f_[2], f_[3]}; *(f32x4*)(Q_ + 12) = (f32x4){f_[4], f_[5], f_[6], f_[7]}; \
        unpack8(rk0, f_); *(f32x4*)(K_) = (f32x4){f_[0], f_[1], f_[2], f_[3]} * 0.0625f; *(f32x4*)(K_ + 4) = (f32x4){f_[4], f_[5], f_[6], f_[7]} * 0.0625f; \
        unpack8(rk1, f_); *(f32x4*)(K_ + 8) = (f32x4){f_[0], f_[1], f_[2], f_[3]} * 0.0625f; *(f32x4*)(K_ + 12) = (f32x4){f_[4], f_[5], f_[6], f_[7]} * 0.0625f; \
        if (tid < 128) { float* V_ = (float*)((bufp) + ML_V) + vt * 32 + vp; unpack8(rv, f_); *(f32x4*)(V_) = (f32x4){f_[0], f_[1], f_[2], f_[3]}; *(f32x4*)(V_ + 4) = (f32x4){f_[4], f_[5], f_[6], f_[7]}; } \
        if (tid < ML_CH) ((f32x2*)((bufp) + ML_FI))[tid] = rfi; } while (0)
        f32x4 C0 = {0.f, 0.f, 0.f, 0.f}, C1 = C0, C2 = C0, C3 = C0, n4 = C0;
        __syncthreads();
        ML_LOAD(0); ML_STORE(lds); __syncthreads();
        float* OUT = (float*)(lds + ML_OUT); float* DENs = (float*)(lds + ML_DEN);
        for (int c = 0; c < SEQ / ML_CH; ++c) {
            char* buf = lds + (c & 1) * ML_BUF;
            if (c + 1 < SEQ / ML_CH) ML_LOAD(c + 1);
            const float* Qs = (const float*)(buf + ML_Q) + lane * 4; const float* Ks = (const float*)(buf + ML_K) + lane * 4;
            const float* Vs = (const float*)(buf + ML_V) + wid * 4; const f32x2* FIs = (const f32x2*)(buf + ML_FI);
#pragma unroll 4
            for (int s = 0; s < ML_CH; ++s) {
                const f32x4 q4 = *(const f32x4*)(Qs + s * 256), k4 = *(const f32x4*)(Ks + s * 256), v4 = *(const f32x4*)(Vs + s * 32); const f32x2 fi = FIs[s];
                const f32x4 iv = v4 * fi.y;
                C0 = C0 * fi.x + iv * k4[0]; C1 = C1 * fi.x + iv * k4[1]; C2 = C2 * fi.x + iv * k4[2]; C3 = C3 * fi.x + iv * k4[3];
                f32x4 d = C0 * q4[0] + C1 * q4[1] + C2 * q4[2] + C3 * q4[3];
                float e0 = swap32_sum(d[0], d[2]), e1 = swap32_sum(d[1], d[3]);
                const float other = __shfl_xor((lane & 16) ? e0 : e1, 16);
                float r = ((lane & 16) ? e1 : e0) + other;
                r = row16_sum(r);
                if ((lane & 15) == 0) OUT[s * 32 + wid * 4 + (lane >> 5) * 2 + ((lane >> 4) & 1)] = r;
                if (denw) { n4 = n4 * fi.x + k4 * fi.y; float dn = n4[0] * q4[0] + n4[1] * q4[1] + n4[2] * q4[2] + n4[3] * q4[3];
                    dn = swap32_sum(dn, dn); dn += __shfl_xor(dn, 16); dn = row16_sum(dn); if (lane == 0) DENs[s] = dn; }
            }
            __syncthreads();
            if (tid < 128) { const float* o_ = OUT + vt * 32 + vp; float f[8];
#pragma unroll
                for (int j = 0; j < 8; ++j) f[j] = o_[j];
                *(bf16x8*)(hcat + (size_t)(b * SEQ + c * ML_CH + vt) * DM + h * 512 + sl * 32 + vp) = pack8f(f); }
            if (sl == 0 && tid < ML_CH) den[c * ML_CH + tid] = DENs[tid];
            if (c + 1 < SEQ / ML_CH) ML_STORE(lds + ((c + 1) & 1) * ML_BUF);
            __syncthreads();
        }
#undef ML_LOAD
#undef ML_STORE
    }
}

#define TRRD(dst, base, off) asm volatile("ds_read_b64_tr_b16 %0, %1 offset:%2" : "=&v"(dst) : "v"(base), "i"(off) : "memory")
#define TRRD(dst, base, off) asm volatile("ds_read_b64_tr_b16 %0, %1 offset:%2" : "=&v"(dst) : "v"(base), "i"(off) : "memory")
namespace mc {
constexpr int L_K = 0, L_Q = 32768, L_V = 65536, L_EV = 81920, L_CT = 98304, L_TAB = 114688, L_G = 116736;
constexpr int T_A = 0, T_AA = 64, T_INT = 128, T_E = 192;
__device__ __forceinline__ int kaddr(int s, int d) { return (d >> 7) * 16384 + s * 256 + (((d & 127) * 2) ^ ((s & 7) << 4)); }
}
#define MC_QF(d0) (*(const bf16x8*)(lds + L_Q + ((d0) >> 3) * 16384 + TB * 8192 + kq[(d0) & 3] + (((d0) >> 2) & 1) * 128))
template <int TB>
__device__ __forceinline__ void mc_inter(char* lds, float* TAB, const int (&kq)[4], int cfrag, int csw, int lane, int hi) {
    using namespace mc;
    f32x16 o = f32x16{};
    bf16x8 fq[2][2], fc[2][2];
#define MJ_LD(g) do { _Pragma("unroll") for (int e = 0; e < 2; ++e) { const int d0 = 2 * (g) + e; fq[(g) & 1][e] = MC_QF(d0); fc[(g) & 1][e] = *(const bf16x8*)(lds + L_CT + cfrag + (((d0 * 16 + hi * 8) * 2) ^ csw)); } } while (0)
#define MJ_MM(g) do { _Pragma("unroll") for (int e = 0; e < 2; ++e) o = __builtin_amdgcn_mfma_f32_32x32x16_bf16(fq[(g) & 1][e], fc[(g) & 1][e], o, 0, 0, 0); } while (0)
    MJ_LD(0); SBAR();
#pragma unroll
    for (int g = 0; g < 8; ++g) { if (g + 1 < 8) { MJ_LD(g + 1); } SBAR(); MJ_MM(g); SBAR(); }
#undef MJ_LD
#undef MJ_MM
    const float* ti = TAB + T_INT + TB * 32 + 4 * hi; float* G = (float*)(lds + L_G) + TB * 1024 + lane;
#pragma unroll
    for (int r = 0; r < 16; ++r) G[r * 64] = o[r] * ti[(r & 3) + 8 * (r >> 2)];
}
template <int TB>
__device__ __forceinline__ void mc_intra(char* lds, float* TAB, const int (&kq)[4], int vbV, int r32, int hi, f32x16& o, float& ps) {
    using namespace mc;
    const float LOG2E = 1.4426950408889634f;
    const int tl = TB * 32 + r32;
    f32x16 p0 = f32x16{}, p1 = f32x16{};
    bf16x8 fq[2][2], fa0[2][2], fa1[2][2];
#define MI_LD(g) do { _Pragma("unroll") for (int e = 0; e < 2; ++e) { const int d0 = 2 * (g) + e; const char* ap = lds + L_K + (d0 >> 3) * 16384 + kq[d0 & 3] + ((d0 >> 2) & 1) * 128; \
        fq[(g) & 1][e] = MC_QF(d0); fa0[(g) & 1][e] = *(const bf16x8*)ap; if constexpr (TB == 1) fa1[(g) & 1][e] = *(const bf16x8*)(ap + 8192); } } while (0)
#define MI_MM(g) do { _Pragma("unroll") for (int e = 0; e < 2; ++e) { p0 = __builtin_amdgcn_mfma_f32_32x32x16_bf16(fa0[(g) & 1][e], fq[(g) & 1][e], p0, 0, 0, 0); \
        if constexpr (TB == 1) p1 = __builtin_amdgcn_mfma_f32_32x32x16_bf16(fa1[(g) & 1][e], fq[(g) & 1][e], p1, 0, 0, 0); } } while (0)
    MI_LD(0); SBAR();
#pragma unroll
    for (int g = 0; g < 8; ++g) { if (g + 1 < 8) { MI_LD(g + 1); } SBAR(); MI_MM(g); SBAR(); }
#undef MI_LD
#undef MI_MM
    const float At = TAB[T_AA + tl];
    ps = 0.f;
    const float* ta = TAB + T_A + 4 * hi;
#pragma unroll
    for (int r = 0; r < 16; ++r) { const int s0 = fa::crow(r, hi), c0 = (r & 3) + 8 * (r >> 2);
        const float e0 = __builtin_amdgcn_exp2f((ta[c0] - At) * LOG2E) * 0.0625f; const float w0 = (s0 <= tl) ? e0 : 0.f; p0[r] *= w0; ps += p0[r];
        if constexpr (TB == 1) { const float e1 = __builtin_amdgcn_exp2f((ta[32 + c0] - At) * LOG2E) * 0.0625f; const float w1 = (s0 + 32 <= tl) ? e1 : 0.f; p1[r] *= w1; ps += p1[r]; } }
    { auto rr = __builtin_amdgcn_permlane32_swap(__float_as_uint(ps), __float_as_uint(ps), false, false); ps = __uint_as_float(rr[0]) + __uint_as_float(rr[1]); }
    bf16x8 pa0, pa1, pa2, pa3;
#define PK4(P, B_, OUT) do { unsigned a0 = fa::cvtpk(P[B_+0], P[B_+1]), a1 = fa::cvtpk(P[B_+2], P[B_+3]);                  \
        unsigned b0_ = fa::cvtpk(P[B_+4], P[B_+5]), b1_ = fa::cvtpk(P[B_+6], P[B_+7]);                                   \
        auto r0 = __builtin_amdgcn_permlane32_swap(a0, b0_, false, false); auto r1 = __builtin_amdgcn_permlane32_swap(a1, b1_, false, false); \
        u32x4 w = {r0[0], r1[0], r0[1], r1[1]}; OUT = *reinterpret_cast<bf16x8*>(&w); } while (0)
    PK4(p0, 0, pa0); PK4(p0, 8, pa1); PK4(p1, 0, pa2); PK4(p1, 8, pa3);
#undef PK4
    o = f32x16{};
    { s16x4 l0, l1, l2, l3, h0, h1, h2, h3;
      TRRD(l0, vbV, 0); TRRD(h0, vbV, 2048); TRRD(l1, vbV, 4096); TRRD(h1, vbV, 6144); TRRD(l2, vbV, 8192); TRRD(h2, vbV, 10240); TRRD(l3, vbV, 12288); TRRD(h3, vbV, 14336);
      asm volatile("s_waitcnt lgkmcnt(0)" ::: "memory"); SBAR();
      o = __builtin_amdgcn_mfma_f32_32x32x16_bf16(pa0, (bf16x8){l0[0], l0[1], l0[2], l0[3], h0[0], h0[1], h0[2], h0[3]}, o, 0, 0, 0);
      o = __builtin_amdgcn_mfma_f32_32x32x16_bf16(pa1, (bf16x8){l1[0], l1[1], l1[2], l1[3], h1[0], h1[1], h1[2], h1[3]}, o, 0, 0, 0);
      if constexpr (TB == 1) { o = __builtin_amdgcn_mfma_f32_32x32x16_bf16(pa2, (bf16x8){l2[0], l2[1], l2[2], l2[3], h2[0], h2[1], h2[2], h2[3]}, o, 0, 0, 0);
                               o = __builtin_amdgcn_mfma_f32_32x32x16_bf16(pa3, (bf16x8){l3[0], l3[1], l3[2], l3[3], h3[0], h3[1], h3[2], h3[3]}, o, 0, 0, 0); } }
}
#undef MC_QF
__device__ __forceinline__ void p4_mlstm_chunk(char* lds, const Args& a) {
    using namespace mc;
    const int tid = threadIdx.x, lane = tid & 63, wid = __builtin_amdgcn_readfirstlane(tid >> 6);
    const bf16_t* proj = (const bf16_t*)(a.ws + WS_R); bf16_t* hcat = (bf16_t*)a.out;
    float* TAB = (float*)(lds + L_TAB);
    const float LOG2E = 1.4426950408889634f;
    for (int unit = blockIdx.x; unit < 256; unit += gridDim.x) {
        const int bh = (gridDim.x == 256) ? 2 * (unit & 7) + (unit >> 7) : unit >> 4, sl = (gridDim.x == 256) ? (unit >> 3) & 15 : unit & 15, b = bh >> 2, h = bh & 3;
        const float* AT = (const float*)(a.ws + WS_AT) + (size_t)bh * SEQ; const float* AA = (const float*)(a.ws + WS_AA) + (size_t)bh * SEQ;
        float* deni = (float*)(a.ws + WS_DENI) + (size_t)bh * SEQ; float* denp = (float*)(a.ws + WS_DENP) + (size_t)(bh * 16 + sl) * SEQ;
        const int krow = tid >> 3, kch = (tid & 7) * 4, vrow = (tid >> 2) & 63, vch = tid & 3;
        const bf16_t* ksrc = proj + (size_t)(b * SEQ + krow) * AB_NP + AB_K + h * 256 + kch * 8;
        const bf16_t* qsrc = proj + (size_t)(b * SEQ + krow) * AB_NP + AB_Q + h * 256 + kch * 8;
        const bf16_t* vsrc = proj + (size_t)(b * SEQ + vrow) * AB_NP + AB_V + h * 512 + sl * 32 + vch * 8;
        int kdst[4];
#pragma unroll
        for (int i = 0; i < 4; ++i) { const int ch = kch + i; kdst[i] = (ch >> 4) * 16384 + KSWZ(krow, (ch & 15) * 16); }
        const int vdst = fa::v_st(vrow, vch * 8);
        bf16x8 rk[4], rq[4], rv; float pa_t = 0.f, pA_t = 0.f, pa_v = 0.f, pA_prev = 0.f, pA_end = 0.f;
#define MC_LOAD(c) do { const size_t o_ = (size_t)(c) * 64 * AB_NP; _Pragma("unroll") for (int i = 0; i < 4; ++i) { rk[i] = *(const bf16x8*)(ksrc + o_ + i * 8); rq[i] = *(const bf16x8*)(qsrc + o_ + i * 8); } \
        if (tid < 256) { rv = *(const bf16x8*)(vsrc + o_); pa_v = AT[(c) * 64 + vrow]; } if (tid < 64) { pa_t = AT[(c) * 64 + tid]; pA_t = AA[(c) * 64 + tid]; } \
        pA_end = AA[(c) * 64 + 63]; pA_prev = (c) > 0 ? AA[(c) * 64 - 1] : 0.f; } while (0)
        f32x16 Cacc = f32x16{};
        f32x16 oi = f32x16{}; float psi = 0.f;
        float nreg = 0.f;
        __syncthreads();
        for (int i = tid; i < 16384 / 16; i += NTHREADS) *(u32x4*)(lds + L_CT + i * 16) = (u32x4){0u, 0u, 0u, 0u};
        MC_LOAD(0);
        for (int c = 0; c < SEQ / 64; ++c) {
            const int t0 = c * 64;
            const float A_prev = pA_prev, A_end = pA_end;
            asm volatile("s_waitcnt vmcnt(0)" ::: "memory");
#pragma unroll
            for (int i = 0; i < 4; ++i) { *(bf16x8*)(lds + L_K + kdst[i]) = rk[i]; *(bf16x8*)(lds + L_Q + kdst[i]) = rq[i]; }
            if (tid < 256) { *(bf16x8*)(lds + L_V + vdst) = rv; const float e = __builtin_amdgcn_exp2f((pa_v - A_end) * LOG2E) * 0.0625f;
                float f[8]; unpack8(rv, f);
#pragma unroll
                for (int j = 0; j < 8; ++j) f[j] *= e;
                *(bf16x8*)(lds + L_EV + vdst) = pack8f(f); }
            if (tid < 64) { TAB[T_A + tid] = pa_t; TAB[T_AA + tid] = pA_t; TAB[T_INT + tid] = __builtin_amdgcn_exp2f((A_prev - pA_t) * LOG2E); TAB[T_E + tid] = __builtin_amdgcn_exp2f((pa_t - A_end) * LOG2E) * 0.0625f; }
            __syncthreads();
            if (c + 1 < SEQ / 64) MC_LOAD(c + 1);
            const float decay = __builtin_amdgcn_exp2f((A_prev - A_end) * LOG2E);
            int lane_o = lane; asm volatile("" : "+v"(lane_o));
            const int r32 = lane_o & 31, hi = lane_o >> 5;
            int kq[4];
#pragma unroll
            for (int dd = 0; dd < 4; ++dd) kq[dd] = KSWZ(r32, dd * 32 + hi * 16);
            const int cfrag = r32 * 512, csw = (r32 & 15) << 4;
            const int trq = (lane_o & 15) >> 2, trp = lane_o & 3, trg = (lane_o >> 4) & 1;
            const int vbV = (int)(uintptr_t)lds + L_V + fa::v_rd_base(lane_o), vbE = (int)(uintptr_t)lds + L_EV + fa::v_rd_base(lane_o);
            if (wid == 0) mc_intra<0>(lds, TAB, kq, vbV, r32, hi, oi, psi);
            else if (wid == 1) mc_intra<1>(lds, TAB, kq, vbV, r32, hi, oi, psi);
            else if (wid == 2) mc_inter<0>(lds, TAB, kq, cfrag, csw, lane_o, hi);
            else if (wid == 3) mc_inter<1>(lds, TAB, kq, cfrag, csw, lane_o, hi);
            if (wid == 7) {
                const int d0_ = 16 * sl;
                float qv[16]; { float f[8]; unpack8(*(const bf16x8*)(lds + L_Q + kaddr(lane, d0_)), f);
#pragma unroll
                    for (int j = 0; j < 8; ++j) qv[j] = f[j];
                    unpack8(*(const bf16x8*)(lds + L_Q + kaddr(lane, d0_ + 8)), f);
#pragma unroll
                    for (int j = 0; j < 8; ++j) qv[8 + j] = f[j]; }
                float dsum = 0.f;
#pragma unroll
                for (int d = 0; d < 16; ++d) dsum += qv[d] * __int_as_float(__builtin_amdgcn_readlane(__float_as_int(nreg), d));
                denp[t0 + lane] = dsum * TAB[T_INT + lane];
                const int dd = lane & 15, sq = lane >> 4; float part = 0.f;
#pragma unroll
                for (int j = 0; j < 16; ++j) { const int s = sq * 16 + j; part += TAB[T_E + s] * bf2f(*(const bf16_t*)(lds + L_K + kaddr(s, d0_ + dd))); }
                part += __shfl_xor(part, 16); part += __shfl_xor(part, 32);
                nreg = nreg * decay + part;
            }
            {
#pragma unroll
                for (int r = 0; r < 16; ++r) Cacc[r] *= decay;
                s16x4 l0, l1, l2, l3, h0, h1, h2, h3;
                TRRD(l0, vbE, 0); TRRD(h0, vbE, 2048); TRRD(l1, vbE, 4096); TRRD(h1, vbE, 6144); TRRD(l2, vbE, 8192); TRRD(h2, vbE, 10240); TRRD(l3, vbE, 12288); TRRD(h3, vbE, 14336);
                s16x4 ka[4][2];
                { const int d = 32 * wid + trg * 16 + 4 * trp;
                  const int ad0 = (int)(uintptr_t)lds + L_K + kaddr(8 * hi + trq, d), ad1 = (int)(uintptr_t)lds + L_K + kaddr(8 * hi + 4 + trq, d);
                  TRRD(ka[0][0], ad0, 0); TRRD(ka[0][1], ad1, 0); TRRD(ka[1][0], ad0, 4096); TRRD(ka[1][1], ad1, 4096);
                  TRRD(ka[2][0], ad0, 8192); TRRD(ka[2][1], ad1, 8192); TRRD(ka[3][0], ad0, 12288); TRRD(ka[3][1], ad1, 12288); }
                asm volatile("s_waitcnt lgkmcnt(0)" ::: "memory"); SBAR();
#define KAF(ks) (bf16x8){ka[ks][0][0], ka[ks][0][1], ka[ks][0][2], ka[ks][0][3], ka[ks][1][0], ka[ks][1][1], ka[ks][1][2], ka[ks][1][3]}
                Cacc = __builtin_amdgcn_mfma_f32_32x32x16_bf16(KAF(0), (bf16x8){l0[0], l0[1], l0[2], l0[3], h0[0], h0[1], h0[2], h0[3]}, Cacc, 0, 0, 0);
                Cacc = __builtin_amdgcn_mfma_f32_32x32x16_bf16(KAF(1), (bf16x8){l1[0], l1[1], l1[2], l1[3], h1[0], h1[1], h1[2], h1[3]}, Cacc, 0, 0, 0);
                Cacc = __builtin_amdgcn_mfma_f32_32x32x16_bf16(KAF(2), (bf16x8){l2[0], l2[1], l2[2], l2[3], h2[0], h2[1], h2[2], h2[3]}, Cacc, 0, 0, 0);
                Cacc = __builtin_amdgcn_mfma_f32_32x32x16_bf16(KAF(3), (bf16x8){l3[0], l3[1], l3[2], l3[3], h3[0], h3[1], h3[2], h3[3]}, Cacc, 0, 0, 0);
#undef KAF
            }
            __syncthreads();
            float one = 1.0f; asm volatile("" : "+v"(one));
#pragma unroll
            for (int g = 0; g < 4; ++g) { const int d4 = 32 * wid + 8 * g + 4 * hi; u32x2 w; w.x = cvt_pk_bf16(Cacc[4 * g] * one, Cacc[4 * g + 1] * one); w.y = cvt_pk_bf16(Cacc[4 * g + 2] * one, Cacc[4 * g + 3] * one);
                *(u32x2*)(lds + L_CT + cfrag + ((d4 * 2) ^ csw)) = w; }
            if (wid < 2) {
                const float* G = (const float*)(lds + L_G) + wid * 1024 + lane_o;
                bf16_t* ob = hcat + (size_t)(b * SEQ + t0 + wid * 32) * DM + h * 512 + sl * 32;
                const int lofs = hi * 4 * DM + r32;
#pragma unroll
                for (int r = 0; r < 16; ++r) { const float v = oi[r] + G[r * 64], vn = dpp_xor1(v);
                    if ((r32 & 1) == 0) *(unsigned*)((ob + (size_t)((r & 3) + 8 * (r >> 2)) * DM) + lofs) = cvt_pk_bf16(v, vn); }
                if (sl == 0 && hi == 0) deni[t0 + wid * 32 + r32] = psi;
            }
        }
#undef MC_LOAD
        __syncthreads();
    }
}
#undef TRRD

__device__ __forceinline__ void p5_mlstm_norm(const Args& a) {
    const int tid = threadIdx.x, lane = tid & 63, wid = tid >> 6;
    const int gw = blockIdx.x * 8 + wid, nw = gridDim.x * 8;
    const bf16_t* proj = (const bf16_t*)(a.ws + WS_R); bf16_t* hcat = (bf16_t*)a.out;
    const float* den = (const float*)(a.ws + WS_DEN); const float* fl = (const float*)(a.ws + WS_FLOOR); const float* mn = a.in[4];
    for (int it = gw; it < M_TOK * 4; it += nw) {
        const int tk = it >> 2, h = it & 3, b = tk >> 12, t = tk & (SEQ - 1), bh = b * 4 + h;
        bf16_t* hp = hcat + (size_t)tk * DM + h * 512 + lane * 8;
        float x[8], og[8];
        unpack8(*(const bf16x8*)hp, x); unpack8(*(const bf16x8*)(proj + (size_t)tk * AB_NP + AB_OG + h * 512 + lane * 8), og);
#if MLSTM_CHUNK && !MLSTM_BOTH && (DEBUG_CMP < 0)
        float dsum = ((const float*)(a.ws + WS_DENI))[(size_t)bh * SEQ + t];
#pragma unroll
        for (int q = 0; q < 16; ++q) dsum += ((const float*)(a.ws + WS_DENP))[(size_t)(bh * 16 + q) * SEQ + t];
#else
        const float dsum = den[(size_t)bh * SEQ + t];
#endif
        const float dd = fmaxf(fabsf(dsum), fl[(size_t)bh * SEQ + t]); const float inv = 1.0f / dd;
        float s = 0.f;
#pragma unroll
        for (int j = 0; j < 8; ++j) { x[j] *= inv; s += x[j] * x[j]; }
        s = wave_sum(s);
        const float r = rsqrtf(s * (1.0f / 512.0f) + RMS_EPS);
#pragma unroll
        for (int j = 0; j < 8; ++j) x[j] = x[j] * r * mn[h * 512 + lane * 8 + j] * sigmoid_f(og[j]);
        *(bf16x8*)hp = pack8f(x);
    }
}
__device__ __forceinline__ int xcd_unit(int k, int per, int groups, int upg) {
    const int w = blockIdx.x, G = gridDim.x;
    if (G != 256 || per * 256 != groups * upg) return w + k * G;
    const int j = w & 7, s = w >> 3, lu = k * 32 + s;
    return (j * (groups >> 3) + lu / upg) * upg + lu % upg;
}
__device__ __forceinline__ void p5_mla(char* lds, const Args& a) {
    const int tid = threadIdx.x, wid = __builtin_amdgcn_readfirstlane(tid >> 6), lane = tid & 63, r32 = lane & 31, hi = lane >> 5;
    const bf16_t* qb = (const bf16_t*)(a.ws + WS_QB); const bf16_t* kvb = (const bf16_t*)(a.ws + WS_KVB); const bf16_t* krope = (const bf16_t*)(a.ws + WS_KROPE);
    bf16_t* hcat = (bf16_t*)a.out;     const f32x2* rp = (const f32x2*)(a.ws + WS_ROPE);
    for (int kk = 0; kk * (int)gridDim.x < 64 * 8 * 2; ++kk) {
        const int it2 = xcd_unit(kk >> 1, 2, 64, 8), pass = kk & 1; if (it2 >= 512) break;
        const int bh = it2 >> 3, x = it2 & 7, b = bh >> 4, h = bh & 15;
        const int qblk = pass ? 15 - x : x, t0 = qblk * 256, pos = t0 + wid * 32 + r32;
        const bf16_t* qrow = qb + (size_t)(b * SEQ + pos) * 3072 + h * 192;
        bf16x8 qr[8], qrr[4];
#pragma unroll
        for (int d0 = 0; d0 < 8; ++d0) qr[d0] = *(const bf16x8*)(qrow + d0 * 16 + hi * 8);
#pragma unroll
        for (int d0 = 0; d0 < 4; ++d0) qrr[d0] = *(const bf16x8*)(qrow + 128 + d0 * 16 + hi * 8);
#pragma unroll
        for (int g = 0; g < 2; ++g) { float x1[8], x2[8], o1[8], o2[8]; unpack8(qrr[g], x1); unpack8(qrr[2 + g], x2);
#pragma unroll
            for (int j = 0; j < 8; ++j) { const f32x2 cs = rp[(size_t)pos * 32 + g * 16 + hi * 8 + j]; o1[j] = x1[j] * cs.x - x2[j] * cs.y; o2[j] = x1[j] * cs.y + x2[j] * cs.x; }
            char* qpark = lds + fa::OFF_QPARK + wid * 4096 + lane * 16;
            *(bf16x8*)(qpark + g * 1024) = pack8f(o1); *(bf16x8*)(qpark + (2 + g) * 1024) = pack8f(o2); }
        fa::FUnit u; u.Kb = kvb + (size_t)(b * SEQ) * 4096 + h * 256; u.ldk = 4096; u.Vb = u.Kb + 128; u.ldv = 4096; u.KRb = krope + (size_t)(b * SEQ) * 64;
        u.j_lo = 0; u.j_hi = (t0 + 255) / 64 + 1; u.qlo = t0 + wid * 32; u.qhi = u.qlo + 31; u.qpos = pos; u.sel = 0ull;
        f32x16 o[4]; float m_reg, l_reg;
        fa::flash_core<0>(lds, u, qr, 0.07216878364870322f, o, m_reg, l_reg);
        float rf[16]; fa::row_factors(lds, wid, r32, hi, 1.0f / l_reg, rf);
        bf16_t* ob = hcat + (size_t)(b * SEQ + t0 + wid * 32) * DM + 2048 + h * 128;
#pragma unroll
        for (int r = 0; r < 16; ++r) { const int orow = fa::crow(r, hi);
#pragma unroll
            for (int d0 = 0; d0 < 4; ++d0) { const float v = o[d0][r] * rf[r]; const float vn = __shfl_xor(v, 1);
                if ((r32 & 1) == 0) *(unsigned*)(ob + (size_t)orow * DM + d0 * 32 + r32) = cvt_pk_bf16(v, vn); } }
        __syncthreads();
    }
}

__device__ __forceinline__ void p7_layernorm(const Args& a, int layer_idx, bool mix, const float* z, float* outf, bf16_t* outb, f32x2* stats) {
    const int tid = threadIdx.x, lane = tid & 63, wid = tid >> 6;
    const int gw = blockIdx.x * 8 + wid, nw = gridDim.x * 8;
    const float* g = (mix ? a.in[22] : a.in[24]) + (size_t)layer_idx * DM; const float* bb = (mix ? a.in[23] : a.in[25]) + (size_t)layer_idx * DM;
    for (int row = gw; row < M_TOK; row += nw) {
        const float* zr = z + (size_t)row * DM;
        f32x4 v[16]; float s = 0.f;
#pragma unroll
        for (int i = 0; i < 16; ++i) { v[i] = *(const f32x4*)(zr + i * 256 + lane * 4); s += (v[i][0] + v[i][1]) + (v[i][2] + v[i][3]); }
        s = wave_sum(s); const float mu = s * (1.0f / DM);
        float q = 0.f;
#pragma unroll
        for (int i = 0; i < 16; ++i) { const f32x4 d = v[i] - mu; q += (d[0] * d[0] + d[1] * d[1]) + (d[2] * d[2] + d[3] * d[3]); }
        q = wave_sum(q); const float rs = rsqrtf(q * (1.0f / DM) + LN_EPS);
        if (stats && lane == 0) stats[row] = (f32x2){mu, rs};
#pragma unroll
        for (int i = 0; i < 16; ++i) { const int c = i * 256 + lane * 4; const f32x4 gg = *(const f32x4*)(g + c), be = *(const f32x4*)(bb + c);
            const f32x4 y = (v[i] - mu) * rs * gg + be;
            if (outf) *(f32x4*)(outf + (size_t)row * DM + c) = y;
            if (outb) { u32x2 w; w.x = cvt_pk_bf16(y[0], y[1]); w.y = cvt_pk_bf16(y[2], y[3]); *(u32x2*)(outb + (size_t)row * DM + c) = w; } }
    }
}
__device__ __forceinline__ void p7_layernorm_b(const Args& a, int layer_idx, bool mix, const bf16_t* zb, float* outf, bf16_t* outb, f32x2* stats) {
    const int tid = threadIdx.x, lane = tid & 63, wid = tid >> 6;
    const int gw = blockIdx.x * 8 + wid, nw = gridDim.x * 8;
    const float* g = (mix ? a.in[22] : a.in[24]) + (size_t)layer_idx * DM; const float* bb = (mix ? a.in[23] : a.in[25]) + (size_t)layer_idx * DM;
    bf16x8 nx[8];
    if (gw < M_TOK) {
#pragma unroll
        for (int i = 0; i < 8; ++i) nx[i] = *(const bf16x8*)(zb + (size_t)gw * DM + i * 512 + lane * 8); }
    for (int row = gw; row < M_TOK; row += nw) {
        float v[8][8]; float s = 0.f;
#pragma unroll
        for (int i = 0; i < 8; ++i) { unpack8h(nx[i], v[i]); s += ((v[i][0] + v[i][1]) + (v[i][2] + v[i][3])) + ((v[i][4] + v[i][5]) + (v[i][6] + v[i][7])); }
        { const int rn = row + nw < M_TOK ? row + nw : row;
#pragma unroll
          for (int i = 0; i < 8; ++i) nx[i] = *(const bf16x8*)(zb + (size_t)rn * DM + i * 512 + lane * 8); }
        s = wave_sum(s); const float mu = s * (1.0f / DM);
        float q = 0.f;
#pragma unroll
        for (int i = 0; i < 8; ++i)
#pragma unroll
            for (int j = 0; j < 8; ++j) { const float d = v[i][j] - mu; q += d * d; }
        q = wave_sum(q); const float rs = rsqrtf(q * (1.0f / DM) + LN_EPS);
        if (stats && lane == 0) stats[row] = (f32x2){mu, rs};
#pragma unroll
        for (int i = 0; i < 8; ++i) { const int c = i * 512 + lane * 8; const f32x4 g0 = *(const f32x4*)(g + c), g1 = *(const f32x4*)(g + c + 4), b0 = *(const f32x4*)(bb + c), b1 = *(const f32x4*)(bb + c + 4);
            float y[8];
#pragma unroll
            for (int j = 0; j < 4; ++j) { y[j] = (v[i][j] - mu) * rs * g0[j] + b0[j]; y[4 + j] = (v[i][4 + j] - mu) * rs * g1[j] + b1[j]; }
            if (outf) { *(f32x4*)(outf + (size_t)row * DM + c) = (f32x4){y[0], y[1], y[2], y[3]}; *(f32x4*)(outf + (size_t)row * DM + c + 4) = (f32x4){y[4], y[5], y[6], y[7]}; }
            if (outb) *(bf16x8*)(outb + (size_t)row * DM + c) = pack8f(y); }
    }
}
__device__ __forceinline__ void p12_blocks(const Args& a) {
    const bf16_t* projc = (const bf16_t*)(a.ws + WS_R);
    const size_t gt = (size_t)blockIdx.x * NTHREADS + threadIdx.x, gs = (size_t)gridDim.x * NTHREADS;
    for (size_t i = gt; i < (size_t)2 * 4096 * 512; i += gs) {
        const int which = (int)(i / ((size_t)4096 * 512)); const int rem = (int)(i % ((size_t)4096 * 512));
        const int r = rem >> 9, l = (rem >> 4) & 31, d8 = rem & 15, g = r & 3, n = (r >> 2) & 255, b = r >> 10;
        bf16_t* A = (bf16_t*)(a.ws + (which ? WS_AV : WS_AK)); const float* pe = which ? a.in[13] : a.in[12];
        float f[8];
        if (n < 255) { unpack8(*(const bf16x8*)(projc + (size_t)(b * SEQ + 16 * n + l) * C_NP + (which ? C_VC : C_KC) + g * 128 + d8 * 8), f);
#pragma unroll
            for (int j = 0; j < 8; ++j) f[j] += pe[l * 128 + d8 * 8 + j]; }
        else {
#pragma unroll
            for (int j = 0; j < 8; ++j) f[j] = 0.f; }
        *(bf16x8*)(A + (size_t)r * 4096 + l * 128 + d8 * 8) = pack8f(f);
    }
}
__device__ __forceinline__ float nsa_gate(const Args& a, int token, int br, int head) {
    const bf16_t* projc = (const bf16_t*)(a.ws + WS_R);
    return sigmoid_f(bf2f(projc[(size_t)token * C_NP + C_GATE + br * 32 + head]) + a.in[11][br * 32 + head]);
}
__device__ __forceinline__ void p15_cmp_attn(char* lds, const Args& a) {
    const int tid = threadIdx.x, wid = __builtin_amdgcn_readfirstlane(tid >> 6), lane = tid & 63, r32 = lane & 31, hi = lane >> 5;
    const bf16_t* projc = (const bf16_t*)(a.ws + WS_R); const bf16_t* kcmp = (const bf16_t*)(a.ws + WS_KCMP); const bf16_t* vcmp = (const bf16_t*)(a.ws + WS_VCMP);
    float* acc = (float*)(a.ws + WS_Z); unsigned long long* selp = (unsigned long long*)(a.ws + WS_SEL);
    const float scale = 0.08838834764831845f, C2 = 1.4426950408889634f * scale;
    float* IMP = (float*)(lds + fa::OFF_IMP);
    for (int kk = 0; kk * (int)gridDim.x < 2048; ++kk) {
        const int unit = xcd_unit(kk, 8, 16, 128); if (unit >= 2048) break;
        const int bg = unit >> 7, xb = unit & 127, b = bg >> 2, g = bg & 3, t0 = xb * 32;
        const int tokl = wid * 4 + (r32 >> 3), head = g * 8 + (r32 & 7), tq = t0 + tokl;
        const bf16_t* qrow = projc + (size_t)(b * SEQ + tq) * C_NP + C_Q + head * 128;
        bf16x8 qr[8];
#pragma unroll
        for (int d0 = 0; d0 < 8; ++d0) qr[d0] = *(const bf16x8*)(qrow + d0 * 16 + hi * 8);
        fa::FUnit u; u.Kb = kcmp + (size_t)(b * 256 * 4 + g) * 256; u.ldk = 1024; u.Vb = vcmp + (size_t)(b * 256 * 4 + g) * 256; u.ldv = 1024; u.KRb = nullptr;
        const int nmax_hi = (t0 + 31 - 31) >> 4;
        u.j_lo = 0; u.j_hi = (nmax_hi >> 6) + 1; u.qlo = (t0 + wid * 4 - 31) >> 4; u.qhi = (t0 + wid * 4 + 3 - 31) >> 4; u.qpos = (tq - 31) >> 4; u.sel = 0ull;
        f32x16 o[4]; float m_reg, l_reg;
        fa::flash_core<3>(lds, u, qr, scale, o, m_reg, l_reg);
        const float inv_l = l_reg > 0.f ? 1.0f / l_reg : 0.f;
        { float rf[16]; fa::row_factors(lds, wid, r32, hi, inv_l * nsa_gate(a, b * SEQ + tq, 0, head), rf);
#pragma unroll
          for (int r = 0; r < 16; ++r) { const int orow = fa::crow(r, hi); const int tk = t0 + wid * 4 + (orow >> 3), hd = g * 8 + (orow & 7);
              float* op = acc + (size_t)(b * SEQ + tk) * DM + hd * 128 + r32;
#pragma unroll
              for (int d0 = 0; d0 < 4; ++d0) op[d0 * 32] = o[d0][r] * rf[r]; } }
        __syncthreads();
        const float mL = -m_reg * C2;
        const int sr = tid >> 4, sc = (tid & 15) * 8, kws = KSWZ(sr, sc * 2);
        for (int t = 0; t < u.j_hi; ++t) {
            const int kb = t * 64;
            const bf16x8 k0 = *(const bf16x8*)(u.Kb + (long)(kb + sr) * u.ldk + sc), k1 = *(const bf16x8*)(u.Kb + (long)(kb + 32 + sr) * u.ldk + sc);
            *(bf16x8*)(lds + fa::OFF_K + kws) = k0; *(bf16x8*)(lds + fa::OFF_K + kws + 32 * 256) = k1;
            __syncthreads();
            f32x16 p0, p1; fa::qkt<0, false, true>(p0, p1, lds, r32, hi, qr);
            fa::mask_tile(p0, p1, u.qpos - kb - 4 * hi, 0x80000000u);
#pragma unroll
            for (int r = 0; r < 16; ++r) {
                float a0 = __builtin_amdgcn_exp2f(fmaf(p0[r], C2, mL)) * inv_l, a1 = __builtin_amdgcn_exp2f(fmaf(p1[r], C2, mL)) * inv_l;
                a0 += dpp_xor1(a0); a0 += dpp_xor2(a0); a0 += dpp_hmir(a0);
                a1 += dpp_xor1(a1); a1 += dpp_xor2(a1); a1 += dpp_hmir(a1);
                if ((r32 & 7) == 0) { const int n = kb + fa::crow(r, hi); IMP[tokl * fa::IMP_LD + n] = a0; IMP[tokl * fa::IMP_LD + n + 32] = a1; }
            }
            __syncthreads();
        }
        for (int q4 = 0; q4 < 4; ++q4) {
            const int tl = wid * 4 + q4, tqq = t0 + tl, cur = tqq >> 6, s = lane;
            float v = 0.f;
#pragma unroll
            for (int dn = -1; dn <= 3; ++dn) { const int n = 4 * s + dn; if (n >= 0 && n <= 254 && n < u.j_hi * 64) v += IMP[tl * fa::IMP_LD + n]; }
            if (s == 0 || s == cur || s == cur - 1) v = 1e9f;
            if (s > cur) v = -1e30f;
            int rank = 0;
#pragma nounroll
            for (int j = 0; j < 64; ++j) { const float vj = __int_as_float(__builtin_amdgcn_readlane(__float_as_int(v), j)); rank += (vj > v || (vj == v && j < s)) ? 1 : 0; }
            const unsigned long long msk = __ballot(rank < 16);
            if (lane == 0) selp[(size_t)bg * SEQ + tqq] = msk;
        }
        __syncthreads();
    }
}
template <int MODE, int VAR = 0>
__device__ __forceinline__ void p16_nsa_attn(char* lds, const Args& a) {
    const int tid = threadIdx.x, wid = __builtin_amdgcn_readfirstlane(tid >> 6), lane = tid & 63, r32 = lane & 31, hi = lane >> 5;
    const bf16_t* projc = (const bf16_t*)(a.ws + WS_R); float* acc = (float*)(a.ws + WS_Z); bf16_t* hcat = (bf16_t*)a.out;
    const unsigned long long* selp = (const unsigned long long*)(a.ws + WS_SEL);
    const float scale = 0.08838834764831845f;
    const int nitems = (MODE == 2) ? 2048 : 2048;
    for (int kk = 0; kk * (int)gridDim.x < nitems; ++kk) {
        int bg, xb;
        if (MODE == 2) { const int pass = kk & 1, it2 = xcd_unit(kk >> 1, 4, 16, 64); if (it2 >= 1024) break; bg = it2 >> 6; const int x = it2 & 63; xb = pass ? 127 - x : x; }
        else { const int item = xcd_unit(kk, 8, 16, 128); if (item >= 2048) break; bg = item >> 7; xb = item & 127; }
        const int b = bg >> 2, g = bg & 3, t0 = xb * 32, head = g * 8 + wid, tq = t0 + r32;
        const bf16_t* qrow = projc + (size_t)(b * SEQ + tq) * C_NP + C_Q + head * 128;
        bf16x8 qr[8];
#pragma unroll
        for (int d0 = 0; d0 < 8; ++d0) qr[d0] = *(const bf16x8*)(qrow + d0 * 16 + hi * 8);
        fa::FUnit u; u.KRb = nullptr; u.ldk = C_NP; u.ldv = C_NP; u.qlo = t0; u.qhi = t0 + 31; u.qpos = tq; u.sel = 0ull;
        if (MODE == 1) { u.Kb = projc + (size_t)(b * SEQ) * C_NP + C_KW + g * 128; u.Vb = projc + (size_t)(b * SEQ) * C_NP + C_VW + g * 128;
            const int lowk = t0 - 511; u.j_lo = lowk > 0 ? lowk / 64 : 0; u.j_hi = (t0 + 31) / 64 + 1; }
        else { u.Kb = projc + (size_t)(b * SEQ) * C_NP + C_KS + g * 128; u.Vb = projc + (size_t)(b * SEQ) * C_NP + C_VS + g * 128;
            u.j_lo = 0; u.j_hi = (t0 + 31) / 64 + 1; u.sel = selp[(size_t)bg * SEQ + tq]; }
        f32x16 o[4]; float m_reg, l_reg;
#if FLASH2
        fa::flash_core2<MODE>(lds, u, qr, scale, o, m_reg, l_reg);
#else
        fa::flash_core<MODE, VAR>(lds, u, qr, scale, o, m_reg, l_reg);
#endif
        float rf[16]; fa::row_factors(lds, wid, r32, hi, nsa_gate(a, b * SEQ + tq, MODE == 1 ? 2 : 1, head) / l_reg, rf);
        if (VAR != 0) { float sink = 0.f; for (int d0 = 0; d0 < 4; ++d0) for (int r = 0; r < 16; ++r) sink += o[d0][r] * rf[r]; if (sink == 1.2345e-30f) acc[0] = sink; __syncthreads(); continue; }
        const size_t off0 = (size_t)(b * SEQ + t0 + 4 * hi) * DM + head * 128 + r32;
        float av[16][4];
#pragma unroll
        for (int r = 0; r < 16; ++r)
#pragma unroll
            for (int d0 = 0; d0 < 4; ++d0) av[r][d0] = acc[off0 + (size_t)((r & 3) + 8 * (r >> 2)) * DM + d0 * 32];
        asm volatile("" ::: "memory");
#pragma unroll
        for (int r = 0; r < 16; ++r) { const size_t off = off0 + (size_t)((r & 3) + 8 * (r >> 2)) * DM;
#pragma unroll
            for (int d0 = 0; d0 < 4; ++d0) { const float v = av[r][d0] + o[d0][r] * rf[r];
                if (MODE == 1) acc[off + d0 * 32] = v;
                else { const float vn = dpp_xor1(v); if ((r32 & 1) == 0) *(unsigned*)(hcat + off + d0 * 32) = cvt_pk_bf16(v, vn); } } }
        __syncthreads();
    }
}
__device__ __forceinline__ void p1617_nsa_attn(char* lds, const Args& a) {
    const int tid = threadIdx.x, wid = __builtin_amdgcn_readfirstlane(tid >> 6), lane = tid & 63, r32 = lane & 31, hi = lane >> 5;
    const bf16_t* projc = (const bf16_t*)(a.ws + WS_R); const float* acc = (const float*)(a.ws + WS_Z); bf16_t* hcat = (bf16_t*)a.out;
    const unsigned long long* selp = (const unsigned long long*)(a.ws + WS_SEL);
    const float scale = 0.08838834764831845f;
    unsigned* park = (unsigned*)(lds + fa::OFF_IMP) + wid * 2048 + lane;
    static_assert(fa::OFF_IMP + 8 * 8192 <= fa::LDS_END, "park region");
    for (int kk = 0; kk * (int)gridDim.x < 2048; ++kk) {
        const int pass = kk & 1, it2 = xcd_unit(kk >> 1, 4, 16, 64); if (it2 >= 1024) break;
        const int bg = it2 >> 6, x = it2 & 63, xb = pass ? 127 - x : x;
        const int b = bg >> 2, g = bg & 3, t0 = xb * 32, head = g * 8 + wid, tq = t0 + r32;
        const bf16_t* qrow = projc + (size_t)(b * SEQ + tq) * C_NP + C_Q + head * 128;
        bf16x8 qr[8];
#pragma unroll
        for (int d0 = 0; d0 < 8; ++d0) qr[d0] = *(const bf16x8*)(qrow + d0 * 16 + hi * 8);
        fa::FUnit u; u.KRb = nullptr; u.ldk = C_NP; u.ldv = C_NP; u.qlo = t0; u.qhi = t0 + 31; u.qpos = tq; u.sel = 0ull;
        f32x16 o[4]; float m_reg, l_reg; float rf[16];
        { u.Kb = projc + (size_t)(b * SEQ) * C_NP + C_KW + g * 128; u.Vb = projc + (size_t)(b * SEQ) * C_NP + C_VW + g * 128;
          const int lowk = t0 - 511; u.j_lo = lowk > 0 ? lowk / 64 : 0; u.j_hi = (t0 + 31) / 64 + 1; }
        fa::flash_core<1, 0>(lds, u, qr, scale, o, m_reg, l_reg);
        fa::row_factors(lds, wid, r32, hi, nsa_gate(a, b * SEQ + tq, 2, head) / l_reg, rf);
#pragma unroll
        for (int d0 = 0; d0 < 4; ++d0)
#pragma unroll
            for (int r = 0; r < 16; r += 2) park[(d0 * 8 + (r >> 1)) * 64] = cvt_pk_bf16(o[d0][r] * rf[r], o[d0][r + 1] * rf[r + 1]);
        __syncthreads();
        u.Kb = projc + (size_t)(b * SEQ) * C_NP + C_KS + g * 128; u.Vb = projc + (size_t)(b * SEQ) * C_NP + C_VS + g * 128;
        u.j_lo = 0; u.j_hi = (t0 + 31) / 64 + 1; u.sel = selp[(size_t)bg * SEQ + tq];
        fa::flash_core<2, 0>(lds, u, qr, scale, o, m_reg, l_reg);
        fa::row_factors(lds, wid, r32, hi, nsa_gate(a, b * SEQ + tq, 1, head) / l_reg, rf);
        const size_t off0 = (size_t)(b * SEQ + t0 + 4 * hi) * DM + head * 128 + r32;
        float av[16][4];
#pragma unroll
        for (int r = 0; r < 16; ++r)
#pragma unroll
            for (int d0 = 0; d0 < 4; ++d0) av[r][d0] = acc[off0 + (size_t)((r & 3) + 8 * (r >> 2)) * DM + d0 * 32];
        asm volatile("" ::: "memory");
#pragma unroll
        for (int r = 0; r < 16; r += 2) {
#pragma unroll
            for (int d0 = 0; d0 < 4; ++d0) { const unsigned pw = park[(d0 * 8 + (r >> 1)) * 64];
#pragma unroll
                for (int e = 0; e < 2; ++e) { const int rr = r + e; const size_t off = off0 + (size_t)((rr & 3) + 8 * (rr >> 2)) * DM;
                    const float v = av[rr][d0] + __uint_as_float(e ? (pw & 0xffff0000u) : (pw << 16)) + o[d0][rr] * rf[rr];
                    const float vn = dpp_xor1(v); if ((r32 & 1) == 0) *(unsigned*)(hcat + off + d0 * 32) = cvt_pk_bf16(v, vn); } } }
        __syncthreads();
    }
}
__device__ __forceinline__ void p15_17_nsa(char* lds, const Args& a) {
    const int tid = threadIdx.x, wid = __builtin_amdgcn_readfirstlane(tid >> 6), lane = tid & 63;
    const bf16_t* projc = (const bf16_t*)(a.ws + WS_R); const bf16_t* kcmp = (const bf16_t*)(a.ws + WS_KCMP); const bf16_t* vcmp = (const bf16_t*)(a.ws + WS_VCMP); bf16_t* hcat = (bf16_t*)a.out;
    const float scale = 0.08838834764831845f, C2 = 1.4426950408889634f * scale;
    constexpr int ILD = 256;
    float* IMP = (float*)(lds + fa::OFF_V);
    unsigned long long* SELM = (unsigned long long*)(lds + fa::OFF_KR);
    char* PARK = lds + fa::OFF_IMP;
    static_assert(fa::OFF_IMP + 8 * 8192 <= fa::LDS_END, "park region");
    for (int kk = 0; kk * (int)gridDim.x < 2048; ++kk) {
        int lk = lane; asm volatile("" : "+v"(lk));
        const int pass = kk & 1, it2 = xcd_unit(kk >> 1, 4, 16, 64); if (it2 >= 1024) break;
        const int bg = it2 >> 6, x = it2 & 63, xb = pass ? 127 - x : x;
        const int b = bg >> 2, g = bg & 3, t0 = xb * 32;
        f32x16 o[4]; float m_reg, l_reg; float rf[16];
        fa::FUnit u;
        {
        const int tokl = wid * 4 + ((lk & 31) >> 3), head = g * 8 + (lk & 7), tq = t0 + tokl;
        const bf16_t* qrow = projc + (size_t)(b * SEQ + tq) * C_NP + C_Q + head * 128;
        bf16x8 qr[8];
#pragma unroll
        for (int d0 = 0; d0 < 8; ++d0) qr[d0] = *(const bf16x8*)(qrow + d0 * 16 + (lk >> 5) * 8);
        u.Kb = kcmp + (size_t)(b * 256 * 4 + g) * 256; u.ldk = 1024; u.Vb = vcmp + (size_t)(b * 256 * 4 + g) * 256; u.ldv = 1024; u.KRb = nullptr;
        const int nmax_hi = (t0 + 31 - 31) >> 4;
        u.j_lo = 0; u.j_hi = (nmax_hi >> 6) + 1; u.qlo = (t0 + wid * 4 - 31) >> 4; u.qhi = (t0 + wid * 4 + 3 - 31) >> 4; u.qpos = (tq - 31) >> 4; u.sel = 0ull;
        fa::flash_core<3>(lds, u, qr, scale, o, m_reg, l_reg);
        int lo_ = lk; asm volatile("" : "+v"(lo_));
        const int r32 = lo_ & 31, hi = lo_ >> 5;
        const float inv_l = l_reg > 0.f ? 1.0f / l_reg : 0.f;
        fa::row_factors(lds, wid, r32, hi, inv_l * nsa_gate(a, b * SEQ + tq, 0, head), rf);
#pragma unroll
        for (int r = 0; r < 16; ++r) { const int orow = fa::crow(r, hi); char* pp = PARK + (orow & 7) * 8192 + (wid * 4 + (orow >> 3)) * 256 + r32 * 2;
#pragma unroll
            for (int d0 = 0; d0 < 4; ++d0) { const float v = o[d0][r] * rf[r]; const float vn = dpp_xor1(v); if ((r32 & 1) == 0) *(unsigned*)(pp + d0 * 64) = cvt_pk_bf16(v, vn); } }
        __syncthreads();
        const float mL = -m_reg * C2;
        const int sr = tid >> 4, sc = (tid & 15) * 8, kws = KSWZ(sr, sc * 2);
        bf16x8 k0 = *(const bf16x8*)(u.Kb + (long)sr * u.ldk + sc), k1 = *(const bf16x8*)(u.Kb + (long)(32 + sr) * u.ldk + sc);
        for (int t = 0; t < u.j_hi; ++t) {
            const int kb = t * 64;
            *(bf16x8*)(lds + fa::OFF_K + kws) = k0; *(bf16x8*)(lds + fa::OFF_K + kws + 32 * 256) = k1;
            __syncthreads();
            { const int kn = (t + 1 < u.j_hi ? t + 1 : t) * 64;
              k0 = *(const bf16x8*)(u.Kb + (long)(kn + sr) * u.ldk + sc); k1 = *(const bf16x8*)(u.Kb + (long)(kn + 32 + sr) * u.ldk + sc); }
            f32x16 p0, p1; fa::qkt<0, false, true>(p0, p1, lds, r32, hi, qr);
            fa::mask_tile(p0, p1, u.qpos - kb - 4 * hi, 0x80000000u);
#pragma unroll
            for (int r = 0; r < 16; ++r) {
                float a0 = __builtin_amdgcn_exp2f(fmaf(p0[r], C2, mL)) * inv_l, a1 = __builtin_amdgcn_exp2f(fmaf(p1[r], C2, mL)) * inv_l;
                a0 += dpp_xor1(a0); a0 += dpp_xor2(a0); a0 += dpp_hmir(a0);
                a1 += dpp_xor1(a1); a1 += dpp_xor2(a1); a1 += dpp_hmir(a1);
                if ((r32 & 7) == 0) { const int n = kb + fa::crow(r, hi); IMP[tokl * ILD + n] = a0; IMP[tokl * ILD + n + 32] = a1; }
            }
            __syncthreads();
        }
        for (int q4 = 0; q4 < 4; ++q4) {
            const int tl = wid * 4 + q4, tqq = t0 + tl, cur = tqq >> 6, sb = lk;
            float v = 0.f;
#pragma unroll
            for (int dn = -1; dn <= 3; ++dn) { const int n = 4 * sb + dn; if (n >= 0 && n <= 254 && n < u.j_hi * 64) v += IMP[tl * ILD + n]; }
            if (sb == 0 || sb == cur || sb == cur - 1) v = 1e9f;
            if (sb > cur) v = -1e30f;
            unsigned key = __float_as_uint(v); key = (key & 0x80000000u) ? ~key : (key | 0x80000000u); key = (key & 0xFFFFFFC0u) | (unsigned)(63 - sb);
            int rank = 0;
#pragma unroll 8
            for (int j = 0; j < 64; ++j) { const unsigned kj = (unsigned)__builtin_amdgcn_readlane((int)key, j); rank += (kj > key) ? 1 : 0; }
            const unsigned long long msk = __ballot(rank < 16);
            if (lk == 0) SELM[tl] = msk;
        }
        __syncthreads();
        }
        const int head = g * 8 + wid, tq = t0 + (lk & 31);
        const bf16_t* qrow = projc + (size_t)(b * SEQ + tq) * C_NP + C_Q + head * 128;
        bf16x8 qr[8];
#pragma unroll
        for (int d0 = 0; d0 < 8; ++d0) qr[d0] = *(const bf16x8*)(qrow + d0 * 16 + (lk >> 5) * 8);
        u.KRb = nullptr; u.ldk = C_NP; u.ldv = C_NP; u.qlo = t0; u.qhi = t0 + 31; u.qpos = tq; u.sel = 0ull;
        { u.Kb = projc + (size_t)(b * SEQ) * C_NP + C_KW + g * 128; u.Vb = projc + (size_t)(b * SEQ) * C_NP + C_VW + g * 128;
          const int lowk = t0 - 511; u.j_lo = lowk > 0 ? lowk / 64 : 0; u.j_hi = (t0 + 31) / 64 + 1; }
        fa::flash_core<1, 0>(lds, u, qr, scale, o, m_reg, l_reg);
        int lw_ = lk; asm volatile("" : "+v"(lw_));
        { const int r32 = lw_ & 31, hi = lw_ >> 5;
        fa::row_factors(lds, wid, r32, hi, nsa_gate(a, b * SEQ + tq, 2, head) / l_reg, rf);
        char* pw_ = PARK + wid * 8192 + (4 * hi) * 256 + (r32 & ~1) * 2;
#pragma unroll
        for (int r = 0; r < 16; ++r)
#pragma unroll
            for (int d0 = 0; d0 < 4; ++d0) { const float v = o[d0][r] * rf[r]; const float vn = dpp_xor1(v);
                if ((r32 & 1) == 0) { unsigned* q_ = (unsigned*)(pw_ + ((r & 3) + 8 * (r >> 2)) * 256 + d0 * 64); const unsigned pw = *q_;
                    *q_ = cvt_pk_bf16(__uint_as_float(pw << 16) + v, __uint_as_float(pw & 0xffff0000u) + vn); } } }
        __syncthreads();
        u.Kb = projc + (size_t)(b * SEQ) * C_NP + C_KS + g * 128; u.Vb = projc + (size_t)(b * SEQ) * C_NP + C_VS + g * 128;
        u.j_lo = 0; u.j_hi = (t0 + 31) / 64 + 1; u.sel = SELM[lk & 31];
        fa::flash_core<2, 0>(lds, u, qr, scale, o, m_reg, l_reg);
        int ls_ = lk; asm volatile("" : "+v"(ls_));
        const int r32 = ls_ & 31, hi = ls_ >> 5;
        fa::row_factors(lds, wid, r32, hi, nsa_gate(a, b * SEQ + tq, 1, head) / l_reg, rf);
        char* pw_ = PARK + wid * 8192 + (4 * hi) * 256 + (r32 & ~1) * 2;
        bf16_t* ob = hcat + (size_t)(b * SEQ + t0 + 4 * hi) * DM + head * 128 + (r32 & ~1);
#pragma unroll
        for (int r = 0; r < 16; ++r)
#pragma unroll
            for (int d0 = 0; d0 < 4; ++d0) { const float v = o[d0][r] * rf[r]; const float vn = dpp_xor1(v);
                if ((r32 & 1) == 0) { const unsigned pw = *(const unsigned*)(pw_ + ((r & 3) + 8 * (r >> 2)) * 256 + d0 * 64);
                    *(unsigned*)(ob + (size_t)((r & 3) + 8 * (r >> 2)) * DM + d0 * 32) = cvt_pk_bf16(__uint_as_float(pw << 16) + v, __uint_as_float(pw & 0xffff0000u) + vn); } }
        __syncthreads();
    }
}


#ifndef DEBUG_CMP
#define DEBUG_CMP -1
#endif
#if DEBUG_CMP >= 0
__device__ __forceinline__ void dbg_copy(const Args& a) {
    const bf16_t* hcat = (const bf16_t*)(a.ws + WS_XB); bf16_t* dbg = (bf16_t*)(a.ws + WS_Z);
    const size_t gt = (size_t)blockIdx.x * NTHREADS + threadIdx.x, gs = (size_t)gridDim.x * NTHREADS;
    for (size_t i = gt; i < (size_t)M_TOK * 256; i += gs) { const size_t row = i >> 8, c8 = i & 255; *(bf16x8*)(dbg + row * 2048 + c8 * 8) = *(const bf16x8*)(hcat + row * DM + c8 * 8); }
}
__device__ __forceinline__ void dbg_compare(const Args& a) {
    const bf16_t* hcat = (const bf16_t*)(a.ws + WS_XB); const bf16_t* dbg = (const bf16_t*)(a.ws + WS_Z);
    float* accum = (float*)(a.ws + WS_CTL + 32 * 1024);
    const size_t gt = (size_t)blockIdx.x * NTHREADS + threadIdx.x, gs = (size_t)gridDim.x * NTHREADS;
    float sd = 0.f, sr = 0.f;
    for (size_t i = gt; i < (size_t)M_TOK * 256; i += gs) { const size_t row = i >> 8, c8 = i & 255; const int t = (int)(row & (SEQ - 1));
        bool in = false;
        if (DEBUG_CMP == 0) in = t < 32; if (DEBUG_CMP == 1) in = t >= 32 && t < 64; if (DEBUG_CMP == 2) in = t >= 64 && t < 128; if (DEBUG_CMP == 3) in = true;
        if (DEBUG_CMP == 4) in = (t & 63) < 32; if (DEBUG_CMP == 5) in = (t & 63) >= 32;
        if (!in) continue;
        float x[8], y[8]; unpack8(*(const bf16x8*)(hcat + row * DM + c8 * 8), x); unpack8(*(const bf16x8*)(dbg + row * 2048 + c8 * 8), y);
#pragma unroll
        for (int j = 0; j < 8; ++j) { const float d = x[j] - y[j]; sd += d * d; sr += x[j] * x[j]; } }
    sd = wave_sum(sd); sr = wave_sum(sr);
    if ((threadIdx.x & 63) == 0) { atomicAdd((unsigned long long*)accum, (unsigned long long)(sd * 1048576.0f)); atomicAdd((unsigned long long*)accum + 1, (unsigned long long)(sr * 1048576.0f)); }
}
#endif

constexpr int N_PHASES = 23;
__global__ void __launch_bounds__(NTHREADS, 2) fwd(Args args) {
    extern __shared__ __attribute__((aligned(16))) unsigned char shm[];
    char* lds = (char*)shm;
    PG8_LAS unsigned char* ldsg = (PG8_LAS unsigned char*)shm;
    unsigned char* ws = args.ws;
    if (threadIdx.x < 64) ((volatile LAS unsigned*)(ldsg + LDS_CTL_OFF))[threadIdx.x] = 0u;
    __syncthreads();
    XcdBarrier bar = xcd_barrier_post((unsigned*)(ws + WS_CTL), (volatile LAS unsigned*)(ldsg + LDS_CTL_OFF));
    const int lo = args.ph_lo, hi = args.ph_hi, G = gridDim.x, bx = blockIdx.x;
#define IN(k) (lo <= (k) && (k) < hi)
#define SEAM(k) do { if (IN(k) && IN((k) + 1)) xcd_barrier(bar); } while (0)
#define GEMMC(EPI, cidx, Aoff, Boff, Mr, Nr, Kr, ...) do { pg8::Gemm g_{(const pg8::bf16_t*)(ws + (Aoff)), (const pg8::bf16_t*)(ws + (Boff)), (Mr), (Nr), (Kr)}; pg8::StaticOrder S_; S_.init((Mr), (Nr), G, (cidx)); S_.WGM = GEMM_WGM; \
        EPI E_{__VA_ARGS__}; pg8::gemm_phase<EPI, pg8::StaticOrder, true, true>(ldsg, g_, S_, E_); } while (0)
#define GEMM(EPI, ...) GEMMC(EPI, bx, __VA_ARGS__)
#define GEMMA(EPI, Aptr, Boff, Mr, Nr, Kr, ...) do { pg8::Gemm g_{(const pg8::bf16_t*)(Aptr), (const pg8::bf16_t*)(ws + (Boff)), (Mr), (Nr), (Kr)}; pg8::StaticOrder S_; S_.init((Mr), (Nr), G, bx); S_.WGM = GEMM_WGM; \
        EPI E_{__VA_ARGS__}; pg8::gemm_phase<EPI, pg8::StaticOrder, true, true>(ldsg, g_, S_, E_); } while (0)
#define GEMM_WGM gemm_wgm
    float* xres = args.out;
    bf16_t* xb = (bf16_t*)(ws + WS_XB); const bf16_t* hcat = (const bf16_t*)args.out; f32x2* stats = (f32x2*)(ws + WS_STATS);
    bf16_t* zA = (bf16_t*)(ws + WS_Z); bf16_t* zB = (bf16_t*)args.out + (size_t)M_TOK * DM; bf16_t* zC = zA; bf16_t* zD = zA + (size_t)M_TOK * DM;

#ifndef FFN_CHUNKED
#define FFN_CHUNKED 0
#endif
#ifndef WGM_IN
#define WGM_IN 8
#endif
#ifndef WGM_WO
#define WGM_WO 4
#endif
#ifndef WGM_UP
#define WGM_UP 8
#endif
#ifndef WGM_DOWN
#define WGM_DOWN 2
#endif
    int gemm_wgm = 8;
#ifndef PROBE_MASK
#define PROBE_MASK 0u
#endif
#define PB(k) (((PROBE_MASK) >> (k)) & 1u)
#define PH(k, ...) do { if (IN(k)) { __VA_ARGS__; if (PB(k)) { xcd_barrier(bar); __VA_ARGS__; } } SEAM(k); } while (0)
    PH(0, p0_prologue(lds, args));
    gemm_wgm = WGM_IN; PH(1, GEMM(pg8::EpiProj, WS_XB, W_AB, M_TOK, AB_NP, DM, (bf16_t*)(ws + WS_R), AB_NP, (float*)(ws + WS_GATES), AB_IG / 256); if (bx >= 192 && G == 256) transpose_late(lds, args, bx - 192));
    PH(2, p2_prep(lds, args));
    gemm_wgm = 8; if (IN(3)) { GEMM(pg8::EpiB<0>, WS_CQN, W_UQ, M_TOK, 3072, 1024, (bf16_t*)(ws + WS_QB), 3072); GEMM(pg8::EpiB<0>, WS_CKVN, W_UKV, M_TOK, 4096, 512, (bf16_t*)(ws + WS_KVB), 4096); }
    if (!(IN(3) && IN(4))) SEAM(3);
#if DEBUG_CMP >= 0
#if MC_VALU_STATE == 4
    PH(4, p4_mlstm_chunk(lds, args); xcd_barrier(bar); p4_mlstm(lds, args));
#else
    PH(4, p4_mlstm_chunk(lds, args); xcd_barrier(bar); dbg_copy(args); xcd_barrier(bar); p4_mlstm(lds, args); xcd_barrier(bar); dbg_compare(args));
#endif
#elif MLSTM_BOTH
    PH(4, p4_mlstm_chunk(lds, args); xcd_barrier(bar); p4_mlstm(lds, args));
#elif MLSTM_CHUNK
    PH(4, p4_mlstm_chunk(lds, args));
#else
    PH(4, p4_mlstm(lds, args));
#endif
    if (IN(5)) { p5_mlstm_norm(args); p5_mla(lds, args); if (PB(5)) { xcd_barrier(bar); p5_mla(lds, args); } } SEAM(5);
    gemm_wgm = WGM_WO; PH(6, GEMMA(pg8::EpiResidB, hcat, W_O0, M_TOK, DM, DM, zA, xb));
    PH(7, p7_layernorm_b(args, 0, true, zA, nullptr, xb, stats));
#if FFN_CHUNKED
#define FFN_UP(WGU, half) GEMM(pg8::EpiSwiGLU, WS_XB + (size_t)(half) * 8192 * DM * 2, WGU, 8192, GU_N, DM, (bf16_t*)(ws + WS_R) + (size_t)(half) * 8192 * FFH, FFH)
#define FFN_DOWN(WD, half, Cp, Zpp, lg, lb) GEMM(pg8::EpiResidLN, WS_R + (size_t)(half) * 8192 * FFH * 2, WD, 8192, DM, FFH, (Cp) + (size_t)(half) * 8192 * DM, (Zpp) + (size_t)(half) * 8192 * DM, stats + (half) * 8192, lg, lb, DM, DN_ALPHA)
    if (IN(8)) { gemm_wgm = WGM_UP; FFN_UP(W_GU0, 0); if (bx >= 192 && G == 256) transpose_late(lds, args, 64 + bx - 192); } SEAM(8);
    if (IN(9)) { gemm_wgm = WGM_DOWN; FFN_DOWN(W_D0, 0, xres, z, args.in[22], args.in[23]); gemm_wgm = WGM_UP; FFN_UP(W_GU0, 1); if (bx >= 192 && G == 256) transpose_late(lds, args, 128 + bx - 192);
                 xcd_barrier(bar); gemm_wgm = WGM_DOWN; FFN_DOWN(W_D0, 1, xres, z, args.in[22], args.in[23]); } SEAM(9);
#else
    gemm_wgm = WGM_UP; PH(8, GEMM(pg8::EpiSwiGLU, WS_XB, W_GU0, M_TOK, GU_N, DM, (bf16_t*)(ws + WS_R), FFH); if (bx >= 128 && G == 256) transpose_late(lds, args, 64 + bx - 128));
    gemm_wgm = WGM_DOWN; PH(9, GEMM(pg8::EpiResidLNB, WS_R, W_D0, M_TOK, DM, FFH, zB, zA, stats, args.in[22], args.in[23]));
#endif
    PH(10, p7_layernorm_b(args, 0, false, zB, nullptr, xb, stats));
    gemm_wgm = WGM_IN; PH(11, GEMM(pg8::EpiB<0>, WS_XB, W_C, M_TOK, C_NP, DM, (bf16_t*)(ws + WS_R), C_NP); if (bx >= 64 && G == 256) transpose_late(lds, args, 192 + bx - 64));
    PH(12, p12_blocks(args));
    gemm_wgm = 8; PH(13, GEMM(pg8::EpiB<1>, WS_AK, W_C1K, 4096, 256, 4096, (bf16_t*)(ws + WS_HK), 256);
           GEMMC(pg8::EpiB<1>, (bx + G - 16) % G, WS_AV, W_C1V, 4096, 256, 4096, (bf16_t*)(ws + WS_HV), 256);
           if (G == 256) { if (bx >= 32) transpose_late(lds, args, 384 + bx - 32); } else { for (int sl_ = bx; sl_ < LATE_SLOTS; sl_ += G) transpose_late(lds, args, sl_); for (int sl_ = bx; sl_ < LATE_D_SLOTS; sl_ += G) transpose_late_d(lds, args, sl_); });
    PH(14, GEMM(pg8::EpiB<0>, WS_HK, W_C2K, 4096, 256, 256, (bf16_t*)(ws + WS_KCMP), 256);
           GEMMC(pg8::EpiB<0>, (bx + G - 16) % G, WS_HV, W_C2V, 4096, 256, 256, (bf16_t*)(ws + WS_VCMP), 256));
#ifndef NSA_ALL
#define NSA_ALL 1
#endif
#if NSA_ALL
    if (IN(15)) { p15_17_nsa(lds, args); } SEAM(15);
#else
    if (IN(15)) { p15_cmp_attn(lds, args); } SEAM(15);
#ifndef NSA_MERGED
#define NSA_MERGED 1
#endif
#if NSA_MERGED
    if (IN(16)) { p1617_nsa_attn(lds, args); } SEAM(16);
#else
    if (IN(16)) { p16_nsa_attn<1>(lds, args); if (PB(16)) { xcd_barrier(bar); p15_cmp_attn(lds, args); xcd_barrier(bar); p16_nsa_attn<1>(lds, args); } } SEAM(16);
#ifndef PROBE_VAR
#define PROBE_VAR 0
#endif
    if (IN(17)) { p16_nsa_attn<2>(lds, args); if (PB(17)) { xcd_barrier(bar); p16_nsa_attn<2, PROBE_VAR>(lds, args); } } SEAM(17);
#endif
#endif
    gemm_wgm = WGM_WO; PH(18, GEMMA(pg8::EpiResidLNB, hcat, W_O1, M_TOK, DM, DM, zC, zB, stats, args.in[24], args.in[25]));
    PH(19, p7_layernorm_b(args, 1, true, zC, nullptr, xb, stats));
#if FFN_CHUNKED
    if (IN(20)) { gemm_wgm = WGM_UP; FFN_UP(W_GU1, 0); } SEAM(20);
    if (IN(21)) { gemm_wgm = WGM_DOWN; FFN_DOWN(W_D1, 0, xres, z, args.in[22] + DM, args.in[23] + DM); gemm_wgm = WGM_UP; FFN_UP(W_GU1, 1);
                  xcd_barrier(bar); gemm_wgm = WGM_DOWN; FFN_DOWN(W_D1, 1, xres, z, args.in[22] + DM, args.in[23] + DM); } SEAM(21);
#else
    gemm_wgm = WGM_UP; PH(20, GEMM(pg8::EpiSwiGLU, WS_XB, W_GU1, M_TOK, GU_N, DM, (bf16_t*)(ws + WS_R), FFH); if (bx >= 128 && G == 256) transpose_late_d(lds, args, bx - 128));
    gemm_wgm = WGM_DOWN; PH(21, GEMM(pg8::EpiResidLNB, WS_R, W_D1, M_TOK, DM, FFH, zD, zC, stats, args.in[22] + DM, args.in[23] + DM));
#endif
    PH(22, p7_layernorm_b(args, 1, false, zD, xres, nullptr, nullptr));
#if DEBUG_CMP >= 0
    if (IN(22)) { xcd_barrier(bar); if (bx == 0 && threadIdx.x == 0) { const unsigned long long* accum = (const unsigned long long*)(ws + WS_CTL + 32 * 1024); const float rel = sqrtf((float)((double)accum[0] / fmax((double)accum[1], 1.0)));
        float k = -20.0f * log10f(fmaxf(rel, 1e-6f)); k = fminf(fmaxf(rintf(k), 0.f), 89.f); xres[0] = 1000.0f + 100.0f * k; } }
#endif
#undef PH
#undef PB
#undef IN
#undef SEAM
#undef GEMM
#undef GEMMC
}

#ifndef MK_N_LAUNCHES
#define MK_N_LAUNCHES 1
#endif
extern "C" void kernel_launch(void* const* d_in, const int* in_sizes, int n_in, void* d_out, int out_size, void* d_ws, size_t ws_size, hipStream_t stream) {
    static int grid = 0;
    if (grid == 0) {
        if (n_in != 26 || in_sizes[0] != M_TOK * DM || out_size != M_TOK * DM || ws_size < WS_END) {
            fprintf(stderr, "kernel_launch: unexpected shapes (n_in %d, in0 %d, out %d, ws %zu, need %zu); nothing launched\n", n_in, n_in > 0 ? in_sizes[0] : -1, out_size, ws_size, (size_t)WS_END); grid = -1; return; }
        int dev = 0, cus = 0, per_cu = 0;
        if (hipGetDevice(&dev) != hipSuccess || hipDeviceGetAttribute(&cus, hipDeviceAttributeMultiprocessorCount, dev) != hipSuccess) { grid = -1; return; }
        if (hipFuncSetAttribute((const void*)fwd, hipFuncAttributeMaxDynamicSharedMemorySize, LDS_BYTES) != hipSuccess) { fprintf(stderr, "kernel_launch: hipFuncSetAttribute failed\n"); grid = -1; return; }
        if (hipOccupancyMaxActiveBlocksPerMultiprocessor(&per_cu, (const void*)fwd, NTHREADS, LDS_BYTES) != hipSuccess || per_cu < 1) { fprintf(stderr, "kernel_launch: occupancy query says %d blocks per CU\n", per_cu); (void)hipGetLastError(); grid = -1; return; }
        grid = cus;
    }
    if (grid < 0) return;
    (void)hipMemsetAsync((char*)d_ws + WS_CTL, 0, 64 * 1024, stream);
    Args a{};
    for (int i = 0; i < 26; ++i) a.in[i] = (const float*)d_in[i];
    a.out = (float*)d_out; a.ws = (unsigned char*)d_ws;
    unsigned char* ws = (unsigned char*)d_ws;
    const float* fg = a.in[19]; const float* fu = a.in[20]; const float* fd = a.in[21];
    const size_t LW = (size_t)DM * FFH;
    int j = 0;
    a.tj[j++] = TJob{a.in[1], nullptr, (bf16_t*)(ws + W_AB), DM, AB_IN, AB_NP, 0};
    a.tj[j++] = TJob{a.in[7], nullptr, (bf16_t*)(ws + W_UQ), 1024, 3072, 3072, 0};
    a.tj[j++] = TJob{a.in[8], nullptr, (bf16_t*)(ws + W_UKV), 512, 4096, 4096, 0};
    a.tj[j++] = TJob{a.in[9], nullptr, (bf16_t*)(ws + W_O0), DM, DM, DM, 0};
    a.tj[j++] = TJob{fg, fu, (bf16_t*)(ws + W_GU0), DM, FFH, GU_N, 1};
    a.tj[j++] = TJob{fd, nullptr, (bf16_t*)(ws + W_D0), FFH, DM, DM, 0};
    a.tj[j++] = TJob{a.in[10], nullptr, (bf16_t*)(ws + W_C), DM, C_IN, C_NP, 0};
    a.tj[j++] = TJob{a.in[14], nullptr, (bf16_t*)(ws + W_C1K), 4096, 256, 256, 0};
    a.tj[j++] = TJob{a.in[16], nullptr, (bf16_t*)(ws + W_C1V), 4096, 256, 256, 0};
    a.tj[j++] = TJob{a.in[15], nullptr, (bf16_t*)(ws + W_C2K), 256, 128, 256, 0};
    a.tj[j++] = TJob{a.in[17], nullptr, (bf16_t*)(ws + W_C2V), 256, 128, 256, 0};
    a.tj[j++] = TJob{a.in[18], nullptr, (bf16_t*)(ws + W_O1), DM, DM, DM, 0};
    a.tj[j++] = TJob{fg + LW, fu + LW, (bf16_t*)(ws + W_GU1), DM, FFH, GU_N, 1};
    a.tj[j++] = TJob{fd + LW, nullptr, (bf16_t*)(ws + W_D1), FFH, DM, DM, 0};
#if MK_N_LAUNCHES == 1
    a.ph_lo = 0; a.ph_hi = N_PHASES;
    hipLaunchKernelGGL(fwd, dim3(grid), dim3(NTHREADS), LDS_BYTES, stream, a);
#else
    for (int p = 0; p < N_PHASES; ++p) { a.ph_lo = p; a.ph_hi = p + 1; hipLaunchKernelGGL(fwd, dim3(grid), dim3(NTHREADS), LDS_BYTES, stream, a); }
#endif
    const hipError_t le = hipPeekAtLastError();
    if (le != hipSuccess) fprintf(stderr, "kernel_launch: launch failed: %s\n", hipGetErrorName(le));
}
```

```cpp
#include <hip/hip_runtime.h>
#include <stdint.h>
#include <stdio.h>
#ifndef FLASH2
#define FLASH2 0
#endif
#ifndef DEBUG_CMP
#define DEBUG_CMP -1
#endif
#ifndef MLSTM_BOTH
#define MLSTM_BOTH 0
#endif
#ifndef MLSTM_CHUNK
#define MLSTM_CHUNK 1
#endif

typedef unsigned short bf16_t;
typedef short bf16x8 __attribute__((ext_vector_type(8)));
typedef short s16x4 __attribute__((ext_vector_type(4)));
typedef float f32x2 __attribute__((ext_vector_type(2)));
typedef float f32x4 __attribute__((ext_vector_type(4)));
typedef float f32x16 __attribute__((ext_vector_type(16)));
typedef unsigned u32x2 __attribute__((ext_vector_type(2)));
typedef unsigned u32x4 __attribute__((ext_vector_type(4)));

constexpr int M_TOK = 16384, SEQ = 4096, NBATCH = 4, DM = 4096;
constexpr int AB_IN = 7752, AB_NP = 7936, C_IN = 7264, C_NP = 7424, FFH = 11008, GU_N = 22016;
constexpr float DN_ALPHA = 1.4142135623730951f;
constexpr float LN_EPS = 1e-5f, RMS_EPS = 1e-6f;
constexpr int AB_Q = 0, AB_K = 1024, AB_V = 2048, AB_IG = 4096, AB_FG = 4100, AB_OG = 4104, AB_CQ = 6152, AB_CKV = 7176, AB_KR = 7688;
constexpr int C_Q = 0, C_KC = 4096, C_VC = 4608, C_KS = 5120, C_VS = 5632, C_KW = 6144, C_VW = 6656, C_GATE = 7168;

__device__ __forceinline__ float bf2f(bf16_t b) { return __uint_as_float(((unsigned)b) << 16); }
__device__ __forceinline__ unsigned cvt_pk_bf16(float lo, float hi) { unsigned r; asm volatile("v_cvt_pk_bf16_f32 %0, %1, %2" : "=v"(r) : "v"(lo), "v"(hi)); return r; }
__device__ __forceinline__ bf16_t f2bf(float f) { return (bf16_t)(cvt_pk_bf16(f, 0.f) & 0xffffu); }
__device__ __forceinline__ void unpack8(const bf16x8 v, float (&f)[8]) {
#pragma unroll
    for (int j = 0; j < 8; ++j) f[j] = bf2f((bf16_t)v[j]);
}
__device__ __forceinline__ bf16x8 pack8f(const float (&f)[8]) {
    u32x4 w = {cvt_pk_bf16(f[0], f[1]), cvt_pk_bf16(f[2], f[3]), cvt_pk_bf16(f[4], f[5]), cvt_pk_bf16(f[6], f[7])};
    return *reinterpret_cast<bf16x8*>(&w);
}
typedef _Float16 f16x2_t __attribute__((ext_vector_type(2)));
__device__ __forceinline__ unsigned cvt_pk_f16(float lo, float hi) { const f16x2_t h = {(_Float16)lo, (_Float16)hi}; return __builtin_bit_cast(unsigned, h); }
__device__ __forceinline__ void unpack8h(const bf16x8 v, float (&f)[8]) {
#pragma unroll
    for (int j = 0; j < 8; ++j) f[j] = (float)__builtin_bit_cast(_Float16, (short)v[j]);
}
__device__ __forceinline__ bf16x8 pack8h(const float (&f)[8]) {
    u32x4 w = {cvt_pk_f16(f[0], f[1]), cvt_pk_f16(f[2], f[3]), cvt_pk_f16(f[4], f[5]), cvt_pk_f16(f[6], f[7])};
    return *reinterpret_cast<bf16x8*>(&w);
}
__device__ __forceinline__ float wave_sum(float v) {
#pragma unroll
    for (int o = 32; o >= 1; o >>= 1) v += __shfl_xor(v, o);
    return v;
}
__device__ __forceinline__ float sigmoid_f(float x) { return __builtin_amdgcn_rcpf(1.0f + __expf(-x)); }

#define XB_TMO      128
#define XB_XCNT(j)  (256  + 64 * (j))
#define XB_XSUB(j)  (1280 + 64 * (j))
#define XB_XGEN(j)  (2304 + 64 * (j))
#define XB_TOP      3328
#define XB_TOPGEN   3392
#define XCD_BAR_WORDS 3456
#define XB_SPIN_CAP (1u << 22)
#define LAS __attribute__((address_space(3)))

__device__ __forceinline__ unsigned xb_ld(unsigned* p)              { return __hip_atomic_load(p, __ATOMIC_RELAXED, __HIP_MEMORY_SCOPE_AGENT); }
__device__ __forceinline__ unsigned xb_add(unsigned* p, unsigned v) { return __hip_atomic_fetch_add(p, v, __ATOMIC_RELAXED, __HIP_MEMORY_SCOPE_AGENT); }
__device__ __forceinline__ unsigned xb_xcc_id() { return (unsigned)__builtin_amdgcn_s_getreg((3 << 11) | 20) & 0xFu; }
#define XB_SPIN(cond, bar) do { unsigned _sp = 0; while (cond) { __builtin_amdgcn_s_sleep(1); \
    if ((++_sp & 255u) == 0u) { if (xb_ld(&(bar)[XB_TMO])) break; if (_sp > XB_SPIN_CAP) { atomicAdd(&(bar)[XB_TMO], 1u); break; } } } } while (0)

struct XcdBarrier {
    unsigned* bar; unsigned x;
    volatile LAS unsigned* st;
};

__device__ __forceinline__ XcdBarrier xcd_barrier_post(unsigned* bar, volatile LAS unsigned* st) {
    XcdBarrier b; b.bar = bar; b.x = xb_xcc_id(); b.st = st;
    if (threadIdx.x == 0) (void)xb_add(&bar[XB_XCNT(b.x)], 1u);
    return b;
}
__device__ __forceinline__ void xcd_barrier_complete(unsigned* bar, unsigned x, unsigned& nloc, unsigned& nx) {
    const unsigned G = gridDim.x * gridDim.y * gridDim.z;
    unsigned sum, cnt, mine, sp = 0u;
    for (;;) {
        sum = 0u; cnt = 0u; mine = 0u;
#pragma unroll
        for (unsigned j = 0; j < 16; ++j) { const unsigned c = xb_ld(&bar[XB_XCNT(j)]); sum += c; cnt += (c > 0u) ? 1u : 0u; mine = (j == x) ? c : mine; }
        if (sum == G) break;
        __builtin_amdgcn_s_sleep(1);
        if ((++sp & 255u) == 0u) { if (xb_ld(&bar[XB_TMO])) break; if (sp > XB_SPIN_CAP) { atomicAdd(&bar[XB_TMO], 1u); break; } }
    }
    nloc = mine > 0u ? mine : 1u; nx = cnt > 0u ? cnt : 1u;
}

__device__ __forceinline__ void xcd_barrier(const XcdBarrier& b) {
    asm volatile("s_waitcnt vmcnt(0)" ::: "memory");
    __syncthreads();
    if (threadIdx.x == 0) {
        unsigned* bar = b.bar;
        __builtin_amdgcn_s_waitcnt(0);
        unsigned nloc = b.st[0], nx = b.st[1];
        if (nloc == 0u) { xcd_barrier_complete(bar, b.x, nloc, nx); b.st[0] = nloc; b.st[1] = nx; }
        const unsigned old = xb_add(&bar[XB_XSUB(b.x)], 1u);
        const unsigned gen = old / nloc;
        if (old + 1u == (gen + 1u) * nloc) {
            __builtin_amdgcn_fence(__ATOMIC_RELEASE, "agent");
            asm volatile("s_waitcnt vmcnt(0)" ::: "memory");
            const unsigned og = xb_add(&bar[XB_TOP], 1u);
            const unsigned tg = og / nx;
            if (og + 1u == (tg + 1u) * nx) xb_add(&bar[XB_TOPGEN], 1u);
            else XB_SPIN(xb_ld(&bar[XB_TOPGEN]) == tg, bar);
            __builtin_amdgcn_fence(__ATOMIC_ACQUIRE, "agent");
            xb_add(&bar[XB_XGEN(b.x)], 1u);
            asm volatile("s_waitcnt vmcnt(0)" ::: "memory");
        } else {
            XB_SPIN(xb_ld(&bar[XB_XGEN(b.x)]) == gen, bar);
            __builtin_amdgcn_fence(__ATOMIC_ACQUIRE, "agent");
            asm volatile("s_waitcnt vmcnt(0)" ::: "memory");
        }
    }
    __syncthreads();
}namespace pg8 {
#define PG8_LAS __attribute__((address_space(3)))
typedef unsigned short bf16_t;
typedef short bf16x8 __attribute__((ext_vector_type(8)));
typedef float f32x4 __attribute__((ext_vector_type(4)));
typedef unsigned u32x4 __attribute__((ext_vector_type(4)));
constexpr int BM = 256, BK = 64, HALF = 128, HTB = HALF * BK * 2  , STAGE_BYTES = 8 * HTB, NXCD = 8;

__host__ __device__ __forceinline__ int lds_byte(int r, int c) { const int st = (r >> 4) * 2 + (c >> 5), rr = r & 15, cc = c & 31, ob = rr * 64 + cc * 2; return st * 1024 + (ob ^ (((ob >> 9) & 1) << 5)); }
__host__ __device__ __forceinline__ void stage_rc(int b, int& R, int& C) { const int st = b / 1024, sb = b % 1024, swz = sb ^ (((sb >> 9) & 1) << 5); R = (st >> 1) * 16 + swz / 64; C = (st & 1) * 32 + (swz % 64) / 2; }
__host__ __device__ __forceinline__ int perm32(int rho) { const int n = rho >> 4, i = rho & 15; return 8 * (i >> 2) + 4 * n + (i & 3); }

struct Unit { int pm, pn; };
struct Gemm { const bf16_t* A; const bf16_t* Bt; int M, N, K; };

struct StaticOrder {
    int nM, nN, nwg, G, c, WGM = 8;
    __host__ __device__ void init(int M, int N, int G_, int c_) { nM = M / BM; nN = N / BM; nwg = nM * nN; G = G_; c = c_; }
    __host__ __device__ bool next(int i, Unit& u) const {
        const long L = (long)i * G + c; if (L >= nwg) return false;
        int wgid = (int)L; { const int q = nwg / NXCD, r = nwg % NXCD, xcd = wgid % NXCD, off = wgid / NXCD; wgid = (xcd < r ? xcd * (q + 1) : r * (q + 1) + (xcd - r) * q) + off; }
        const int nig = WGM * nN, gid = wgid / nig, fm = gid * WGM, gsz = (nM - fm) < WGM ? (nM - fm) : WGM;
        u.pm = fm + ((wgid % nig) % gsz); u.pn = (wgid % nig) / gsz; return true;
    }
    __device__ __forceinline__ void a_ready(const Unit&) const {}
    __device__ __forceinline__ void done(const Unit&) const {}
};
struct CountedOrder : StaticOrder {
    const unsigned* ready; unsigned need; unsigned* tmo;
    __device__ __forceinline__ void a_ready(const Unit& u) const {
        if (threadIdx.x < 64) {
            const unsigned long long t0 = __builtin_amdgcn_s_memrealtime(); unsigned polls = 0;
            while ((unsigned)__builtin_amdgcn_readfirstlane(__hip_atomic_load(ready + 64 * u.pm, __ATOMIC_RELAXED, __HIP_MEMORY_SCOPE_AGENT)) < need) {
                if ((++polls & 255u) == 0u && __builtin_amdgcn_readfirstlane(__hip_atomic_load(tmo, __ATOMIC_RELAXED, __HIP_MEMORY_SCOPE_AGENT)) != 0u) break;
                if (__builtin_amdgcn_s_memrealtime() - t0 > 2000000ull) {
                    if (threadIdx.x == 0) { unsigned expect = 0u; __hip_atomic_compare_exchange_strong(tmo + 1, &expect, 0x600u | (unsigned)(u.pm & 0xff), __ATOMIC_RELAXED, __ATOMIC_RELAXED, __HIP_MEMORY_SCOPE_AGENT); __hip_atomic_store(tmo, 1u, __ATOMIC_RELAXED, __HIP_MEMORY_SCOPE_AGENT); }
                    break; }
                __builtin_amdgcn_s_sleep(2); }
            __builtin_amdgcn_fence(__ATOMIC_ACQUIRE, "agent");
            asm volatile("s_waitcnt vmcnt(0)" ::: "memory");
        }
#if !defined(BROKEN_HOOK_NO_BARRIER)
        asm volatile("" ::: "memory"); __builtin_amdgcn_s_barrier(); asm volatile("" ::: "memory");
#endif
    }
};

__device__ __forceinline__ unsigned cvt_pk_bf16(float lo, float hi) { unsigned r; asm volatile("v_cvt_pk_bf16_f32 %0, %1, %2" : "=v"(r) : "v"(lo), "v"(hi)); return r; }
typedef float f32x2 __attribute__((ext_vector_type(2)));
__device__ __forceinline__ f32x2 gelu_pk(f32x2 v) {
    const f32x2 av = __builtin_elementwise_abs(v), d = av * 0.2316418882f + 1.0f;
    f32x2 t; t.x = __builtin_amdgcn_rcpf(d.x); t.y = __builtin_amdgcn_rcpf(d.y);
    f32x2 q = t * 0.5307027145f + (-0.7265760135f); q = q * t + 0.7107068705f; q = q * t + (-0.142248368f); q = q * t + 0.127414796f; q = q * t;
    const f32x2 s = (v * v) * (-0.72134752044f);
    f32x2 e; e.x = __builtin_amdgcn_exp2f(s.x); e.y = __builtin_amdgcn_exp2f(s.y);
    const f32x2 m = v * (q * e), r = v - m;
    f32x2 o; o.x = v.x < 0.f ? m.x : r.x; o.y = v.y < 0.f ? m.y : r.y; return o;
}

struct EpiF32 {
    static constexpr bool PERM = false, AFTER_DRAIN = false, PREFETCH = false;
    float* C; int ldc; const float* bias;
    __device__ __forceinline__ void operator()(const f32x4 (&acc)[2][2][4][2], const Unit& u, int wr, int wc, int fr, int fq) const {
        const int row0 = u.pm * BM + wr * 64 + fr, col0 = u.pn * BM + wc * 32 + 4 * fq;
        f32x4 bv[2][2];
#pragma unroll
        for (int bj = 0; bj < 2; ++bj)
#pragma unroll
            for (int n = 0; n < 2; ++n) bv[bj][n] = bias ? *(const f32x4*)(bias + col0 + bj * HALF + n * 16) : (f32x4){0.f, 0.f, 0.f, 0.f};
#pragma unroll
        for (int ai = 0; ai < 2; ++ai)
#pragma unroll
            for (int m = 0; m < 4; ++m) { float* rowp = C + (size_t)(row0 + ai * HALF + m * 16) * ldc + col0;
#pragma unroll
                for (int bj = 0; bj < 2; ++bj)
#pragma unroll
                    for (int n = 0; n < 2; ++n) *(f32x4*)(rowp + bj * HALF + n * 16) = acc[ai][bj][m][n] + bv[bj][n]; }
    }
};
template <int ACT  > struct EpiBf16 {
    static constexpr bool PERM = true, AFTER_DRAIN = false, PREFETCH = false;
    bf16_t* O; int ldc; const float* bias; int split_cols; size_t split_stride;
    __device__ __forceinline__ void operator()(const f32x4 (&acc)[2][2][4][2], const Unit& u, int wr, int wc, int fr, int fq) const {
        const int row0 = u.pm * BM + wr * 64 + fr; int colt = u.pn * BM; bf16_t* base = O;
        if (split_cols) { const int t = colt / split_cols; base += (size_t)t * split_stride; colt -= t * split_cols; }
        const int col0 = colt + wc * 32 + 8 * fq, bcol0 = u.pn * BM + wc * 32 + 8 * fq;
        f32x4 bv[2][2];
#pragma unroll
        for (int bj = 0; bj < 2; ++bj)
#pragma unroll
            for (int n = 0; n < 2; ++n) bv[bj][n] = bias ? *(const f32x4*)(bias + bcol0 + bj * HALF + 4 * n) : (f32x4){0.f, 0.f, 0.f, 0.f};
#pragma unroll
        for (int ai = 0; ai < 2; ++ai)
#pragma unroll
            for (int m = 0; m < 4; ++m) { bf16_t* rowp = base + (size_t)(row0 + ai * HALF + m * 16) * ldc + col0;
#pragma unroll
                for (int bj = 0; bj < 2; ++bj) { f32x4 v0 = acc[ai][bj][m][0] + bv[bj][0], v1 = acc[ai][bj][m][1] + bv[bj][1];
                    if (ACT == 1) { f32x2 a = gelu_pk((f32x2){v0[0], v0[1]}), b = gelu_pk((f32x2){v0[2], v0[3]}), c = gelu_pk((f32x2){v1[0], v1[1]}), d = gelu_pk((f32x2){v1[2], v1[3]});
                        v0 = (f32x4){a.x, a.y, b.x, b.y}; v1 = (f32x4){c.x, c.y, d.x, d.y}; }
                    if (ACT == 2) {
#pragma unroll
                        for (int j = 0; j < 4; ++j) { v0[j] = 0.5f * v0[j] * (1.0f + erff(v0[j] * 0.70710678f)); v1[j] = 0.5f * v1[j] * (1.0f + erff(v1[j] * 0.70710678f)); } }
                    u32x4 w; w.x = cvt_pk_bf16(v0[0], v0[1]); w.y = cvt_pk_bf16(v0[2], v0[3]); w.z = cvt_pk_bf16(v1[0], v1[1]); w.w = cvt_pk_bf16(v1[2], v1[3]);
                    *(u32x4*)(rowp + bj * HALF) = w; } }
    }
};
#ifndef EPI_PREFETCH
#define EPI_PREFETCH false
#endif
#ifndef EPI_PF_TILES
#define EPI_PF_TILES 16
#endif
__device__ __forceinline__ float silu_f(float g) { return g * __builtin_amdgcn_rcpf(1.0f + __expf(-g)); }
__device__ __forceinline__ float gelu_tanh_f(float x) { const float y = 0.7978845608028654f * (x + 0.044715f * x * x * x); const float e = __expf(2.0f * y); const float t = 1.0f - 2.0f * __builtin_amdgcn_rcpf(e + 1.0f); return 0.5f * x * (1.0f + t); }
template <int ACT> struct EpiB {
    static constexpr bool PERM = true, AFTER_DRAIN = false, PREFETCH = false;
    bf16_t* O; int ldc;
    __device__ __forceinline__ void operator()(const f32x4 (&acc)[2][2][4][2], const Unit& u, int wr, int wc, int fr, int fq) const {
        const int row0 = u.pm * BM + wr * 64 + fr, col0 = u.pn * BM + wc * 32 + 8 * fq;
        float one = 1.0f; asm volatile("" : "+v"(one));
#pragma unroll
        for (int ai = 0; ai < 2; ++ai)
#pragma unroll
            for (int m = 0; m < 4; ++m) { bf16_t* rowp = O + (size_t)(row0 + ai * HALF + m * 16) * ldc + col0;
#pragma unroll
                for (int bj = 0; bj < 2; ++bj) { f32x4 v0 = acc[ai][bj][m][0] * one, v1 = acc[ai][bj][m][1] * one;
                    if (ACT == 1) {
#pragma unroll
                        for (int j = 0; j < 4; ++j) { v0[j] = gelu_tanh_f(v0[j]); v1[j] = gelu_tanh_f(v1[j]); } }
                    u32x4 w; w.x = cvt_pk_bf16(v0[0], v0[1]); w.y = cvt_pk_bf16(v0[2], v0[3]); w.z = cvt_pk_bf16(v1[0], v1[1]); w.w = cvt_pk_bf16(v1[2], v1[3]);
                    *(u32x4*)(rowp + bj * HALF) = w; } }
    }
};
struct EpiProj {
    static constexpr bool PERM = true, AFTER_DRAIN = false, PREFETCH = false;
    bf16_t* O; int ldc; float* gates; int gate_pn;
    __device__ __forceinline__ void operator()(const f32x4 (&acc)[2][2][4][2], const Unit& u, int wr, int wc, int fr, int fq) const {
        const int row0 = u.pm * BM + wr * 64 + fr, col0 = u.pn * BM + wc * 32 + 8 * fq;
        float one = 1.0f; asm volatile("" : "+v"(one));
#pragma unroll
        for (int ai = 0; ai < 2; ++ai)
#pragma unroll
            for (int m = 0; m < 4; ++m) { bf16_t* rowp = O + (size_t)(row0 + ai * HALF + m * 16) * ldc + col0;
#pragma unroll
                for (int bj = 0; bj < 2; ++bj) { const f32x4 v0 = acc[ai][bj][m][0] * one, v1 = acc[ai][bj][m][1] * one;
                    u32x4 w; w.x = cvt_pk_bf16(v0[0], v0[1]); w.y = cvt_pk_bf16(v0[2], v0[3]); w.z = cvt_pk_bf16(v1[0], v1[1]); w.w = cvt_pk_bf16(v1[2], v1[3]);
                    *(u32x4*)(rowp + bj * HALF) = w; } }
        if (u.pn == gate_pn && wc == 0 && fq == 0) {
#pragma unroll
            for (int ai = 0; ai < 2; ++ai)
#pragma unroll
                for (int m = 0; m < 4; ++m) { float* g = gates + (size_t)(row0 + ai * HALF + m * 16) * 8;
                    *(f32x4*)g = acc[ai][0][m][0]; *(f32x4*)(g + 4) = acc[ai][0][m][1]; }
        }
    }
};
struct EpiSwiGLU {
    static constexpr bool PERM = true, AFTER_DRAIN = false, PREFETCH = false;
    bf16_t* H; int ldh;
    __device__ __forceinline__ void operator()(const f32x4 (&acc)[2][2][4][2], const Unit& u, int wr, int wc, int fr, int fq) const {
        const int row0 = u.pm * BM + wr * 64 + fr, col0 = u.pn * HALF + wc * 32 + 8 * fq;
#pragma unroll
        for (int ai = 0; ai < 2; ++ai)
#pragma unroll
            for (int m = 0; m < 4; ++m) { bf16_t* rowp = H + (size_t)(row0 + ai * HALF + m * 16) * ldh + col0;
                const f32x4 g0 = acc[ai][0][m][0], g1 = acc[ai][0][m][1], u0 = acc[ai][1][m][0], u1 = acc[ai][1][m][1];
                float h[8];
#pragma unroll
                for (int j = 0; j < 4; ++j) { h[j] = silu_f(g0[j]) * u0[j]; h[4 + j] = silu_f(g1[j]) * u1[j]; }
                u32x4 w; w.x = cvt_pk_bf16(h[0], h[1]); w.y = cvt_pk_bf16(h[2], h[3]); w.z = cvt_pk_bf16(h[4], h[5]); w.w = cvt_pk_bf16(h[6], h[7]);
                *(u32x4*)rowp = w; }
    }
};
struct EpiResid {
    static constexpr bool PERM = false, AFTER_DRAIN = false, PREFETCH = false;
    float* C; const float* R; int ldc; float alpha;
    __device__ __forceinline__ void operator()(const f32x4 (&acc)[2][2][4][2], const Unit& u, int wr, int wc, int fr, int fq) const {
        const int row0 = u.pm * BM + wr * 64 + fr, col0 = u.pn * BM + wc * 32 + 4 * fq;
#pragma unroll
        for (int ai = 0; ai < 2; ++ai) {
            f32x4 r[4][2][2];
#pragma unroll
            for (int m = 0; m < 4; ++m) { const size_t off = (size_t)(row0 + ai * HALF + m * 16) * ldc + col0;
#pragma unroll
                for (int bj = 0; bj < 2; ++bj)
#pragma unroll
                    for (int n = 0; n < 2; ++n) r[m][bj][n] = *(const f32x4*)(R + off + bj * HALF + n * 16); }
            asm volatile("" ::: "memory");
#pragma unroll
            for (int m = 0; m < 4; ++m) { const size_t off = (size_t)(row0 + ai * HALF + m * 16) * ldc + col0;
#pragma unroll
                for (int bj = 0; bj < 2; ++bj)
#pragma unroll
                    for (int n = 0; n < 2; ++n) *(f32x4*)(C + off + bj * HALF + n * 16) = acc[ai][bj][m][n] + alpha * r[m][bj][n]; }
            asm volatile("" ::: "memory");
        }
    }
};
struct EpiResidLN {
    static constexpr bool PERM = false, AFTER_DRAIN = false, PREFETCH = false;
    float* C; const float* Zp; const f32x2* st; const float* g; const float* b; int ldc; float alpha;
    __device__ __forceinline__ void operator()(const f32x4 (&acc)[2][2][4][2], const Unit& u, int wr, int wc, int fr, int fq) const {
        const int row0 = u.pm * BM + wr * 64 + fr, col0 = u.pn * BM + wc * 32 + 4 * fq;
#pragma unroll
        for (int bj = 0; bj < 2; ++bj)
#pragma unroll
            for (int n = 0; n < 2; ++n) {
                const int cc = col0 + bj * HALF + n * 16;
                const f32x4 gv = *(const f32x4*)(g + cc) * alpha, bv = *(const f32x4*)(b + cc) * alpha;
                f32x4 r[2][4]; f32x2 ms[2][4];
#pragma unroll
                for (int ai = 0; ai < 2; ++ai)
#pragma unroll
                    for (int m = 0; m < 4; ++m) { const int row = row0 + ai * HALF + m * 16; ms[ai][m] = st[row]; r[ai][m] = *(const f32x4*)(Zp + (size_t)row * ldc + cc); }
                asm volatile("" ::: "memory");
#pragma unroll
                for (int ai = 0; ai < 2; ++ai)
#pragma unroll
                    for (int m = 0; m < 4; ++m) { const int row = row0 + ai * HALF + m * 16;
                        *(f32x4*)(C + (size_t)row * ldc + cc) = acc[ai][bj][m][n] + ((r[ai][m] - ms[ai][m].x) * ms[ai][m].y) * gv + bv; }
                asm volatile("" ::: "memory");
            }
    }
};
struct EpiResidB {
    static constexpr bool PERM = true, AFTER_DRAIN = false, PREFETCH = EPI_PREFETCH;
    bf16_t* C; const bf16_t* R;
    __device__ __forceinline__ void prefetch(const Unit& u, PG8_LAS unsigned char* dummy, int wid, int lane) const {
#pragma unroll
        for (int i = 0; i < 2; ++i) { const int L = wid * 128 + i * 64 + lane;
            __builtin_amdgcn_global_load_lds((const unsigned*)((const char*)R + (unsigned)((u.pm * BM + (L >> 2)) * DM + u.pn * BM + (L & 3) * 64) * 2u), (PG8_LAS unsigned*)dummy, 4, 0, 0); }
    }
    __device__ __forceinline__ void operator()(const f32x4 (&acc)[2][2][4][2], const Unit& u, int wr, int wc, int fr, int fq) const {
        const int row0 = u.pm * BM + wr * 64 + fr, col0 = u.pn * BM + wc * 32 + 8 * fq;
#pragma unroll
        for (int ai = 0; ai < 2; ++ai) {
            bf16x8 r[4][2];
#pragma unroll
            for (int m = 0; m < 4; ++m)
#pragma unroll
                for (int bj = 0; bj < 2; ++bj) r[m][bj] = *(const bf16x8*)((const char*)R + (unsigned)((row0 + ai * HALF + m * 16) * DM + col0 + bj * HALF) * 2u);
            asm volatile("" ::: "memory");
#pragma unroll
            for (int m = 0; m < 4; ++m)
#pragma unroll
                for (int bj = 0; bj < 2; ++bj) { float x[8]; unpack8(r[m][bj], x);
                    const f32x4 a0 = acc[ai][bj][m][0], a1 = acc[ai][bj][m][1];
                    float v[8];
#pragma unroll
                    for (int j = 0; j < 4; ++j) { v[j] = a0[j] + DN_ALPHA * x[j]; v[4 + j] = a1[j] + DN_ALPHA * x[4 + j]; }
                    *(bf16x8*)((char*)C + (unsigned)((row0 + ai * HALF + m * 16) * DM + col0 + bj * HALF) * 2u) = pack8h(v); }
            asm volatile("" ::: "memory");
        }
    }
};
struct EpiResidLNB {
    static constexpr bool PERM = true, AFTER_DRAIN = false, PREFETCH = EPI_PREFETCH;
    bf16_t* C; const bf16_t* Zp; const f32x2* st; const float* g; const float* b;
    __device__ __forceinline__ void prefetch(const Unit& u, PG8_LAS unsigned char* dummy, int wid, int lane) const {
#pragma unroll
        for (int i = 0; i < 2; ++i) { const int L = wid * 128 + i * 64 + lane;
            __builtin_amdgcn_global_load_lds((const unsigned*)((const char*)Zp + (unsigned)((u.pm * BM + (L >> 2)) * DM + u.pn * BM + (L & 3) * 64) * 2u), (PG8_LAS unsigned*)dummy, 4, 0, 0); }
    }
    __device__ __forceinline__ void operator()(const f32x4 (&acc)[2][2][4][2], const Unit& u, int wr, int wc, int fr, int fq) const {
        const int row0 = u.pm * BM + wr * 64 + fr, col0 = u.pn * BM + wc * 32 + 8 * fq;
#pragma unroll
        for (int bj = 0; bj < 2; ++bj) {
            const int cc = col0 + bj * HALF;
            const f32x4 g0 = *(const f32x4*)(g + cc) * DN_ALPHA, g1 = *(const f32x4*)(g + cc + 4) * DN_ALPHA, b0 = *(const f32x4*)(b + cc) * DN_ALPHA, b1 = *(const f32x4*)(b + cc + 4) * DN_ALPHA;
            bf16x8 r[2][4]; f32x2 ms[2][4];
#pragma unroll
            for (int ai = 0; ai < 2; ++ai)
#pragma unroll
                for (int m = 0; m < 4; ++m) { const int row = row0 + ai * HALF + m * 16; ms[ai][m] = *(const f32x2*)((const char*)st + (unsigned)row * 8u); r[ai][m] = *(const bf16x8*)((const char*)Zp + (unsigned)(row * DM + cc) * 2u); }
            asm volatile("" ::: "memory");
#pragma unroll
            for (int ai = 0; ai < 2; ++ai)
#pragma unroll
                for (int m = 0; m < 4; ++m) { const int row = row0 + ai * HALF + m * 16; float x[8]; unpack8h(r[ai][m], x);
                    const f32x4 a0 = acc[ai][bj][m][0], a1 = acc[ai][bj][m][1]; const float mu = ms[ai][m].x, rs = ms[ai][m].y;
                    float v[8];
#pragma unroll
                    for (int j = 0; j < 4; ++j) { v[j] = a0[j] + (((x[j] - mu) * rs) * g0[j] + b0[j]); v[4 + j] = a1[j] + (((x[4 + j] - mu) * rs) * g1[j] + b1[j]); }
                    *(bf16x8*)((char*)C + (unsigned)(row * DM + cc) * 2u) = pack8h(v); __builtin_amdgcn_sched_barrier(0); }
            asm volatile("" ::: "memory");
        }
    }
};
template <class Epi, class Sched, bool ALIGN_EPI = false, bool SP2 = false>
__device__ __forceinline__ void gemm_phase(PG8_LAS unsigned char* lds, const Gemm g, const Sched& S, const Epi& E) {
    const int tid = threadIdx.x, wid = __builtin_amdgcn_readfirstlane(tid >> 6), lane = tid & 63, wr = wid >> 2, wc = wid & 3, fr = lane & 15, fq = lane >> 4;
    const int K = g.K, nt = K / BK;
    unsigned voffA[2], voffB[2];
#pragma unroll
    for (int i = 0; i < 2; ++i) { int R, C; stage_rc(tid * 16 + i * 8192, R, C); const int Rb = Epi::PERM ? ((R & ~31) + perm32(R & 31)) : R;
        voffA[i] = (unsigned)(R * K + C) * 2u; voffB[i] = (unsigned)(Rb * K + C) * 2u; }
    const size_t kstep = (size_t)(BK * 2);
    const size_t hstep = (size_t)HALF * K * 2;
    const size_t tstep = 2 * hstep;
    const unsigned ldsw = (unsigned)wid * 1024u;
    const int aoff = lds_byte(wr * 64 + fr, fq * 8), boff = lds_byte(wc * 32 + fr, fq * 8);
#define PG8_SA(b, h) (((b) * 2 + (h)) * HTB)
#define PG8_SB(b, h) ((4 + (b) * 2 + (h)) * HTB)
#define PG8_STAGE(bufoff, gbase, voff) do { _Pragma("unroll") for (int _i = 0; _i < 2; ++_i) \
        __builtin_amdgcn_global_load_lds((const unsigned*)((const char*)(gbase) + (voff)[_i]), (PG8_LAS unsigned*)(lds + (bufoff) + ldsw + _i * 8192), 16, 0, 0); } while (0)
#define PG8_LDA(dst, b, h) do { _Pragma("unroll") for (int m = 0; m < 4; ++m) _Pragma("unroll") for (int k = 0; k < 2; ++k) dst[m][k] = *(const PG8_LAS bf16x8*)(lds + PG8_SA(b, h) + aoff + m * 2048 + k * 1024); } while (0)
#define PG8_LDB(dst, b, h) do { _Pragma("unroll") for (int n = 0; n < 2; ++n) _Pragma("unroll") for (int k = 0; k < 2; ++k) dst[n][k] = *(const PG8_LAS bf16x8*)(lds + PG8_SB(b, h) + boff + n * 2048 + k * 1024); } while (0)
#define PG8_MMA(ai, bj, At, Bt) do { __builtin_amdgcn_s_setprio(1); _Pragma("unroll") for (int m = 0; m < 4; ++m) _Pragma("unroll") for (int n = 0; n < 2; ++n) _Pragma("unroll") for (int k = 0; k < 2; ++k) \
        acc[ai][bj][m][n] = __builtin_amdgcn_mfma_f32_16x16x32_bf16(Bt[n][k], At[m][k], acc[ai][bj][m][n], 0, 0, 0); __builtin_amdgcn_s_setprio(0); } while (0)
#define PG8_WAIT_V(n) asm volatile("s_waitcnt vmcnt(" #n ")" ::: "memory")
#define PG8_WAIT_L(n) asm volatile("s_waitcnt lgkmcnt(" #n ")" ::: "memory")
#define PG8_BAR __builtin_amdgcn_s_barrier()
#define PG8_SCHED __builtin_amdgcn_sched_barrier(0)
    Unit cur, nxt; int ui = 0;
    if (!S.next(0, cur)) return;
    f32x4 acc[2][2][4][2];
#pragma unroll
    for (int a = 0; a < 2; ++a)
#pragma unroll
        for (int b = 0; b < 2; ++b)
#pragma unroll
            for (int m = 0; m < 4; ++m)
#pragma unroll
                for (int n = 0; n < 2; ++n) acc[a][b][m][n] = (f32x4){0.f, 0.f, 0.f, 0.f};
    bf16x8 At[4][2], B0[2][2], B1[2][2];
    const char* cA = (const char*)g.A + (size_t)cur.pm * tstep; const char* cB = (const char*)g.Bt + (size_t)cur.pn * tstep;
    S.a_ready(cur);
    if constexpr (SP2) {
        PG8_STAGE(PG8_SB(0, 0), cB, voffB); PG8_STAGE(PG8_SB(0, 1), cB + hstep, voffB); PG8_STAGE(PG8_SA(0, 0), cA, voffA); PG8_STAGE(PG8_SA(0, 1), cA + hstep, voffA);
        if (wr == 1) PG8_BAR;
        PG8_WAIT_V(2); PG8_BAR;
        PG8_STAGE(PG8_SB(1, 0), cB + kstep, voffB); PG8_STAGE(PG8_SA(1, 0), cA + kstep, voffA); PG8_STAGE(PG8_SB(1, 1), cB + hstep + kstep, voffB);
        PG8_WAIT_V(6); PG8_BAR;
    } else {
        PG8_STAGE(PG8_SB(0, 0), cB, voffB); PG8_STAGE(PG8_SA(0, 0), cA, voffA); PG8_STAGE(PG8_SB(0, 1), cB + hstep, voffB); PG8_STAGE(PG8_SA(0, 1), cA + hstep, voffA);
        if (wr == 1) PG8_BAR;
        PG8_WAIT_V(4); PG8_BAR;
        PG8_STAGE(PG8_SB(1, 0), cB + kstep, voffB); PG8_STAGE(PG8_SA(1, 0), cA + kstep, voffA); PG8_STAGE(PG8_SB(1, 1), cB + hstep + kstep, voffB);
        PG8_WAIT_V(6); PG8_BAR;
    }
    for (;;) {
        const bool has_next = S.next(ui + 1, nxt);
        const char* nA = has_next ? (const char*)g.A + (size_t)nxt.pm * tstep : cA; const char* nB = has_next ? (const char*)g.Bt + (size_t)nxt.pn * tstep : cB;
        for (int t = 0; t < nt; t += 2) {
            const bool last = (t == nt - 2);
            const char* a1 = cA + (size_t)(t + 1) * kstep;
            const char* a2 = last ? nA : cA + (size_t)(t + 2) * kstep; const char* b2 = last ? nB : cB + (size_t)(t + 2) * kstep;
            const char* a3 = a2 + kstep; const char* b3 = b2 + kstep;
            if (last && has_next) S.a_ready(nxt);
            if constexpr (Epi::PREFETCH) { if (t == nt - EPI_PF_TILES) E.prefetch(cur, lds + STAGE_BYTES + wid * 256, wid, lane); }
            if constexpr (SP2) {
            PG8_LDB(B0, 0, 0); PG8_LDB(B1, 0, 1); PG8_SCHED; PG8_LDA(At, 0, 0); PG8_STAGE(PG8_SA(1, 1), a1 + hstep, voffA);
            PG8_WAIT_V(8); PG8_WAIT_L(0); PG8_BAR; PG8_MMA(0, 0, At, B0); PG8_MMA(0, 1, At, B1); PG8_BAR; PG8_SCHED;
            PG8_LDA(At, 0, 1); PG8_STAGE(PG8_SB(0, 0), b2, voffB); PG8_STAGE(PG8_SB(0, 1), b2 + hstep, voffB); PG8_STAGE(PG8_SA(0, 0), a2, voffA);
            PG8_WAIT_V(8); PG8_WAIT_L(0); PG8_BAR; PG8_MMA(1, 0, At, B0); PG8_MMA(1, 1, At, B1); PG8_BAR; PG8_SCHED;
            PG8_LDB(B0, 1, 0); PG8_LDB(B1, 1, 1); PG8_SCHED; PG8_LDA(At, 1, 0); PG8_STAGE(PG8_SA(0, 1), a2 + hstep, voffA);
            PG8_WAIT_V(8); PG8_WAIT_L(0); PG8_BAR; PG8_MMA(0, 0, At, B0); PG8_MMA(0, 1, At, B1); PG8_BAR; PG8_SCHED;
            PG8_LDA(At, 1, 1); PG8_STAGE(PG8_SB(1, 0), b3, voffB); PG8_STAGE(PG8_SB(1, 1), b3 + hstep, voffB); PG8_STAGE(PG8_SA(1, 0), a3, voffA);
            PG8_WAIT_V(8); PG8_WAIT_L(0); PG8_BAR; PG8_MMA(1, 0, At, B0); PG8_MMA(1, 1, At, B1); PG8_BAR; PG8_SCHED;
            } else {
            PG8_LDB(B0, 0, 0); PG8_SCHED; PG8_LDA(At, 0, 0); PG8_STAGE(PG8_SA(1, 1), a1 + hstep, voffA);
            PG8_WAIT_L(8); PG8_BAR; PG8_WAIT_L(0); PG8_MMA(0, 0, At, B0); PG8_BAR; PG8_SCHED;
            PG8_LDB(B1, 0, 1); PG8_STAGE(PG8_SB(0, 0), b2, voffB);
            PG8_BAR; PG8_WAIT_L(0); PG8_MMA(0, 1, At, B1); PG8_BAR;
            PG8_LDA(At, 0, 1); PG8_STAGE(PG8_SA(0, 0), a2, voffA);
            PG8_BAR; PG8_WAIT_L(0); PG8_MMA(1, 0, At, B0); PG8_BAR; PG8_SCHED;
            PG8_STAGE(PG8_SB(0, 1), b2 + hstep, voffB);
            PG8_WAIT_V(6); PG8_BAR; PG8_MMA(1, 1, At, B1); PG8_BAR;
            PG8_LDB(B0, 1, 0); PG8_SCHED; PG8_LDA(At, 1, 0); PG8_STAGE(PG8_SA(0, 1), a2 + hstep, voffA);
            PG8_WAIT_L(8); PG8_BAR; PG8_WAIT_L(0); PG8_MMA(0, 0, At, B0); PG8_BAR; PG8_SCHED;
            PG8_LDB(B1, 1, 1); PG8_STAGE(PG8_SB(1, 0), b3, voffB);
            PG8_BAR; PG8_WAIT_L(0); PG8_MMA(0, 1, At, B1); PG8_BAR;
            PG8_LDA(At, 1, 1); PG8_STAGE(PG8_SA(1, 0), a3, voffA);
            PG8_BAR; PG8_WAIT_L(0); PG8_MMA(1, 0, At, B0); PG8_BAR; PG8_SCHED;
            PG8_STAGE(PG8_SB(1, 1), b3 + hstep, voffB);
            PG8_WAIT_V(6); PG8_BAR; PG8_MMA(1, 1, At, B1); PG8_BAR;
            }
        }
        if constexpr (ALIGN_EPI) { if (wr == 0) PG8_BAR; }
        if constexpr (!Epi::AFTER_DRAIN) { E(acc, cur, wr, wc, fr, fq); S.done(cur); }
        if (!has_next) break;
#pragma unroll
        for (int a = 0; a < 2; ++a)
#pragma unroll
            for (int b = 0; b < 2; ++b)
#pragma unroll
                for (int m = 0; m < 4; ++m)
#pragma unroll
                    for (int n = 0; n < 2; ++n) acc[a][b][m][n] = (f32x4){0.f, 0.f, 0.f, 0.f};
        cur = nxt; cA = nA; cB = nB; ++ui;
        if constexpr (ALIGN_EPI) { if (wr == 1) PG8_BAR; }
    }
    PG8_WAIT_V(0);
    if constexpr (!ALIGN_EPI) { if (wr == 0) PG8_BAR; }
    PG8_BAR;
    if constexpr (Epi::AFTER_DRAIN) { E.fused(acc, cur, wr, wc, fr, fq, lds, wid, lane); S.done(cur); }
#undef PG8_SA
#undef PG8_SB
#undef PG8_STAGE
#undef PG8_LDA
#undef PG8_LDB
#undef PG8_MMA
#undef PG8_WAIT_V
#undef PG8_WAIT_L
#undef PG8_BAR
#undef PG8_SCHED
}
}
#ifndef EXP_IN_A
#define EXP_IN_A 2
#endif
namespace fa {
constexpr int KVBLK = 64, SHM_V = 16384, SHM_K = 16384, SHM_KR = 8192;
constexpr int OFF_V = 0, OFF_K = 2 * SHM_V, OFF_KR = OFF_K + 2 * SHM_K, OFF_WS = OFF_KR + 2 * SHM_KR, OFF_IMP = OFF_WS + 8 * 64 * 4, IMP_LD = 257, OFF_QPARK = OFF_IMP + 32 * IMP_LD * 4 + 128  , LDS_END = OFF_QPARK + 8 * 4096;
#define KSWZ(row, colB) ((row) * 256 + ((colB) ^ (((row) & 7) << 4)))
#define KSWZ16(row, colB) ((row) * 256 + ((colB) ^ (((row) & 15) << 4)))
#define SBAR() __builtin_amdgcn_sched_barrier(0)
__device__ __forceinline__ int v_st(int k, int c) { const int kk = (k & ~0xC) | ((k & 4) << 1) | ((k & 8) >> 1); return ((kk >> 3) * 4 + (c >> 5)) * 512 + ((kk & 7) * 32 + (c & 31)) * 2; }
__device__ __forceinline__ int v_rd_base(int lane) { return ((lane & 3) << 3) | (((lane >> 2) & 3) << 6) | (((lane >> 4) & 1) << 5) | (((lane >> 5) & 1) << 8); }
constexpr int v_rd_off(int d0, int ks, int half) { return d0 * 512 + ks * 4096 + half * 2048; }
__device__ __forceinline__ int crow(int r, int hi) { return (r & 3) + 8 * (r >> 2) + 4 * hi; }
__device__ __forceinline__ unsigned cvtpk(float lo, float hi) { unsigned r; asm volatile("v_cvt_pk_bf16_f32 %0, %1, %2" : "=v"(r) : "v"(lo), "v"(hi)); return r; }
__device__ __forceinline__ bf16x8 pack8(f32x4 a, f32x4 b) { u32x4 w = {cvtpk(a[0], a[1]), cvtpk(a[2], a[3]), cvtpk(b[0], b[1]), cvtpk(b[2], b[3])}; return *reinterpret_cast<bf16x8*>(&w); }
__device__ __forceinline__ void mask_tile(f32x16& p0, f32x16& p1, int dq, unsigned W) {
    const float NEG = -__builtin_inff();
#pragma unroll
    for (int r = 0; r < 16; ++r) {
        const int c = (r & 3) + 8 * (r >> 2);
        if ((unsigned)(dq - c) >= W) p0[r] = NEG;
        if ((unsigned)(dq - c - 32) >= W) p1[r] = NEG;
    }
}
__device__ __forceinline__ void mask_all(f32x16& p0, f32x16& p1, bool kill) {
    const float NEG = -__builtin_inff();
#pragma unroll
    for (int r = 0; r < 16; ++r) { if (kill) { p0[r] = NEG; p1[r] = NEG; } }
}
__device__ __forceinline__ void partialSM(f32x16& p0, f32x16& p1, float& m_reg, float& mn, float& alpha, float scale, float C2, bool kill = false) {
    float pmax = p0[0];
#pragma unroll
    for (int r = 1; r < 16; ++r) pmax = fmaxf(pmax, p0[r]);
#pragma unroll
    for (int r = 0; r < 16; ++r) pmax = fmaxf(pmax, p1[r]);
    { auto rr = __builtin_amdgcn_permlane32_swap(__float_as_uint(pmax), __float_as_uint(pmax), false, false);
      pmax = fmaxf(__uint_as_float(rr[0]), __uint_as_float(rr[1])); }
    if (__builtin_expect(__all((pmax - m_reg) * scale <= 8.0f), 1)) { mn = m_reg; alpha = 1.f; }
    else { mn = fmaxf(m_reg, pmax); alpha = __builtin_amdgcn_exp2f((m_reg - mn) * C2); m_reg = mn; }
    const float mnL = kill ? -__builtin_inff() : -mn * C2;
#pragma unroll
    for (int r = 0; r < 16; ++r) p0[r] = fmaf(p0[r], C2, mnL);
#pragma unroll
    for (int r = 0; r < 16; ++r) p1[r] = fmaf(p1[r], C2, mnL);
#pragma unroll
    for (int r = 0; r < 16; ++r) p0[r] = __builtin_amdgcn_exp2f(p0[r]);
#if EXP_IN_A >= 2
#pragma unroll
    for (int r = 0; r < 16; ++r) p1[r] = __builtin_amdgcn_exp2f(p1[r]);
#endif
}
__device__ __forceinline__ void finishSM(f32x16& p0, f32x16& p1, float alpha, float& l_reg, bf16x8& pa0, bf16x8& pa1, bf16x8& pa2, bf16x8& pa3) {
#if EXP_IN_A < 2
#pragma unroll
    for (int r = 0; r < 16; ++r) p1[r] = __builtin_amdgcn_exp2f(p1[r]);
#endif
    float ps = 0;
#pragma unroll
    for (int r = 0; r < 16; ++r) ps += p0[r];
#pragma unroll
    for (int r = 0; r < 16; ++r) ps += p1[r];
    { auto rr = __builtin_amdgcn_permlane32_swap(__float_as_uint(ps), __float_as_uint(ps), false, false);
      ps = __uint_as_float(rr[0]) + __uint_as_float(rr[1]); }
    l_reg = l_reg * alpha + ps;
#define PK4(P, B_, OUT) do { unsigned a0 = cvtpk(P[B_+0], P[B_+1]), a1 = cvtpk(P[B_+2], P[B_+3]);                          \
        unsigned b0 = cvtpk(P[B_+4], P[B_+5]), b1 = cvtpk(P[B_+6], P[B_+7]);                                             \
        auto r0 = __builtin_amdgcn_permlane32_swap(a0, b0, false, false); auto r1 = __builtin_amdgcn_permlane32_swap(a1, b1, false, false); \
        u32x4 w = {r0[0], r1[0], r0[1], r1[1]}; OUT = *reinterpret_cast<bf16x8*>(&w); } while (0)
    PK4(p0, 0, pa0); PK4(p0, 8, pa1); PK4(p1, 0, pa2); PK4(p1, 8, pa3);
#undef PK4
}
template <int KB, bool ROPE, bool LIGHT = false>
__device__ __forceinline__ void qkt(f32x16& p0, f32x16& p1, const char* lds, int r32, int hi, const bf16x8* qr, const char* qpark = nullptr) {
    p0 = f32x16{}; p1 = f32x16{};
    const char* K_lds = lds + OFF_K;
    const char* kb[4];
#pragma unroll
    for (int dd = 0; dd < 4; ++dd) kb[dd] = K_lds + KB * SHM_K + KSWZ(r32, (dd * 16 + hi * 8) * 2);
    bf16x8 f[4][4];
#define QK_LD(g) do { const char* a0_ = kb[(2 * (g)) & 3] + ((2 * (g)) >> 2) * 128; const char* a1_ = kb[(2 * (g) + 1) & 3] + ((2 * (g) + 1) >> 2) * 128; \
        f[(g) & 3][0] = *reinterpret_cast<const bf16x8*>(a0_); f[(g) & 3][1] = *reinterpret_cast<const bf16x8*>(a0_ + 32 * 256); \
        f[(g) & 3][2] = *reinterpret_cast<const bf16x8*>(a1_); f[(g) & 3][3] = *reinterpret_cast<const bf16x8*>(a1_ + 32 * 256); } while (0)
#define QK_MM(g) do { p0 = __builtin_amdgcn_mfma_f32_32x32x16_bf16(f[(g) & 3][0], qr[2 * (g)], p0, 0, 0, 0); p1 = __builtin_amdgcn_mfma_f32_32x32x16_bf16(f[(g) & 3][1], qr[2 * (g)], p1, 0, 0, 0); \
        p0 = __builtin_amdgcn_mfma_f32_32x32x16_bf16(f[(g) & 3][2], qr[2 * (g) + 1], p0, 0, 0, 0); p1 = __builtin_amdgcn_mfma_f32_32x32x16_bf16(f[(g) & 3][3], qr[2 * (g) + 1], p1, 0, 0, 0); } while (0)
    if constexpr (ROPE) {
        QK_LD(0); SBAR();
        QK_LD(1); SBAR(); QK_MM(0); SBAR();
        QK_LD(2); SBAR(); QK_MM(1); SBAR();
        QK_LD(3); SBAR(); QK_MM(2); SBAR();
        const char* KR_lds = lds + OFF_KR + KB * SHM_KR + r32 * 128;
        bf16x8 ra[2], rb[2], qa, qb_;
#define QR_LD(d0, R, Q) do { const char* a = KR_lds + (((d0) * 32 + hi * 16) ^ ((r32 & 7) << 4)); R[0] = *reinterpret_cast<const bf16x8*>(a); R[1] = *reinterpret_cast<const bf16x8*>(a + 32 * 128); Q = *reinterpret_cast<const bf16x8*>(qpark + (d0) * 1024); } while (0)
#define QR_MM(R, Q) do { p0 = __builtin_amdgcn_mfma_f32_32x32x16_bf16(R[0], Q, p0, 0, 0, 0); p1 = __builtin_amdgcn_mfma_f32_32x32x16_bf16(R[1], Q, p1, 0, 0, 0); } while (0)
        QR_LD(0, ra, qa); SBAR(); QK_MM(3); SBAR();
        QR_LD(1, rb, qb_); SBAR(); QR_MM(ra, qa); SBAR();
        QR_LD(2, ra, qa); SBAR(); QR_MM(rb, qb_); SBAR();
        QR_LD(3, rb, qb_); SBAR(); QR_MM(ra, qa); SBAR();
        QR_MM(rb, qb_);
#undef QR_LD
#undef QR_MM
    } else if constexpr (LIGHT) {
        QK_LD(0); SBAR();
        QK_LD(1); SBAR(); QK_MM(0); SBAR();
        QK_LD(2); SBAR(); QK_MM(1); SBAR();
        QK_LD(3); SBAR(); QK_MM(2); SBAR();
        QK_MM(3);
    } else {
        QK_LD(0); QK_LD(1); SBAR();
        QK_LD(2); SBAR(); QK_MM(0); SBAR();
        QK_LD(3); SBAR(); QK_MM(1); SBAR();
        QK_MM(2); QK_MM(3);
    }
#undef QK_LD
#undef QK_MM
}
template <int VB, bool PIPE>
__device__ __forceinline__ void pv_tile(f32x16* o, int vb0, bf16x8 pa0, bf16x8 pa1, bf16x8 pa2, bf16x8 pa3) {
#define TRRD(dst, off) asm volatile("ds_read_b64_tr_b16 %0, %1 offset:%2" : "=&v"(dst) : "v"(vb0), "i"(off) : "memory")
#define PV_LD(S, d0) do { constexpr int b_ = OFF_V + VB * SHM_V + v_rd_off(d0, 0, 0); TRRD(S[0], b_); TRRD(S[1], b_ + 2048); TRRD(S[2], b_ + 4096); TRRD(S[3], b_ + 6144); TRRD(S[4], b_ + 8192); TRRD(S[5], b_ + 10240); TRRD(S[6], b_ + 12288); TRRD(S[7], b_ + 14336); } while (0)
#define PV_MM(S, d0) do { \
        o[d0] = __builtin_amdgcn_mfma_f32_32x32x16_bf16(pa0, (bf16x8){S[0][0], S[0][1], S[0][2], S[0][3], S[1][0], S[1][1], S[1][2], S[1][3]}, o[d0], 0, 0, 0);   \
        o[d0] = __builtin_amdgcn_mfma_f32_32x32x16_bf16(pa1, (bf16x8){S[2][0], S[2][1], S[2][2], S[2][3], S[3][0], S[3][1], S[3][2], S[3][3]}, o[d0], 0, 0, 0);   \
        o[d0] = __builtin_amdgcn_mfma_f32_32x32x16_bf16(pa2, (bf16x8){S[4][0], S[4][1], S[4][2], S[4][3], S[5][0], S[5][1], S[5][2], S[5][3]}, o[d0], 0, 0, 0);   \
        o[d0] = __builtin_amdgcn_mfma_f32_32x32x16_bf16(pa3, (bf16x8){S[6][0], S[6][1], S[6][2], S[6][3], S[7][0], S[7][1], S[7][2], S[7][3]}, o[d0], 0, 0, 0); } while (0)
#define PV_W(n) do { asm volatile("s_waitcnt lgkmcnt(" #n ")" ::: "memory"); SBAR(); } while (0)
    if constexpr (PIPE) {
        s16x4 A[8], B[8];
        PV_LD(A, 0); PV_LD(B, 1); PV_W(8); PV_MM(A, 0);
        PV_LD(A, 2); PV_W(8); PV_MM(B, 1);
        PV_LD(B, 3); PV_W(8); PV_MM(A, 2);
        PV_W(0); PV_MM(B, 3);
    } else {
        s16x4 A[8];
        PV_LD(A, 0); PV_W(0); PV_MM(A, 0); PV_LD(A, 1); PV_W(0); PV_MM(A, 1); PV_LD(A, 2); PV_W(0); PV_MM(A, 2); PV_LD(A, 3); PV_W(0); PV_MM(A, 3);
    }
#undef PV_W
#undef PV_MM
#undef PV_LD
#undef TRRD
}

struct FUnit {
    const bf16_t* Kb; long ldk; const bf16_t* Vb; long ldv; const bf16_t* KRb;
    int j_lo, j_hi;
    int qlo, qhi;
    int qpos;
    unsigned long long sel;
};
template <int MODE, int VAR = 0>
__device__ __forceinline__ void flash_core(char* lds, const FUnit& u, const bf16x8* qr, float scale, f32x16 (&o)[4], float& m_reg, float& l_reg) {
    constexpr bool ROPE = (MODE == 0);
    const int tid = threadIdx.x, wid = __builtin_amdgcn_readfirstlane(tid >> 6), lane = tid & 63, r32 = lane & 31, hi = lane >> 5;
    const int grp = wid >> 2;
    const float C2 = 1.4426950408889634f * scale;
    char* V_lds = lds + OFF_V; char* K_lds = lds + OFF_K; char* KR_lds = lds + OFF_KR;
    float* ws = (float*)(lds + OFF_WS) + wid * 64; float* al_l = ws + 32;
    const int sr = tid >> 4, sc = (tid & 15) * 8, vst0 = v_st(sr, sc), vst1 = v_st(32 + sr, sc), kws = KSWZ(sr, sc * 2);
    const int rr = tid >> 3, rc = (tid & 7) * 8, krws = rr * 128 + ((rc * 2) ^ ((rr & 7) << 4));
    const int vb0 = (int)(uintptr_t)lds + v_rd_base(lane);
    const char* qpark = lds + OFF_QPARK + wid * 4096 + lane * 16;
    m_reg = -1e30f; l_reg = 0.f;
#pragma unroll
    for (int d = 0; d < 4; ++d) o[d] = f32x16{};
    const int NT = u.j_hi - u.j_lo;
    if (NT <= 0) return;
    bf16x8 st_k0, st_k1, st_v0, st_v1, st_kr;
    f32x16 p0, p1; float mn, al; bf16x8 pa0, pa1, pa2, pa3;
    const unsigned W = (MODE == 1) ? 512u : ((MODE == 3) ? 0x80000000u : 0x7fffffffu);
#define FA_KBASE(t) ((u.j_lo + (t)) * KVBLK)
#define FA_KLOAD(k0) do { st_k0 = *(const bf16x8*)(u.Kb + (long)((k0) + sr) * u.ldk + sc); st_k1 = *(const bf16x8*)(u.Kb + (long)((k0) + 32 + sr) * u.ldk + sc);   \
                          if constexpr (ROPE) st_kr = *(const bf16x8*)(u.KRb + (long)((k0) + rr) * 64 + rc); } while (0)
#define FA_VLOAD(k0) do { st_v0 = *(const bf16x8*)(u.Vb + (long)((k0) + sr) * u.ldv + sc); st_v1 = *(const bf16x8*)(u.Vb + (long)((k0) + 32 + sr) * u.ldv + sc); } while (0)
#define FA_KWRITE(bf) do { *(bf16x8*)(K_lds + (bf) * SHM_K + kws) = st_k0; *(bf16x8*)(K_lds + (bf) * SHM_K + kws + 32 * 256) = st_k1;   \
                           if constexpr (ROPE) *(bf16x8*)(KR_lds + (bf) * SHM_KR + krws) = st_kr; } while (0)
#define FA_VWRITE(bf) do { *(bf16x8*)(V_lds + (bf) * SHM_V + vst0) = st_v0; *(bf16x8*)(V_lds + (bf) * SHM_V + vst1) = st_v1; } while (0)
#define FA_BAR() do { asm volatile("s_waitcnt lgkmcnt(0)" ::: "memory"); __builtin_amdgcn_s_barrier(); asm volatile("" ::: "memory"); } while (0)
#define FA_RESC(a) do { if (__any((a) < 1.f)) { if (hi == 0) al_l[r32] = (a); asm volatile("s_waitcnt lgkmcnt(0)" ::: "memory");              \
                     _Pragma("unroll") for (int d_ = 0; d_ < 4; ++d_) { _Pragma("unroll") for (int r = 0; r < 16; ++r) o[d_][r] *= al_l[crow(r, hi)]; } asm volatile("" ::: "memory"); } } while (0)
#define FA_MASK(t) do { const int kb_ = FA_KBASE(t);                                                                             \
        if (MODE == 1) { if (kb_ + KVBLK - 1 > u.qlo || kb_ <= u.qhi - 512) mask_tile(p0, p1, u.qpos - kb_ - 4 * hi, W); }       \
        else { if (kb_ + KVBLK - 1 > u.qlo) mask_tile(p0, p1, u.qpos - kb_ - 4 * hi, W); }                                       \
        } while (0)
#define FA_KILL(t) ((MODE == 2) && (((u.sel >> (u.j_lo + (t))) & 1ull) == 0ull))
    const int kb_last = FA_KBASE(NT - 1);
    FA_KLOAD(FA_KBASE(0)); FA_VLOAD(FA_KBASE(0));
    FA_KWRITE(0); FA_VWRITE(0);
    { const int k1 = FA_KBASE(1); FA_KLOAD(k1 < kb_last ? k1 : kb_last); }
    FA_BAR();
    if (grp == 1) FA_BAR();
#define FA_STEP(BF, t) do {                                                                                                      \
        if (!(VAR & 8)) { const int k1 = FA_KBASE((t) + 1); FA_VLOAD(k1 < kb_last ? k1 : kb_last); }                             \
        SBAR(); if (!(VAR & 1)) qkt<BF, ROPE, MODE == 3>(p0, p1, lds, r32, hi, qr, qpark); else { p0 = f32x16{}; p1 = f32x16{}; p0[0] = (float)(t); }   \
        if (!(VAR & 2)) { FA_MASK(t); partialSM(p0, p1, m_reg, mn, al, scale, C2, FA_KILL(t)); if ((t) != 0) FA_RESC(al); } else { al = 1.f; }     \
        if (!(VAR & 8)) FA_KWRITE((BF) ^ 1);                                                                                     \
        if (!(VAR & 16)) FA_BAR();                                                                                               \
        if (!(VAR & 8)) { const int k2 = FA_KBASE((t) + 2); FA_KLOAD(k2 < kb_last ? k2 : kb_last); }                             \
        if (!(VAR & 2)) finishSM(p0, p1, al, l_reg, pa0, pa1, pa2, pa3); else { l_reg += p0[0]; pa0 = pack8(f32x4{p0[0], p0[1], p0[2], p0[3]}, f32x4{p1[0], p1[1], p1[2], p1[3]}); pa1 = pa0; pa2 = pa0; pa3 = pa0; } \
        SBAR();                                                                                                                  \
        if (!(VAR & 4)) pv_tile<BF, (MODE == 1 || MODE == 2)>(o, vb0, pa0, pa1, pa2, pa3); else { o[0][0] += __builtin_bit_cast(float, (int)pa0[0]); }      \
        if (!(VAR & 8)) FA_VWRITE((BF) ^ 1);                                                                                     \
        if (!(VAR & 16)) FA_BAR(); } while (0)
    int t = 0;
    for (; t + 1 < NT; t += 2) {
        FA_STEP(0, t);
        FA_STEP(1, t + 1);
    }
    if (NT & 1) {
        SBAR(); if (!(VAR & 1)) qkt<0, ROPE, MODE == 3>(p0, p1, lds, r32, hi, qr, qpark); else { p0 = f32x16{}; p1 = f32x16{}; }
        if (!(VAR & 2)) { FA_MASK(t); partialSM(p0, p1, m_reg, mn, al, scale, C2, FA_KILL(t)); FA_RESC(al); } else { al = 1.f; }
        if (!(VAR & 16)) FA_BAR();
        if (!(VAR & 2)) finishSM(p0, p1, al, l_reg, pa0, pa1, pa2, pa3); else { pa0 = pack8(f32x4{p0[0], p0[1], p0[2], p0[3]}, f32x4{p1[0], p1[1], p1[2], p1[3]}); pa1 = pa0; pa2 = pa0; pa3 = pa0; }
        SBAR();
        if (!(VAR & 4)) pv_tile<0, (MODE == 1 || MODE == 2)>(o, vb0, pa0, pa1, pa2, pa3);
        if (!(VAR & 16)) FA_BAR();
    }
#undef FA_STEP
    if (grp == 0) FA_BAR();
#undef FA_MASK
#undef FA_KILL
#undef FA_RESC
#undef FA_BAR
#undef FA_VWRITE
#undef FA_KWRITE
#undef FA_VLOAD
#undef FA_KLOAD
#undef FA_KBASE
}
template <int MODE>
__device__ __forceinline__ void flash_core2(char* lds, const FUnit& u, const bf16x8* qr, float scale, f32x16 (&o)[4], float& m_reg, float& l_reg) {
    const int tid = threadIdx.x, wid = __builtin_amdgcn_readfirstlane(tid >> 6), lane = tid & 63, r32 = lane & 31, hi = lane >> 5;
    const float C2 = 1.4426950408889634f * scale;
    char* V_lds = lds + OFF_V; char* K_lds = lds + OFF_K;
    float* ws = (float*)(lds + OFF_WS) + wid * 64; float* al_l = ws + 32;
    const int sr = tid >> 4, sc = (tid & 15) * 8, vst0 = v_st(sr, sc), vst1 = v_st(32 + sr, sc), kws = KSWZ(sr, sc * 2);
    const int vb0 = (int)(uintptr_t)lds + v_rd_base(lane);
    m_reg = -1e30f; l_reg = 0.f;
#pragma unroll
    for (int d = 0; d < 4; ++d) o[d] = f32x16{};
    const int NT = u.j_hi - u.j_lo;
    if (NT <= 0) return;
    bf16x8 st_k0, st_k1, st_v0, st_v1;
    f32x16 pA0, pA1, pB0, pB1; float mnA, mnB, alA, alB; bf16x8 pa0, pa1, pa2, pa3;
    const unsigned W = (MODE == 1) ? 512u : 0x7fffffffu;
#define F2_KBASE(t) ((u.j_lo + (t)) * KVBLK)
#define F2_LOAD(k0) do { st_v0 = *(const bf16x8*)(u.Vb + (long)((k0) + sr) * u.ldv + sc); st_v1 = *(const bf16x8*)(u.Vb + (long)((k0) + 32 + sr) * u.ldv + sc);   \
                         st_k0 = *(const bf16x8*)(u.Kb + (long)((k0) + sr) * u.ldk + sc); st_k1 = *(const bf16x8*)(u.Kb + (long)((k0) + 32 + sr) * u.ldk + sc); } while (0)
#define F2_WRITE(bf) do { *(bf16x8*)(V_lds + (bf) * SHM_V + vst0) = st_v0; *(bf16x8*)(V_lds + (bf) * SHM_V + vst1) = st_v1;   \
                          *(bf16x8*)(K_lds + (bf) * SHM_K + kws) = st_k0; *(bf16x8*)(K_lds + (bf) * SHM_K + kws + 32 * 256) = st_k1; } while (0)
#define F2_VMW() asm volatile("s_waitcnt vmcnt(0)" ::: "memory")
#define F2_RESC(a) do { if (__any((a) < 1.f)) { if (hi == 0) al_l[r32] = (a); asm volatile("s_waitcnt lgkmcnt(0)" ::: "memory");              \
                     _Pragma("unroll") for (int d_ = 0; d_ < 4; ++d_) { _Pragma("unroll") for (int r = 0; r < 16; ++r) o[d_][r] *= al_l[crow(r, hi)]; } asm volatile("" ::: "memory"); } } while (0)
#define F2_MASK(P0_, P1_, t) do { const int kb_ = F2_KBASE(t);                                                                    \
        if (MODE == 1) { if (kb_ + KVBLK - 1 > u.qlo || kb_ <= u.qhi - 512) mask_tile(P0_, P1_, u.qpos - kb_ - 4 * hi, W); }      \
        else { if (kb_ + KVBLK - 1 > u.qlo) mask_tile(P0_, P1_, u.qpos - kb_ - 4 * hi, W); } } while (0)
#define F2_KILL(t) ((MODE == 2) && (((u.sel >> (u.j_lo + (t))) & 1ull) == 0ull))
#define F2_HALF(PX0, PX1, mnX, alX, PY0, PY1, alY, t, KB, VB, SB) do {                                                            \
        SBAR(); qkt<KB, false, true>(PX0, PX1, lds, r32, hi, qr);                                                                 \
        finishSM(PY0, PY1, alY, l_reg, pa0, pa1, pa2, pa3); SBAR();                                                               \
        if ((t) + 1 < NT) { F2_LOAD(F2_KBASE((t) + 1)); SBAR(); }                                                                 \
        pv_tile<VB, false>(o, vb0, pa0, pa1, pa2, pa3); F2_MASK(PX0, PX1, (t)); partialSM(PX0, PX1, m_reg, mnX, alX, scale, C2, F2_KILL(t)); \
        __syncthreads();                                                                                                          \
        if ((t) + 1 < NT) { F2_VMW(); F2_WRITE(SB); }                                                                             \
        F2_RESC(alX); __syncthreads(); } while (0)
    F2_LOAD(F2_KBASE(0)); F2_VMW(); F2_WRITE(0); __syncthreads();
    if (NT > 1) F2_LOAD(F2_KBASE(1));
    SBAR(); qkt<0, false, true>(pA0, pA1, lds, r32, hi, qr);
    F2_MASK(pA0, pA1, 0); partialSM(pA0, pA1, m_reg, mnA, alA, scale, C2, F2_KILL(0));
    if (NT > 1) { F2_VMW(); F2_WRITE(1); }
    __syncthreads();
    for (int t = 1; t + 1 < NT; t += 2) {
        F2_HALF(pB0, pB1, mnB, alB, pA0, pA1, alA, t, 1, 0, 0);
        F2_HALF(pA0, pA1, mnA, alA, pB0, pB1, alB, t + 1, 0, 1, 1);
    }
    const bool even = (NT & 1) == 0;
    if (even) { SBAR(); qkt<1, false, true>(pB0, pB1, lds, r32, hi, qr); SBAR(); }
    finishSM(pA0, pA1, alA, l_reg, pa0, pa1, pa2, pa3); SBAR();
    pv_tile<0, false>(o, vb0, pa0, pa1, pa2, pa3);
    if (even) { F2_MASK(pB0, pB1, NT - 1); partialSM(pB0, pB1, m_reg, mnB, alB, scale, C2, F2_KILL(NT - 1)); F2_RESC(alB);
        finishSM(pB0, pB1, alB, l_reg, pa0, pa1, pa2, pa3); SBAR(); pv_tile<1, false>(o, vb0, pa0, pa1, pa2, pa3); }
#undef F2_HALF
#undef F2_KILL
#undef F2_MASK
#undef F2_RESC
#undef F2_VMW
#undef F2_WRITE
#undef F2_LOAD
#undef F2_KBASE
}
__device__ __forceinline__ void row_factors(char* lds, int wid, int r32, int hi, float f, float (&rf)[16]) {
    float* li_l = (float*)(lds + OFF_WS) + wid * 64;
    asm volatile("" ::: "memory");
    if (hi == 0) li_l[r32] = f;
    asm volatile("s_waitcnt lgkmcnt(0)" ::: "memory");
#pragma unroll
    for (int r = 0; r < 16; ++r) rf[r] = li_l[crow(r, hi)];
    asm volatile("s_waitcnt lgkmcnt(0)" ::: "memory");
}
}

constexpr size_t MiB = 1ull << 20, KiB = 1ull << 10;
constexpr size_t WS_CTL = 0;
constexpr size_t WS_ROPE = 64 * KiB;
constexpr size_t WS_MG = WS_ROPE + 1 * MiB;
constexpr size_t WS_FLOOR = WS_MG + 512 * KiB;
constexpr size_t WS_DEN = WS_FLOOR + 256 * KiB;
constexpr size_t WS_GATES = WS_DEN + 256 * KiB;
constexpr size_t WS_SEL = WS_GATES + 512 * KiB;
constexpr size_t WS_KROPE = WS_SEL + 512 * KiB;
constexpr size_t WS_CQN = WS_KROPE + 2 * MiB;
constexpr size_t WS_CKVN = WS_CQN + 32 * MiB;
constexpr size_t WS_KVB = WS_CKVN + 16 * MiB;
constexpr size_t WS_XB = WS_KVB + 128 * MiB;
constexpr size_t WS_Z = WS_XB + 128 * MiB;
constexpr size_t WS_R = WS_Z + 256 * MiB;
constexpr size_t WS_W = WS_R + 344 * MiB;
constexpr size_t W_AB = WS_W, W_UQ = W_AB + 62 * MiB, W_UKV = W_UQ + 6 * MiB, W_O0 = W_UKV + 4 * MiB, W_GU0 = W_O0 + 32 * MiB, W_D0 = W_GU0 + 172 * MiB;
constexpr size_t W_C = W_D0 + 86 * MiB, W_C1K = W_C + 58 * MiB, W_C1V = W_C1K + 2 * MiB, W_C2K = W_C1V + 2 * MiB, W_C2V = W_C2K + 128 * KiB, W_O1 = W_C2V + 128 * KiB;
constexpr size_t W_GU1 = W_O1 + 32 * MiB, W_D1 = W_GU1 + 172 * MiB, WS_AT = W_D1 + 86 * MiB;
constexpr size_t WS_AA = WS_AT + 256 * KiB;
constexpr size_t WS_DENI = WS_AA + 256 * KiB;
constexpr size_t WS_DENP = WS_DENI + 256 * KiB;
constexpr size_t WS_STATS = WS_DENP + 4 * MiB;
constexpr size_t WS_END = WS_STATS + 128 * KiB;
constexpr size_t WS_AK = WS_KVB, WS_AV = WS_AK + 32 * MiB, WS_HK = WS_AV + 32 * MiB, WS_HV = WS_HK + 2 * MiB, WS_KCMP = WS_HV + 2 * MiB, WS_VCMP = WS_KCMP + 2 * MiB;
constexpr size_t WS_QB = WS_R + (size_t)M_TOK * AB_NP * 2;

constexpr int NTHREADS = 512;
constexpr int LDS_BYTES = 152 * 1024, LDS_CTL_OFF = LDS_BYTES - 256;
constexpr int N_TJOBS = 14;
struct TJob { const float* s; const float* s2; bf16_t* d; int K, N, Np, mode; };
struct Args { const float* in[26]; float* out; unsigned char* ws; TJob tj[N_TJOBS]; int ph_lo, ph_hi; };

__device__ __forceinline__ void transpose_tile(char* lds, const TJob& jb, int t) {
    float* T = (float*)lds;
    const int tid = threadIdx.x;
    const int tn = jb.Np >> 6;
    const int in_ = t % tn, ik = t / tn, n0 = in_ * 64, k0 = ik * 64;
    const float* sp = jb.s; int c0 = n0; const int ncols = jb.N;
    if (jb.mode == 1) { const int tile = n0 >> 8, j = n0 & 255; sp = (j < 128) ? jb.s : jb.s2; c0 = tile * 128 + (j & 127); }
    const int kk = tid >> 4, nc = (tid & 15) * 4;
    f32x4 v0 = {0.f, 0.f, 0.f, 0.f}, v1 = v0;
    if (c0 + nc < ncols) { v0 = *(const f32x4*)(sp + (size_t)(k0 + kk) * ncols + c0 + nc); v1 = *(const f32x4*)(sp + (size_t)(k0 + kk + 32) * ncols + c0 + nc); }
#pragma unroll
    for (int j = 0; j < 4; ++j) { T[(nc + j) * 65 + kk] = v0[j]; T[(nc + j) * 65 + kk + 32] = v1[j]; }
    __syncthreads();
    const int n = tid >> 3, kc = (tid & 7) * 8;
    float f[8];
#pragma unroll
    for (int j = 0; j < 8; ++j) f[j] = T[n * 65 + kc + j];
    *(bf16x8*)(jb.d + (size_t)(n0 + n) * jb.K + k0 + kc) = pack8f(f);
    __syncthreads();
}
constexpr int N_TJOBS_PRO = 11;
__device__ __forceinline__ void transpose_jobs(char* lds, const Args& a) {
    for (int ji = 0; ji < N_TJOBS_PRO; ++ji) {
        const TJob jb = a.tj[ji];
        const int nt = (jb.K >> 6) * (jb.Np >> 6);
        for (int t = blockIdx.x; t < nt; t += gridDim.x) transpose_tile(lds, jb, t);
    }
}
constexpr int LATE_T0 = 64 * 64, LATE_T1 = 64 * 344, LATE_T2 = 172 * 64, LATE_A = LATE_T0 + LATE_T1, LATE_TOTAL = LATE_A + LATE_T2, LATE_SLOTS = 64 + 128 + 192 + 224, LATE_PER = (LATE_A + LATE_SLOTS - 1) / LATE_SLOTS;
constexpr int LATE_D_SLOTS = 128, LATE_D_PER = LATE_T2 / LATE_D_SLOTS;
static_assert(LATE_D_PER * LATE_D_SLOTS == LATE_T2, "down-weight tiles per slot");
struct TTile { const float* sp; bf16_t* d; int K, ncols, c0, n0, k0; };
__device__ __forceinline__ TTile late_tile(const Args& a, int g) {
    const int ji = g < LATE_T0 ? 11 : (g < LATE_T0 + LATE_T1 ? 12 : 13); const int t = g - (ji == 11 ? 0 : (ji == 12 ? LATE_T0 : LATE_T0 + LATE_T1));
    const TJob jb = a.tj[ji]; const int tn = jb.Np >> 6; TTile r; r.n0 = (t % tn) * 64; r.k0 = (t / tn) * 64; r.sp = jb.s; r.c0 = r.n0; r.ncols = jb.N; r.d = jb.d; r.K = jb.K;
    if (jb.mode == 1) { const int tile = r.n0 >> 8, j = r.n0 & 255; r.sp = (j < 128) ? jb.s : jb.s2; r.c0 = tile * 128 + (j & 127); }
    return r;
}
__device__ __forceinline__ void transpose_span(char* lds, const Args& a, int g0, int g1) {
    float* T = (float*)lds;
    const int tid = threadIdx.x, kk = tid >> 4, nc = (tid & 15) * 4, n = tid >> 3, kc = (tid & 7) * 8;
    if (g0 >= g1) return;
    __syncthreads();
    TTile cur = late_tile(a, g0);
    f32x4 v0 = {0.f, 0.f, 0.f, 0.f}, v1 = v0;
    if (cur.c0 + nc < cur.ncols) { v0 = *(const f32x4*)(cur.sp + (size_t)(cur.k0 + kk) * cur.ncols + cur.c0 + nc); v1 = *(const f32x4*)(cur.sp + (size_t)(cur.k0 + kk + 32) * cur.ncols + cur.c0 + nc); }
    for (int g = g0; g < g1; ++g) {
        const TTile nxt = late_tile(a, g + 1 < g1 ? g + 1 : g);
        f32x4 w0 = {0.f, 0.f, 0.f, 0.f}, w1 = w0;
        if (nxt.c0 + nc < nxt.ncols) { w0 = *(const f32x4*)(nxt.sp + (size_t)(nxt.k0 + kk) * nxt.ncols + nxt.c0 + nc); w1 = *(const f32x4*)(nxt.sp + (size_t)(nxt.k0 + kk + 32) * nxt.ncols + nxt.c0 + nc); }
#pragma unroll
        for (int j = 0; j < 4; ++j) { T[(nc + j) * 65 + kk] = v0[j]; T[(nc + j) * 65 + kk + 32] = v1[j]; }
        __syncthreads();
        float f[8];
#pragma unroll
        for (int j = 0; j < 8; ++j) f[j] = T[n * 65 + kc + j];
        *(bf16x8*)(cur.d + (size_t)(cur.n0 + n) * cur.K + cur.k0 + kc) = pack8f(f);
        __syncthreads();
        cur = nxt; v0 = w0; v1 = w1;
    }
}
__device__ __forceinline__ void transpose_late(char* lds, const Args& a, int slot) { const int g0 = slot * LATE_PER, g1 = (slot + 1) * LATE_PER < LATE_A ? (slot + 1) * LATE_PER : LATE_A; transpose_span(lds, a, g0, g1); }
__device__ __forceinline__ void transpose_late_d(char* lds, const Args& a, int slot) { transpose_span(lds, a, LATE_A + slot * LATE_D_PER, LATE_A + (slot + 1) * LATE_D_PER); }
__device__ __forceinline__ void p0_prologue(char* lds, const Args& a) {
    const int tid = threadIdx.x;
    const size_t gt = (size_t)blockIdx.x * NTHREADS + tid, gs = (size_t)gridDim.x * NTHREADS;
    { const float* x = a.in[0]; bf16_t* xb = (bf16_t*)(a.ws + WS_XB);
      for (size_t i = gt; i < (size_t)M_TOK * DM / 8; i += gs) { const f32x4 v0 = *(const f32x4*)(x + i * 8), v1 = *(const f32x4*)(x + i * 8 + 4);
          float f[8] = {v0[0], v0[1], v0[2], v0[3], v1[0], v1[1], v1[2], v1[3]}; *(bf16x8*)(xb + i * 8) = pack8f(f); } }
    { f32x2* rp = (f32x2*)(a.ws + WS_ROPE);
      for (size_t i = gt; i < (size_t)SEQ * 32; i += gs) { const int pos = (int)(i >> 5), j = (int)(i & 31);
          const double inv = exp(-(double)j / 32.0 * 9.210340371976184  ); const double ang = (double)pos * inv; rp[i] = (f32x2){(float)cos(ang), (float)sin(ang)}; } }
    transpose_jobs(lds, a);
}

__device__ __forceinline__ float softcap15(float z) { return 15.0f * tanhf(z * (1.0f / 15.0f)); }
__device__ __forceinline__ float logsigmoid_f(float z) { return fminf(z, 0.f) - log1pf(__expf(-fabsf(z))); }
__device__ __forceinline__ void p2_prep(char* lds, const Args& a) {
    const int tid = threadIdx.x, lane = tid & 63, wid = __builtin_amdgcn_readfirstlane(tid >> 6);
    const int gw = blockIdx.x * 8 + wid, nw = gridDim.x * 8;
    const bf16_t* proj = (const bf16_t*)(a.ws + WS_R);
    for (int bh = blockIdx.x; bh < 16; bh += gridDim.x) {
        const int b = bh >> 2, h = bh & 3;
        const float* gates = (const float*)(a.ws + WS_GATES);
        f32x2* mg = (f32x2*)(a.ws + WS_MG) + (size_t)bh * SEQ; float* fl = (float*)(a.ws + WS_FLOOR) + (size_t)bh * SEQ;
        float* at = (float*)(a.ws + WS_AT) + (size_t)bh * SEQ; float* aa = (float*)(a.ws + WS_AA) + (size_t)bh * SEQ;
        const float bi = a.in[2][h], bfg = a.in[3][h];
        float* S = (float*)lds;
        float li[8], lf[8], Fl[8], Al[8];
#pragma unroll
        for (int i = 0; i < 8; ++i) { const int c = wid * 8 + i, t = c * 64 + lane; const float* g = gates + (size_t)(b * SEQ + t) * 8;
            li[i] = softcap15(g[h] + bi); lf[i] = logsigmoid_f(softcap15(g[4 + h] + bfg));
            float F = lf[i];
#pragma unroll
            for (int o = 1; o < 64; o <<= 1) { const float y = __shfl_up(F, o); if (lane >= o) F += y; }
            float A = li[i] - F;
#pragma unroll
            for (int o = 1; o < 64; o <<= 1) { const float y = __shfl_up(A, o); if (lane >= o) A = fmaxf(A, y); }
            Fl[i] = F; Al[i] = A;
            if (lane == 63) { S[c] = F; S[64 + c] = A; } }
        __syncthreads();
        float Fc_all, Ac_all;
        { const float sF = S[lane], mA = S[64 + lane];
          float inc = sF;
#pragma unroll
          for (int o = 1; o < 64; o <<= 1) { const float y = __shfl_up(inc, o); if (lane >= o) inc += y; }
          Fc_all = inc - sF;
          float X = mA - Fc_all;
#pragma unroll
          for (int o = 1; o < 64; o <<= 1) { const float y = __shfl_up(X, o); if (lane >= o) X = fmaxf(X, y); }
          const float xp = __shfl_up(X, 1); Ac_all = lane == 0 ? 0.f : fmaxf(xp, 0.f); }
        __syncthreads();
#pragma unroll
        for (int i = 0; i < 8; ++i) { const int c = wid * 8 + i, t = c * 64 + lane;
            const float Fc = __shfl(Fc_all, c), Ac = __shfl(Ac_all, c);
            const float F = Fl[i] + Fc, A = fmaxf(Al[i] - Fc, Ac), m = F + A;
            float mp = __shfl_up(m, 1); if (lane == 0) mp = Fc + Ac;
            mg[t] = (f32x2){__expf(lf[i] + mp - m), __expf(li[i] - m)}; fl[t] = __expf(-m);
            at[t] = li[i] - F; aa[t] = A; }
    }
    const float* qn = a.in[5]; const float* kvn = a.in[6];
    bf16_t* cqn = (bf16_t*)(a.ws + WS_CQN); bf16_t* ckvn = (bf16_t*)(a.ws + WS_CKVN); bf16_t* krope = (bf16_t*)(a.ws + WS_KROPE);
    const f32x2* rp = (const f32x2*)(a.ws + WS_ROPE);
    for (int tk = gw; tk < M_TOK; tk += nw) {
        const bf16_t* row = proj + (size_t)tk * AB_NP;
        float x0[8], x1[8], y[8];
        unpack8(*(const bf16x8*)(row + AB_CQ + lane * 8), x0); unpack8(*(const bf16x8*)(row + AB_CQ + 512 + lane * 8), x1); unpack8(*(const bf16x8*)(row + AB_CKV + lane * 8), y);
        const float kr = bf2f(row[AB_KR + lane]);
        float s = 0.f, s2 = 0.f;
#pragma unroll
        for (int j = 0; j < 8; ++j) { s += x0[j] * x0[j] + x1[j] * x1[j]; s2 += y[j] * y[j]; }
        s = wave_sum(s); s2 = wave_sum(s2);
        const float r1 = rsqrtf(s * (1.0f / 1024.0f) + RMS_EPS), r2 = rsqrtf(s2 * (1.0f / 512.0f) + RMS_EPS);
#pragma unroll
        for (int j = 0; j < 8; ++j) { x0[j] *= r1 * qn[lane * 8 + j]; x1[j] *= r1 * qn[512 + lane * 8 + j]; y[j] *= r2 * kvn[lane * 8 + j]; }
        *(bf16x8*)(cqn + (size_t)tk * 1024 + lane * 8) = pack8f(x0); *(bf16x8*)(cqn + (size_t)tk * 1024 + 512 + lane * 8) = pack8f(x1);
        *(bf16x8*)(ckvn + (size_t)tk * 512 + lane * 8) = pack8f(y);
        const float pr = __shfl_xor(kr, 32); const f32x2 cs = rp[(size_t)(tk & (SEQ - 1)) * 32 + (lane & 31)];
        const float out = lane < 32 ? kr * cs.x - pr * cs.y : pr * cs.y + kr * cs.x;
        krope[(size_t)tk * 64 + lane] = f2bf(out);
    }
}

__device__ __forceinline__ float dpp_xor1(float v) { return __int_as_float(__builtin_amdgcn_update_dpp(0, __float_as_int(v), 0xB1, 0xF, 0xF, true)); }
__device__ __forceinline__ float dpp_xor2(float v) { return __int_as_float(__builtin_amdgcn_update_dpp(0, __float_as_int(v), 0x4E, 0xF, 0xF, true)); }
__device__ __forceinline__ float dpp_hmir(float v) { return __int_as_float(__builtin_amdgcn_update_dpp(0, __float_as_int(v), 0x141, 0xF, 0xF, true)); }
__device__ __forceinline__ float dpp_mir(float v)  { return __int_as_float(__builtin_amdgcn_update_dpp(0, __float_as_int(v), 0x140, 0xF, 0xF, true)); }
__device__ __forceinline__ float row16_sum(float v) { v += dpp_xor1(v); v += dpp_xor2(v); v += dpp_hmir(v); v += dpp_mir(v); return v; }
__device__ __forceinline__ float swap32_sum(float a, float b) {
    auto rr = __builtin_amdgcn_permlane32_swap(__float_as_uint(a), __float_as_uint(b), false, false); return __uint_as_float(rr[0]) + __uint_as_float(rr[1]); }
constexpr int ML_CH = 32;
constexpr int ML_Q = 0, ML_K = ML_CH * 256 * 4, ML_V = 2 * ML_CH * 256 * 4, ML_FI = ML_V + ML_CH * 32 * 4, ML_BUF = ML_FI + ML_CH * 8;
constexpr int ML_OUT = 2 * ML_BUF, ML_DEN = ML_OUT + ML_CH * 32 * 4, ML_END = ML_DEN + ML_CH * 4;
static_assert(ML_END <= LDS_CTL_OFF, "mLSTM LDS");
__device__ __forceinline__ void p4_mlstm(char* lds, const Args& a) {
    const int tid = threadIdx.x, lane = tid & 63, wid = __builtin_amdgcn_readfirstlane(tid >> 6);
    const bf16_t* proj = (const bf16_t*)(a.ws + WS_R); bf16_t* hcat = (bf16_t*)a.out;
    for (int unit = blockIdx.x; unit < 256; unit += gridDim.x) {
        const int bh = unit >> 4, sl = unit & 15, b = bh >> 2, h = bh & 3;
        const f32x2* mg = (const f32x2*)(a.ws + WS_MG) + (size_t)bh * SEQ;
        float* den = (float*)(a.ws + WS_DEN) + (size_t)bh * SEQ;
        const bool denw = (wid == 0) && (sl == 0);
        const int st = tid >> 4, sp = (tid & 15) * 16, vt = tid >> 2, vp = (tid & 3) * 8;
        const bf16_t* qsrc = proj + (size_t)(b * SEQ + st) * AB_NP + AB_Q + h * 256 + sp;
        const bf16_t* ksrc = proj + (size_t)(b * SEQ + st) * AB_NP + AB_K + h * 256 + sp;
        const bf16_t* vsrc = proj + (size_t)(b * SEQ + vt) * AB_NP + AB_V + h * 512 + sl * 32 + vp;
        bf16x8 rq0, rq1, rk0, rk1, rv; f32x2 rfi;
#define ML_LOAD(c) do { const size_t o_ = (size_t)(c) * ML_CH * AB_NP; rq0 = *(const bf16x8*)(qsrc + o_); rq1 = *(const bf16x8*)(qsrc + o_ + 8); rk0 = *(const bf16x8*)(ksrc + o_); rk1 = *(const bf16x8*)(ksrc + o_ + 8); \
        if (tid < 128) rv = *(const bf16x8*)(vsrc + o_); if (tid < ML_CH) rfi = mg[(c) * ML_CH + tid]; } while (0)
#define ML_STORE(bufp) do { float f_[8]; float* Q_ = (float*)((bufp) + ML_Q) + st * 256 + sp; float* K_ = (float*)((bufp) + ML_K) + st * 256 + sp; \
        unpack8(rq0, f_); *(f32x4*)(Q_) = (f32x4){f_[0], f_[1], f_[2], f_[3]}; *(f32x4*)(Q_ + 4) = (f32x4){f_[4], f_[5], f_[6], f_[7]}; \
        unpack8(rq1, f_); *(f32x4*)(Q_ + 8) = (f32x4){f_[0], f_[1], f_[2], f_[3]}; *(f32x4*)(Q_ + 12) = (f32x4){f_[4], f_[5], f_[6], f_[7]}; \
        unpack8(rk0, f_); *(f32x4*)(K_) = (f32x4){f_[0], f_[1], f_[2], f_[3]} * 0.0625f; *(f32x4*)(K_ + 4) = (f32x4){f_[4], f_[5], f_[6], f_[7]} * 0.0625f; \
        unpack8(rk1, f_); *(f32x4*)(K_ + 8) = (f32x4){f_[0], f_[1], f_[2], f_[3]} * 0.0625f; *(f32x4*)(K_ + 12) = (f32x4){f_[4], f_[5], f_[6], f_[7]} * 0.0625f; \
        if (tid < 128) { float* V_ = (float*)((bufp) + ML_V) + vt * 32 + vp; unpack8(rv, f_); *(f32x4*)(V_) = (f32x4){f_[0], f_[1], f_[2], f_[3]}; *(f32x4*)(V_ + 4) = (f32x4){f_[4], f_[5], f_[6], f_[7]}; } \
        if (tid < ML_CH) ((f32x2*)((bufp) + ML_FI))[tid] = rfi; } while (0)
        f32x4 C0 = {0.f, 0.f, 0.f, 0.f}, C1 = C0, C2 = C0, C3 = C0, n4 = C0;
        __syncthreads();
        ML_LOAD(0); ML_STORE(lds); __syncthreads();
        float* OUT = (float*)(lds + ML_OUT); float* DENs = (float*)(lds + ML_DEN);
        for (int c = 0; c < SEQ / ML_CH; ++c) {
            char* buf = lds + (c & 1) * ML_BUF;
            if (c + 1 < SEQ / ML_CH) ML_LOAD(c + 1);
            const float* Qs = (const float*)(buf + ML_Q) + lane * 4; const float* Ks = (const float*)(buf + ML_K) + lane * 4;
            const float* Vs = (const float*)(buf + ML_V) + wid * 4; const f32x2* FIs = (const f32x2*)(buf + ML_FI);
#pragma unroll 4
            for (int s = 0; s < ML_CH; ++s) {
                const f32x4 q4 = *(const f32x4*)(Qs + s * 256), k4 = *(const f32x4*)(Ks + s * 256), v4 = *(const f32x4*)(Vs + s * 32); const f32x2 fi = FIs[s];
                const f32x4 iv = v4 * fi.y;
                C0 = C0 * fi.x + iv * k4[0]; C1 = C1 * fi.x + iv * k4[1]; C2 = C2 * fi.x + iv * k4[2]; C3 = C3 * fi.x + iv * k4[3];
                f32x4 d = C0 * q4[0] + C1 * q4[1] + C2 * q4[2] + C3 * q4[3];
                float e0 = swap32_sum(d[0], d[2]), e1 = swap32_sum(d[1], d[3]);
                const float other = __shfl_xor((lane & 16) ? e0 : e1, 16);
                float r = ((lane & 16) ? e1 : e0) + other;
                r = row16_sum(r);
                if ((lane & 15) == 0) OUT[s * 32 + wid * 4 + (lane >> 5) * 2 + ((lane >> 4) & 1)] = r;
                if (denw) { n4 = n4 * fi.x + k4 * fi.y; float dn = n4[0] * q4[0] + n4[1] * q4[1] + n4[2] * q4[2] + n4[3] * q4[3];
                    dn = swap32_sum(dn, dn); dn += __shfl_xor(dn, 16); dn = row16_sum(dn); if (lane == 0) DENs[s] = dn; }
            }
            __syncthreads();
            if (tid < 128) { const float* o_ = OUT + vt * 32 + vp; float f[8];
#pragma unroll
                for (int j = 0; j < 8; ++j) f[j] = o_[j];
                *(bf16x8*)(hcat + (size_t)(b * SEQ + c * ML_CH + vt) * DM + h * 512 + sl * 32 + vp) = pack8f(f); }
            if (sl == 0 && tid < ML_CH) den[c * ML_CH + tid] = DENs[tid];
            if (c + 1 < SEQ / ML_CH) ML_STORE(lds + ((c + 1) & 1) * ML_BUF);
            __syncthreads();
        }
#undef ML_LOAD
#undef ML_STORE
    }
}

#define TRRD(dst, base, off) asm volatile("ds_read_b64_tr_b16 %0, %1 offset:%2" : "=&v"(dst) : "v"(base), "i"(off) : "memory")
#define TRRD(dst, base, off) asm volatile("ds_read_b64_tr_b16 %0, %1 offset:%2" : "=&v"(dst) : "v"(base), "i"(off) : "memory")
namespace mc {
constexpr int L_K = 0, L_Q = 32768, L_V = 65536, L_EV = 81920, L_CT = 98304, L_TAB = 114688, L_G = 116736;
constexpr int T_A = 0, T_AA = 64, T_INT = 128, T_E = 192;
__device__ __forceinline__ int kaddr(int s, int d) { return (d >> 7) * 16384 + s * 256 + (((d & 127) * 2) ^ ((s & 7) << 4)); }
}
#define MC_QF(d0) (*(const bf16x8*)(lds + L_Q + ((d0) >> 3) * 16384 + TB * 8192 + kq[(d0) & 3] + (((d0) >> 2) & 1) * 128))
template <int TB>
__device__ __forceinline__ void mc_inter(char* lds, float* TAB, const int (&kq)[4], int cfrag, int csw, int lane, int hi) {
    using namespace mc;
    f32x16 o = f32x16{};
    bf16x8 fq[2][2], fc[2][2];
#define MJ_LD(g) do { _Pragma("unroll") for (int e = 0; e < 2; ++e) { const int d0 = 2 * (g) + e; fq[(g) & 1][e] = MC_QF(d0); fc[(g) & 1][e] = *(const bf16x8*)(lds + L_CT + cfrag + (((d0 * 16 + hi * 8) * 2) ^ csw)); } } while (0)
#define MJ_MM(g) do { _Pragma("unroll") for (int e = 0; e < 2; ++e) o = __builtin_amdgcn_mfma_f32_32x32x16_bf16(fq[(g) & 1][e], fc[(g) & 1][e], o, 0, 0, 0); } while (0)
    MJ_LD(0); SBAR();
#pragma unroll
    for (int g = 0; g < 8; ++g) { if (g + 1 < 8) { MJ_LD(g + 1); } SBAR(); MJ_MM(g); SBAR(); }
#undef MJ_LD
#undef MJ_MM
    const float* ti = TAB + T_INT + TB * 32 + 4 * hi; float* G = (float*)(lds + L_G) + TB * 1024 + lane;
#pragma unroll
    for (int r = 0; r < 16; ++r) G[r * 64] = o[r] * ti[(r & 3) + 8 * (r >> 2)];
}
template <int TB>
__device__ __forceinline__ void mc_intra(char* lds, float* TAB, const int (&kq)[4], int vbV, int r32, int hi, f32x16& o, float& ps) {
    using namespace mc;
    const float LOG2E = 1.4426950408889634f;
    const int tl = TB * 32 + r32;
    f32x16 p0 = f32x16{}, p1 = f32x16{};
    bf16x8 fq[2][2], fa0[2][2], fa1[2][2];
#define MI_LD(g) do { _Pragma("unroll") for (int e = 0; e < 2; ++e) { const int d0 = 2 * (g) + e; const char* ap = lds + L_K + (d0 >> 3) * 16384 + kq[d0 & 3] + ((d0 >> 2) & 1) * 128; \
        fq[(g) & 1][e] = MC_QF(d0); fa0[(g) & 1][e] = *(const bf16x8*)ap; if constexpr (TB == 1) fa1[(g) & 1][e] = *(const bf16x8*)(ap + 8192); } } while (0)
#define MI_MM(g) do { _Pragma("unroll") for (int e = 0; e < 2; ++e) { p0 = __builtin_amdgcn_mfma_f32_32x32x16_bf16(fa0[(g) & 1][e], fq[(g) & 1][e], p0, 0, 0, 0); \
        if constexpr (TB == 1) p1 = __builtin_amdgcn_mfma_f32_32x32x16_bf16(fa1[(g) & 1][e], fq[(g) & 1][e], p1, 0, 0, 0); } } while (0)
    MI_LD(0); SBAR();
#pragma unroll
    for (int g = 0; g < 8; ++g) { if (g + 1 < 8) { MI_LD(g + 1); } SBAR(); MI_MM(g); SBAR(); }
#undef MI_LD
#undef MI_MM
    const float At = TAB[T_AA + tl];
    ps = 0.f;
    const float* ta = TAB + T_A + 4 * hi;
#pragma unroll
    for (int r = 0; r < 16; ++r) { const int s0 = fa::crow(r, hi), c0 = (r & 3) + 8 * (r >> 2);
        const float e0 = __builtin_amdgcn_exp2f((ta[c0] - At) * LOG2E) * 0.0625f; const float w0 = (s0 <= tl) ? e0 : 0.f; p0[r] *= w0; ps += p0[r];
        if constexpr (TB == 1) { const float e1 = __builtin_amdgcn_exp2f((ta[32 + c0] - At) * LOG2E) * 0.0625f; const float w1 = (s0 + 32 <= tl) ? e1 : 0.f; p1[r] *= w1; ps += p1[r]; } }
    { auto rr = __builtin_amdgcn_permlane32_swap(__float_as_uint(ps), __float_as_uint(ps), false, false); ps = __uint_as_float(rr[0]) + __uint_as_float(rr[1]); }
    bf16x8 pa0, pa1, pa2, pa3;
#define PK4(P, B_, OUT) do { unsigned a0 = fa::cvtpk(P[B_+0], P[B_+1]), a1 = fa::cvtpk(P[B_+2], P[B_+3]);                  \
        unsigned b0_ = fa::cvtpk(P[B_+4], P[B_+5]), b1_ = fa::cvtpk(P[B_+6], P[B_+7]);                                   \
        auto r0 = __builtin_amdgcn_permlane32_swap(a0, b0_, false, false); auto r1 = __builtin_amdgcn_permlane32_swap(a1, b1_, false, false); \
        u32x4 w = {r0[0], r1[0], r0[1], r1[1]}; OUT = *reinterpret_cast<bf16x8*>(&w); } while (0)
    PK4(p0, 0, pa0); PK4(p0, 8, pa1); PK4(p1, 0, pa2); PK4(p1, 8, pa3);
#undef PK4
    o = f32x16{};
    { s16x4 l0, l1, l2, l3, h0, h1, h2, h3;
      TRRD(l0, vbV, 0); TRRD(h0, vbV, 2048); TRRD(l1, vbV, 4096); TRRD(h1, vbV, 6144); TRRD(l2, vbV, 8192); TRRD(h2, vbV, 10240); TRRD(l3, vbV, 12288); TRRD(h3, vbV, 14336);
      asm volatile("s_waitcnt lgkmcnt(0)" ::: "memory"); SBAR();
      o = __builtin_amdgcn_mfma_f32_32x32x16_bf16(pa0, (bf16x8){l0[0], l0[1], l0[2], l0[3], h0[0], h0[1], h0[2], h0[3]}, o, 0, 0, 0);
      o = __builtin_amdgcn_mfma_f32_32x32x16_bf16(pa1, (bf16x8){l1[0], l1[1], l1[2], l1[3], h1[0], h1[1], h1[2], h1[3]}, o, 0, 0, 0);
      if constexpr (TB == 1) { o = __builtin_amdgcn_mfma_f32_32x32x16_bf16(pa2, (bf16x8){l2[0], l2[1], l2[2], l2[3], h2[0], h2[1], h2[2], h2[3]}, o, 0, 0, 0);
                               o = __builtin_amdgcn_mfma_f32_32x32x16_bf16(pa3, (bf16x8){l3[0], l3[1], l3[2], l3[3], h3[0], h3[1], h3[2], h3[3]}, o, 0, 0, 0); } }
}
#undef MC_QF
__device__ __forceinline__ void p4_mlstm_chunk(char* lds, const Args& a) {
    using namespace mc;
    const int tid = threadIdx.x, lane = tid & 63, wid = __builtin_amdgcn_readfirstlane(tid >> 6);
    const bf16_t* proj = (const bf16_t*)(a.ws + WS_R); bf16_t* hcat = (bf16_t*)a.out;
    float* TAB = (float*)(lds + L_TAB);
    const float LOG2E = 1.4426950408889634f;
    for (int unit = blockIdx.x; unit < 256; unit += gridDim.x) {
        const int bh = (gridDim.x == 256) ? 2 * (unit & 7) + (unit >> 7) : unit >> 4, sl = (gridDim.x == 256) ? (unit >> 3) & 15 : unit & 15, b = bh >> 2, h = bh & 3;
        const float* AT = (const float*)(a.ws + WS_AT) + (size_t)bh * SEQ; const float* AA = (const float*)(a.ws + WS_AA) + (size_t)bh * SEQ;
        float* deni = (float*)(a.ws + WS_DENI) + (size_t)bh * SEQ; float* denp = (float*)(a.ws + WS_DENP) + (size_t)(bh * 16 + sl) * SEQ;
        const int krow = tid >> 3, kch = (tid & 7) * 4, vrow = (tid >> 2) & 63, vch = tid & 3;
        const bf16_t* ksrc = proj + (size_t)(b * SEQ + krow) * AB_NP + AB_K + h * 256 + kch * 8;
        const bf16_t* qsrc = proj + (size_t)(b * SEQ + krow) * AB_NP + AB_Q + h * 256 + kch * 8;
        const bf16_t* vsrc = proj + (size_t)(b * SEQ + vrow) * AB_NP + AB_V + h * 512 + sl * 32 + vch * 8;
        int kdst[4];
#pragma unroll
        for (int i = 0; i < 4; ++i) { const int ch = kch + i; kdst[i] = (ch >> 4) * 16384 + KSWZ(krow, (ch & 15) * 16); }
        const int vdst = fa::v_st(vrow, vch * 8);
        bf16x8 rk[4], rq[4], rv; float pa_t = 0.f, pA_t = 0.f, pa_v = 0.f, pA_prev = 0.f, pA_end = 0.f;
#define MC_LOAD(c) do { const size_t o_ = (size_t)(c) * 64 * AB_NP; _Pragma("unroll") for (int i = 0; i < 4; ++i) { rk[i] = *(const bf16x8*)(ksrc + o_ + i * 8); rq[i] = *(const bf16x8*)(qsrc + o_ + i * 8); } \
        if (tid < 256) { rv = *(const bf16x8*)(vsrc + o_); pa_v = AT[(c) * 64 + vrow]; } if (tid < 64) { pa_t = AT[(c) * 64 + tid]; pA_t = AA[(c) * 64 + tid]; } \
        pA_end = AA[(c) * 64 + 63]; pA_prev = (c) > 0 ? AA[(c) * 64 - 1] : 0.f; } while (0)
        f32x16 Cacc = f32x16{};
        f32x16 oi = f32x16{}; float psi = 0.f;
        float nreg = 0.f;
        __syncthreads();
        for (int i = tid; i < 16384 / 16; i += NTHREADS) *(u32x4*)(lds + L_CT + i * 16) = (u32x4){0u, 0u, 0u, 0u};
        MC_LOAD(0);
        for (int c = 0; c < SEQ / 64; ++c) {
            const int t0 = c * 64;
            const float A_prev = pA_prev, A_end = pA_end;
            asm volatile("s_waitcnt vmcnt(0)" ::: "memory");
#pragma unroll
            for (int i = 0; i < 4; ++i) { *(bf16x8*)(lds + L_K + kdst[i]) = rk[i]; *(bf16x8*)(lds + L_Q + kdst[i]) = rq[i]; }
            if (tid < 256) { *(bf16x8*)(lds + L_V + vdst) = rv; const float e = __builtin_amdgcn_exp2f((pa_v - A_end) * LOG2E) * 0.0625f;
                float f[8]; unpack8(rv, f);
#pragma unroll
                for (int j = 0; j < 8; ++j) f[j] *= e;
                *(bf16x8*)(lds + L_EV + vdst) = pack8f(f); }
            if (tid < 64) { TAB[T_A + tid] = pa_t; TAB[T_AA + tid] = pA_t; TAB[T_INT + tid] = __builtin_amdgcn_exp2f((A_prev - pA_t) * LOG2E); TAB[T_E + tid] = __builtin_amdgcn_exp2f((pa_t - A_end) * LOG2E) * 0.0625f; }
            __syncthreads();
            if (c + 1 < SEQ / 64) MC_LOAD(c + 1);
            const float decay = __builtin_amdgcn_exp2f((A_prev - A_end) * LOG2E);
            int lane_o = lane; asm volatile("" : "+v"(lane_o));
            const int r32 = lane_o & 31, hi = lane_o >> 5;
            int kq[4];
#pragma unroll
            for (int dd = 0; dd < 4; ++dd) kq[dd] = KSWZ(r32, dd * 32 + hi * 16);
            const int cfrag = r32 * 512, csw = (r32 & 15) << 4;
            const int trq = (lane_o & 15) >> 2, trp = lane_o & 3, trg = (lane_o >> 4) & 1;
            const int vbV = (int)(uintptr_t)lds + L_V + fa::v_rd_base(lane_o), vbE = (int)(uintptr_t)lds + L_EV + fa::v_rd_base(lane_o);
            if (wid == 0) mc_intra<0>(lds, TAB, kq, vbV, r32, hi, oi, psi);
            else if (wid == 1) mc_intra<1>(lds, TAB, kq, vbV, r32, hi, oi, psi);
            else if (wid == 2) mc_inter<0>(lds, TAB, kq, cfrag, csw, lane_o, hi);
            else if (wid == 3) mc_inter<1>(lds, TAB, kq, cfrag, csw, lane_o, hi);
            if (wid == 7) {
                const int d0_ = 16 * sl;
                float qv[16]; { float f[8]; unpack8(*(const bf16x8*)(lds + L_Q + kaddr(lane, d0_)), f);
#pragma unroll
                    for (int j = 0; j < 8; ++j) qv[j] = f[j];
                    unpack8(*(const bf16x8*)(lds + L_Q + kaddr(lane, d0_ + 8)), f);
#pragma unroll
                    for (int j = 0; j < 8; ++j) qv[8 + j] = f[j]; }
                float dsum = 0.f;
#pragma unroll
                for (int d = 0; d < 16; ++d) dsum += qv[d] * __int_as_float(__builtin_amdgcn_readlane(__float_as_int(nreg), d));
                denp[t0 + lane] = dsum * TAB[T_INT + lane];
                const int dd = lane & 15, sq = lane >> 4; float part = 0.f;
#pragma unroll
                for (int j = 0; j < 16; ++j) { const int s = sq * 16 + j; part += TAB[T_E + s] * bf2f(*(const bf16_t*)(lds + L_K + kaddr(s, d0_ + dd))); }
                part += __shfl_xor(part, 16); part += __shfl_xor(part, 32);
                nreg = nreg * decay + part;
            }
            {
#pragma unroll
                for (int r = 0; r < 16; ++r) Cacc[r] *= decay;
                s16x4 l0, l1, l2, l3, h0, h1, h2, h3;
                TRRD(l0, vbE, 0); TRRD(h0, vbE, 2048); TRRD(l1, vbE, 4096); TRRD(h1, vbE, 6144); TRRD(l2, vbE, 8192); TRRD(h2, vbE, 10240); TRRD(l3, vbE, 12288); TRRD(h3, vbE, 14336);
                s16x4 ka[4][2];
                { const int d = 32 * wid + trg * 16 + 4 * trp;
                  const int ad0 = (int)(uintptr_t)lds + L_K + kaddr(8 * hi + trq, d), ad1 = (int)(uintptr_t)lds + L_K + kaddr(8 * hi + 4 + trq, d);
                  TRRD(ka[0][0], ad0, 0); TRRD(ka[0][1], ad1, 0); TRRD(ka[1][0], ad0, 4096); TRRD(ka[1][1], ad1, 4096);
                  TRRD(ka[2][0], ad0, 8192); TRRD(ka[2][1], ad1, 8192); TRRD(ka[3][0], ad0, 12288); TRRD(ka[3][1], ad1, 12288); }
                asm volatile("s_waitcnt lgkmcnt(0)" ::: "memory"); SBAR();
#define KAF(ks) (bf16x8){ka[ks][0][0], ka[ks][0][1], ka[ks][0][2], ka[ks][0][3], ka[ks][1][0], ka[ks][1][1], ka[ks][1][2], ka[ks][1][3]}
                Cacc = __builtin_amdgcn_mfma_f32_32x32x16_bf16(KAF(0), (bf16x8){l0[0], l0[1], l0[2], l0[3], h0[0], h0[1], h0[2], h0[3]}, Cacc, 0, 0, 0);
                Cacc = __builtin_amdgcn_mfma_f32_32x32x16_bf16(KAF(1), (bf16x8){l1[0], l1[1], l1[2], l1[3], h1[0], h1[1], h1[2], h1[3]}, Cacc, 0, 0, 0);
                Cacc = __builtin_amdgcn_mfma_f32_32x32x16_bf16(KAF(2), (bf16x8){l2[0], l2[1], l2[2], l2[3], h2[0], h2[1], h2[2], h2[3]}, Cacc, 0, 0, 0);
                Cacc = __builtin_amdgcn_mfma_f32_32x32x16_bf16(KAF(3), (bf16x8){l3[0], l3[1], l3[2], l3[3], h3[0], h3[1], h3[2], h3[3]}, Cacc, 0, 0, 0);
#undef KAF
            }
            __syncthreads();
            float one = 1.0f; asm volatile("" : "+v"(one));
#pragma unroll
            for (int g = 0; g < 4; ++g) { const int d4 = 32 * wid + 8 * g + 4 * hi; u32x2 w; w.x = cvt_pk_bf16(Cacc[4 * g] * one, Cacc[4 * g + 1] * one); w.y = cvt_pk_bf16(Cacc[4 * g + 2] * one, Cacc[4 * g + 3] * one);
                *(u32x2*)(lds + L_CT + cfrag + ((d4 * 2) ^ csw)) = w; }
            if (wid < 2) {
                const float* G = (const float*)(lds + L_G) + wid * 1024 + lane_o;
                bf16_t* ob = hcat + (size_t)(b * SEQ + t0 + wid * 32) * DM + h * 512 + sl * 32;
                const int lofs = hi * 4 * DM + r32;
#pragma unroll
                for (int r = 0; r < 16; ++r) { const float v = oi[r] + G[r * 64], vn = dpp_xor1(v);
                    if ((r32 & 1) == 0) *(unsigned*)((ob + (size_t)((r & 3) + 8 * (r >> 2)) * DM) + lofs) = cvt_pk_bf16(v, vn); }
                if (sl == 0 && hi == 0) deni[t0 + wid * 32 + r32] = psi;
            }
        }
#undef MC_LOAD
        __syncthreads();
    }
}
#undef TRRD

__device__ __forceinline__ void p5_mlstm_norm(const Args& a) {
    const int tid = threadIdx.x, lane = tid & 63, wid = tid >> 6;
    const int gw = blockIdx.x * 8 + wid, nw = gridDim.x * 8;
    const bf16_t* proj = (const bf16_t*)(a.ws + WS_R); bf16_t* hcat = (bf16_t*)a.out;
    const float* den = (const float*)(a.ws + WS_DEN); const float* fl = (const float*)(a.ws + WS_FLOOR); const float* mn = a.in[4];
    for (int it = gw; it < M_TOK * 4; it += nw) {
        const int tk = it >> 2, h = it & 3, b = tk >> 12, t = tk & (SEQ - 1), bh = b * 4 + h;
        bf16_t* hp = hcat + (size_t)tk * DM + h * 512 + lane * 8;
        float x[8], og[8];
        unpack8(*(const bf16x8*)hp, x); unpack8(*(const bf16x8*)(proj + (size_t)tk * AB_NP + AB_OG + h * 512 + lane * 8), og);
#if MLSTM_CHUNK && !MLSTM_BOTH && (DEBUG_CMP < 0)
        float dsum = ((const float*)(a.ws + WS_DENI))[(size_t)bh * SEQ + t];
#pragma unroll
        for (int q = 0; q < 16; ++q) dsum += ((const float*)(a.ws + WS_DENP))[(size_t)(bh * 16 + q) * SEQ + t];
#else
        const float dsum = den[(size_t)bh * SEQ + t];
#endif
        const float dd = fmaxf(fabsf(dsum), fl[(size_t)bh * SEQ + t]); const float inv = 1.0f / dd;
        float s = 0.f;
#pragma unroll
        for (int j = 0; j < 8; ++j) { x[j] *= inv; s += x[j] * x[j]; }
        s = wave_sum(s);
        const float r = rsqrtf(s * (1.0f / 512.0f) + RMS_EPS);
#pragma unroll
        for (int j = 0; j < 8; ++j) x[j] = x[j] * r * mn[h * 512 + lane * 8 + j] * sigmoid_f(og[j]);
        *(bf16x8*)hp = pack8f(x);
    }
}
__device__ __forceinline__ int xcd_unit(int k, int per, int groups, int upg) {
    const int w = blockIdx.x, G = gridDim.x;
    if (G != 256 || per * 256 != groups * upg) return w + k * G;
    const int j = w & 7, s = w >> 3, lu = k * 32 + s;
    return (j * (groups >> 3) + lu / upg) * upg + lu % upg;
}
__device__ __forceinline__ void p5_mla(char* lds, const Args& a) {
    const int tid = threadIdx.x, wid = __builtin_amdgcn_readfirstlane(tid >> 6), lane = tid & 63, r32 = lane & 31, hi = lane >> 5;
    const bf16_t* qb = (const bf16_t*)(a.ws + WS_QB); const bf16_t* kvb = (const bf16_t*)(a.ws + WS_KVB); const bf16_t* krope = (const bf16_t*)(a.ws + WS_KROPE);
    bf16_t* hcat = (bf16_t*)a.out;     const f32x2* rp = (const f32x2*)(a.ws + WS_ROPE);
    for (int kk = 0; kk * (int)gridDim.x < 64 * 8 * 2; ++kk) {
        const int it2 = xcd_unit(kk >> 1, 2, 64, 8), pass = kk & 1; if (it2 >= 512) break;
        const int bh = it2 >> 3, x = it2 & 7, b = bh >> 4, h = bh & 15;
        const int qblk = pass ? 15 - x : x, t0 = qblk * 256, pos = t0 + wid * 32 + r32;
        const bf16_t* qrow = qb + (size_t)(b * SEQ + pos) * 3072 + h * 192;
        bf16x8 qr[8], qrr[4];
#pragma unroll
        for (int d0 = 0; d0 < 8; ++d0) qr[d0] = *(const bf16x8*)(qrow + d0 * 16 + hi * 8);
#pragma unroll
        for (int d0 = 0; d0 < 4; ++d0) qrr[d0] = *(const bf16x8*)(qrow + 128 + d0 * 16 + hi * 8);
#pragma unroll
        for (int g = 0; g < 2; ++g) { float x1[8], x2[8], o1[8], o2[8]; unpack8(qrr[g], x1); unpack8(qrr[2 + g], x2);
#pragma unroll
            for (int j = 0; j < 8; ++j) { const f32x2 cs = rp[(size_t)pos * 32 + g * 16 + hi * 8 + j]; o1[j] = x1[j] * cs.x - x2[j] * cs.y; o2[j] = x1[j] * cs.y + x2[j] * cs.x; }
            char* qpark = lds + fa::OFF_QPARK + wid * 4096 + lane * 16;
            *(bf16x8*)(qpark + g * 1024) = pack8f(o1); *(bf16x8*)(qpark + (2 + g) * 1024) = pack8f(o2); }
        fa::FUnit u; u.Kb = kvb + (size_t)(b * SEQ) * 4096 + h * 256; u.ldk = 4096; u.Vb = u.Kb + 128; u.ldv = 4096; u.KRb = krope + (size_t)(b * SEQ) * 64;
        u.j_lo = 0; u.j_hi = (t0 + 255) / 64 + 1; u.qlo = t0 + wid * 32; u.qhi = u.qlo + 31; u.qpos = pos; u.sel = 0ull;
        f32x16 o[4]; float m_reg, l_reg;
        fa::flash_core<0>(lds, u, qr, 0.07216878364870322f, o, m_reg, l_reg);
        float rf[16]; fa::row_factors(lds, wid, r32, hi, 1.0f / l_reg, rf);
        bf16_t* ob = hcat + (size_t)(b * SEQ + t0 + wid * 32) * DM + 2048 + h * 128;
#pragma unroll
        for (int r = 0; r < 16; ++r) { const int orow = fa::crow(r, hi);
#pragma unroll
            for (int d0 = 0; d0 < 4; ++d0) { const float v = o[d0][r] * rf[r]; const float vn = __shfl_xor(v, 1);
                if ((r32 & 1) == 0) *(unsigned*)(ob + (size_t)orow * DM + d0 * 32 + r32) = cvt_pk_bf16(v, vn); } }
        __syncthreads();
    }
}

__device__ __forceinline__ void p7_layernorm(const Args& a, int layer_idx, bool mix, const float* z, float* outf, bf16_t* outb, f32x2* stats) {
    const int tid = threadIdx.x, lane = tid & 63, wid = tid >> 6;
    const int gw = blockIdx.x * 8 + wid, nw = gridDim.x * 8;
    const float* g = (mix ? a.in[22] : a.in[24]) + (size_t)layer_idx * DM; const float* bb = (mix ? a.in[23] : a.in[25]) + (size_t)layer_idx * DM;
    for (int row = gw; row < M_TOK; row += nw) {
        const float* zr = z + (size_t)row * DM;
        f32x4 v[16]; float s = 0.f;
#pragma unroll
        for (int i = 0; i < 16; ++i) { v[i] = *(const f32x4*)(zr + i * 256 + lane * 4); s += (v[i][0] + v[i][1]) + (v[i][2] + v[i][3]); }
        s = wave_sum(s); const float mu = s * (1.0f / DM);
        float q = 0.f;
#pragma unroll
        for (int i = 0; i < 16; ++i) { const f32x4 d = v[i] - mu; q += (d[0] * d[0] + d[1] * d[1]) + (d[2] * d[2] + d[3] * d[3]); }
        q = wave_sum(q); const float rs = rsqrtf(q * (1.0f / DM) + LN_EPS);
        if (stats && lane == 0) stats[row] = (f32x2){mu, rs};
#pragma unroll
        for (int i = 0; i < 16; ++i) { const int c = i * 256 + lane * 4; const f32x4 gg = *(const f32x4*)(g + c), be = *(const f32x4*)(bb + c);
            const f32x4 y = (v[i] - mu) * rs * gg + be;
            if (outf) *(f32x4*)(outf + (size_t)row * DM + c) = y;
            if (outb) { u32x2 w; w.x = cvt_pk_bf16(y[0], y[1]); w.y = cvt_pk_bf16(y[2], y[3]); *(u32x2*)(outb + (size_t)row * DM + c) = w; } }
    }
}
__device__ __forceinline__ void p7_layernorm_b(const Args& a, int layer_idx, bool mix, const bf16_t* zb, float* outf, bf16_t* outb, f32x2* stats) {
    const int tid = threadIdx.x, lane = tid & 63, wid = tid >> 6;
    const int gw = blockIdx.x * 8 + wid, nw = gridDim.x * 8;
    const float* g = (mix ? a.in[22] : a.in[24]) + (size_t)layer_idx * DM; const float* bb = (mix ? a.in[23] : a.in[25]) + (size_t)layer_idx * DM;
    bf16x8 nx[8];
    if (gw < M_TOK) {
#pragma unroll
        for (int i = 0; i < 8; ++i) nx[i] = *(const bf16x8*)(zb + (size_t)gw * DM + i * 512 + lane * 8); }
    for (int row = gw; row < M_TOK; row += nw) {
        float v[8][8]; float s = 0.f;
#pragma unroll
        for (int i = 0; i < 8; ++i) { unpack8h(nx[i], v[i]); s += ((v[i][0] + v[i][1]) + (v[i][2] + v[i][3])) + ((v[i][4] + v[i][5]) + (v[i][6] + v[i][7])); }
        { const int rn = row + nw < M_TOK ? row + nw : row;
#pragma unroll
          for (int i = 0; i < 8; ++i) nx[i] = *(const bf16x8*)(zb + (size_t)rn * DM + i * 512 + lane * 8); }
        s = wave_sum(s); const float mu = s * (1.0f / DM);
        float q = 0.f;
#pragma unroll
        for (int i = 0; i < 8; ++i)
#pragma unroll
            for (int j = 0; j < 8; ++j) { const float d = v[i][j] - mu; q += d * d; }
        q = wave_sum(q); const float rs = rsqrtf(q * (1.0f / DM) + LN_EPS);
        if (stats && lane == 0) stats[row] = (f32x2){mu, rs};
#pragma unroll
        for (int i = 0; i < 8; ++i) { const int c = i * 512 + lane * 8; const f32x4 g0 = *(const f32x4*)(g + c), g1 = *(const f32x4*)(g + c + 4), b0 = *(const f32x4*)(bb + c), b1 = *(const f32x4*)(bb + c + 4);
            float y[8];
#pragma unroll
            for (int j = 0; j < 4; ++j) { y[j] = (v[i][j] - mu) * rs * g0[j] + b0[j]; y[4 + j] = (v[i][4 + j] - mu) * rs * g1[j] + b1[j]; }
            if (outf) { *(f32x4*)(outf + (size_t)row * DM + c) = (f32x4){y[0], y[1], y[2], y[3]}; *(f32x4*)(outf + (size_t)row * DM + c + 4) = (f32x4){y[4], y[5], y[6], y[7]}; }
            if (outb) *(bf16x8*)(outb + (size_t)row * DM + c) = pack8f(y); }
    }
}
__device__ __forceinline__ void p12_blocks(const Args& a) {
    const bf16_t* projc = (const bf16_t*)(a.ws + WS_R);
    const size_t gt = (size_t)blockIdx.x * NTHREADS + threadIdx.x, gs = (size_t)gridDim.x * NTHREADS;
    for (size_t i = gt; i < (size_t)2 * 4096 * 512; i += gs) {
        const int which = (int)(i / ((size_t)4096 * 512)); const int rem = (int)(i % ((size_t)4096 * 512));
        const int r = rem >> 9, l = (rem >> 4) & 31, d8 = rem & 15, g = r & 3, n = (r >> 2) & 255, b = r >> 10;
        bf16_t* A = (bf16_t*)(a.ws + (which ? WS_AV : WS_AK)); const float* pe = which ? a.in[13] : a.in[12];
        float f[8];
        if (n < 255) { unpack8(*(const bf16x8*)(projc + (size_t)(b * SEQ + 16 * n + l) * C_NP + (which ? C_VC : C_KC) + g * 128 + d8 * 8), f);
#pragma unroll
            for (int j = 0; j < 8; ++j) f[j] += pe[l * 128 + d8 * 8 + j]; }
        else {
#pragma unroll
            for (int j = 0; j < 8; ++j) f[j] = 0.f; }
        *(bf16x8*)(A + (size_t)r * 4096 + l * 128 + d8 * 8) = pack8f(f);
    }
}
__device__ __forceinline__ float nsa_gate(const Args& a, int token, int br, int head) {
    const bf16_t* projc = (const bf16_t*)(a.ws + WS_R);
    return sigmoid_f(bf2f(projc[(size_t)token * C_NP + C_GATE + br * 32 + head]) + a.in[11][br * 32 + head]);
}
__device__ __forceinline__ void p15_cmp_attn(char* lds, const Args& a) {
    const int tid = threadIdx.x, wid = __builtin_amdgcn_readfirstlane(tid >> 6), lane = tid & 63, r32 = lane & 31, hi = lane >> 5;
    const bf16_t* projc = (const bf16_t*)(a.ws + WS_R); const bf16_t* kcmp = (const bf16_t*)(a.ws + WS_KCMP); const bf16_t* vcmp = (const bf16_t*)(a.ws + WS_VCMP);
    float* acc = (float*)(a.ws + WS_Z); unsigned long long* selp = (unsigned long long*)(a.ws + WS_SEL);
    const float scale = 0.08838834764831845f, C2 = 1.4426950408889634f * scale;
    float* IMP = (float*)(lds + fa::OFF_IMP);
    for (int kk = 0; kk * (int)gridDim.x < 2048; ++kk) {
        const int unit = xcd_unit(kk, 8, 16, 128); if (unit >= 2048) break;
        const int bg = unit >> 7, xb = unit & 127, b = bg >> 2, g = bg & 3, t0 = xb * 32;
        const int tokl = wid * 4 + (r32 >> 3), head = g * 8 + (r32 & 7), tq = t0 + tokl;
        const bf16_t* qrow = projc + (size_t)(b * SEQ + tq) * C_NP + C_Q + head * 128;
        bf16x8 qr[8];
#pragma unroll
        for (int d0 = 0; d0 < 8; ++d0) qr[d0] = *(const bf16x8*)(qrow + d0 * 16 + hi * 8);
        fa::FUnit u; u.Kb = kcmp + (size_t)(b * 256 * 4 + g) * 256; u.ldk = 1024; u.Vb = vcmp + (size_t)(b * 256 * 4 + g) * 256; u.ldv = 1024; u.KRb = nullptr;
        const int nmax_hi = (t0 + 31 - 31) >> 4;
        u.j_lo = 0; u.j_hi = (nmax_hi >> 6) + 1; u.qlo = (t0 + wid * 4 - 31) >> 4; u.qhi = (t0 + wid * 4 + 3 - 31) >> 4; u.qpos = (tq - 31) >> 4; u.sel = 0ull;
        f32x16 o[4]; float m_reg, l_reg;
        fa::flash_core<3>(lds, u, qr, scale, o, m_reg, l_reg);
        const float inv_l = l_reg > 0.f ? 1.0f / l_reg : 0.f;
        { float rf[16]; fa::row_factors(lds, wid, r32, hi, inv_l * nsa_gate(a, b * SEQ + tq, 0, head), rf);
#pragma unroll
          for (int r = 0; r < 16; ++r) { const int orow = fa::crow(r, hi); const int tk = t0 + wid * 4 + (orow >> 3), hd = g * 8 + (orow & 7);
              float* op = acc + (size_t)(b * SEQ + tk) * DM + hd * 128 + r32;
#pragma unroll
              for (int d0 = 0; d0 < 4; ++d0) op[d0 * 32] = o[d0][r] * rf[r]; } }
        __syncthreads();
        const float mL = -m_reg * C2;
        const int sr = tid >> 4, sc = (tid & 15) * 8, kws = KSWZ(sr, sc * 2);
        for (int t = 0; t < u.j_hi; ++t) {
            const int kb = t * 64;
            const bf16x8 k0 = *(const bf16x8*)(u.Kb + (long)(kb + sr) * u.ldk + sc), k1 = *(const bf16x8*)(u.Kb + (long)(kb + 32 + sr) * u.ldk + sc);
            *(bf16x8*)(lds + fa::OFF_K + kws) = k0; *(bf16x8*)(lds + fa::OFF_K + kws + 32 * 256) = k1;
            __syncthreads();
            f32x16 p0, p1; fa::qkt<0, false, true>(p0, p1, lds, r32, hi, qr);
            fa::mask_tile(p0, p1, u.qpos - kb - 4 * hi, 0x80000000u);
#pragma unroll
            for (int r = 0; r < 16; ++r) {
                float a0 = __builtin_amdgcn_exp2f(fmaf(p0[r], C2, mL)) * inv_l, a1 = __builtin_amdgcn_exp2f(fmaf(p1[r], C2, mL)) * inv_l;
                a0 += dpp_xor1(a0); a0 += dpp_xor2(a0); a0 += dpp_hmir(a0);
                a1 += dpp_xor1(a1); a1 += dpp_xor2(a1); a1 += dpp_hmir(a1);
                if ((r32 & 7) == 0) { const int n = kb + fa::crow(r, hi); IMP[tokl * fa::IMP_LD + n] = a0; IMP[tokl * fa::IMP_LD + n + 32] = a1; }
            }
            __syncthreads();
        }
        for (int q4 = 0; q4 < 4; ++q4) {
            const int tl = wid * 4 + q4, tqq = t0 + tl, cur = tqq >> 6, s = lane;
            float v = 0.f;
#pragma unroll
            for (int dn = -1; dn <= 3; ++dn) { const int n = 4 * s + dn; if (n >= 0 && n <= 254 && n < u.j_hi * 64) v += IMP[tl * fa::IMP_LD + n]; }
            if (s == 0 || s == cur || s == cur - 1) v = 1e9f;
            if (s > cur) v = -1e30f;
            int rank = 0;
#pragma nounroll
            for (int j = 0; j < 64; ++j) { const float vj = __int_as_float(__builtin_amdgcn_readlane(__float_as_int(v), j)); rank += (vj > v || (vj == v && j < s)) ? 1 : 0; }
            const unsigned long long msk = __ballot(rank < 16);
            if (lane == 0) selp[(size_t)bg * SEQ + tqq] = msk;
        }
        __syncthreads();
    }
}
template <int MODE, int VAR = 0>
__device__ __forceinline__ void p16_nsa_attn(char* lds, const Args& a) {
    const int tid = threadIdx.x, wid = __builtin_amdgcn_readfirstlane(tid >> 6), lane = tid & 63, r32 = lane & 31, hi = lane >> 5;
    const bf16_t* projc = (const bf16_t*)(a.ws + WS_R); float* acc = (float*)(a.ws + WS_Z); bf16_t* hcat = (bf16_t*)a.out;
    const unsigned long long* selp = (const unsigned long long*)(a.ws + WS_SEL);
    const float scale = 0.08838834764831845f;
    const int nitems = (MODE == 2) ? 2048 : 2048;
    for (int kk = 0; kk * (int)gridDim.x < nitems; ++kk) {
        int bg, xb;
        if (MODE == 2) { const int pass = kk & 1, it2 = xcd_unit(kk >> 1, 4, 16, 64); if (it2 >= 1024) break; bg = it2 >> 6; const int x = it2 & 63; xb = pass ? 127 - x : x; }
        else { const int item = xcd_unit(kk, 8, 16, 128); if (item >= 2048) break; bg = item >> 7; xb = item & 127; }
        const int b = bg >> 2, g = bg & 3, t0 = xb * 32, head = g * 8 + wid, tq = t0 + r32;
        const bf16_t* qrow = projc + (size_t)(b * SEQ + tq) * C_NP + C_Q + head * 128;
        bf16x8 qr[8];
#pragma unroll
        for (int d0 = 0; d0 < 8; ++d0) qr[d0] = *(const bf16x8*)(qrow + d0 * 16 + hi * 8);
        fa::FUnit u; u.KRb = nullptr; u.ldk = C_NP; u.ldv = C_NP; u.qlo = t0; u.qhi = t0 + 31; u.qpos = tq; u.sel = 0ull;
        if (MODE == 1) { u.Kb = projc + (size_t)(b * SEQ) * C_NP + C_KW + g * 128; u.Vb = projc + (size_t)(b * SEQ) * C_NP + C_VW + g * 128;
            const int lowk = t0 - 511; u.j_lo = lowk > 0 ? lowk / 64 : 0; u.j_hi = (t0 + 31) / 64 + 1; }
        else { u.Kb = projc + (size_t)(b * SEQ) * C_NP + C_KS + g * 128; u.Vb = projc + (size_t)(b * SEQ) * C_NP + C_VS + g * 128;
            u.j_lo = 0; u.j_hi = (t0 + 31) / 64 + 1; u.sel = selp[(size_t)bg * SEQ + tq]; }
        f32x16 o[4]; float m_reg, l_reg;
#if FLASH2
        fa::flash_core2<MODE>(lds, u, qr, scale, o, m_reg, l_reg);
#else
        fa::flash_core<MODE, VAR>(lds, u, qr, scale, o, m_reg, l_reg);
#endif
        float rf[16]; fa::row_factors(lds, wid, r32, hi, nsa_gate(a, b * SEQ + tq, MODE == 1 ? 2 : 1, head) / l_reg, rf);
        if (VAR != 0) { float sink = 0.f; for (int d0 = 0; d0 < 4; ++d0) for (int r = 0; r < 16; ++r) sink += o[d0][r] * rf[r]; if (sink == 1.2345e-30f) acc[0] = sink; __syncthreads(); continue; }
        const size_t off0 = (size_t)(b * SEQ + t0 + 4 * hi) * DM + head * 128 + r32;
        float av[16][4];
#pragma unroll
        for (int r = 0; r < 16; ++r)
#pragma unroll
            for (int d0 = 0; d0 < 4; ++d0) av[r][d0] = acc[off0 + (size_t)((r & 3) + 8 * (r >> 2)) * DM + d0 * 32];
        asm volatile("" ::: "memory");
#pragma unroll
        for (int r = 0; r < 16; ++r) { const size_t off = off0 + (size_t)((r & 3) + 8 * (r >> 2)) * DM;
#pragma unroll
            for (int d0 = 0; d0 < 4; ++d0) { const float v = av[r][d0] + o[d0][r] * rf[r];
                if (MODE == 1) acc[off + d0 * 32] = v;
                else { const float vn = dpp_xor1(v); if ((r32 & 1) == 0) *(unsigned*)(hcat + off + d0 * 32) = cvt_pk_bf16(v, vn); } } }
        __syncthreads();
    }
}
__device__ __forceinline__ void p1617_nsa_attn(char* lds, const Args& a) {
    const int tid = threadIdx.x, wid = __builtin_amdgcn_readfirstlane(tid >> 6), lane = tid & 63, r32 = lane & 31, hi = lane >> 5;
    const bf16_t* projc = (const bf16_t*)(a.ws + WS_R); const float* acc = (const float*)(a.ws + WS_Z); bf16_t* hcat = (bf16_t*)a.out;
    const unsigned long long* selp = (const unsigned long long*)(a.ws + WS_SEL);
    const float scale = 0.08838834764831845f;
    unsigned* park = (unsigned*)(lds + fa::OFF_IMP) + wid * 2048 + lane;
    static_assert(fa::OFF_IMP + 8 * 8192 <= fa::LDS_END, "park region");
    for (int kk = 0; kk * (int)gridDim.x < 2048; ++kk) {
        const int pass = kk & 1, it2 = xcd_unit(kk >> 1, 4, 16, 64); if (it2 >= 1024) break;
        const int bg = it2 >> 6, x = it2 & 63, xb = pass ? 127 - x : x;
        const int b = bg >> 2, g = bg & 3, t0 = xb * 32, head = g * 8 + wid, tq = t0 + r32;
        const bf16_t* qrow = projc + (size_t)(b * SEQ + tq) * C_NP + C_Q + head * 128;
        bf16x8 qr[8];
#pragma unroll
        for (int d0 = 0; d0 < 8; ++d0) qr[d0] = *(const bf16x8*)(qrow + d0 * 16 + hi * 8);
        fa::FUnit u; u.KRb = nullptr; u.ldk = C_NP; u.ldv = C_NP; u.qlo = t0; u.qhi = t0 + 31; u.qpos = tq; u.sel = 0ull;
        f32x16 o[4]; float m_reg, l_reg; float rf[16];
        { u.Kb = projc + (size_t)(b * SEQ) * C_NP + C_KW + g * 128; u.Vb = projc + (size_t)(b * SEQ) * C_NP + C_VW + g * 128;
          const int lowk = t0 - 511; u.j_lo = lowk > 0 ? lowk / 64 : 0; u.j_hi = (t0 + 31) / 64 + 1; }
        fa::flash_core<1, 0>(lds, u, qr, scale, o, m_reg, l_reg);
        fa::row_factors(lds, wid, r32, hi, nsa_gate(a, b * SEQ + tq, 2, head) / l_reg, rf);
#pragma unroll
        for (int d0 = 0; d0 < 4; ++d0)
#pragma unroll
            for (int r = 0; r < 16; r += 2) park[(d0 * 8 + (r >> 1)) * 64] = cvt_pk_bf16(o[d0][r] * rf[r], o[d0][r + 1] * rf[r + 1]);
        __syncthreads();
        u.Kb = projc + (size_t)(b * SEQ) * C_NP + C_KS + g * 128; u.Vb = projc + (size_t)(b * SEQ) * C_NP + C_VS + g * 128;
        u.j_lo = 0; u.j_hi = (t0 + 31) / 64 + 1; u.sel = selp[(size_t)bg * SEQ + tq];
        fa::flash_core<2, 0>(lds, u, qr, scale, o, m_reg, l_reg);
        fa::row_factors(lds, wid, r32, hi, nsa_gate(a, b * SEQ + tq, 1, head) / l_reg, rf);
        const size_t off0 = (size_t)(b * SEQ + t0 + 4 * hi) * DM + head * 128 + r32;
        float av[16][4];
#pragma unroll
        for (int r = 0; r < 16; ++r)
#pragma unroll
            for (int d0 = 0; d0 < 4; ++d0) av[r][d0] = acc[off0 + (size_t)((r & 3) + 8 * (r >> 2)) * DM + d0 * 32];
        asm volatile("" ::: "memory");
#pragma unroll
        for (int r = 0; r < 16; r += 2) {
#pragma unroll
            for (int d0 = 0; d0 < 4; ++d0) { const unsigned pw = park[(d0 * 8 + (r >> 1)) * 64];
#pragma unroll
                for (int e = 0; e < 2; ++e) { const int rr = r + e; const size_t off = off0 + (size_t)((rr & 3) + 8 * (rr >> 2)) * DM;
                    const float v = av[rr][d0] + __uint_as_float(e ? (pw & 0xffff0000u) : (pw << 16)) + o[d0][rr] * rf[rr];
                    const float vn = dpp_xor1(v); if ((r32 & 1) == 0) *(unsigned*)(hcat + off + d0 * 32) = cvt_pk_bf16(v, vn); } } }
        __syncthreads();
    }
}
__device__ __forceinline__ void p15_17_nsa(char* lds, const Args& a) {
    const int tid = threadIdx.x, wid = __builtin_amdgcn_readfirstlane(tid >> 6), lane = tid & 63;
    const bf16_t* projc = (const bf16_t*)(a.ws + WS_R); const bf16_t* kcmp = (const bf16_t*)(a.ws + WS_KCMP); const bf16_t* vcmp = (const bf16_t*)(a.ws + WS_VCMP); bf16_t* hcat = (bf16_t*)a.out;
    const float scale = 0.08838834764831845f, C2 = 1.4426950408889634f * scale;
    constexpr int ILD = 256;
    float* IMP = (float*)(lds + fa::OFF_V);
    unsigned long long* SELM = (unsigned long long*)(lds + fa::OFF_KR);
    char* PARK = lds + fa::OFF_IMP;
    static_assert(fa::OFF_IMP + 8 * 8192 <= fa::LDS_END, "park region");
    for (int kk = 0; kk * (int)gridDim.x < 2048; ++kk) {
        int lk = lane; asm volatile("" : "+v"(lk));
        const int pass = kk & 1, it2 = xcd_unit(kk >> 1, 4, 16, 64); if (it2 >= 1024) break;
        const int bg = it2 >> 6, x = it2 & 63, xb = pass ? 127 - x : x;
        const int b = bg >> 2, g = bg & 3, t0 = xb * 32;
        f32x16 o[4]; float m_reg, l_reg; float rf[16];
        fa::FUnit u;
        {
        const int tokl = wid * 4 + ((lk & 31) >> 3), head = g * 8 + (lk & 7), tq = t0 + tokl;
        const bf16_t* qrow = projc + (size_t)(b * SEQ + tq) * C_NP + C_Q + head * 128;
        bf16x8 qr[8];
#pragma unroll
        for (int d0 = 0; d0 < 8; ++d0) qr[d0] = *(const bf16x8*)(qrow + d0 * 16 + (lk >> 5) * 8);
        u.Kb = kcmp + (size_t)(b * 256 * 4 + g) * 256; u.ldk = 1024; u.Vb = vcmp + (size_t)(b * 256 * 4 + g) * 256; u.ldv = 1024; u.KRb = nullptr;
        const int nmax_hi = (t0 + 31 - 31) >> 4;
        u.j_lo = 0; u.j_hi = (nmax_hi >> 6) + 1; u.qlo = (t0 + wid * 4 - 31) >> 4; u.qhi = (t0 + wid * 4 + 3 - 31) >> 4; u.qpos = (tq - 31) >> 4; u.sel = 0ull;
        fa::flash_core<3>(lds, u, qr, scale, o, m_reg, l_reg);
        int lo_ = lk; asm volatile("" : "+v"(lo_));
        const int r32 = lo_ & 31, hi = lo_ >> 5;
        const float inv_l = l_reg > 0.f ? 1.0f / l_reg : 0.f;
        fa::row_factors(lds, wid, r32, hi, inv_l * nsa_gate(a, b * SEQ + tq, 0, head), rf);
#pragma unroll
        for (int r = 0; r < 16; ++r) { const int orow = fa::crow(r, hi); char* pp = PARK + (orow & 7) * 8192 + (wid * 4 + (orow >> 3)) * 256 + r32 * 2;
#pragma unroll
            for (int d0 = 0; d0 < 4; ++d0) { const float v = o[d0][r] * rf[r]; const float vn = dpp_xor1(v); if ((r32 & 1) == 0) *(unsigned*)(pp + d0 * 64) = cvt_pk_bf16(v, vn); } }
        __syncthreads();
        const float mL = -m_reg * C2;
        const int sr = tid >> 4, sc = (tid & 15) * 8, kws = KSWZ(sr, sc * 2);
        bf16x8 k0 = *(const bf16x8*)(u.Kb + (long)sr * u.ldk + sc), k1 = *(const bf16x8*)(u.Kb + (long)(32 + sr) * u.ldk + sc);
        for (int t = 0; t < u.j_hi; ++t) {
            const int kb = t * 64;
            *(bf16x8*)(lds + fa::OFF_K + kws) = k0; *(bf16x8*)(lds + fa::OFF_K + kws + 32 * 256) = k1;
            __syncthreads();
            { const int kn = (t + 1 < u.j_hi ? t + 1 : t) * 64;
              k0 = *(const bf16x8*)(u.Kb + (long)(kn + sr) * u.ldk + sc); k1 = *(const bf16x8*)(u.Kb + (long)(kn + 32 + sr) * u.ldk + sc); }
            f32x16 p0, p1; fa::qkt<0, false, true>(p0, p1, lds, r32, hi, qr);
            fa::mask_tile(p0, p1, u.qpos - kb - 4 * hi, 0x80000000u);
#pragma unroll
            for (int r = 0; r < 16; ++r) {
                float a0 = __builtin_amdgcn_exp2f(fmaf(p0[r], C2, mL)) * inv_l, a1 = __builtin_amdgcn_exp2f(fmaf(p1[r], C2, mL)) * inv_l;
                a0 += dpp_xor1(a0); a0 += dpp_xor2(a0); a0 += dpp_hmir(a0);
                a1 += dpp_xor1(a1); a1 += dpp_xor2(a1); a1 += dpp_hmir(a1);
                if ((r32 & 7) == 0) { const int n = kb + fa::crow(r, hi); IMP[tokl * ILD + n] = a0; IMP[tokl * ILD + n + 32] = a1; }
            }
            __syncthreads();
        }
        for (int q4 = 0; q4 < 4; ++q4) {
            const int tl = wid * 4 + q4, tqq = t0 + tl, cur = tqq >> 6, sb = lk;
            float v = 0.f;
#pragma unroll
            for (int dn = -1; dn <= 3; ++dn) { const int n = 4 * sb + dn; if (n >= 0 && n <= 254 && n < u.j_hi * 64) v += IMP[tl * ILD + n]; }
            if (sb == 0 || sb == cur || sb == cur - 1) v = 1e9f;
            if (sb > cur) v = -1e30f;
            unsigned key = __float_as_uint(v); key = (key & 0x80000000u) ? ~key : (key | 0x80000000u); key = (key & 0xFFFFFFC0u) | (unsigned)(63 - sb);
            int rank = 0;
#pragma unroll 8
            for (int j = 0; j < 64; ++j) { const unsigned kj = (unsigned)__builtin_amdgcn_readlane((int)key, j); rank += (kj > key) ? 1 : 0; }
            const unsigned long long msk = __ballot(rank < 16);
            if (lk == 0) SELM[tl] = msk;
        }
        __syncthreads();
        }
        const int head = g * 8 + wid, tq = t0 + (lk & 31);
        const bf16_t* qrow = projc + (size_t)(b * SEQ + tq) * C_NP + C_Q + head * 128;
        bf16x8 qr[8];
#pragma unroll
        for (int d0 = 0; d0 < 8; ++d0) qr[d0] = *(const bf16x8*)(qrow + d0 * 16 + (lk >> 5) * 8);
        u.KRb = nullptr; u.ldk = C_NP; u.ldv = C_NP; u.qlo = t0; u.qhi = t0 + 31; u.qpos = tq; u.sel = 0ull;
        { u.Kb = projc + (size_t)(b * SEQ) * C_NP + C_KW + g * 128; u.Vb = projc + (size_t)(b * SEQ) * C_NP + C_VW + g * 128;
          const int lowk = t0 - 511; u.j_lo = lowk > 0 ? lowk / 64 : 0; u.j_hi = (t0 + 31) / 64 + 1; }
        fa::flash_core<1, 0>(lds, u, qr, scale, o, m_reg, l_reg);
        int lw_ = lk; asm volatile("" : "+v"(lw_));
        { const int r32 = lw_ & 31, hi = lw_ >> 5;
        fa::row_factors(lds, wid, r32, hi, nsa_gate(a, b * SEQ + tq, 2, head) / l_reg, rf);
        char* pw_ = PARK + wid * 8192 + (4 * hi) * 256 + (r32 & ~1) * 2;
#pragma unroll
        for (int r = 0; r < 16; ++r)
#pragma unroll
            for (int d0 = 0; d0 < 4; ++d0) { const float v = o[d0][r] * rf[r]; const float vn = dpp_xor1(v);
                if ((r32 & 1) == 0) { unsigned* q_ = (unsigned*)(pw_ + ((r & 3) + 8 * (r >> 2)) * 256 + d0 * 64); const unsigned pw = *q_;
                    *q_ = cvt_pk_bf16(__uint_as_float(pw << 16) + v, __uint_as_float(pw & 0xffff0000u) + vn); } } }
        __syncthreads();
        u.Kb = projc + (size_t)(b * SEQ) * C_NP + C_KS + g * 128; u.Vb = projc + (size_t)(b * SEQ) * C_NP + C_VS + g * 128;
        u.j_lo = 0; u.j_hi = (t0 + 31) / 64 + 1; u.sel = SELM[lk & 31];
        fa::flash_core<2, 0>(lds, u, qr, scale, o, m_reg, l_reg);
        int ls_ = lk; asm volatile("" : "+v"(ls_));
        const int r32 = ls_ & 31, hi = ls_ >> 5;
        fa::row_factors(lds, wid, r32, hi, nsa_gate(a, b * SEQ + tq, 1, head) / l_reg, rf);
        char* pw_ = PARK + wid * 8192 + (4 * hi) * 256 + (r32 & ~1) * 2;
        bf16_t* ob = hcat + (size_t)(b * SEQ + t0 + 4 * hi) * DM + head * 128 + (r32 & ~1);
#pragma unroll
        for (int r = 0; r < 16; ++r)
#pragma unroll
            for (int d0 = 0; d0 < 4; ++d0) { const float v = o[d0][r] * rf[r]; const float vn = dpp_xor1(v);
                if ((r32 & 1) == 0) { const unsigned pw = *(const unsigned*)(pw_ + ((r & 3) + 8 * (r >> 2)) * 256 + d0 * 64);
                    *(unsigned*)(ob + (size_t)((r & 3) + 8 * (r >> 2)) * DM + d0 * 32) = cvt_pk_bf16(__uint_as_float(pw << 16) + v, __uint_as_float(pw & 0xffff0000u) + vn); } }
        __syncthreads();
    }
}


#ifndef DEBUG_CMP
#define DEBUG_CMP -1
#endif
#if DEBUG_CMP >= 0
__device__ __forceinline__ void dbg_copy(const Args& a) {
    const bf16_t* hcat = (const bf16_t*)(a.ws + WS_XB); bf16_t* dbg = (bf16_t*)(a.ws + WS_Z);
    const size_t gt = (size_t)blockIdx.x * NTHREADS + threadIdx.x, gs = (size_t)gridDim.x * NTHREADS;
    for (size_t i = gt; i < (size_t)M_TOK * 256; i += gs) { const size_t row = i >> 8, c8 = i & 255; *(bf16x8*)(dbg + row * 2048 + c8 * 8) = *(const bf16x8*)(hcat + row * DM + c8 * 8); }
}
__device__ __forceinline__ void dbg_compare(const Args& a) {
    const bf16_t* hcat = (const bf16_t*)(a.ws + WS_XB); const bf16_t* dbg = (const bf16_t*)(a.ws + WS_Z);
    float* accum = (float*)(a.ws + WS_CTL + 32 * 1024);
    const size_t gt = (size_t)blockIdx.x * NTHREADS + threadIdx.x, gs = (size_t)gridDim.x * NTHREADS;
    float sd = 0.f, sr = 0.f;
    for (size_t i = gt; i < (size_t)M_TOK * 256; i += gs) { const size_t row = i >> 8, c8 = i & 255; const int t = (int)(row & (SEQ - 1));
        bool in = false;
        if (DEBUG_CMP == 0) in = t < 32; if (DEBUG_CMP == 1) in = t >= 32 && t < 64; if (DEBUG_CMP == 2) in = t >= 64 && t < 128; if (DEBUG_CMP == 3) in = true;
        if (DEBUG_CMP == 4) in = (t & 63) < 32; if (DEBUG_CMP == 5) in = (t & 63) >= 32;
        if (!in) continue;
        float x[8], y[8]; unpack8(*(const bf16x8*)(hcat + row * DM + c8 * 8), x); unpack8(*(const bf16x8*)(dbg + row * 2048 + c8 * 8), y);
#pragma unroll
        for (int j = 0; j < 8; ++j) { const float d = x[j] - y[j]; sd += d * d; sr += x[j] * x[j]; } }
    sd = wave_sum(sd); sr = wave_sum(sr);
    if ((threadIdx.x & 63) == 0) { atomicAdd((unsigned long long*)accum, (unsigned long long)(sd * 1048576.0f)); atomicAdd((unsigned long long*)accum + 1, (unsigned long long)(sr * 1048576.0f)); }
}
#endif

constexpr int N_PHASES = 23;
__global__ void __launch_bounds__(NTHREADS, 2) fwd(Args args) {
    extern __shared__ __attribute__((aligned(16))) unsigned char shm[];
    char* lds = (char*)shm;
    PG8_LAS unsigned char* ldsg = (PG8_LAS unsigned char*)shm;
    unsigned char* ws = args.ws;
    if (threadIdx.x < 64) ((volatile LAS unsigned*)(ldsg + LDS_CTL_OFF))[threadIdx.x] = 0u;
    __syncthreads();
    XcdBarrier bar = xcd_barrier_post((unsigned*)(ws + WS_CTL), (volatile LAS unsigned*)(ldsg + LDS_CTL_OFF));
    const int lo = args.ph_lo, hi = args.ph_hi, G = gridDim.x, bx = blockIdx.x;
#define IN(k) (lo <= (k) && (k) < hi)
#define SEAM(k) do { if (IN(k) && IN((k) + 1)) xcd_barrier(bar); } while (0)
#define GEMMC(EPI, cidx, Aoff, Boff, Mr, Nr, Kr, ...) do { pg8::Gemm g_{(const pg8::bf16_t*)(ws + (Aoff)), (const pg8::bf16_t*)(ws + (Boff)), (Mr), (Nr), (Kr)}; pg8::StaticOrder S_; S_.init((Mr), (Nr), G, (cidx)); S_.WGM = GEMM_WGM; \
        EPI E_{__VA_ARGS__}; pg8::gemm_phase<EPI, pg8::StaticOrder, true, true>(ldsg, g_, S_, E_); } while (0)
#define GEMM(EPI, ...) GEMMC(EPI, bx, __VA_ARGS__)
#define GEMMA(EPI, Aptr, Boff, Mr, Nr, Kr, ...) do { pg8::Gemm g_{(const pg8::bf16_t*)(Aptr), (const pg8::bf16_t*)(ws + (Boff)), (Mr), (Nr), (Kr)}; pg8::StaticOrder S_; S_.init((Mr), (Nr), G, bx); S_.WGM = GEMM_WGM; \
        EPI E_{__VA_ARGS__}; pg8::gemm_phase<EPI, pg8::StaticOrder, true, true>(ldsg, g_, S_, E_); } while (0)
#define GEMM_WGM gemm_wgm
    float* xres = args.out;
    bf16_t* xb = (bf16_t*)(ws + WS_XB); const bf16_t* hcat = (const bf16_t*)args.out; f32x2* stats = (f32x2*)(ws + WS_STATS);
    bf16_t* zA = (bf16_t*)(ws + WS_Z); bf16_t* zB = (bf16_t*)args.out + (size_t)M_TOK * DM; bf16_t* zC = zA; bf16_t* zD = zA + (size_t)M_TOK * DM;

#ifndef FFN_CHUNKED
#define FFN_CHUNKED 0
#endif
#ifndef WGM_IN
#define WGM_IN 8
#endif
#ifndef WGM_WO
#define WGM_WO 4
#endif
#ifndef WGM_UP
#define WGM_UP 8
#endif
#ifndef WGM_DOWN
#define WGM_DOWN 2
#endif
    int gemm_wgm = 8;
#ifndef PROBE_MASK
#define PROBE_MASK 0u
#endif
#define PB(k) (((PROBE_MASK) >> (k)) & 1u)
#define PH(k, ...) do { if (IN(k)) { __VA_ARGS__; if (PB(k)) { xcd_barrier(bar); __VA_ARGS__; } } SEAM(k); } while (0)
    PH(0, p0_prologue(lds, args));
    gemm_wgm = WGM_IN; PH(1, GEMM(pg8::EpiProj, WS_XB, W_AB, M_TOK, AB_NP, DM, (bf16_t*)(ws + WS_R), AB_NP, (float*)(ws + WS_GATES), AB_IG / 256); if (bx >= 192 && G == 256) transpose_late(lds, args, bx - 192));
    PH(2, p2_prep(lds, args));
    gemm_wgm = 8; if (IN(3)) { GEMM(pg8::EpiB<0>, WS_CQN, W_UQ, M_TOK, 3072, 1024, (bf16_t*)(ws + WS_QB), 3072); GEMM(pg8::EpiB<0>, WS_CKVN, W_UKV, M_TOK, 4096, 512, (bf16_t*)(ws + WS_KVB), 4096); }
    if (!(IN(3) && IN(4))) SEAM(3);
#if DEBUG_CMP >= 0
#if MC_VALU_STATE == 4
    PH(4, p4_mlstm_chunk(lds, args); xcd_barrier(bar); p4_mlstm(lds, args));
#else
    PH(4, p4_mlstm_chunk(lds, args); xcd_barrier(bar); dbg_copy(args); xcd_barrier(bar); p4_mlstm(lds, args); xcd_barrier(bar); dbg_compare(args));
#endif
#elif MLSTM_BOTH
    PH(4, p4_mlstm_chunk(lds, args); xcd_barrier(bar); p4_mlstm(lds, args));
#elif MLSTM_CHUNK
    PH(4, p4_mlstm_chunk(lds, args));
#else
    PH(4, p4_mlstm(lds, args));
#endif
    if (IN(5)) { p5_mlstm_norm(args); p5_mla(lds, args); if (PB(5)) { xcd_barrier(bar); p5_mla(lds, args); } } SEAM(5);
    gemm_wgm = WGM_WO; PH(6, GEMMA(pg8::EpiResidB, hcat, W_O0, M_TOK, DM, DM, zA, xb));
    PH(7, p7_layernorm_b(args, 0, true, zA, nullptr, xb, stats));
#if FFN_CHUNKED
#define FFN_UP(WGU, half) GEMM(pg8::EpiSwiGLU, WS_XB + (size_t)(half) * 8192 * DM * 2, WGU, 8192, GU_N, DM, (bf16_t*)(ws + WS_R) + (size_t)(half) * 8192 * FFH, FFH)
#define FFN_DOWN(WD, half, Cp, Zpp, lg, lb) GEMM(pg8::EpiResidLN, WS_R + (size_t)(half) * 8192 * FFH * 2, WD, 8192, DM, FFH, (Cp) + (size_t)(half) * 8192 * DM, (Zpp) + (size_t)(half) * 8192 * DM, stats + (half) * 8192, lg, lb, DM, DN_ALPHA)
    if (IN(8)) { gemm_wgm = WGM_UP; FFN_UP(W_GU0, 0); if (bx >= 192 && G == 256) transpose_late(lds, args, 64 + bx - 192); } SEAM(8);
    if (IN(9)) { gemm_wgm = WGM_DOWN; FFN_DOWN(W_D0, 0, xres, z, args.in[22], args.in[23]); gemm_wgm = WGM_UP; FFN_UP(W_GU0, 1); if (bx >= 192 && G == 256) transpose_late(lds, args, 128 + bx - 192);
                 xcd_barrier(bar); gemm_wgm = WGM_DOWN; FFN_DOWN(W_D0, 1, xres, z, args.in[22], args.in[23]); } SEAM(9);
#else
    gemm_wgm = WGM_UP; PH(8, GEMM(pg8::EpiSwiGLU, WS_XB, W_GU0, M_TOK, GU_N, DM, (bf16_t*)(ws + WS_R), FFH); if (bx >= 128 && G == 256) transpose_late(lds, args, 64 + bx - 128));
    gemm_wgm = WGM_DOWN; PH(9, GEMM(pg8::EpiResidLNB, WS_R, W_D0, M_TOK, DM, FFH, zB, zA, stats, args.in[22], args.in[23]));
#endif
    PH(10, p7_layernorm_b(args, 0, false, zB, nullptr, xb, stats));
    gemm_wgm = WGM_IN; PH(11, GEMM(pg8::EpiB<0>, WS_XB, W_C, M_TOK, C_NP, DM, (bf16_t*)(ws + WS_R), C_NP); if (bx >= 64 && G == 256) transpose_late(lds, args, 192 + bx - 64));
    PH(12, p12_blocks(args));
    gemm_wgm = 8; PH(13, GEMM(pg8::EpiB<1>, WS_AK, W_C1K, 4096, 256, 4096, (bf16_t*)(ws + WS_HK), 256);
           GEMMC(pg8::EpiB<1>, (bx + G - 16) % G, WS_AV, W_C1V, 4096, 256, 4096, (bf16_t*)(ws + WS_HV), 256);
           if (G == 256) { if (bx >= 32) transpose_late(lds, args, 384 + bx - 32); } else { for (int sl_ = bx; sl_ < LATE_SLOTS; sl_ += G) transpose_late(lds, args, sl_); for (int sl_ = bx; sl_ < LATE_D_SLOTS; sl_ += G) transpose_late_d(lds, args, sl_); });
    PH(14, GEMM(pg8::EpiB<0>, WS_HK, W_C2K, 4096, 256, 256, (bf16_t*)(ws + WS_KCMP), 256);
           GEMMC(pg8::EpiB<0>, (bx + G - 16) % G, WS_HV, W_C2V, 4096, 256, 256, (bf16_t*)(ws + WS_VCMP), 256));
#ifndef NSA_ALL
#define NSA_ALL 1
#endif
#if NSA_ALL
    if (IN(15)) { p15_17_nsa(lds, args); } SEAM(15);
#else
    if (IN(15)) { p15_cmp_attn(lds, args); } SEAM(15);
#ifndef NSA_MERGED
#define NSA_MERGED 1
#endif
#if NSA_MERGED
    if (IN(16)) { p1617_nsa_attn(lds, args); } SEAM(16);
#else
    if (IN(16)) { p16_nsa_attn<1>(lds, args); if (PB(16)) { xcd_barrier(bar); p15_cmp_attn(lds, args); xcd_barrier(bar); p16_nsa_attn<1>(lds, args); } } SEAM(16);
#ifndef PROBE_VAR
#define PROBE_VAR 0
#endif
    if (IN(17)) { p16_nsa_attn<2>(lds, args); if (PB(17)) { xcd_barrier(bar); p16_nsa_attn<2, PROBE_VAR>(lds, args); } } SEAM(17);
#endif
#endif
    gemm_wgm = WGM_WO; PH(18, GEMMA(pg8::EpiResidLNB, hcat, W_O1, M_TOK, DM, DM, zC, zB, stats, args.in[24], args.in[25]));
    PH(19, p7_layernorm_b(args, 1, true, zC, nullptr, xb, stats));
#if FFN_CHUNKED
    if (IN(20)) { gemm_wgm = WGM_UP; FFN_UP(W_GU1, 0); } SEAM(20);
    if (IN(21)) { gemm_wgm = WGM_DOWN; FFN_DOWN(W_D1, 0, xres, z, args.in[22] + DM, args.in[23] + DM); gemm_wgm = WGM_UP; FFN_UP(W_GU1, 1);
                  xcd_barrier(bar); gemm_wgm = WGM_DOWN; FFN_DOWN(W_D1, 1, xres, z, args.in[22] + DM, args.in[23] + DM); } SEAM(21);
#else
    gemm_wgm = WGM_UP; PH(20, GEMM(pg8::EpiSwiGLU, WS_XB, W_GU1, M_TOK, GU_N, DM, (bf16_t*)(ws + WS_R), FFH); if (bx >= 128 && G == 256) transpose_late_d(lds, args, bx - 128));
    gemm_wgm = WGM_DOWN; PH(21, GEMM(pg8::EpiResidLNB, WS_R, W_D1, M_TOK, DM, FFH, zD, zC, stats, args.in[22] + DM, args.in[23] + DM));
#endif
    PH(22, p7_layernorm_b(args, 1, false, zD, xres, nullptr, nullptr));
#if DEBUG_CMP >= 0
    if (IN(22)) { xcd_barrier(bar); if (bx == 0 && threadIdx.x == 0) { const unsigned long long* accum = (const unsigned long long*)(ws + WS_CTL + 32 * 1024); const float rel = sqrtf((float)((double)accum[0] / fmax((double)accum[1], 1.0)));
        float k = -20.0f * log10f(fmaxf(rel, 1e-6f)); k = fminf(fmaxf(rintf(k), 0.f), 89.f); xres[0] = 1000.0f + 100.0f * k; } }
#endif
#undef PH
#undef PB
#undef IN
#undef SEAM
#undef GEMM
#undef GEMMC
}

#ifndef MK_N_LAUNCHES
#define MK_N_LAUNCHES 1
#endif
extern "C" void kernel_launch(void* const* d_in, const int* in_sizes, int n_in, void* d_out, int out_size, void* d_ws, size_t ws_size, hipStream_t stream) {
    static int grid = 0;
    if (grid == 0) {
        if (n_in != 26 || in_sizes[0] != M_TOK * DM || out_size != M_TOK * DM || ws_size < WS_END) {
            fprintf(stderr, "kernel_launch: unexpected shapes (n_in %d, in0 %d, out %d, ws %zu, need %zu); nothing launched\n", n_in, n_in > 0 ? in_sizes[0] : -1, out_size, ws_size, (size_t)WS_END); grid = -1; return; }
        int dev = 0, cus = 0, per_cu = 0;
        if (hipGetDevice(&dev) != hipSuccess || hipDeviceGetAttribute(&cus, hipDeviceAttributeMultiprocessorCount, dev) != hipSuccess) { grid = -1; return; }
        if (hipFuncSetAttribute((const void*)fwd, hipFuncAttributeMaxDynamicSharedMemorySize, LDS_BYTES) != hipSuccess) { fprintf(stderr, "kernel_launch: hipFuncSetAttribute failed\n"); grid = -1; return; }
        if (hipOccupancyMaxActiveBlocksPerMultiprocessor(&per_cu, (const void*)fwd, NTHREADS, LDS_BYTES) != hipSuccess || per_cu < 1) { fprintf(stderr, "kernel_launch: occupancy query says %d blocks per CU\n", per_cu); (void)hipGetLastError(); grid = -1; return; }
        grid = cus;
    }
    if (grid < 0) return;
    (void)hipMemsetAsync((char*)d_ws + WS_CTL, 0, 64 * 1024, stream);
    Args a{};
    for (int i = 0; i < 26; ++i) a.in[i] = (const float*)d_in[i];
    a.out = (float*)d_out; a.ws = (unsigned char*)d_ws;
    unsigned char* ws = (unsigned char*)d_ws;
    const float* fg = a.in[19]; const float* fu = a.in[20]; const float* fd = a.in[21];
    const size_t LW = (size_t)DM * FFH;
    int j = 0;
    a.tj[j++] = TJob{a.in[1], nullptr, (bf16_t*)(ws + W_AB), DM, AB_IN, AB_NP, 0};
    a.tj[j++] = TJob{a.in[7], nullptr, (bf16_t*)(ws + W_UQ), 1024, 3072, 3072, 0};
    a.tj[j++] = TJob{a.in[8], nullptr, (bf16_t*)(ws + W_UKV), 512, 4096, 4096, 0};
    a.tj[j++] = TJob{a.in[9], nullptr, (bf16_t*)(ws + W_O0), DM, DM, DM, 0};
    a.tj[j++] = TJob{fg, fu, (bf16_t*)(ws + W_GU0), DM, FFH, GU_N, 1};
    a.tj[j++] = TJob{fd, nullptr, (bf16_t*)(ws + W_D0), FFH, DM, DM, 0};
    a.tj[j++] = TJob{a.in[10], nullptr, (bf16_t*)(ws + W_C), DM, C_IN, C_NP, 0};
    a.tj[j++] = TJob{a.in[14], nullptr, (bf16_t*)(ws + W_C1K), 4096, 256, 256, 0};
    a.tj[j++] = TJob{a.in[16], nullptr, (bf16_t*)(ws + W_C1V), 4096, 256, 256, 0};
    a.tj[j++] = TJob{a.in[15], nullptr, (bf16_t*)(ws + W_C2K), 256, 128, 256, 0};
    a.tj[j++] = TJob{a.in[17], nullptr, (bf16_t*)(ws + W_C2V), 256, 128, 256, 0};
    a.tj[j++] = TJob{a.in[18], nullptr, (bf16_t*)(ws + W_O1), DM, DM, DM, 0};
    a.tj[j++] = TJob{fg + LW, fu + LW, (bf16_t*)(ws + W_GU1), DM, FFH, GU_N, 1};
    a.tj[j++] = TJob{fd + LW, nullptr, (bf16_t*)(ws + W_D1), FFH, DM, DM, 0};
#if MK_N_LAUNCHES == 1
    a.ph_lo = 0; a.ph_hi = N_PHASES;
    hipLaunchKernelGGL(fwd, dim3(grid), dim3(NTHREADS), LDS_BYTES, stream, a);
#else
    for (int p = 0; p < N_PHASES; ++p) { a.ph_lo = p; a.ph_hi = p + 1; hipLaunchKernelGGL(fwd, dim3(grid), dim3(NTHREADS), LDS_BYTES, stream, a); }
#endif
    const hipError_t le = hipPeekAtLastError();
    if (le != hipSuccess) fprintf(stderr, "kernel_launch: launch failed: %s\n", hipGetErrorName(le));
}
```
